# Optimizing an MI355X kernel written in HIP

```python
import jax, jax.numpy as jnp
from jax import lax
import numpy as np

D_MODEL = 1024
BATCH = 16
SEQ = 2048
DEPTH = 4

N_MIXERS = 2
N_HGRN_LAYERS = (DEPTH + 1) // 2
N_DSA_LAYERS = DEPTH // 2
N_DENSE_LAYERS = (DEPTH + 1) // 2
N_MOE_LAYERS = DEPTH // 2

HG_HEADS = 8
HG_DK = D_MODEL // HG_HEADS
HG_DV = D_MODEL // HG_HEADS
HG_CHUNK = 64

DSA_HEADS = 8
DSA_HEAD_DIM = 128
DSA_Q_RANK = 256
DSA_KV_RANK = 256
IDX_HEADS = 8
IDX_DIM = 64
IDX_TOPK_MAX = 256
Q_BLOCK = 128

D_FF = 3584
N_EXPERTS = 8
TOP_K_EXPERTS = 2

ALPHA = (2 * DEPTH) ** 0.25
BETA = (8 * DEPTH) ** -0.25
LN_EPS = 1e-5
RMS_EPS = 1e-6
NEG_BIG = -1e30

kernel_name = 'hgrn2_dsa_moe_deepnorm_hybrid'


def layer_norm(x, g, b):
    xf = x.astype(jnp.float32)
    mu = jnp.mean(xf, axis=-1, keepdims=True)
    var = jnp.mean(jnp.square(xf - mu), axis=-1, keepdims=True)
    return ((xf - mu) * lax.rsqrt(var + LN_EPS) * g + b).astype(x.dtype)


def rms_norm(x, g):
    xf = x.astype(jnp.float32)
    ms = jnp.mean(jnp.square(xf), axis=-1, keepdims=True)
    return (xf * lax.rsqrt(ms + RMS_EPS) * g).astype(x.dtype)


def swiglu(h, w_gate_up, w_down):
    gate, up = jnp.split(h @ w_gate_up, 2, axis=-1)
    return (jax.nn.silu(gate) * up) @ w_down


def hgrn2_mixer(x, w_in, lb, norm_g, w_out):
    B, S, _ = x.shape
    nc = S // HG_CHUNK
    q, f_pre, inp, g = jnp.split(x @ w_in, 4, axis=-1)
    f_pre = f_pre.astype(jnp.float32)
    f = lb + (1.0 - lb) * jax.nn.sigmoid(f_pre)
    log_f = jnp.log(f)
    k = (1.0 - lb) * jax.nn.sigmoid(-f_pre)

    def to_chunks(t, d):
        return t.astype(jnp.float32).reshape(B, nc, HG_CHUNK, HG_HEADS, d).transpose(1, 0, 3, 2, 4)

    qc, kc, lfc = to_chunks(q, HG_DK), to_chunks(k, HG_DK), to_chunks(log_f, HG_DK)
    vc = to_chunks(inp, HG_DV)
    causal = jnp.tril(jnp.ones((HG_CHUNK, HG_CHUNK), dtype=bool))[:, :, None]

    def step(state, chunk):
        q_, k_, v_, lf_ = chunk
        b = jnp.cumsum(lf_, axis=2)
        diff = b[:, :, :, None, :] - b[:, :, None, :, :]
        decay = jnp.where(causal, jnp.exp(jnp.where(causal, diff, 0.0)), 0.0)
        scores = jnp.einsum('bhtd,bhtsd,bhsd->bhts', q_, decay, k_)
        o = (jnp.einsum('bhts,bhsv->bhtv', scores, v_)
             + jnp.einsum('bhtd,bhdv->bhtv', q_ * jnp.exp(b), state))
        b_last = b[:, :, -1:, :]
        state = (jnp.exp(b_last[:, :, 0, :])[..., None] * state
                 + jnp.einsum('bhsd,bhsv->bhdv', k_ * jnp.exp(b_last - b), v_))
        return state, o

    state0 = jnp.zeros((B, HG_HEADS, HG_DK, HG_DV), jnp.float32)
    _, o = lax.scan(step, state0, (qc, kc, vc, lfc))
    o = o.transpose(1, 0, 3, 2, 4).reshape(B, S, HG_HEADS, HG_DV)
    o = rms_norm(o, norm_g) * jax.nn.silu(g.astype(jnp.float32)).reshape(B, S, HG_HEADS, HG_DV)
    return o.astype(x.dtype).reshape(B, S, D_MODEL) @ w_out


def dsa_mixer(x, w_in, q_norm_g, kv_norm_g, w_uq, w_uk, w_uv, w_qidx, kidx_norm_g, kidx_norm_b, w_out):
    B, S, _ = x.shape
    topk = min(IDX_TOPK_MAX, S // 4)
    splits = [DSA_Q_RANK, DSA_Q_RANK + DSA_KV_RANK, DSA_Q_RANK + DSA_KV_RANK + IDX_DIM]
    c_q, c_kv, k_idx, w_idx = jnp.split(x @ w_in, splits, axis=-1)
    c_q = rms_norm(c_q, q_norm_g)
    c_kv = rms_norm(c_kv, kv_norm_g)
    q = (c_q @ w_uq).reshape(B, S, DSA_HEADS, DSA_HEAD_DIM)
    q_lat = jnp.einsum('bshd,hdc->bshc', q, w_uk)
    q_idx = (c_q @ w_qidx).reshape(B, S, IDX_HEADS, IDX_DIM)
    k_idx = layer_norm(k_idx, kidx_norm_g, kidx_norm_b)
    w_idx = w_idx.astype(jnp.float32) * (IDX_HEADS ** -0.5 * IDX_DIM ** -0.5)
    key_pos = jnp.arange(S)

    def block(blk):
        t0 = blk * Q_BLOCK
        sl = lambda t: lax.dynamic_slice_in_dim(t, t0, Q_BLOCK, axis=1)
        qi, wi, ql = sl(q_idx), sl(w_idx), sl(q_lat)
        q_pos = t0 + jnp.arange(Q_BLOCK)
        rel = jax.nn.relu(jnp.einsum('bthd,bsd->bths', qi, k_idx).astype(jnp.float32))
        idx_score = jnp.einsum('bths,bth->bts', rel, wi)
        causal = key_pos[None, :] <= q_pos[:, None]
        idx_score = jnp.where(causal[None], idx_score, NEG_BIG)
        _, sel = lax.top_k(idx_score, topk)
        valid = sel <= q_pos[None, :, None]
        kv_sel = jax.vmap(lambda c, s: c[s])(c_kv, sel)
        logits = jnp.einsum('bthc,btkc->bthk', ql, kv_sel).astype(jnp.float32) * (DSA_HEAD_DIM ** -0.5)
        logits = jnp.where(valid[:, :, None, :], logits, NEG_BIG)
        p = jax.nn.softmax(logits, axis=-1).astype(kv_sel.dtype)
        return jnp.einsum('bthk,btkc->bthc', p, kv_sel)

    o_lat = lax.map(block, jnp.arange(S // Q_BLOCK))
    o_lat = jnp.moveaxis(o_lat, 0, 1).reshape(B, S, DSA_HEADS, DSA_KV_RANK)
    o = jnp.einsum('bshc,hcd->bshd', o_lat, w_uv).reshape(B, S, DSA_HEADS * DSA_HEAD_DIM)
    return o @ w_out


def moe_swiglu(h, w_router, w_gate_up, w_down):
    logits = (h @ w_router).astype(jnp.float32)
    top_vals, top_idx = lax.top_k(logits, TOP_K_EXPERTS)
    top_w = jax.nn.softmax(top_vals, axis=-1)
    gates = jnp.sum(jax.nn.one_hot(top_idx, N_EXPERTS, dtype=jnp.float32) * top_w[..., None], axis=-2)
    y = jnp.zeros_like(h)
    for e in range(N_EXPERTS):
        y = y + gates[..., e:e + 1].astype(h.dtype) * swiglu(h, w_gate_up[e], w_down[e])
    return y


def setup_inputs(seed: int = 0) -> dict:
    key = jax.random.key(seed)
    ks = iter(jax.random.split(key, 32))

    def w(shape, fan_in, scale=1.0):
        return jax.random.normal(next(ks), shape, jnp.float32) * (scale * fan_in ** -0.5)

    def near_one(shape):
        return 1.0 + 0.02 * jax.random.normal(next(ks), shape, jnp.float32)

    def small(shape, s=0.02):
        return s * jax.random.normal(next(ks), shape, jnp.float32)

    dsa_in_width = DSA_Q_RANK + DSA_KV_RANK + IDX_DIM + IDX_HEADS
    x = jax.random.normal(next(ks), (BATCH, SEQ, D_MODEL), jnp.float32)
    return {
        'x': x,
        'ln_g': near_one((DEPTH, 2, D_MODEL)),
        'ln_b': small((DEPTH, 2, D_MODEL)),
        'hg_w_in': w((N_HGRN_LAYERS, D_MODEL, 4 * D_MODEL), D_MODEL),
        'hg_lower_bounds': small((N_HGRN_LAYERS, D_MODEL), 0.5),
        'hg_norm_g': near_one((N_HGRN_LAYERS, HG_HEADS, HG_DV)),
        'hg_w_out': w((N_HGRN_LAYERS, D_MODEL, D_MODEL), D_MODEL, BETA),
        'dsa_w_in': w((N_DSA_LAYERS, D_MODEL, dsa_in_width), D_MODEL),
        'dsa_q_norm_g': near_one((N_DSA_LAYERS, DSA_Q_RANK)),
        'dsa_kv_norm_g': near_one((N_DSA_LAYERS, DSA_KV_RANK)),
        'dsa_w_uq': w((N_DSA_LAYERS, DSA_Q_RANK, DSA_HEADS * DSA_HEAD_DIM), DSA_Q_RANK),
        'dsa_w_uk': w((N_DSA_LAYERS, DSA_HEADS, DSA_HEAD_DIM, DSA_KV_RANK), DSA_HEAD_DIM),
        'dsa_w_uv': w((N_DSA_LAYERS, DSA_HEADS, DSA_KV_RANK, DSA_HEAD_DIM), DSA_KV_RANK),
        'dsa_w_qidx': w((N_DSA_LAYERS, DSA_Q_RANK, IDX_HEADS * IDX_DIM), DSA_Q_RANK),
        'dsa_kidx_norm_g': near_one((N_DSA_LAYERS, IDX_DIM)),
        'dsa_kidx_norm_b': small((N_DSA_LAYERS, IDX_DIM)),
        'dsa_w_out': w((N_DSA_LAYERS, DSA_HEADS * DSA_HEAD_DIM, D_MODEL), DSA_HEADS * DSA_HEAD_DIM, BETA),
        'ffn_w_gate_up': w((N_DENSE_LAYERS, D_MODEL, 2 * D_FF), D_MODEL),
        'ffn_w_down': w((N_DENSE_LAYERS, D_FF, D_MODEL), D_FF, BETA),
        'moe_w_router': w((N_MOE_LAYERS, D_MODEL, N_EXPERTS), D_MODEL),
        'moe_w_gate_up': w((N_MOE_LAYERS, N_EXPERTS, D_MODEL, 2 * D_FF), D_MODEL),
        'moe_w_down': w((N_MOE_LAYERS, N_EXPERTS, D_FF, D_MODEL), D_FF, BETA),
    }


def reference(x, ln_g, ln_b, hg_w_in, hg_lower_bounds, hg_norm_g, hg_w_out, dsa_w_in, dsa_q_norm_g,
              dsa_kv_norm_g, dsa_w_uq, dsa_w_uk, dsa_w_uv, dsa_w_qidx, dsa_kidx_norm_g, dsa_kidx_norm_b,
              dsa_w_out, ffn_w_gate_up, ffn_w_down, moe_w_router, moe_w_gate_up, moe_w_down):
    lb_all = jax.nn.softmax(hg_lower_bounds.astype(jnp.float32), axis=0)
    lb_all = jnp.cumsum(lb_all, axis=0) - lb_all[0]
    for layer in range(DEPTH):
        j = layer // N_MIXERS
        if layer % N_MIXERS == 0:
            mix = hgrn2_mixer(x, hg_w_in[j], lb_all[j], hg_norm_g[j], hg_w_out[j])
        else:
            mix = dsa_mixer(x, dsa_w_in[j], dsa_q_norm_g[j], dsa_kv_norm_g[j], dsa_w_uq[j], dsa_w_uk[j],
                            dsa_w_uv[j], dsa_w_qidx[j], dsa_kidx_norm_g[j], dsa_kidx_norm_b[j], dsa_w_out[j])
        x = layer_norm(ALPHA * x + mix, ln_g[layer, 0], ln_b[layer, 0])
        m = layer // 2
        if layer % 2 == 0:
            ff = swiglu(x, ffn_w_gate_up[m], ffn_w_down[m])
        else:
            ff = moe_swiglu(x, moe_w_router[m], moe_w_gate_up[m], moe_w_down[m])
        x = layer_norm(ALPHA * x + ff, ln_g[layer, 1], ln_b[layer, 1])
    return x
```

```cpp
#include <hip/hip_runtime.h>
#include <cstdio>
#include <cstdint>

#ifndef MK_DEBUG_SCAN
#define MK_DEBUG_SCAN 0
#endif
#ifndef MK_N_LAUNCHES
#define MK_N_LAUNCHES 1
#endif

#define GAS __attribute__((address_space(1)))
#define LAS __attribute__((address_space(3)))
typedef unsigned short bf16_t;
typedef short bf16x8 __attribute__((ext_vector_type(8)));
typedef short s16x4 __attribute__((ext_vector_type(4)));
typedef float f32x4 __attribute__((ext_vector_type(4)));
typedef float f32x2 __attribute__((ext_vector_type(2)));
typedef unsigned u32x4 __attribute__((ext_vector_type(4)));
typedef unsigned u32x2 __attribute__((ext_vector_type(2)));

constexpr int D = 1024, BATCH = 16, SEQ = 2048, M = BATCH * SEQ;
constexpr int DFF = 3584, NEXP = 8;
constexpr int HG_H = 8, HG_DK = 128, HG_C = 64;
constexpr int QR = 256, KVR = 256, IDXD = 64, IDXH = 8, DSA_H = 8, DSA_HD = 128, TOPK = 256;
constexpr int DSA_IN = 584, DSA_IN_PAD = 768;
constexpr int MOE_ROWS = 2 * M + NEXP * 256;
constexpr float ALPHA = 1.6817928305074290f;
constexpr float LN_EPS = 1e-5f, RMS_EPS = 1e-6f;
constexpr int NWAVES = 8, NTHREADS = 512;

constexpr size_t MiB = 1u << 20;
constexpr size_t WS_CTL = 0, CTL_ZERO_BYTES = 1 * MiB;
constexpr size_t WS_W_HGIN = 1 * MiB;
constexpr size_t WS_W_HGOUT = 17 * MiB;
constexpr size_t WS_W_FGU = 21 * MiB;
constexpr size_t WS_W_FDN = 49 * MiB;
constexpr size_t WS_W_DIN = 63 * MiB;
constexpr size_t WS_W_DQ = 66 * MiB;
constexpr size_t WS_W_DO = 69 * MiB;
constexpr size_t WS_W_MGU = 77 * MiB;
constexpr size_t WS_W_MDN = 301 * MiB;
constexpr size_t WS_X = 416 * MiB;
constexpr size_t WS_XB = 544 * MiB;
constexpr size_t WS_Y = 608 * MiB;
constexpr size_t WS_A = 736 * MiB;
constexpr size_t WS_H = 1184 * MiB;
constexpr size_t WS_END = 1648 * MiB;
constexpr size_t A_HQ = 0, A_HV = 64 * MiB, A_HG = 128 * MiB, A_HF = 192 * MiB, A_HO = 320 * MiB, A_HOG = 384 * MiB;
constexpr size_t A_RAW = 0, A_CQ = 96 * MiB, A_CKV = 112 * MiB, A_KIDX = 128 * MiB, A_WIDX = 132 * MiB, A_MASK = 136 * MiB, A_QLAT = 144 * MiB, A_QIDX = 272 * MiB, A_OLAT = 304 * MiB;
constexpr size_t A_XG = 0, A_OUTM = 136 * MiB, A_EIDX = 404 * MiB, A_POS = 405 * MiB, A_TOPW = 406 * MiB, A_SLOT = 407 * MiB, A_GATE = 408 * MiB;
constexpr int CW_BAR = 4096, CW_MOE = 16384;

constexpr int RING_BYTES = 131072;
constexpr int LDSCTL_OFF = RING_BYTES, MISC_OFF = LDSCTL_OFF + 320;
constexpr int LDS_BYTES = 147456;

typedef __bf16 hwbf16x2 __attribute__((ext_vector_type(2)));
__device__ __forceinline__ unsigned cvt_pk_bf16(float lo, float hi) { const f32x2 v = {lo, hi}; const hwbf16x2 b = __builtin_convertvector(v, hwbf16x2); return __builtin_bit_cast(unsigned, b); }
__device__ __forceinline__ bf16_t f2bf(float f) { return (bf16_t)(cvt_pk_bf16(f, 0.f) & 0xffffu); }
__device__ __forceinline__ float bf2f(bf16_t b) { return __uint_as_float(((unsigned)b) << 16); }
__device__ __forceinline__ float wave_sum(float v) {
#pragma unroll
    for (int o = 1; o < 64; o <<= 1) v += __shfl_xor(v, o);
    return v;
}
__device__ __forceinline__ float fast_exp2(float x) { return __builtin_amdgcn_exp2f(x); }
__device__ __forceinline__ float fast_rcp(float x) { return __builtin_amdgcn_rcpf(x); }
__device__ __forceinline__ float sigmoidf_(float x) { return fast_rcp(1.0f + __expf(-x)); }
__device__ __forceinline__ float siluf_(float x) { return x * sigmoidf_(x); }
#define LDS_WAIT() asm volatile("s_waitcnt lgkmcnt(0)" ::: "memory")
#define VM_WAIT() asm volatile("s_waitcnt vmcnt(0)" ::: "memory")

#define XB_TMO      128
#define XB_XCNT(j)  (256  + 64 * (j))
#define XB_XSUB(j)  (1280 + 64 * (j))
#define XB_XGEN(j)  (2304 + 64 * (j))
#define XB_TOP      3328
#define XB_TOPGEN   3392
#define XCD_BAR_WORDS 3456
#define XB_SPIN_CAP (1u << 20)

__device__ __forceinline__ unsigned xb_ld(unsigned* p)              { return __hip_atomic_load(p, __ATOMIC_RELAXED, __HIP_MEMORY_SCOPE_AGENT); }
__device__ __forceinline__ unsigned xb_add(unsigned* p, unsigned v) { return __hip_atomic_fetch_add(p, v, __ATOMIC_RELAXED, __HIP_MEMORY_SCOPE_AGENT); }
__device__ __forceinline__ unsigned xb_xcc_id() { return (unsigned)__builtin_amdgcn_s_getreg((3 << 11) | 20) & 0xFu; }
#define XB_SPIN(cond, bar) do { unsigned _sp = 0; while (cond) { __builtin_amdgcn_s_sleep(1); \
    if ((++_sp & 255u) == 0u) { if (xb_ld(&(bar)[XB_TMO])) break; if (_sp > XB_SPIN_CAP) { atomicAdd(&(bar)[XB_TMO], 1u); break; } } } } while (0)

struct XcdBarrier { unsigned* bar; unsigned x; volatile LAS unsigned* st; };

__device__ __forceinline__ XcdBarrier xcd_barrier_post(unsigned* bar, volatile LAS unsigned* st) {
    XcdBarrier b; b.bar = bar; b.x = xb_xcc_id(); b.st = st;
    if (threadIdx.x == 0) (void)xb_add(&bar[XB_XCNT(b.x)], 1u);
    return b;
}
__device__ __forceinline__ void xcd_barrier_complete(unsigned* bar, unsigned x, unsigned& nloc, unsigned& nx) {
    const unsigned G = gridDim.x * gridDim.y * gridDim.z;
    unsigned sum, cnt, mine, sp = 0u;
    for (;;) {
        sum = 0u; cnt = 0u; mine = 0u;
#pragma unroll
        for (unsigned j = 0; j < 16; ++j) { const unsigned c = xb_ld(&bar[XB_XCNT(j)]); sum += c; cnt += (c > 0u) ? 1u : 0u; mine = (j == x) ? c : mine; }
        if (sum == G) break;
        __builtin_amdgcn_s_sleep(1);
        if ((++sp & 255u) == 0u) { if (xb_ld(&bar[XB_TMO])) break; if (sp > XB_SPIN_CAP) { atomicAdd(&bar[XB_TMO], 1u); break; } }
    }
    nloc = mine > 0u ? mine : 1u; nx = cnt > 0u ? cnt : 1u;
}
__device__ __forceinline__ void xcd_barrier(const XcdBarrier& b) {
    asm volatile("s_waitcnt vmcnt(0)" ::: "memory");
    __syncthreads();
    if (threadIdx.x == 0) {
        unsigned* bar = b.bar;
        __builtin_amdgcn_s_waitcnt(0);
        unsigned nloc = b.st[0], nx = b.st[1];
        if (nloc == 0u) { xcd_barrier_complete(bar, b.x, nloc, nx); b.st[0] = nloc; b.st[1] = nx; }
        const unsigned old = xb_add(&bar[XB_XSUB(b.x)], 1u);
        const unsigned gen = old / nloc;
        if (old + 1u == (gen + 1u) * nloc) {
            __builtin_amdgcn_fence(__ATOMIC_RELEASE, "agent");
            asm volatile("s_waitcnt vmcnt(0)" ::: "memory");
            const unsigned og = xb_add(&bar[XB_TOP], 1u);
            const unsigned tg = og / nx;
            if (og + 1u == (tg + 1u) * nx) xb_add(&bar[XB_TOPGEN], 1u);
            else XB_SPIN(xb_ld(&bar[XB_TOPGEN]) == tg, bar);
            __builtin_amdgcn_fence(__ATOMIC_ACQUIRE, "agent");
            xb_add(&bar[XB_XGEN(b.x)], 1u);
            asm volatile("s_waitcnt vmcnt(0)" ::: "memory");
        } else {
            XB_SPIN(xb_ld(&bar[XB_XGEN(b.x)]) == gen, bar);
            __builtin_amdgcn_fence(__ATOMIC_ACQUIRE, "agent");
            asm volatile("s_waitcnt vmcnt(0)" ::: "memory");
        }
    }
    __syncthreads();
}

constexpr int BM = 256, BK = 64, HALF = 128, HTB = HALF * BK * 2, NXCD = 8, WGM = 8;
__device__ __forceinline__ int lds_byte(int r, int c) { const int st = (r >> 4) * 2 + (c >> 5), rr = r & 15, cc = c & 31, ob = rr * 64 + cc * 2; return st * 1024 + (ob ^ (((ob >> 9) & 1) << 5)); }
__device__ __forceinline__ void stage_rc(int b, int& R, int& C) { const int st = b / 1024, sb = b % 1024, swz = sb ^ (((sb >> 9) & 1) << 5); R = (st >> 1) * 16 + swz / 64; C = (st & 1) * 32 + (swz % 64) / 2; }
__device__ __forceinline__ int perm32(int rho) { const int n = rho >> 4, i = rho & 15; return 8 * (i >> 2) + 4 * n + (i & 3); }

struct Unit { int pm, pn, pb; };
struct Gemm { const bf16_t* A; const bf16_t* Bt; int K; };

__device__ __forceinline__ void tile_map(int L, int nM, int nN, int& pm, int& pn) {
    const int nwg = nM * nN;
    int wgid = L; { const int q = nwg / NXCD, r = nwg % NXCD, xcd = wgid % NXCD, off = wgid / NXCD; wgid = (xcd < r ? xcd * (q + 1) : r * (q + 1) + (xcd - r) * q) + off; }
    const int nig = WGM * nN, gid = wgid / nig, fm = gid * WGM, gsz = (nM - fm) < WGM ? (nM - fm) : WGM;
    pm = fm + ((wgid % nig) % gsz); pn = (wgid % nig) / gsz;
}
struct StaticOrder {
    int nM, nN, nwg, G, c;
    __device__ __forceinline__ void init(int M_, int N_, int G_, int c_) { nM = M_ / BM; nN = N_ / BM; nwg = nM * nN; G = G_; c = c_; }
    __device__ __forceinline__ bool next(int i, Unit& u) const {
        const long L = (long)i * G + c; if (L >= nwg) return false;
        tile_map((int)L, nM, nN, u.pm, u.pn); u.pb = u.pn; return true;
    }
};
struct MoeOrder {
    int t1, t2, t3, t4, t5, t6, t7, nM, nN, nwg, G, c;
    __device__ __forceinline__ void init(const unsigned* cnt, int nN_, int G_, int c_) {
        int t = 0, o[9];
#pragma unroll
        for (int e = 0; e < 8; ++e) { o[e] = t; const int ce = __builtin_amdgcn_readfirstlane((int)__hip_atomic_load(cnt + e, __ATOMIC_RELAXED, __HIP_MEMORY_SCOPE_AGENT)); t += (ce + 255) >> 8; }
        o[8] = t; t1 = o[1]; t2 = o[2]; t3 = o[3]; t4 = o[4]; t5 = o[5]; t6 = o[6]; t7 = o[7];
        nM = t; nN = nN_; nwg = nM * nN; G = G_; c = c_;
    }
    __device__ __forceinline__ bool next(int i, Unit& u) const {
        const long L = (long)i * G + c; if (L >= nwg) return false;
        tile_map((int)L, nM, nN, u.pm, u.pn);
        const int e = (u.pm >= t1) + (u.pm >= t2) + (u.pm >= t3) + (u.pm >= t4) + (u.pm >= t5) + (u.pm >= t6) + (u.pm >= t7);
        u.pb = e * nN + u.pn; return true;
    }
};

typedef f32x4 Acc[2][2][4][2];

template <class Epi, class Sched>
__device__ __forceinline__ void gemm_phase(LAS unsigned char* lds, const Gemm g, const Sched& S, const Epi& E) {
    int tid_ = threadIdx.x; asm volatile("" : "+v"(tid_));
    const int tid = tid_, wid = __builtin_amdgcn_readfirstlane(tid >> 6), lane = tid & 63, wr = wid >> 2, wc = wid & 3, fr = lane & 15, fq = lane >> 4;
    const int K = g.K, nt = K / BK;
    unsigned voffA[2], voffB[2];
#pragma unroll
    for (int i = 0; i < 2; ++i) { int R, C; stage_rc(tid * 16 + i * 8192, R, C); const int Rb = (R & ~31) + perm32(R & 31);
        voffA[i] = (unsigned)(R * K + C) * 2u; voffB[i] = (unsigned)(Rb * K + C) * 2u; }
    const size_t kstep = (size_t)(BK * 2);
    const size_t hstep = (size_t)HALF * K * 2;
    const size_t tstep = 2 * hstep;
    const unsigned ldsw = (unsigned)wid * 1024u;
    const int aoff = lds_byte(wr * 64 + fr, fq * 8), boff = lds_byte(wc * 32 + fr, fq * 8);
#define PG8_SA(b, h) (((b) * 2 + (h)) * HTB)
#define PG8_SB(b, h) ((4 + (b) * 2 + (h)) * HTB)
#define PG8_STAGE(bufoff, gbase, voff) do { _Pragma("unroll") for (int _i = 0; _i < 2; ++_i) \
        __builtin_amdgcn_global_load_lds((const unsigned*)((const char*)(gbase) + (voff)[_i]), (LAS unsigned*)(lds + (bufoff) + ldsw + _i * 8192), 16, 0, 0); } while (0)
#define PG8_LDA(dst, b, h) do { _Pragma("unroll") for (int m = 0; m < 4; ++m) _Pragma("unroll") for (int k = 0; k < 2; ++k) dst[m][k] = *(const LAS bf16x8*)(lds + PG8_SA(b, h) + aoff + m * 2048 + k * 1024); } while (0)
#define PG8_LDB(dst, b, h) do { _Pragma("unroll") for (int n = 0; n < 2; ++n) _Pragma("unroll") for (int k = 0; k < 2; ++k) dst[n][k] = *(const LAS bf16x8*)(lds + PG8_SB(b, h) + boff + n * 2048 + k * 1024); } while (0)
#define PG8_MMA(ai, bj, At, Bt) do { __builtin_amdgcn_s_setprio(1); _Pragma("unroll") for (int m = 0; m < 4; ++m) _Pragma("unroll") for (int n = 0; n < 2; ++n) _Pragma("unroll") for (int k = 0; k < 2; ++k) \
        acc[ai][bj][m][n] = __builtin_amdgcn_mfma_f32_16x16x32_bf16(Bt[n][k], At[m][k], acc[ai][bj][m][n], 0, 0, 0); __builtin_amdgcn_s_setprio(0); } while (0)
#define PG8_WAIT_V(n) asm volatile("s_waitcnt vmcnt(" #n ")" ::: "memory")
#define PG8_WAIT_L(n) asm volatile("s_waitcnt lgkmcnt(" #n ")" ::: "memory")
#define PG8_BAR __builtin_amdgcn_s_barrier()
#define PG8_SCHED __builtin_amdgcn_sched_barrier(0)
    Unit cur, nxt; int ui = 0;
    if (!S.next(0, cur)) return;
    Acc acc;
#pragma unroll
    for (int a = 0; a < 2; ++a)
#pragma unroll
        for (int b = 0; b < 2; ++b)
#pragma unroll
            for (int m = 0; m < 4; ++m)
#pragma unroll
                for (int n = 0; n < 2; ++n) acc[a][b][m][n] = (f32x4){0.f, 0.f, 0.f, 0.f};
    bf16x8 At[4][2], B0[2][2], B1[2][2];
    const char* cA = (const char*)g.A + (size_t)cur.pm * tstep; const char* cB = (const char*)g.Bt + (size_t)cur.pb * tstep;
    PG8_STAGE(PG8_SB(0, 0), cB, voffB); PG8_STAGE(PG8_SA(0, 0), cA, voffA); PG8_STAGE(PG8_SB(0, 1), cB + hstep, voffB); PG8_STAGE(PG8_SA(0, 1), cA + hstep, voffA);
    if (wr == 1) PG8_BAR;
    PG8_WAIT_V(4); PG8_BAR;
    PG8_STAGE(PG8_SB(1, 0), cB + kstep, voffB); PG8_STAGE(PG8_SA(1, 0), cA + kstep, voffA); PG8_STAGE(PG8_SB(1, 1), cB + hstep + kstep, voffB);
    PG8_WAIT_V(6); PG8_BAR;
    for (;;) {
        const bool has_next = S.next(ui + 1, nxt);
        const char* nA = has_next ? (const char*)g.A + (size_t)nxt.pm * tstep : cA; const char* nB = has_next ? (const char*)g.Bt + (size_t)nxt.pb * tstep : cB;
        for (int t = 0; t < nt; t += 2) {
            const bool last = (t == nt - 2);
            const char* a1 = cA + (size_t)(t + 1) * kstep;
            const char* a2 = last ? nA : cA + (size_t)(t + 2) * kstep; const char* b2 = last ? nB : cB + (size_t)(t + 2) * kstep;
            const char* a3 = a2 + kstep; const char* b3 = b2 + kstep;
            PG8_LDB(B0, 0, 0); PG8_SCHED; PG8_LDA(At, 0, 0); PG8_STAGE(PG8_SA(1, 1), a1 + hstep, voffA);
            PG8_WAIT_L(8); PG8_BAR; PG8_WAIT_L(0); PG8_MMA(0, 0, At, B0); PG8_BAR; PG8_SCHED;
            PG8_LDB(B1, 0, 1); PG8_STAGE(PG8_SB(0, 0), b2, voffB);
            PG8_BAR; PG8_WAIT_L(0); PG8_MMA(0, 1, At, B1); PG8_BAR;
            PG8_LDA(At, 0, 1); PG8_STAGE(PG8_SA(0, 0), a2, voffA);
            PG8_BAR; PG8_WAIT_L(0); PG8_MMA(1, 0, At, B0); PG8_BAR; PG8_SCHED;
            PG8_STAGE(PG8_SB(0, 1), b2 + hstep, voffB);
            PG8_WAIT_V(6); PG8_BAR; PG8_MMA(1, 1, At, B1); PG8_BAR;
            PG8_LDB(B0, 1, 0); PG8_SCHED; PG8_LDA(At, 1, 0); PG8_STAGE(PG8_SA(0, 1), a2 + hstep, voffA);
            PG8_WAIT_L(8); PG8_BAR; PG8_WAIT_L(0); PG8_MMA(0, 0, At, B0); PG8_BAR; PG8_SCHED;
            PG8_LDB(B1, 1, 1); PG8_STAGE(PG8_SB(1, 0), b3, voffB);
            PG8_BAR; PG8_WAIT_L(0); PG8_MMA(0, 1, At, B1); PG8_BAR;
            PG8_LDA(At, 1, 1); PG8_STAGE(PG8_SA(1, 0), a3, voffA);
            PG8_BAR; PG8_WAIT_L(0); PG8_MMA(1, 0, At, B0); PG8_BAR; PG8_SCHED;
            PG8_STAGE(PG8_SB(1, 1), b3 + hstep, voffB);
            PG8_WAIT_V(6); PG8_BAR; PG8_MMA(1, 1, At, B1); PG8_BAR;
        }
        E(acc, cur, wr, wc, fr, fq);
        if (!has_next) break;
#pragma unroll
        for (int a = 0; a < 2; ++a)
#pragma unroll
            for (int b = 0; b < 2; ++b)
#pragma unroll
                for (int m = 0; m < 4; ++m)
#pragma unroll
                    for (int n = 0; n < 2; ++n) acc[a][b][m][n] = (f32x4){0.f, 0.f, 0.f, 0.f};
        cur = nxt; cA = nA; cB = nB; ++ui;
    }
    PG8_WAIT_V(0);
    if (wr == 0) PG8_BAR;
    PG8_BAR;
#undef PG8_SA
#undef PG8_SB
#undef PG8_STAGE
#undef PG8_LDA
#undef PG8_LDB
#undef PG8_MMA
#undef PG8_WAIT_V
#undef PG8_WAIT_L
#undef PG8_BAR
#undef PG8_SCHED
}

__device__ __forceinline__ u32x4 pack8(const f32x4 a, const f32x4 b) { u32x4 w; w.x = cvt_pk_bf16(a[0], a[1]); w.y = cvt_pk_bf16(a[2], a[3]); w.z = cvt_pk_bf16(b[0], b[1]); w.w = cvt_pk_bf16(b[2], b[3]); return w; }

struct EpiHgIn {
    bf16_t* QVG; float* F;
    __device__ __forceinline__ void operator()(const Acc& acc, const Unit& u, int wr, int wc, int fr, int fq) const {
        const int part = u.pn >> 2, row0 = u.pm * BM + wr * 64 + fr, col0 = (u.pn & 3) * 256 + wc * 32 + 8 * fq;
        if (part == 1) {
#pragma unroll
            for (int ai = 0; ai < 2; ++ai)
#pragma unroll
                for (int m = 0; m < 4; ++m) { float* rowp = F + (size_t)(row0 + ai * HALF + m * 16) * D + col0;
#pragma unroll
                    for (int bj = 0; bj < 2; ++bj) { *(f32x4*)(rowp + bj * HALF) = acc[ai][bj][m][0]; *(f32x4*)(rowp + bj * HALF + 4) = acc[ai][bj][m][1]; } }
        } else {
            bf16_t* base = QVG + (size_t)(part == 0 ? 0 : part - 1) * ((size_t)M * D);
#pragma unroll
            for (int ai = 0; ai < 2; ++ai)
#pragma unroll
                for (int m = 0; m < 4; ++m) { bf16_t* rowp = base + (size_t)(row0 + ai * HALF + m * 16) * D + col0;
#pragma unroll
                    for (int bj = 0; bj < 2; ++bj) *(u32x4*)(rowp + bj * HALF) = pack8(acc[ai][bj][m][0], acc[ai][bj][m][1]); }
        }
    }
};
struct EpiRes {
    const float* X; float* Y;
    __device__ __forceinline__ void operator()(const Acc& acc, const Unit& u, int wr, int wc, int fr, int fq) const {
        const int row0 = u.pm * BM + wr * 64 + fr, col0 = u.pn * BM + wc * 32 + 8 * fq;
#pragma unroll
        for (int ai = 0; ai < 2; ++ai)
#pragma unroll
            for (int m = 0; m < 4; ++m) { const size_t o = (size_t)(row0 + ai * HALF + m * 16) * D + col0;
#pragma unroll
                for (int bj = 0; bj < 2; ++bj) {
                    const f32x4 x0 = *(const f32x4*)(X + o + bj * HALF), x1 = *(const f32x4*)(X + o + bj * HALF + 4);
                    *(f32x4*)(Y + o + bj * HALF) = x0 * ALPHA + acc[ai][bj][m][0]; *(f32x4*)(Y + o + bj * HALF + 4) = x1 * ALPHA + acc[ai][bj][m][1]; } }
    }
};
struct EpiSwiglu {
    bf16_t* H;
    __device__ __forceinline__ void operator()(const Acc& acc, const Unit& u, int wr, int wc, int fr, int fq) const {
        const int row0 = u.pm * BM + wr * 64 + fr, col0 = u.pn * 128 + wc * 32 + 8 * fq;
#pragma unroll
        for (int ai = 0; ai < 2; ++ai)
#pragma unroll
            for (int m = 0; m < 4; ++m) { bf16_t* rowp = H + (size_t)(row0 + ai * HALF + m * 16) * DFF + col0;
                f32x4 h0, h1;
#pragma unroll
                for (int j = 0; j < 4; ++j) { h0[j] = siluf_(acc[ai][0][m][0][j]) * acc[ai][1][m][0][j]; h1[j] = siluf_(acc[ai][0][m][1][j]) * acc[ai][1][m][1][j]; }
                *(u32x4*)rowp = pack8(h0, h1); }
    }
};
struct EpiF32 {
    float* C; int ldc;
    __device__ __forceinline__ void operator()(const Acc& acc, const Unit& u, int wr, int wc, int fr, int fq) const {
        const int row0 = u.pm * BM + wr * 64 + fr, col0 = u.pn * BM + wc * 32 + 8 * fq;
#pragma unroll
        for (int ai = 0; ai < 2; ++ai)
#pragma unroll
            for (int m = 0; m < 4; ++m) { float* rowp = C + (size_t)(row0 + ai * HALF + m * 16) * ldc + col0;
#pragma unroll
                for (int bj = 0; bj < 2; ++bj) { *(f32x4*)(rowp + bj * HALF) = acc[ai][bj][m][0]; *(f32x4*)(rowp + bj * HALF + 4) = acc[ai][bj][m][1]; } }
    }
};
struct EpiQ {
    bf16_t* QLAT; bf16_t* QIDX;
    __device__ __forceinline__ void operator()(const Acc& acc, const Unit& u, int wr, int wc, int fr, int fq) const {
        const bool lat = u.pn < 8; bf16_t* base = lat ? QLAT : QIDX; const int ld = lat ? 2048 : 512;
        const int row0 = u.pm * BM + wr * 64 + fr, col0 = (lat ? u.pn : u.pn - 8) * BM + wc * 32 + 8 * fq;
#pragma unroll
        for (int ai = 0; ai < 2; ++ai)
#pragma unroll
            for (int m = 0; m < 4; ++m) { bf16_t* rowp = base + (size_t)(row0 + ai * HALF + m * 16) * ld + col0;
#pragma unroll
                for (int bj = 0; bj < 2; ++bj) *(u32x4*)(rowp + bj * HALF) = pack8(acc[ai][bj][m][0], acc[ai][bj][m][1]); }
    }
};
struct EpiMoeDn {
    float* O; const float* gate;
    __device__ __forceinline__ void operator()(const Acc& acc, const Unit& u, int wr, int wc, int fr, int fq) const {
        const int row0 = u.pm * BM + wr * 64 + fr, col0 = u.pn * BM + wc * 32 + 8 * fq;
#pragma unroll
        for (int ai = 0; ai < 2; ++ai)
#pragma unroll
            for (int m = 0; m < 4; ++m) { const int row = row0 + ai * HALF + m * 16; const float gv = gate[row]; float* rowp = O + (size_t)row * D + col0;
#pragma unroll
                for (int bj = 0; bj < 2; ++bj) { *(f32x4*)(rowp + bj * HALF) = acc[ai][bj][m][0] * gv; *(f32x4*)(rowp + bj * HALF + 4) = acc[ai][bj][m][1] * gv; } }
    }
};

struct Params { const float* in[22]; float* out; unsigned char* ws; int ph_lo, ph_hi; };
enum { IN_X = 0, IN_LNG, IN_LNB, IN_HGWIN, IN_HGLB, IN_HGNG, IN_HGWOUT, IN_DWIN, IN_DQNG, IN_DKVNG, IN_DWUQ, IN_DWUK, IN_DWUV, IN_DWQIDX, IN_DKIG, IN_DKIB, IN_DWOUT, IN_FGU, IN_FDN, IN_MR, IN_MGU, IN_MDN };

__device__ __forceinline__ const float* inptr(int i) {
    int off = i * 8; asm volatile("" : "+s"(off));
    typedef const float* cfp;
    return *(const __attribute__((address_space(4))) cfp*)((const __attribute__((address_space(4))) char*)__builtin_amdgcn_kernarg_segment_ptr() + off);
}
#define INP(i) inptr(i)
struct Frame {
    LAS unsigned char* lds;
    unsigned* ctl;
    int tid, lane, wave, G, c;
};

__device__ __forceinline__ void p0_transpose_item(const float* W, int K, int Nsrc, int nblk, bf16_t* WT, int mode, LAS float* scr, int item, int lane) {
    const int kb = item / nblk, nb = item % nblk, k0 = 64 * kb, n0 = 32 * nb;
    const int c4 = (lane & 7) * 4, kr = lane >> 3;
#pragma unroll
    for (int i = 0; i < 8; ++i) { const int kk = 8 * i + kr;
        f32x4 v = (f32x4){0.f, 0.f, 0.f, 0.f};
        if (n0 + c4 < Nsrc) v = *(const f32x4*)(W + (size_t)(k0 + kk) * Nsrc + n0 + c4);
        scr[kk * 33 + c4 + 0] = v[0]; scr[kk * 33 + c4 + 1] = v[1]; scr[kk * 33 + c4 + 2] = v[2]; scr[kk * 33 + c4 + 3] = v[3]; }
    LDS_WAIT(); asm volatile("" ::: "memory");
    int drow0 = n0;
    if (mode == 1) { const int half = n0 / DFF, r = n0 % DFF; drow0 = 256 * (r / 128) + 128 * half + (r % 128); }
    const int c = lane & 7;
#pragma unroll
    for (int j = 0; j < 4; ++j) { const int n = (lane >> 3) + 8 * j; const LAS float* s = scr + (8 * c) * 33 + n;
        u32x4 o; o.x = cvt_pk_bf16(s[0 * 33], s[1 * 33]); o.y = cvt_pk_bf16(s[2 * 33], s[3 * 33]); o.z = cvt_pk_bf16(s[4 * 33], s[5 * 33]); o.w = cvt_pk_bf16(s[6 * 33], s[7 * 33]);
        *(u32x4*)(WT + (size_t)(drow0 + n) * K + k0 + 8 * c) = o; }
    LDS_WAIT(); asm volatile("" ::: "memory");
}
__device__ __forceinline__ void p0_combo_item(Frame& F, const float* A, int lda, const float* B, int ldb, bf16_t* out, int ldo, float scale) {
    LAS float* As = (LAS float*)F.lds; LAS float* Bs = As + 64 * 128;
    const int t = F.tid;
#pragma unroll
    for (int q = 0; q < 4; ++q) { const int r = (t >> 5) + 16 * q, c4 = (t & 31) * 4; *(LAS f32x4*)(As + r * 128 + c4) = *(const f32x4*)(A + (size_t)r * lda + c4); }
#pragma unroll
    for (int q = 0; q < 4; ++q) { const int r = (t >> 4) + 32 * q, c4 = (t & 15) * 4; *(LAS f32x4*)(Bs + r * 64 + c4) = *(const f32x4*)(B + (size_t)r * ldb + c4); }
    __syncthreads();
    const int tj = t & 63, ti = t >> 6;
    float acc[8];
#pragma unroll
    for (int ii = 0; ii < 8; ++ii) acc[ii] = 0.f;
    for (int d = 0; d < 128; d += 4) {
        const float b0 = Bs[(d + 0) * 64 + tj], b1 = Bs[(d + 1) * 64 + tj], b2 = Bs[(d + 2) * 64 + tj], b3 = Bs[(d + 3) * 64 + tj];
#pragma unroll
        for (int ii = 0; ii < 8; ++ii) { const f32x4 a = *(const LAS f32x4*)(As + (8 * ti + ii) * 128 + d); acc[ii] += a[0] * b0 + a[1] * b1 + a[2] * b2 + a[3] * b3; }
    }
    u32x4 o; o.x = cvt_pk_bf16(acc[0] * scale, acc[1] * scale); o.y = cvt_pk_bf16(acc[2] * scale, acc[3] * scale); o.z = cvt_pk_bf16(acc[4] * scale, acc[5] * scale); o.w = cvt_pk_bf16(acc[6] * scale, acc[7] * scale);
    *(u32x4*)(out + (size_t)tj * ldo + 8 * ti) = o;
    __syncthreads();
}
__device__ __forceinline__ void p0_prologue(Frame& F, const Params& p) {
    unsigned char* ws = p.ws;
    LAS float* scr = (LAS float*)(F.lds + F.wave * 8448);
    const int gw = F.c * NWAVES + F.wave, NGW = F.G * NWAVES;
    constexpr int I0 = 16 * 128, I1 = 16 * 32, I2 = 16 * 224, I3 = 56 * 32, I4 = 16 * 24, I5 = 4 * 16;
    constexpr int NITEMS = 2 * (I0 + I1 + I2 + I3 + I4 + I5) + 16 * (I2 + I3);
    for (int it = gw; it < NITEMS; it += NGW) {
        int r = it;
        if (r < 16 * I2) { const int job = r / I2; p0_transpose_item(INP(IN_MGU) + (size_t)job * D * 2 * DFF, D, 2 * DFF, 224, (bf16_t*)(ws + WS_W_MGU) + (size_t)job * 2 * DFF * D, 1, scr, r % I2, F.lane); continue; } r -= 16 * I2;
        if (r < 16 * I3) { const int job = r / I3; p0_transpose_item(INP(IN_MDN) + (size_t)job * DFF * D, DFF, D, 32, (bf16_t*)(ws + WS_W_MDN) + (size_t)job * D * DFF, 0, scr, r % I3, F.lane); continue; } r -= 16 * I3;
        if (r < 2 * I0) { const int job = r / I0; p0_transpose_item(INP(IN_HGWIN) + (size_t)job * D * 4 * D, D, 4 * D, 128, (bf16_t*)(ws + WS_W_HGIN) + (size_t)job * 4 * D * D, 0, scr, r % I0, F.lane); continue; } r -= 2 * I0;
        if (r < 2 * I1) { const int job = r / I1; p0_transpose_item(INP(IN_HGWOUT) + (size_t)job * D * D, D, D, 32, (bf16_t*)(ws + WS_W_HGOUT) + (size_t)job * D * D, 0, scr, r % I1, F.lane); continue; } r -= 2 * I1;
        if (r < 2 * I2) { const int job = r / I2; p0_transpose_item(INP(IN_FGU) + (size_t)job * D * 2 * DFF, D, 2 * DFF, 224, (bf16_t*)(ws + WS_W_FGU) + (size_t)job * 2 * DFF * D, 1, scr, r % I2, F.lane); continue; } r -= 2 * I2;
        if (r < 2 * I3) { const int job = r / I3; p0_transpose_item(INP(IN_FDN) + (size_t)job * DFF * D, DFF, D, 32, (bf16_t*)(ws + WS_W_FDN) + (size_t)job * D * DFF, 0, scr, r % I3, F.lane); continue; } r -= 2 * I3;
        if (r < 2 * I4) { const int job = r / I4; p0_transpose_item(INP(IN_DWIN) + (size_t)job * D * DSA_IN, D, DSA_IN, 24, (bf16_t*)(ws + WS_W_DIN) + (size_t)job * DSA_IN_PAD * D, 0, scr, r % I4, F.lane); continue; } r -= 2 * I4;
        { const int job = r / I5; p0_transpose_item(INP(IN_DWQIDX) + (size_t)job * QR * 512, QR, 512, 16, (bf16_t*)(ws + WS_W_DQ) + (size_t)job * 2560 * QR + (size_t)2048 * QR, 0, scr, r % I5, F.lane); }
    }
    { const f32x4* x4 = (const f32x4*)INP(IN_X); u32x2* xb = (u32x2*)(ws + WS_XB); const size_t n4 = (size_t)M * D / 4;
      for (size_t i = (size_t)F.c * NTHREADS + F.tid; i < n4; i += (size_t)F.G * NTHREADS) { const f32x4 v = x4[i]; u32x2 o; o.x = cvt_pk_bf16(v[0], v[1]); o.y = cvt_pk_bf16(v[2], v[3]); xb[i] = o; } }
    __syncthreads();
    const float qscale = 0.08838834764831845f * 1.4426950408889634f;
    for (int it = F.c; it < 256 + 1024; it += F.G) {
        if (it < 256) { const int j = it >> 7, h = (it >> 4) & 7, ib = (it >> 2) & 3, jb = it & 3;
            p0_combo_item(F, INP(IN_DWUQ) + (size_t)j * QR * D + (size_t)(64 * ib) * D + h * 128, D, INP(IN_DWUK) + ((size_t)j * 8 + h) * 128 * KVR + 64 * jb, KVR,
                          (bf16_t*)(ws + WS_W_DQ) + (size_t)j * 2560 * QR + (size_t)(h * 256 + 64 * jb) * QR + 64 * ib, QR, qscale);
        } else { const int r = it - 256, j = r >> 9, h = (r >> 6) & 7, ib = (r >> 4) & 3, jb = r & 15;
            p0_combo_item(F, INP(IN_DWUV) + (((size_t)j * 8 + h) * KVR + 64 * ib) * 128, 128, INP(IN_DWOUT) + (size_t)j * D * D + (size_t)(h * 128) * D + 64 * jb, D,
                          (bf16_t*)(ws + WS_W_DO) + (size_t)j * D * 2048 + (size_t)(64 * jb) * 2048 + h * 256 + 64 * ib, 2048, 1.0f);
        }
    }
}

__device__ __forceinline__ void ln_row(f32x4 (&v)[4], const f32x4 (&g)[4], const f32x4 (&b)[4]) {
    float s = 0.f;
#pragma unroll
    for (int j = 0; j < 4; ++j) s += (v[j][0] + v[j][1]) + (v[j][2] + v[j][3]);
    const float mean = wave_sum(s) * (1.f / D); float s2 = 0.f;
#pragma unroll
    for (int j = 0; j < 4; ++j) { v[j] = v[j] - mean; s2 += (v[j][0] * v[j][0] + v[j][1] * v[j][1]) + (v[j][2] * v[j][2] + v[j][3] * v[j][3]); }
    const float rstd = 1.f / sqrtf(wave_sum(s2) * (1.f / D) + LN_EPS);
#pragma unroll
    for (int j = 0; j < 4; ++j) v[j] = v[j] * rstd * g[j] + b[j];
}
__device__ __forceinline__ void store_row(const f32x4 (&v)[4], float* xrow, bf16_t* xbrow, int lane) {
#pragma unroll
    for (int j = 0; j < 4; ++j) {
        if (xrow) *(f32x4*)(xrow + 4 * lane + 256 * j) = v[j];
        if (xbrow) { u32x2 o; o.x = cvt_pk_bf16(v[j][0], v[j][1]); o.y = cvt_pk_bf16(v[j][2], v[j][3]); *(u32x2*)(xbrow + 4 * lane + 256 * j) = o; }
    }
}
__device__ __forceinline__ void ln_phase(Frame& F, const float* Y, const float* g, const float* b, float* X, bf16_t* XB) {
    f32x4 gv[4], bv[4];
#pragma unroll
    for (int j = 0; j < 4; ++j) { gv[j] = *(const f32x4*)(g + 4 * F.lane + 256 * j); bv[j] = *(const f32x4*)(b + 4 * F.lane + 256 * j); }
    const int gw = F.c * NWAVES + F.wave, NGW = F.G * NWAVES;
    for (int m = gw; m < M; m += NGW) {
        f32x4 v[4];
#pragma unroll
        for (int j = 0; j < 4; ++j) v[j] = *(const f32x4*)(Y + (size_t)m * D + 4 * F.lane + 256 * j);
        ln_row(v, gv, bv);
        store_row(v, X + (size_t)m * D, XB + (size_t)m * D, F.lane);
    }
}
__device__ __forceinline__ void ln_moe_phase(Frame& F, const float* Xin, const float* OUTM, const int* SLOT, const float* g, const float* b, float* X, bf16_t* XB) {
    f32x4 gv[4], bv[4];
#pragma unroll
    for (int j = 0; j < 4; ++j) { gv[j] = *(const f32x4*)(g + 4 * F.lane + 256 * j); bv[j] = *(const f32x4*)(b + 4 * F.lane + 256 * j); }
    const int gw = F.c * NWAVES + F.wave, NGW = F.G * NWAVES;
    for (int m = gw; m < M; m += NGW) {
        const int s0 = SLOT[2 * m], s1 = SLOT[2 * m + 1];
        f32x4 v[4];
#pragma unroll
        for (int j = 0; j < 4; ++j) { const int o = 4 * F.lane + 256 * j;
            v[j] = *(const f32x4*)(Xin + (size_t)m * D + o) * ALPHA + *(const f32x4*)(OUTM + (size_t)s0 * D + o) + *(const f32x4*)(OUTM + (size_t)s1 * D + o); }
        ln_row(v, gv, bv);
        store_row(v, X + (size_t)m * D, XB ? XB + (size_t)m * D : nullptr, F.lane);
    }
}
__device__ __forceinline__ void ln_router_phase(Frame& F, const float* Y, const float* g, const float* b, const float* wrouter, float* X, bf16_t* XB,
                                                int* EIDX, int* POS, float* TOPW, unsigned* gcnt) {
    LAS float* WR = (LAS float*)F.lds;
    LAS int* SEL = (LAS int*)(F.lds + 32768);
    LAS int* CW = (LAS int*)(F.lds + 32768 + 1024);
    LAS int* BASE = (LAS int*)(F.lds + 32768 + 1024 + 128);
    for (int q = 0; q < 16; ++q) { const int idx = F.tid + NTHREADS * q; WR[(idx & 7) * 1024 + (idx >> 3)] = wrouter[idx]; }
    f32x4 gv[4], bv[4];
#pragma unroll
    for (int j = 0; j < 4; ++j) { gv[j] = *(const f32x4*)(g + 4 * F.lane + 256 * j); bv[j] = *(const f32x4*)(b + 4 * F.lane + 256 * j); }
    __syncthreads();
    for (int blk = F.c; blk < M / 128; blk += F.G) {
        for (int rl = F.wave; rl < 128; rl += NWAVES) {
            const int m = blk * 128 + rl;
            f32x4 v[4];
#pragma unroll
            for (int j = 0; j < 4; ++j) v[j] = *(const f32x4*)(Y + (size_t)m * D + 4 * F.lane + 256 * j);
            ln_row(v, gv, bv);
            store_row(v, X + (size_t)m * D, XB + (size_t)m * D, F.lane);
            float lg[8];
#pragma unroll
            for (int e = 0; e < 8; ++e) { float s = 0.f;
#pragma unroll
                for (int j = 0; j < 4; ++j) { const f32x4 w = *(const LAS f32x4*)(WR + e * 1024 + 4 * F.lane + 256 * j); s += (v[j][0] * w[0] + v[j][1] * w[1]) + (v[j][2] * w[2] + v[j][3] * w[3]); }
                lg[e] = wave_sum(s); }
            int e0 = 0; float v0 = lg[0];
#pragma unroll
            for (int e = 1; e < 8; ++e) if (lg[e] > v0) { v0 = lg[e]; e0 = e; }
            int e1 = -1; float v1 = -3.0e38f;
#pragma unroll
            for (int e = 0; e < 8; ++e) if (e != e0 && lg[e] > v1) { v1 = lg[e]; e1 = e; }
            const float w1 = 1.f / (1.f + __expf(v0 - v1)), w0 = 1.f - w1;
            if (F.lane == 0) { SEL[2 * rl] = e0; SEL[2 * rl + 1] = e1; EIDX[2 * m] = e0; EIDX[2 * m + 1] = e1; TOPW[2 * m] = w0; TOPW[2 * m + 1] = w1; }
        }
        __syncthreads();
        const int mine = F.tid < 256 ? SEL[F.tid] : -1;
        int myrank = 0;
        if (F.wave < 4) {
#pragma unroll
            for (int e = 0; e < 8; ++e) { const unsigned long long mk = __ballot(mine == e); const int rk = __builtin_popcountll(mk & ((1ull << F.lane) - 1ull)); if (mine == e) myrank = rk;
                if (F.lane == 0) CW[F.wave * 8 + e] = __builtin_popcountll(mk); }
        }
        __syncthreads();
        if (F.tid < 8) { const int tot = CW[F.tid] + CW[8 + F.tid] + CW[16 + F.tid] + CW[24 + F.tid]; BASE[F.tid] = (int)__hip_atomic_fetch_add(gcnt + F.tid, (unsigned)tot, __ATOMIC_RELAXED, __HIP_MEMORY_SCOPE_AGENT); }
        __syncthreads();
        if (F.tid < 256) { int pos = BASE[mine] + myrank; for (int w = 0; w < F.wave; ++w) pos += CW[w * 8 + mine]; POS[blk * 256 + F.tid] = pos; }
        __syncthreads();
    }
}
__device__ __forceinline__ void moe_gather_phase(Frame& F, const bf16_t* XB, const int* EIDX, const int* POS, const float* TOPW, const unsigned* gcnt, bf16_t* XG, int* SLOT, float* GATE) {
    int roff[9], cnt[8]; { int t = 0;
#pragma unroll
        for (int e = 0; e < 8; ++e) { roff[e] = t * 256; cnt[e] = __builtin_amdgcn_readfirstlane((int)__hip_atomic_load(gcnt + e, __ATOMIC_RELAXED, __HIP_MEMORY_SCOPE_AGENT)); t += (cnt[e] + 255) >> 8; } roff[8] = t * 256; }
    const int gw = F.c * NWAVES + F.wave, NGW = F.G * NWAVES;
    for (int ent = gw; ent < 2 * M; ent += NGW) {
        const int e = EIDX[ent], pos = POS[ent]; int ro = 0;
#pragma unroll
        for (int k = 0; k < 8; ++k) ro = (e == k) ? roff[k] : ro;
        const int slot = ro + pos, m = ent >> 1;
        const u32x4* src = (const u32x4*)(XB + (size_t)m * D); u32x4* dst = (u32x4*)(XG + (size_t)slot * D);
        dst[F.lane] = src[F.lane]; dst[64 + F.lane] = src[64 + F.lane];
        if (F.lane == 0) { SLOT[ent] = slot; GATE[slot] = TOPW[ent]; }
    }
#pragma unroll
    for (int e = 0; e < 8; ++e) { const int npad = roff[e + 1] - roff[e] - cnt[e];
        for (int r = gw; r < npad; r += NGW) { const int slot = roff[e] + cnt[e] + r; u32x4* dst = (u32x4*)(XG + (size_t)slot * D); const u32x4 z = (u32x4){0u, 0u, 0u, 0u};
            dst[F.lane] = z; dst[64 + F.lane] = z; if (F.lane == 0) GATE[slot] = 0.f; } }
}

__device__ __forceinline__ void hgrn_phase(Frame& F, const bf16_t* Q, const float* FP, const bf16_t* V, const float* lbparam, int jl, bf16_t* O) {
    constexpr int QS = 0, KS = 17408, KST = 34816, VST = 53248, PS = 62464, SST = 71680, SEG = 89088, RV = 91136, DV = 91648;
    constexpr int LQ = 136, LT = 72;
    LAS unsigned char* L = F.lds;
    const int tid = F.tid, lane = F.lane, w = F.wave, fr = lane & 15, fq = lane >> 4;
    const int d = tid & 127, seg = tid >> 7;
    const int ve = tid & 63, vs = tid >> 6;
    for (int u = F.c; u < BATCH * HG_H * 2; u += F.G) {
        const int b = u >> 4, h = (u >> 1) & 7, vh = u & 1;
        float lb = 0.f;
        if (jl == 1) { const float l0 = lbparam[h * 128 + d], l1 = lbparam[D + h * 128 + d]; lb = 1.f / (1.f + __expf(l0 - l1)); }
        const float oml = 1.f - lb;
        f32x4 St[4];
#pragma unroll
        for (int et = 0; et < 4; ++et) St[et] = (f32x4){0.f, 0.f, 0.f, 0.f};
        for (int ch = 0; ch < SEQ / HG_C; ++ch) {
            const size_t row0 = (size_t)b * SEQ + (size_t)ch * HG_C;
            float cum[16], kk[16], qv[16];
            { const float* fp = FP + (row0 + 16 * seg) * D + h * 128 + d; const bf16_t* qp = Q + (row0 + 16 * seg) * D + h * 128 + d;
              float fpv[16];
#pragma unroll
              for (int i = 0; i < 16; ++i) { fpv[i] = fp[(size_t)i * D]; qv[i] = bf2f(qp[(size_t)i * D]); }
              float c = 0.f;
#pragma unroll
              for (int i = 0; i < 16; ++i) { const float sg = sigmoidf_(fpv[i]); const float f = lb + oml * sg; c += __logf(f); cum[i] = c; kk[i] = oml * (1.f - sg); }
              *(LAS float*)(L + SEG + (seg * 128 + d) * 4) = c; }
            { const bf16_t* vp = V + (row0 + 8 * vs) * D + h * 128 + vh * 64 + ve; bf16_t vv[8];
#pragma unroll
              for (int i = 0; i < 8; ++i) vv[i] = vp[(size_t)i * D];
              u32x4 pk; pk.x = vv[0] | ((unsigned)vv[1] << 16); pk.y = vv[2] | ((unsigned)vv[3] << 16); pk.z = vv[4] | ((unsigned)vv[5] << 16); pk.w = vv[6] | ((unsigned)vv[7] << 16);
              *(LAS u32x4*)(L + VST + (ve * LT + 8 * vs) * 2) = pk; }
            __syncthreads();
            { const float s0 = *(LAS float*)(L + SEG + (0 * 128 + d) * 4), s1 = *(LAS float*)(L + SEG + (1 * 128 + d) * 4), s2 = *(LAS float*)(L + SEG + (2 * 128 + d) * 4), s3 = *(LAS float*)(L + SEG + (3 * 128 + d) * 4);
              const float pre = (seg > 0 ? s0 : 0.f) + (seg > 1 ? s1 : 0.f) + (seg > 2 ? s2 : 0.f);
              const float r = s0 + s1, bl = (s0 + s1) + (s2 + s3);
              unsigned kp[8];
#pragma unroll
              for (int i = 0; i < 16; i += 2) {
                  const float bt0 = pre + cum[i], bt1 = pre + cum[i + 1];
                  const float q0 = qv[i] * __expf(bt0 - r), q1 = qv[i + 1] * __expf(bt1 - r);
                  const float k0 = kk[i] * __expf(r - bt0), k1 = kk[i + 1] * __expf(r - bt1);
                  const int t0 = 16 * seg + i;
                  *(LAS bf16_t*)(L + QS + ((t0) * LQ + d) * 2) = f2bf(q0); *(LAS bf16_t*)(L + QS + ((t0 + 1) * LQ + d) * 2) = f2bf(q1);
                  const unsigned kpk = cvt_pk_bf16(k0, k1); kp[i >> 1] = kpk;
                  *(LAS bf16_t*)(L + KS + ((t0) * LQ + d) * 2) = (bf16_t)(kpk & 0xffffu); *(LAS bf16_t*)(L + KS + ((t0 + 1) * LQ + d) * 2) = (bf16_t)(kpk >> 16);
              }
              *(LAS u32x4*)(L + KST + (d * LT + 16 * seg) * 2) = (u32x4){kp[0], kp[1], kp[2], kp[3]};
              *(LAS u32x4*)(L + KST + (d * LT + 16 * seg + 8) * 2) = (u32x4){kp[4], kp[5], kp[6], kp[7]};
              if (seg == 0) { *(LAS float*)(L + RV + d * 4) = __expf(r); *(LAS float*)(L + DV + d * 4) = __expf(bl - r); } }
            __syncthreads();
            { const f32x4 rv = *(LAS f32x4*)(L + RV + (16 * w + 4 * fq) * 4);
#pragma unroll
              for (int et = 0; et < 4; ++et) { St[et] = St[et] * rv; u32x2 o; o.x = cvt_pk_bf16(St[et][0], St[et][1]); o.y = cvt_pk_bf16(St[et][2], St[et][3]);
                  *(LAS u32x2*)(L + SST + ((16 * et + fr) * LQ + 16 * w + 4 * fq) * 2) = o; } }
            { const int tt = w >> 1;
#pragma unroll
              for (int sx = 0; sx < 2; ++sx) { const int st = 2 * (w & 1) + sx;
                  f32x4 acc = (f32x4){0.f, 0.f, 0.f, 0.f};
                  if (st <= tt) {
#pragma unroll
                      for (int ks = 0; ks < 4; ++ks) { const bf16x8 a = *(LAS bf16x8*)(L + QS + ((16 * tt + fr) * LQ + 32 * ks + 8 * fq) * 2); const bf16x8 bb = *(LAS bf16x8*)(L + KS + ((16 * st + fr) * LQ + 32 * ks + 8 * fq) * 2);
                          acc = __builtin_amdgcn_mfma_f32_16x16x32_bf16(a, bb, acc, 0, 0, 0); }
                  }
#pragma unroll
                  for (int r = 0; r < 4; ++r) { const int t = 16 * tt + 4 * fq + r, s = 16 * st + fr; const float pv = (s <= t) ? acc[r] : 0.f; *(LAS bf16_t*)(L + PS + (t * LT + s) * 2) = f2bf(pv); }
              } }
            __syncthreads();
            { const int tt = w >> 1;
#pragma unroll
              for (int ex = 0; ex < 2; ++ex) { const int et = 2 * (w & 1) + ex;
                  f32x4 acc = (f32x4){0.f, 0.f, 0.f, 0.f};
#pragma unroll
                  for (int ks = 0; ks < 2; ++ks) { const bf16x8 a = *(LAS bf16x8*)(L + PS + ((16 * tt + fr) * LT + 32 * ks + 8 * fq) * 2); const bf16x8 bb = *(LAS bf16x8*)(L + VST + ((16 * et + fr) * LT + 32 * ks + 8 * fq) * 2);
                      acc = __builtin_amdgcn_mfma_f32_16x16x32_bf16(a, bb, acc, 0, 0, 0); }
#pragma unroll
                  for (int ks = 0; ks < 4; ++ks) { const bf16x8 a = *(LAS bf16x8*)(L + QS + ((16 * tt + fr) * LQ + 32 * ks + 8 * fq) * 2); const bf16x8 bb = *(LAS bf16x8*)(L + SST + ((16 * et + fr) * LQ + 32 * ks + 8 * fq) * 2);
                      acc = __builtin_amdgcn_mfma_f32_16x16x32_bf16(a, bb, acc, 0, 0, 0); }
#pragma unroll
                  for (int r = 0; r < 4; ++r) { const int t = 16 * tt + 4 * fq + r; O[(row0 + t) * D + h * 128 + vh * 64 + 16 * et + fr] = f2bf(acc[r]); }
              } }
            { const f32x4 dv = *(LAS f32x4*)(L + DV + (16 * w + 4 * fq) * 4);
#pragma unroll
              for (int et = 0; et < 4; ++et) {
#pragma unroll
                  for (int ks = 0; ks < 2; ++ks) { const bf16x8 a = *(LAS bf16x8*)(L + KST + ((16 * w + fr) * LT + 32 * ks + 8 * fq) * 2); const bf16x8 bb = *(LAS bf16x8*)(L + VST + ((16 * et + fr) * LT + 32 * ks + 8 * fq) * 2);
                      St[et] = __builtin_amdgcn_mfma_f32_16x16x32_bf16(a, bb, St[et], 0, 0, 0); }
                  St[et] = St[et] * dv; } }
            __syncthreads();
        }
    }
}
__device__ __forceinline__ void hgrn_gate_phase(Frame& F, const bf16_t* O, const bf16_t* Gt, const float* ng, bf16_t* OG) {
    float gw_[16];
#pragma unroll
    for (int i = 0; i < 16; ++i) gw_[i] = ng[16 * F.lane + i];
    const int gw = F.c * NWAVES + F.wave, NGW = F.G * NWAVES;
    for (int m = gw; m < M; m += NGW) {
        const u32x4 o0 = *(const u32x4*)(O + (size_t)m * D + 16 * F.lane), o1 = *(const u32x4*)(O + (size_t)m * D + 16 * F.lane + 8);
        const u32x4 g0 = *(const u32x4*)(Gt + (size_t)m * D + 16 * F.lane), g1 = *(const u32x4*)(Gt + (size_t)m * D + 16 * F.lane + 8);
        float ov[16], gv[16];
#pragma unroll
        for (int i = 0; i < 4; ++i) { ov[2 * i] = __uint_as_float(o0[i] << 16); ov[2 * i + 1] = __uint_as_float(o0[i] & 0xffff0000u); ov[8 + 2 * i] = __uint_as_float(o1[i] << 16); ov[8 + 2 * i + 1] = __uint_as_float(o1[i] & 0xffff0000u);
            gv[2 * i] = __uint_as_float(g0[i] << 16); gv[2 * i + 1] = __uint_as_float(g0[i] & 0xffff0000u); gv[8 + 2 * i] = __uint_as_float(g1[i] << 16); gv[8 + 2 * i + 1] = __uint_as_float(g1[i] & 0xffff0000u); }
        float ss = 0.f;
#pragma unroll
        for (int i = 0; i < 16; ++i) ss += ov[i] * ov[i];
        ss += __shfl_xor(ss, 1); ss += __shfl_xor(ss, 2); ss += __shfl_xor(ss, 4);
        const float rs = 1.f / sqrtf(ss * (1.f / 128.f) + RMS_EPS);
        float r[16];
#pragma unroll
        for (int i = 0; i < 16; ++i) r[i] = ov[i] * rs * gw_[i] * siluf_(gv[i]);
        u32x4 w0, w1; w0.x = cvt_pk_bf16(r[0], r[1]); w0.y = cvt_pk_bf16(r[2], r[3]); w0.z = cvt_pk_bf16(r[4], r[5]); w0.w = cvt_pk_bf16(r[6], r[7]);
        w1.x = cvt_pk_bf16(r[8], r[9]); w1.y = cvt_pk_bf16(r[10], r[11]); w1.z = cvt_pk_bf16(r[12], r[13]); w1.w = cvt_pk_bf16(r[14], r[15]);
        *(u32x4*)(OG + (size_t)m * D + 16 * F.lane) = w0; *(u32x4*)(OG + (size_t)m * D + 16 * F.lane + 8) = w1;
    }
}

__device__ __forceinline__ void dsa_norm_phase(Frame& F, const float* RAW, const float* qg, const float* kvg, const float* kig, const float* kib, bf16_t* CQ, bf16_t* CKV, bf16_t* KIDX, float* WIDX) {
    const f32x4 qgv = *(const f32x4*)(qg + 4 * F.lane), kvgv = *(const f32x4*)(kvg + 4 * F.lane); const float kg = kig[F.lane], kb = kib[F.lane];
    const int gw = F.c * NWAVES + F.wave, NGW = F.G * NWAVES;
    for (int m = gw; m < M; m += NGW) {
        const float* r = RAW + (size_t)m * DSA_IN_PAD;
        const f32x4 a = *(const f32x4*)(r + 4 * F.lane), c = *(const f32x4*)(r + 256 + 4 * F.lane); const float ki = r[512 + F.lane];
        const float sa = wave_sum((a[0] * a[0] + a[1] * a[1]) + (a[2] * a[2] + a[3] * a[3])), sc = wave_sum((c[0] * c[0] + c[1] * c[1]) + (c[2] * c[2] + c[3] * c[3]));
        const float ra = 1.f / sqrtf(sa * (1.f / 256.f) + RMS_EPS), rc = 1.f / sqrtf(sc * (1.f / 256.f) + RMS_EPS);
        u32x2 o; o.x = cvt_pk_bf16(a[0] * ra * qgv[0], a[1] * ra * qgv[1]); o.y = cvt_pk_bf16(a[2] * ra * qgv[2], a[3] * ra * qgv[3]); *(u32x2*)(CQ + (size_t)m * 256 + 4 * F.lane) = o;
        o.x = cvt_pk_bf16(c[0] * rc * kvgv[0], c[1] * rc * kvgv[1]); o.y = cvt_pk_bf16(c[2] * rc * kvgv[2], c[3] * rc * kvgv[3]); *(u32x2*)(CKV + (size_t)m * 256 + 4 * F.lane) = o;
        const float mu = wave_sum(ki) * (1.f / 64.f), dk = ki - mu, var = wave_sum(dk * dk) * (1.f / 64.f);
        KIDX[(size_t)m * 64 + F.lane] = f2bf(dk * (1.f / sqrtf(var + LN_EPS)) * kg + kb);
        if (F.lane < 8) WIDX[(size_t)m * 8 + F.lane] = r[576 + F.lane] * 0.04419417382415922f;
    }
}
__device__ __forceinline__ unsigned f2ord(float v) { const unsigned u = __float_as_uint(v); return (u & 0x80000000u) ? ~u : (u | 0x80000000u); }
__device__ __forceinline__ void dsa_index_phase(Frame& F, const bf16_t* QIDX, const bf16_t* KIDX, const float* WIDX, unsigned long long* MASK) {
    LAS float* SC = (LAS float*)F.lds;
    const int lane = F.lane, w = F.wave, fr = lane & 15, fq = lane >> 4;
    for (int i = 0;; ++i) {
        const int u = i * F.G + F.c; if (u >= BATCH * (SEQ / 16)) break;
        const int b = (u & 255) >> 4, qt = (u >> 8) * 16 + (u & 15), t0 = 16 * qt; const size_t rb = (size_t)b * SEQ;
        bf16x8 Af[4][2][2]; float wv[4][8];
#pragma unroll
        for (int tg = 0; tg < 4; ++tg) {
#pragma unroll
            for (int hh = 0; hh < 2; ++hh)
#pragma unroll
                for (int ks = 0; ks < 2; ++ks) Af[tg][hh][ks] = *(const bf16x8*)(QIDX + (rb + t0 + 4 * tg + (fr >> 2)) * 512 + (4 * hh + (fr & 3)) * 64 + 32 * ks + 8 * fq);
            const f32x4 w0 = *(const f32x4*)(WIDX + (rb + t0 + 4 * tg + fq) * 8), w1 = *(const f32x4*)(WIDX + (rb + t0 + 4 * tg + fq) * 8 + 4);
#pragma unroll
            for (int r = 0; r < 4; ++r) { wv[tg][r] = w0[r]; wv[tg][4 + r] = w1[r]; }
        }
        for (int kg = w; kg <= qt; kg += NWAVES) {
            const bf16x8 B0 = *(const bf16x8*)(KIDX + (rb + 16 * kg + fr) * 64 + 8 * fq), B1 = *(const bf16x8*)(KIDX + (rb + 16 * kg + fr) * 64 + 32 + 8 * fq);
#pragma unroll
            for (int tg = 0; tg < 4; ++tg) { float s = 0.f;
#pragma unroll
                for (int hh = 0; hh < 2; ++hh) { f32x4 acc = (f32x4){0.f, 0.f, 0.f, 0.f};
                    acc = __builtin_amdgcn_mfma_f32_16x16x32_bf16(Af[tg][hh][0], B0, acc, 0, 0, 0); acc = __builtin_amdgcn_mfma_f32_16x16x32_bf16(Af[tg][hh][1], B1, acc, 0, 0, 0);
#pragma unroll
                    for (int r = 0; r < 4; ++r) s += wv[tg][4 * hh + r] * fmaxf(acc[r], 0.f); }
                SC[(4 * tg + fq) * 2048 + 16 * kg + fr] = s + 0.0f; }
        }
        __syncthreads();
        for (int tq = 2 * w; tq < 2 * w + 2; ++tq) {
            const int t = t0 + tq;
            unsigned key[32];
#pragma unroll
            for (int r = 0; r < 32; ++r) { const int s = 64 * r + lane; key[r] = (s <= t) ? f2ord(SC[tq * 2048 + s]) : 0u; }
            unsigned long long selw = 0ull;
            if (t < TOPK) {
#pragma unroll
                for (int r = 0; r < 32; ++r) { const unsigned long long mk = __ballot(64 * r + lane <= t); if (lane == r) selw = mk; }
            } else {
                unsigned prefix = 0u; bool exact = false;
                for (int bit = 31; bit >= 0; --bit) {
                    const unsigned cand = prefix | (1u << bit); int cnt = 0;
#pragma unroll
                    for (int r = 0; r < 32; ++r) cnt += __builtin_popcountll(__ballot(key[r] >= cand));
                    if (cnt >= TOPK) { prefix = cand; if (cnt == TOPK) { exact = true; break; } }
                }
                if (exact) {
#pragma unroll
                    for (int r = 0; r < 32; ++r) { const unsigned long long mk = __ballot(key[r] >= prefix); if (lane == r) selw = mk; }
                } else {
                    int ngt = 0;
#pragma unroll
                    for (int r = 0; r < 32; ++r) ngt += __builtin_popcountll(__ballot(key[r] > prefix));
                    const int need = TOPK - ngt; int run = 0;
#pragma unroll
                    for (int r = 0; r < 32; ++r) { const unsigned long long tie = __ballot(key[r] == prefix); const int rk = run + __builtin_popcountll(tie & ((1ull << lane) - 1ull));
                        const unsigned long long mk = __ballot(key[r] > prefix || (key[r] == prefix && rk < need)); if (lane == r) selw = mk; run += __builtin_popcountll(tie); }
                }
            }
            if (lane < 32) MASK[(rb + t) * 32 + lane] = selw;
        }
        __syncthreads();
    }
}
__device__ __forceinline__ void dsa_attn_phase(Frame& F, const bf16_t* QLAT, const bf16_t* CKV, const unsigned long long* MASK, bf16_t* OLAT) {
    constexpr int RS = 528, TB = 64 * RS;
    LAS unsigned char* L = F.lds;
    const int lane = F.lane, w = F.wave, fr = lane & 15, fq = lane >> 4, tid = F.tid;
    const int qq = fr >> 2, pp = lane & 3;
    for (int i = 0;; ++i) {
        const int u = i * F.G + F.c; if (u >= BATCH * (SEQ / 16)) break;
        const int b = (u & 255) >> 4, qt = (u >> 8) * 16 + (u & 15), t0 = 16 * qt; const size_t rb = (size_t)b * SEQ;
        const int ntiles = (t0 + 15) / 64 + 1;
        bf16x8 Qf[8];
#pragma unroll
        for (int ks = 0; ks < 8; ++ks) Qf[ks] = *(const bf16x8*)(QLAT + (rb + t0 + fr) * 2048 + w * 256 + 32 * ks + 8 * fq);
        f32x4 Ot[16];
#pragma unroll
        for (int cb = 0; cb < 16; ++cb) Ot[cb] = (f32x4){0.f, 0.f, 0.f, 0.f};
        float mrun = -1.0e30f, lrun = 0.f;
        u32x4 pre[4];
#pragma unroll
        for (int q = 0; q < 4; ++q) { const int cid = tid + NTHREADS * q; pre[q] = *(const u32x4*)(CKV + (rb + (cid >> 5)) * 256 + 8 * (cid & 31)); }
#pragma unroll
        for (int q = 0; q < 4; ++q) { const int cid = tid + NTHREADS * q; *(LAS u32x4*)(L + (cid >> 5) * RS + 16 * (cid & 31)) = pre[q]; }
        __syncthreads();
        for (int kt = 0; kt < ntiles; ++kt) {
            LAS unsigned char* T = L + (kt & 1) * TB;
            const bool more = kt + 1 < ntiles;
            if (more) {
#pragma unroll
                for (int q = 0; q < 4; ++q) { const int cid = tid + NTHREADS * q; pre[q] = *(const u32x4*)(CKV + (rb + 64 * (kt + 1) + (cid >> 5)) * 256 + 8 * (cid & 31)); }
            }
            const unsigned long long mw = MASK[(rb + t0 + fr) * 32 + kt];
            f32x4 S[4];
#pragma unroll
            for (int kb = 0; kb < 4; ++kb) { S[kb] = (f32x4){0.f, 0.f, 0.f, 0.f};
#pragma unroll
                for (int ks = 0; ks < 8; ++ks) { const bf16x8 a = *(LAS bf16x8*)(T + (16 * kb + fr) * RS + (32 * ks + 8 * fq) * 2); S[kb] = __builtin_amdgcn_mfma_f32_16x16x32_bf16(a, Qf[ks], S[kb], 0, 0, 0); } }
            float mx = -3.0e38f;
#pragma unroll
            for (int kb = 0; kb < 4; ++kb)
#pragma unroll
                for (int r = 0; r < 4; ++r) { const bool on = (mw >> (16 * kb + 4 * fq + r)) & 1ull; S[kb][r] = on ? S[kb][r] : -__builtin_inff(); mx = fmaxf(mx, S[kb][r]); }
            mx = fmaxf(mx, __shfl_xor(mx, 16)); mx = fmaxf(mx, __shfl_xor(mx, 32));
            const float mnew = fmaxf(mrun, mx), alpha = fast_exp2(mrun - mnew); mrun = mnew;
            float ls = 0.f;
#pragma unroll
            for (int kb = 0; kb < 4; ++kb)
#pragma unroll
                for (int r = 0; r < 4; ++r) { S[kb][r] = fast_exp2(S[kb][r] - mnew); ls += S[kb][r]; }
            ls += __shfl_xor(ls, 16); ls += __shfl_xor(ls, 32);
            lrun = lrun * alpha + ls;
#pragma unroll
            for (int cb = 0; cb < 16; ++cb) Ot[cb] = Ot[cb] * alpha;
            bf16x8 Pf[2];
#pragma unroll
            for (int s2 = 0; s2 < 2; ++s2) { const u32x4 pk = pack8(S[2 * s2], S[2 * s2 + 1]); Pf[s2] = __builtin_bit_cast(bf16x8, pk); }
#pragma unroll
            for (int cb = 0; cb < 16; ++cb)
#pragma unroll
                for (int s2 = 0; s2 < 2; ++s2) {
                    const s16x4 v0 = __builtin_amdgcn_ds_read_tr16_b64_v4i16((LAS s16x4*)(T + (32 * s2 + 4 * fq + qq) * RS + (16 * cb + 4 * pp) * 2));
                    const s16x4 v1 = __builtin_amdgcn_ds_read_tr16_b64_v4i16((LAS s16x4*)(T + (32 * s2 + 16 + 4 * fq + qq) * RS + (16 * cb + 4 * pp) * 2));
                    const bf16x8 vf = (bf16x8){v0[0], v0[1], v0[2], v0[3], v1[0], v1[1], v1[2], v1[3]};
                    Ot[cb] = __builtin_amdgcn_mfma_f32_16x16x32_bf16(vf, Pf[s2], Ot[cb], 0, 0, 0);
                }
            if (more) {
                LAS unsigned char* T2 = L + ((kt + 1) & 1) * TB;
#pragma unroll
                for (int q = 0; q < 4; ++q) { const int cid = tid + NTHREADS * q; *(LAS u32x4*)(T2 + (cid >> 5) * RS + 16 * (cid & 31)) = pre[q]; }
            }
            __syncthreads();
        }
        const float inv = 1.f / lrun;
#pragma unroll
        for (int cb = 0; cb < 16; ++cb) { u32x2 o; o.x = cvt_pk_bf16(Ot[cb][0] * inv, Ot[cb][1] * inv); o.y = cvt_pk_bf16(Ot[cb][2] * inv, Ot[cb][3] * inv);
            *(u32x2*)(OLAT + (rb + t0 + fr) * 2048 + w * 256 + 16 * cb + 4 * fq) = o; }
    }
}

constexpr int PH_PER_PAIR = 19, N_PHASES = 1 + 2 * PH_PER_PAIR;

__global__ void __launch_bounds__(NTHREADS, 2) fwd_kernel(Params p) {
    extern __shared__ __attribute__((aligned(16))) unsigned char lds_raw[];
    Frame F;
    F.lds = (LAS unsigned char*)lds_raw;
    F.tid = threadIdx.x; F.lane = F.tid & 63; F.wave = __builtin_amdgcn_readfirstlane(F.tid >> 6);
    F.G = gridDim.x; F.c = blockIdx.x;
    unsigned char* ws = p.ws;
    F.ctl = (unsigned*)(ws + WS_CTL);
    for (int u = F.tid; u < (LDS_BYTES - LDSCTL_OFF) / 4; u += NTHREADS) ((LAS unsigned*)(F.lds + LDSCTL_OFF))[u] = 0u;
    __syncthreads();
    const bool one_launch = (p.ph_hi - p.ph_lo) > 1;
    XcdBarrier bar; bar.bar = F.ctl + CW_BAR; bar.x = 0; bar.st = nullptr;
    if (one_launch) bar = xcd_barrier_post(F.ctl + CW_BAR, (volatile LAS unsigned*)(F.lds + MISC_OFF) + 8);
    const int lo = p.ph_lo, hi = p.ph_hi;
#define REFRESH() do { int t_ = threadIdx.x; asm volatile("" : "+v"(t_)); F.tid = t_; F.lane = t_ & 63; F.wave = __builtin_amdgcn_readfirstlane(t_ >> 6); } while (0)
#define IN(k) (lo <= (k) && (k) < hi)
#define SEAM(k) do { if (IN(k) && IN((k) + 1)) xcd_barrier(bar); } while (0)

    float* X = (float*)(ws + WS_X); bf16_t* XB = (bf16_t*)(ws + WS_XB); float* Y = (float*)(ws + WS_Y);
    unsigned char* A = ws + WS_A; bf16_t* Hb = (bf16_t*)(ws + WS_H);

    if (IN(0)) { REFRESH(); p0_prologue(F, p); } SEAM(0);

    for (int j = 0; j < 2; ++j) {
        const int pb = 1 + j * PH_PER_PAIR;
        const int layerA = 2 * j, layerB = 2 * j + 1;
        const float* Xin = (j == 0) ? INP(IN_X) : X;
        if (IN(pb + 0)) {
            Gemm g{XB, (const bf16_t*)(ws + WS_W_HGIN) + (size_t)j * 4 * D * D, D}; StaticOrder S; S.init(M, 4 * D, F.G, F.c);
            EpiHgIn E{(bf16_t*)(A + A_HQ), (float*)(A + A_HF)};
            gemm_phase(F.lds, g, S, E);
        } SEAM(pb + 0);
        if (IN(pb + 1)) { REFRESH(); hgrn_phase(F, (const bf16_t*)(A + A_HQ), (const float*)(A + A_HF), (const bf16_t*)(A + A_HV), INP(IN_HGLB), j, (bf16_t*)(A + A_HO)); } SEAM(pb + 1);
        if (IN(pb + 2)) { REFRESH(); hgrn_gate_phase(F, (const bf16_t*)(A + A_HO), (const bf16_t*)(A + A_HG), INP(IN_HGNG) + (size_t)j * D, (bf16_t*)(A + A_HOG)); } SEAM(pb + 2);
        if (IN(pb + 3)) {
            Gemm g{(const bf16_t*)(A + A_HOG), (const bf16_t*)(ws + WS_W_HGOUT) + (size_t)j * D * D, D}; StaticOrder S; S.init(M, D, F.G, F.c);
            EpiRes E{Xin, Y}; gemm_phase(F.lds, g, S, E);
        } SEAM(pb + 3);
        if (IN(pb + 4)) { REFRESH(); ln_phase(F, Y, INP(IN_LNG) + (size_t)(layerA * 2 + 0) * D, INP(IN_LNB) + (size_t)(layerA * 2 + 0) * D, X, XB); } SEAM(pb + 4);
        if (IN(pb + 5)) {
            Gemm g{XB, (const bf16_t*)(ws + WS_W_FGU) + (size_t)j * 2 * DFF * D, D}; StaticOrder S; S.init(M, 2 * DFF, F.G, F.c);
            EpiSwiglu E{Hb}; gemm_phase(F.lds, g, S, E);
        } SEAM(pb + 5);
        if (IN(pb + 6)) {
            Gemm g{Hb, (const bf16_t*)(ws + WS_W_FDN) + (size_t)j * D * DFF, DFF}; StaticOrder S; S.init(M, D, F.G, F.c);
            EpiRes E{X, Y}; gemm_phase(F.lds, g, S, E);
        } SEAM(pb + 6);
        if (IN(pb + 7)) { REFRESH(); ln_phase(F, Y, INP(IN_LNG) + (size_t)(layerA * 2 + 1) * D, INP(IN_LNB) + (size_t)(layerA * 2 + 1) * D, X, XB); } SEAM(pb + 7);
        if (IN(pb + 8)) {
            Gemm g{XB, (const bf16_t*)(ws + WS_W_DIN) + (size_t)j * DSA_IN_PAD * D, D}; StaticOrder S; S.init(M, DSA_IN_PAD, F.G, F.c);
            EpiF32 E{(float*)(A + A_RAW), DSA_IN_PAD}; gemm_phase(F.lds, g, S, E);
        } SEAM(pb + 8);
        if (IN(pb + 9)) { REFRESH(); dsa_norm_phase(F, (const float*)(A + A_RAW), INP(IN_DQNG) + (size_t)j * QR, INP(IN_DKVNG) + (size_t)j * KVR, INP(IN_DKIG) + (size_t)j * IDXD, INP(IN_DKIB) + (size_t)j * IDXD,
                                         (bf16_t*)(A + A_CQ), (bf16_t*)(A + A_CKV), (bf16_t*)(A + A_KIDX), (float*)(A + A_WIDX)); } SEAM(pb + 9);
        if (IN(pb + 10)) {
            Gemm g{(const bf16_t*)(A + A_CQ), (const bf16_t*)(ws + WS_W_DQ) + (size_t)j * 2560 * QR, QR}; StaticOrder S; S.init(M, 2560, F.G, F.c);
            EpiQ E{(bf16_t*)(A + A_QLAT), (bf16_t*)(A + A_QIDX)}; gemm_phase(F.lds, g, S, E);
        } SEAM(pb + 10);
        if (IN(pb + 11)) { REFRESH(); dsa_index_phase(F, (const bf16_t*)(A + A_QIDX), (const bf16_t*)(A + A_KIDX), (const float*)(A + A_WIDX), (unsigned long long*)(A + A_MASK)); } SEAM(pb + 11);
        if (IN(pb + 12)) { REFRESH(); dsa_attn_phase(F, (const bf16_t*)(A + A_QLAT), (const bf16_t*)(A + A_CKV), (const unsigned long long*)(A + A_MASK), (bf16_t*)(A + A_OLAT)); } SEAM(pb + 12);
        if (IN(pb + 13)) {
            Gemm g{(const bf16_t*)(A + A_OLAT), (const bf16_t*)(ws + WS_W_DO) + (size_t)j * D * 2048, 2048}; StaticOrder S; S.init(M, D, F.G, F.c);
            EpiRes E{X, Y}; gemm_phase(F.lds, g, S, E);
        } SEAM(pb + 13);
        if (IN(pb + 14)) { REFRESH(); ln_router_phase(F, Y, INP(IN_LNG) + (size_t)(layerB * 2 + 0) * D, INP(IN_LNB) + (size_t)(layerB * 2 + 0) * D, INP(IN_MR) + (size_t)j * D * NEXP, X, XB,
                                           (int*)(A + A_EIDX), (int*)(A + A_POS), (float*)(A + A_TOPW), F.ctl + CW_MOE + 64 * j); } SEAM(pb + 14);
        if (IN(pb + 15)) { REFRESH(); moe_gather_phase(F, XB, (const int*)(A + A_EIDX), (const int*)(A + A_POS), (const float*)(A + A_TOPW), F.ctl + CW_MOE + 64 * j, (bf16_t*)(A + A_XG), (int*)(A + A_SLOT), (float*)(A + A_GATE)); } SEAM(pb + 15);
        if (IN(pb + 16)) {
            Gemm g{(const bf16_t*)(A + A_XG), (const bf16_t*)(ws + WS_W_MGU) + (size_t)j * NEXP * 2 * DFF * D, D}; MoeOrder S; S.init(F.ctl + CW_MOE + 64 * j, 2 * DFF / BM, F.G, F.c);
            EpiSwiglu E{Hb}; gemm_phase(F.lds, g, S, E);
        } SEAM(pb + 16);
        if (IN(pb + 17)) {
            Gemm g{Hb, (const bf16_t*)(ws + WS_W_MDN) + (size_t)j * NEXP * D * DFF, DFF}; MoeOrder S; S.init(F.ctl + CW_MOE + 64 * j, D / BM, F.G, F.c);
            EpiMoeDn E{(float*)(A + A_OUTM), (const float*)(A + A_GATE)}; gemm_phase(F.lds, g, S, E);
        } SEAM(pb + 17);
        if (IN(pb + 18)) { REFRESH(); ln_moe_phase(F, X, (const float*)(A + A_OUTM), (const int*)(A + A_SLOT), INP(IN_LNG) + (size_t)(layerB * 2 + 1) * D, INP(IN_LNB) + (size_t)(layerB * 2 + 1) * D,
                                        (j == 1) ? p.out : X, (j == 1) ? nullptr : XB); } SEAM(pb + 18);
    }
}


#if MK_DEBUG_SCAN
__global__ void scan_kernel(const void* ptr, size_t n, int is_bf16, unsigned code, unsigned* flag, const unsigned* gcnt, size_t row_elems) {
    size_t nn = n;
    if (gcnt) { unsigned t = 0; for (int e = 0; e < 8; ++e) t += (gcnt[e] + 255u) >> 8; nn = (size_t)t * 256 * row_elems; }
    bool bad = false;
    for (size_t i = (size_t)blockIdx.x * blockDim.x + threadIdx.x; i < nn; i += (size_t)gridDim.x * blockDim.x) {
        if (is_bf16) { const unsigned short v = ((const unsigned short*)ptr)[i]; bad |= (v & 0x7f80u) == 0x7f80u; }
        else { const unsigned v = ((const unsigned*)ptr)[i]; bad |= (v & 0x7f800000u) == 0x7f800000u; }
    }
    if (bad) atomicMin(flag, code);
}
__global__ void fin_kernel(float* out, size_t n, const unsigned* flag) {
    const unsigned f = *flag; if (f == 0xffffffffu) return;
    const float cval = (float)f + 0.25f * (float)flag[64];
    for (size_t i = (size_t)blockIdx.x * blockDim.x + threadIdx.x; i < n; i += (size_t)gridDim.x * blockDim.x) out[i] = cval;
}

__global__ void chk_a1_kernel(const float* x, const float* w, const bf16_t* Q, const float* FP, unsigned code, unsigned* flag) {
    const unsigned id = blockIdx.x * blockDim.x + threadIdx.x;
    unsigned hsh = id * 2654435761u + 12345u; hsh ^= hsh >> 13; hsh *= 0x5bd1e995u; hsh ^= hsh >> 15;
    const int row = hsh % M, col = (hsh >> 15) % (4 * D);
    float ref = 0.f; for (int k = 0; k < D; ++k) ref += x[(size_t)row * D + k] * w[(size_t)k * 4 * D + col];
    const int part = col >> 10, cc = col & 1023;
    float got;
    if (part == 1) got = FP[(size_t)row * D + cc];
    else got = bf2f(Q[(size_t)(part == 0 ? 0 : part - 1) * M * D + (size_t)row * D + cc]);
    if (!(fabsf(got - ref) < 0.08f)) atomicMin(flag, code);
}
__global__ void chk_hgrn_kernel(const bf16_t* Q, const float* FP, const bf16_t* V, const bf16_t* O, unsigned* bits) {
    const int sample = blockIdx.x, lane = threadIdx.x;
    const int b = sample % BATCH, h = (sample / BATCH) % HG_H, e = (sample * 37 + 11) % 128;
    float s0 = 0.f, s1 = 0.f; unsigned r = 0;
    for (int t = 0; t < 128; ++t) {
        const size_t base = ((size_t)b * SEQ + t) * D + h * 128;
        const float f0 = sigmoidf_(FP[base + lane]), f1 = sigmoidf_(FP[base + lane + 64]);
        const float v = bf2f(V[base + e]);
        s0 = f0 * s0 + (1.f - f0) * v; s1 = f1 * s1 + (1.f - f1) * v;
        const float o = wave_sum(bf2f(Q[base + lane]) * s0 + bf2f(Q[base + lane + 64]) * s1);
        const unsigned short gb = O[base + e]; const float got = bf2f(gb);
        const bool nf = (gb & 0x7f80u) == 0x7f80u;
        if (t < 64) { if (nf) r |= 4u; else if (!(fabsf(got - o) < 0.05f + 0.03f * fabsf(o))) r |= 2u; }
        else if (nf) r |= 1u;
    }
    if (r && lane == 0) atomicOr(bits, r);
}
__global__ void flaginit_kernel(unsigned* flag) { *flag = 0xffffffffu; }
#endif

extern "C" void kernel_launch(void* const* d_in, const int* in_sizes, int n_in, void* d_out, int out_size, void* d_ws, size_t ws_size, hipStream_t stream) {
    static int grid = 0;
    if (grid == 0) {
        if (n_in != 22 || out_size != M * D || ws_size < WS_END) { fprintf(stderr, "kernel_launch: unexpected problem (n_in %d out %d ws %zu need %zu)\n", n_in, out_size, ws_size, (size_t)WS_END); grid = -1; return; }
        int dev = 0, cus = 0, per_cu = 0;
        if (hipGetDevice(&dev) != hipSuccess || hipDeviceGetAttribute(&cus, hipDeviceAttributeMultiprocessorCount, dev) != hipSuccess) { grid = -1; return; }
        if (hipFuncSetAttribute((const void*)fwd_kernel, hipFuncAttributeMaxDynamicSharedMemorySize, LDS_BYTES) != hipSuccess) { fprintf(stderr, "kernel_launch: hipFuncSetAttribute failed\n"); grid = -1; return; }
        if (hipOccupancyMaxActiveBlocksPerMultiprocessor(&per_cu, (const void*)fwd_kernel, NTHREADS, LDS_BYTES) != hipSuccess || per_cu < 1) fprintf(stderr, "kernel_launch: occupancy query reports %d\n", per_cu);
        grid = cus;
    }
    if (grid <= 0) return;
    (void)hipMemsetAsync((char*)d_ws + WS_CTL, 0, CTL_ZERO_BYTES, stream);
    Params p{};
    for (int i = 0; i < 22; ++i) p.in[i] = (const float*)d_in[i];
    p.out = (float*)d_out; p.ws = (unsigned char*)d_ws;
#if MK_N_LAUNCHES == 1
    p.ph_lo = 0; p.ph_hi = N_PHASES;
    hipLaunchKernelGGL(fwd_kernel, dim3(grid), dim3(NTHREADS), LDS_BYTES, stream, p);
#else
#if MK_DEBUG_SCAN
    unsigned char* ws = (unsigned char*)d_ws; unsigned* flag = (unsigned*)(ws + WS_CTL) + 2048;
    hipLaunchKernelGGL(flaginit_kernel, dim3(1), dim3(1), 0, stream, flag);
#define SCAN(ptr, n, isbf, k) hipLaunchKernelGGL(scan_kernel, dim3(1024), dim3(256), 0, stream, (const void*)(ptr), (size_t)(n), isbf, (unsigned)((k) + 1), flag, (const unsigned*)nullptr, (size_t)0)
#define SCANM(ptr, re, isbf, k, jj) hipLaunchKernelGGL(scan_kernel, dim3(1024), dim3(256), 0, stream, (const void*)(ptr), (size_t)0, isbf, (unsigned)((k) + 1), flag, (const unsigned*)(ws + WS_CTL) + CW_MOE + 64 * (jj), (size_t)(re))
#endif
    for (int k = 0; k < N_PHASES; ++k) { p.ph_lo = k; p.ph_hi = k + 1; hipLaunchKernelGGL(fwd_kernel, dim3(grid), dim3(NTHREADS), LDS_BYTES, stream, p);
#if MK_DEBUG_SCAN
        unsigned char* A = ws + WS_A; const size_t MD = (size_t)M * D;
        if (k == 0) { SCAN(ws + WS_W_HGIN, 2 * 4 * MD / M * D, 1, k); SCAN(ws + WS_W_HGOUT, 2 * (size_t)D * D, 1, k); SCAN(ws + WS_W_FGU, 2 * (size_t)2 * DFF * D, 1, k); SCAN(ws + WS_W_FDN, 2 * (size_t)DFF * D, 1, k);
            SCAN(ws + WS_W_DIN, 2 * (size_t)DSA_IN_PAD * D, 1, k); SCAN(ws + WS_W_DQ, 2 * (size_t)2560 * QR, 1, k); SCAN(ws + WS_W_DO, 2 * (size_t)D * 2048, 1, k);
            SCAN(ws + WS_W_MGU, 16 * (size_t)2 * DFF * D, 1, k); SCAN(ws + WS_W_MDN, 16 * (size_t)DFF * D, 1, k); SCAN(ws + WS_XB, MD, 1, k); }
        else { const int l = (k - 1) % PH_PER_PAIR, jj = (k - 1) / PH_PER_PAIR;
            switch (l) {
            case 0: SCAN(A + A_HQ, 3 * MD, 1, k); SCAN(A + A_HF, MD, 0, k);
                if (jj == 0) hipLaunchKernelGGL(chk_a1_kernel, dim3(64), dim3(256), 0, stream, (const float*)d_in[IN_X], (const float*)d_in[IN_HGWIN], (const bf16_t*)(A + A_HQ), (const float*)(A + A_HF), (unsigned)(k + 1), flag);
                break;
            case 1: SCAN(A + A_HO, MD, 1, k);
                if (jj == 0) hipLaunchKernelGGL(chk_hgrn_kernel, dim3(256), dim3(64), 0, stream, (const bf16_t*)(A + A_HQ), (const float*)(A + A_HF), (const bf16_t*)(A + A_HV), (const bf16_t*)(A + A_HO), flag + 64);
                break;
            case 2: SCAN(A + A_HOG, MD, 1, k); break;
            case 3: case 6: case 13: SCAN(ws + WS_Y, MD, 0, k); break;
            case 4: case 7: case 14: SCAN(ws + WS_X, MD, 0, k); SCAN(ws + WS_XB, MD, 1, k); break;
            case 5: SCAN(ws + WS_H, (size_t)M * DFF, 1, k); break;
            case 8: SCAN(A + A_RAW, (size_t)M * DSA_IN_PAD, 0, k); break;
            case 9: SCAN(A + A_CQ, (size_t)M * 256, 1, k); SCAN(A + A_CKV, (size_t)M * 256, 1, k); SCAN(A + A_KIDX, (size_t)M * 64, 1, k); SCAN(A + A_WIDX, (size_t)M * 8, 0, k); break;
            case 10: SCAN(A + A_QLAT, (size_t)M * 2048, 1, k); SCAN(A + A_QIDX, (size_t)M * 512, 1, k); break;
            case 12: SCAN(A + A_OLAT, (size_t)M * 2048, 1, k); break;
            case 15: SCANM(A + A_XG, D, 1, k, jj); break;
            case 16: SCANM(ws + WS_H, DFF, 1, k, jj); break;
            case 17: SCANM(A + A_OUTM, D, 0, k, jj); break;
            case 18: if (jj == 0) SCAN(ws + WS_X, MD, 0, k); else SCAN(d_out, MD, 0, k); break;
            default: break; } }
#endif
    }
#if MK_DEBUG_SCAN
    hipLaunchKernelGGL(fin_kernel, dim3(1024), dim3(256), 0, stream, (float*)d_out, (size_t)M * D, (const unsigned*)flag);
#endif
#endif
}
```

```cpp
#include <hip/hip_runtime.h>
#include <cstdio>
#include <cstdint>

#ifndef MK_DEBUG_SCAN
#define MK_DEBUG_SCAN 0
#endif
#ifndef MK_N_LAUNCHES
#define MK_N_LAUNCHES 1
#endif

#define GAS __attribute__((address_space(1)))
#define LAS __attribute__((address_space(3)))
typedef unsigned short bf16_t;
typedef short bf16x8 __attribute__((ext_vector_type(8)));
typedef short s16x4 __attribute__((ext_vector_type(4)));
typedef float f32x4 __attribute__((ext_vector_type(4)));
typedef float f32x2 __attribute__((ext_vector_type(2)));
typedef unsigned u32x4 __attribute__((ext_vector_type(4)));
typedef unsigned u32x2 __attribute__((ext_vector_type(2)));

constexpr int D = 1024, BATCH = 16, SEQ = 2048, M = BATCH * SEQ;
constexpr int DFF = 3584, NEXP = 8;
constexpr int HG_H = 8, HG_DK = 128, HG_C = 64;
constexpr int QR = 256, KVR = 256, IDXD = 64, IDXH = 8, DSA_H = 8, DSA_HD = 128, TOPK = 256;
constexpr int DSA_IN = 584, DSA_IN_PAD = 768;
constexpr int MOE_ROWS = 2 * M + NEXP * 256;
constexpr float ALPHA = 1.6817928305074290f;
constexpr float LN_EPS = 1e-5f, RMS_EPS = 1e-6f;
constexpr int NWAVES = 8, NTHREADS = 512;

constexpr size_t MiB = 1u << 20;
constexpr size_t WS_CTL = 0, CTL_ZERO_BYTES = 1 * MiB;
constexpr size_t WS_W_HGIN = 1 * MiB;
constexpr size_t WS_W_HGOUT = 17 * MiB;
constexpr size_t WS_W_FGU = 21 * MiB;
constexpr size_t WS_W_FDN = 49 * MiB;
constexpr size_t WS_W_DIN = 63 * MiB;
constexpr size_t WS_W_DQ = 66 * MiB;
constexpr size_t WS_W_DO = 69 * MiB;
constexpr size_t WS_W_MGU = 77 * MiB;
constexpr size_t WS_W_MDN = 301 * MiB;
constexpr size_t WS_X = 416 * MiB;
constexpr size_t WS_XB = 544 * MiB;
constexpr size_t WS_Y = 608 * MiB;
constexpr size_t WS_A = 736 * MiB;
constexpr size_t WS_H = 1184 * MiB;
constexpr size_t WS_END = 1648 * MiB;
constexpr size_t A_HQ = 0, A_HF = 64 * MiB, A_HV = 128 * MiB, A_HG = 192 * MiB, A_HO = 320 * MiB, A_HOG = 384 * MiB;
constexpr size_t A_RAW = 0, A_CQ = 96 * MiB, A_CKV = 112 * MiB, A_KIDX = 128 * MiB, A_WIDX = 132 * MiB, A_MASK = 136 * MiB, A_QLAT = 144 * MiB, A_QIDX = 272 * MiB, A_OLAT = 304 * MiB;
constexpr size_t A_OUTM = 136 * MiB, A_EIDX = 404 * MiB, A_POS = 405 * MiB, A_TOK = 406 * MiB, A_GW = 407 * MiB;
constexpr int CW_BAR = 4096, CW_MOE = 16384;

constexpr int RING_BYTES = 131072;
constexpr int LDSCTL_OFF = RING_BYTES, MISC_OFF = LDSCTL_OFF + 320;
constexpr int STAGE_TOKL = RING_BYTES + 2048;
constexpr int LDS_BYTES = 147456;

typedef __bf16 hwbf16x2 __attribute__((ext_vector_type(2)));
__device__ __forceinline__ unsigned cvt_pk_bf16(float lo, float hi) { const f32x2 v = {lo, hi}; const hwbf16x2 b = __builtin_convertvector(v, hwbf16x2); return __builtin_bit_cast(unsigned, b); }
__device__ __forceinline__ bf16_t f2bf(float f) { return (bf16_t)(cvt_pk_bf16(f, 0.f) & 0xffffu); }
__device__ __forceinline__ float bf2f(bf16_t b) { return __uint_as_float(((unsigned)b) << 16); }
__device__ __forceinline__ float wave_sum(float v) {
    v += __builtin_bit_cast(float, __builtin_amdgcn_update_dpp(0, __builtin_bit_cast(int, v), 0xB1, 0xF, 0xF, true));
    v += __builtin_bit_cast(float, __builtin_amdgcn_update_dpp(0, __builtin_bit_cast(int, v), 0x4E, 0xF, 0xF, true));
    v += __builtin_bit_cast(float, __builtin_amdgcn_update_dpp(0, __builtin_bit_cast(int, v), 0x141, 0xF, 0xF, true));
    v += __builtin_bit_cast(float, __builtin_amdgcn_update_dpp(0, __builtin_bit_cast(int, v), 0x140, 0xF, 0xF, true));
    const float r0 = __builtin_bit_cast(float, __builtin_amdgcn_readlane(__builtin_bit_cast(int, v), 0)), r1 = __builtin_bit_cast(float, __builtin_amdgcn_readlane(__builtin_bit_cast(int, v), 16));
    const float r2 = __builtin_bit_cast(float, __builtin_amdgcn_readlane(__builtin_bit_cast(int, v), 32)), r3 = __builtin_bit_cast(float, __builtin_amdgcn_readlane(__builtin_bit_cast(int, v), 48));
    return (r0 + r1) + (r2 + r3);
}
__device__ __forceinline__ float fast_exp2(float x) { return __builtin_amdgcn_exp2f(x); }
__device__ __forceinline__ float fast_rcp(float x) { return __builtin_amdgcn_rcpf(x); }
__device__ __forceinline__ float sigmoidf_(float x) { return fast_rcp(1.0f + __expf(-x)); }
__device__ __forceinline__ float siluf_(float x) { return x * sigmoidf_(x); }
#define LDS_WAIT() asm volatile("s_waitcnt lgkmcnt(0)" ::: "memory")
#define VM_WAIT() asm volatile("s_waitcnt vmcnt(0)" ::: "memory")

#define XB_TMO      128
#define XB_XCNT(j)  (256  + 64 * (j))
#define XB_XSUB(j)  (1280 + 64 * (j))
#define XB_XGEN(j)  (2304 + 64 * (j))
#define XB_TOP      3328
#define XB_TOPGEN   3392
#define XCD_BAR_WORDS 3456
#define XB_SPIN_CAP (1u << 20)

__device__ __forceinline__ unsigned xb_ld(unsigned* p)              { return __hip_atomic_load(p, __ATOMIC_RELAXED, __HIP_MEMORY_SCOPE_AGENT); }
__device__ __forceinline__ unsigned xb_add(unsigned* p, unsigned v) { return __hip_atomic_fetch_add(p, v, __ATOMIC_RELAXED, __HIP_MEMORY_SCOPE_AGENT); }
__device__ __forceinline__ unsigned xb_xcc_id() { return (unsigned)__builtin_amdgcn_s_getreg((3 << 11) | 20) & 0xFu; }
#define XB_SPIN(cond, bar) do { unsigned _sp = 0; while (cond) { __builtin_amdgcn_s_sleep(1); \
    if ((++_sp & 255u) == 0u) { if (xb_ld(&(bar)[XB_TMO])) break; if (_sp > XB_SPIN_CAP) { atomicAdd(&(bar)[XB_TMO], 1u); break; } } } } while (0)

struct XcdBarrier { unsigned* bar; unsigned x; volatile LAS unsigned* st; };

__device__ __forceinline__ XcdBarrier xcd_barrier_post(unsigned* bar, volatile LAS unsigned* st) {
    XcdBarrier b; b.bar = bar; b.x = xb_xcc_id(); b.st = st;
    if (threadIdx.x == 0) (void)xb_add(&bar[XB_XCNT(b.x)], 1u);
    return b;
}
__device__ __forceinline__ void xcd_barrier_complete(unsigned* bar, unsigned x, unsigned& nloc, unsigned& nx) {
    const unsigned G = gridDim.x * gridDim.y * gridDim.z;
    unsigned sum, cnt, mine, sp = 0u;
    for (;;) {
        sum = 0u; cnt = 0u; mine = 0u;
#pragma unroll
        for (unsigned j = 0; j < 16; ++j) { const unsigned c = xb_ld(&bar[XB_XCNT(j)]); sum += c; cnt += (c > 0u) ? 1u : 0u; mine = (j == x) ? c : mine; }
        if (sum == G) break;
        __builtin_amdgcn_s_sleep(1);
        if ((++sp & 255u) == 0u) { if (xb_ld(&bar[XB_TMO])) break; if (sp > XB_SPIN_CAP) { atomicAdd(&bar[XB_TMO], 1u); break; } }
    }
    nloc = mine > 0u ? mine : 1u; nx = cnt > 0u ? cnt : 1u;
}
__device__ __forceinline__ void xcd_barrier(const XcdBarrier& b) {
    asm volatile("s_waitcnt vmcnt(0)" ::: "memory");
    __syncthreads();
    if (threadIdx.x == 0) {
        unsigned* bar = b.bar;
        __builtin_amdgcn_s_waitcnt(0);
        unsigned nloc = b.st[0], nx = b.st[1];
        if (nloc == 0u) { xcd_barrier_complete(bar, b.x, nloc, nx); b.st[0] = nloc; b.st[1] = nx; }
        const unsigned old = xb_add(&bar[XB_XSUB(b.x)], 1u);
        const unsigned gen = old / nloc;
        if (old + 1u == (gen + 1u) * nloc) {
            __builtin_amdgcn_fence(__ATOMIC_RELEASE, "agent");
            asm volatile("s_waitcnt vmcnt(0)" ::: "memory");
            const unsigned og = xb_add(&bar[XB_TOP], 1u);
            const unsigned tg = og / nx;
            if (og + 1u == (tg + 1u) * nx) xb_add(&bar[XB_TOPGEN], 1u);
            else XB_SPIN(xb_ld(&bar[XB_TOPGEN]) == tg, bar);
            __builtin_amdgcn_fence(__ATOMIC_ACQUIRE, "agent");
            xb_add(&bar[XB_XGEN(b.x)], 1u);
            asm volatile("s_waitcnt vmcnt(0)" ::: "memory");
        } else {
            XB_SPIN(xb_ld(&bar[XB_XGEN(b.x)]) == gen, bar);
            __builtin_amdgcn_fence(__ATOMIC_ACQUIRE, "agent");
            asm volatile("s_waitcnt vmcnt(0)" ::: "memory");
        }
    }
    __syncthreads();
}

constexpr int BM = 256, BK = 64, HALF = 128, HTB = HALF * BK * 2, NXCD = 8, WGM = 8;
__device__ __forceinline__ int lds_byte(int r, int c) { const int st = (r >> 4) * 2 + (c >> 5), rr = r & 15, cc = c & 31, ob = rr * 64 + cc * 2; return st * 1024 + (ob ^ (((ob >> 9) & 1) << 5)); }
__device__ __forceinline__ void stage_rc(int b, int& R, int& C) { const int st = b / 1024, sb = b % 1024, swz = sb ^ (((sb >> 9) & 1) << 5); R = (st >> 1) * 16 + swz / 64; C = (st & 1) * 32 + (swz % 64) / 2; }
__device__ __forceinline__ int perm32(int rho) { const int n = rho >> 4, i = rho & 15; return 8 * (i >> 2) + 4 * n + (i & 3); }

struct Unit { int pm, pn, pb, lt, cnt, e; };
struct Gemm { const bf16_t* A; const bf16_t* Bt; int K; };

__device__ __forceinline__ void tile_map(int L, int nM, int nN, int& pm, int& pn) {
    const int nwg = nM * nN;
    int wgid = L; { const int q = nwg / NXCD, r = nwg % NXCD, xcd = wgid % NXCD, off = wgid / NXCD; wgid = (xcd < r ? xcd * (q + 1) : r * (q + 1) + (xcd - r) * q) + off; }
    const int nig = WGM * nN, gid = wgid / nig, fm = gid * WGM, gsz = (nM - fm) < WGM ? (nM - fm) : WGM;
    pm = fm + ((wgid % nig) % gsz); pn = (wgid % nig) / gsz;
}
struct StaticOrder {
    int nM, nN, nwg, G, c;
    __device__ __forceinline__ void init(int M_, int N_, int G_, int c_) { nM = M_ / BM; nN = N_ / BM; nwg = nM * nN; G = G_; c = c_; }
    __device__ __forceinline__ bool next(int i, Unit& u) const {
        const long L = (long)i * G + c; if (L >= nwg) return false;
        tile_map((int)L, nM, nN, u.pm, u.pn); u.pb = u.pn; u.lt = 0; u.cnt = 0; u.e = 0; return true;
    }
};
struct MoeOrder {
    int t1, t2, t3, t4, t5, t6, t7, nM, nN, nwg, G, c; const unsigned* cntp;
    __device__ __forceinline__ void init(const unsigned* cnt, int nN_, int G_, int c_) {
        int t = 0, o[9];
#pragma unroll
        for (int e = 0; e < 8; ++e) { o[e] = t; const int ce = __builtin_amdgcn_readfirstlane((int)__hip_atomic_load(cnt + e, __ATOMIC_RELAXED, __HIP_MEMORY_SCOPE_AGENT)); t += (ce + 255) >> 8; }
        o[8] = t; t1 = o[1]; t2 = o[2]; t3 = o[3]; t4 = o[4]; t5 = o[5]; t6 = o[6]; t7 = o[7];
        nM = t; nN = nN_; nwg = nM * nN; G = G_; c = c_; cntp = cnt;
    }
    __device__ __forceinline__ bool next(int i, Unit& u) const {
        const long L = (long)i * G + c; if (L >= nwg) return false;
        tile_map((int)L, nM, nN, u.pm, u.pn);
        const int e = (u.pm >= t1) + (u.pm >= t2) + (u.pm >= t3) + (u.pm >= t4) + (u.pm >= t5) + (u.pm >= t6) + (u.pm >= t7);
        const int tb = e == 0 ? 0 : e == 1 ? t1 : e == 2 ? t2 : e == 3 ? t3 : e == 4 ? t4 : e == 5 ? t5 : e == 6 ? t6 : t7;
        u.cnt = __builtin_amdgcn_readfirstlane((int)__hip_atomic_load(cntp + e, __ATOMIC_RELAXED, __HIP_MEMORY_SCOPE_AGENT));
        u.lt = u.pm - tb; u.e = e; u.pb = e * nN + u.pn; return true;
    }
};

typedef f32x4 Acc[2][2][4][2];

template <class Epi, class Sched>
__device__ __forceinline__ void gemm_phase(LAS unsigned char* lds, const Gemm g, const Sched& S, const Epi& E) {
    int tid_ = threadIdx.x; asm volatile("" : "+v"(tid_));
    const int tid = tid_, wid = __builtin_amdgcn_readfirstlane(tid >> 6), lane = tid & 63, wr = wid >> 2, wc = wid & 3, fr = lane & 15, fq = lane >> 4;
    const int K = g.K, nt = K / BK;
    unsigned voffA[2], voffB[2];
#pragma unroll
    for (int i = 0; i < 2; ++i) { int R, C; stage_rc(tid * 16 + i * 8192, R, C); const int Rb = (R & ~31) + perm32(R & 31);
        voffA[i] = (unsigned)(R * K + C) * 2u; voffB[i] = (unsigned)(Rb * K + C) * 2u; }
    const size_t kstep = (size_t)(BK * 2);
    const size_t hstep = (size_t)HALF * K * 2;
    const size_t tstep = 2 * hstep;
    const unsigned ldsw = (unsigned)wid * 1024u;
    const int aoff = lds_byte(wr * 64 + fr, fq * 8), boff = lds_byte(wc * 32 + fr, fq * 8);
#define PG8_SA(b, h) (((b) * 2 + (h)) * HTB)
#define PG8_SB(b, h) ((4 + (b) * 2 + (h)) * HTB)
#define PG8_STAGE(bufoff, gbase, voff) do { _Pragma("unroll") for (int _i = 0; _i < 2; ++_i) \
        __builtin_amdgcn_global_load_lds((const unsigned*)((const char*)(gbase) + (voff)[_i]), (LAS unsigned*)(lds + (bufoff) + ldsw + _i * 8192), 16, 0, 0); } while (0)
#define PG8_LDA(dst, b, h) do { _Pragma("unroll") for (int m = 0; m < 4; ++m) _Pragma("unroll") for (int k = 0; k < 2; ++k) dst[m][k] = *(const LAS bf16x8*)(lds + PG8_SA(b, h) + aoff + m * 2048 + k * 1024); } while (0)
#define PG8_LDB(dst, b, h) do { _Pragma("unroll") for (int n = 0; n < 2; ++n) _Pragma("unroll") for (int k = 0; k < 2; ++k) dst[n][k] = *(const LAS bf16x8*)(lds + PG8_SB(b, h) + boff + n * 2048 + k * 1024); } while (0)
#define PG8_MMA(ai, bj, At, Bt) do { __builtin_amdgcn_s_setprio(1); _Pragma("unroll") for (int m = 0; m < 4; ++m) _Pragma("unroll") for (int n = 0; n < 2; ++n) _Pragma("unroll") for (int k = 0; k < 2; ++k) \
        acc[ai][bj][m][n] = __builtin_amdgcn_mfma_f32_16x16x32_bf16(Bt[n][k], At[m][k], acc[ai][bj][m][n], 0, 0, 0); __builtin_amdgcn_s_setprio(0); } while (0)
#define PG8_WAIT_V(n) asm volatile("s_waitcnt vmcnt(" #n ")" ::: "memory")
#define PG8_WAIT_L(n) asm volatile("s_waitcnt lgkmcnt(" #n ")" ::: "memory")
#define PG8_BAR __builtin_amdgcn_s_barrier()
#define PG8_SCHED __builtin_amdgcn_sched_barrier(0)
    Unit cur, nxt; int ui = 0;
    if (!S.next(0, cur)) return;
    Acc acc;
#pragma unroll
    for (int a = 0; a < 2; ++a)
#pragma unroll
        for (int b = 0; b < 2; ++b)
#pragma unroll
            for (int m = 0; m < 4; ++m)
#pragma unroll
                for (int n = 0; n < 2; ++n) acc[a][b][m][n] = (f32x4){0.f, 0.f, 0.f, 0.f};
    bf16x8 At[4][2], B0[2][2], B1[2][2];
    const char* cA = (const char*)g.A + (size_t)cur.pm * tstep; const char* cB = (const char*)g.Bt + (size_t)cur.pb * tstep;
    PG8_STAGE(PG8_SB(0, 0), cB, voffB); PG8_STAGE(PG8_SA(0, 0), cA, voffA); PG8_STAGE(PG8_SB(0, 1), cB + hstep, voffB); PG8_STAGE(PG8_SA(0, 1), cA + hstep, voffA);
    if (wr == 1) PG8_BAR;
    PG8_WAIT_V(4); PG8_BAR;
    PG8_STAGE(PG8_SB(1, 0), cB + kstep, voffB); PG8_STAGE(PG8_SA(1, 0), cA + kstep, voffA); PG8_STAGE(PG8_SB(1, 1), cB + hstep + kstep, voffB);
    PG8_WAIT_V(6); PG8_BAR;
    for (;;) {
        const bool has_next = S.next(ui + 1, nxt);
        const char* nA = has_next ? (const char*)g.A + (size_t)nxt.pm * tstep : cA; const char* nB = has_next ? (const char*)g.Bt + (size_t)nxt.pb * tstep : cB;
        for (int t = 0; t < nt; t += 2) {
            const bool last = (t == nt - 2);
            const char* a1 = cA + (size_t)(t + 1) * kstep;
            const char* a2 = last ? nA : cA + (size_t)(t + 2) * kstep; const char* b2 = last ? nB : cB + (size_t)(t + 2) * kstep;
            const char* a3 = a2 + kstep; const char* b3 = b2 + kstep;
            PG8_LDB(B0, 0, 0); PG8_SCHED; PG8_LDA(At, 0, 0); PG8_STAGE(PG8_SA(1, 1), a1 + hstep, voffA);
            PG8_WAIT_L(8); PG8_BAR; PG8_WAIT_L(0); PG8_MMA(0, 0, At, B0); PG8_BAR; PG8_SCHED;
            PG8_LDB(B1, 0, 1); PG8_STAGE(PG8_SB(0, 0), b2, voffB);
            PG8_BAR; PG8_WAIT_L(0); PG8_MMA(0, 1, At, B1); PG8_BAR;
            PG8_LDA(At, 0, 1); PG8_STAGE(PG8_SA(0, 0), a2, voffA);
            PG8_BAR; PG8_WAIT_L(0); PG8_MMA(1, 0, At, B0); PG8_BAR; PG8_SCHED;
            PG8_STAGE(PG8_SB(0, 1), b2 + hstep, voffB);
            PG8_WAIT_V(6); PG8_BAR; PG8_MMA(1, 1, At, B1); PG8_BAR;
            PG8_LDB(B0, 1, 0); PG8_SCHED; PG8_LDA(At, 1, 0); PG8_STAGE(PG8_SA(0, 1), a2 + hstep, voffA);
            PG8_WAIT_L(8); PG8_BAR; PG8_WAIT_L(0); PG8_MMA(0, 0, At, B0); PG8_BAR; PG8_SCHED;
            PG8_LDB(B1, 1, 1); PG8_STAGE(PG8_SB(1, 0), b3, voffB);
            PG8_BAR; PG8_WAIT_L(0); PG8_MMA(0, 1, At, B1); PG8_BAR;
            PG8_LDA(At, 1, 1); PG8_STAGE(PG8_SA(1, 0), a3, voffA);
            PG8_BAR; PG8_WAIT_L(0); PG8_MMA(1, 0, At, B0); PG8_BAR; PG8_SCHED;
            PG8_STAGE(PG8_SB(1, 1), b3 + hstep, voffB);
            PG8_WAIT_V(6); PG8_BAR; PG8_MMA(1, 1, At, B1); PG8_BAR;
        }
        E(acc, cur, wr, wc, fr, fq);
        if (!has_next) break;
#pragma unroll
        for (int a = 0; a < 2; ++a)
#pragma unroll
            for (int b = 0; b < 2; ++b)
#pragma unroll
                for (int m = 0; m < 4; ++m)
#pragma unroll
                    for (int n = 0; n < 2; ++n) acc[a][b][m][n] = (f32x4){0.f, 0.f, 0.f, 0.f};
        cur = nxt; cA = nA; cB = nB; ++ui;
    }
    PG8_WAIT_V(0);
    if (wr == 0) PG8_BAR;
    PG8_BAR;
#undef PG8_SA
#undef PG8_SB
#undef PG8_STAGE
#undef PG8_LDA
#undef PG8_LDB
#undef PG8_MMA
#undef PG8_WAIT_V
#undef PG8_WAIT_L
#undef PG8_BAR
#undef PG8_SCHED
}

template <class Epi, class Sched>
__device__ __forceinline__ void gemm_phase_gather(LAS unsigned char* lds, const Gemm g, const Sched& S, const Epi& E, const int* TOKV) {
    int tid_ = threadIdx.x; asm volatile("" : "+v"(tid_));
    const int tid = tid_, wid = __builtin_amdgcn_readfirstlane(tid >> 6), lane = tid & 63, wr = wid >> 2, wc = wid & 3, fr = lane & 15, fq = lane >> 4;
    const int K = g.K, nt = K / BK;
    unsigned voffB[2];
#pragma unroll
    for (int i = 0; i < 2; ++i) { int R, C; stage_rc(tid * 16 + i * 8192, R, C); const int Rb = (R & ~31) + perm32(R & 31); voffB[i] = (unsigned)(Rb * K + C) * 2u; }
    unsigned vgC[2][2];
    LAS int* TOKL = (LAS int*)(lds + STAGE_TOKL);
#define PG8_GROWS(dst, u_) do { int tq_ = threadIdx.x; asm volatile("" : "+v"(tq_)); _Pragma("unroll") for (int i_ = 0; i_ < 2; ++i_) { int R_, C_; stage_rc(tq_ * 16 + i_ * 8192, R_, C_); \
            _Pragma("unroll") for (int h_ = 0; h_ < 2; ++h_) { const int pos_ = 256 * (u_).lt + 128 * h_ + R_; \
                const int tok_ = (pos_ < (u_).cnt) ? TOKV[(size_t)(u_).e * M + pos_] : 0; dst[h_][i_] = (unsigned)tok_ * (unsigned)(K * 2) + (unsigned)C_ * 2u; } } } while (0)
#define PG8_GROWS_LDS(dst, u_, par_) do { int tq_ = threadIdx.x; asm volatile("" : "+v"(tq_)); _Pragma("unroll") for (int i_ = 0; i_ < 2; ++i_) { int R_, C_; stage_rc(tq_ * 16 + i_ * 8192, R_, C_); \
            _Pragma("unroll") for (int h_ = 0; h_ < 2; ++h_) { const int rl_ = 128 * h_ + R_; \
                const int tok_ = (256 * (u_).lt + rl_ < (u_).cnt) ? TOKL[256 * (par_) + rl_] : 0; dst[h_][i_] = (unsigned)tok_ * (unsigned)(K * 2) + (unsigned)C_ * 2u; } } } while (0)
    const size_t kstep = (size_t)(BK * 2);
    const size_t hstep = (size_t)HALF * K * 2;
    const size_t tstep = 2 * hstep;
    const unsigned ldsw = (unsigned)wid * 1024u;
    const int aoff = lds_byte(wr * 64 + fr, fq * 8), boff = lds_byte(wc * 32 + fr, fq * 8);
#define PG8_SA(b, h) (((b) * 2 + (h)) * HTB)
#define PG8_SB(b, h) ((4 + (b) * 2 + (h)) * HTB)
#define PG8_STAGE(bufoff, gbase, voff) do { _Pragma("unroll") for (int _i = 0; _i < 2; ++_i) \
        __builtin_amdgcn_global_load_lds((const unsigned*)((const char*)(gbase) + (voff)[_i]), (LAS unsigned*)(lds + (bufoff) + ldsw + _i * 8192), 16, 0, 0); } while (0)
#define PG8_STAGEA(bufoff, gbase, h_, nx_) PG8_STAGE(bufoff, gbase, vgC[h_])
#define PG8_LDA(dst, b, h) do { _Pragma("unroll") for (int m = 0; m < 4; ++m) _Pragma("unroll") for (int k = 0; k < 2; ++k) dst[m][k] = *(const LAS bf16x8*)(lds + PG8_SA(b, h) + aoff + m * 2048 + k * 1024); } while (0)
#define PG8_LDB(dst, b, h) do { _Pragma("unroll") for (int n = 0; n < 2; ++n) _Pragma("unroll") for (int k = 0; k < 2; ++k) dst[n][k] = *(const LAS bf16x8*)(lds + PG8_SB(b, h) + boff + n * 2048 + k * 1024); } while (0)
#define PG8_MMA(ai, bj, At, Bt) do { __builtin_amdgcn_s_setprio(1); _Pragma("unroll") for (int m = 0; m < 4; ++m) _Pragma("unroll") for (int n = 0; n < 2; ++n) _Pragma("unroll") for (int k = 0; k < 2; ++k) \
        acc[ai][bj][m][n] = __builtin_amdgcn_mfma_f32_16x16x32_bf16(Bt[n][k], At[m][k], acc[ai][bj][m][n], 0, 0, 0); __builtin_amdgcn_s_setprio(0); } while (0)
#define PG8_WAIT_V(n) asm volatile("s_waitcnt vmcnt(" #n ")" ::: "memory")
#define PG8_WAIT_L(n) asm volatile("s_waitcnt lgkmcnt(" #n ")" ::: "memory")
#define PG8_BAR __builtin_amdgcn_s_barrier()
#define PG8_SCHED __builtin_amdgcn_sched_barrier(0)
    Unit cur, nxt; int ui = 0;
    if (!S.next(0, cur)) return;
    Acc acc;
#pragma unroll
    for (int a = 0; a < 2; ++a)
#pragma unroll
        for (int b = 0; b < 2; ++b)
#pragma unroll
            for (int m = 0; m < 4; ++m)
#pragma unroll
                for (int n = 0; n < 2; ++n) acc[a][b][m][n] = (f32x4){0.f, 0.f, 0.f, 0.f};
    bf16x8 At[4][2], B0[2][2], B1[2][2];
    const char* cA = (const char*)g.A; const char* cB = (const char*)g.Bt + (size_t)cur.pb * tstep;
    PG8_GROWS(vgC, cur);
    PG8_STAGE(PG8_SB(0, 0), cB, voffB); PG8_STAGEA(PG8_SA(0, 0), cA, 0, false); PG8_STAGE(PG8_SB(0, 1), cB + hstep, voffB); PG8_STAGEA(PG8_SA(0, 1), cA, 1, false);
    if (wr == 1) PG8_BAR;
    PG8_WAIT_V(4); PG8_BAR;
    PG8_STAGE(PG8_SB(1, 0), cB + kstep, voffB); PG8_STAGEA(PG8_SA(1, 0), cA + kstep, 0, false); PG8_STAGE(PG8_SB(1, 1), cB + hstep + kstep, voffB);
    PG8_WAIT_V(6); PG8_BAR;
    for (;;) {
        const bool has_next = S.next(ui + 1, nxt);
        const char* nA = cA; const char* nB = has_next ? (const char*)g.Bt + (size_t)nxt.pb * tstep : cB;
        if (has_next && wid == 0) __builtin_amdgcn_global_load_lds((const unsigned*)(TOKV + (size_t)nxt.e * M + 256 * nxt.lt + 4 * lane), (LAS unsigned*)(TOKL + 256 * ((ui + 1) & 1)), 16, 0, 0);

        for (int t = 0; t < nt; t += 2) {
            const bool last = (t == nt - 2);
            const char* a1 = cA + (size_t)(t + 1) * kstep;
            const char* a2 = last ? nA : cA + (size_t)(t + 2) * kstep; const char* b2 = last ? nB : cB + (size_t)(t + 2) * kstep;
            const char* a3 = a2 + kstep; const char* b3 = b2 + kstep;
            PG8_LDB(B0, 0, 0); PG8_SCHED; PG8_LDA(At, 0, 0); PG8_STAGEA(PG8_SA(1, 1), a1, 1, false);
            if (last && has_next) { PG8_GROWS_LDS(vgC, nxt, (ui + 1) & 1); }
            PG8_WAIT_L(8); PG8_BAR; PG8_WAIT_L(0); PG8_MMA(0, 0, At, B0); PG8_BAR; PG8_SCHED;
            PG8_LDB(B1, 0, 1); PG8_STAGE(PG8_SB(0, 0), b2, voffB);
            PG8_BAR; PG8_WAIT_L(0); PG8_MMA(0, 1, At, B1); PG8_BAR;
            PG8_LDA(At, 0, 1); PG8_STAGEA(PG8_SA(0, 0), a2, 0, last);
            PG8_BAR; PG8_WAIT_L(0); PG8_MMA(1, 0, At, B0); PG8_BAR; PG8_SCHED;
            PG8_STAGE(PG8_SB(0, 1), b2 + hstep, voffB);
            PG8_WAIT_V(6); PG8_BAR; PG8_MMA(1, 1, At, B1); PG8_BAR;
            PG8_LDB(B0, 1, 0); PG8_SCHED; PG8_LDA(At, 1, 0); PG8_STAGEA(PG8_SA(0, 1), a2, 1, last);
            PG8_WAIT_L(8); PG8_BAR; PG8_WAIT_L(0); PG8_MMA(0, 0, At, B0); PG8_BAR; PG8_SCHED;
            PG8_LDB(B1, 1, 1); PG8_STAGE(PG8_SB(1, 0), b3, voffB);
            PG8_BAR; PG8_WAIT_L(0); PG8_MMA(0, 1, At, B1); PG8_BAR;
            PG8_LDA(At, 1, 1); PG8_STAGEA(PG8_SA(1, 0), a3, 0, last);
            PG8_BAR; PG8_WAIT_L(0); PG8_MMA(1, 0, At, B0); PG8_BAR; PG8_SCHED;
            PG8_STAGE(PG8_SB(1, 1), b3 + hstep, voffB);
            PG8_WAIT_V(6); PG8_BAR; PG8_MMA(1, 1, At, B1); PG8_BAR;
        }
        E(acc, cur, wr, wc, fr, fq);
        if (!has_next) break;
#pragma unroll
        for (int a = 0; a < 2; ++a)
#pragma unroll
            for (int b = 0; b < 2; ++b)
#pragma unroll
                for (int m = 0; m < 4; ++m)
#pragma unroll
                    for (int n = 0; n < 2; ++n) acc[a][b][m][n] = (f32x4){0.f, 0.f, 0.f, 0.f};
        cur = nxt; cB = nB; ++ui;
    }
    PG8_WAIT_V(0);
    if (wr == 0) PG8_BAR;
    PG8_BAR;
#undef PG8_SA
#undef PG8_STAGEA
#undef PG8_GROWS
#undef PG8_GROWS_LDS
#undef PG8_SB
#undef PG8_STAGE
#undef PG8_LDA
#undef PG8_LDB
#undef PG8_MMA
#undef PG8_WAIT_V
#undef PG8_WAIT_L
#undef PG8_BAR
#undef PG8_SCHED
}

__device__ __forceinline__ u32x4 pack8(const f32x4 a, const f32x4 b) { u32x4 w; w.x = cvt_pk_bf16(a[0], a[1]); w.y = cvt_pk_bf16(a[2], a[3]); w.z = cvt_pk_bf16(b[0], b[1]); w.w = cvt_pk_bf16(b[2], b[3]); return w; }

struct EpiHgIn {
    bf16_t* QFVG;
    __device__ __forceinline__ void operator()(const Acc& acc, const Unit& u, int wr, int wc, int fr, int fq) const {
        const int part = u.pn >> 2, row0 = u.pm * BM + wr * 64 + fr, col0 = (u.pn & 3) * 256 + wc * 32 + 8 * fq;
        bf16_t* base = QFVG + (size_t)part * ((size_t)M * D);
#pragma unroll
        for (int ai = 0; ai < 2; ++ai)
#pragma unroll
            for (int m = 0; m < 4; ++m) { bf16_t* rowp = base + (size_t)(row0 + ai * HALF + m * 16) * D + col0;
#pragma unroll
                for (int bj = 0; bj < 2; ++bj) *(u32x4*)(rowp + bj * HALF) = pack8(acc[ai][bj][m][0], acc[ai][bj][m][1]); }
    }
};
struct EpiRes {
    const bf16_t* X; bf16_t* Y;
    __device__ __forceinline__ void operator()(const Acc& acc, const Unit& u, int wr, int wc, int fr, int fq) const {
        const int row0 = u.pm * BM + wr * 64 + fr, col0 = u.pn * BM + wc * 32 + 8 * fq;
#pragma unroll
        for (int ai = 0; ai < 2; ++ai)
#pragma unroll
            for (int m = 0; m < 4; ++m) { const size_t o = (size_t)(row0 + ai * HALF + m * 16) * D + col0;
#pragma unroll
                for (int bj = 0; bj < 2; ++bj) {
                    const u32x4 xv = *(const u32x4*)(X + o + bj * HALF);
                    f32x4 y0, y1;
#pragma unroll
                    for (int q = 0; q < 2; ++q) { y0[2 * q] = __uint_as_float(xv[q] << 16) * ALPHA + acc[ai][bj][m][0][2 * q]; y0[2 * q + 1] = __uint_as_float(xv[q] & 0xffff0000u) * ALPHA + acc[ai][bj][m][0][2 * q + 1];
                        y1[2 * q] = __uint_as_float(xv[2 + q] << 16) * ALPHA + acc[ai][bj][m][1][2 * q]; y1[2 * q + 1] = __uint_as_float(xv[2 + q] & 0xffff0000u) * ALPHA + acc[ai][bj][m][1][2 * q + 1]; }
                    *(u32x4*)(Y + o + bj * HALF) = pack8(y0, y1); } }
    }
};
struct EpiSwiglu {
    bf16_t* H;
    __device__ __forceinline__ void operator()(const Acc& acc, const Unit& u, int wr, int wc, int fr, int fq) const {
        const int row0 = u.pm * BM + wr * 64 + fr, col0 = u.pn * 128 + wc * 32 + 8 * fq;
#pragma unroll
        for (int ai = 0; ai < 2; ++ai)
#pragma unroll
            for (int m = 0; m < 4; ++m) { bf16_t* rowp = H + (size_t)(row0 + ai * HALF + m * 16) * DFF + col0;
                f32x4 h0, h1;
#pragma unroll
                for (int j = 0; j < 4; ++j) { h0[j] = siluf_(acc[ai][0][m][0][j]) * acc[ai][1][m][0][j]; h1[j] = siluf_(acc[ai][0][m][1][j]) * acc[ai][1][m][1][j]; }
                *(u32x4*)rowp = pack8(h0, h1); }
    }
};
struct EpiBf16 {
    bf16_t* C; int ldc;
    __device__ __forceinline__ void operator()(const Acc& acc, const Unit& u, int wr, int wc, int fr, int fq) const {
        const int row0 = u.pm * BM + wr * 64 + fr, col0 = u.pn * BM + wc * 32 + 8 * fq;
#pragma unroll
        for (int ai = 0; ai < 2; ++ai)
#pragma unroll
            for (int m = 0; m < 4; ++m) { bf16_t* rowp = C + (size_t)(row0 + ai * HALF + m * 16) * ldc + col0;
#pragma unroll
                for (int bj = 0; bj < 2; ++bj) *(u32x4*)(rowp + bj * HALF) = pack8(acc[ai][bj][m][0], acc[ai][bj][m][1]); }
    }
};
struct EpiQ {
    bf16_t* QLAT; bf16_t* QIDX;
    __device__ __forceinline__ void operator()(const Acc& acc, const Unit& u, int wr, int wc, int fr, int fq) const {
        const bool lat = u.pn < 8; bf16_t* base = lat ? QLAT : QIDX; const int ld = lat ? 2048 : 512;
        const int row0 = u.pm * BM + wr * 64 + fr, col0 = (lat ? u.pn : u.pn - 8) * BM + wc * 32 + 8 * fq;
#pragma unroll
        for (int ai = 0; ai < 2; ++ai)
#pragma unroll
            for (int m = 0; m < 4; ++m) { bf16_t* rowp = base + (size_t)(row0 + ai * HALF + m * 16) * ld + col0;
#pragma unroll
                for (int bj = 0; bj < 2; ++bj) *(u32x4*)(rowp + bj * HALF) = pack8(acc[ai][bj][m][0], acc[ai][bj][m][1]); }
    }
};
struct EpiMoeDn {
    bf16_t* O; const float* GW;
    __device__ __forceinline__ void operator()(const Acc& acc, const Unit& u, int wr, int wc, int fr, int fq) const {
        const int rl0 = wr * 64 + fr, col0 = u.pn * BM + wc * 32 + 8 * fq; const float* gwp = GW + (size_t)u.e * M + 256 * u.lt;
#pragma unroll
        for (int ai = 0; ai < 2; ++ai)
#pragma unroll
            for (int m = 0; m < 4; ++m) { const int rl = rl0 + ai * HALF + m * 16; const float gv = (256 * u.lt + rl < u.cnt) ? gwp[rl] : 0.f; bf16_t* rowp = O + (size_t)(u.pm * BM + rl) * D + col0;
#pragma unroll
                for (int bj = 0; bj < 2; ++bj) *(u32x4*)(rowp + bj * HALF) = pack8(acc[ai][bj][m][0] * gv, acc[ai][bj][m][1] * gv); }
    }
};

struct Params { const float* in[22]; float* out; unsigned char* ws; int ph_lo, ph_hi; };
enum { IN_X = 0, IN_LNG, IN_LNB, IN_HGWIN, IN_HGLB, IN_HGNG, IN_HGWOUT, IN_DWIN, IN_DQNG, IN_DKVNG, IN_DWUQ, IN_DWUK, IN_DWUV, IN_DWQIDX, IN_DKIG, IN_DKIB, IN_DWOUT, IN_FGU, IN_FDN, IN_MR, IN_MGU, IN_MDN };

__device__ __forceinline__ const float* inptr(int i) {
    int off = i * 8; asm volatile("" : "+s"(off));
    typedef const float* cfp;
    return *(const __attribute__((address_space(4))) cfp*)((const __attribute__((address_space(4))) char*)__builtin_amdgcn_kernarg_segment_ptr() + off);
}
#define INP(i) inptr(i)
struct Frame {
    LAS unsigned char* lds;
    unsigned* ctl;
    int tid, lane, wave, G, c;
};

__device__ __forceinline__ void p0_transpose_item(const float* W, int K, int Nsrc, int nblk, bf16_t* WT, int mode, LAS float* scr, int item, int lane) {
    const int kb = item / nblk, nb = item % nblk, k0 = 64 * kb, n0 = 32 * nb;
    const int c4 = (lane & 7) * 4, kr = lane >> 3;
#pragma unroll
    for (int i = 0; i < 8; ++i) { const int kk = 8 * i + kr;
        f32x4 v = (f32x4){0.f, 0.f, 0.f, 0.f};
        if (n0 + c4 < Nsrc) v = *(const f32x4*)(W + (size_t)(k0 + kk) * Nsrc + n0 + c4);
        scr[kk * 33 + c4 + 0] = v[0]; scr[kk * 33 + c4 + 1] = v[1]; scr[kk * 33 + c4 + 2] = v[2]; scr[kk * 33 + c4 + 3] = v[3]; }
    LDS_WAIT(); asm volatile("" ::: "memory");
    int drow0 = n0;
    if (mode == 1) { const int half = n0 / DFF, r = n0 % DFF; drow0 = 256 * (r / 128) + 128 * half + (r % 128); }
    const int c = lane & 7;
#pragma unroll
    for (int j = 0; j < 4; ++j) { const int n = (lane >> 3) + 8 * j; const LAS float* s = scr + (8 * c) * 33 + n;
        u32x4 o; o.x = cvt_pk_bf16(s[0 * 33], s[1 * 33]); o.y = cvt_pk_bf16(s[2 * 33], s[3 * 33]); o.z = cvt_pk_bf16(s[4 * 33], s[5 * 33]); o.w = cvt_pk_bf16(s[6 * 33], s[7 * 33]);
        *(u32x4*)(WT + (size_t)(drow0 + n) * K + k0 + 8 * c) = o; }
    LDS_WAIT(); asm volatile("" ::: "memory");
}
__device__ __forceinline__ void p0_combo_item(Frame& F, const float* A, int lda, const float* B, int ldb, bf16_t* out, int ldo, float scale) {
    LAS float* As = (LAS float*)F.lds; LAS float* Bs = As + 64 * 128;
    const int t = F.tid;
#pragma unroll
    for (int q = 0; q < 4; ++q) { const int r = (t >> 5) + 16 * q, c4 = (t & 31) * 4; *(LAS f32x4*)(As + r * 128 + c4) = *(const f32x4*)(A + (size_t)r * lda + c4); }
#pragma unroll
    for (int q = 0; q < 4; ++q) { const int r = (t >> 4) + 32 * q, c4 = (t & 15) * 4; *(LAS f32x4*)(Bs + r * 64 + c4) = *(const f32x4*)(B + (size_t)r * ldb + c4); }
    __syncthreads();
    const int tj = t & 63, ti = t >> 6;
    float acc[8];
#pragma unroll
    for (int ii = 0; ii < 8; ++ii) acc[ii] = 0.f;
    for (int d = 0; d < 128; d += 4) {
        const float b0 = Bs[(d + 0) * 64 + tj], b1 = Bs[(d + 1) * 64 + tj], b2 = Bs[(d + 2) * 64 + tj], b3 = Bs[(d + 3) * 64 + tj];
#pragma unroll
        for (int ii = 0; ii < 8; ++ii) { const f32x4 a = *(const LAS f32x4*)(As + (8 * ti + ii) * 128 + d); acc[ii] += a[0] * b0 + a[1] * b1 + a[2] * b2 + a[3] * b3; }
    }
    u32x4 o; o.x = cvt_pk_bf16(acc[0] * scale, acc[1] * scale); o.y = cvt_pk_bf16(acc[2] * scale, acc[3] * scale); o.z = cvt_pk_bf16(acc[4] * scale, acc[5] * scale); o.w = cvt_pk_bf16(acc[6] * scale, acc[7] * scale);
    *(u32x4*)(out + (size_t)tj * ldo + 8 * ti) = o;
    __syncthreads();
}
__device__ __forceinline__ void p0_prologue(Frame& F, const Params& p) {
    unsigned char* ws = p.ws;
    LAS float* scr = (LAS float*)(F.lds + F.wave * 8448);
    const int gw = F.c * NWAVES + F.wave, NGW = F.G * NWAVES;
    constexpr int I0 = 16 * 128, I1 = 16 * 32, I2 = 16 * 224, I3 = 56 * 32, I4 = 16 * 24, I5 = 4 * 16;
    constexpr int NITEMS = 2 * (I0 + I1 + I2 + I3 + I4 + I5) + 16 * (I2 + I3);
    for (int it = gw; it < NITEMS; it += NGW) {
        int r = it;
        if (r < 16 * I2) { const int job = r / I2; p0_transpose_item(INP(IN_MGU) + (size_t)job * D * 2 * DFF, D, 2 * DFF, 224, (bf16_t*)(ws + WS_W_MGU) + (size_t)job * 2 * DFF * D, 1, scr, r % I2, F.lane); continue; } r -= 16 * I2;
        if (r < 16 * I3) { const int job = r / I3; p0_transpose_item(INP(IN_MDN) + (size_t)job * DFF * D, DFF, D, 32, (bf16_t*)(ws + WS_W_MDN) + (size_t)job * D * DFF, 0, scr, r % I3, F.lane); continue; } r -= 16 * I3;
        if (r < 2 * I0) { const int job = r / I0; p0_transpose_item(INP(IN_HGWIN) + (size_t)job * D * 4 * D, D, 4 * D, 128, (bf16_t*)(ws + WS_W_HGIN) + (size_t)job * 4 * D * D, 0, scr, r % I0, F.lane); continue; } r -= 2 * I0;
        if (r < 2 * I1) { const int job = r / I1; p0_transpose_item(INP(IN_HGWOUT) + (size_t)job * D * D, D, D, 32, (bf16_t*)(ws + WS_W_HGOUT) + (size_t)job * D * D, 0, scr, r % I1, F.lane); continue; } r -= 2 * I1;
        if (r < 2 * I2) { const int job = r / I2; p0_transpose_item(INP(IN_FGU) + (size_t)job * D * 2 * DFF, D, 2 * DFF, 224, (bf16_t*)(ws + WS_W_FGU) + (size_t)job * 2 * DFF * D, 1, scr, r % I2, F.lane); continue; } r -= 2 * I2;
        if (r < 2 * I3) { const int job = r / I3; p0_transpose_item(INP(IN_FDN) + (size_t)job * DFF * D, DFF, D, 32, (bf16_t*)(ws + WS_W_FDN) + (size_t)job * D * DFF, 0, scr, r % I3, F.lane); continue; } r -= 2 * I3;
        if (r < 2 * I4) { const int job = r / I4; p0_transpose_item(INP(IN_DWIN) + (size_t)job * D * DSA_IN, D, DSA_IN, 24, (bf16_t*)(ws + WS_W_DIN) + (size_t)job * DSA_IN_PAD * D, 0, scr, r % I4, F.lane); continue; } r -= 2 * I4;
        { const int job = r / I5; p0_transpose_item(INP(IN_DWQIDX) + (size_t)job * QR * 512, QR, 512, 16, (bf16_t*)(ws + WS_W_DQ) + (size_t)job * 2560 * QR + (size_t)2048 * QR, 0, scr, r % I5, F.lane); }
    }
    { const f32x4* x4 = (const f32x4*)INP(IN_X); u32x2* xb = (u32x2*)(ws + WS_XB); const size_t n4 = (size_t)M * D / 4;
      for (size_t i = (size_t)F.c * NTHREADS + F.tid; i < n4; i += (size_t)F.G * NTHREADS) { const f32x4 v = x4[i]; u32x2 o; o.x = cvt_pk_bf16(v[0], v[1]); o.y = cvt_pk_bf16(v[2], v[3]); xb[i] = o; } }
    __syncthreads();
    const float qscale = 0.08838834764831845f * 1.4426950408889634f;
    for (int it = F.c; it < 256 + 1024; it += F.G) {
        if (it < 256) { const int j = it >> 7, h = (it >> 4) & 7, ib = (it >> 2) & 3, jb = it & 3;
            p0_combo_item(F, INP(IN_DWUQ) + (size_t)j * QR * D + (size_t)(64 * ib) * D + h * 128, D, INP(IN_DWUK) + ((size_t)j * 8 + h) * 128 * KVR + 64 * jb, KVR,
                          (bf16_t*)(ws + WS_W_DQ) + (size_t)j * 2560 * QR + (size_t)(h * 256 + 64 * jb) * QR + 64 * ib, QR, qscale);
        } else { const int r = it - 256, j = r >> 9, h = (r >> 6) & 7, ib = (r >> 4) & 3, jb = r & 15;
            p0_combo_item(F, INP(IN_DWUV) + (((size_t)j * 8 + h) * KVR + 64 * ib) * 128, 128, INP(IN_DWOUT) + (size_t)j * D * D + (size_t)(h * 128) * D + 64 * jb, D,
                          (bf16_t*)(ws + WS_W_DO) + (size_t)j * D * 2048 + (size_t)(64 * jb) * 2048 + h * 256 + 64 * ib, 2048, 1.0f);
        }
    }
}

__device__ __forceinline__ void unpack8(const u32x4 w, float* v) {
#pragma unroll
    for (int q = 0; q < 4; ++q) { v[2 * q] = __uint_as_float(w[q] << 16); v[2 * q + 1] = __uint_as_float(w[q] & 0xffff0000u); }
}
__device__ __forceinline__ void load_row_bf16(const bf16_t* row, int lane, float (&v)[16]) {
    const u32x4 a = *(const u32x4*)(row + 8 * lane), b = *(const u32x4*)(row + 512 + 8 * lane); unpack8(a, v); unpack8(b, v + 8);
}
__device__ __forceinline__ void load_vec_f32(const float* p, int lane, float (&v)[16]) {
#pragma unroll
    for (int h = 0; h < 2; ++h)
#pragma unroll
        for (int q = 0; q < 2; ++q) { const f32x4 x = *(const f32x4*)(p + 512 * h + 8 * lane + 4 * q); v[8 * h + 4 * q] = x[0]; v[8 * h + 4 * q + 1] = x[1]; v[8 * h + 4 * q + 2] = x[2]; v[8 * h + 4 * q + 3] = x[3]; }
}
__device__ __forceinline__ void store_row_bf16(const float (&v)[16], bf16_t* row, int lane) {
    u32x4 a, b;
#pragma unroll
    for (int q = 0; q < 4; ++q) { a[q] = cvt_pk_bf16(v[2 * q], v[2 * q + 1]); b[q] = cvt_pk_bf16(v[8 + 2 * q], v[8 + 2 * q + 1]); }
    *(u32x4*)(row + 8 * lane) = a; *(u32x4*)(row + 512 + 8 * lane) = b;
}
__device__ __forceinline__ void store_row_f32(const float (&v)[16], float* row, int lane) {
#pragma unroll
    for (int h = 0; h < 2; ++h)
#pragma unroll
        for (int q = 0; q < 2; ++q) *(f32x4*)(row + 512 * h + 8 * lane + 4 * q) = (f32x4){v[8 * h + 4 * q], v[8 * h + 4 * q + 1], v[8 * h + 4 * q + 2], v[8 * h + 4 * q + 3]};
}
__device__ __forceinline__ void ln_row(float (&v)[16], const float (&g)[16], const float (&b)[16]) {
    float s = 0.f;
#pragma unroll
    for (int i = 0; i < 16; ++i) s += v[i];
    const float mean = wave_sum(s) * (1.f / D); float s2 = 0.f;
#pragma unroll
    for (int i = 0; i < 16; ++i) { v[i] -= mean; s2 += v[i] * v[i]; }
    const float rstd = 1.f / sqrtf(wave_sum(s2) * (1.f / D) + LN_EPS);
#pragma unroll
    for (int i = 0; i < 16; ++i) v[i] = v[i] * rstd * g[i] + b[i];
}
__device__ __forceinline__ void ln_phase(Frame& F, const bf16_t* Y, const float* g, const float* b, bf16_t* XB) {
    float gv[16], bv[16]; load_vec_f32(g, F.lane, gv); load_vec_f32(b, F.lane, bv);
    const int gw = F.c * NWAVES + F.wave, NGW = F.G * NWAVES;
    for (int m = gw; m < M; m += NGW) {
        float v[16]; load_row_bf16(Y + (size_t)m * D, F.lane, v);
        ln_row(v, gv, bv);
        store_row_bf16(v, XB + (size_t)m * D, F.lane);
    }
}
__device__ __forceinline__ void ln_moe_phase(Frame& F, const bf16_t* Xin, const bf16_t* OUTM, const int* EIDX, const int* POS, const unsigned* gcnt, const float* g, const float* b, bf16_t* XB, float* OUT) {
    float gv[16], bv[16]; load_vec_f32(g, F.lane, gv); load_vec_f32(b, F.lane, bv);
    int roff[8]; { int t = 0;
#pragma unroll
        for (int e = 0; e < 8; ++e) { roff[e] = t * 256; t += (__builtin_amdgcn_readfirstlane((int)__hip_atomic_load(gcnt + e, __ATOMIC_RELAXED, __HIP_MEMORY_SCOPE_AGENT)) + 255) >> 8; } }
    const int gw = F.c * NWAVES + F.wave, NGW = F.G * NWAVES;
    for (int m = gw; m < M; m += NGW) {
        const int e0 = EIDX[2 * m], e1 = EIDX[2 * m + 1]; int s0 = POS[2 * m], s1 = POS[2 * m + 1];
#pragma unroll
        for (int k = 0; k < 8; ++k) { s0 += (e0 == k) ? roff[k] : 0; s1 += (e1 == k) ? roff[k] : 0; }
        float v[16], o0[16], o1[16]; load_row_bf16(Xin + (size_t)m * D, F.lane, v); load_row_bf16(OUTM + (size_t)s0 * D, F.lane, o0); load_row_bf16(OUTM + (size_t)s1 * D, F.lane, o1);
#pragma unroll
        for (int i = 0; i < 16; ++i) v[i] = v[i] * ALPHA + o0[i] + o1[i];
        ln_row(v, gv, bv);
        if (OUT) store_row_f32(v, OUT + (size_t)m * D, F.lane); else store_row_bf16(v, XB + (size_t)m * D, F.lane);
    }
}
__device__ __forceinline__ void ln_router_phase(Frame& F, const bf16_t* Y, const float* g, const float* b, const float* wrouter, bf16_t* XB,
                                                int* EIDX, int* POS, int* TOK, float* GW, unsigned* gcnt) {
    LAS float* WR = (LAS float*)F.lds;
    LAS int* SEL = (LAS int*)(F.lds + 32768);
    LAS int* CW = (LAS int*)(F.lds + 32768 + 1024);
    LAS int* BASE = (LAS int*)(F.lds + 32768 + 1024 + 128);
    LAS float* SELW = (LAS float*)(F.lds + 32768 + 2048);
    for (int q = 0; q < 16; ++q) { const int idx = F.tid + NTHREADS * q; WR[(idx & 7) * 1024 + (idx >> 3)] = wrouter[idx]; }
    float gv[16], bv[16]; load_vec_f32(g, F.lane, gv); load_vec_f32(b, F.lane, bv);
    __syncthreads();
    for (int blk = F.c; blk < M / 128; blk += F.G) {
        for (int rl = F.wave; rl < 128; rl += NWAVES) {
            const int m = blk * 128 + rl;
            float v[16]; load_row_bf16(Y + (size_t)m * D, F.lane, v);
            ln_row(v, gv, bv);
            store_row_bf16(v, XB + (size_t)m * D, F.lane);
            float lg[8];
#pragma unroll
            for (int e = 0; e < 8; ++e) { float s = 0.f;
#pragma unroll
                for (int h = 0; h < 2; ++h)
#pragma unroll
                    for (int q = 0; q < 2; ++q) { const f32x4 w = *(const LAS f32x4*)(WR + e * 1024 + 512 * h + 8 * F.lane + 4 * q); const int o = 8 * h + 4 * q;
                        s += (v[o] * w[0] + v[o + 1] * w[1]) + (v[o + 2] * w[2] + v[o + 3] * w[3]); }
                lg[e] = wave_sum(s); }
            int e0 = 0; float v0 = lg[0];
#pragma unroll
            for (int e = 1; e < 8; ++e) if (lg[e] > v0) { v0 = lg[e]; e0 = e; }
            int e1 = -1; float v1 = -3.0e38f;
#pragma unroll
            for (int e = 0; e < 8; ++e) if (e != e0 && lg[e] > v1) { v1 = lg[e]; e1 = e; }
            const float w1 = 1.f / (1.f + __expf(v0 - v1)), w0 = 1.f - w1;
            if (F.lane == 0) { SEL[2 * rl] = e0; SEL[2 * rl + 1] = e1; SELW[2 * rl] = w0; SELW[2 * rl + 1] = w1; EIDX[2 * m] = e0; EIDX[2 * m + 1] = e1; }
        }
        __syncthreads();
        const int mine = F.tid < 256 ? SEL[F.tid] : -1;
        int myrank = 0;
        if (F.wave < 4) {
#pragma unroll
            for (int e = 0; e < 8; ++e) { const unsigned long long mk = __ballot(mine == e); const int rk = __builtin_popcountll(mk & ((1ull << F.lane) - 1ull)); if (mine == e) myrank = rk;
                if (F.lane == 0) CW[F.wave * 8 + e] = __builtin_popcountll(mk); }
        }
        __syncthreads();
        if (F.tid < 8) { const int tot = CW[F.tid] + CW[8 + F.tid] + CW[16 + F.tid] + CW[24 + F.tid]; BASE[F.tid] = (int)__hip_atomic_fetch_add(gcnt + F.tid, (unsigned)tot, __ATOMIC_RELAXED, __HIP_MEMORY_SCOPE_AGENT); }
        __syncthreads();
        if (F.tid < 256) { int pos = BASE[mine] + myrank; for (int w = 0; w < F.wave; ++w) pos += CW[w * 8 + mine]; POS[blk * 256 + F.tid] = pos;
            TOK[(size_t)mine * M + pos] = blk * 128 + (F.tid >> 1); GW[(size_t)mine * M + pos] = SELW[F.tid]; }
        __syncthreads();
    }
}
__device__ __forceinline__ void hgrn_phase(Frame& F, const bf16_t* Q, const bf16_t* FP, const bf16_t* V, const float* lbparam, int jl, bf16_t* O) {
    constexpr int QST = 0, QS2 = 18432, KST = 36864, VS = 55296, SST0 = 64512, SSTB = 17408, SEG = 99328, RV = 103424, DV = 103936;
    constexpr int LQ = 136, LT = 72;
    LAS unsigned char* L = F.lds;
    const int tid = F.tid, lane = F.lane, w = F.wave, fr = lane & 15, fq = lane >> 4, qq = fr >> 2, pp = lane & 3;
    const int dp = tid & 63, seg = tid >> 6, d0 = 2 * dp;
    const int vrow = tid >> 3, vch = tid & 7;
    const int tt = w >> 1, eh = w & 1;
    for (int u = F.c; u < BATCH * HG_H * 2; u += F.G) {
        const int b = u >> 4, h = (u >> 1) & 7, vh = u & 1;
        float lb0 = 0.f, lb1 = 0.f;
        if (jl == 1) { const f32x2 l0 = *(const f32x2*)(lbparam + h * 128 + d0), l1 = *(const f32x2*)(lbparam + D + h * 128 + d0); lb0 = 1.f / (1.f + __expf(l0[0] - l1[0])); lb1 = 1.f / (1.f + __expf(l0[1] - l1[1])); }
        const float om0 = 1.f - lb0, om1 = 1.f - lb1;
        f32x4 St[4];
#pragma unroll
        for (int et = 0; et < 4; ++et) { St[et] = (f32x4){0.f, 0.f, 0.f, 0.f}; *(LAS u32x2*)(L + SST0 + ((16 * et + fr) * LQ + 16 * w + 4 * fq) * 2) = (u32x2){0u, 0u}; }
        const size_t ubase = (size_t)b * SEQ * D + h * 128;
        unsigned fpn[8], qn[8]; u32x4 vn;
        { const bf16_t* fp = FP + ubase + (size_t)(8 * seg) * D + d0; const bf16_t* qp = Q + ubase + (size_t)(8 * seg) * D + d0;
#pragma unroll
          for (int i = 0; i < 8; ++i) { fpn[i] = *(const unsigned*)(fp + (size_t)i * D); qn[i] = *(const unsigned*)(qp + (size_t)i * D); }
          vn = *(const u32x4*)(V + ubase + (size_t)vrow * D + vh * 64 + 8 * vch); }
        for (int ch = 0; ch < SEQ / HG_C; ++ch) {
            const size_t rowoff = ubase + (size_t)ch * HG_C * D;
            LAS unsigned char* SSTc = L + SST0 + (ch & 1) * SSTB; LAS unsigned char* SSTn = L + SST0 + ((ch + 1) & 1) * SSTB;
            float c0[8], c1[8], k0[8], k1[8], q0[8], q1[8];
            { float a0 = 0.f, a1 = 0.f;
#pragma unroll
              for (int i = 0; i < 8; ++i) { const float s0 = sigmoidf_(__uint_as_float(fpn[i] << 16)), s1 = sigmoidf_(__uint_as_float(fpn[i] & 0xffff0000u));
                  a0 += __logf(lb0 + om0 * s0); a1 += __logf(lb1 + om1 * s1); c0[i] = a0; c1[i] = a1; k0[i] = om0 * (1.f - s0); k1[i] = om1 * (1.f - s1);
                  q0[i] = __uint_as_float(qn[i] << 16); q1[i] = __uint_as_float(qn[i] & 0xffff0000u); }
              *(LAS f32x2*)(L + SEG + (seg * 128 + d0) * 4) = (f32x2){a0, a1};
              *(LAS u32x4*)(L + VS + (vrow * LT + 8 * vch) * 2) = vn; }
            __syncthreads();
            { float pre0 = 0.f, pre1 = 0.f, r0 = 0.f, r1 = 0.f, bl0 = 0.f, bl1 = 0.f;
#pragma unroll
              for (int s = 0; s < 8; ++s) { const f32x2 v = *(LAS f32x2*)(L + SEG + (s * 128 + d0) * 4);
                  if (s < seg) { pre0 += v[0]; pre1 += v[1]; } if (s < 4) { r0 += v[0]; r1 += v[1]; } bl0 += v[0]; bl1 += v[1]; }
              const float er0 = __expf(r0), er1 = __expf(r1);
              unsigned qa[4], qb[4], ka[4], xa[4], xb[4], kb[4];
#pragma unroll
              for (int i = 0; i < 8; i += 2) {
                  const float ba = pre0 + c0[i], bb = pre0 + c0[i + 1], bc = pre1 + c1[i], bd = pre1 + c1[i + 1];
                  const float qa0 = q0[i] * __expf(ba - r0), qa1 = q0[i + 1] * __expf(bb - r0), qb0 = q1[i] * __expf(bc - r1), qb1 = q1[i + 1] * __expf(bd - r1);
                  qa[i >> 1] = cvt_pk_bf16(qa0, qa1); qb[i >> 1] = cvt_pk_bf16(qb0, qb1);
                  xa[i >> 1] = cvt_pk_bf16(qa0 * er0, qa1 * er0); xb[i >> 1] = cvt_pk_bf16(qb0 * er1, qb1 * er1);
                  ka[i >> 1] = cvt_pk_bf16(k0[i] * __expf(r0 - ba), k0[i + 1] * __expf(r0 - bb)); kb[i >> 1] = cvt_pk_bf16(k1[i] * __expf(r1 - bc), k1[i + 1] * __expf(r1 - bd));
              }
              const int o0 = (d0 * LT + 8 * seg) * 2, o1 = o0 + LT * 2;
              *(LAS u32x4*)(L + QST + o0) = (u32x4){qa[0], qa[1], qa[2], qa[3]}; *(LAS u32x4*)(L + QST + o1) = (u32x4){qb[0], qb[1], qb[2], qb[3]};
              *(LAS u32x4*)(L + QS2 + o0) = (u32x4){xa[0], xa[1], xa[2], xa[3]}; *(LAS u32x4*)(L + QS2 + o1) = (u32x4){xb[0], xb[1], xb[2], xb[3]};
              *(LAS u32x4*)(L + KST + o0) = (u32x4){ka[0], ka[1], ka[2], ka[3]}; *(LAS u32x4*)(L + KST + o1) = (u32x4){kb[0], kb[1], kb[2], kb[3]};
              if (seg == 0) { *(LAS f32x2*)(L + RV + d0 * 4) = (f32x2){er0, er1}; *(LAS f32x2*)(L + DV + d0 * 4) = (f32x2){__expf(bl0 - r0), __expf(bl1 - r1)}; } }
            __syncthreads();
            if (ch + 1 < SEQ / HG_C) {
                const bf16_t* fp = FP + rowoff + (size_t)(HG_C + 8 * seg) * D + d0; const bf16_t* qp = Q + rowoff + (size_t)(HG_C + 8 * seg) * D + d0;
#pragma unroll
                for (int i = 0; i < 8; ++i) { fpn[i] = *(const unsigned*)(fp + (size_t)i * D); qn[i] = *(const unsigned*)(qp + (size_t)i * D); }
                vn = *(const u32x4*)(V + rowoff + (size_t)(HG_C + vrow) * D + vh * 64 + 8 * vch);
            }
            bf16x8 Pf[2];
            { f32x4 sc[4];
#pragma unroll
              for (int st = 0; st < 4; ++st) { sc[st] = (f32x4){0.f, 0.f, 0.f, 0.f};
                  if (st <= tt) {
#pragma unroll
                      for (int ks = 0; ks < 4; ++ks) {
                          const int ro = ((32 * ks + 8 * fq + qq) * LT + 4 * pp) * 2;
                          const s16x4 a0 = __builtin_amdgcn_ds_read_tr16_b64_v4i16((LAS s16x4*)(L + KST + ro + 32 * st)), a1 = __builtin_amdgcn_ds_read_tr16_b64_v4i16((LAS s16x4*)(L + KST + ro + 4 * LT * 2 + 32 * st));
                          const s16x4 b0 = __builtin_amdgcn_ds_read_tr16_b64_v4i16((LAS s16x4*)(L + QST + ro + 32 * tt)), b1 = __builtin_amdgcn_ds_read_tr16_b64_v4i16((LAS s16x4*)(L + QST + ro + 4 * LT * 2 + 32 * tt));
                          const bf16x8 av = (bf16x8){a0[0], a0[1], a0[2], a0[3], a1[0], a1[1], a1[2], a1[3]}, bv = (bf16x8){b0[0], b0[1], b0[2], b0[3], b1[0], b1[1], b1[2], b1[3]};
                          sc[st] = __builtin_amdgcn_mfma_f32_16x16x32_bf16(av, bv, sc[st], 0, 0, 0); }
#pragma unroll
                      for (int r = 0; r < 4; ++r) sc[st][r] = (16 * st + 4 * fq + r <= 16 * tt + fr) ? sc[st][r] : 0.f;
                  } }
              const u32x4 p0 = pack8(sc[0], sc[1]), p1 = pack8(sc[2], sc[3]); Pf[0] = __builtin_bit_cast(bf16x8, p0); Pf[1] = __builtin_bit_cast(bf16x8, p1); }
            { bf16x8 q2[4];
#pragma unroll
              for (int ks = 0; ks < 4; ++ks) { const int ro = ((32 * ks + 8 * fq + qq) * LT + 4 * pp) * 2 + 32 * tt;
                  const s16x4 b0 = __builtin_amdgcn_ds_read_tr16_b64_v4i16((LAS s16x4*)(L + QS2 + ro)), b1 = __builtin_amdgcn_ds_read_tr16_b64_v4i16((LAS s16x4*)(L + QS2 + ro + 4 * LT * 2));
                  q2[ks] = (bf16x8){b0[0], b0[1], b0[2], b0[3], b1[0], b1[1], b1[2], b1[3]}; }
#pragma unroll
              for (int ex = 0; ex < 2; ++ex) { const int et = 2 * eh + ex;
                  f32x4 acc = (f32x4){0.f, 0.f, 0.f, 0.f};
#pragma unroll
                  for (int k2 = 0; k2 < 2; ++k2) {
                      if (k2 == 0 || tt >= 2) {
                          const int ro = ((32 * k2 + 4 * fq + qq) * LT + 16 * et + 4 * pp) * 2;
                          const s16x4 a0 = __builtin_amdgcn_ds_read_tr16_b64_v4i16((LAS s16x4*)(L + VS + ro)), a1 = __builtin_amdgcn_ds_read_tr16_b64_v4i16((LAS s16x4*)(L + VS + ro + 16 * LT * 2));
                          const bf16x8 av = (bf16x8){a0[0], a0[1], a0[2], a0[3], a1[0], a1[1], a1[2], a1[3]};
                          acc = __builtin_amdgcn_mfma_f32_16x16x32_bf16(av, Pf[k2], acc, 0, 0, 0); } }
#pragma unroll
                  for (int ks = 0; ks < 4; ++ks) { const bf16x8 av = *(LAS bf16x8*)(SSTc + ((16 * et + fr) * LQ + 32 * ks + 8 * fq) * 2);
                      acc = __builtin_amdgcn_mfma_f32_16x16x32_bf16(av, q2[ks], acc, 0, 0, 0); }
                  u32x2 ov; ov.x = cvt_pk_bf16(acc[0], acc[1]); ov.y = cvt_pk_bf16(acc[2], acc[3]);
                  *(u32x2*)(O + rowoff + (size_t)(16 * tt + fr) * D + vh * 64 + 16 * et + 4 * fq) = ov;
              } }
            { const f32x4 rv = *(LAS f32x4*)(L + RV + (16 * w + 4 * fq) * 4), dv = *(LAS f32x4*)(L + DV + (16 * w + 4 * fq) * 4);
              bf16x8 kf[2];
#pragma unroll
              for (int ks = 0; ks < 2; ++ks) kf[ks] = *(LAS bf16x8*)(L + KST + ((16 * w + fr) * LT + 32 * ks + 8 * fq) * 2);
#pragma unroll
              for (int et = 0; et < 4; ++et) { St[et] = St[et] * rv;
#pragma unroll
                  for (int ks = 0; ks < 2; ++ks) { const int ro = ((32 * ks + 8 * fq + qq) * LT + 16 * et + 4 * pp) * 2;
                      const s16x4 b0 = __builtin_amdgcn_ds_read_tr16_b64_v4i16((LAS s16x4*)(L + VS + ro)), b1 = __builtin_amdgcn_ds_read_tr16_b64_v4i16((LAS s16x4*)(L + VS + ro + 4 * LT * 2));
                      const bf16x8 bb = (bf16x8){b0[0], b0[1], b0[2], b0[3], b1[0], b1[1], b1[2], b1[3]};
                      St[et] = __builtin_amdgcn_mfma_f32_16x16x32_bf16(kf[ks], bb, St[et], 0, 0, 0); }
                  St[et] = St[et] * dv;
                  u32x2 o; o.x = cvt_pk_bf16(St[et][0], St[et][1]); o.y = cvt_pk_bf16(St[et][2], St[et][3]);
                  *(LAS u32x2*)(SSTn + ((16 * et + fr) * LQ + 16 * w + 4 * fq) * 2) = o; } }
            __syncthreads();
        }
    }
}
__device__ __forceinline__ void hgrn_gate_phase(Frame& F, const bf16_t* O, const bf16_t* Gt, const float* ng, bf16_t* OG) {
    float gw_[16];
#pragma unroll
    for (int i = 0; i < 16; ++i) gw_[i] = ng[16 * F.lane + i];
    const int gw = F.c * NWAVES + F.wave, NGW = F.G * NWAVES;
    for (int m = gw; m < M; m += NGW) {
        const u32x4 o0 = *(const u32x4*)(O + (size_t)m * D + 16 * F.lane), o1 = *(const u32x4*)(O + (size_t)m * D + 16 * F.lane + 8);
        const u32x4 g0 = *(const u32x4*)(Gt + (size_t)m * D + 16 * F.lane), g1 = *(const u32x4*)(Gt + (size_t)m * D + 16 * F.lane + 8);
        float ov[16], gv[16];
#pragma unroll
        for (int i = 0; i < 4; ++i) { ov[2 * i] = __uint_as_float(o0[i] << 16); ov[2 * i + 1] = __uint_as_float(o0[i] & 0xffff0000u); ov[8 + 2 * i] = __uint_as_float(o1[i] << 16); ov[8 + 2 * i + 1] = __uint_as_float(o1[i] & 0xffff0000u);
            gv[2 * i] = __uint_as_float(g0[i] << 16); gv[2 * i + 1] = __uint_as_float(g0[i] & 0xffff0000u); gv[8 + 2 * i] = __uint_as_float(g1[i] << 16); gv[8 + 2 * i + 1] = __uint_as_float(g1[i] & 0xffff0000u); }
        float ss = 0.f;
#pragma unroll
        for (int i = 0; i < 16; ++i) ss += ov[i] * ov[i];
        ss += __builtin_bit_cast(float, __builtin_amdgcn_update_dpp(0, __builtin_bit_cast(int, ss), 0xB1, 0xF, 0xF, true));
        ss += __builtin_bit_cast(float, __builtin_amdgcn_update_dpp(0, __builtin_bit_cast(int, ss), 0x4E, 0xF, 0xF, true));
        ss += __builtin_bit_cast(float, __builtin_amdgcn_update_dpp(0, __builtin_bit_cast(int, ss), 0x141, 0xF, 0xF, true));
        const float rs = 1.f / sqrtf(ss * (1.f / 128.f) + RMS_EPS);
        float r[16];
#pragma unroll
        for (int i = 0; i < 16; ++i) r[i] = ov[i] * rs * gw_[i] * siluf_(gv[i]);
        u32x4 w0, w1; w0.x = cvt_pk_bf16(r[0], r[1]); w0.y = cvt_pk_bf16(r[2], r[3]); w0.z = cvt_pk_bf16(r[4], r[5]); w0.w = cvt_pk_bf16(r[6], r[7]);
        w1.x = cvt_pk_bf16(r[8], r[9]); w1.y = cvt_pk_bf16(r[10], r[11]); w1.z = cvt_pk_bf16(r[12], r[13]); w1.w = cvt_pk_bf16(r[14], r[15]);
        *(u32x4*)(OG + (size_t)m * D + 16 * F.lane) = w0; *(u32x4*)(OG + (size_t)m * D + 16 * F.lane + 8) = w1;
    }
}

__device__ __forceinline__ void dsa_norm_phase(Frame& F, const bf16_t* RAW, const float* qg, const float* kvg, const float* kig, const float* kib, bf16_t* CQ, bf16_t* CKV, bf16_t* KIDX, float* WIDX) {
    const f32x4 qgv = *(const f32x4*)(qg + 4 * F.lane), kvgv = *(const f32x4*)(kvg + 4 * F.lane); const float kg = kig[F.lane], kb = kib[F.lane];
    const int gw = F.c * NWAVES + F.wave, NGW = F.G * NWAVES;
    for (int m = gw; m < M; m += NGW) {
        const bf16_t* r = RAW + (size_t)m * DSA_IN_PAD;
        const u32x2 ar = *(const u32x2*)(r + 4 * F.lane), cr = *(const u32x2*)(r + 256 + 4 * F.lane); const float ki = bf2f(r[512 + F.lane]);
        const f32x4 a = (f32x4){__uint_as_float(ar.x << 16), __uint_as_float(ar.x & 0xffff0000u), __uint_as_float(ar.y << 16), __uint_as_float(ar.y & 0xffff0000u)};
        const f32x4 c = (f32x4){__uint_as_float(cr.x << 16), __uint_as_float(cr.x & 0xffff0000u), __uint_as_float(cr.y << 16), __uint_as_float(cr.y & 0xffff0000u)};
        const float sa = wave_sum((a[0] * a[0] + a[1] * a[1]) + (a[2] * a[2] + a[3] * a[3])), sc = wave_sum((c[0] * c[0] + c[1] * c[1]) + (c[2] * c[2] + c[3] * c[3]));
        const float ra = 1.f / sqrtf(sa * (1.f / 256.f) + RMS_EPS), rc = 1.f / sqrtf(sc * (1.f / 256.f) + RMS_EPS);
        u32x2 o; o.x = cvt_pk_bf16(a[0] * ra * qgv[0], a[1] * ra * qgv[1]); o.y = cvt_pk_bf16(a[2] * ra * qgv[2], a[3] * ra * qgv[3]); *(u32x2*)(CQ + (size_t)m * 256 + 4 * F.lane) = o;
        o.x = cvt_pk_bf16(c[0] * rc * kvgv[0], c[1] * rc * kvgv[1]); o.y = cvt_pk_bf16(c[2] * rc * kvgv[2], c[3] * rc * kvgv[3]); *(u32x2*)(CKV + (size_t)m * 256 + 4 * F.lane) = o;
        const float mu = wave_sum(ki) * (1.f / 64.f), dk = ki - mu, var = wave_sum(dk * dk) * (1.f / 64.f);
        KIDX[(size_t)m * 64 + F.lane] = f2bf(dk * (1.f / sqrtf(var + LN_EPS)) * kg + kb);
        if (F.lane < 8) WIDX[(size_t)m * 8 + F.lane] = bf2f(r[576 + F.lane]) * 0.04419417382415922f;
    }
}
__device__ __forceinline__ unsigned f2ord(float v) { const unsigned u = __float_as_uint(v); return (u & 0x80000000u) ? ~u : (u | 0x80000000u); }
__device__ __forceinline__ void dsa_index_phase(Frame& F, const bf16_t* QIDX, const bf16_t* KIDX, const float* WIDX, unsigned long long* MASK) {
    LAS float* SC = (LAS float*)F.lds;
    const int lane = F.lane, w = F.wave, fr = lane & 15, fq = lane >> 4;
    for (int i = 0;; ++i) {
        const int u = i * F.G + F.c; if (u >= BATCH * (SEQ / 16)) break;
        const int b = (u & 255) >> 4, qlo = (u & 15) + 16 * (u >> 9), qt = ((u >> 8) & 1) ? 127 - qlo : qlo, t0 = 16 * qt;     const size_t rb = (size_t)b * SEQ;
        bf16x8 Af[4][2][2]; float wv[4][8];
#pragma unroll
        for (int tg = 0; tg < 4; ++tg) {
#pragma unroll
            for (int hh = 0; hh < 2; ++hh)
#pragma unroll
                for (int ks = 0; ks < 2; ++ks) Af[tg][hh][ks] = *(const bf16x8*)(QIDX + (rb + t0 + 4 * tg + (fr >> 2)) * 512 + (4 * hh + (fr & 3)) * 64 + 32 * ks + 8 * fq);
            const f32x4 w0 = *(const f32x4*)(WIDX + (rb + t0 + 4 * tg + fq) * 8), w1 = *(const f32x4*)(WIDX + (rb + t0 + 4 * tg + fq) * 8 + 4);
#pragma unroll
            for (int r = 0; r < 4; ++r) { wv[tg][r] = w0[r]; wv[tg][4 + r] = w1[r]; }
        }
        bf16x8 nB0 = *(const bf16x8*)(KIDX + (rb + 16 * w + fr) * 64 + 8 * fq), nB1 = *(const bf16x8*)(KIDX + (rb + 16 * w + fr) * 64 + 32 + 8 * fq);
        for (int kg = w; kg <= qt; kg += NWAVES) {
            const bf16x8 B0 = nB0, B1 = nB1;
            { const int kn = (kg + NWAVES <= qt) ? kg + NWAVES : kg;
              nB0 = *(const bf16x8*)(KIDX + (rb + 16 * kn + fr) * 64 + 8 * fq); nB1 = *(const bf16x8*)(KIDX + (rb + 16 * kn + fr) * 64 + 32 + 8 * fq); }
#pragma unroll
            for (int tg = 0; tg < 4; ++tg) { float s = 0.f;
#pragma unroll
                for (int hh = 0; hh < 2; ++hh) { f32x4 acc = (f32x4){0.f, 0.f, 0.f, 0.f};
                    acc = __builtin_amdgcn_mfma_f32_16x16x32_bf16(Af[tg][hh][0], B0, acc, 0, 0, 0); acc = __builtin_amdgcn_mfma_f32_16x16x32_bf16(Af[tg][hh][1], B1, acc, 0, 0, 0);
#pragma unroll
                    for (int r = 0; r < 4; ++r) s += wv[tg][4 * hh + r] * fmaxf(acc[r], 0.f); }
                SC[(4 * tg + fq) * 2048 + 16 * kg + fr] = s + 0.0f; }
        }
        __syncthreads();
        for (int tq = 2 * w; tq < 2 * w + 2; ++tq) {
            const int t = t0 + tq;
            unsigned key[32];
#pragma unroll
            for (int r = 0; r < 32; ++r) { const int s = 64 * r + lane; key[r] = (s <= t) ? f2ord(SC[tq * 2048 + s]) : 0u; }
            unsigned long long selw = 0ull;
            if (t < TOPK) {
#pragma unroll
                for (int r = 0; r < 32; ++r) { const unsigned long long mk = __ballot(64 * r + lane <= t); if (lane == r) selw = mk; }
            } else {
                unsigned prefix = 0u; bool exact = false;
                for (int bit = 31; bit >= 0; --bit) {
                    const unsigned cand = prefix | (1u << bit); int cnt = 0;
#pragma unroll
                    for (int r = 0; r < 32; ++r) cnt += __builtin_popcountll(__ballot(key[r] >= cand));
                    if (cnt >= TOPK) { prefix = cand; if (cnt == TOPK) { exact = true; break; } }
                }
                if (exact) {
#pragma unroll
                    for (int r = 0; r < 32; ++r) { const unsigned long long mk = __ballot(key[r] >= prefix); if (lane == r) selw = mk; }
                } else {
                    int ngt = 0;
#pragma unroll
                    for (int r = 0; r < 32; ++r) ngt += __builtin_popcountll(__ballot(key[r] > prefix));
                    const int need = TOPK - ngt; int run = 0;
#pragma unroll
                    for (int r = 0; r < 32; ++r) { const unsigned long long tie = __ballot(key[r] == prefix); const int rk = run + __builtin_popcountll(tie & ((1ull << lane) - 1ull));
                        const unsigned long long mk = __ballot(key[r] > prefix || (key[r] == prefix && rk < need)); if (lane == r) selw = mk; run += __builtin_popcountll(tie); }
                }
            }
            if (lane < 32) MASK[(rb + t) * 32 + lane] = selw;
        }
        __syncthreads();
    }
}
__device__ __forceinline__ void dsa_attn_phase(Frame& F, const bf16_t* QLAT, const bf16_t* CKV, const unsigned long long* MASK, bf16_t* OLAT) {
    constexpr int TB = 32768;
    LAS unsigned char* L = F.lds;
    const int lane = F.lane, w = F.wave, fr = lane & 15, fq = lane >> 4;
    const int qq = fr >> 2, pp = lane & 3;
    const bool grpB = w >= 4;
    const int kbase = fr * 512, ysh = (fq ^ (2 * (fr & 7))) << 4;
    const int x2s = (2 * (4 * (fq & 1) + qq)) << 4;
    const int vbase = (4 * fq + qq) * 512 + (pp >> 1) * 16 + (pp & 1) * 8;
    const int drow = lane >> 5, dpc = lane & 31;
    for (int i = 0;; ++i) {
        const int u = i * F.G + F.c; if (u >= BATCH * (SEQ / 16)) break;
        const int b = (u & 255) >> 4, qlo = (u & 15) + 16 * (u >> 9), qt = ((u >> 8) & 1) ? 127 - qlo : qlo, t0 = 16 * qt;     const size_t rb = (size_t)b * SEQ;
        const int ntiles = (t0 + 15) / 64 + 1;
        bf16x8 Qf[8];
#pragma unroll
        for (int ks = 0; ks < 8; ++ks) Qf[ks] = *(const bf16x8*)(QLAT + (rb + t0 + fr) * 2048 + w * 256 + 32 * ks + 8 * fq);
        f32x4 Ot[16];
#pragma unroll
        for (int cb = 0; cb < 16; ++cb) Ot[cb] = (f32x4){0.f, 0.f, 0.f, 0.f};
        float mrun = -1.0e30f, lsum = 0.f;
        bf16x8 Pf[2];
#define ATT_DMA(kt_, buf_) do { _Pragma("unroll") for (int q_ = 0; q_ < 4; ++q_) { const int row_ = 2 * (4 * w + q_) + drow; \
            __builtin_amdgcn_global_load_lds((const unsigned*)(CKV + (rb + 64 * (kt_) + row_) * 256 + 8 * (dpc ^ (2 * (row_ & 7)))), (LAS unsigned*)(L + (buf_) * TB + (4 * w + q_) * 1024), 16, 0, 0); } } while (0)
#define ATT_ST(buf_) do { int ka_[8]; { const int kb_t_ = kbase + (buf_) * TB; _Pragma("unroll") for (int ks = 0; ks < 8; ++ks) ka_[ks] = kb_t_ + ((64 * ks) ^ ysh); } \
            _Pragma("unroll") for (int kb = 0; kb < 4; ++kb) S[kb] = (f32x4){0.f, 0.f, 0.f, 0.f}; \
            bf16x8 kf[2][2]; \
            _Pragma("unroll") for (int j = 0; j < 2; ++j) kf[0][j] = *(LAS bf16x8*)(L + ka_[j]); \
            _Pragma("unroll") for (int bt = 0; bt < 16; ++bt) {        \
                if (bt + 1 < 16) { _Pragma("unroll") for (int j = 0; j < 2; ++j) kf[(bt + 1) & 1][j] = *(LAS bf16x8*)(L + ka_[2 * ((bt + 1) & 3) + j] + 8192 * ((bt + 1) >> 2)); } \
                _Pragma("unroll") for (int j = 0; j < 2; ++j) S[bt >> 2] = __builtin_amdgcn_mfma_f32_16x16x32_bf16(kf[bt & 1][j], Qf[2 * (bt & 3) + j], S[bt >> 2], 0, 0, 0); \
                __builtin_amdgcn_sched_barrier(0); } } while (0)
#define ATT_SOFTMAX(mw_) do { \
            float mx = fmaxf(fmaxf(fmaxf(S[0][0], S[0][1]), fmaxf(S[0][2], S[0][3])), fmaxf(fmaxf(S[1][0], S[1][1]), fmaxf(S[1][2], S[1][3]))); \
            mx = fmaxf(mx, fmaxf(fmaxf(fmaxf(S[2][0], S[2][1]), fmaxf(S[2][2], S[2][3])), fmaxf(fmaxf(S[3][0], S[3][1]), fmaxf(S[3][2], S[3][3])))); \
            mx = fmaxf(mx, __shfl_xor(mx, 16)); mx = fmaxf(mx, __shfl_xor(mx, 32)); \
            const bool need = mx > mrun + 8.0f; \
            if (__any(need)) { const float mnew = need ? mx : mrun, alpha = fast_exp2(mrun - mnew); mrun = mnew; lsum *= alpha; \
                _Pragma("unroll") for (int cb = 0; cb < 16; ++cb) Ot[cb] = Ot[cb] * alpha; } \
            const unsigned long long mq = (mw_) >> (4 * fq); const unsigned mlo = (unsigned)mq, mhi = (unsigned)(mq >> 32); \
            _Pragma("unroll") for (int kb = 0; kb < 4; ++kb) _Pragma("unroll") for (int r = 0; r < 4; ++r) { \
                const unsigned mk = (unsigned)__builtin_amdgcn_sbfe((int)(kb < 2 ? mlo : mhi), 16 * (kb & 1) + r, 1); \
                const float pv = __uint_as_float(__float_as_uint(fast_exp2(S[kb][r] - mrun)) & mk); S[kb][r] = pv; lsum += pv; } \
            _Pragma("unroll") for (int s2 = 0; s2 < 2; ++s2) { const u32x4 pk = pack8(S[2 * s2], S[2 * s2 + 1]); Pf[s2] = __builtin_bit_cast(bf16x8, pk); } } while (0)
#define ATT_VLOAD(dst, vb_, cb_) do { const int va_ = (vb_) + ((32 * (cb_)) ^ x2s); \
            dst[0] = __builtin_amdgcn_ds_read_tr16_b64_v4i16((LAS s16x4*)(L + va_)); dst[1] = __builtin_amdgcn_ds_read_tr16_b64_v4i16((LAS s16x4*)(L + va_ + 16 * 512)); \
            dst[2] = __builtin_amdgcn_ds_read_tr16_b64_v4i16((LAS s16x4*)(L + va_ + 32 * 512)); dst[3] = __builtin_amdgcn_ds_read_tr16_b64_v4i16((LAS s16x4*)(L + va_ + 48 * 512)); } while (0)
#define ATT_PV(buf_) do { const int vb_ = vbase + (buf_) * TB; s16x4 tv[2][4]; ATT_VLOAD(tv[0], vb_, 0); \
            _Pragma("unroll") for (int cb = 0; cb < 16; ++cb) { \
                if (cb + 1 < 16) ATT_VLOAD(tv[(cb + 1) & 1], vb_, cb + 1); \
                const s16x4 a0 = tv[cb & 1][0], a1 = tv[cb & 1][1], a2 = tv[cb & 1][2], a3 = tv[cb & 1][3]; \
                const bf16x8 v0 = (bf16x8){a0[0], a0[1], a0[2], a0[3], a1[0], a1[1], a1[2], a1[3]}; \
                const bf16x8 v1 = (bf16x8){a2[0], a2[1], a2[2], a2[3], a3[0], a3[1], a3[2], a3[3]}; \
                Ot[cb] = __builtin_amdgcn_mfma_f32_16x16x32_bf16(v0, Pf[0], Ot[cb], 0, 0, 0); \
                Ot[cb] = __builtin_amdgcn_mfma_f32_16x16x32_bf16(v1, Pf[1], Ot[cb], 0, 0, 0); __builtin_amdgcn_sched_barrier(0); } } while (0)
        ATT_DMA(0, 0);
        unsigned long long mwn = MASK[(rb + t0 + fr) * 32];
        asm volatile("s_waitcnt vmcnt(0)" ::: "memory");
        __syncthreads();
        int bufc = 0;
        for (int it = 0; it < ntiles; ++it) {
            const int bufn = (bufc == 2) ? 0 : bufc + 1;
            if (it + 1 < ntiles) ATT_DMA(it + 1, bufn);
            const unsigned long long mw = mwn; mwn = MASK[(rb + t0 + fr) * 32 + ((it + 1 < ntiles) ? it + 1 : it)];
            f32x4 S[4];
            ATT_ST(bufc); ATT_SOFTMAX(mw);
            if (grpB) { asm volatile("s_waitcnt vmcnt(0)" ::: "memory"); __builtin_amdgcn_s_barrier(); asm volatile("" ::: "memory"); }
            ATT_PV(bufc);
            if (!grpB) { asm volatile("s_waitcnt vmcnt(0)" ::: "memory"); __builtin_amdgcn_s_barrier(); asm volatile("" ::: "memory"); }
            bufc = bufn;
        }
        __syncthreads();
#undef ATT_DMA
#undef ATT_ST
#undef ATT_SOFTMAX
#undef ATT_VLOAD
#undef ATT_PV
        lsum += __shfl_xor(lsum, 16); lsum += __shfl_xor(lsum, 32);
        const float inv = 1.f / lsum;
#pragma unroll
        for (int cb = 0; cb < 16; ++cb) { u32x2 o; o.x = cvt_pk_bf16(Ot[cb][0] * inv, Ot[cb][1] * inv); o.y = cvt_pk_bf16(Ot[cb][2] * inv, Ot[cb][3] * inv);
            *(u32x2*)(OLAT + (rb + t0 + fr) * 2048 + w * 256 + 16 * cb + 4 * fq) = o; }
    }
}

constexpr int PH_PER_PAIR = 18, N_PHASES = 1 + 2 * PH_PER_PAIR;

__global__ void __launch_bounds__(NTHREADS, 2) fwd_kernel(Params p) {
    extern __shared__ __attribute__((aligned(16))) unsigned char lds_raw[];
    Frame F;
    F.lds = (LAS unsigned char*)lds_raw;
    F.tid = threadIdx.x; F.lane = F.tid & 63; F.wave = __builtin_amdgcn_readfirstlane(F.tid >> 6);
    F.G = gridDim.x; F.c = blockIdx.x;
    unsigned char* ws = p.ws;
    F.ctl = (unsigned*)(ws + WS_CTL);
    for (int u = F.tid; u < (LDS_BYTES - LDSCTL_OFF) / 4; u += NTHREADS) ((LAS unsigned*)(F.lds + LDSCTL_OFF))[u] = 0u;
    __syncthreads();
    const bool one_launch = (p.ph_hi - p.ph_lo) > 1;
    XcdBarrier bar; bar.bar = F.ctl + CW_BAR; bar.x = 0; bar.st = nullptr;
    if (one_launch) bar = xcd_barrier_post(F.ctl + CW_BAR, (volatile LAS unsigned*)(F.lds + MISC_OFF) + 8);
    const int lo = p.ph_lo, hi = p.ph_hi;
#define REFRESH() do { int t_ = threadIdx.x; asm volatile("" : "+v"(t_)); F.tid = t_; F.lane = t_ & 63; F.wave = __builtin_amdgcn_readfirstlane(t_ >> 6); } while (0)
#ifndef DBLMASK
#define DBLMASK 0u
#endif
#define REP(b) for (int rep_ = 0; rep_ < 1 + (int)((DBLMASK >> (b)) & 1u); ++rep_)
#define IN(k) (lo <= (k) && (k) < hi)
#ifndef MK_BARTIME
#define MK_BARTIME 0
#endif
    unsigned long long bt_acc = 0ull;
#if MK_BARTIME
#define SEAM(k) do { if (IN(k) && IN((k) + 1)) { const unsigned long long t0_ = __builtin_amdgcn_s_memrealtime(); xcd_barrier(bar); bt_acc += __builtin_amdgcn_s_memrealtime() - t0_; } } while (0)
#else
#ifndef MK_DBLSEAM
#define MK_DBLSEAM 0
#endif
#define SEAM(k) do { if (IN(k) && IN((k) + 1)) { xcd_barrier(bar); if (MK_DBLSEAM) xcd_barrier(bar); } } while (0)
#endif

    bf16_t* XB = (bf16_t*)(ws + WS_XB); bf16_t* Y = (bf16_t*)(ws + WS_Y);
    unsigned char* A = ws + WS_A; bf16_t* Hb = (bf16_t*)(ws + WS_H);

    if (IN(0)) REP(31) { REFRESH(); p0_prologue(F, p); } SEAM(0);

    for (int j = 0; j < 2; ++j) {
        const int pb = 1 + j * PH_PER_PAIR;
        const int layerA = 2 * j, layerB = 2 * j + 1;
        if (IN(pb + 0)) REP(0) {
            Gemm g{XB, (const bf16_t*)(ws + WS_W_HGIN) + (size_t)j * 4 * D * D, D}; StaticOrder S; S.init(M, 4 * D, F.G, F.c);
            EpiHgIn E{(bf16_t*)(A + A_HQ)};
            gemm_phase(F.lds, g, S, E);
        } SEAM(pb + 0);
        if (IN(pb + 1)) REP(1) { REFRESH(); hgrn_phase(F, (const bf16_t*)(A + A_HQ), (const bf16_t*)(A + A_HF), (const bf16_t*)(A + A_HV), INP(IN_HGLB), j, (bf16_t*)(A + A_HO)); } SEAM(pb + 1);
        if (IN(pb + 2)) REP(2) { REFRESH(); hgrn_gate_phase(F, (const bf16_t*)(A + A_HO), (const bf16_t*)(A + A_HG), INP(IN_HGNG) + (size_t)j * D, (bf16_t*)(A + A_HOG)); } SEAM(pb + 2);
        if (IN(pb + 3)) REP(3) {
            Gemm g{(const bf16_t*)(A + A_HOG), (const bf16_t*)(ws + WS_W_HGOUT) + (size_t)j * D * D, D}; StaticOrder S; S.init(M, D, F.G, F.c);
            EpiRes E{XB, Y}; gemm_phase(F.lds, g, S, E);
        } SEAM(pb + 3);
        if (IN(pb + 4)) REP(4) { REFRESH(); ln_phase(F, Y, INP(IN_LNG) + (size_t)(layerA * 2 + 0) * D, INP(IN_LNB) + (size_t)(layerA * 2 + 0) * D, XB); } SEAM(pb + 4);
        if (IN(pb + 5)) REP(5) {
            Gemm g{XB, (const bf16_t*)(ws + WS_W_FGU) + (size_t)j * 2 * DFF * D, D}; StaticOrder S; S.init(M, 2 * DFF, F.G, F.c);
            EpiSwiglu E{Hb}; gemm_phase(F.lds, g, S, E);
        } SEAM(pb + 5);
        if (IN(pb + 6)) REP(6) {
            Gemm g{Hb, (const bf16_t*)(ws + WS_W_FDN) + (size_t)j * D * DFF, DFF}; StaticOrder S; S.init(M, D, F.G, F.c);
            EpiRes E{XB, Y}; gemm_phase(F.lds, g, S, E);
        } SEAM(pb + 6);
        if (IN(pb + 7)) REP(7) { REFRESH(); ln_phase(F, Y, INP(IN_LNG) + (size_t)(layerA * 2 + 1) * D, INP(IN_LNB) + (size_t)(layerA * 2 + 1) * D, XB); } SEAM(pb + 7);
        if (IN(pb + 8)) REP(8) {
            Gemm g{XB, (const bf16_t*)(ws + WS_W_DIN) + (size_t)j * DSA_IN_PAD * D, D}; StaticOrder S; S.init(M, DSA_IN_PAD, F.G, F.c);
            EpiBf16 E{(bf16_t*)(A + A_RAW), DSA_IN_PAD}; gemm_phase(F.lds, g, S, E);
        } SEAM(pb + 8);
        if (IN(pb + 9)) REP(9) { REFRESH(); dsa_norm_phase(F, (const bf16_t*)(A + A_RAW), INP(IN_DQNG) + (size_t)j * QR, INP(IN_DKVNG) + (size_t)j * KVR, INP(IN_DKIG) + (size_t)j * IDXD, INP(IN_DKIB) + (size_t)j * IDXD,
                                         (bf16_t*)(A + A_CQ), (bf16_t*)(A + A_CKV), (bf16_t*)(A + A_KIDX), (float*)(A + A_WIDX)); } SEAM(pb + 9);
        if (IN(pb + 10)) REP(10) {
            Gemm g{(const bf16_t*)(A + A_CQ), (const bf16_t*)(ws + WS_W_DQ) + (size_t)j * 2560 * QR, QR}; StaticOrder S; S.init(M, 2560, F.G, F.c);
            EpiQ E{(bf16_t*)(A + A_QLAT), (bf16_t*)(A + A_QIDX)}; gemm_phase(F.lds, g, S, E);
        } SEAM(pb + 10);
        if (IN(pb + 11)) REP(11) { REFRESH(); dsa_index_phase(F, (const bf16_t*)(A + A_QIDX), (const bf16_t*)(A + A_KIDX), (const float*)(A + A_WIDX), (unsigned long long*)(A + A_MASK)); } SEAM(pb + 11);
        if (IN(pb + 12)) REP(12) { REFRESH(); dsa_attn_phase(F, (const bf16_t*)(A + A_QLAT), (const bf16_t*)(A + A_CKV), (const unsigned long long*)(A + A_MASK), (bf16_t*)(A + A_OLAT)); } SEAM(pb + 12);
        if (IN(pb + 13)) REP(13) {
            Gemm g{(const bf16_t*)(A + A_OLAT), (const bf16_t*)(ws + WS_W_DO) + (size_t)j * D * 2048, 2048}; StaticOrder S; S.init(M, D, F.G, F.c);
            EpiRes E{XB, Y}; gemm_phase(F.lds, g, S, E);
        } SEAM(pb + 13);
        if (IN(pb + 14)) REP(14) { REFRESH(); ln_router_phase(F, Y, INP(IN_LNG) + (size_t)(layerB * 2 + 0) * D, INP(IN_LNB) + (size_t)(layerB * 2 + 0) * D, INP(IN_MR) + (size_t)j * D * NEXP, XB,
                                           (int*)(A + A_EIDX), (int*)(A + A_POS), (int*)(A + A_TOK), (float*)(A + A_GW), F.ctl + CW_MOE + 64 * j); } SEAM(pb + 14);
        if (IN(pb + 15)) REP(15) {
            Gemm g{XB, (const bf16_t*)(ws + WS_W_MGU) + (size_t)j * NEXP * 2 * DFF * D, D}; MoeOrder S; S.init(F.ctl + CW_MOE + 64 * j, 2 * DFF / BM, F.G, F.c);
            EpiSwiglu E{Hb}; gemm_phase_gather(F.lds, g, S, E, (const int*)(A + A_TOK));
        } SEAM(pb + 15);
        if (IN(pb + 16)) REP(16) {
            Gemm g{Hb, (const bf16_t*)(ws + WS_W_MDN) + (size_t)j * NEXP * D * DFF, DFF}; MoeOrder S; S.init(F.ctl + CW_MOE + 64 * j, D / BM, F.G, F.c);
            EpiMoeDn E{(bf16_t*)(A + A_OUTM), (const float*)(A + A_GW)}; gemm_phase(F.lds, g, S, E);
        } SEAM(pb + 16);
        if (IN(pb + 17)) REP(17) { REFRESH(); ln_moe_phase(F, XB, (const bf16_t*)(A + A_OUTM), (const int*)(A + A_EIDX), (const int*)(A + A_POS), F.ctl + CW_MOE + 64 * j,
                                        INP(IN_LNG) + (size_t)(layerB * 2 + 1) * D, INP(IN_LNB) + (size_t)(layerB * 2 + 1) * D, XB, (j == 1) ? p.out : nullptr); } SEAM(pb + 17);
    }
#if MK_BARTIME
    if (one_launch) {
        if (blockIdx.x == 0 && threadIdx.x == 0) __hip_atomic_store(F.ctl + 3000, (unsigned)bt_acc, __ATOMIC_RELAXED, __HIP_MEMORY_SCOPE_AGENT);
        xcd_barrier(bar);
        const float cval = 2.0f + 4.0f * (float)__hip_atomic_load(F.ctl + 3000, __ATOMIC_RELAXED, __HIP_MEMORY_SCOPE_AGENT) * 1e-5f;
        for (size_t i = (size_t)blockIdx.x * NTHREADS + threadIdx.x; i < (size_t)M * D; i += (size_t)gridDim.x * NTHREADS) p.out[i] = cval;
    }
#endif
}


#if MK_DEBUG_SCAN
__global__ void scan_kernel(const void* ptr, size_t n, int is_bf16, unsigned code, unsigned* flag, const unsigned* gcnt, size_t row_elems) {
    size_t nn = n;
    if (gcnt) { unsigned t = 0; for (int e = 0; e < 8; ++e) t += (gcnt[e] + 255u) >> 8; nn = (size_t)t * 256 * row_elems; }
    bool bad = false;
    for (size_t i = (size_t)blockIdx.x * blockDim.x + threadIdx.x; i < nn; i += (size_t)gridDim.x * blockDim.x) {
        if (is_bf16) { const unsigned short v = ((const unsigned short*)ptr)[i]; bad |= (v & 0x7f80u) == 0x7f80u; }
        else { const unsigned v = ((const unsigned*)ptr)[i]; bad |= (v & 0x7f800000u) == 0x7f800000u; }
    }
    if (bad) atomicMin(flag, code);
}
__global__ void fin_kernel(float* out, size_t n, const unsigned* flag) {
    const unsigned f = *flag; if (f == 0xffffffffu) return;
    const float cval = (float)f + 0.25f * (float)flag[64];
    for (size_t i = (size_t)blockIdx.x * blockDim.x + threadIdx.x; i < n; i += (size_t)gridDim.x * blockDim.x) out[i] = cval;
}

__global__ void chk_a1_kernel(const float* x, const float* w, const bf16_t* Q, const float* FP, unsigned code, unsigned* flag) {
    const unsigned id = blockIdx.x * blockDim.x + threadIdx.x;
    unsigned hsh = id * 2654435761u + 12345u; hsh ^= hsh >> 13; hsh *= 0x5bd1e995u; hsh ^= hsh >> 15;
    const int row = hsh % M, col = (hsh >> 15) % (4 * D);
    float ref = 0.f; for (int k = 0; k < D; ++k) ref += x[(size_t)row * D + k] * w[(size_t)k * 4 * D + col];
    const int part = col >> 10, cc = col & 1023;
    float got;
    if (part == 1) got = FP[(size_t)row * D + cc];
    else got = bf2f(Q[(size_t)(part == 0 ? 0 : part - 1) * M * D + (size_t)row * D + cc]);
    if (!(fabsf(got - ref) < 0.08f)) atomicMin(flag, code);
}
__global__ void chk_hgrn_kernel(const bf16_t* Q, const float* FP, const bf16_t* V, const bf16_t* O, unsigned* bits) {
    const int sample = blockIdx.x, lane = threadIdx.x;
    const int b = sample % BATCH, h = (sample / BATCH) % HG_H, e = (sample * 37 + 11) % 128;
    float s0 = 0.f, s1 = 0.f; unsigned r = 0;
    for (int t = 0; t < 128; ++t) {
        const size_t base = ((size_t)b * SEQ + t) * D + h * 128;
        const float f0 = sigmoidf_(FP[base + lane]), f1 = sigmoidf_(FP[base + lane + 64]);
        const float v = bf2f(V[base + e]);
        s0 = f0 * s0 + (1.f - f0) * v; s1 = f1 * s1 + (1.f - f1) * v;
        const float o = wave_sum(bf2f(Q[base + lane]) * s0 + bf2f(Q[base + lane + 64]) * s1);
        const unsigned short gb = O[base + e]; const float got = bf2f(gb);
        const bool nf = (gb & 0x7f80u) == 0x7f80u;
        if (t < 64) { if (nf) r |= 4u; else if (!(fabsf(got - o) < 0.05f + 0.03f * fabsf(o))) r |= 2u; }
        else if (nf) r |= 1u;
    }
    if (r && lane == 0) atomicOr(bits, r);
}
__global__ void flaginit_kernel(unsigned* flag) { *flag = 0xffffffffu; }
#endif

extern "C" void kernel_launch(void* const* d_in, const int* in_sizes, int n_in, void* d_out, int out_size, void* d_ws, size_t ws_size, hipStream_t stream) {
    static int grid = 0;
    if (grid == 0) {
        if (n_in != 22 || out_size != M * D || ws_size < WS_END) { fprintf(stderr, "kernel_launch: unexpected problem (n_in %d out %d ws %zu need %zu)\n", n_in, out_size, ws_size, (size_t)WS_END); grid = -1; return; }
        int dev = 0, cus = 0, per_cu = 0;
        if (hipGetDevice(&dev) != hipSuccess || hipDeviceGetAttribute(&cus, hipDeviceAttributeMultiprocessorCount, dev) != hipSuccess) { grid = -1; return; }
        if (hipFuncSetAttribute((const void*)fwd_kernel, hipFuncAttributeMaxDynamicSharedMemorySize, LDS_BYTES) != hipSuccess) { fprintf(stderr, "kernel_launch: hipFuncSetAttribute failed\n"); grid = -1; return; }
        if (hipOccupancyMaxActiveBlocksPerMultiprocessor(&per_cu, (const void*)fwd_kernel, NTHREADS, LDS_BYTES) != hipSuccess || per_cu < 1) fprintf(stderr, "kernel_launch: occupancy query reports %d\n", per_cu);
        grid = cus;
    }
    if (grid <= 0) return;
    (void)hipMemsetAsync((char*)d_ws + WS_CTL, 0, CTL_ZERO_BYTES, stream);
    Params p{};
    for (int i = 0; i < 22; ++i) p.in[i] = (const float*)d_in[i];
    p.out = (float*)d_out; p.ws = (unsigned char*)d_ws;
#if MK_N_LAUNCHES == 1
    p.ph_lo = 0; p.ph_hi = N_PHASES;
    hipLaunchKernelGGL(fwd_kernel, dim3(grid), dim3(NTHREADS), LDS_BYTES, stream, p);
#ifdef MK_EXTRA_PHASES
    { const int extra[] = {MK_EXTRA_PHASES}; for (int r = 0; r < MK_EXTRA_REPS; ++r) for (int k : extra) { p.ph_lo = k; p.ph_hi = k + 1; hipLaunchKernelGGL(fwd_kernel, dim3(grid), dim3(NTHREADS), LDS_BYTES, stream, p); } }
#endif
#else
#if MK_DEBUG_SCAN
    unsigned char* ws = (unsigned char*)d_ws; unsigned* flag = (unsigned*)(ws + WS_CTL) + 2048;
    hipLaunchKernelGGL(flaginit_kernel, dim3(1), dim3(1), 0, stream, flag);
#define SCAN(ptr, n, isbf, k) hipLaunchKernelGGL(scan_kernel, dim3(1024), dim3(256), 0, stream, (const void*)(ptr), (size_t)(n), isbf, (unsigned)((k) + 1), flag, (const unsigned*)nullptr, (size_t)0)
#define SCANM(ptr, re, isbf, k, jj) hipLaunchKernelGGL(scan_kernel, dim3(1024), dim3(256), 0, stream, (const void*)(ptr), (size_t)0, isbf, (unsigned)((k) + 1), flag, (const unsigned*)(ws + WS_CTL) + CW_MOE + 64 * (jj), (size_t)(re))
#endif
    for (int k = 0; k < N_PHASES; ++k) { p.ph_lo = k; p.ph_hi = k + 1; hipLaunchKernelGGL(fwd_kernel, dim3(grid), dim3(NTHREADS), LDS_BYTES, stream, p);
#if MK_DEBUG_SCAN
        unsigned char* A = ws + WS_A; const size_t MD = (size_t)M * D;
        if (k == 0) { SCAN(ws + WS_W_HGIN, 2 * 4 * MD / M * D, 1, k); SCAN(ws + WS_W_HGOUT, 2 * (size_t)D * D, 1, k); SCAN(ws + WS_W_FGU, 2 * (size_t)2 * DFF * D, 1, k); SCAN(ws + WS_W_FDN, 2 * (size_t)DFF * D, 1, k);
            SCAN(ws + WS_W_DIN, 2 * (size_t)DSA_IN_PAD * D, 1, k); SCAN(ws + WS_W_DQ, 2 * (size_t)2560 * QR, 1, k); SCAN(ws + WS_W_DO, 2 * (size_t)D * 2048, 1, k);
            SCAN(ws + WS_W_MGU, 16 * (size_t)2 * DFF * D, 1, k); SCAN(ws + WS_W_MDN, 16 * (size_t)DFF * D, 1, k); SCAN(ws + WS_XB, MD, 1, k); }
        else { const int l = (k - 1) % PH_PER_PAIR, jj = (k - 1) / PH_PER_PAIR;
            switch (l) {
            case 0: SCAN(A + A_HQ, 3 * MD, 1, k); SCAN(A + A_HF, MD, 0, k);
                if (jj == 0) hipLaunchKernelGGL(chk_a1_kernel, dim3(64), dim3(256), 0, stream, (const float*)d_in[IN_X], (const float*)d_in[IN_HGWIN], (const bf16_t*)(A + A_HQ), (const float*)(A + A_HF), (unsigned)(k + 1), flag);
                break;
            case 1: SCAN(A + A_HO, MD, 1, k);
                if (jj == 0) hipLaunchKernelGGL(chk_hgrn_kernel, dim3(256), dim3(64), 0, stream, (const bf16_t*)(A + A_HQ), (const float*)(A + A_HF), (const bf16_t*)(A + A_HV), (const bf16_t*)(A + A_HO), flag + 64);
                break;
            case 2: SCAN(A + A_HOG, MD, 1, k); break;
            case 3: case 6: case 13: SCAN(ws + WS_Y, MD, 1, k); break;
            case 4: case 7: case 14: SCAN(ws + WS_XB, MD, 1, k); break;
            case 5: SCAN(ws + WS_H, (size_t)M * DFF, 1, k); break;
            case 8: SCAN(A + A_RAW, (size_t)M * DSA_IN_PAD, 0, k); break;
            case 9: SCAN(A + A_CQ, (size_t)M * 256, 1, k); SCAN(A + A_CKV, (size_t)M * 256, 1, k); SCAN(A + A_KIDX, (size_t)M * 64, 1, k); SCAN(A + A_WIDX, (size_t)M * 8, 0, k); break;
            case 10: SCAN(A + A_QLAT, (size_t)M * 2048, 1, k); SCAN(A + A_QIDX, (size_t)M * 512, 1, k); break;
            case 12: SCAN(A + A_OLAT, (size_t)M * 2048, 1, k); break;
            case 16: SCANM(ws + WS_H, DFF, 1, k, jj); break;
            case 17: SCANM(A + A_OUTM, D, 0, k, jj); break;
            case 18: if (jj == 0) SCAN(ws + WS_XB, MD, 1, k); else SCAN(d_out, MD, 0, k); break;
            default: break; } }
#endif
    }
#if MK_DEBUG_SCAN
    hipLaunchKernelGGL(fin_kernel, dim3(1024), dim3(256), 0, stream, (float*)d_out, (size_t)M * D, (const unsigned*)flag);
#endif
#endif
}
```

```cpp
#include <hip/hip_runtime.h>
#include <cstdio>
#include <cstdint>

#ifndef MK_DEBUG_SCAN
#define MK_DEBUG_SCAN 0
#endif
#ifndef MK_MOE_FP8
#define MK_MOE_FP8 1
#endif
#ifndef MK_N_LAUNCHES
#define MK_N_LAUNCHES 1
#endif

#define GAS __attribute__((address_space(1)))
#define LAS __attribute__((address_space(3)))
typedef unsigned short bf16_t;
typedef short bf16x8 __attribute__((ext_vector_type(8)));
typedef short s16x4 __attribute__((ext_vector_type(4)));
typedef float f32x4 __attribute__((ext_vector_type(4)));
typedef float f32x2 __attribute__((ext_vector_type(2)));
typedef unsigned u32x4 __attribute__((ext_vector_type(4)));
typedef unsigned u32x2 __attribute__((ext_vector_type(2)));
typedef int v8i32 __attribute__((ext_vector_type(8)));
typedef int v4i32 __attribute__((ext_vector_type(4)));

constexpr int D = 1024, BATCH = 16, SEQ = 2048, M = BATCH * SEQ;
constexpr int DFF = 3584, NEXP = 8;
constexpr int HG_H = 8, HG_DK = 128, HG_C = 64;
constexpr int QR = 256, KVR = 256, IDXD = 64, IDXH = 8, DSA_H = 8, DSA_HD = 128, TOPK = 256;
constexpr int DSA_IN = 584, DSA_IN_PAD = 768;
constexpr int MOE_ROWS = 2 * M + NEXP * 256;
constexpr float ALPHA = 1.6817928305074290f;
constexpr float LN_EPS = 1e-5f, RMS_EPS = 1e-6f;
constexpr int NWAVES = 8, NTHREADS = 512;

constexpr size_t MiB = 1u << 20;
constexpr size_t WS_CTL = 0, CTL_ZERO_BYTES = 1 * MiB;
constexpr size_t WS_W_HGIN = 1 * MiB;
constexpr size_t WS_W_HGOUT = 17 * MiB;
constexpr size_t WS_W_FGU = 21 * MiB;
constexpr size_t WS_W_FDN = 49 * MiB;
constexpr size_t WS_W_DIN = 63 * MiB;
constexpr size_t WS_W_DQ = 66 * MiB;
constexpr size_t WS_W_DO = 69 * MiB;
constexpr size_t WS_W_MGU = 77 * MiB;
constexpr size_t WS_W_MDN = 301 * MiB;
constexpr size_t WS_XB8 = 416 * MiB;
constexpr size_t WS_W_MGU8 = 77 * MiB;
constexpr size_t WS_W_MDN8 = 192 * MiB;
constexpr size_t WS_XB = 544 * MiB;
constexpr size_t WS_Y = 608 * MiB;
constexpr size_t WS_A = 736 * MiB;
constexpr size_t WS_H = 1184 * MiB;
constexpr size_t WS_END = 1648 * MiB;
constexpr size_t A_HQ = 0, A_HF = 64 * MiB, A_HV = 128 * MiB, A_HG = 192 * MiB, A_HO = 320 * MiB, A_HOG = 384 * MiB;
constexpr size_t A_RAW = 0, A_CQ = 96 * MiB, A_CKV = 112 * MiB, A_KIDX = 128 * MiB, A_WIDX = 132 * MiB, A_MASK = 136 * MiB, A_QLAT = 144 * MiB, A_QIDX = 272 * MiB, A_OLAT = 304 * MiB;
constexpr size_t A_OUTM = 136 * MiB, A_EIDX = 404 * MiB, A_POS = 405 * MiB, A_TOK = 406 * MiB, A_GW = 407 * MiB;
constexpr int CW_BAR = 4096, CW_MOE = 16384;

constexpr int RING_BYTES = 131072;
constexpr int LDSCTL_OFF = RING_BYTES, MISC_OFF = LDSCTL_OFF + 320;
constexpr int STAGE_TOKL = RING_BYTES + 2048;
constexpr int LDS_BYTES = 147456;

typedef __bf16 hwbf16x2 __attribute__((ext_vector_type(2)));
__device__ __forceinline__ unsigned cvt_pk_bf16(float lo, float hi) { const f32x2 v = {lo, hi}; const hwbf16x2 b = __builtin_convertvector(v, hwbf16x2); return __builtin_bit_cast(unsigned, b); }
__device__ __forceinline__ bf16_t f2bf(float f) { return (bf16_t)(cvt_pk_bf16(f, 0.f) & 0xffffu); }
__device__ __forceinline__ float bf2f(bf16_t b) { return __uint_as_float(((unsigned)b) << 16); }
__device__ __forceinline__ float wave_sum(float v) {
    v += __builtin_bit_cast(float, __builtin_amdgcn_update_dpp(0, __builtin_bit_cast(int, v), 0xB1, 0xF, 0xF, true));
    v += __builtin_bit_cast(float, __builtin_amdgcn_update_dpp(0, __builtin_bit_cast(int, v), 0x4E, 0xF, 0xF, true));
    v += __builtin_bit_cast(float, __builtin_amdgcn_update_dpp(0, __builtin_bit_cast(int, v), 0x141, 0xF, 0xF, true));
    v += __builtin_bit_cast(float, __builtin_amdgcn_update_dpp(0, __builtin_bit_cast(int, v), 0x140, 0xF, 0xF, true));
    const float r0 = __builtin_bit_cast(float, __builtin_amdgcn_readlane(__builtin_bit_cast(int, v), 0)), r1 = __builtin_bit_cast(float, __builtin_amdgcn_readlane(__builtin_bit_cast(int, v), 16));
    const float r2 = __builtin_bit_cast(float, __builtin_amdgcn_readlane(__builtin_bit_cast(int, v), 32)), r3 = __builtin_bit_cast(float, __builtin_amdgcn_readlane(__builtin_bit_cast(int, v), 48));
    return (r0 + r1) + (r2 + r3);
}
__device__ __forceinline__ float fast_exp2(float x) { return __builtin_amdgcn_exp2f(x); }
__device__ __forceinline__ float fast_rcp(float x) { return __builtin_amdgcn_rcpf(x); }
__device__ __forceinline__ float sigmoidf_(float x) { return fast_rcp(1.0f + __expf(-x)); }
__device__ __forceinline__ float siluf_(float x) { return x * sigmoidf_(x); }
#define LDS_WAIT() asm volatile("s_waitcnt lgkmcnt(0)" ::: "memory")
#define VM_WAIT() asm volatile("s_waitcnt vmcnt(0)" ::: "memory")

#define XB_TMO      128
#define XB_XCNT(j)  (256  + 64 * (j))
#define XB_XSUB(j)  (1280 + 64 * (j))
#define XB_XGEN(j)  (2304 + 64 * (j))
#define XB_TOP      3328
#define XB_TOPGEN   3392
#define XCD_BAR_WORDS 3456
#define XB_SPIN_CAP (1u << 20)

__device__ __forceinline__ unsigned xb_ld(unsigned* p)              { return __hip_atomic_load(p, __ATOMIC_RELAXED, __HIP_MEMORY_SCOPE_AGENT); }
__device__ __forceinline__ unsigned xb_add(unsigned* p, unsigned v) { return __hip_atomic_fetch_add(p, v, __ATOMIC_RELAXED, __HIP_MEMORY_SCOPE_AGENT); }
__device__ __forceinline__ unsigned xb_xcc_id() { return (unsigned)__builtin_amdgcn_s_getreg((3 << 11) | 20) & 0xFu; }
#define XB_SPIN(cond, bar) do { unsigned _sp = 0; while (cond) { __builtin_amdgcn_s_sleep(1); \
    if ((++_sp & 255u) == 0u) { if (xb_ld(&(bar)[XB_TMO])) break; if (_sp > XB_SPIN_CAP) { atomicAdd(&(bar)[XB_TMO], 1u); break; } } } } while (0)

struct XcdBarrier { unsigned* bar; unsigned x; volatile LAS unsigned* st; };

__device__ __forceinline__ XcdBarrier xcd_barrier_post(unsigned* bar, volatile LAS unsigned* st) {
    XcdBarrier b; b.bar = bar; b.x = xb_xcc_id(); b.st = st;
    if (threadIdx.x == 0) (void)xb_add(&bar[XB_XCNT(b.x)], 1u);
    return b;
}
__device__ __forceinline__ void xcd_barrier_complete(unsigned* bar, unsigned x, unsigned& nloc, unsigned& nx) {
    const unsigned G = gridDim.x * gridDim.y * gridDim.z;
    unsigned sum, cnt, mine, sp = 0u;
    for (;;) {
        sum = 0u; cnt = 0u; mine = 0u;
#pragma unroll
        for (unsigned j = 0; j < 16; ++j) { const unsigned c = xb_ld(&bar[XB_XCNT(j)]); sum += c; cnt += (c > 0u) ? 1u : 0u; mine = (j == x) ? c : mine; }
        if (sum == G) break;
        __builtin_amdgcn_s_sleep(1);
        if ((++sp & 255u) == 0u) { if (xb_ld(&bar[XB_TMO])) break; if (sp > XB_SPIN_CAP) { atomicAdd(&bar[XB_TMO], 1u); break; } }
    }
    nloc = mine > 0u ? mine : 1u; nx = cnt > 0u ? cnt : 1u;
}
__device__ __forceinline__ void xcd_barrier(const XcdBarrier& b) {
    asm volatile("s_waitcnt vmcnt(0)" ::: "memory");
    __syncthreads();
    if (threadIdx.x == 0) {
        unsigned* bar = b.bar;
        __builtin_amdgcn_s_waitcnt(0);
        unsigned nloc = b.st[0], nx = b.st[1];
        if (nloc == 0u) { xcd_barrier_complete(bar, b.x, nloc, nx); b.st[0] = nloc; b.st[1] = nx; }
        const unsigned old = xb_add(&bar[XB_XSUB(b.x)], 1u);
        const unsigned gen = old / nloc;
        if (old + 1u == (gen + 1u) * nloc) {
            __builtin_amdgcn_fence(__ATOMIC_RELEASE, "agent");
            asm volatile("s_waitcnt vmcnt(0)" ::: "memory");
            const unsigned og = xb_add(&bar[XB_TOP], 1u);
            const unsigned tg = og / nx;
            if (og + 1u == (tg + 1u) * nx) xb_add(&bar[XB_TOPGEN], 1u);
            else XB_SPIN(xb_ld(&bar[XB_TOPGEN]) == tg, bar);
            __builtin_amdgcn_fence(__ATOMIC_ACQUIRE, "agent");
            xb_add(&bar[XB_XGEN(b.x)], 1u);
            asm volatile("s_waitcnt vmcnt(0)" ::: "memory");
        } else {
            XB_SPIN(xb_ld(&bar[XB_XGEN(b.x)]) == gen, bar);
            __builtin_amdgcn_fence(__ATOMIC_ACQUIRE, "agent");
            asm volatile("s_waitcnt vmcnt(0)" ::: "memory");
        }
    }
    __syncthreads();
}

constexpr int BM = 256, BK = 64, HALF = 128, HTB = HALF * BK * 2, NXCD = 8, WGM = 8;
__device__ __forceinline__ int lds_byte(int r, int c) { const int st = (r >> 4) * 2 + (c >> 5), rr = r & 15, cc = c & 31, ob = rr * 64 + cc * 2; return st * 1024 + (ob ^ (((ob >> 9) & 1) << 5)); }
__device__ __forceinline__ void stage_rc(int b, int& R, int& C) { const int st = b / 1024, sb = b % 1024, swz = sb ^ (((sb >> 9) & 1) << 5); R = (st >> 1) * 16 + swz / 64; C = (st & 1) * 32 + (swz % 64) / 2; }
__device__ __forceinline__ int perm32(int rho) { const int n = rho >> 4, i = rho & 15; return 8 * (i >> 2) + 4 * n + (i & 3); }

struct Unit { int pm, pn, pb, lt, cnt, e; };
struct Gemm { const bf16_t* A; const bf16_t* Bt; int K; };

__device__ __forceinline__ void tile_map(int L, int nM, int nN, int& pm, int& pn) {
    const int nwg = nM * nN;
    int wgid = L; { const int q = nwg / NXCD, r = nwg % NXCD, xcd = wgid % NXCD, off = wgid / NXCD; wgid = (xcd < r ? xcd * (q + 1) : r * (q + 1) + (xcd - r) * q) + off; }
    const int nig = WGM * nN, gid = wgid / nig, fm = gid * WGM, gsz = (nM - fm) < WGM ? (nM - fm) : WGM;
    pm = fm + ((wgid % nig) % gsz); pn = (wgid % nig) / gsz;
}
struct StaticOrder {
    int nM, nN, nwg, G, c;
    __device__ __forceinline__ void init(int M_, int N_, int G_, int c_) { nM = M_ / BM; nN = N_ / BM; nwg = nM * nN; G = G_; c = c_; }
    __device__ __forceinline__ bool next(int i, Unit& u) const {
        const long L = (long)i * G + c; if (L >= nwg) return false;
        tile_map((int)L, nM, nN, u.pm, u.pn); u.pb = u.pn; u.lt = 0; u.cnt = 0; u.e = 0; return true;
    }
};
struct MoeOrder {
    int t1, t2, t3, t4, t5, t6, t7, nM, nN, nwg, G, c; const unsigned* cntp;
    __device__ __forceinline__ void init(const unsigned* cnt, int nN_, int G_, int c_) {
        int t = 0, o[9];
#pragma unroll
        for (int e = 0; e < 8; ++e) { o[e] = t; const int ce = __builtin_amdgcn_readfirstlane((int)__hip_atomic_load(cnt + e, __ATOMIC_RELAXED, __HIP_MEMORY_SCOPE_AGENT)); t += (ce + 255) >> 8; }
        o[8] = t; t1 = o[1]; t2 = o[2]; t3 = o[3]; t4 = o[4]; t5 = o[5]; t6 = o[6]; t7 = o[7];
        nM = t; nN = nN_; nwg = nM * nN; G = G_; c = c_; cntp = cnt;
    }
    __device__ __forceinline__ bool next(int i, Unit& u) const {
        const long L = (long)i * G + c; if (L >= nwg) return false;
        tile_map((int)L, nM, nN, u.pm, u.pn);
        const int e = (u.pm >= t1) + (u.pm >= t2) + (u.pm >= t3) + (u.pm >= t4) + (u.pm >= t5) + (u.pm >= t6) + (u.pm >= t7);
        const int tb = e == 0 ? 0 : e == 1 ? t1 : e == 2 ? t2 : e == 3 ? t3 : e == 4 ? t4 : e == 5 ? t5 : e == 6 ? t6 : t7;
        u.cnt = __builtin_amdgcn_readfirstlane((int)__hip_atomic_load(cntp + e, __ATOMIC_RELAXED, __HIP_MEMORY_SCOPE_AGENT));
        u.lt = u.pm - tb; u.e = e; u.pb = e * nN + u.pn; return true;
    }
};

typedef f32x4 Acc[2][2][4][2];

template <bool F8 = false, class Epi, class Sched>
__device__ __forceinline__ void gemm_phase(LAS unsigned char* lds, const Gemm g, const Sched& S, const Epi& E) {
    int tid_ = threadIdx.x; asm volatile("" : "+v"(tid_));
    const int tid = tid_, wid = __builtin_amdgcn_readfirstlane(tid >> 6), lane = tid & 63, wr = wid >> 2, wc = wid & 3, fr = lane & 15, fq = lane >> 4;
    const int K = g.K, nt = K / BK;
    unsigned voffA[2], voffB[2];
#pragma unroll
    for (int i = 0; i < 2; ++i) { int R, C; stage_rc(tid * 16 + i * 8192, R, C); const int Rb = (R & ~31) + perm32(R & 31);
        voffA[i] = (unsigned)(R * K + C) * 2u; voffB[i] = (unsigned)(Rb * K + C) * 2u; }
    const size_t kstep = (size_t)(BK * 2);
    const size_t hstep = (size_t)HALF * K * 2;
    const size_t tstep = 2 * hstep;
    const unsigned ldsw = (unsigned)wid * 1024u;
    const int aoff = lds_byte(wr * 64 + fr, fq * 8), boff = lds_byte(wc * 32 + fr, fq * 8);
#define PG8_SA(b, h) (((b) * 2 + (h)) * HTB)
#define PG8_SB(b, h) ((4 + (b) * 2 + (h)) * HTB)
#define PG8_STAGE(bufoff, gbase, voff) do { _Pragma("unroll") for (int _i = 0; _i < 2; ++_i) \
        __builtin_amdgcn_global_load_lds((const unsigned*)((const char*)(gbase) + (voff)[_i]), (LAS unsigned*)(lds + (bufoff) + ldsw + _i * 8192), 16, 0, 0); } while (0)
#define PG8_LDA(dst, b, h) do { _Pragma("unroll") for (int m = 0; m < 4; ++m) _Pragma("unroll") for (int k = 0; k < 2; ++k) dst[m][k] = *(const LAS bf16x8*)(lds + PG8_SA(b, h) + aoff + m * 2048 + k * 1024); } while (0)
#define PG8_LDB(dst, b, h) do { _Pragma("unroll") for (int n = 0; n < 2; ++n) _Pragma("unroll") for (int k = 0; k < 2; ++k) dst[n][k] = *(const LAS bf16x8*)(lds + PG8_SB(b, h) + boff + n * 2048 + k * 1024); } while (0)
#define PG8_MMA(ai, bj, At, Bt) do { __builtin_amdgcn_s_setprio(1); \
        if constexpr (F8) {        \
            _Pragma("unroll") for (int m = 0; m < 4; ++m) _Pragma("unroll") for (int n = 0; n < 2; ++n) { \
                const v8i32 bv_ = __builtin_shufflevector(__builtin_bit_cast(v4i32, Bt[n][0]), __builtin_bit_cast(v4i32, Bt[n][1]), 0, 1, 2, 3, 4, 5, 6, 7); \
                const v8i32 av_ = __builtin_shufflevector(__builtin_bit_cast(v4i32, At[m][0]), __builtin_bit_cast(v4i32, At[m][1]), 0, 1, 2, 3, 4, 5, 6, 7); \
                acc[ai][bj][m][n] = __builtin_amdgcn_mfma_scale_f32_16x16x128_f8f6f4(bv_, av_, acc[ai][bj][m][n], 0, 0, 0, 0x7f7f7f7f, 0, 0x7f7f7f7f); } \
        } else { \
            _Pragma("unroll") for (int m = 0; m < 4; ++m) _Pragma("unroll") for (int n = 0; n < 2; ++n) _Pragma("unroll") for (int k = 0; k < 2; ++k) \
                acc[ai][bj][m][n] = __builtin_amdgcn_mfma_f32_16x16x32_bf16(Bt[n][k], At[m][k], acc[ai][bj][m][n], 0, 0, 0); } \
        __builtin_amdgcn_s_setprio(0); } while (0)
#define PG8_WAIT_V(n) asm volatile("s_waitcnt vmcnt(" #n ")" ::: "memory")
#define PG8_WAIT_L(n) asm volatile("s_waitcnt lgkmcnt(" #n ")" ::: "memory")
#define PG8_BAR __builtin_amdgcn_s_barrier()
#define PG8_SCHED __builtin_amdgcn_sched_barrier(0)
    Unit cur, nxt; int ui = 0;
    if (!S.next(0, cur)) return;
    Acc acc;
#pragma unroll
    for (int a = 0; a < 2; ++a)
#pragma unroll
        for (int b = 0; b < 2; ++b)
#pragma unroll
            for (int m = 0; m < 4; ++m)
#pragma unroll
                for (int n = 0; n < 2; ++n) acc[a][b][m][n] = (f32x4){0.f, 0.f, 0.f, 0.f};
    bf16x8 At[4][2], B0[2][2], B1[2][2];
    const char* cA = (const char*)g.A + (size_t)cur.pm * tstep; const char* cB = (const char*)g.Bt + (size_t)cur.pb * tstep;
    PG8_STAGE(PG8_SB(0, 0), cB, voffB); PG8_STAGE(PG8_SA(0, 0), cA, voffA); PG8_STAGE(PG8_SB(0, 1), cB + hstep, voffB); PG8_STAGE(PG8_SA(0, 1), cA + hstep, voffA);
    if (wr == 1) PG8_BAR;
    PG8_WAIT_V(4); PG8_BAR;
    PG8_STAGE(PG8_SB(1, 0), cB + kstep, voffB); PG8_STAGE(PG8_SA(1, 0), cA + kstep, voffA); PG8_STAGE(PG8_SB(1, 1), cB + hstep + kstep, voffB);
    PG8_WAIT_V(6); PG8_BAR;
    for (;;) {
        const bool has_next = S.next(ui + 1, nxt);
        const char* nA = has_next ? (const char*)g.A + (size_t)nxt.pm * tstep : cA; const char* nB = has_next ? (const char*)g.Bt + (size_t)nxt.pb * tstep : cB;
#pragma nounroll
        for (int t = 0; t < nt; t += 2) {
            const bool last = (t == nt - 2);
            const char* a1 = cA + (size_t)(t + 1) * kstep;
            const char* a2 = last ? nA : cA + (size_t)(t + 2) * kstep; const char* b2 = last ? nB : cB + (size_t)(t + 2) * kstep;
            const char* a3 = a2 + kstep; const char* b3 = b2 + kstep;
            PG8_LDB(B0, 0, 0); PG8_SCHED; PG8_LDA(At, 0, 0); PG8_STAGE(PG8_SA(1, 1), a1 + hstep, voffA);
            PG8_WAIT_L(8); PG8_BAR; PG8_WAIT_L(0); PG8_MMA(0, 0, At, B0); PG8_BAR; PG8_SCHED;
            PG8_LDB(B1, 0, 1); PG8_STAGE(PG8_SB(0, 0), b2, voffB);
            PG8_BAR; PG8_WAIT_L(0); PG8_MMA(0, 1, At, B1); PG8_BAR;
            PG8_LDA(At, 0, 1); PG8_STAGE(PG8_SA(0, 0), a2, voffA);
            PG8_BAR; PG8_WAIT_L(0); PG8_MMA(1, 0, At, B0); PG8_BAR; PG8_SCHED;
            PG8_STAGE(PG8_SB(0, 1), b2 + hstep, voffB);
            PG8_WAIT_V(6); PG8_BAR; PG8_MMA(1, 1, At, B1); PG8_BAR;
            PG8_LDB(B0, 1, 0); PG8_SCHED; PG8_LDA(At, 1, 0); PG8_STAGE(PG8_SA(0, 1), a2 + hstep, voffA);
            PG8_WAIT_L(8); PG8_BAR; PG8_WAIT_L(0); PG8_MMA(0, 0, At, B0); PG8_BAR; PG8_SCHED;
            PG8_LDB(B1, 1, 1); PG8_STAGE(PG8_SB(1, 0), b3, voffB);
            PG8_BAR; PG8_WAIT_L(0); PG8_MMA(0, 1, At, B1); PG8_BAR;
            PG8_LDA(At, 1, 1); PG8_STAGE(PG8_SA(1, 0), a3, voffA);
            PG8_BAR; PG8_WAIT_L(0); PG8_MMA(1, 0, At, B0); PG8_BAR; PG8_SCHED;
            PG8_STAGE(PG8_SB(1, 1), b3 + hstep, voffB);
            PG8_WAIT_V(6); PG8_BAR; PG8_MMA(1, 1, At, B1); PG8_BAR;
        }
        E(acc, cur, wr, wc, fr, fq);
        if (!has_next) break;
#pragma unroll
        for (int a = 0; a < 2; ++a)
#pragma unroll
            for (int b = 0; b < 2; ++b)
#pragma unroll
                for (int m = 0; m < 4; ++m)
#pragma unroll
                    for (int n = 0; n < 2; ++n) acc[a][b][m][n] = (f32x4){0.f, 0.f, 0.f, 0.f};
        cur = nxt; cA = nA; cB = nB; ++ui;
    }
    PG8_WAIT_V(0);
    if (wr == 0) PG8_BAR;
    PG8_BAR;
#undef PG8_SA
#undef PG8_SB
#undef PG8_STAGE
#undef PG8_LDA
#undef PG8_LDB
#undef PG8_MMA
#undef PG8_WAIT_V
#undef PG8_WAIT_L
#undef PG8_BAR
#undef PG8_SCHED
}

template <bool F8 = false, bool IDENT = false, class Epi, class Sched>
__device__ __forceinline__ void gemm_phase_gather(LAS unsigned char* lds, const Gemm g, const Sched& S, const Epi& E, const int* TOKV) {
    int tid_ = threadIdx.x; asm volatile("" : "+v"(tid_));
    const int tid = tid_, wid = __builtin_amdgcn_readfirstlane(tid >> 6), lane = tid & 63, wr = wid >> 2, wc = wid & 3, fr = lane & 15, fq = lane >> 4;
    const int K = g.K, nt = K / BK;
    unsigned voffB[2];
#pragma unroll
    for (int i = 0; i < 2; ++i) { int R, C; stage_rc(tid * 16 + i * 8192, R, C); const int Rb = (R & ~31) + perm32(R & 31); voffB[i] = (unsigned)(Rb * K + C) * 2u; }
    unsigned vgC[2][2];
    LAS int* TOKL = (LAS int*)(lds + STAGE_TOKL);
#define PG8_GROWS(dst, u_) do { int tq_ = threadIdx.x; asm volatile("" : "+v"(tq_)); _Pragma("unroll") for (int i_ = 0; i_ < 2; ++i_) { int R_, C_; stage_rc(tq_ * 16 + i_ * 8192, R_, C_); \
            _Pragma("unroll") for (int h_ = 0; h_ < 2; ++h_) { const int pos_ = 256 * (u_).lt + 128 * h_ + R_; \
                int tok_; if constexpr (IDENT) tok_ = 256 * (u_).pm + 128 * h_ + R_; else tok_ = (pos_ < (u_).cnt) ? TOKV[(size_t)(u_).e * M + pos_] : 0; dst[h_][i_] = (unsigned)tok_ * (unsigned)(K * 2) + (unsigned)C_ * 2u; } } } while (0)
#define PG8_GROWS_LDS(dst, u_, par_) do { int tq_ = threadIdx.x; asm volatile("" : "+v"(tq_)); _Pragma("unroll") for (int i_ = 0; i_ < 2; ++i_) { int R_, C_; stage_rc(tq_ * 16 + i_ * 8192, R_, C_); \
            _Pragma("unroll") for (int h_ = 0; h_ < 2; ++h_) { const int rl_ = 128 * h_ + R_; \
                int tok_; if constexpr (IDENT) tok_ = 256 * (u_).pm + rl_; else tok_ = (256 * (u_).lt + rl_ < (u_).cnt) ? TOKL[256 * (par_) + rl_] : 0; dst[h_][i_] = (unsigned)tok_ * (unsigned)(K * 2) + (unsigned)C_ * 2u; } } } while (0)
    const size_t kstep = (size_t)(BK * 2);
    const size_t hstep = (size_t)HALF * K * 2;
    const size_t tstep = 2 * hstep;
    const unsigned ldsw = (unsigned)wid * 1024u;
    const int aoff = lds_byte(wr * 64 + fr, fq * 8), boff = lds_byte(wc * 32 + fr, fq * 8);
#define PG8_SA(b, h) (((b) * 2 + (h)) * HTB)
#define PG8_SB(b, h) ((4 + (b) * 2 + (h)) * HTB)
#define PG8_STAGE(bufoff, gbase, voff) do { _Pragma("unroll") for (int _i = 0; _i < 2; ++_i) \
        __builtin_amdgcn_global_load_lds((const unsigned*)((const char*)(gbase) + (voff)[_i]), (LAS unsigned*)(lds + (bufoff) + ldsw + _i * 8192), 16, 0, 0); } while (0)
#define PG8_STAGEA(bufoff, gbase, h_, nx_) PG8_STAGE(bufoff, gbase, vgC[h_])
#define PG8_LDA(dst, b, h) do { _Pragma("unroll") for (int m = 0; m < 4; ++m) _Pragma("unroll") for (int k = 0; k < 2; ++k) dst[m][k] = *(const LAS bf16x8*)(lds + PG8_SA(b, h) + aoff + m * 2048 + k * 1024); } while (0)
#define PG8_LDB(dst, b, h) do { _Pragma("unroll") for (int n = 0; n < 2; ++n) _Pragma("unroll") for (int k = 0; k < 2; ++k) dst[n][k] = *(const LAS bf16x8*)(lds + PG8_SB(b, h) + boff + n * 2048 + k * 1024); } while (0)
#define PG8_MMA(ai, bj, At, Bt) do { __builtin_amdgcn_s_setprio(1); \
        if constexpr (F8) {        \
            _Pragma("unroll") for (int m = 0; m < 4; ++m) _Pragma("unroll") for (int n = 0; n < 2; ++n) { \
                const v8i32 bv_ = __builtin_shufflevector(__builtin_bit_cast(v4i32, Bt[n][0]), __builtin_bit_cast(v4i32, Bt[n][1]), 0, 1, 2, 3, 4, 5, 6, 7); \
                const v8i32 av_ = __builtin_shufflevector(__builtin_bit_cast(v4i32, At[m][0]), __builtin_bit_cast(v4i32, At[m][1]), 0, 1, 2, 3, 4, 5, 6, 7); \
                acc[ai][bj][m][n] = __builtin_amdgcn_mfma_scale_f32_16x16x128_f8f6f4(bv_, av_, acc[ai][bj][m][n], 0, 0, 0, 0x7f7f7f7f, 0, 0x7f7f7f7f); } \
        } else { \
            _Pragma("unroll") for (int m = 0; m < 4; ++m) _Pragma("unroll") for (int n = 0; n < 2; ++n) _Pragma("unroll") for (int k = 0; k < 2; ++k) \
                acc[ai][bj][m][n] = __builtin_amdgcn_mfma_f32_16x16x32_bf16(Bt[n][k], At[m][k], acc[ai][bj][m][n], 0, 0, 0); } \
        __builtin_amdgcn_s_setprio(0); } while (0)
#define PG8_WAIT_V(n) asm volatile("s_waitcnt vmcnt(" #n ")" ::: "memory")
#define PG8_WAIT_L(n) asm volatile("s_waitcnt lgkmcnt(" #n ")" ::: "memory")
#define PG8_BAR __builtin_amdgcn_s_barrier()
#define PG8_SCHED __builtin_amdgcn_sched_barrier(0)
    Unit cur, nxt; int ui = 0;
    if (!S.next(0, cur)) return;
    Acc acc;
#pragma unroll
    for (int a = 0; a < 2; ++a)
#pragma unroll
        for (int b = 0; b < 2; ++b)
#pragma unroll
            for (int m = 0; m < 4; ++m)
#pragma unroll
                for (int n = 0; n < 2; ++n) acc[a][b][m][n] = (f32x4){0.f, 0.f, 0.f, 0.f};
    bf16x8 At[4][2], B0[2][2], B1[2][2];
    const char* cA = (const char*)g.A; const char* cB = (const char*)g.Bt + (size_t)cur.pb * tstep;
    PG8_GROWS(vgC, cur);
    PG8_STAGE(PG8_SB(0, 0), cB, voffB); PG8_STAGEA(PG8_SA(0, 0), cA, 0, false); PG8_STAGE(PG8_SB(0, 1), cB + hstep, voffB); PG8_STAGEA(PG8_SA(0, 1), cA, 1, false);
    if (wr == 1) PG8_BAR;
    PG8_WAIT_V(4); PG8_BAR;
    PG8_STAGE(PG8_SB(1, 0), cB + kstep, voffB); PG8_STAGEA(PG8_SA(1, 0), cA + kstep, 0, false); PG8_STAGE(PG8_SB(1, 1), cB + hstep + kstep, voffB);
    PG8_WAIT_V(6); PG8_BAR;
    for (;;) {
        const bool has_next = S.next(ui + 1, nxt);
        const char* nA = cA; const char* nB = has_next ? (const char*)g.Bt + (size_t)nxt.pb * tstep : cB;
        if (!IDENT && has_next && wid == 0) __builtin_amdgcn_global_load_lds((const unsigned*)(TOKV + (size_t)nxt.e * M + 256 * nxt.lt + 4 * lane), (LAS unsigned*)(TOKL + 256 * ((ui + 1) & 1)), 16, 0, 0);

#pragma nounroll
        for (int t = 0; t < nt; t += 2) {
            const bool last = (t == nt - 2);
            const char* a1 = cA + (size_t)(t + 1) * kstep;
            const char* a2 = last ? nA : cA + (size_t)(t + 2) * kstep; const char* b2 = last ? nB : cB + (size_t)(t + 2) * kstep;
            const char* a3 = a2 + kstep; const char* b3 = b2 + kstep;
            PG8_LDB(B0, 0, 0); PG8_SCHED; PG8_LDA(At, 0, 0); PG8_STAGEA(PG8_SA(1, 1), a1, 1, false);
            if (last && has_next) { PG8_GROWS_LDS(vgC, nxt, (ui + 1) & 1); }
            PG8_WAIT_L(8); PG8_BAR; PG8_WAIT_L(0); PG8_MMA(0, 0, At, B0); PG8_BAR; PG8_SCHED;
            PG8_LDB(B1, 0, 1); PG8_STAGE(PG8_SB(0, 0), b2, voffB);
            PG8_BAR; PG8_WAIT_L(0); PG8_MMA(0, 1, At, B1); PG8_BAR;
            PG8_LDA(At, 0, 1); PG8_STAGEA(PG8_SA(0, 0), a2, 0, last);
            PG8_BAR; PG8_WAIT_L(0); PG8_MMA(1, 0, At, B0); PG8_BAR; PG8_SCHED;
            PG8_STAGE(PG8_SB(0, 1), b2 + hstep, voffB);
            PG8_WAIT_V(6); PG8_BAR; PG8_MMA(1, 1, At, B1); PG8_BAR;
            PG8_LDB(B0, 1, 0); PG8_SCHED; PG8_LDA(At, 1, 0); PG8_STAGEA(PG8_SA(0, 1), a2, 1, last);
            PG8_WAIT_L(8); PG8_BAR; PG8_WAIT_L(0); PG8_MMA(0, 0, At, B0); PG8_BAR; PG8_SCHED;
            PG8_LDB(B1, 1, 1); PG8_STAGE(PG8_SB(1, 0), b3, voffB);
            PG8_BAR; PG8_WAIT_L(0); PG8_MMA(0, 1, At, B1); PG8_BAR;
            PG8_LDA(At, 1, 1); PG8_STAGEA(PG8_SA(1, 0), a3, 0, last);
            PG8_BAR; PG8_WAIT_L(0); PG8_MMA(1, 0, At, B0); PG8_BAR; PG8_SCHED;
            PG8_STAGE(PG8_SB(1, 1), b3 + hstep, voffB);
            PG8_WAIT_V(6); PG8_BAR; PG8_MMA(1, 1, At, B1); PG8_BAR;
        }
        E(acc, cur, wr, wc, fr, fq);
        if (!has_next) break;
#pragma unroll
        for (int a = 0; a < 2; ++a)
#pragma unroll
            for (int b = 0; b < 2; ++b)
#pragma unroll
                for (int m = 0; m < 4; ++m)
#pragma unroll
                    for (int n = 0; n < 2; ++n) acc[a][b][m][n] = (f32x4){0.f, 0.f, 0.f, 0.f};
        cur = nxt; cB = nB; ++ui;
    }
    PG8_WAIT_V(0);
    if (wr == 0) PG8_BAR;
    PG8_BAR;
#undef PG8_SA
#undef PG8_STAGEA
#undef PG8_GROWS
#undef PG8_GROWS_LDS
#undef PG8_SB
#undef PG8_STAGE
#undef PG8_LDA
#undef PG8_LDB
#undef PG8_MMA
#undef PG8_WAIT_V
#undef PG8_WAIT_L
#undef PG8_BAR
#undef PG8_SCHED
}

__device__ __forceinline__ u32x4 pack8(const f32x4 a, const f32x4 b) { u32x4 w; w.x = cvt_pk_bf16(a[0], a[1]); w.y = cvt_pk_bf16(a[2], a[3]); w.z = cvt_pk_bf16(b[0], b[1]); w.w = cvt_pk_bf16(b[2], b[3]); return w; }

struct EpiHgIn {
    bf16_t* QFVG;
    __device__ __forceinline__ void operator()(const Acc& acc, const Unit& u, int wr, int wc, int fr, int fq) const {
        const int part = u.pn >> 2, row0 = u.pm * BM + wr * 64 + fr, col0 = (u.pn & 3) * 256 + wc * 32 + 8 * fq;
        bf16_t* base = QFVG + (size_t)part * ((size_t)M * D);
#pragma unroll
        for (int ai = 0; ai < 2; ++ai)
#pragma unroll
            for (int m = 0; m < 4; ++m) { bf16_t* rowp = base + (size_t)(row0 + ai * HALF + m * 16) * D + col0;
#pragma unroll
                for (int bj = 0; bj < 2; ++bj) *(u32x4*)(rowp + bj * HALF) = pack8(acc[ai][bj][m][0], acc[ai][bj][m][1]); }
    }
};
struct EpiRes {
    const bf16_t* X; bf16_t* Y;
    __device__ __forceinline__ void operator()(const Acc& acc, const Unit& u, int wr, int wc, int fr, int fq) const {
        const int row0 = u.pm * BM + wr * 64 + fr, col0 = u.pn * BM + wc * 32 + 8 * fq;
#pragma unroll
        for (int ai = 0; ai < 2; ++ai)
#pragma unroll
            for (int m = 0; m < 4; ++m) { const size_t o = (size_t)(row0 + ai * HALF + m * 16) * D + col0;
#pragma unroll
                for (int bj = 0; bj < 2; ++bj) {
                    const u32x4 xv = *(const u32x4*)(X + o + bj * HALF);
                    f32x4 y0, y1;
#pragma unroll
                    for (int q = 0; q < 2; ++q) { y0[2 * q] = __uint_as_float(xv[q] << 16) * ALPHA + acc[ai][bj][m][0][2 * q]; y0[2 * q + 1] = __uint_as_float(xv[q] & 0xffff0000u) * ALPHA + acc[ai][bj][m][0][2 * q + 1];
                        y1[2 * q] = __uint_as_float(xv[2 + q] << 16) * ALPHA + acc[ai][bj][m][1][2 * q]; y1[2 * q + 1] = __uint_as_float(xv[2 + q] & 0xffff0000u) * ALPHA + acc[ai][bj][m][1][2 * q + 1]; }
                    *(u32x4*)(Y + o + bj * HALF) = pack8(y0, y1); } }
    }
};
__device__ __forceinline__ unsigned pack4_fp8(float a, float b, float c, float d) {
    a = fminf(fmaxf(a, -448.f), 448.f); b = fminf(fmaxf(b, -448.f), 448.f); c = fminf(fmaxf(c, -448.f), 448.f); d = fminf(fmaxf(d, -448.f), 448.f);
    int p = 0; p = __builtin_amdgcn_cvt_pk_fp8_f32(a, b, p, false); p = __builtin_amdgcn_cvt_pk_fp8_f32(c, d, p, true); return (unsigned)p;
}
constexpr float F8_X = 16.f, F8_WGU = 64.f, F8_H = 4.f, F8_WDN = 256.f;
struct EpiSwiglu8 {
    unsigned char* H;
    __device__ __forceinline__ void operator()(const Acc& acc, const Unit& u, int wr, int wc, int fr, int fq) const {
        const int row0 = u.pm * BM + wr * 64 + fr, col0 = u.pn * 128 + wc * 32 + 8 * fq; constexpr float s = 1.f / (F8_X * F8_WGU);
#pragma unroll
        for (int ai = 0; ai < 2; ++ai)
#pragma unroll
            for (int m = 0; m < 4; ++m) { unsigned char* rowp = H + (size_t)(row0 + ai * HALF + m * 16) * DFF + col0;
                float h[8];
#pragma unroll
                for (int j = 0; j < 4; ++j) { h[j] = siluf_(acc[ai][0][m][0][j] * s) * (acc[ai][1][m][0][j] * (s * F8_H)); h[4 + j] = siluf_(acc[ai][0][m][1][j] * s) * (acc[ai][1][m][1][j] * (s * F8_H)); }
                u32x2 o; o.x = pack4_fp8(h[0], h[1], h[2], h[3]); o.y = pack4_fp8(h[4], h[5], h[6], h[7]);
                *(u32x2*)rowp = o; }
    }
};
struct EpiSwiglu {
    bf16_t* H;
    __device__ __forceinline__ void operator()(const Acc& acc, const Unit& u, int wr, int wc, int fr, int fq) const {
        const int row0 = u.pm * BM + wr * 64 + fr, col0 = u.pn * 128 + wc * 32 + 8 * fq;
#pragma unroll
        for (int ai = 0; ai < 2; ++ai)
#pragma unroll
            for (int m = 0; m < 4; ++m) { bf16_t* rowp = H + (size_t)(row0 + ai * HALF + m * 16) * DFF + col0;
                f32x4 h0, h1;
#pragma unroll
                for (int j = 0; j < 4; ++j) { h0[j] = siluf_(acc[ai][0][m][0][j]) * acc[ai][1][m][0][j]; h1[j] = siluf_(acc[ai][0][m][1][j]) * acc[ai][1][m][1][j]; }
                *(u32x4*)rowp = pack8(h0, h1); }
    }
};
struct EpiBf16 {
    bf16_t* C; int ldc;
    __device__ __forceinline__ void operator()(const Acc& acc, const Unit& u, int wr, int wc, int fr, int fq) const {
        const int row0 = u.pm * BM + wr * 64 + fr, col0 = u.pn * BM + wc * 32 + 8 * fq;
#pragma unroll
        for (int ai = 0; ai < 2; ++ai)
#pragma unroll
            for (int m = 0; m < 4; ++m) { bf16_t* rowp = C + (size_t)(row0 + ai * HALF + m * 16) * ldc + col0;
#pragma unroll
                for (int bj = 0; bj < 2; ++bj) *(u32x4*)(rowp + bj * HALF) = pack8(acc[ai][bj][m][0], acc[ai][bj][m][1]); }
    }
};
struct EpiQ {
    bf16_t* QLAT; bf16_t* QIDX;
    __device__ __forceinline__ void operator()(const Acc& acc, const Unit& u, int wr, int wc, int fr, int fq) const {
        const bool lat = u.pn < 8; bf16_t* base = lat ? QLAT : QIDX; const int ld = lat ? 2048 : 512;
        const int row0 = u.pm * BM + wr * 64 + fr, col0 = (lat ? u.pn : u.pn - 8) * BM + wc * 32 + 8 * fq;
#pragma unroll
        for (int ai = 0; ai < 2; ++ai)
#pragma unroll
            for (int m = 0; m < 4; ++m) { bf16_t* rowp = base + (size_t)(row0 + ai * HALF + m * 16) * ld + col0;
#pragma unroll
                for (int bj = 0; bj < 2; ++bj) *(u32x4*)(rowp + bj * HALF) = pack8(acc[ai][bj][m][0], acc[ai][bj][m][1]); }
    }
};
struct EpiMoeDn {
    bf16_t* O; const float* GW; float scale;
    __device__ __forceinline__ void operator()(const Acc& acc, const Unit& u, int wr, int wc, int fr, int fq) const {
        const int rl0 = wr * 64 + fr, col0 = u.pn * BM + wc * 32 + 8 * fq; const float* gwp = GW + (size_t)u.e * M + 256 * u.lt;
#pragma unroll
        for (int ai = 0; ai < 2; ++ai)
#pragma unroll
            for (int m = 0; m < 4; ++m) { const int rl = rl0 + ai * HALF + m * 16; const float gv = (256 * u.lt + rl < u.cnt) ? gwp[rl] * scale : 0.f; bf16_t* rowp = O + (size_t)(u.pm * BM + rl) * D + col0;
#pragma unroll
                for (int bj = 0; bj < 2; ++bj) *(u32x4*)(rowp + bj * HALF) = pack8(acc[ai][bj][m][0] * gv, acc[ai][bj][m][1] * gv); }
    }
};

struct Params { const float* in[22]; float* out; unsigned char* ws; int ph_lo, ph_hi; };
enum { IN_X = 0, IN_LNG, IN_LNB, IN_HGWIN, IN_HGLB, IN_HGNG, IN_HGWOUT, IN_DWIN, IN_DQNG, IN_DKVNG, IN_DWUQ, IN_DWUK, IN_DWUV, IN_DWQIDX, IN_DKIG, IN_DKIB, IN_DWOUT, IN_FGU, IN_FDN, IN_MR, IN_MGU, IN_MDN };

__device__ __forceinline__ const float* inptr(int i) {
    int off = i * 8; asm volatile("" : "+s"(off));
    typedef const float* cfp;
    return *(const __attribute__((address_space(4))) cfp*)((const __attribute__((address_space(4))) char*)__builtin_amdgcn_kernarg_segment_ptr() + off);
}
#define INP(i) inptr(i)
struct Frame {
    LAS unsigned char* lds;
    unsigned* ctl;
    int tid, lane, wave, G, c;
};

__device__ __forceinline__ void p0_transpose_item(const float* W, int K, int Nsrc, int nblk, bf16_t* WT, int mode, float f8scale, LAS float* scr, int item, int lane) {
    const int kb = item / nblk, nb = item % nblk, k0 = 64 * kb, n0 = 32 * nb;
    const int c4 = (lane & 7) * 4, kr = lane >> 3;
#pragma unroll
    for (int i = 0; i < 8; ++i) { const int kk = 8 * i + kr;
        f32x4 v = (f32x4){0.f, 0.f, 0.f, 0.f};
        if (n0 + c4 < Nsrc) v = *(const f32x4*)(W + (size_t)(k0 + kk) * Nsrc + n0 + c4);
        scr[kk * 33 + c4 + 0] = v[0]; scr[kk * 33 + c4 + 1] = v[1]; scr[kk * 33 + c4 + 2] = v[2]; scr[kk * 33 + c4 + 3] = v[3]; }
    LDS_WAIT(); asm volatile("" ::: "memory");
    int drow0 = n0;
    if (mode == 1) { const int half = n0 / DFF, r = n0 % DFF; drow0 = 256 * (r / 128) + 128 * half + (r % 128); }
    if (f8scale > 0.f) {
        const int c = lane & 3;
#pragma unroll
        for (int j = 0; j < 2; ++j) { const int n = (lane >> 2) + 16 * j; const LAS float* s = scr + (16 * c) * 33 + n;
            u32x4 o;
#pragma unroll
            for (int q = 0; q < 4; ++q) o[q] = pack4_fp8(s[(4 * q) * 33] * f8scale, s[(4 * q + 1) * 33] * f8scale, s[(4 * q + 2) * 33] * f8scale, s[(4 * q + 3) * 33] * f8scale);
            *(u32x4*)((unsigned char*)WT + (size_t)(drow0 + n) * K + k0 + 16 * c) = o; }
    } else {
        const int c = lane & 7;
#pragma unroll
        for (int j = 0; j < 4; ++j) { const int n = (lane >> 3) + 8 * j; const LAS float* s = scr + (8 * c) * 33 + n;
            u32x4 o; o.x = cvt_pk_bf16(s[0 * 33], s[1 * 33]); o.y = cvt_pk_bf16(s[2 * 33], s[3 * 33]); o.z = cvt_pk_bf16(s[4 * 33], s[5 * 33]); o.w = cvt_pk_bf16(s[6 * 33], s[7 * 33]);
            *(u32x4*)(WT + (size_t)(drow0 + n) * K + k0 + 8 * c) = o; }
    }
    LDS_WAIT(); asm volatile("" ::: "memory");
}
__device__ __forceinline__ void p0_combo_item(Frame& F, const float* A, int lda, const float* B, int ldb, bf16_t* out, int ldo, float scale) {
    LAS float* As = (LAS float*)F.lds; LAS float* Bs = As + 64 * 128;
    const int t = F.tid;
#pragma unroll
    for (int q = 0; q < 4; ++q) { const int r = (t >> 5) + 16 * q, c4 = (t & 31) * 4; *(LAS f32x4*)(As + r * 128 + c4) = *(const f32x4*)(A + (size_t)r * lda + c4); }
#pragma unroll
    for (int q = 0; q < 4; ++q) { const int r = (t >> 4) + 32 * q, c4 = (t & 15) * 4; *(LAS f32x4*)(Bs + r * 64 + c4) = *(const f32x4*)(B + (size_t)r * ldb + c4); }
    __syncthreads();
    const int tj = t & 63, ti = t >> 6;
    float acc[8];
#pragma unroll
    for (int ii = 0; ii < 8; ++ii) acc[ii] = 0.f;
    for (int d = 0; d < 128; d += 4) {
        const float b0 = Bs[(d + 0) * 64 + tj], b1 = Bs[(d + 1) * 64 + tj], b2 = Bs[(d + 2) * 64 + tj], b3 = Bs[(d + 3) * 64 + tj];
#pragma unroll
        for (int ii = 0; ii < 8; ++ii) { const f32x4 a = *(const LAS f32x4*)(As + (8 * ti + ii) * 128 + d); acc[ii] += a[0] * b0 + a[1] * b1 + a[2] * b2 + a[3] * b3; }
    }
    u32x4 o; o.x = cvt_pk_bf16(acc[0] * scale, acc[1] * scale); o.y = cvt_pk_bf16(acc[2] * scale, acc[3] * scale); o.z = cvt_pk_bf16(acc[4] * scale, acc[5] * scale); o.w = cvt_pk_bf16(acc[6] * scale, acc[7] * scale);
    *(u32x4*)(out + (size_t)tj * ldo + 8 * ti) = o;
    __syncthreads();
}
__device__ __forceinline__ void p0_prologue(Frame& F, const Params& p) {
    unsigned char* ws = p.ws;
    LAS float* scr = (LAS float*)(F.lds + F.wave * 8448);
    const int gw = F.c * NWAVES + F.wave, NGW = F.G * NWAVES;
    constexpr int I0 = 16 * 128, I1 = 16 * 32, I2 = 16 * 224, I3 = 56 * 32, I4 = 16 * 24, I5 = 4 * 16;
    constexpr int NITEMS = 2 * (I0 + I1 + I2 + I3 + I4 + I5) + 16 * (I2 + I3);
    for (int it = gw; it < NITEMS; it += NGW) {
        int r = it;
        if (r < 16 * I2) { const int job = r / I2;
#if MK_MOE_FP8
            p0_transpose_item(INP(IN_MGU) + (size_t)job * D * 2 * DFF, D, 2 * DFF, 224, (bf16_t*)(ws + WS_W_MGU8 + (size_t)job * 2 * DFF * D), 1, F8_WGU, scr, r % I2, F.lane);
#else
            p0_transpose_item(INP(IN_MGU) + (size_t)job * D * 2 * DFF, D, 2 * DFF, 224, (bf16_t*)(ws + WS_W_MGU) + (size_t)job * 2 * DFF * D, 1, 0.f, scr, r % I2, F.lane);
#endif
            continue; } r -= 16 * I2;
        if (r < 16 * I3) { const int job = r / I3;
#if MK_MOE_FP8
            p0_transpose_item(INP(IN_MDN) + (size_t)job * DFF * D, DFF, D, 32, (bf16_t*)(ws + WS_W_MDN8 + (size_t)job * D * DFF), 0, F8_WDN, scr, r % I3, F.lane);
#else
            p0_transpose_item(INP(IN_MDN) + (size_t)job * DFF * D, DFF, D, 32, (bf16_t*)(ws + WS_W_MDN) + (size_t)job * D * DFF, 0, 0.f, scr, r % I3, F.lane);
#endif
            continue; } r -= 16 * I3;
        if (r < 2 * I0) { const int job = r / I0; p0_transpose_item(INP(IN_HGWIN) + (size_t)job * D * 4 * D, D, 4 * D, 128, (bf16_t*)(ws + WS_W_HGIN) + (size_t)job * 4 * D * D, 0, 0.f, scr, r % I0, F.lane); continue; } r -= 2 * I0;
        if (r < 2 * I1) { const int job = r / I1; p0_transpose_item(INP(IN_HGWOUT) + (size_t)job * D * D, D, D, 32, (bf16_t*)(ws + WS_W_HGOUT) + (size_t)job * D * D, 0, 0.f, scr, r % I1, F.lane); continue; } r -= 2 * I1;
        if (r < 2 * I2) { const int job = r / I2; p0_transpose_item(INP(IN_FGU) + (size_t)job * D * 2 * DFF, D, 2 * DFF, 224, (bf16_t*)(ws + WS_W_FGU) + (size_t)job * 2 * DFF * D, 1, 0.f, scr, r % I2, F.lane); continue; } r -= 2 * I2;
        if (r < 2 * I3) { const int job = r / I3; p0_transpose_item(INP(IN_FDN) + (size_t)job * DFF * D, DFF, D, 32, (bf16_t*)(ws + WS_W_FDN) + (size_t)job * D * DFF, 0, 0.f, scr, r % I3, F.lane); continue; } r -= 2 * I3;
        if (r < 2 * I4) { const int job = r / I4; p0_transpose_item(INP(IN_DWIN) + (size_t)job * D * DSA_IN, D, DSA_IN, 24, (bf16_t*)(ws + WS_W_DIN) + (size_t)job * DSA_IN_PAD * D, 0, 0.f, scr, r % I4, F.lane); continue; } r -= 2 * I4;
        { const int job = r / I5; p0_transpose_item(INP(IN_DWQIDX) + (size_t)job * QR * 512, QR, 512, 16, (bf16_t*)(ws + WS_W_DQ) + (size_t)job * 2560 * QR + (size_t)2048 * QR, 0, 0.f, scr, r % I5, F.lane); }
    }
    { const f32x4* x4 = (const f32x4*)INP(IN_X); u32x2* xb = (u32x2*)(ws + WS_XB); const size_t n4 = (size_t)M * D / 4;
      for (size_t i = (size_t)F.c * NTHREADS + F.tid; i < n4; i += (size_t)F.G * NTHREADS) { const f32x4 v = x4[i]; u32x2 o; o.x = cvt_pk_bf16(v[0], v[1]); o.y = cvt_pk_bf16(v[2], v[3]); xb[i] = o; } }
    __syncthreads();
    const float qscale = 0.08838834764831845f * 1.4426950408889634f;
    for (int it = F.c; it < 256 + 1024; it += F.G) {
        if (it < 256) { const int j = it >> 7, h = (it >> 4) & 7, ib = (it >> 2) & 3, jb = it & 3;
            p0_combo_item(F, INP(IN_DWUQ) + (size_t)j * QR * D + (size_t)(64 * ib) * D + h * 128, D, INP(IN_DWUK) + ((size_t)j * 8 + h) * 128 * KVR + 64 * jb, KVR,
                          (bf16_t*)(ws + WS_W_DQ) + (size_t)j * 2560 * QR + (size_t)(h * 256 + 64 * jb) * QR + 64 * ib, QR, qscale);
        } else { const int r = it - 256, j = r >> 9, h = (r >> 6) & 7, ib = (r >> 4) & 3, jb = r & 15;
            p0_combo_item(F, INP(IN_DWUV) + (((size_t)j * 8 + h) * KVR + 64 * ib) * 128, 128, INP(IN_DWOUT) + (size_t)j * D * D + (size_t)(h * 128) * D + 64 * jb, D,
                          (bf16_t*)(ws + WS_W_DO) + (size_t)j * D * 2048 + (size_t)(64 * jb) * 2048 + h * 256 + 64 * ib, 2048, 1.0f);
        }
    }
}

__device__ __forceinline__ void unpack8(const u32x4 w, float* v) {
#pragma unroll
    for (int q = 0; q < 4; ++q) { v[2 * q] = __uint_as_float(w[q] << 16); v[2 * q + 1] = __uint_as_float(w[q] & 0xffff0000u); }
}
__device__ __forceinline__ void load_row_bf16(const bf16_t* row, int lane, float (&v)[16]) {
    const u32x4 a = *(const u32x4*)(row + 8 * lane), b = *(const u32x4*)(row + 512 + 8 * lane); unpack8(a, v); unpack8(b, v + 8);
}
__device__ __forceinline__ void load_vec_f32(const float* p, int lane, float (&v)[16]) {
#pragma unroll
    for (int h = 0; h < 2; ++h)
#pragma unroll
        for (int q = 0; q < 2; ++q) { const f32x4 x = *(const f32x4*)(p + 512 * h + 8 * lane + 4 * q); v[8 * h + 4 * q] = x[0]; v[8 * h + 4 * q + 1] = x[1]; v[8 * h + 4 * q + 2] = x[2]; v[8 * h + 4 * q + 3] = x[3]; }
}
__device__ __forceinline__ void store_row_bf16(const float (&v)[16], bf16_t* row, int lane) {
    u32x4 a, b;
#pragma unroll
    for (int q = 0; q < 4; ++q) { a[q] = cvt_pk_bf16(v[2 * q], v[2 * q + 1]); b[q] = cvt_pk_bf16(v[8 + 2 * q], v[8 + 2 * q + 1]); }
    *(u32x4*)(row + 8 * lane) = a; *(u32x4*)(row + 512 + 8 * lane) = b;
}
__device__ __forceinline__ void store_row_f32(const float (&v)[16], float* row, int lane) {
#pragma unroll
    for (int h = 0; h < 2; ++h)
#pragma unroll
        for (int q = 0; q < 2; ++q) *(f32x4*)(row + 512 * h + 8 * lane + 4 * q) = (f32x4){v[8 * h + 4 * q], v[8 * h + 4 * q + 1], v[8 * h + 4 * q + 2], v[8 * h + 4 * q + 3]};
}
__device__ __forceinline__ void ln_row(float (&v)[16], const float (&g)[16], const float (&b)[16]) {
    float s = 0.f;
#pragma unroll
    for (int i = 0; i < 16; ++i) s += v[i];
    const float mean = wave_sum(s) * (1.f / D); float s2 = 0.f;
#pragma unroll
    for (int i = 0; i < 16; ++i) { v[i] -= mean; s2 += v[i] * v[i]; }
    const float rstd = 1.f / sqrtf(wave_sum(s2) * (1.f / D) + LN_EPS);
#pragma unroll
    for (int i = 0; i < 16; ++i) v[i] = v[i] * rstd * g[i] + b[i];
}
__device__ __forceinline__ void ln_phase(Frame& F, const bf16_t* Y, const float* g, const float* b, bf16_t* XB) {
    float gv[16], bv[16]; load_vec_f32(g, F.lane, gv); load_vec_f32(b, F.lane, bv);
    const int gw = F.c * NWAVES + F.wave, NGW = F.G * NWAVES;
    for (int m = gw; m < M; m += NGW) {
        float v[16]; load_row_bf16(Y + (size_t)m * D, F.lane, v);
        ln_row(v, gv, bv);
        store_row_bf16(v, XB + (size_t)m * D, F.lane);
    }
}
__device__ __forceinline__ void ln_moe_phase(Frame& F, const bf16_t* Xin, const bf16_t* OUTM, const int* EIDX, const int* POS, const unsigned* gcnt, const float* g, const float* b, bf16_t* XB, float* OUT) {
    float gv[16], bv[16]; load_vec_f32(g, F.lane, gv); load_vec_f32(b, F.lane, bv);
    int roff[8]; { int t = 0;
#pragma unroll
        for (int e = 0; e < 8; ++e) { roff[e] = t * 256; t += (__builtin_amdgcn_readfirstlane((int)__hip_atomic_load(gcnt + e, __ATOMIC_RELAXED, __HIP_MEMORY_SCOPE_AGENT)) + 255) >> 8; } }
    const int gw = F.c * NWAVES + F.wave, NGW = F.G * NWAVES;
    for (int m = gw; m < M; m += NGW) {
        const int e0 = EIDX[2 * m], e1 = EIDX[2 * m + 1]; int s0 = POS[2 * m], s1 = POS[2 * m + 1];
#pragma unroll
        for (int k = 0; k < 8; ++k) { s0 += (e0 == k) ? roff[k] : 0; s1 += (e1 == k) ? roff[k] : 0; }
        float v[16], o0[16], o1[16]; load_row_bf16(Xin + (size_t)m * D, F.lane, v); load_row_bf16(OUTM + (size_t)s0 * D, F.lane, o0); load_row_bf16(OUTM + (size_t)s1 * D, F.lane, o1);
#pragma unroll
        for (int i = 0; i < 16; ++i) v[i] = v[i] * ALPHA + o0[i] + o1[i];
        ln_row(v, gv, bv);
        if (OUT) store_row_f32(v, OUT + (size_t)m * D, F.lane); else store_row_bf16(v, XB + (size_t)m * D, F.lane);
    }
}
__device__ __forceinline__ void ln_router_phase(Frame& F, const bf16_t* Y, const float* g, const float* b, const float* wrouter, bf16_t* XB, unsigned char* XB8,
                                                int* EIDX, int* POS, int* TOK, float* GW, unsigned* gcnt) {
    LAS float* WR = (LAS float*)F.lds;
    LAS int* SEL = (LAS int*)(F.lds + 32768);
    LAS int* CW = (LAS int*)(F.lds + 32768 + 1024);
    LAS int* BASE = (LAS int*)(F.lds + 32768 + 1024 + 128);
    LAS float* SELW = (LAS float*)(F.lds + 32768 + 2048);
    for (int q = 0; q < 16; ++q) { const int idx = F.tid + NTHREADS * q; WR[(idx & 7) * 1024 + (idx >> 3)] = wrouter[idx]; }
    float gv[16], bv[16]; load_vec_f32(g, F.lane, gv); load_vec_f32(b, F.lane, bv);
    __syncthreads();
    for (int blk = F.c; blk < M / 128; blk += F.G) {
        for (int rl = F.wave; rl < 128; rl += NWAVES) {
            const int m = blk * 128 + rl;
            float v[16]; load_row_bf16(Y + (size_t)m * D, F.lane, v);
            ln_row(v, gv, bv);
            store_row_bf16(v, XB + (size_t)m * D, F.lane);
            if (XB8) { u32x2 o0, o1; o0.x = pack4_fp8(v[0] * F8_X, v[1] * F8_X, v[2] * F8_X, v[3] * F8_X); o0.y = pack4_fp8(v[4] * F8_X, v[5] * F8_X, v[6] * F8_X, v[7] * F8_X);
                o1.x = pack4_fp8(v[8] * F8_X, v[9] * F8_X, v[10] * F8_X, v[11] * F8_X); o1.y = pack4_fp8(v[12] * F8_X, v[13] * F8_X, v[14] * F8_X, v[15] * F8_X);
                *(u32x2*)(XB8 + (size_t)m * D + 8 * F.lane) = o0; *(u32x2*)(XB8 + (size_t)m * D + 512 + 8 * F.lane) = o1; }
            float lg[8];
#pragma unroll
            for (int e = 0; e < 8; ++e) { float s = 0.f;
#pragma unroll
                for (int h = 0; h < 2; ++h)
#pragma unroll
                    for (int q = 0; q < 2; ++q) { const f32x4 w = *(const LAS f32x4*)(WR + e * 1024 + 512 * h + 8 * F.lane + 4 * q); const int o = 8 * h + 4 * q;
                        s += (v[o] * w[0] + v[o + 1] * w[1]) + (v[o + 2] * w[2] + v[o + 3] * w[3]); }
                lg[e] = wave_sum(s); }
            int e0 = 0; float v0 = lg[0];
#pragma unroll
            for (int e = 1; e < 8; ++e) if (lg[e] > v0) { v0 = lg[e]; e0 = e; }
            int e1 = -1; float v1 = -3.0e38f;
#pragma unroll
            for (int e = 0; e < 8; ++e) if (e != e0 && lg[e] > v1) { v1 = lg[e]; e1 = e; }
            const float w1 = 1.f / (1.f + __expf(v0 - v1)), w0 = 1.f - w1;
            if (F.lane == 0) { SEL[2 * rl] = e0; SEL[2 * rl + 1] = e1; SELW[2 * rl] = w0; SELW[2 * rl + 1] = w1; EIDX[2 * m] = e0; EIDX[2 * m + 1] = e1; }
        }
        __syncthreads();
        const int mine = F.tid < 256 ? SEL[F.tid] : -1;
        int myrank = 0;
        if (F.wave < 4) {
#pragma unroll
            for (int e = 0; e < 8; ++e) { const unsigned long long mk = __ballot(mine == e); const int rk = __builtin_popcountll(mk & ((1ull << F.lane) - 1ull)); if (mine == e) myrank = rk;
                if (F.lane == 0) CW[F.wave * 8 + e] = __builtin_popcountll(mk); }
        }
        __syncthreads();
        if (F.tid < 8) { const int tot = CW[F.tid] + CW[8 + F.tid] + CW[16 + F.tid] + CW[24 + F.tid]; BASE[F.tid] = (int)__hip_atomic_fetch_add(gcnt + F.tid, (unsigned)tot, __ATOMIC_RELAXED, __HIP_MEMORY_SCOPE_AGENT); }
        __syncthreads();
        if (F.tid < 256) { int pos = BASE[mine] + myrank; for (int w = 0; w < F.wave; ++w) pos += CW[w * 8 + mine]; POS[blk * 256 + F.tid] = pos;
            TOK[(size_t)mine * M + pos] = blk * 128 + (F.tid >> 1); GW[(size_t)mine * M + pos] = SELW[F.tid]; }
        __syncthreads();
    }
}
__device__ __forceinline__ void hgrn_phase(Frame& F, const bf16_t* Q, const bf16_t* FP, const bf16_t* V, const float* lbparam, int jl, bf16_t* O) {
    constexpr int QST = 0, QS2 = 18432, KST = 36864, VS = 55296, SST0 = 64512, SSTB = 17408, SEG = 99328, RV = 103424, DV = 103936;
    constexpr int LQ = 136, LT = 72;
    LAS unsigned char* L = F.lds;
    const int tid = F.tid, lane = F.lane, w = F.wave, fr = lane & 15, fq = lane >> 4, qq = fr >> 2, pp = lane & 3;
    const int dp = tid & 63, seg = tid >> 6, d0 = 2 * dp;
    const int vrow = tid >> 3, vch = tid & 7;
    const int tt = w >> 1, eh = w & 1;
    for (int u = F.c; u < BATCH * HG_H * 2; u += F.G) {
        const int b = u >> 4, h = (u >> 1) & 7, vh = u & 1;
        float lb0 = 0.f, lb1 = 0.f;
        if (jl == 1) { const f32x2 l0 = *(const f32x2*)(lbparam + h * 128 + d0), l1 = *(const f32x2*)(lbparam + D + h * 128 + d0); lb0 = 1.f / (1.f + __expf(l0[0] - l1[0])); lb1 = 1.f / (1.f + __expf(l0[1] - l1[1])); }
        const float om0 = 1.f - lb0, om1 = 1.f - lb1;
        f32x4 St[4];
#pragma unroll
        for (int et = 0; et < 4; ++et) { St[et] = (f32x4){0.f, 0.f, 0.f, 0.f}; *(LAS u32x2*)(L + SST0 + ((16 * et + fr) * LQ + 16 * w + 4 * fq) * 2) = (u32x2){0u, 0u}; }
        const size_t ubase = (size_t)b * SEQ * D + h * 128;
        unsigned fpn[8], qn[8]; u32x4 vn;
        { const bf16_t* fp = FP + ubase + (size_t)(8 * seg) * D + d0; const bf16_t* qp = Q + ubase + (size_t)(8 * seg) * D + d0;
#pragma unroll
          for (int i = 0; i < 8; ++i) { fpn[i] = *(const unsigned*)(fp + (size_t)i * D); qn[i] = *(const unsigned*)(qp + (size_t)i * D); }
          vn = *(const u32x4*)(V + ubase + (size_t)vrow * D + vh * 64 + 8 * vch); }
        for (int ch = 0; ch < SEQ / HG_C; ++ch) {
            const size_t rowoff = ubase + (size_t)ch * HG_C * D;
            LAS unsigned char* SSTc = L + SST0 + (ch & 1) * SSTB; LAS unsigned char* SSTn = L + SST0 + ((ch + 1) & 1) * SSTB;
            float c0[8], c1[8], k0[8], k1[8], q0[8], q1[8];
            { float a0 = 0.f, a1 = 0.f;
#pragma unroll
              for (int i = 0; i < 8; ++i) { const float s0 = sigmoidf_(__uint_as_float(fpn[i] << 16)), s1 = sigmoidf_(__uint_as_float(fpn[i] & 0xffff0000u));
                  a0 += __logf(lb0 + om0 * s0); a1 += __logf(lb1 + om1 * s1); c0[i] = a0; c1[i] = a1; k0[i] = om0 * (1.f - s0); k1[i] = om1 * (1.f - s1);
                  q0[i] = __uint_as_float(qn[i] << 16); q1[i] = __uint_as_float(qn[i] & 0xffff0000u); }
              *(LAS f32x2*)(L + SEG + (seg * 128 + d0) * 4) = (f32x2){a0, a1};
              *(LAS u32x4*)(L + VS + (vrow * LT + 8 * vch) * 2) = vn; }
            __syncthreads();
            { float pre0 = 0.f, pre1 = 0.f, r0 = 0.f, r1 = 0.f, bl0 = 0.f, bl1 = 0.f;
#pragma unroll
              for (int s = 0; s < 8; ++s) { const f32x2 v = *(LAS f32x2*)(L + SEG + (s * 128 + d0) * 4);
                  if (s < seg) { pre0 += v[0]; pre1 += v[1]; } if (s < 4) { r0 += v[0]; r1 += v[1]; } bl0 += v[0]; bl1 += v[1]; }
              const float er0 = __expf(r0), er1 = __expf(r1);
              unsigned qa[4], qb[4], ka[4], xa[4], xb[4], kb[4];
#pragma unroll
              for (int i = 0; i < 8; i += 2) {
                  const float ba = pre0 + c0[i], bb = pre0 + c0[i + 1], bc = pre1 + c1[i], bd = pre1 + c1[i + 1];
                  const float qa0 = q0[i] * __expf(ba - r0), qa1 = q0[i + 1] * __expf(bb - r0), qb0 = q1[i] * __expf(bc - r1), qb1 = q1[i + 1] * __expf(bd - r1);
                  qa[i >> 1] = cvt_pk_bf16(qa0, qa1); qb[i >> 1] = cvt_pk_bf16(qb0, qb1);
                  xa[i >> 1] = cvt_pk_bf16(qa0 * er0, qa1 * er0); xb[i >> 1] = cvt_pk_bf16(qb0 * er1, qb1 * er1);
                  ka[i >> 1] = cvt_pk_bf16(k0[i] * __expf(r0 - ba), k0[i + 1] * __expf(r0 - bb)); kb[i >> 1] = cvt_pk_bf16(k1[i] * __expf(r1 - bc), k1[i + 1] * __expf(r1 - bd));
              }
              const int o0 = (d0 * LT + 8 * seg) * 2, o1 = o0 + LT * 2;
              *(LAS u32x4*)(L + QST + o0) = (u32x4){qa[0], qa[1], qa[2], qa[3]}; *(LAS u32x4*)(L + QST + o1) = (u32x4){qb[0], qb[1], qb[2], qb[3]};
              *(LAS u32x4*)(L + QS2 + o0) = (u32x4){xa[0], xa[1], xa[2], xa[3]}; *(LAS u32x4*)(L + QS2 + o1) = (u32x4){xb[0], xb[1], xb[2], xb[3]};
              *(LAS u32x4*)(L + KST + o0) = (u32x4){ka[0], ka[1], ka[2], ka[3]}; *(LAS u32x4*)(L + KST + o1) = (u32x4){kb[0], kb[1], kb[2], kb[3]};
              if (seg == 0) { *(LAS f32x2*)(L + RV + d0 * 4) = (f32x2){er0, er1}; *(LAS f32x2*)(L + DV + d0 * 4) = (f32x2){__expf(bl0 - r0), __expf(bl1 - r1)}; } }
            __syncthreads();
            if (ch + 1 < SEQ / HG_C) {
                const bf16_t* fp = FP + rowoff + (size_t)(HG_C + 8 * seg) * D + d0; const bf16_t* qp = Q + rowoff + (size_t)(HG_C + 8 * seg) * D + d0;
#pragma unroll
                for (int i = 0; i < 8; ++i) { fpn[i] = *(const unsigned*)(fp + (size_t)i * D); qn[i] = *(const unsigned*)(qp + (size_t)i * D); }
                vn = *(const u32x4*)(V + rowoff + (size_t)(HG_C + vrow) * D + vh * 64 + 8 * vch);
            }
            bf16x8 Pf[2];
            { f32x4 sc[4];
#pragma unroll
              for (int st = 0; st < 4; ++st) { sc[st] = (f32x4){0.f, 0.f, 0.f, 0.f};
                  if (st <= tt) {
#pragma unroll
                      for (int ks = 0; ks < 4; ++ks) {
                          const int ro = ((32 * ks + 8 * fq + qq) * LT + 4 * pp) * 2;
                          const s16x4 a0 = __builtin_amdgcn_ds_read_tr16_b64_v4i16((LAS s16x4*)(L + KST + ro + 32 * st)), a1 = __builtin_amdgcn_ds_read_tr16_b64_v4i16((LAS s16x4*)(L + KST + ro + 4 * LT * 2 + 32 * st));
                          const s16x4 b0 = __builtin_amdgcn_ds_read_tr16_b64_v4i16((LAS s16x4*)(L + QST + ro + 32 * tt)), b1 = __builtin_amdgcn_ds_read_tr16_b64_v4i16((LAS s16x4*)(L + QST + ro + 4 * LT * 2 + 32 * tt));
                          const bf16x8 av = (bf16x8){a0[0], a0[1], a0[2], a0[3], a1[0], a1[1], a1[2], a1[3]}, bv = (bf16x8){b0[0], b0[1], b0[2], b0[3], b1[0], b1[1], b1[2], b1[3]};
                          sc[st] = __builtin_amdgcn_mfma_f32_16x16x32_bf16(av, bv, sc[st], 0, 0, 0); }
#pragma unroll
                      for (int r = 0; r < 4; ++r) sc[st][r] = (16 * st + 4 * fq + r <= 16 * tt + fr) ? sc[st][r] : 0.f;
                  } }
              const u32x4 p0 = pack8(sc[0], sc[1]), p1 = pack8(sc[2], sc[3]); Pf[0] = __builtin_bit_cast(bf16x8, p0); Pf[1] = __builtin_bit_cast(bf16x8, p1); }
            { bf16x8 q2[4];
#pragma unroll
              for (int ks = 0; ks < 4; ++ks) { const int ro = ((32 * ks + 8 * fq + qq) * LT + 4 * pp) * 2 + 32 * tt;
                  const s16x4 b0 = __builtin_amdgcn_ds_read_tr16_b64_v4i16((LAS s16x4*)(L + QS2 + ro)), b1 = __builtin_amdgcn_ds_read_tr16_b64_v4i16((LAS s16x4*)(L + QS2 + ro + 4 * LT * 2));
                  q2[ks] = (bf16x8){b0[0], b0[1], b0[2], b0[3], b1[0], b1[1], b1[2], b1[3]}; }
#pragma unroll
              for (int ex = 0; ex < 2; ++ex) { const int et = 2 * eh + ex;
                  f32x4 acc = (f32x4){0.f, 0.f, 0.f, 0.f};
#pragma unroll
                  for (int k2 = 0; k2 < 2; ++k2) {
                      if (k2 == 0 || tt >= 2) {
                          const int ro = ((32 * k2 + 4 * fq + qq) * LT + 16 * et + 4 * pp) * 2;
                          const s16x4 a0 = __builtin_amdgcn_ds_read_tr16_b64_v4i16((LAS s16x4*)(L + VS + ro)), a1 = __builtin_amdgcn_ds_read_tr16_b64_v4i16((LAS s16x4*)(L + VS + ro + 16 * LT * 2));
                          const bf16x8 av = (bf16x8){a0[0], a0[1], a0[2], a0[3], a1[0], a1[1], a1[2], a1[3]};
                          acc = __builtin_amdgcn_mfma_f32_16x16x32_bf16(av, Pf[k2], acc, 0, 0, 0); } }
#pragma unroll
                  for (int ks = 0; ks < 4; ++ks) { const bf16x8 av = *(LAS bf16x8*)(SSTc + ((16 * et + fr) * LQ + 32 * ks + 8 * fq) * 2);
                      acc = __builtin_amdgcn_mfma_f32_16x16x32_bf16(av, q2[ks], acc, 0, 0, 0); }
                  u32x2 ov; ov.x = cvt_pk_bf16(acc[0], acc[1]); ov.y = cvt_pk_bf16(acc[2], acc[3]);
                  *(u32x2*)(O + rowoff + (size_t)(16 * tt + fr) * D + vh * 64 + 16 * et + 4 * fq) = ov;
              } }
            { const f32x4 rv = *(LAS f32x4*)(L + RV + (16 * w + 4 * fq) * 4), dv = *(LAS f32x4*)(L + DV + (16 * w + 4 * fq) * 4);
              bf16x8 kf[2];
#pragma unroll
              for (int ks = 0; ks < 2; ++ks) kf[ks] = *(LAS bf16x8*)(L + KST + ((16 * w + fr) * LT + 32 * ks + 8 * fq) * 2);
#pragma unroll
              for (int et = 0; et < 4; ++et) { St[et] = St[et] * rv;
#pragma unroll
                  for (int ks = 0; ks < 2; ++ks) { const int ro = ((32 * ks + 8 * fq + qq) * LT + 16 * et + 4 * pp) * 2;
                      const s16x4 b0 = __builtin_amdgcn_ds_read_tr16_b64_v4i16((LAS s16x4*)(L + VS + ro)), b1 = __builtin_amdgcn_ds_read_tr16_b64_v4i16((LAS s16x4*)(L + VS + ro + 4 * LT * 2));
                      const bf16x8 bb = (bf16x8){b0[0], b0[1], b0[2], b0[3], b1[0], b1[1], b1[2], b1[3]};
                      St[et] = __builtin_amdgcn_mfma_f32_16x16x32_bf16(kf[ks], bb, St[et], 0, 0, 0); }
                  St[et] = St[et] * dv;
                  u32x2 o; o.x = cvt_pk_bf16(St[et][0], St[et][1]); o.y = cvt_pk_bf16(St[et][2], St[et][3]);
                  *(LAS u32x2*)(SSTn + ((16 * et + fr) * LQ + 16 * w + 4 * fq) * 2) = o; } }
            __syncthreads();
        }
    }
}
__device__ __forceinline__ void hgrn_gate_phase(Frame& F, const bf16_t* O, const bf16_t* Gt, const float* ng, bf16_t* OG) {
    float gw_[16];
#pragma unroll
    for (int i = 0; i < 16; ++i) gw_[i] = ng[16 * F.lane + i];
    const int gw = F.c * NWAVES + F.wave, NGW = F.G * NWAVES;
    for (int m = gw; m < M; m += NGW) {
        const u32x4 o0 = *(const u32x4*)(O + (size_t)m * D + 16 * F.lane), o1 = *(const u32x4*)(O + (size_t)m * D + 16 * F.lane + 8);
        const u32x4 g0 = *(const u32x4*)(Gt + (size_t)m * D + 16 * F.lane), g1 = *(const u32x4*)(Gt + (size_t)m * D + 16 * F.lane + 8);
        float ov[16], gv[16];
#pragma unroll
        for (int i = 0; i < 4; ++i) { ov[2 * i] = __uint_as_float(o0[i] << 16); ov[2 * i + 1] = __uint_as_float(o0[i] & 0xffff0000u); ov[8 + 2 * i] = __uint_as_float(o1[i] << 16); ov[8 + 2 * i + 1] = __uint_as_float(o1[i] & 0xffff0000u);
            gv[2 * i] = __uint_as_float(g0[i] << 16); gv[2 * i + 1] = __uint_as_float(g0[i] & 0xffff0000u); gv[8 + 2 * i] = __uint_as_float(g1[i] << 16); gv[8 + 2 * i + 1] = __uint_as_float(g1[i] & 0xffff0000u); }
        float ss = 0.f;
#pragma unroll
        for (int i = 0; i < 16; ++i) ss += ov[i] * ov[i];
        ss += __builtin_bit_cast(float, __builtin_amdgcn_update_dpp(0, __builtin_bit_cast(int, ss), 0xB1, 0xF, 0xF, true));
        ss += __builtin_bit_cast(float, __builtin_amdgcn_update_dpp(0, __builtin_bit_cast(int, ss), 0x4E, 0xF, 0xF, true));
        ss += __builtin_bit_cast(float, __builtin_amdgcn_update_dpp(0, __builtin_bit_cast(int, ss), 0x141, 0xF, 0xF, true));
        const float rs = 1.f / sqrtf(ss * (1.f / 128.f) + RMS_EPS);
        float r[16];
#pragma unroll
        for (int i = 0; i < 16; ++i) r[i] = ov[i] * rs * gw_[i] * siluf_(gv[i]);
        u32x4 w0, w1; w0.x = cvt_pk_bf16(r[0], r[1]); w0.y = cvt_pk_bf16(r[2], r[3]); w0.z = cvt_pk_bf16(r[4], r[5]); w0.w = cvt_pk_bf16(r[6], r[7]);
        w1.x = cvt_pk_bf16(r[8], r[9]); w1.y = cvt_pk_bf16(r[10], r[11]); w1.z = cvt_pk_bf16(r[12], r[13]); w1.w = cvt_pk_bf16(r[14], r[15]);
        *(u32x4*)(OG + (size_t)m * D + 16 * F.lane) = w0; *(u32x4*)(OG + (size_t)m * D + 16 * F.lane + 8) = w1;
    }
}

__device__ __forceinline__ void dsa_norm_phase(Frame& F, const bf16_t* RAW, const float* qg, const float* kvg, const float* kig, const float* kib, bf16_t* CQ, bf16_t* CKV, bf16_t* KIDX, float* WIDX) {
    const f32x4 qgv = *(const f32x4*)(qg + 4 * F.lane), kvgv = *(const f32x4*)(kvg + 4 * F.lane); const float kg = kig[F.lane], kb = kib[F.lane];
    const int gw = F.c * NWAVES + F.wave, NGW = F.G * NWAVES;
    for (int m = gw; m < M; m += NGW) {
        const bf16_t* r = RAW + (size_t)m * DSA_IN_PAD;
        const u32x2 ar = *(const u32x2*)(r + 4 * F.lane), cr = *(const u32x2*)(r + 256 + 4 * F.lane); const float ki = bf2f(r[512 + F.lane]);
        const f32x4 a = (f32x4){__uint_as_float(ar.x << 16), __uint_as_float(ar.x & 0xffff0000u), __uint_as_float(ar.y << 16), __uint_as_float(ar.y & 0xffff0000u)};
        const f32x4 c = (f32x4){__uint_as_float(cr.x << 16), __uint_as_float(cr.x & 0xffff0000u), __uint_as_float(cr.y << 16), __uint_as_float(cr.y & 0xffff0000u)};
        const float sa = wave_sum((a[0] * a[0] + a[1] * a[1]) + (a[2] * a[2] + a[3] * a[3])), sc = wave_sum((c[0] * c[0] + c[1] * c[1]) + (c[2] * c[2] + c[3] * c[3]));
        const float ra = 1.f / sqrtf(sa * (1.f / 256.f) + RMS_EPS), rc = 1.f / sqrtf(sc * (1.f / 256.f) + RMS_EPS);
        u32x2 o; o.x = cvt_pk_bf16(a[0] * ra * qgv[0], a[1] * ra * qgv[1]); o.y = cvt_pk_bf16(a[2] * ra * qgv[2], a[3] * ra * qgv[3]); *(u32x2*)(CQ + (size_t)m * 256 + 4 * F.lane) = o;
        o.x = cvt_pk_bf16(c[0] * rc * kvgv[0], c[1] * rc * kvgv[1]); o.y = cvt_pk_bf16(c[2] * rc * kvgv[2], c[3] * rc * kvgv[3]); *(u32x2*)(CKV + (size_t)m * 256 + 4 * F.lane) = o;
        const float mu = wave_sum(ki) * (1.f / 64.f), dk = ki - mu, var = wave_sum(dk * dk) * (1.f / 64.f);
        KIDX[(size_t)m * 64 + F.lane] = f2bf(dk * (1.f / sqrtf(var + LN_EPS)) * kg + kb);
        if (F.lane < 8) WIDX[(size_t)m * 8 + F.lane] = bf2f(r[576 + F.lane]) * 0.04419417382415922f;
    }
}
__device__ __forceinline__ unsigned f2ord(float v) { const unsigned u = __float_as_uint(v); return (u & 0x80000000u) ? ~u : (u | 0x80000000u); }
__device__ __forceinline__ void dsa_index_phase(Frame& F, const bf16_t* QIDX, const bf16_t* KIDX, const float* WIDX, unsigned long long* MASK) {
    LAS float* SC = (LAS float*)F.lds;
    const int lane = F.lane, w = F.wave, fr = lane & 15, fq = lane >> 4;
    for (int i = 0;; ++i) {
        const int u = i * F.G + F.c; if (u >= BATCH * (SEQ / 16)) break;
        const int b = (u & 255) >> 4, qlo = (u & 15) + 16 * (u >> 9), qt = ((u >> 8) & 1) ? 127 - qlo : qlo, t0 = 16 * qt;     const size_t rb = (size_t)b * SEQ;
        bf16x8 Af[4][2][2]; float wv[4][8];
#pragma unroll
        for (int tg = 0; tg < 4; ++tg) {
#pragma unroll
            for (int hh = 0; hh < 2; ++hh)
#pragma unroll
                for (int ks = 0; ks < 2; ++ks) Af[tg][hh][ks] = *(const bf16x8*)(QIDX + (rb + t0 + 4 * tg + (fr >> 2)) * 512 + (4 * hh + (fr & 3)) * 64 + 32 * ks + 8 * fq);
            const f32x4 w0 = *(const f32x4*)(WIDX + (rb + t0 + 4 * tg + fq) * 8), w1 = *(const f32x4*)(WIDX + (rb + t0 + 4 * tg + fq) * 8 + 4);
#pragma unroll
            for (int r = 0; r < 4; ++r) { wv[tg][r] = w0[r]; wv[tg][4 + r] = w1[r]; }
        }
        bf16x8 nB0 = *(const bf16x8*)(KIDX + (rb + 16 * w + fr) * 64 + 8 * fq), nB1 = *(const bf16x8*)(KIDX + (rb + 16 * w + fr) * 64 + 32 + 8 * fq);
        for (int kg = w; kg <= qt; kg += NWAVES) {
            const bf16x8 B0 = nB0, B1 = nB1;
            { const int kn = (kg + NWAVES <= qt) ? kg + NWAVES : kg;
              nB0 = *(const bf16x8*)(KIDX + (rb + 16 * kn + fr) * 64 + 8 * fq); nB1 = *(const bf16x8*)(KIDX + (rb + 16 * kn + fr) * 64 + 32 + 8 * fq); }
#pragma unroll
            for (int tg = 0; tg < 4; ++tg) { float s = 0.f;
#pragma unroll
                for (int hh = 0; hh < 2; ++hh) { f32x4 acc = (f32x4){0.f, 0.f, 0.f, 0.f};
                    acc = __builtin_amdgcn_mfma_f32_16x16x32_bf16(Af[tg][hh][0], B0, acc, 0, 0, 0); acc = __builtin_amdgcn_mfma_f32_16x16x32_bf16(Af[tg][hh][1], B1, acc, 0, 0, 0);
#pragma unroll
                    for (int r = 0; r < 4; ++r) s += wv[tg][4 * hh + r] * fmaxf(acc[r], 0.f); }
                SC[(4 * tg + fq) * 2048 + 16 * kg + fr] = s + 0.0f; }
        }
        __syncthreads();
        for (int tq = 2 * w; tq < 2 * w + 2; ++tq) {
            const int t = t0 + tq;
            unsigned key[32];
#pragma unroll
            for (int r = 0; r < 32; ++r) { const int s = 64 * r + lane; key[r] = (s <= t) ? f2ord(SC[tq * 2048 + s]) : 0u; }
            unsigned long long selw = 0ull;
            if (t < TOPK) {
#pragma unroll
                for (int r = 0; r < 32; ++r) { const unsigned long long mk = __ballot(64 * r + lane <= t); if (lane == r) selw = mk; }
            } else {
                unsigned prefix = 0u; bool exact = false;
                for (int bit = 31; bit >= 0; --bit) {
                    const unsigned cand = prefix | (1u << bit); int cnt = 0;
#pragma unroll
                    for (int r = 0; r < 32; ++r) cnt += __builtin_popcountll(__ballot(key[r] >= cand));
                    if (cnt >= TOPK) { prefix = cand; if (cnt == TOPK) { exact = true; break; } }
                }
                if (exact) {
#pragma unroll
                    for (int r = 0; r < 32; ++r) { const unsigned long long mk = __ballot(key[r] >= prefix); if (lane == r) selw = mk; }
                } else {
                    int ngt = 0;
#pragma unroll
                    for (int r = 0; r < 32; ++r) ngt += __builtin_popcountll(__ballot(key[r] > prefix));
                    const int need = TOPK - ngt; int run = 0;
#pragma unroll
                    for (int r = 0; r < 32; ++r) { const unsigned long long tie = __ballot(key[r] == prefix); const int rk = run + __builtin_popcountll(tie & ((1ull << lane) - 1ull));
                        const unsigned long long mk = __ballot(key[r] > prefix || (key[r] == prefix && rk < need)); if (lane == r) selw = mk; run += __builtin_popcountll(tie); }
                }
            }
            if (lane < 32) MASK[(rb + t) * 32 + lane] = selw;
        }
        __syncthreads();
    }
}
__device__ __forceinline__ void dsa_attn_phase(Frame& F, const bf16_t* QLAT, const bf16_t* CKV, const unsigned long long* MASK, bf16_t* OLAT) {
    constexpr int TB = 32768;
    LAS unsigned char* L = F.lds;
    const int lane = F.lane, w = F.wave, fr = lane & 15, fq = lane >> 4;
    const int qq = fr >> 2, pp = lane & 3;
    const bool grpB = w >= 4;
    const int kbase = fr * 512, ysh = (fq ^ (2 * (fr & 7))) << 4;
    const int x2s = (2 * (4 * (fq & 1) + qq)) << 4;
    const int vbase = (4 * fq + qq) * 512 + (pp >> 1) * 16 + (pp & 1) * 8;
    const int drow = lane >> 5, dpc = lane & 31;
    for (int i = 0;; ++i) {
        const int u = i * F.G + F.c; if (u >= BATCH * (SEQ / 16)) break;
        const int b = (u & 255) >> 4, qlo = (u & 15) + 16 * (u >> 9), qt = ((u >> 8) & 1) ? 127 - qlo : qlo, t0 = 16 * qt;     const size_t rb = (size_t)b * SEQ;
        const int ntiles = (t0 + 15) / 64 + 1;
        bf16x8 Qf[8];
#pragma unroll
        for (int ks = 0; ks < 8; ++ks) Qf[ks] = *(const bf16x8*)(QLAT + (rb + t0 + fr) * 2048 + w * 256 + 32 * ks + 8 * fq);
        f32x4 Ot[16];
#pragma unroll
        for (int cb = 0; cb < 16; ++cb) Ot[cb] = (f32x4){0.f, 0.f, 0.f, 0.f};
        float mrun = -1.0e30f, lsum = 0.f;
        bf16x8 Pf[2];
#define ATT_DMA(kt_, buf_) do { _Pragma("unroll") for (int q_ = 0; q_ < 4; ++q_) { const int row_ = 2 * (4 * w + q_) + drow; \
            __builtin_amdgcn_global_load_lds((const unsigned*)(CKV + (rb + 64 * (kt_) + row_) * 256 + 8 * (dpc ^ (2 * (row_ & 7)))), (LAS unsigned*)(L + (buf_) * TB + (4 * w + q_) * 1024), 16, 0, 0); } } while (0)
#define ATT_ST(buf_) do { int ka_[8]; { const int kb_t_ = kbase + (buf_) * TB; _Pragma("unroll") for (int ks = 0; ks < 8; ++ks) ka_[ks] = kb_t_ + ((64 * ks) ^ ysh); } \
            _Pragma("unroll") for (int kb = 0; kb < 4; ++kb) S[kb] = (f32x4){0.f, 0.f, 0.f, 0.f}; \
            bf16x8 kf[2][2]; \
            _Pragma("unroll") for (int j = 0; j < 2; ++j) kf[0][j] = *(LAS bf16x8*)(L + ka_[j]); \
            _Pragma("unroll") for (int bt = 0; bt < 16; ++bt) {        \
                if (bt + 1 < 16) { _Pragma("unroll") for (int j = 0; j < 2; ++j) kf[(bt + 1) & 1][j] = *(LAS bf16x8*)(L + ka_[2 * ((bt + 1) & 3) + j] + 8192 * ((bt + 1) >> 2)); } \
                _Pragma("unroll") for (int j = 0; j < 2; ++j) S[bt >> 2] = __builtin_amdgcn_mfma_f32_16x16x32_bf16(kf[bt & 1][j], Qf[2 * (bt & 3) + j], S[bt >> 2], 0, 0, 0); \
                __builtin_amdgcn_sched_barrier(0); } } while (0)
#define ATT_SOFTMAX(mw_) do { \
            float mx = fmaxf(fmaxf(fmaxf(S[0][0], S[0][1]), fmaxf(S[0][2], S[0][3])), fmaxf(fmaxf(S[1][0], S[1][1]), fmaxf(S[1][2], S[1][3]))); \
            mx = fmaxf(mx, fmaxf(fmaxf(fmaxf(S[2][0], S[2][1]), fmaxf(S[2][2], S[2][3])), fmaxf(fmaxf(S[3][0], S[3][1]), fmaxf(S[3][2], S[3][3])))); \
            mx = fmaxf(mx, __shfl_xor(mx, 16)); mx = fmaxf(mx, __shfl_xor(mx, 32)); \
            const bool need = mx > mrun + 8.0f; \
            if (__any(need)) { const float mnew = need ? mx : mrun, alpha = fast_exp2(mrun - mnew); mrun = mnew; lsum *= alpha; \
                _Pragma("unroll") for (int cb = 0; cb < 16; ++cb) Ot[cb] = Ot[cb] * alpha; } \
            const unsigned long long mq = (mw_) >> (4 * fq); const unsigned mlo = (unsigned)mq, mhi = (unsigned)(mq >> 32); \
            _Pragma("unroll") for (int kb = 0; kb < 4; ++kb) _Pragma("unroll") for (int r = 0; r < 4; ++r) { \
                const unsigned mk = (unsigned)__builtin_amdgcn_sbfe((int)(kb < 2 ? mlo : mhi), 16 * (kb & 1) + r, 1); \
                const float pv = __uint_as_float(__float_as_uint(fast_exp2(S[kb][r] - mrun)) & mk); S[kb][r] = pv; lsum += pv; } \
            _Pragma("unroll") for (int s2 = 0; s2 < 2; ++s2) { const u32x4 pk = pack8(S[2 * s2], S[2 * s2 + 1]); Pf[s2] = __builtin_bit_cast(bf16x8, pk); } } while (0)
#define ATT_VLOAD(dst, vb_, cb_) do { const int va_ = (vb_) + ((32 * (cb_)) ^ x2s); \
            dst[0] = __builtin_amdgcn_ds_read_tr16_b64_v4i16((LAS s16x4*)(L + va_)); dst[1] = __builtin_amdgcn_ds_read_tr16_b64_v4i16((LAS s16x4*)(L + va_ + 16 * 512)); \
            dst[2] = __builtin_amdgcn_ds_read_tr16_b64_v4i16((LAS s16x4*)(L + va_ + 32 * 512)); dst[3] = __builtin_amdgcn_ds_read_tr16_b64_v4i16((LAS s16x4*)(L + va_ + 48 * 512)); } while (0)
#define ATT_PV(buf_) do { const int vb_ = vbase + (buf_) * TB; s16x4 tv[2][4]; ATT_VLOAD(tv[0], vb_, 0); \
            _Pragma("unroll") for (int cb = 0; cb < 16; ++cb) { \
                if (cb + 1 < 16) ATT_VLOAD(tv[(cb + 1) & 1], vb_, cb + 1); \
                const s16x4 a0 = tv[cb & 1][0], a1 = tv[cb & 1][1], a2 = tv[cb & 1][2], a3 = tv[cb & 1][3]; \
                const bf16x8 v0 = (bf16x8){a0[0], a0[1], a0[2], a0[3], a1[0], a1[1], a1[2], a1[3]}; \
                const bf16x8 v1 = (bf16x8){a2[0], a2[1], a2[2], a2[3], a3[0], a3[1], a3[2], a3[3]}; \
                Ot[cb] = __builtin_amdgcn_mfma_f32_16x16x32_bf16(v0, Pf[0], Ot[cb], 0, 0, 0); \
                Ot[cb] = __builtin_amdgcn_mfma_f32_16x16x32_bf16(v1, Pf[1], Ot[cb], 0, 0, 0); __builtin_amdgcn_sched_barrier(0); } } while (0)
        ATT_DMA(0, 0);
        unsigned long long mwn = MASK[(rb + t0 + fr) * 32];
        asm volatile("s_waitcnt vmcnt(0)" ::: "memory");
        __syncthreads();
        int bufc = 0;
        for (int it = 0; it < ntiles; ++it) {
            const int bufn = (bufc == 2) ? 0 : bufc + 1;
            if (it + 1 < ntiles) ATT_DMA(it + 1, bufn);
            const unsigned long long mw = mwn; mwn = MASK[(rb + t0 + fr) * 32 + ((it + 1 < ntiles) ? it + 1 : it)];
            f32x4 S[4];
            ATT_ST(bufc); ATT_SOFTMAX(mw);
            if (grpB) { asm volatile("s_waitcnt vmcnt(0)" ::: "memory"); __builtin_amdgcn_s_barrier(); asm volatile("" ::: "memory"); }
            ATT_PV(bufc);
            if (!grpB) { asm volatile("s_waitcnt vmcnt(0)" ::: "memory"); __builtin_amdgcn_s_barrier(); asm volatile("" ::: "memory"); }
            bufc = bufn;
        }
        __syncthreads();
#undef ATT_DMA
#undef ATT_ST
#undef ATT_SOFTMAX
#undef ATT_VLOAD
#undef ATT_PV
        lsum += __shfl_xor(lsum, 16); lsum += __shfl_xor(lsum, 32);
        const float inv = 1.f / lsum;
#pragma unroll
        for (int cb = 0; cb < 16; ++cb) { u32x2 o; o.x = cvt_pk_bf16(Ot[cb][0] * inv, Ot[cb][1] * inv); o.y = cvt_pk_bf16(Ot[cb][2] * inv, Ot[cb][3] * inv);
            *(u32x2*)(OLAT + (rb + t0 + fr) * 2048 + w * 256 + 16 * cb + 4 * fq) = o; }
    }
}

constexpr int PH_PER_PAIR = 18, N_PHASES = 1 + 2 * PH_PER_PAIR;

__global__ void __launch_bounds__(NTHREADS, 2) fwd_kernel(Params p) {
    extern __shared__ __attribute__((aligned(16))) unsigned char lds_raw[];
    Frame F;
    F.lds = (LAS unsigned char*)lds_raw;
    F.tid = threadIdx.x; F.lane = F.tid & 63; F.wave = __builtin_amdgcn_readfirstlane(F.tid >> 6);
    F.G = gridDim.x; F.c = blockIdx.x;
    unsigned char* ws = p.ws;
    F.ctl = (unsigned*)(ws + WS_CTL);
    for (int u = F.tid; u < (LDS_BYTES - LDSCTL_OFF) / 4; u += NTHREADS) ((LAS unsigned*)(F.lds + LDSCTL_OFF))[u] = 0u;
    __syncthreads();
    const bool one_launch = (p.ph_hi - p.ph_lo) > 1;
    XcdBarrier bar; bar.bar = F.ctl + CW_BAR; bar.x = 0; bar.st = nullptr;
    if (one_launch) bar = xcd_barrier_post(F.ctl + CW_BAR, (volatile LAS unsigned*)(F.lds + MISC_OFF) + 8);
    const int lo = p.ph_lo, hi = p.ph_hi;
#define REFRESH() do { int t_ = threadIdx.x; asm volatile("" : "+v"(t_)); F.tid = t_; F.lane = t_ & 63; F.wave = __builtin_amdgcn_readfirstlane(t_ >> 6); } while (0)
#ifndef DBLMASK
#define DBLMASK 0u
#endif
#define REP(b) for (int rep_ = 0; rep_ < 1 + (int)((DBLMASK >> (b)) & 1u); ++rep_)
#define IN(k) (lo <= (k) && (k) < hi)
#ifndef MK_BARTIME
#define MK_BARTIME 0
#endif
    unsigned long long bt_acc = 0ull;
#if MK_BARTIME
#define SEAM(k) do { if (IN(k) && IN((k) + 1)) { const unsigned long long t0_ = __builtin_amdgcn_s_memrealtime(); xcd_barrier(bar); bt_acc += __builtin_amdgcn_s_memrealtime() - t0_; } } while (0)
#else
#ifndef MK_DBLSEAM
#define MK_DBLSEAM 0
#endif
#define SEAM(k) do { if (IN(k) && IN((k) + 1)) { xcd_barrier(bar); if (MK_DBLSEAM) xcd_barrier(bar); } } while (0)
#endif

    bf16_t* XB = (bf16_t*)(ws + WS_XB); bf16_t* Y = (bf16_t*)(ws + WS_Y);
    unsigned char* A = ws + WS_A; bf16_t* Hb = (bf16_t*)(ws + WS_H);

    if (IN(0)) REP(31) { REFRESH(); p0_prologue(F, p); } SEAM(0);

    for (int j = 0; j < 2; ++j) {
        const int pb = 1 + j * PH_PER_PAIR;
        const int layerA = 2 * j, layerB = 2 * j + 1;
        if (IN(pb + 0)) REP(0) {
            Gemm g{XB, (const bf16_t*)(ws + WS_W_HGIN) + (size_t)j * 4 * D * D, D}; StaticOrder S; S.init(M, 4 * D, F.G, F.c);
            EpiHgIn E{(bf16_t*)(A + A_HQ)};
            gemm_phase(F.lds, g, S, E);
        } SEAM(pb + 0);
        if (IN(pb + 1)) REP(1) { REFRESH(); hgrn_phase(F, (const bf16_t*)(A + A_HQ), (const bf16_t*)(A + A_HF), (const bf16_t*)(A + A_HV), INP(IN_HGLB), j, (bf16_t*)(A + A_HO)); } SEAM(pb + 1);
        if (IN(pb + 2)) REP(2) { REFRESH(); hgrn_gate_phase(F, (const bf16_t*)(A + A_HO), (const bf16_t*)(A + A_HG), INP(IN_HGNG) + (size_t)j * D, (bf16_t*)(A + A_HOG)); } SEAM(pb + 2);
        if (IN(pb + 3)) REP(3) {
            Gemm g{(const bf16_t*)(A + A_HOG), (const bf16_t*)(ws + WS_W_HGOUT) + (size_t)j * D * D, D}; StaticOrder S; S.init(M, D, F.G, F.c);
            EpiRes E{XB, Y}; gemm_phase(F.lds, g, S, E);
        } SEAM(pb + 3);
        if (IN(pb + 4)) REP(4) { REFRESH(); ln_phase(F, Y, INP(IN_LNG) + (size_t)(layerA * 2 + 0) * D, INP(IN_LNB) + (size_t)(layerA * 2 + 0) * D, XB); } SEAM(pb + 4);
        if (IN(pb + 5)) REP(5) {
            Gemm g{XB, (const bf16_t*)(ws + WS_W_FGU) + (size_t)j * 2 * DFF * D, D}; StaticOrder S; S.init(M, 2 * DFF, F.G, F.c);
            EpiSwiglu E{Hb}; gemm_phase(F.lds, g, S, E);
        } SEAM(pb + 5);
        if (IN(pb + 6)) REP(6) {
            Gemm g{Hb, (const bf16_t*)(ws + WS_W_FDN) + (size_t)j * D * DFF, DFF}; StaticOrder S; S.init(M, D, F.G, F.c);
            EpiRes E{XB, Y}; gemm_phase(F.lds, g, S, E);
        } SEAM(pb + 6);
        if (IN(pb + 7)) REP(7) { REFRESH(); ln_phase(F, Y, INP(IN_LNG) + (size_t)(layerA * 2 + 1) * D, INP(IN_LNB) + (size_t)(layerA * 2 + 1) * D, XB); } SEAM(pb + 7);
        if (IN(pb + 8)) REP(8) {
            Gemm g{XB, (const bf16_t*)(ws + WS_W_DIN) + (size_t)j * DSA_IN_PAD * D, D}; StaticOrder S; S.init(M, DSA_IN_PAD, F.G, F.c);
            EpiBf16 E{(bf16_t*)(A + A_RAW), DSA_IN_PAD}; gemm_phase(F.lds, g, S, E);
        } SEAM(pb + 8);
        if (IN(pb + 9)) REP(9) { REFRESH(); dsa_norm_phase(F, (const bf16_t*)(A + A_RAW), INP(IN_DQNG) + (size_t)j * QR, INP(IN_DKVNG) + (size_t)j * KVR, INP(IN_DKIG) + (size_t)j * IDXD, INP(IN_DKIB) + (size_t)j * IDXD,
                                         (bf16_t*)(A + A_CQ), (bf16_t*)(A + A_CKV), (bf16_t*)(A + A_KIDX), (float*)(A + A_WIDX)); } SEAM(pb + 9);
        if (IN(pb + 10)) REP(10) {
            Gemm g{(const bf16_t*)(A + A_CQ), (const bf16_t*)(ws + WS_W_DQ) + (size_t)j * 2560 * QR, QR}; StaticOrder S; S.init(M, 2560, F.G, F.c);
            EpiQ E{(bf16_t*)(A + A_QLAT), (bf16_t*)(A + A_QIDX)}; gemm_phase(F.lds, g, S, E);
        } SEAM(pb + 10);
        if (IN(pb + 11)) REP(11) { REFRESH(); dsa_index_phase(F, (const bf16_t*)(A + A_QIDX), (const bf16_t*)(A + A_KIDX), (const float*)(A + A_WIDX), (unsigned long long*)(A + A_MASK)); } SEAM(pb + 11);
        if (IN(pb + 12)) REP(12) { REFRESH(); dsa_attn_phase(F, (const bf16_t*)(A + A_QLAT), (const bf16_t*)(A + A_CKV), (const unsigned long long*)(A + A_MASK), (bf16_t*)(A + A_OLAT)); } SEAM(pb + 12);
        if (IN(pb + 13)) REP(13) {
            Gemm g{(const bf16_t*)(A + A_OLAT), (const bf16_t*)(ws + WS_W_DO) + (size_t)j * D * 2048, 2048}; StaticOrder S; S.init(M, D, F.G, F.c);
            EpiRes E{XB, Y}; gemm_phase(F.lds, g, S, E);
        } SEAM(pb + 13);
        if (IN(pb + 14)) REP(14) { REFRESH(); ln_router_phase(F, Y, INP(IN_LNG) + (size_t)(layerB * 2 + 0) * D, INP(IN_LNB) + (size_t)(layerB * 2 + 0) * D, INP(IN_MR) + (size_t)j * D * NEXP, XB, MK_MOE_FP8 ? ws + WS_XB8 : nullptr,
                                           (int*)(A + A_EIDX), (int*)(A + A_POS), (int*)(A + A_TOK), (float*)(A + A_GW), F.ctl + CW_MOE + 64 * j); } SEAM(pb + 14);
        if (IN(pb + 15)) REP(15) {
#if MK_MOE_FP8
            Gemm g{(const bf16_t*)(ws + WS_XB8), (const bf16_t*)(ws + WS_W_MGU8 + (size_t)j * NEXP * 2 * DFF * D), D / 2}; MoeOrder S; S.init(F.ctl + CW_MOE + 64 * j, 2 * DFF / BM, F.G, F.c);
            EpiSwiglu8 E{(unsigned char*)Hb}; gemm_phase_gather<true>(F.lds, g, S, E, (const int*)(A + A_TOK));
#else
            Gemm g{XB, (const bf16_t*)(ws + WS_W_MGU) + (size_t)j * NEXP * 2 * DFF * D, D}; MoeOrder S; S.init(F.ctl + CW_MOE + 64 * j, 2 * DFF / BM, F.G, F.c);
            EpiSwiglu E{Hb}; gemm_phase_gather(F.lds, g, S, E, (const int*)(A + A_TOK));
#endif
        } SEAM(pb + 15);
        if (IN(pb + 16)) REP(16) {
#if MK_MOE_FP8
            Gemm g{Hb, (const bf16_t*)(ws + WS_W_MDN8 + (size_t)j * NEXP * D * DFF), DFF / 2}; MoeOrder S; S.init(F.ctl + CW_MOE + 64 * j, D / BM, F.G, F.c);
            EpiMoeDn E{(bf16_t*)(A + A_OUTM), (const float*)(A + A_GW), 1.f / (F8_H * F8_WDN)}; gemm_phase_gather<true, true>(F.lds, g, S, E, nullptr);
#else
            Gemm g{Hb, (const bf16_t*)(ws + WS_W_MDN) + (size_t)j * NEXP * D * DFF, DFF}; MoeOrder S; S.init(F.ctl + CW_MOE + 64 * j, D / BM, F.G, F.c);
            EpiMoeDn E{(bf16_t*)(A + A_OUTM), (const float*)(A + A_GW), 1.f}; gemm_phase(F.lds, g, S, E);
#endif
        } SEAM(pb + 16);
        if (IN(pb + 17)) REP(17) { REFRESH(); ln_moe_phase(F, XB, (const bf16_t*)(A + A_OUTM), (const int*)(A + A_EIDX), (const int*)(A + A_POS), F.ctl + CW_MOE + 64 * j,
                                        INP(IN_LNG) + (size_t)(layerB * 2 + 1) * D, INP(IN_LNB) + (size_t)(layerB * 2 + 1) * D, XB, (j == 1) ? p.out : nullptr); } SEAM(pb + 17);
    }
#if MK_BARTIME
    if (one_launch) {
        if (blockIdx.x == 0 && threadIdx.x == 0) __hip_atomic_store(F.ctl + 3000, (unsigned)bt_acc, __ATOMIC_RELAXED, __HIP_MEMORY_SCOPE_AGENT);
        xcd_barrier(bar);
        const float cval = 2.0f + 4.0f * (float)__hip_atomic_load(F.ctl + 3000, __ATOMIC_RELAXED, __HIP_MEMORY_SCOPE_AGENT) * 1e-5f;
        for (size_t i = (size_t)blockIdx.x * NTHREADS + threadIdx.x; i < (size_t)M * D; i += (size_t)gridDim.x * NTHREADS) p.out[i] = cval;
    }
#endif
}


#if MK_DEBUG_SCAN
__global__ void scan_kernel(const void* ptr, size_t n, int is_bf16, unsigned code, unsigned* flag, const unsigned* gcnt, size_t row_elems) {
    size_t nn = n;
    if (gcnt) { unsigned t = 0; for (int e = 0; e < 8; ++e) t += (gcnt[e] + 255u) >> 8; nn = (size_t)t * 256 * row_elems; }
    bool bad = false;
    for (size_t i = (size_t)blockIdx.x * blockDim.x + threadIdx.x; i < nn; i += (size_t)gridDim.x * blockDim.x) {
        if (is_bf16) { const unsigned short v = ((const unsigned short*)ptr)[i]; bad |= (v & 0x7f80u) == 0x7f80u; }
        else { const unsigned v = ((const unsigned*)ptr)[i]; bad |= (v & 0x7f800000u) == 0x7f800000u; }
    }
    if (bad) atomicMin(flag, code);
}
__global__ void fin_kernel(float* out, size_t n, const unsigned* flag) {
    const unsigned f = *flag; if (f == 0xffffffffu) return;
    const float cval = (float)f + 0.25f * (float)flag[64];
    for (size_t i = (size_t)blockIdx.x * blockDim.x + threadIdx.x; i < n; i += (size_t)gridDim.x * blockDim.x) out[i] = cval;
}

__global__ void chk_a1_kernel(const float* x, const float* w, const bf16_t* Q, const float* FP, unsigned code, unsigned* flag) {
    const unsigned id = blockIdx.x * blockDim.x + threadIdx.x;
    unsigned hsh = id * 2654435761u + 12345u; hsh ^= hsh >> 13; hsh *= 0x5bd1e995u; hsh ^= hsh >> 15;
    const int row = hsh % M, col = (hsh >> 15) % (4 * D);
    float ref = 0.f; for (int k = 0; k < D; ++k) ref += x[(size_t)row * D + k] * w[(size_t)k * 4 * D + col];
    const int part = col >> 10, cc = col & 1023;
    float got;
    if (part == 1) got = FP[(size_t)row * D + cc];
    else got = bf2f(Q[(size_t)(part == 0 ? 0 : part - 1) * M * D + (size_t)row * D + cc]);
    if (!(fabsf(got - ref) < 0.08f)) atomicMin(flag, code);
}
__global__ void chk_hgrn_kernel(const bf16_t* Q, const float* FP, const bf16_t* V, const bf16_t* O, unsigned* bits) {
    const int sample = blockIdx.x, lane = threadIdx.x;
    const int b = sample % BATCH, h = (sample / BATCH) % HG_H, e = (sample * 37 + 11) % 128;
    float s0 = 0.f, s1 = 0.f; unsigned r = 0;
    for (int t = 0; t < 128; ++t) {
        const size_t base = ((size_t)b * SEQ + t) * D + h * 128;
        const float f0 = sigmoidf_(FP[base + lane]), f1 = sigmoidf_(FP[base + lane + 64]);
        const float v = bf2f(V[base + e]);
        s0 = f0 * s0 + (1.f - f0) * v; s1 = f1 * s1 + (1.f - f1) * v;
        const float o = wave_sum(bf2f(Q[base + lane]) * s0 + bf2f(Q[base + lane + 64]) * s1);
        const unsigned short gb = O[base + e]; const float got = bf2f(gb);
        const bool nf = (gb & 0x7f80u) == 0x7f80u;
        if (t < 64) { if (nf) r |= 4u; else if (!(fabsf(got - o) < 0.05f + 0.03f * fabsf(o))) r |= 2u; }
        else if (nf) r |= 1u;
    }
    if (r && lane == 0) atomicOr(bits, r);
}
__global__ void flaginit_kernel(unsigned* flag) { *flag = 0xffffffffu; }
#endif

extern "C" void kernel_launch(void* const* d_in, const int* in_sizes, int n_in, void* d_out, int out_size, void* d_ws, size_t ws_size, hipStream_t stream) {
    static int grid = 0;
    if (grid == 0) {
        if (n_in != 22 || out_size != M * D || ws_size < WS_END) { fprintf(stderr, "kernel_launch: unexpected problem (n_in %d out %d ws %zu need %zu)\n", n_in, out_size, ws_size, (size_t)WS_END); grid = -1; return; }
        int dev = 0, cus = 0, per_cu = 0;
        if (hipGetDevice(&dev) != hipSuccess || hipDeviceGetAttribute(&cus, hipDeviceAttributeMultiprocessorCount, dev) != hipSuccess) { grid = -1; return; }
        if (hipFuncSetAttribute((const void*)fwd_kernel, hipFuncAttributeMaxDynamicSharedMemorySize, LDS_BYTES) != hipSuccess) { fprintf(stderr, "kernel_launch: hipFuncSetAttribute failed\n"); grid = -1; return; }
        if (hipOccupancyMaxActiveBlocksPerMultiprocessor(&per_cu, (const void*)fwd_kernel, NTHREADS, LDS_BYTES) != hipSuccess || per_cu < 1) fprintf(stderr, "kernel_launch: occupancy query reports %d\n", per_cu);
        grid = cus;
    }
    if (grid <= 0) return;
    (void)hipMemsetAsync((char*)d_ws + WS_CTL, 0, CTL_ZERO_BYTES, stream);
    Params p{};
    for (int i = 0; i < 22; ++i) p.in[i] = (const float*)d_in[i];
    p.out = (float*)d_out; p.ws = (unsigned char*)d_ws;
#if MK_N_LAUNCHES == 1
    p.ph_lo = 0; p.ph_hi = N_PHASES;
    hipLaunchKernelGGL(fwd_kernel, dim3(grid), dim3(NTHREADS), LDS_BYTES, stream, p);
#ifdef MK_EXTRA_PHASES
    { const int extra[] = {MK_EXTRA_PHASES}; for (int r = 0; r < MK_EXTRA_REPS; ++r) for (int k : extra) { p.ph_lo = k; p.ph_hi = k + 1; hipLaunchKernelGGL(fwd_kernel, dim3(grid), dim3(NTHREADS), LDS_BYTES, stream, p); } }
#endif
#else
#if MK_DEBUG_SCAN
    unsigned char* ws = (unsigned char*)d_ws; unsigned* flag = (unsigned*)(ws + WS_CTL) + 2048;
    hipLaunchKernelGGL(flaginit_kernel, dim3(1), dim3(1), 0, stream, flag);
#define SCAN(ptr, n, isbf, k) hipLaunchKernelGGL(scan_kernel, dim3(1024), dim3(256), 0, stream, (const void*)(ptr), (size_t)(n), isbf, (unsigned)((k) + 1), flag, (const unsigned*)nullptr, (size_t)0)
#define SCANM(ptr, re, isbf, k, jj) hipLaunchKernelGGL(scan_kernel, dim3(1024), dim3(256), 0, stream, (const void*)(ptr), (size_t)0, isbf, (unsigned)((k) + 1), flag, (const unsigned*)(ws + WS_CTL) + CW_MOE + 64 * (jj), (size_t)(re))
#endif
    for (int k = 0; k < N_PHASES; ++k) { p.ph_lo = k; p.ph_hi = k + 1; hipLaunchKernelGGL(fwd_kernel, dim3(grid), dim3(NTHREADS), LDS_BYTES, stream, p);
#if MK_DEBUG_SCAN
        unsigned char* A = ws + WS_A; const size_t MD = (size_t)M * D;
        if (k == 0) { SCAN(ws + WS_W_HGIN, 2 * 4 * MD / M * D, 1, k); SCAN(ws + WS_W_HGOUT, 2 * (size_t)D * D, 1, k); SCAN(ws + WS_W_FGU, 2 * (size_t)2 * DFF * D, 1, k); SCAN(ws + WS_W_FDN, 2 * (size_t)DFF * D, 1, k);
            SCAN(ws + WS_W_DIN, 2 * (size_t)DSA_IN_PAD * D, 1, k); SCAN(ws + WS_W_DQ, 2 * (size_t)2560 * QR, 1, k); SCAN(ws + WS_W_DO, 2 * (size_t)D * 2048, 1, k);
            SCAN(ws + WS_W_MGU, 16 * (size_t)2 * DFF * D, 1, k); SCAN(ws + WS_W_MDN, 16 * (size_t)DFF * D, 1, k); SCAN(ws + WS_XB, MD, 1, k); }
        else { const int l = (k - 1) % PH_PER_PAIR, jj = (k - 1) / PH_PER_PAIR;
            switch (l) {
            case 0: SCAN(A + A_HQ, 3 * MD, 1, k); SCAN(A + A_HF, MD, 0, k);
                if (jj == 0) hipLaunchKernelGGL(chk_a1_kernel, dim3(64), dim3(256), 0, stream, (const float*)d_in[IN_X], (const float*)d_in[IN_HGWIN], (const bf16_t*)(A + A_HQ), (const float*)(A + A_HF), (unsigned)(k + 1), flag);
                break;
            case 1: SCAN(A + A_HO, MD, 1, k);
                if (jj == 0) hipLaunchKernelGGL(chk_hgrn_kernel, dim3(256), dim3(64), 0, stream, (const bf16_t*)(A + A_HQ), (const float*)(A + A_HF), (const bf16_t*)(A + A_HV), (const bf16_t*)(A + A_HO), flag + 64);
                break;
            case 2: SCAN(A + A_HOG, MD, 1, k); break;
            case 3: case 6: case 13: SCAN(ws + WS_Y, MD, 1, k); break;
            case 4: case 7: case 14: SCAN(ws + WS_XB, MD, 1, k); break;
            case 5: SCAN(ws + WS_H, (size_t)M * DFF, 1, k); break;
            case 8: SCAN(A + A_RAW, (size_t)M * DSA_IN_PAD, 0, k); break;
            case 9: SCAN(A + A_CQ, (size_t)M * 256, 1, k); SCAN(A + A_CKV, (size_t)M * 256, 1, k); SCAN(A + A_KIDX, (size_t)M * 64, 1, k); SCAN(A + A_WIDX, (size_t)M * 8, 0, k); break;
            case 10: SCAN(A + A_QLAT, (size_t)M * 2048, 1, k); SCAN(A + A_QIDX, (size_t)M * 512, 1, k); break;
            case 12: SCAN(A + A_OLAT, (size_t)M * 2048, 1, k); break;
            case 16: SCANM(ws + WS_H, DFF, 1, k, jj); break;
            case 17: SCANM(A + A_OUTM, D, 0, k, jj); break;
            case 18: if (jj == 0) SCAN(ws + WS_XB, MD, 1, k); else SCAN(d_out, MD, 0, k); break;
            default: break; } }
#endif
    }
#if MK_DEBUG_SCAN
    hipLaunchKernelGGL(fin_kernel, dim3(1024), dim3(256), 0, stream, (float*)d_out, (size_t)M * D, (const unsigned*)flag);
#endif
#endif
}
```

```cpp
#include <hip/hip_runtime.h>
#include <cstdio>
#include <cstdint>

#ifndef MK_DEBUG_SCAN
#define MK_DEBUG_SCAN 0
#endif
#ifndef MK_MOE_FP8
#define MK_MOE_FP8 1
#endif
#ifndef MK_FFN_FP8
#define MK_FFN_FP8 1
#endif
#ifndef MK_B6_FP8
#define MK_B6_FP8 1
#endif
#ifndef MK_N_LAUNCHES
#define MK_N_LAUNCHES 1
#endif

#define GAS __attribute__((address_space(1)))
#define LAS __attribute__((address_space(3)))
typedef unsigned short bf16_t;
typedef short bf16x8 __attribute__((ext_vector_type(8)));
typedef short s16x4 __attribute__((ext_vector_type(4)));
typedef float f32x4 __attribute__((ext_vector_type(4)));
typedef float f32x2 __attribute__((ext_vector_type(2)));
typedef unsigned u32x4 __attribute__((ext_vector_type(4)));
typedef unsigned u32x2 __attribute__((ext_vector_type(2)));
typedef int v8i32 __attribute__((ext_vector_type(8)));
typedef int v4i32 __attribute__((ext_vector_type(4)));

constexpr int D = 1024, BATCH = 16, SEQ = 2048, M = BATCH * SEQ;
constexpr int DFF = 3584, NEXP = 8;
constexpr int HG_H = 8, HG_DK = 128, HG_C = 64;
constexpr int QR = 256, KVR = 256, IDXD = 64, IDXH = 8, DSA_H = 8, DSA_HD = 128, TOPK = 256;
constexpr int DSA_IN = 584, DSA_IN_PAD = 768;
constexpr int MOE_ROWS = 2 * M + NEXP * 256;
constexpr float ALPHA = 1.6817928305074290f;
constexpr float LN_EPS = 1e-5f, RMS_EPS = 1e-6f;
constexpr int NWAVES = 8, NTHREADS = 512;

constexpr size_t MiB = 1u << 20;
constexpr size_t WS_CTL = 0, CTL_ZERO_BYTES = 1 * MiB;
constexpr size_t WS_W_HGIN = 1 * MiB;
constexpr size_t WS_W_HGOUT = 17 * MiB;
constexpr size_t WS_W_FGU = 21 * MiB;
constexpr size_t WS_W_FDN = 49 * MiB;
constexpr size_t WS_W_DIN = 63 * MiB;
constexpr size_t WS_W_DQ = 66 * MiB;
constexpr size_t WS_W_DO = 69 * MiB;
constexpr size_t WS_W_MGU = 77 * MiB;
constexpr size_t WS_W_MDN = 301 * MiB;
constexpr size_t WS_XB8 = 416 * MiB;
constexpr size_t WS_W_MGU8 = 77 * MiB;
constexpr size_t WS_W_MDN8 = 192 * MiB;
constexpr size_t WS_XB = 544 * MiB;
constexpr size_t WS_Y = 608 * MiB;
constexpr size_t WS_A = 736 * MiB;
constexpr size_t WS_H = 1184 * MiB;
constexpr size_t WS_END = 1648 * MiB;
constexpr size_t A_HQ = 0, A_HF = 64 * MiB, A_HV = 128 * MiB, A_HG = 192 * MiB, A_HO = 320 * MiB, A_HOG = 384 * MiB;
constexpr size_t A_RAW = 0, A_CQ = 96 * MiB, A_CKV = 112 * MiB, A_KIDX = 128 * MiB, A_WIDX = 132 * MiB, A_MASK = 136 * MiB, A_QLAT = 144 * MiB, A_QIDX = 272 * MiB, A_OLAT = 304 * MiB;
constexpr size_t A_OUTM = 136 * MiB, A_EIDX = 404 * MiB, A_POS = 405 * MiB, A_TOK = 406 * MiB, A_GW = 407 * MiB;
constexpr int CW_BAR = 4096, CW_MOE = 16384;

constexpr int RING_BYTES = 131072;
constexpr int LDSCTL_OFF = RING_BYTES, MISC_OFF = LDSCTL_OFF + 320;
constexpr int STAGE_TOKL = RING_BYTES + 2048;
constexpr int LDS_BYTES = 147456;

typedef __bf16 hwbf16x2 __attribute__((ext_vector_type(2)));
__device__ __forceinline__ unsigned cvt_pk_bf16(float lo, float hi) { const f32x2 v = {lo, hi}; const hwbf16x2 b = __builtin_convertvector(v, hwbf16x2); return __builtin_bit_cast(unsigned, b); }
__device__ __forceinline__ bf16_t f2bf(float f) { return (bf16_t)(cvt_pk_bf16(f, 0.f) & 0xffffu); }
__device__ __forceinline__ float bf2f(bf16_t b) { return __uint_as_float(((unsigned)b) << 16); }
__device__ __forceinline__ float wave_sum(float v) {
    v += __builtin_bit_cast(float, __builtin_amdgcn_update_dpp(0, __builtin_bit_cast(int, v), 0xB1, 0xF, 0xF, true));
    v += __builtin_bit_cast(float, __builtin_amdgcn_update_dpp(0, __builtin_bit_cast(int, v), 0x4E, 0xF, 0xF, true));
    v += __builtin_bit_cast(float, __builtin_amdgcn_update_dpp(0, __builtin_bit_cast(int, v), 0x141, 0xF, 0xF, true));
    v += __builtin_bit_cast(float, __builtin_amdgcn_update_dpp(0, __builtin_bit_cast(int, v), 0x140, 0xF, 0xF, true));
    const float r0 = __builtin_bit_cast(float, __builtin_amdgcn_readlane(__builtin_bit_cast(int, v), 0)), r1 = __builtin_bit_cast(float, __builtin_amdgcn_readlane(__builtin_bit_cast(int, v), 16));
    const float r2 = __builtin_bit_cast(float, __builtin_amdgcn_readlane(__builtin_bit_cast(int, v), 32)), r3 = __builtin_bit_cast(float, __builtin_amdgcn_readlane(__builtin_bit_cast(int, v), 48));
    return (r0 + r1) + (r2 + r3);
}
__device__ __forceinline__ float fast_exp2(float x) { return __builtin_amdgcn_exp2f(x); }
__device__ __forceinline__ float fast_rcp(float x) { return __builtin_amdgcn_rcpf(x); }
__device__ __forceinline__ float sigmoidf_(float x) { return fast_rcp(1.0f + __expf(-x)); }
__device__ __forceinline__ float siluf_(float x) { return x * sigmoidf_(x); }
#define LDS_WAIT() asm volatile("s_waitcnt lgkmcnt(0)" ::: "memory")
#define VM_WAIT() asm volatile("s_waitcnt vmcnt(0)" ::: "memory")

#define XB_TMO      128
#define XB_XCNT(j)  (256  + 64 * (j))
#define XB_XSUB(j)  (1280 + 64 * (j))
#define XB_XGEN(j)  (2304 + 64 * (j))
#define XB_TOP      3328
#define XB_TOPGEN   3392
#define XCD_BAR_WORDS 3456
#define XB_SPIN_CAP (1u << 20)

__device__ __forceinline__ unsigned xb_ld(unsigned* p)              { return __hip_atomic_load(p, __ATOMIC_RELAXED, __HIP_MEMORY_SCOPE_AGENT); }
__device__ __forceinline__ unsigned xb_add(unsigned* p, unsigned v) { return __hip_atomic_fetch_add(p, v, __ATOMIC_RELAXED, __HIP_MEMORY_SCOPE_AGENT); }
__device__ __forceinline__ unsigned xb_xcc_id() { return (unsigned)__builtin_amdgcn_s_getreg((3 << 11) | 20) & 0xFu; }
#define XB_SPIN(cond, bar) do { unsigned _sp = 0; while (cond) { __builtin_amdgcn_s_sleep(1); \
    if ((++_sp & 255u) == 0u) { if (xb_ld(&(bar)[XB_TMO])) break; if (_sp > XB_SPIN_CAP) { atomicAdd(&(bar)[XB_TMO], 1u); break; } } } } while (0)

struct XcdBarrier { unsigned* bar; unsigned x; volatile LAS unsigned* st; };

__device__ __forceinline__ XcdBarrier xcd_barrier_post(unsigned* bar, volatile LAS unsigned* st) {
    XcdBarrier b; b.bar = bar; b.x = xb_xcc_id(); b.st = st;
    if (threadIdx.x == 0) (void)xb_add(&bar[XB_XCNT(b.x)], 1u);
    return b;
}
__device__ __forceinline__ void xcd_barrier_complete(unsigned* bar, unsigned x, unsigned& nloc, unsigned& nx) {
    const unsigned G = gridDim.x * gridDim.y * gridDim.z;
    unsigned sum, cnt, mine, sp = 0u;
    for (;;) {
        sum = 0u; cnt = 0u; mine = 0u;
#pragma unroll
        for (unsigned j = 0; j < 16; ++j) { const unsigned c = xb_ld(&bar[XB_XCNT(j)]); sum += c; cnt += (c > 0u) ? 1u : 0u; mine = (j == x) ? c : mine; }
        if (sum == G) break;
        __builtin_amdgcn_s_sleep(1);
        if ((++sp & 255u) == 0u) { if (xb_ld(&bar[XB_TMO])) break; if (sp > XB_SPIN_CAP) { atomicAdd(&bar[XB_TMO], 1u); break; } }
    }
    nloc = mine > 0u ? mine : 1u; nx = cnt > 0u ? cnt : 1u;
}
__device__ __forceinline__ void xcd_barrier(const XcdBarrier& b) {
    asm volatile("s_waitcnt vmcnt(0)" ::: "memory");
    __syncthreads();
    if (threadIdx.x == 0) {
        unsigned* bar = b.bar;
        __builtin_amdgcn_s_waitcnt(0);
        unsigned nloc = b.st[0], nx = b.st[1];
        if (nloc == 0u) { xcd_barrier_complete(bar, b.x, nloc, nx); b.st[0] = nloc; b.st[1] = nx; }
        const unsigned old = xb_add(&bar[XB_XSUB(b.x)], 1u);
        const unsigned gen = old / nloc;
        if (old + 1u == (gen + 1u) * nloc) {
            __builtin_amdgcn_fence(__ATOMIC_RELEASE, "agent");
            asm volatile("s_waitcnt vmcnt(0)" ::: "memory");
            const unsigned og = xb_add(&bar[XB_TOP], 1u);
            const unsigned tg = og / nx;
            if (og + 1u == (tg + 1u) * nx) xb_add(&bar[XB_TOPGEN], 1u);
            else XB_SPIN(xb_ld(&bar[XB_TOPGEN]) == tg, bar);
            __builtin_amdgcn_fence(__ATOMIC_ACQUIRE, "agent");
            xb_add(&bar[XB_XGEN(b.x)], 1u);
            asm volatile("s_waitcnt vmcnt(0)" ::: "memory");
        } else {
            XB_SPIN(xb_ld(&bar[XB_XGEN(b.x)]) == gen, bar);
            __builtin_amdgcn_fence(__ATOMIC_ACQUIRE, "agent");
            asm volatile("s_waitcnt vmcnt(0)" ::: "memory");
        }
    }
    __syncthreads();
}

constexpr int BM = 256, BK = 64, HALF = 128, HTB = HALF * BK * 2, NXCD = 8, WGM = 8;
__device__ __forceinline__ int lds_byte(int r, int c) { const int st = (r >> 4) * 2 + (c >> 5), rr = r & 15, cc = c & 31, ob = rr * 64 + cc * 2; return st * 1024 + (ob ^ (((ob >> 9) & 1) << 5)); }
__device__ __forceinline__ void stage_rc(int b, int& R, int& C) { const int st = b / 1024, sb = b % 1024, swz = sb ^ (((sb >> 9) & 1) << 5); R = (st >> 1) * 16 + swz / 64; C = (st & 1) * 32 + (swz % 64) / 2; }
__device__ __forceinline__ int perm32(int rho) { const int n = rho >> 4, i = rho & 15; return 8 * (i >> 2) + 4 * n + (i & 3); }

struct Unit { int pm, pn, pb, lt, cnt, e; };
struct Gemm { const bf16_t* A; const bf16_t* Bt; int K; };

__device__ __forceinline__ void tile_map(int L, int nM, int nN, int& pm, int& pn) {
    const int nwg = nM * nN;
    int wgid = L; { const int q = nwg / NXCD, r = nwg % NXCD, xcd = wgid % NXCD, off = wgid / NXCD; wgid = (xcd < r ? xcd * (q + 1) : r * (q + 1) + (xcd - r) * q) + off; }
    const int nig = WGM * nN, gid = wgid / nig, fm = gid * WGM, gsz = (nM - fm) < WGM ? (nM - fm) : WGM;
    pm = fm + ((wgid % nig) % gsz); pn = (wgid % nig) / gsz;
}
struct StaticOrder {
    int nM, nN, nwg, G, c;
    __device__ __forceinline__ void init(int M_, int N_, int G_, int c_) { nM = M_ / BM; nN = N_ / BM; nwg = nM * nN; G = G_; c = c_; }
    __device__ __forceinline__ bool next(int i, Unit& u) const {
        const long L = (long)i * G + c; if (L >= nwg) return false;
        tile_map((int)L, nM, nN, u.pm, u.pn); u.pb = u.pn; u.lt = 0; u.cnt = 0; u.e = 0; return true;
    }
};
struct MoeOrder {
    int t1, t2, t3, t4, t5, t6, t7, nM, nN, nwg, G, c; const unsigned* cntp;
    __device__ __forceinline__ void init(const unsigned* cnt, int nN_, int G_, int c_) {
        int t = 0, o[9];
#pragma unroll
        for (int e = 0; e < 8; ++e) { o[e] = t; const int ce = __builtin_amdgcn_readfirstlane((int)__hip_atomic_load(cnt + e, __ATOMIC_RELAXED, __HIP_MEMORY_SCOPE_AGENT)); t += (ce + 255) >> 8; }
        o[8] = t; t1 = o[1]; t2 = o[2]; t3 = o[3]; t4 = o[4]; t5 = o[5]; t6 = o[6]; t7 = o[7];
        nM = t; nN = nN_; nwg = nM * nN; G = G_; c = c_; cntp = cnt;
    }
    __device__ __forceinline__ bool next(int i, Unit& u) const {
        const long L = (long)i * G + c; if (L >= nwg) return false;
        tile_map((int)L, nM, nN, u.pm, u.pn);
        const int e = (u.pm >= t1) + (u.pm >= t2) + (u.pm >= t3) + (u.pm >= t4) + (u.pm >= t5) + (u.pm >= t6) + (u.pm >= t7);
        const int tb = e == 0 ? 0 : e == 1 ? t1 : e == 2 ? t2 : e == 3 ? t3 : e == 4 ? t4 : e == 5 ? t5 : e == 6 ? t6 : t7;
        u.cnt = __builtin_amdgcn_readfirstlane((int)__hip_atomic_load(cntp + e, __ATOMIC_RELAXED, __HIP_MEMORY_SCOPE_AGENT));
        u.lt = u.pm - tb; u.e = e; u.pb = e * nN + u.pn; return true;
    }
};

typedef f32x4 Acc[2][2][4][2];

template <bool F8 = false, class Epi, class Sched>
__device__ __forceinline__ void gemm_phase(LAS unsigned char* lds, const Gemm g, const Sched& S, const Epi& E) {
    int tid_ = threadIdx.x; asm volatile("" : "+v"(tid_));
    const int tid = tid_, wid = __builtin_amdgcn_readfirstlane(tid >> 6), lane = tid & 63, wr = wid >> 2, wc = wid & 3, fr = lane & 15, fq = lane >> 4;
    const int K = g.K, nt = K / BK;
    unsigned voffA[2], voffB[2];
#pragma unroll
    for (int i = 0; i < 2; ++i) { int R, C; stage_rc(tid * 16 + i * 8192, R, C); const int Rb = (R & ~31) + perm32(R & 31);
        voffA[i] = (unsigned)(R * K + C) * 2u; voffB[i] = (unsigned)(Rb * K + C) * 2u; }
    const size_t kstep = (size_t)(BK * 2);
    const size_t hstep = (size_t)HALF * K * 2;
    const size_t tstep = 2 * hstep;
    const unsigned ldsw = (unsigned)wid * 1024u;
    const int aoff = lds_byte(wr * 64 + fr, fq * 8), boff = lds_byte(wc * 32 + fr, fq * 8);
#define PG8_SA(b, h) (((b) * 2 + (h)) * HTB)
#define PG8_SB(b, h) ((4 + (b) * 2 + (h)) * HTB)
#define PG8_STAGE(bufoff, gbase, voff) do { _Pragma("unroll") for (int _i = 0; _i < 2; ++_i) \
        __builtin_amdgcn_global_load_lds((const unsigned*)((const char*)(gbase) + (voff)[_i]), (LAS unsigned*)(lds + (bufoff) + ldsw + _i * 8192), 16, 0, 0); } while (0)
#define PG8_LDA(dst, b, h) do { _Pragma("unroll") for (int m = 0; m < 4; ++m) _Pragma("unroll") for (int k = 0; k < 2; ++k) dst[m][k] = *(const LAS bf16x8*)(lds + PG8_SA(b, h) + aoff + m * 2048 + k * 1024); } while (0)
#define PG8_LDB(dst, b, h) do { _Pragma("unroll") for (int n = 0; n < 2; ++n) _Pragma("unroll") for (int k = 0; k < 2; ++k) dst[n][k] = *(const LAS bf16x8*)(lds + PG8_SB(b, h) + boff + n * 2048 + k * 1024); } while (0)
#define PG8_MMA(ai, bj, At, Bt) do { __builtin_amdgcn_s_setprio(1); \
        if constexpr (F8) {        \
            _Pragma("unroll") for (int m = 0; m < 4; ++m) _Pragma("unroll") for (int n = 0; n < 2; ++n) { \
                const v8i32 bv_ = __builtin_shufflevector(__builtin_bit_cast(v4i32, Bt[n][0]), __builtin_bit_cast(v4i32, Bt[n][1]), 0, 1, 2, 3, 4, 5, 6, 7); \
                const v8i32 av_ = __builtin_shufflevector(__builtin_bit_cast(v4i32, At[m][0]), __builtin_bit_cast(v4i32, At[m][1]), 0, 1, 2, 3, 4, 5, 6, 7); \
                acc[ai][bj][m][n] = __builtin_amdgcn_mfma_scale_f32_16x16x128_f8f6f4(bv_, av_, acc[ai][bj][m][n], 0, 0, 0, 0x7f7f7f7f, 0, 0x7f7f7f7f); } \
        } else { \
            _Pragma("unroll") for (int m = 0; m < 4; ++m) _Pragma("unroll") for (int n = 0; n < 2; ++n) _Pragma("unroll") for (int k = 0; k < 2; ++k) \
                acc[ai][bj][m][n] = __builtin_amdgcn_mfma_f32_16x16x32_bf16(Bt[n][k], At[m][k], acc[ai][bj][m][n], 0, 0, 0); } \
        __builtin_amdgcn_s_setprio(0); } while (0)
#define PG8_WAIT_V(n) asm volatile("s_waitcnt vmcnt(" #n ")" ::: "memory")
#define PG8_WAIT_L(n) asm volatile("s_waitcnt lgkmcnt(" #n ")" ::: "memory")
#define PG8_BAR __builtin_amdgcn_s_barrier()
#define PG8_SCHED __builtin_amdgcn_sched_barrier(0)
    Unit cur, nxt; int ui = 0;
    if (!S.next(0, cur)) return;
    Acc acc;
#pragma unroll
    for (int a = 0; a < 2; ++a)
#pragma unroll
        for (int b = 0; b < 2; ++b)
#pragma unroll
            for (int m = 0; m < 4; ++m)
#pragma unroll
                for (int n = 0; n < 2; ++n) acc[a][b][m][n] = (f32x4){0.f, 0.f, 0.f, 0.f};
    bf16x8 At[4][2], B0[2][2], B1[2][2];
    const char* cA = (const char*)g.A + (size_t)cur.pm * tstep; const char* cB = (const char*)g.Bt + (size_t)cur.pb * tstep;
    PG8_STAGE(PG8_SB(0, 0), cB, voffB); PG8_STAGE(PG8_SA(0, 0), cA, voffA); PG8_STAGE(PG8_SB(0, 1), cB + hstep, voffB); PG8_STAGE(PG8_SA(0, 1), cA + hstep, voffA);
    if (wr == 1) PG8_BAR;
    PG8_WAIT_V(4); PG8_BAR;
    PG8_STAGE(PG8_SB(1, 0), cB + kstep, voffB); PG8_STAGE(PG8_SA(1, 0), cA + kstep, voffA); PG8_STAGE(PG8_SB(1, 1), cB + hstep + kstep, voffB);
    PG8_WAIT_V(6); PG8_BAR;
    for (;;) {
        const bool has_next = S.next(ui + 1, nxt);
        const char* nA = has_next ? (const char*)g.A + (size_t)nxt.pm * tstep : cA; const char* nB = has_next ? (const char*)g.Bt + (size_t)nxt.pb * tstep : cB;
#pragma nounroll
        for (int t = 0; t < nt; t += 2) {
            const bool last = (t == nt - 2);
            const char* a1 = cA + (size_t)(t + 1) * kstep;
            const char* a2 = last ? nA : cA + (size_t)(t + 2) * kstep; const char* b2 = last ? nB : cB + (size_t)(t + 2) * kstep;
            const char* a3 = a2 + kstep; const char* b3 = b2 + kstep;
            PG8_LDB(B0, 0, 0); PG8_SCHED; PG8_LDA(At, 0, 0); PG8_STAGE(PG8_SA(1, 1), a1 + hstep, voffA);
            PG8_WAIT_L(8); PG8_BAR; PG8_WAIT_L(0); PG8_MMA(0, 0, At, B0); PG8_BAR; PG8_SCHED;
            PG8_LDB(B1, 0, 1); PG8_STAGE(PG8_SB(0, 0), b2, voffB);
            PG8_BAR; PG8_WAIT_L(0); PG8_MMA(0, 1, At, B1); PG8_BAR;
            PG8_LDA(At, 0, 1); PG8_STAGE(PG8_SA(0, 0), a2, voffA);
            PG8_BAR; PG8_WAIT_L(0); PG8_MMA(1, 0, At, B0); PG8_BAR; PG8_SCHED;
            PG8_STAGE(PG8_SB(0, 1), b2 + hstep, voffB);
            PG8_WAIT_V(6); PG8_BAR; PG8_MMA(1, 1, At, B1); PG8_BAR;
            PG8_LDB(B0, 1, 0); PG8_SCHED; PG8_LDA(At, 1, 0); PG8_STAGE(PG8_SA(0, 1), a2 + hstep, voffA);
            PG8_WAIT_L(8); PG8_BAR; PG8_WAIT_L(0); PG8_MMA(0, 0, At, B0); PG8_BAR; PG8_SCHED;
            PG8_LDB(B1, 1, 1); PG8_STAGE(PG8_SB(1, 0), b3, voffB);
            PG8_BAR; PG8_WAIT_L(0); PG8_MMA(0, 1, At, B1); PG8_BAR;
            PG8_LDA(At, 1, 1); PG8_STAGE(PG8_SA(1, 0), a3, voffA);
            PG8_BAR; PG8_WAIT_L(0); PG8_MMA(1, 0, At, B0); PG8_BAR; PG8_SCHED;
            PG8_STAGE(PG8_SB(1, 1), b3 + hstep, voffB);
            PG8_WAIT_V(6); PG8_BAR; PG8_MMA(1, 1, At, B1); PG8_BAR;
        }
        E(acc, cur, wr, wc, fr, fq);
        if (!has_next) break;
#pragma unroll
        for (int a = 0; a < 2; ++a)
#pragma unroll
            for (int b = 0; b < 2; ++b)
#pragma unroll
                for (int m = 0; m < 4; ++m)
#pragma unroll
                    for (int n = 0; n < 2; ++n) acc[a][b][m][n] = (f32x4){0.f, 0.f, 0.f, 0.f};
        cur = nxt; cA = nA; cB = nB; ++ui;
    }
    PG8_WAIT_V(0);
    if (wr == 0) PG8_BAR;
    PG8_BAR;
#undef PG8_SA
#undef PG8_SB
#undef PG8_STAGE
#undef PG8_LDA
#undef PG8_LDB
#undef PG8_MMA
#undef PG8_WAIT_V
#undef PG8_WAIT_L
#undef PG8_BAR
#undef PG8_SCHED
}

template <bool F8 = false, bool IDENT = false, class Epi, class Sched>
__device__ __forceinline__ void gemm_phase_gather(LAS unsigned char* lds, const Gemm g, const Sched& S, const Epi& E, const int* TOKV) {
    int tid_ = threadIdx.x; asm volatile("" : "+v"(tid_));
    const int tid = tid_, wid = __builtin_amdgcn_readfirstlane(tid >> 6), lane = tid & 63, wr = wid >> 2, wc = wid & 3, fr = lane & 15, fq = lane >> 4;
    const int K = g.K, nt = K / BK;
    unsigned voffB[2];
#pragma unroll
    for (int i = 0; i < 2; ++i) { int R, C; stage_rc(tid * 16 + i * 8192, R, C); const int Rb = (R & ~31) + perm32(R & 31); voffB[i] = (unsigned)(Rb * K + C) * 2u; }
    unsigned vgC[2][2];
    LAS int* TOKL = (LAS int*)(lds + STAGE_TOKL);
#define PG8_GROWS(dst, u_) do { int tq_ = threadIdx.x; asm volatile("" : "+v"(tq_)); _Pragma("unroll") for (int i_ = 0; i_ < 2; ++i_) { int R_, C_; stage_rc(tq_ * 16 + i_ * 8192, R_, C_); \
            _Pragma("unroll") for (int h_ = 0; h_ < 2; ++h_) { const int pos_ = 256 * (u_).lt + 128 * h_ + R_; \
                int tok_; if constexpr (IDENT) tok_ = 256 * (u_).pm + 128 * h_ + R_; else tok_ = (pos_ < (u_).cnt) ? TOKV[(size_t)(u_).e * M + pos_] : 0; dst[h_][i_] = (unsigned)tok_ * (unsigned)(K * 2) + (unsigned)C_ * 2u; } } } while (0)
#define PG8_GROWS_LDS(dst, u_, par_) do { int tq_ = threadIdx.x; asm volatile("" : "+v"(tq_)); _Pragma("unroll") for (int i_ = 0; i_ < 2; ++i_) { int R_, C_; stage_rc(tq_ * 16 + i_ * 8192, R_, C_); \
            _Pragma("unroll") for (int h_ = 0; h_ < 2; ++h_) { const int rl_ = 128 * h_ + R_; \
                int tok_; if constexpr (IDENT) tok_ = 256 * (u_).pm + rl_; else tok_ = (256 * (u_).lt + rl_ < (u_).cnt) ? TOKL[256 * (par_) + rl_] : 0; dst[h_][i_] = (unsigned)tok_ * (unsigned)(K * 2) + (unsigned)C_ * 2u; } } } while (0)
    const size_t kstep = (size_t)(BK * 2);
    const size_t hstep = (size_t)HALF * K * 2;
    const size_t tstep = 2 * hstep;
    const unsigned ldsw = (unsigned)wid * 1024u;
    const int aoff = lds_byte(wr * 64 + fr, fq * 8), boff = lds_byte(wc * 32 + fr, fq * 8);
#define PG8_SA(b, h) (((b) * 2 + (h)) * HTB)
#define PG8_SB(b, h) ((4 + (b) * 2 + (h)) * HTB)
#define PG8_STAGE(bufoff, gbase, voff) do { _Pragma("unroll") for (int _i = 0; _i < 2; ++_i) \
        __builtin_amdgcn_global_load_lds((const unsigned*)((const char*)(gbase) + (voff)[_i]), (LAS unsigned*)(lds + (bufoff) + ldsw + _i * 8192), 16, 0, 0); } while (0)
#define PG8_STAGEA(bufoff, gbase, h_, nx_) PG8_STAGE(bufoff, gbase, vgC[h_])
#define PG8_LDA(dst, b, h) do { _Pragma("unroll") for (int m = 0; m < 4; ++m) _Pragma("unroll") for (int k = 0; k < 2; ++k) dst[m][k] = *(const LAS bf16x8*)(lds + PG8_SA(b, h) + aoff + m * 2048 + k * 1024); } while (0)
#define PG8_LDB(dst, b, h) do { _Pragma("unroll") for (int n = 0; n < 2; ++n) _Pragma("unroll") for (int k = 0; k < 2; ++k) dst[n][k] = *(const LAS bf16x8*)(lds + PG8_SB(b, h) + boff + n * 2048 + k * 1024); } while (0)
#define PG8_MMA(ai, bj, At, Bt) do { __builtin_amdgcn_s_setprio(1); \
        if constexpr (F8) {        \
            _Pragma("unroll") for (int m = 0; m < 4; ++m) _Pragma("unroll") for (int n = 0; n < 2; ++n) { \
                const v8i32 bv_ = __builtin_shufflevector(__builtin_bit_cast(v4i32, Bt[n][0]), __builtin_bit_cast(v4i32, Bt[n][1]), 0, 1, 2, 3, 4, 5, 6, 7); \
                const v8i32 av_ = __builtin_shufflevector(__builtin_bit_cast(v4i32, At[m][0]), __builtin_bit_cast(v4i32, At[m][1]), 0, 1, 2, 3, 4, 5, 6, 7); \
                acc[ai][bj][m][n] = __builtin_amdgcn_mfma_scale_f32_16x16x128_f8f6f4(bv_, av_, acc[ai][bj][m][n], 0, 0, 0, 0x7f7f7f7f, 0, 0x7f7f7f7f); } \
        } else { \
            _Pragma("unroll") for (int m = 0; m < 4; ++m) _Pragma("unroll") for (int n = 0; n < 2; ++n) _Pragma("unroll") for (int k = 0; k < 2; ++k) \
                acc[ai][bj][m][n] = __builtin_amdgcn_mfma_f32_16x16x32_bf16(Bt[n][k], At[m][k], acc[ai][bj][m][n], 0, 0, 0); } \
        __builtin_amdgcn_s_setprio(0); } while (0)
#define PG8_WAIT_V(n) asm volatile("s_waitcnt vmcnt(" #n ")" ::: "memory")
#define PG8_WAIT_L(n) asm volatile("s_waitcnt lgkmcnt(" #n ")" ::: "memory")
#define PG8_BAR __builtin_amdgcn_s_barrier()
#define PG8_SCHED __builtin_amdgcn_sched_barrier(0)
    Unit cur, nxt; int ui = 0;
    if (!S.next(0, cur)) return;
    Acc acc;
#pragma unroll
    for (int a = 0; a < 2; ++a)
#pragma unroll
        for (int b = 0; b < 2; ++b)
#pragma unroll
            for (int m = 0; m < 4; ++m)
#pragma unroll
                for (int n = 0; n < 2; ++n) acc[a][b][m][n] = (f32x4){0.f, 0.f, 0.f, 0.f};
    bf16x8 At[4][2], B0[2][2], B1[2][2];
    const char* cA = (const char*)g.A; const char* cB = (const char*)g.Bt + (size_t)cur.pb * tstep;
    PG8_GROWS(vgC, cur);
    PG8_STAGE(PG8_SB(0, 0), cB, voffB); PG8_STAGEA(PG8_SA(0, 0), cA, 0, false); PG8_STAGE(PG8_SB(0, 1), cB + hstep, voffB); PG8_STAGEA(PG8_SA(0, 1), cA, 1, false);
    if (wr == 1) PG8_BAR;
    PG8_WAIT_V(4); PG8_BAR;
    PG8_STAGE(PG8_SB(1, 0), cB + kstep, voffB); PG8_STAGEA(PG8_SA(1, 0), cA + kstep, 0, false); PG8_STAGE(PG8_SB(1, 1), cB + hstep + kstep, voffB);
    PG8_WAIT_V(6); PG8_BAR;
    for (;;) {
        const bool has_next = S.next(ui + 1, nxt);
        const char* nA = cA; const char* nB = has_next ? (const char*)g.Bt + (size_t)nxt.pb * tstep : cB;
        if (!IDENT && has_next && wid == 0) __builtin_amdgcn_global_load_lds((const unsigned*)(TOKV + (size_t)nxt.e * M + 256 * nxt.lt + 4 * lane), (LAS unsigned*)(TOKL + 256 * ((ui + 1) & 1)), 16, 0, 0);

#pragma nounroll
        for (int t = 0; t < nt; t += 2) {
            const bool last = (t == nt - 2);
            const char* a1 = cA + (size_t)(t + 1) * kstep;
            const char* a2 = last ? nA : cA + (size_t)(t + 2) * kstep; const char* b2 = last ? nB : cB + (size_t)(t + 2) * kstep;
            const char* a3 = a2 + kstep; const char* b3 = b2 + kstep;
            PG8_LDB(B0, 0, 0); PG8_SCHED; PG8_LDA(At, 0, 0); PG8_STAGEA(PG8_SA(1, 1), a1, 1, false);
            if (last && has_next) { PG8_GROWS_LDS(vgC, nxt, (ui + 1) & 1); }
            PG8_WAIT_L(8); PG8_BAR; PG8_WAIT_L(0); PG8_MMA(0, 0, At, B0); PG8_BAR; PG8_SCHED;
            PG8_LDB(B1, 0, 1); PG8_STAGE(PG8_SB(0, 0), b2, voffB);
            PG8_BAR; PG8_WAIT_L(0); PG8_MMA(0, 1, At, B1); PG8_BAR;
            PG8_LDA(At, 0, 1); PG8_STAGEA(PG8_SA(0, 0), a2, 0, last);
            PG8_BAR; PG8_WAIT_L(0); PG8_MMA(1, 0, At, B0); PG8_BAR; PG8_SCHED;
            PG8_STAGE(PG8_SB(0, 1), b2 + hstep, voffB);
            PG8_WAIT_V(6); PG8_BAR; PG8_MMA(1, 1, At, B1); PG8_BAR;
            PG8_LDB(B0, 1, 0); PG8_SCHED; PG8_LDA(At, 1, 0); PG8_STAGEA(PG8_SA(0, 1), a2, 1, last);
            PG8_WAIT_L(8); PG8_BAR; PG8_WAIT_L(0); PG8_MMA(0, 0, At, B0); PG8_BAR; PG8_SCHED;
            PG8_LDB(B1, 1, 1); PG8_STAGE(PG8_SB(1, 0), b3, voffB);
            PG8_BAR; PG8_WAIT_L(0); PG8_MMA(0, 1, At, B1); PG8_BAR;
            PG8_LDA(At, 1, 1); PG8_STAGEA(PG8_SA(1, 0), a3, 0, last);
            PG8_BAR; PG8_WAIT_L(0); PG8_MMA(1, 0, At, B0); PG8_BAR; PG8_SCHED;
            PG8_STAGE(PG8_SB(1, 1), b3 + hstep, voffB);
            PG8_WAIT_V(6); PG8_BAR; PG8_MMA(1, 1, At, B1); PG8_BAR;
        }
        E(acc, cur, wr, wc, fr, fq);
        if (!has_next) break;
#pragma unroll
        for (int a = 0; a < 2; ++a)
#pragma unroll
            for (int b = 0; b < 2; ++b)
#pragma unroll
                for (int m = 0; m < 4; ++m)
#pragma unroll
                    for (int n = 0; n < 2; ++n) acc[a][b][m][n] = (f32x4){0.f, 0.f, 0.f, 0.f};
        cur = nxt; cB = nB; ++ui;
    }
    PG8_WAIT_V(0);
    if (wr == 0) PG8_BAR;
    PG8_BAR;
#undef PG8_SA
#undef PG8_STAGEA
#undef PG8_GROWS
#undef PG8_GROWS_LDS
#undef PG8_SB
#undef PG8_STAGE
#undef PG8_LDA
#undef PG8_LDB
#undef PG8_MMA
#undef PG8_WAIT_V
#undef PG8_WAIT_L
#undef PG8_BAR
#undef PG8_SCHED
}

__device__ __forceinline__ u32x4 pack8(const f32x4 a, const f32x4 b) { u32x4 w; w.x = cvt_pk_bf16(a[0], a[1]); w.y = cvt_pk_bf16(a[2], a[3]); w.z = cvt_pk_bf16(b[0], b[1]); w.w = cvt_pk_bf16(b[2], b[3]); return w; }

struct EpiHgIn {
    bf16_t* QFVG;
    __device__ __forceinline__ void operator()(const Acc& acc, const Unit& u, int wr, int wc, int fr, int fq) const {
        const int part = u.pn >> 2, row0 = u.pm * BM + wr * 64 + fr, col0 = (u.pn & 3) * 256 + wc * 32 + 8 * fq;
        bf16_t* base = QFVG + (size_t)part * ((size_t)M * D);
#pragma unroll
        for (int ai = 0; ai < 2; ++ai)
#pragma unroll
            for (int m = 0; m < 4; ++m) { bf16_t* rowp = base + (size_t)(row0 + ai * HALF + m * 16) * D + col0;
#pragma unroll
                for (int bj = 0; bj < 2; ++bj) *(u32x4*)(rowp + bj * HALF) = pack8(acc[ai][bj][m][0], acc[ai][bj][m][1]); }
    }
};
struct EpiRes {
    const bf16_t* X; bf16_t* Y; float s;
    __device__ __forceinline__ void operator()(const Acc& acc, const Unit& u, int wr, int wc, int fr, int fq) const {
        const int row0 = u.pm * BM + wr * 64 + fr, col0 = u.pn * BM + wc * 32 + 8 * fq;
#pragma unroll
        for (int ai = 0; ai < 2; ++ai)
#pragma unroll
            for (int m = 0; m < 4; ++m) { const size_t o = (size_t)(row0 + ai * HALF + m * 16) * D + col0;
#pragma unroll
                for (int bj = 0; bj < 2; ++bj) {
                    const u32x4 xv = *(const u32x4*)(X + o + bj * HALF);
                    f32x4 y0, y1;
#pragma unroll
                    for (int q = 0; q < 2; ++q) { y0[2 * q] = __uint_as_float(xv[q] << 16) * ALPHA + acc[ai][bj][m][0][2 * q] * s; y0[2 * q + 1] = __uint_as_float(xv[q] & 0xffff0000u) * ALPHA + acc[ai][bj][m][0][2 * q + 1] * s;
                        y1[2 * q] = __uint_as_float(xv[2 + q] << 16) * ALPHA + acc[ai][bj][m][1][2 * q] * s; y1[2 * q + 1] = __uint_as_float(xv[2 + q] & 0xffff0000u) * ALPHA + acc[ai][bj][m][1][2 * q + 1] * s; }
                    *(u32x4*)(Y + o + bj * HALF) = pack8(y0, y1); } }
    }
};
__device__ __forceinline__ unsigned pack4_fp8(float a, float b, float c, float d) {
    a = fminf(fmaxf(a, -448.f), 448.f); b = fminf(fmaxf(b, -448.f), 448.f); c = fminf(fmaxf(c, -448.f), 448.f); d = fminf(fmaxf(d, -448.f), 448.f);
    int p = 0; p = __builtin_amdgcn_cvt_pk_fp8_f32(a, b, p, false); p = __builtin_amdgcn_cvt_pk_fp8_f32(c, d, p, true); return (unsigned)p;
}
constexpr float F8_X = 16.f, F8_WGU = 64.f, F8_H = 4.f, F8_WDN = 256.f, F8_O = 64.f, F8_WDO = 128.f;
struct EpiSwiglu8 {
    unsigned char* H; float s;
    __device__ __forceinline__ void operator()(const Acc& acc, const Unit& u, int wr, int wc, int fr, int fq) const {
        const int row0 = u.pm * BM + wr * 64 + fr, col0 = u.pn * 128 + wc * 32 + 8 * fq;
#pragma unroll
        for (int ai = 0; ai < 2; ++ai)
#pragma unroll
            for (int m = 0; m < 4; ++m) { unsigned char* rowp = H + (size_t)(row0 + ai * HALF + m * 16) * DFF + col0;
                float h[8];
#pragma unroll
                for (int j = 0; j < 4; ++j) { h[j] = siluf_(acc[ai][0][m][0][j] * s) * (acc[ai][1][m][0][j] * (s * F8_H)); h[4 + j] = siluf_(acc[ai][0][m][1][j] * s) * (acc[ai][1][m][1][j] * (s * F8_H)); }
                u32x2 o; o.x = pack4_fp8(h[0], h[1], h[2], h[3]); o.y = pack4_fp8(h[4], h[5], h[6], h[7]);
                *(u32x2*)rowp = o; }
    }
};
struct EpiSwiglu {
    bf16_t* H;
    __device__ __forceinline__ void operator()(const Acc& acc, const Unit& u, int wr, int wc, int fr, int fq) const {
        const int row0 = u.pm * BM + wr * 64 + fr, col0 = u.pn * 128 + wc * 32 + 8 * fq;
#pragma unroll
        for (int ai = 0; ai < 2; ++ai)
#pragma unroll
            for (int m = 0; m < 4; ++m) { bf16_t* rowp = H + (size_t)(row0 + ai * HALF + m * 16) * DFF + col0;
                f32x4 h0, h1;
#pragma unroll
                for (int j = 0; j < 4; ++j) { h0[j] = siluf_(acc[ai][0][m][0][j]) * acc[ai][1][m][0][j]; h1[j] = siluf_(acc[ai][0][m][1][j]) * acc[ai][1][m][1][j]; }
                *(u32x4*)rowp = pack8(h0, h1); }
    }
};
struct EpiBf16 {
    bf16_t* C; int ldc;
    __device__ __forceinline__ void operator()(const Acc& acc, const Unit& u, int wr, int wc, int fr, int fq) const {
        const int row0 = u.pm * BM + wr * 64 + fr, col0 = u.pn * BM + wc * 32 + 8 * fq;
#pragma unroll
        for (int ai = 0; ai < 2; ++ai)
#pragma unroll
            for (int m = 0; m < 4; ++m) { bf16_t* rowp = C + (size_t)(row0 + ai * HALF + m * 16) * ldc + col0;
#pragma unroll
                for (int bj = 0; bj < 2; ++bj) *(u32x4*)(rowp + bj * HALF) = pack8(acc[ai][bj][m][0], acc[ai][bj][m][1]); }
    }
};
struct EpiQ {
    bf16_t* QLAT; bf16_t* QIDX;
    __device__ __forceinline__ void operator()(const Acc& acc, const Unit& u, int wr, int wc, int fr, int fq) const {
        const bool lat = u.pn < 8; bf16_t* base = lat ? QLAT : QIDX; const int ld = lat ? 2048 : 512;
        const int row0 = u.pm * BM + wr * 64 + fr, col0 = (lat ? u.pn : u.pn - 8) * BM + wc * 32 + 8 * fq;
#pragma unroll
        for (int ai = 0; ai < 2; ++ai)
#pragma unroll
            for (int m = 0; m < 4; ++m) { bf16_t* rowp = base + (size_t)(row0 + ai * HALF + m * 16) * ld + col0;
#pragma unroll
                for (int bj = 0; bj < 2; ++bj) *(u32x4*)(rowp + bj * HALF) = pack8(acc[ai][bj][m][0], acc[ai][bj][m][1]); }
    }
};
struct EpiMoeDn {
    bf16_t* O; const float* GW; float scale;
    __device__ __forceinline__ void operator()(const Acc& acc, const Unit& u, int wr, int wc, int fr, int fq) const {
        const int rl0 = wr * 64 + fr, col0 = u.pn * BM + wc * 32 + 8 * fq; const float* gwp = GW + (size_t)u.e * M + 256 * u.lt;
#pragma unroll
        for (int ai = 0; ai < 2; ++ai)
#pragma unroll
            for (int m = 0; m < 4; ++m) { const int rl = rl0 + ai * HALF + m * 16; const float gv = (256 * u.lt + rl < u.cnt) ? gwp[rl] * scale : 0.f; bf16_t* rowp = O + (size_t)(u.pm * BM + rl) * D + col0;
#pragma unroll
                for (int bj = 0; bj < 2; ++bj) *(u32x4*)(rowp + bj * HALF) = pack8(acc[ai][bj][m][0] * gv, acc[ai][bj][m][1] * gv); }
    }
};

struct Params { const float* in[22]; float* out; unsigned char* ws; int ph_lo, ph_hi; };
enum { IN_X = 0, IN_LNG, IN_LNB, IN_HGWIN, IN_HGLB, IN_HGNG, IN_HGWOUT, IN_DWIN, IN_DQNG, IN_DKVNG, IN_DWUQ, IN_DWUK, IN_DWUV, IN_DWQIDX, IN_DKIG, IN_DKIB, IN_DWOUT, IN_FGU, IN_FDN, IN_MR, IN_MGU, IN_MDN };

__device__ __forceinline__ const float* inptr(int i) {
    int off = i * 8; asm volatile("" : "+s"(off));
    typedef const float* cfp;
    return *(const __attribute__((address_space(4))) cfp*)((const __attribute__((address_space(4))) char*)__builtin_amdgcn_kernarg_segment_ptr() + off);
}
#define INP(i) inptr(i)
struct Frame {
    LAS unsigned char* lds;
    unsigned* ctl;
    int tid, lane, wave, G, c;
};

__device__ __forceinline__ void p0_transpose_item(const float* W, int K, int Nsrc, int nblk, bf16_t* WT, int mode, float f8scale, LAS float* scr, int item, int lane) {
    const int kb = item / nblk, nb = item % nblk, k0 = 64 * kb, n0 = 32 * nb;
    const int c4 = (lane & 7) * 4, kr = lane >> 3;
#pragma unroll
    for (int i = 0; i < 8; ++i) { const int kk = 8 * i + kr;
        f32x4 v = (f32x4){0.f, 0.f, 0.f, 0.f};
        if (n0 + c4 < Nsrc) v = *(const f32x4*)(W + (size_t)(k0 + kk) * Nsrc + n0 + c4);
        scr[kk * 33 + c4 + 0] = v[0]; scr[kk * 33 + c4 + 1] = v[1]; scr[kk * 33 + c4 + 2] = v[2]; scr[kk * 33 + c4 + 3] = v[3]; }
    LDS_WAIT(); asm volatile("" ::: "memory");
    int drow0 = n0;
    if (mode == 1) { const int half = n0 / DFF, r = n0 % DFF; drow0 = 256 * (r / 128) + 128 * half + (r % 128); }
    if (f8scale > 0.f) {
        const int c = lane & 3;
#pragma unroll
        for (int j = 0; j < 2; ++j) { const int n = (lane >> 2) + 16 * j; const LAS float* s = scr + (16 * c) * 33 + n;
            u32x4 o;
#pragma unroll
            for (int q = 0; q < 4; ++q) o[q] = pack4_fp8(s[(4 * q) * 33] * f8scale, s[(4 * q + 1) * 33] * f8scale, s[(4 * q + 2) * 33] * f8scale, s[(4 * q + 3) * 33] * f8scale);
            *(u32x4*)((unsigned char*)WT + (size_t)(drow0 + n) * K + k0 + 16 * c) = o; }
    } else {
        const int c = lane & 7;
#pragma unroll
        for (int j = 0; j < 4; ++j) { const int n = (lane >> 3) + 8 * j; const LAS float* s = scr + (8 * c) * 33 + n;
            u32x4 o; o.x = cvt_pk_bf16(s[0 * 33], s[1 * 33]); o.y = cvt_pk_bf16(s[2 * 33], s[3 * 33]); o.z = cvt_pk_bf16(s[4 * 33], s[5 * 33]); o.w = cvt_pk_bf16(s[6 * 33], s[7 * 33]);
            *(u32x4*)(WT + (size_t)(drow0 + n) * K + k0 + 8 * c) = o; }
    }
    LDS_WAIT(); asm volatile("" ::: "memory");
}
__device__ __forceinline__ void p0_combo_item(Frame& F, const float* A, int lda, const float* B, int ldb, bf16_t* out, int ldo, float scale, bool f8 = false) {
    LAS float* As = (LAS float*)F.lds; LAS float* Bs = As + 64 * 128;
    const int t = F.tid;
#pragma unroll
    for (int q = 0; q < 4; ++q) { const int r = (t >> 5) + 16 * q, c4 = (t & 31) * 4; *(LAS f32x4*)(As + r * 128 + c4) = *(const f32x4*)(A + (size_t)r * lda + c4); }
#pragma unroll
    for (int q = 0; q < 4; ++q) { const int r = (t >> 4) + 32 * q, c4 = (t & 15) * 4; *(LAS f32x4*)(Bs + r * 64 + c4) = *(const f32x4*)(B + (size_t)r * ldb + c4); }
    __syncthreads();
    const int tj = t & 63, ti = t >> 6;
    float acc[8];
#pragma unroll
    for (int ii = 0; ii < 8; ++ii) acc[ii] = 0.f;
    for (int d = 0; d < 128; d += 4) {
        const float b0 = Bs[(d + 0) * 64 + tj], b1 = Bs[(d + 1) * 64 + tj], b2 = Bs[(d + 2) * 64 + tj], b3 = Bs[(d + 3) * 64 + tj];
#pragma unroll
        for (int ii = 0; ii < 8; ++ii) { const f32x4 a = *(const LAS f32x4*)(As + (8 * ti + ii) * 128 + d); acc[ii] += a[0] * b0 + a[1] * b1 + a[2] * b2 + a[3] * b3; }
    }
    u32x4 o; o.x = cvt_pk_bf16(acc[0] * scale, acc[1] * scale); o.y = cvt_pk_bf16(acc[2] * scale, acc[3] * scale); o.z = cvt_pk_bf16(acc[4] * scale, acc[5] * scale); o.w = cvt_pk_bf16(acc[6] * scale, acc[7] * scale);
    if (f8) { u32x2 o8; o8.x = pack4_fp8(acc[0] * scale, acc[1] * scale, acc[2] * scale, acc[3] * scale); o8.y = pack4_fp8(acc[4] * scale, acc[5] * scale, acc[6] * scale, acc[7] * scale);
        *(u32x2*)((unsigned char*)out + (size_t)tj * ldo + 8 * ti) = o8; }
    else *(u32x4*)(out + (size_t)tj * ldo + 8 * ti) = o;
    __syncthreads();
}
__device__ __forceinline__ void p0_prologue(Frame& F, const Params& p) {
    unsigned char* ws = p.ws;
    LAS float* scr = (LAS float*)(F.lds + F.wave * 8448);
    const int gw = F.c * NWAVES + F.wave, NGW = F.G * NWAVES;
    constexpr int I0 = 16 * 128, I1 = 16 * 32, I2 = 16 * 224, I3 = 56 * 32, I4 = 16 * 24, I5 = 4 * 16;
    constexpr int NITEMS = 2 * (I0 + I1 + I2 + I3 + I4 + I5) + 16 * (I2 + I3);
    for (int it = gw; it < NITEMS; it += NGW) {
        int r = it;
        if (r < 16 * I2) { const int job = r / I2;
#if MK_MOE_FP8
            p0_transpose_item(INP(IN_MGU) + (size_t)job * D * 2 * DFF, D, 2 * DFF, 224, (bf16_t*)(ws + WS_W_MGU8 + (size_t)job * 2 * DFF * D), 1, F8_WGU, scr, r % I2, F.lane);
#else
            p0_transpose_item(INP(IN_MGU) + (size_t)job * D * 2 * DFF, D, 2 * DFF, 224, (bf16_t*)(ws + WS_W_MGU) + (size_t)job * 2 * DFF * D, 1, 0.f, scr, r % I2, F.lane);
#endif
            continue; } r -= 16 * I2;
        if (r < 16 * I3) { const int job = r / I3;
#if MK_MOE_FP8
            p0_transpose_item(INP(IN_MDN) + (size_t)job * DFF * D, DFF, D, 32, (bf16_t*)(ws + WS_W_MDN8 + (size_t)job * D * DFF), 0, F8_WDN, scr, r % I3, F.lane);
#else
            p0_transpose_item(INP(IN_MDN) + (size_t)job * DFF * D, DFF, D, 32, (bf16_t*)(ws + WS_W_MDN) + (size_t)job * D * DFF, 0, 0.f, scr, r % I3, F.lane);
#endif
            continue; } r -= 16 * I3;
        if (r < 2 * I0) { const int job = r / I0; p0_transpose_item(INP(IN_HGWIN) + (size_t)job * D * 4 * D, D, 4 * D, 128, (bf16_t*)(ws + WS_W_HGIN) + (size_t)job * 4 * D * D, 0, 0.f, scr, r % I0, F.lane); continue; } r -= 2 * I0;
        if (r < 2 * I1) { const int job = r / I1; p0_transpose_item(INP(IN_HGWOUT) + (size_t)job * D * D, D, D, 32, (bf16_t*)(ws + WS_W_HGOUT) + (size_t)job * D * D, 0, 0.f, scr, r % I1, F.lane); continue; } r -= 2 * I1;
        if (r < 2 * I2) { const int job = r / I2;
#if MK_FFN_FP8 == 2
            p0_transpose_item(INP(IN_FGU) + (size_t)job * D * 2 * DFF, D, 2 * DFF, 224, (bf16_t*)(ws + WS_W_FGU + (size_t)job * 2 * DFF * D), 1, F8_WGU, scr, r % I2, F.lane);
#else
            p0_transpose_item(INP(IN_FGU) + (size_t)job * D * 2 * DFF, D, 2 * DFF, 224, (bf16_t*)(ws + WS_W_FGU) + (size_t)job * 2 * DFF * D, 1, 0.f, scr, r % I2, F.lane);
#endif
            continue; } r -= 2 * I2;
        if (r < 2 * I3) { const int job = r / I3;
#if MK_FFN_FP8 >= 1
            p0_transpose_item(INP(IN_FDN) + (size_t)job * DFF * D, DFF, D, 32, (bf16_t*)(ws + WS_W_FDN + (size_t)job * D * DFF), 0, F8_WDN, scr, r % I3, F.lane);
#else
            p0_transpose_item(INP(IN_FDN) + (size_t)job * DFF * D, DFF, D, 32, (bf16_t*)(ws + WS_W_FDN) + (size_t)job * D * DFF, 0, 0.f, scr, r % I3, F.lane);
#endif
            continue; } r -= 2 * I3;
        if (r < 2 * I4) { const int job = r / I4; p0_transpose_item(INP(IN_DWIN) + (size_t)job * D * DSA_IN, D, DSA_IN, 24, (bf16_t*)(ws + WS_W_DIN) + (size_t)job * DSA_IN_PAD * D, 0, 0.f, scr, r % I4, F.lane); continue; } r -= 2 * I4;
        { const int job = r / I5; p0_transpose_item(INP(IN_DWQIDX) + (size_t)job * QR * 512, QR, 512, 16, (bf16_t*)(ws + WS_W_DQ) + (size_t)job * 2560 * QR + (size_t)2048 * QR, 0, 0.f, scr, r % I5, F.lane); }
    }
    { const f32x4* x4 = (const f32x4*)INP(IN_X); u32x2* xb = (u32x2*)(ws + WS_XB); const size_t n4 = (size_t)M * D / 4;
      for (size_t i = (size_t)F.c * NTHREADS + F.tid; i < n4; i += (size_t)F.G * NTHREADS) { const f32x4 v = x4[i]; u32x2 o; o.x = cvt_pk_bf16(v[0], v[1]); o.y = cvt_pk_bf16(v[2], v[3]); xb[i] = o; } }
    __syncthreads();
    const float qscale = 0.08838834764831845f * 1.4426950408889634f;
    for (int it = F.c; it < 256 + 1024; it += F.G) {
        if (it < 256) { const int j = it >> 7, h = (it >> 4) & 7, ib = (it >> 2) & 3, jb = it & 3;
            p0_combo_item(F, INP(IN_DWUQ) + (size_t)j * QR * D + (size_t)(64 * ib) * D + h * 128, D, INP(IN_DWUK) + ((size_t)j * 8 + h) * 128 * KVR + 64 * jb, KVR,
                          (bf16_t*)(ws + WS_W_DQ) + (size_t)j * 2560 * QR + (size_t)(h * 256 + 64 * jb) * QR + 64 * ib, QR, qscale);
        } else { const int r = it - 256, j = r >> 9, h = (r >> 6) & 7, ib = (r >> 4) & 3, jb = r & 15;
            p0_combo_item(F, INP(IN_DWUV) + (((size_t)j * 8 + h) * KVR + 64 * ib) * 128, 128, INP(IN_DWOUT) + (size_t)j * D * D + (size_t)(h * 128) * D + 64 * jb, D,
#if MK_B6_FP8
                          (bf16_t*)(ws + WS_W_DO + (size_t)j * D * 2048 + (size_t)(64 * jb) * 2048 + h * 256 + 64 * ib), 2048, F8_WDO, true);
#else
                          (bf16_t*)(ws + WS_W_DO) + (size_t)j * D * 2048 + (size_t)(64 * jb) * 2048 + h * 256 + 64 * ib, 2048, 1.0f);
#endif
        }
    }
}

__device__ __forceinline__ void unpack8(const u32x4 w, float* v) {
#pragma unroll
    for (int q = 0; q < 4; ++q) { v[2 * q] = __uint_as_float(w[q] << 16); v[2 * q + 1] = __uint_as_float(w[q] & 0xffff0000u); }
}
__device__ __forceinline__ void load_row_bf16(const bf16_t* row, int lane, float (&v)[16]) {
    const u32x4 a = *(const u32x4*)(row + 8 * lane), b = *(const u32x4*)(row + 512 + 8 * lane); unpack8(a, v); unpack8(b, v + 8);
}
__device__ __forceinline__ void load_vec_f32(const float* p, int lane, float (&v)[16]) {
#pragma unroll
    for (int h = 0; h < 2; ++h)
#pragma unroll
        for (int q = 0; q < 2; ++q) { const f32x4 x = *(const f32x4*)(p + 512 * h + 8 * lane + 4 * q); v[8 * h + 4 * q] = x[0]; v[8 * h + 4 * q + 1] = x[1]; v[8 * h + 4 * q + 2] = x[2]; v[8 * h + 4 * q + 3] = x[3]; }
}
__device__ __forceinline__ void store_row_bf16(const float (&v)[16], bf16_t* row, int lane) {
    u32x4 a, b;
#pragma unroll
    for (int q = 0; q < 4; ++q) { a[q] = cvt_pk_bf16(v[2 * q], v[2 * q + 1]); b[q] = cvt_pk_bf16(v[8 + 2 * q], v[8 + 2 * q + 1]); }
    *(u32x4*)(row + 8 * lane) = a; *(u32x4*)(row + 512 + 8 * lane) = b;
}
__device__ __forceinline__ void store_row_fp8(const float (&v)[16], unsigned char* row, int lane) {
    u32x2 o0, o1; o0.x = pack4_fp8(v[0] * F8_X, v[1] * F8_X, v[2] * F8_X, v[3] * F8_X); o0.y = pack4_fp8(v[4] * F8_X, v[5] * F8_X, v[6] * F8_X, v[7] * F8_X);
    o1.x = pack4_fp8(v[8] * F8_X, v[9] * F8_X, v[10] * F8_X, v[11] * F8_X); o1.y = pack4_fp8(v[12] * F8_X, v[13] * F8_X, v[14] * F8_X, v[15] * F8_X);
    *(u32x2*)(row + 8 * lane) = o0; *(u32x2*)(row + 512 + 8 * lane) = o1;
}
__device__ __forceinline__ void store_row_f32(const float (&v)[16], float* row, int lane) {
#pragma unroll
    for (int h = 0; h < 2; ++h)
#pragma unroll
        for (int q = 0; q < 2; ++q) *(f32x4*)(row + 512 * h + 8 * lane + 4 * q) = (f32x4){v[8 * h + 4 * q], v[8 * h + 4 * q + 1], v[8 * h + 4 * q + 2], v[8 * h + 4 * q + 3]};
}
__device__ __forceinline__ void ln_row(float (&v)[16], const float (&g)[16], const float (&b)[16]) {
    float s = 0.f;
#pragma unroll
    for (int i = 0; i < 16; ++i) s += v[i];
    const float mean = wave_sum(s) * (1.f / D); float s2 = 0.f;
#pragma unroll
    for (int i = 0; i < 16; ++i) { v[i] -= mean; s2 += v[i] * v[i]; }
    const float rstd = 1.f / sqrtf(wave_sum(s2) * (1.f / D) + LN_EPS);
#pragma unroll
    for (int i = 0; i < 16; ++i) v[i] = v[i] * rstd * g[i] + b[i];
}
__device__ __forceinline__ void ln_phase(Frame& F, const bf16_t* Y, const float* g, const float* b, bf16_t* XB, unsigned char* XB8) {
    float gv[16], bv[16]; load_vec_f32(g, F.lane, gv); load_vec_f32(b, F.lane, bv);
    const int gw = F.c * NWAVES + F.wave, NGW = F.G * NWAVES;
    for (int m = gw; m < M; m += NGW) {
        float v[16]; load_row_bf16(Y + (size_t)m * D, F.lane, v);
        ln_row(v, gv, bv);
        store_row_bf16(v, XB + (size_t)m * D, F.lane);
        if (XB8) store_row_fp8(v, XB8 + (size_t)m * D, F.lane);
    }
}
__device__ __forceinline__ void ln_moe_phase(Frame& F, const bf16_t* Xin, const bf16_t* OUTM, const int* EIDX, const int* POS, const unsigned* gcnt, const float* g, const float* b, bf16_t* XB, float* OUT) {
    float gv[16], bv[16]; load_vec_f32(g, F.lane, gv); load_vec_f32(b, F.lane, bv);
    int roff[8]; { int t = 0;
#pragma unroll
        for (int e = 0; e < 8; ++e) { roff[e] = t * 256; t += (__builtin_amdgcn_readfirstlane((int)__hip_atomic_load(gcnt + e, __ATOMIC_RELAXED, __HIP_MEMORY_SCOPE_AGENT)) + 255) >> 8; } }
    const int gw = F.c * NWAVES + F.wave, NGW = F.G * NWAVES;
    for (int m = gw; m < M; m += NGW) {
        const int e0 = EIDX[2 * m], e1 = EIDX[2 * m + 1]; int s0 = POS[2 * m], s1 = POS[2 * m + 1];
#pragma unroll
        for (int k = 0; k < 8; ++k) { s0 += (e0 == k) ? roff[k] : 0; s1 += (e1 == k) ? roff[k] : 0; }
        float v[16], o0[16], o1[16]; load_row_bf16(Xin + (size_t)m * D, F.lane, v); load_row_bf16(OUTM + (size_t)s0 * D, F.lane, o0); load_row_bf16(OUTM + (size_t)s1 * D, F.lane, o1);
#pragma unroll
        for (int i = 0; i < 16; ++i) v[i] = v[i] * ALPHA + o0[i] + o1[i];
        ln_row(v, gv, bv);
        if (OUT) store_row_f32(v, OUT + (size_t)m * D, F.lane); else store_row_bf16(v, XB + (size_t)m * D, F.lane);
    }
}
__device__ __forceinline__ void ln_router_phase(Frame& F, const bf16_t* Y, const float* g, const float* b, const float* wrouter, bf16_t* XB, unsigned char* XB8,
                                                int* EIDX, int* POS, int* TOK, float* GW, unsigned* gcnt) {
    LAS float* WR = (LAS float*)F.lds;
    LAS int* SEL = (LAS int*)(F.lds + 32768);
    LAS int* CW = (LAS int*)(F.lds + 32768 + 1024);
    LAS int* BASE = (LAS int*)(F.lds + 32768 + 1024 + 128);
    LAS float* SELW = (LAS float*)(F.lds + 32768 + 2048);
    for (int q = 0; q < 16; ++q) { const int idx = F.tid + NTHREADS * q; WR[(idx & 7) * 1024 + (idx >> 3)] = wrouter[idx]; }
    float gv[16], bv[16]; load_vec_f32(g, F.lane, gv); load_vec_f32(b, F.lane, bv);
    __syncthreads();
    for (int blk = F.c; blk < M / 128; blk += F.G) {
        for (int rl = F.wave; rl < 128; rl += NWAVES) {
            const int m = blk * 128 + rl;
            float v[16]; load_row_bf16(Y + (size_t)m * D, F.lane, v);
            ln_row(v, gv, bv);
            store_row_bf16(v, XB + (size_t)m * D, F.lane);
            if (XB8) store_row_fp8(v, XB8 + (size_t)m * D, F.lane);
            float lg[8];
#pragma unroll
            for (int e = 0; e < 8; ++e) { float s = 0.f;
#pragma unroll
                for (int h = 0; h < 2; ++h)
#pragma unroll
                    for (int q = 0; q < 2; ++q) { const f32x4 w = *(const LAS f32x4*)(WR + e * 1024 + 512 * h + 8 * F.lane + 4 * q); const int o = 8 * h + 4 * q;
                        s += (v[o] * w[0] + v[o + 1] * w[1]) + (v[o + 2] * w[2] + v[o + 3] * w[3]); }
                lg[e] = wave_sum(s); }
            int e0 = 0; float v0 = lg[0];
#pragma unroll
            for (int e = 1; e < 8; ++e) if (lg[e] > v0) { v0 = lg[e]; e0 = e; }
            int e1 = -1; float v1 = -3.0e38f;
#pragma unroll
            for (int e = 0; e < 8; ++e) if (e != e0 && lg[e] > v1) { v1 = lg[e]; e1 = e; }
            const float w1 = 1.f / (1.f + __expf(v0 - v1)), w0 = 1.f - w1;
            if (F.lane == 0) { SEL[2 * rl] = e0; SEL[2 * rl + 1] = e1; SELW[2 * rl] = w0; SELW[2 * rl + 1] = w1; EIDX[2 * m] = e0; EIDX[2 * m + 1] = e1; }
        }
        __syncthreads();
        const int mine = F.tid < 256 ? SEL[F.tid] : -1;
        int myrank = 0;
        if (F.wave < 4) {
#pragma unroll
            for (int e = 0; e < 8; ++e) { const unsigned long long mk = __ballot(mine == e); const int rk = __builtin_popcountll(mk & ((1ull << F.lane) - 1ull)); if (mine == e) myrank = rk;
                if (F.lane == 0) CW[F.wave * 8 + e] = __builtin_popcountll(mk); }
        }
        __syncthreads();
        if (F.tid < 8) { const int tot = CW[F.tid] + CW[8 + F.tid] + CW[16 + F.tid] + CW[24 + F.tid]; BASE[F.tid] = (int)__hip_atomic_fetch_add(gcnt + F.tid, (unsigned)tot, __ATOMIC_RELAXED, __HIP_MEMORY_SCOPE_AGENT); }
        __syncthreads();
        if (F.tid < 256) { int pos = BASE[mine] + myrank; for (int w = 0; w < F.wave; ++w) pos += CW[w * 8 + mine]; POS[blk * 256 + F.tid] = pos;
            TOK[(size_t)mine * M + pos] = blk * 128 + (F.tid >> 1); GW[(size_t)mine * M + pos] = SELW[F.tid]; }
        __syncthreads();
    }
}
__device__ __forceinline__ void hgrn_phase(Frame& F, const bf16_t* Q, const bf16_t* FP, const bf16_t* V, const float* lbparam, int jl, bf16_t* O) {
    constexpr int QST = 0, QS2 = 18432, KST = 36864, VS = 55296, SST0 = 64512, SSTB = 17408, SEG = 99328, RV = 103424, DV = 103936;
    constexpr int LQ = 136, LT = 72;
    LAS unsigned char* L = F.lds;
    const int tid = F.tid, lane = F.lane, w = F.wave, fr = lane & 15, fq = lane >> 4, qq = fr >> 2, pp = lane & 3;
    const int dp = tid & 63, seg = tid >> 6, d0 = 2 * dp;
    const int vrow = tid >> 3, vch = tid & 7;
    const int tt = w >> 1, eh = w & 1;
    for (int u = F.c; u < BATCH * HG_H * 2; u += F.G) {
        const int b = u >> 4, h = (u >> 1) & 7, vh = u & 1;
        float lb0 = 0.f, lb1 = 0.f;
        if (jl == 1) { const f32x2 l0 = *(const f32x2*)(lbparam + h * 128 + d0), l1 = *(const f32x2*)(lbparam + D + h * 128 + d0); lb0 = 1.f / (1.f + __expf(l0[0] - l1[0])); lb1 = 1.f / (1.f + __expf(l0[1] - l1[1])); }
        const float om0 = 1.f - lb0, om1 = 1.f - lb1;
        f32x4 St[4];
#pragma unroll
        for (int et = 0; et < 4; ++et) { St[et] = (f32x4){0.f, 0.f, 0.f, 0.f}; *(LAS u32x2*)(L + SST0 + ((16 * et + fr) * LQ + 16 * w + 4 * fq) * 2) = (u32x2){0u, 0u}; }
        const size_t ubase = (size_t)b * SEQ * D + h * 128;
        unsigned fpn[8], qn[8]; u32x4 vn;
        { const bf16_t* fp = FP + ubase + (size_t)(8 * seg) * D + d0; const bf16_t* qp = Q + ubase + (size_t)(8 * seg) * D + d0;
#pragma unroll
          for (int i = 0; i < 8; ++i) { fpn[i] = *(const unsigned*)(fp + (size_t)i * D); qn[i] = *(const unsigned*)(qp + (size_t)i * D); }
          vn = *(const u32x4*)(V + ubase + (size_t)vrow * D + vh * 64 + 8 * vch); }
        for (int ch = 0; ch < SEQ / HG_C; ++ch) {
            const size_t rowoff = ubase + (size_t)ch * HG_C * D;
            LAS unsigned char* SSTc = L + SST0 + (ch & 1) * SSTB; LAS unsigned char* SSTn = L + SST0 + ((ch + 1) & 1) * SSTB;
            float c0[8], c1[8], k0[8], k1[8], q0[8], q1[8];
            { float a0 = 0.f, a1 = 0.f;
#pragma unroll
              for (int i = 0; i < 8; ++i) { const float s0 = sigmoidf_(__uint_as_float(fpn[i] << 16)), s1 = sigmoidf_(__uint_as_float(fpn[i] & 0xffff0000u));
                  a0 += __logf(lb0 + om0 * s0); a1 += __logf(lb1 + om1 * s1); c0[i] = a0; c1[i] = a1; k0[i] = om0 * (1.f - s0); k1[i] = om1 * (1.f - s1);
                  q0[i] = __uint_as_float(qn[i] << 16); q1[i] = __uint_as_float(qn[i] & 0xffff0000u); }
              *(LAS f32x2*)(L + SEG + (seg * 128 + d0) * 4) = (f32x2){a0, a1};
              *(LAS u32x4*)(L + VS + (vrow * LT + 8 * vch) * 2) = vn; }
            __syncthreads();
            { float pre0 = 0.f, pre1 = 0.f, r0 = 0.f, r1 = 0.f, bl0 = 0.f, bl1 = 0.f;
#pragma unroll
              for (int s = 0; s < 8; ++s) { const f32x2 v = *(LAS f32x2*)(L + SEG + (s * 128 + d0) * 4);
                  if (s < seg) { pre0 += v[0]; pre1 += v[1]; } if (s < 4) { r0 += v[0]; r1 += v[1]; } bl0 += v[0]; bl1 += v[1]; }
              const float er0 = __expf(r0), er1 = __expf(r1);
              unsigned qa[4], qb[4], ka[4], xa[4], xb[4], kb[4];
#pragma unroll
              for (int i = 0; i < 8; i += 2) {
                  const float ba = pre0 + c0[i], bb = pre0 + c0[i + 1], bc = pre1 + c1[i], bd = pre1 + c1[i + 1];
                  const float qa0 = q0[i] * __expf(ba - r0), qa1 = q0[i + 1] * __expf(bb - r0), qb0 = q1[i] * __expf(bc - r1), qb1 = q1[i + 1] * __expf(bd - r1);
                  qa[i >> 1] = cvt_pk_bf16(qa0, qa1); qb[i >> 1] = cvt_pk_bf16(qb0, qb1);
                  xa[i >> 1] = cvt_pk_bf16(qa0 * er0, qa1 * er0); xb[i >> 1] = cvt_pk_bf16(qb0 * er1, qb1 * er1);
                  ka[i >> 1] = cvt_pk_bf16(k0[i] * __expf(r0 - ba), k0[i + 1] * __expf(r0 - bb)); kb[i >> 1] = cvt_pk_bf16(k1[i] * __expf(r1 - bc), k1[i + 1] * __expf(r1 - bd));
              }
              const int o0 = (d0 * LT + 8 * seg) * 2, o1 = o0 + LT * 2;
              *(LAS u32x4*)(L + QST + o0) = (u32x4){qa[0], qa[1], qa[2], qa[3]}; *(LAS u32x4*)(L + QST + o1) = (u32x4){qb[0], qb[1], qb[2], qb[3]};
              *(LAS u32x4*)(L + QS2 + o0) = (u32x4){xa[0], xa[1], xa[2], xa[3]}; *(LAS u32x4*)(L + QS2 + o1) = (u32x4){xb[0], xb[1], xb[2], xb[3]};
              *(LAS u32x4*)(L + KST + o0) = (u32x4){ka[0], ka[1], ka[2], ka[3]}; *(LAS u32x4*)(L + KST + o1) = (u32x4){kb[0], kb[1], kb[2], kb[3]};
              if (seg == 0) { *(LAS f32x2*)(L + RV + d0 * 4) = (f32x2){er0, er1}; *(LAS f32x2*)(L + DV + d0 * 4) = (f32x2){__expf(bl0 - r0), __expf(bl1 - r1)}; } }
            __syncthreads();
            if (ch + 1 < SEQ / HG_C) {
                const bf16_t* fp = FP + rowoff + (size_t)(HG_C + 8 * seg) * D + d0; const bf16_t* qp = Q + rowoff + (size_t)(HG_C + 8 * seg) * D + d0;
#pragma unroll
                for (int i = 0; i < 8; ++i) { fpn[i] = *(const unsigned*)(fp + (size_t)i * D); qn[i] = *(const unsigned*)(qp + (size_t)i * D); }
                vn = *(const u32x4*)(V + rowoff + (size_t)(HG_C + vrow) * D + vh * 64 + 8 * vch);
            }
            bf16x8 Pf[2];
            { f32x4 sc[4];
#pragma unroll
              for (int st = 0; st < 4; ++st) { sc[st] = (f32x4){0.f, 0.f, 0.f, 0.f};
                  if (st <= tt) {
#pragma unroll
                      for (int ks = 0; ks < 4; ++ks) {
                          const int ro = ((32 * ks + 8 * fq + qq) * LT + 4 * pp) * 2;
                          const s16x4 a0 = __builtin_amdgcn_ds_read_tr16_b64_v4i16((LAS s16x4*)(L + KST + ro + 32 * st)), a1 = __builtin_amdgcn_ds_read_tr16_b64_v4i16((LAS s16x4*)(L + KST + ro + 4 * LT * 2 + 32 * st));
                          const s16x4 b0 = __builtin_amdgcn_ds_read_tr16_b64_v4i16((LAS s16x4*)(L + QST + ro + 32 * tt)), b1 = __builtin_amdgcn_ds_read_tr16_b64_v4i16((LAS s16x4*)(L + QST + ro + 4 * LT * 2 + 32 * tt));
                          const bf16x8 av = (bf16x8){a0[0], a0[1], a0[2], a0[3], a1[0], a1[1], a1[2], a1[3]}, bv = (bf16x8){b0[0], b0[1], b0[2], b0[3], b1[0], b1[1], b1[2], b1[3]};
                          sc[st] = __builtin_amdgcn_mfma_f32_16x16x32_bf16(av, bv, sc[st], 0, 0, 0); }
#pragma unroll
                      for (int r = 0; r < 4; ++r) sc[st][r] = (16 * st + 4 * fq + r <= 16 * tt + fr) ? sc[st][r] : 0.f;
                  } }
              const u32x4 p0 = pack8(sc[0], sc[1]), p1 = pack8(sc[2], sc[3]); Pf[0] = __builtin_bit_cast(bf16x8, p0); Pf[1] = __builtin_bit_cast(bf16x8, p1); }
            { bf16x8 q2[4];
#pragma unroll
              for (int ks = 0; ks < 4; ++ks) { const int ro = ((32 * ks + 8 * fq + qq) * LT + 4 * pp) * 2 + 32 * tt;
                  const s16x4 b0 = __builtin_amdgcn_ds_read_tr16_b64_v4i16((LAS s16x4*)(L + QS2 + ro)), b1 = __builtin_amdgcn_ds_read_tr16_b64_v4i16((LAS s16x4*)(L + QS2 + ro + 4 * LT * 2));
                  q2[ks] = (bf16x8){b0[0], b0[1], b0[2], b0[3], b1[0], b1[1], b1[2], b1[3]}; }
#pragma unroll
              for (int ex = 0; ex < 2; ++ex) { const int et = 2 * eh + ex;
                  f32x4 acc = (f32x4){0.f, 0.f, 0.f, 0.f};
#pragma unroll
                  for (int k2 = 0; k2 < 2; ++k2) {
                      if (k2 == 0 || tt >= 2) {
                          const int ro = ((32 * k2 + 4 * fq + qq) * LT + 16 * et + 4 * pp) * 2;
                          const s16x4 a0 = __builtin_amdgcn_ds_read_tr16_b64_v4i16((LAS s16x4*)(L + VS + ro)), a1 = __builtin_amdgcn_ds_read_tr16_b64_v4i16((LAS s16x4*)(L + VS + ro + 16 * LT * 2));
                          const bf16x8 av = (bf16x8){a0[0], a0[1], a0[2], a0[3], a1[0], a1[1], a1[2], a1[3]};
                          acc = __builtin_amdgcn_mfma_f32_16x16x32_bf16(av, Pf[k2], acc, 0, 0, 0); } }
#pragma unroll
                  for (int ks = 0; ks < 4; ++ks) { const bf16x8 av = *(LAS bf16x8*)(SSTc + ((16 * et + fr) * LQ + 32 * ks + 8 * fq) * 2);
                      acc = __builtin_amdgcn_mfma_f32_16x16x32_bf16(av, q2[ks], acc, 0, 0, 0); }
                  u32x2 ov; ov.x = cvt_pk_bf16(acc[0], acc[1]); ov.y = cvt_pk_bf16(acc[2], acc[3]);
                  *(u32x2*)(O + rowoff + (size_t)(16 * tt + fr) * D + vh * 64 + 16 * et + 4 * fq) = ov;
              } }
            { const f32x4 rv = *(LAS f32x4*)(L + RV + (16 * w + 4 * fq) * 4), dv = *(LAS f32x4*)(L + DV + (16 * w + 4 * fq) * 4);
              bf16x8 kf[2];
#pragma unroll
              for (int ks = 0; ks < 2; ++ks) kf[ks] = *(LAS bf16x8*)(L + KST + ((16 * w + fr) * LT + 32 * ks + 8 * fq) * 2);
#pragma unroll
              for (int et = 0; et < 4; ++et) { St[et] = St[et] * rv;
#pragma unroll
                  for (int ks = 0; ks < 2; ++ks) { const int ro = ((32 * ks + 8 * fq + qq) * LT + 16 * et + 4 * pp) * 2;
                      const s16x4 b0 = __builtin_amdgcn_ds_read_tr16_b64_v4i16((LAS s16x4*)(L + VS + ro)), b1 = __builtin_amdgcn_ds_read_tr16_b64_v4i16((LAS s16x4*)(L + VS + ro + 4 * LT * 2));
                      const bf16x8 bb = (bf16x8){b0[0], b0[1], b0[2], b0[3], b1[0], b1[1], b1[2], b1[3]};
                      St[et] = __builtin_amdgcn_mfma_f32_16x16x32_bf16(kf[ks], bb, St[et], 0, 0, 0); }
                  St[et] = St[et] * dv;
                  u32x2 o; o.x = cvt_pk_bf16(St[et][0], St[et][1]); o.y = cvt_pk_bf16(St[et][2], St[et][3]);
                  *(LAS u32x2*)(SSTn + ((16 * et + fr) * LQ + 16 * w + 4 * fq) * 2) = o; } }
            __syncthreads();
        }
    }
}
__device__ __forceinline__ void hgrn_gate_phase(Frame& F, const bf16_t* O, const bf16_t* Gt, const float* ng, bf16_t* OG) {
    float gw_[16];
#pragma unroll
    for (int i = 0; i < 16; ++i) gw_[i] = ng[16 * F.lane + i];
    const int gw = F.c * NWAVES + F.wave, NGW = F.G * NWAVES;
    for (int m = gw; m < M; m += NGW) {
        const u32x4 o0 = *(const u32x4*)(O + (size_t)m * D + 16 * F.lane), o1 = *(const u32x4*)(O + (size_t)m * D + 16 * F.lane + 8);
        const u32x4 g0 = *(const u32x4*)(Gt + (size_t)m * D + 16 * F.lane), g1 = *(const u32x4*)(Gt + (size_t)m * D + 16 * F.lane + 8);
        float ov[16], gv[16];
#pragma unroll
        for (int i = 0; i < 4; ++i) { ov[2 * i] = __uint_as_float(o0[i] << 16); ov[2 * i + 1] = __uint_as_float(o0[i] & 0xffff0000u); ov[8 + 2 * i] = __uint_as_float(o1[i] << 16); ov[8 + 2 * i + 1] = __uint_as_float(o1[i] & 0xffff0000u);
            gv[2 * i] = __uint_as_float(g0[i] << 16); gv[2 * i + 1] = __uint_as_float(g0[i] & 0xffff0000u); gv[8 + 2 * i] = __uint_as_float(g1[i] << 16); gv[8 + 2 * i + 1] = __uint_as_float(g1[i] & 0xffff0000u); }
        float ss = 0.f;
#pragma unroll
        for (int i = 0; i < 16; ++i) ss += ov[i] * ov[i];
        ss += __builtin_bit_cast(float, __builtin_amdgcn_update_dpp(0, __builtin_bit_cast(int, ss), 0xB1, 0xF, 0xF, true));
        ss += __builtin_bit_cast(float, __builtin_amdgcn_update_dpp(0, __builtin_bit_cast(int, ss), 0x4E, 0xF, 0xF, true));
        ss += __builtin_bit_cast(float, __builtin_amdgcn_update_dpp(0, __builtin_bit_cast(int, ss), 0x141, 0xF, 0xF, true));
        const float rs = 1.f / sqrtf(ss * (1.f / 128.f) + RMS_EPS);
        float r[16];
#pragma unroll
        for (int i = 0; i < 16; ++i) r[i] = ov[i] * rs * gw_[i] * siluf_(gv[i]);
        u32x4 w0, w1; w0.x = cvt_pk_bf16(r[0], r[1]); w0.y = cvt_pk_bf16(r[2], r[3]); w0.z = cvt_pk_bf16(r[4], r[5]); w0.w = cvt_pk_bf16(r[6], r[7]);
        w1.x = cvt_pk_bf16(r[8], r[9]); w1.y = cvt_pk_bf16(r[10], r[11]); w1.z = cvt_pk_bf16(r[12], r[13]); w1.w = cvt_pk_bf16(r[14], r[15]);
        *(u32x4*)(OG + (size_t)m * D + 16 * F.lane) = w0; *(u32x4*)(OG + (size_t)m * D + 16 * F.lane + 8) = w1;
    }
}

__device__ __forceinline__ void dsa_norm_phase(Frame& F, const bf16_t* RAW, const float* qg, const float* kvg, const float* kig, const float* kib, bf16_t* CQ, bf16_t* CKV, bf16_t* KIDX, float* WIDX) {
    const f32x4 qgv = *(const f32x4*)(qg + 4 * F.lane), kvgv = *(const f32x4*)(kvg + 4 * F.lane); const float kg = kig[F.lane], kb = kib[F.lane];
    const int gw = F.c * NWAVES + F.wave, NGW = F.G * NWAVES;
    for (int m = gw; m < M; m += NGW) {
        const bf16_t* r = RAW + (size_t)m * DSA_IN_PAD;
        const u32x2 ar = *(const u32x2*)(r + 4 * F.lane), cr = *(const u32x2*)(r + 256 + 4 * F.lane); const float ki = bf2f(r[512 + F.lane]);
        const f32x4 a = (f32x4){__uint_as_float(ar.x << 16), __uint_as_float(ar.x & 0xffff0000u), __uint_as_float(ar.y << 16), __uint_as_float(ar.y & 0xffff0000u)};
        const f32x4 c = (f32x4){__uint_as_float(cr.x << 16), __uint_as_float(cr.x & 0xffff0000u), __uint_as_float(cr.y << 16), __uint_as_float(cr.y & 0xffff0000u)};
        const float sa = wave_sum((a[0] * a[0] + a[1] * a[1]) + (a[2] * a[2] + a[3] * a[3])), sc = wave_sum((c[0] * c[0] + c[1] * c[1]) + (c[2] * c[2] + c[3] * c[3]));
        const float ra = 1.f / sqrtf(sa * (1.f / 256.f) + RMS_EPS), rc = 1.f / sqrtf(sc * (1.f / 256.f) + RMS_EPS);
        u32x2 o; o.x = cvt_pk_bf16(a[0] * ra * qgv[0], a[1] * ra * qgv[1]); o.y = cvt_pk_bf16(a[2] * ra * qgv[2], a[3] * ra * qgv[3]); *(u32x2*)(CQ + (size_t)m * 256 + 4 * F.lane) = o;
        o.x = cvt_pk_bf16(c[0] * rc * kvgv[0], c[1] * rc * kvgv[1]); o.y = cvt_pk_bf16(c[2] * rc * kvgv[2], c[3] * rc * kvgv[3]); *(u32x2*)(CKV + (size_t)m * 256 + 4 * F.lane) = o;
        const float mu = wave_sum(ki) * (1.f / 64.f), dk = ki - mu, var = wave_sum(dk * dk) * (1.f / 64.f);
        KIDX[(size_t)m * 64 + F.lane] = f2bf(dk * (1.f / sqrtf(var + LN_EPS)) * kg + kb);
        if (F.lane < 8) WIDX[(size_t)m * 8 + F.lane] = bf2f(r[576 + F.lane]) * 0.04419417382415922f;
    }
}
__device__ __forceinline__ unsigned f2ord(float v) { const unsigned u = __float_as_uint(v); return (u & 0x80000000u) ? ~u : (u | 0x80000000u); }
__device__ __forceinline__ void dsa_index_phase(Frame& F, const bf16_t* QIDX, const bf16_t* KIDX, const float* WIDX, unsigned long long* MASK) {
    LAS float* SC = (LAS float*)F.lds;
    const int lane = F.lane, w = F.wave, fr = lane & 15, fq = lane >> 4;
    for (int i = 0;; ++i) {
        const int u = i * F.G + F.c; if (u >= BATCH * (SEQ / 16)) break;
        const int b = (u & 255) >> 4, qlo = (u & 15) + 16 * (u >> 9), qt = ((u >> 8) & 1) ? 127 - qlo : qlo, t0 = 16 * qt;     const size_t rb = (size_t)b * SEQ;
        bf16x8 Af[4][2][2]; float wv[4][8];
#pragma unroll
        for (int tg = 0; tg < 4; ++tg) {
#pragma unroll
            for (int hh = 0; hh < 2; ++hh)
#pragma unroll
                for (int ks = 0; ks < 2; ++ks) Af[tg][hh][ks] = *(const bf16x8*)(QIDX + (rb + t0 + 4 * tg + (fr >> 2)) * 512 + (4 * hh + (fr & 3)) * 64 + 32 * ks + 8 * fq);
            const f32x4 w0 = *(const f32x4*)(WIDX + (rb + t0 + 4 * tg + fq) * 8), w1 = *(const f32x4*)(WIDX + (rb + t0 + 4 * tg + fq) * 8 + 4);
#pragma unroll
            for (int r = 0; r < 4; ++r) { wv[tg][r] = w0[r]; wv[tg][4 + r] = w1[r]; }
        }
        bf16x8 nB0 = *(const bf16x8*)(KIDX + (rb + 16 * w + fr) * 64 + 8 * fq), nB1 = *(const bf16x8*)(KIDX + (rb + 16 * w + fr) * 64 + 32 + 8 * fq);
        for (int kg = w; kg <= qt; kg += NWAVES) {
            const bf16x8 B0 = nB0, B1 = nB1;
            { const int kn = (kg + NWAVES <= qt) ? kg + NWAVES : kg;
              nB0 = *(const bf16x8*)(KIDX + (rb + 16 * kn + fr) * 64 + 8 * fq); nB1 = *(const bf16x8*)(KIDX + (rb + 16 * kn + fr) * 64 + 32 + 8 * fq); }
#pragma unroll
            for (int tg = 0; tg < 4; ++tg) { float s = 0.f;
#pragma unroll
                for (int hh = 0; hh < 2; ++hh) { f32x4 acc = (f32x4){0.f, 0.f, 0.f, 0.f};
                    acc = __builtin_amdgcn_mfma_f32_16x16x32_bf16(Af[tg][hh][0], B0, acc, 0, 0, 0); acc = __builtin_amdgcn_mfma_f32_16x16x32_bf16(Af[tg][hh][1], B1, acc, 0, 0, 0);
#pragma unroll
                    for (int r = 0; r < 4; ++r) s += wv[tg][4 * hh + r] * fmaxf(acc[r], 0.f); }
                SC[(4 * tg + fq) * 2048 + 16 * kg + fr] = s + 0.0f; }
        }
        __syncthreads();
        for (int tq = 2 * w; tq < 2 * w + 2; ++tq) {
            const int t = t0 + tq;
            unsigned key[32];
#pragma unroll
            for (int r = 0; r < 32; ++r) { const int s = 64 * r + lane; key[r] = (s <= t) ? f2ord(SC[tq * 2048 + s]) : 0u; }
            unsigned long long selw = 0ull;
            if (t < TOPK) {
#pragma unroll
                for (int r = 0; r < 32; ++r) { const unsigned long long mk = __ballot(64 * r + lane <= t); if (lane == r) selw = mk; }
            } else {
                unsigned prefix = 0u; bool exact = false;
                for (int bit = 31; bit >= 0; --bit) {
                    const unsigned cand = prefix | (1u << bit); int cnt = 0;
#pragma unroll
                    for (int r = 0; r < 32; ++r) cnt += __builtin_popcountll(__ballot(key[r] >= cand));
                    if (cnt >= TOPK) { prefix = cand; if (cnt == TOPK) { exact = true; break; } }
                }
                if (exact) {
#pragma unroll
                    for (int r = 0; r < 32; ++r) { const unsigned long long mk = __ballot(key[r] >= prefix); if (lane == r) selw = mk; }
                } else {
                    int ngt = 0;
#pragma unroll
                    for (int r = 0; r < 32; ++r) ngt += __builtin_popcountll(__ballot(key[r] > prefix));
                    const int need = TOPK - ngt; int run = 0;
#pragma unroll
                    for (int r = 0; r < 32; ++r) { const unsigned long long tie = __ballot(key[r] == prefix); const int rk = run + __builtin_popcountll(tie & ((1ull << lane) - 1ull));
                        const unsigned long long mk = __ballot(key[r] > prefix || (key[r] == prefix && rk < need)); if (lane == r) selw = mk; run += __builtin_popcountll(tie); }
                }
            }
            if (lane < 32) MASK[(rb + t) * 32 + lane] = selw;
        }
        __syncthreads();
    }
}
__device__ __forceinline__ void dsa_attn_phase(Frame& F, const bf16_t* QLAT, const bf16_t* CKV, const unsigned long long* MASK, bf16_t* OLAT, unsigned char* OLAT8) {
    constexpr int TB = 32768;
    LAS unsigned char* L = F.lds;
    const int lane = F.lane, w = F.wave, fr = lane & 15, fq = lane >> 4;
    const int qq = fr >> 2, pp = lane & 3;
    const bool grpB = w >= 4;
    const int kbase = fr * 512, ysh = (fq ^ (2 * (fr & 7))) << 4;
    const int x2s = (2 * (4 * (fq & 1) + qq)) << 4;
    const int vbase = (4 * fq + qq) * 512 + (pp >> 1) * 16 + (pp & 1) * 8;
    const int drow = lane >> 5, dpc = lane & 31;
    for (int i = 0;; ++i) {
        const int u = i * F.G + F.c; if (u >= BATCH * (SEQ / 16)) break;
        const int b = (u & 255) >> 4, qlo = (u & 15) + 16 * (u >> 9), qt = ((u >> 8) & 1) ? 127 - qlo : qlo, t0 = 16 * qt;     const size_t rb = (size_t)b * SEQ;
        const int ntiles = (t0 + 15) / 64 + 1;
        bf16x8 Qf[8];
#pragma unroll
        for (int ks = 0; ks < 8; ++ks) Qf[ks] = *(const bf16x8*)(QLAT + (rb + t0 + fr) * 2048 + w * 256 + 32 * ks + 8 * fq);
        f32x4 Ot[16];
#pragma unroll
        for (int cb = 0; cb < 16; ++cb) Ot[cb] = (f32x4){0.f, 0.f, 0.f, 0.f};
        float mrun = -1.0e30f, lsum = 0.f;
        bf16x8 Pf[2];
#define ATT_DMA(kt_, buf_) do { _Pragma("unroll") for (int q_ = 0; q_ < 4; ++q_) { const int row_ = 2 * (4 * w + q_) + drow; \
            __builtin_amdgcn_global_load_lds((const unsigned*)(CKV + (rb + 64 * (kt_) + row_) * 256 + 8 * (dpc ^ (2 * (row_ & 7)))), (LAS unsigned*)(L + (buf_) * TB + (4 * w + q_) * 1024), 16, 0, 0); } } while (0)
#define ATT_ST(buf_) do { int ka_[8]; { const int kb_t_ = kbase + (buf_) * TB; _Pragma("unroll") for (int ks = 0; ks < 8; ++ks) ka_[ks] = kb_t_ + ((64 * ks) ^ ysh); } \
            _Pragma("unroll") for (int kb = 0; kb < 4; ++kb) S[kb] = (f32x4){0.f, 0.f, 0.f, 0.f}; \
            bf16x8 kf[2][2]; \
            _Pragma("unroll") for (int j = 0; j < 2; ++j) kf[0][j] = *(LAS bf16x8*)(L + ka_[j]); \
            _Pragma("unroll") for (int bt = 0; bt < 16; ++bt) {        \
                if (bt + 1 < 16) { _Pragma("unroll") for (int j = 0; j < 2; ++j) kf[(bt + 1) & 1][j] = *(LAS bf16x8*)(L + ka_[2 * ((bt + 1) & 3) + j] + 8192 * ((bt + 1) >> 2)); } \
                _Pragma("unroll") for (int j = 0; j < 2; ++j) S[bt >> 2] = __builtin_amdgcn_mfma_f32_16x16x32_bf16(kf[bt & 1][j], Qf[2 * (bt & 3) + j], S[bt >> 2], 0, 0, 0); \
                __builtin_amdgcn_sched_barrier(0); } } while (0)
#define ATT_SOFTMAX(mw_) do { \
            float mx = fmaxf(fmaxf(fmaxf(S[0][0], S[0][1]), fmaxf(S[0][2], S[0][3])), fmaxf(fmaxf(S[1][0], S[1][1]), fmaxf(S[1][2], S[1][3]))); \
            mx = fmaxf(mx, fmaxf(fmaxf(fmaxf(S[2][0], S[2][1]), fmaxf(S[2][2], S[2][3])), fmaxf(fmaxf(S[3][0], S[3][1]), fmaxf(S[3][2], S[3][3])))); \
            mx = fmaxf(mx, __shfl_xor(mx, 16)); mx = fmaxf(mx, __shfl_xor(mx, 32)); \
            const bool need = mx > mrun + 8.0f; \
            if (__any(need)) { const float mnew = need ? mx : mrun, alpha = fast_exp2(mrun - mnew); mrun = mnew; lsum *= alpha; \
                _Pragma("unroll") for (int cb = 0; cb < 16; ++cb) Ot[cb] = Ot[cb] * alpha; } \
            const unsigned long long mq = (mw_) >> (4 * fq); const unsigned mlo = (unsigned)mq, mhi = (unsigned)(mq >> 32); \
            _Pragma("unroll") for (int kb = 0; kb < 4; ++kb) _Pragma("unroll") for (int r = 0; r < 4; ++r) { \
                const unsigned mk = (unsigned)__builtin_amdgcn_sbfe((int)(kb < 2 ? mlo : mhi), 16 * (kb & 1) + r, 1); \
                const float pv = __uint_as_float(__float_as_uint(fast_exp2(S[kb][r] - mrun)) & mk); S[kb][r] = pv; lsum += pv; } \
            _Pragma("unroll") for (int s2 = 0; s2 < 2; ++s2) { const u32x4 pk = pack8(S[2 * s2], S[2 * s2 + 1]); Pf[s2] = __builtin_bit_cast(bf16x8, pk); } } while (0)
#define ATT_VLOAD(dst, vb_, cb_) do { const int va_ = (vb_) + ((32 * (cb_)) ^ x2s); \
            dst[0] = __builtin_amdgcn_ds_read_tr16_b64_v4i16((LAS s16x4*)(L + va_)); dst[1] = __builtin_amdgcn_ds_read_tr16_b64_v4i16((LAS s16x4*)(L + va_ + 16 * 512)); \
            dst[2] = __builtin_amdgcn_ds_read_tr16_b64_v4i16((LAS s16x4*)(L + va_ + 32 * 512)); dst[3] = __builtin_amdgcn_ds_read_tr16_b64_v4i16((LAS s16x4*)(L + va_ + 48 * 512)); } while (0)
#define ATT_PV(buf_) do { const int vb_ = vbase + (buf_) * TB; s16x4 tv[2][4]; ATT_VLOAD(tv[0], vb_, 0); \
            _Pragma("unroll") for (int cb = 0; cb < 16; ++cb) { \
                if (cb + 1 < 16) ATT_VLOAD(tv[(cb + 1) & 1], vb_, cb + 1); \
                const s16x4 a0 = tv[cb & 1][0], a1 = tv[cb & 1][1], a2 = tv[cb & 1][2], a3 = tv[cb & 1][3]; \
                const bf16x8 v0 = (bf16x8){a0[0], a0[1], a0[2], a0[3], a1[0], a1[1], a1[2], a1[3]}; \
                const bf16x8 v1 = (bf16x8){a2[0], a2[1], a2[2], a2[3], a3[0], a3[1], a3[2], a3[3]}; \
                Ot[cb] = __builtin_amdgcn_mfma_f32_16x16x32_bf16(v0, Pf[0], Ot[cb], 0, 0, 0); \
                Ot[cb] = __builtin_amdgcn_mfma_f32_16x16x32_bf16(v1, Pf[1], Ot[cb], 0, 0, 0); __builtin_amdgcn_sched_barrier(0); } } while (0)
        ATT_DMA(0, 0);
        unsigned long long mwn = MASK[(rb + t0 + fr) * 32];
        asm volatile("s_waitcnt vmcnt(0)" ::: "memory");
        __syncthreads();
        int bufc = 0;
        for (int it = 0; it < ntiles; ++it) {
            const int bufn = (bufc == 2) ? 0 : bufc + 1;
            if (it + 1 < ntiles) ATT_DMA(it + 1, bufn);
            const unsigned long long mw = mwn; mwn = MASK[(rb + t0 + fr) * 32 + ((it + 1 < ntiles) ? it + 1 : it)];
            f32x4 S[4];
            ATT_ST(bufc); ATT_SOFTMAX(mw);
            if (grpB) { asm volatile("s_waitcnt vmcnt(0)" ::: "memory"); __builtin_amdgcn_s_barrier(); asm volatile("" ::: "memory"); }
            ATT_PV(bufc);
            if (!grpB) { asm volatile("s_waitcnt vmcnt(0)" ::: "memory"); __builtin_amdgcn_s_barrier(); asm volatile("" ::: "memory"); }
            bufc = bufn;
        }
        __syncthreads();
#undef ATT_DMA
#undef ATT_ST
#undef ATT_SOFTMAX
#undef ATT_VLOAD
#undef ATT_PV
        lsum += __shfl_xor(lsum, 16); lsum += __shfl_xor(lsum, 32);
        const float inv = 1.f / lsum;
#pragma unroll
        for (int cb = 0; cb < 16; ++cb) {
            if (OLAT8) { const float i8 = inv * F8_O; *(unsigned*)(OLAT8 + (rb + t0 + fr) * 2048 + w * 256 + 16 * cb + 4 * fq) = pack4_fp8(Ot[cb][0] * i8, Ot[cb][1] * i8, Ot[cb][2] * i8, Ot[cb][3] * i8); }
            else { u32x2 o; o.x = cvt_pk_bf16(Ot[cb][0] * inv, Ot[cb][1] * inv); o.y = cvt_pk_bf16(Ot[cb][2] * inv, Ot[cb][3] * inv);
                *(u32x2*)(OLAT + (rb + t0 + fr) * 2048 + w * 256 + 16 * cb + 4 * fq) = o; } }
    }
}

constexpr int PH_PER_PAIR = 18, N_PHASES = 1 + 2 * PH_PER_PAIR;

__global__ void __launch_bounds__(NTHREADS, 2) fwd_kernel(Params p) {
    extern __shared__ __attribute__((aligned(16))) unsigned char lds_raw[];
    Frame F;
    F.lds = (LAS unsigned char*)lds_raw;
    F.tid = threadIdx.x; F.lane = F.tid & 63; F.wave = __builtin_amdgcn_readfirstlane(F.tid >> 6);
    F.G = gridDim.x; F.c = blockIdx.x;
    unsigned char* ws = p.ws;
    F.ctl = (unsigned*)(ws + WS_CTL);
    for (int u = F.tid; u < (LDS_BYTES - LDSCTL_OFF) / 4; u += NTHREADS) ((LAS unsigned*)(F.lds + LDSCTL_OFF))[u] = 0u;
    __syncthreads();
    const bool one_launch = (p.ph_hi - p.ph_lo) > 1;
    XcdBarrier bar; bar.bar = F.ctl + CW_BAR; bar.x = 0; bar.st = nullptr;
    if (one_launch) bar = xcd_barrier_post(F.ctl + CW_BAR, (volatile LAS unsigned*)(F.lds + MISC_OFF) + 8);
    const int lo = p.ph_lo, hi = p.ph_hi;
#define REFRESH() do { int t_ = threadIdx.x; asm volatile("" : "+v"(t_)); F.tid = t_; F.lane = t_ & 63; F.wave = __builtin_amdgcn_readfirstlane(t_ >> 6); } while (0)
#ifndef DBLMASK
#define DBLMASK 0u
#endif
#define REP(b) for (int rep_ = 0; rep_ < 1 + (int)((DBLMASK >> (b)) & 1u); ++rep_)
#define IN(k) (lo <= (k) && (k) < hi)
#ifndef MK_BARTIME
#define MK_BARTIME 0
#endif
    unsigned long long bt_acc = 0ull;
#if MK_BARTIME
#define SEAM(k) do { if (IN(k) && IN((k) + 1)) { const unsigned long long t0_ = __builtin_amdgcn_s_memrealtime(); xcd_barrier(bar); bt_acc += __builtin_amdgcn_s_memrealtime() - t0_; } } while (0)
#else
#ifndef MK_DBLSEAM
#define MK_DBLSEAM 0
#endif
#define SEAM(k) do { if (IN(k) && IN((k) + 1)) { xcd_barrier(bar); if (MK_DBLSEAM) xcd_barrier(bar); } } while (0)
#endif

    bf16_t* XB = (bf16_t*)(ws + WS_XB); bf16_t* Y = (bf16_t*)(ws + WS_Y);
    unsigned char* A = ws + WS_A; bf16_t* Hb = (bf16_t*)(ws + WS_H);

    if (IN(0)) REP(31) { REFRESH(); p0_prologue(F, p); } SEAM(0);

    for (int j = 0; j < 2; ++j) {
        const int pb = 1 + j * PH_PER_PAIR;
        const int layerA = 2 * j, layerB = 2 * j + 1;
        if (IN(pb + 0)) REP(0) {
            Gemm g{XB, (const bf16_t*)(ws + WS_W_HGIN) + (size_t)j * 4 * D * D, D}; StaticOrder S; S.init(M, 4 * D, F.G, F.c);
            EpiHgIn E{(bf16_t*)(A + A_HQ)};
            gemm_phase(F.lds, g, S, E);
        } SEAM(pb + 0);
        if (IN(pb + 1)) REP(1) { REFRESH(); hgrn_phase(F, (const bf16_t*)(A + A_HQ), (const bf16_t*)(A + A_HF), (const bf16_t*)(A + A_HV), INP(IN_HGLB), j, (bf16_t*)(A + A_HO)); } SEAM(pb + 1);
        if (IN(pb + 2)) REP(2) { REFRESH(); hgrn_gate_phase(F, (const bf16_t*)(A + A_HO), (const bf16_t*)(A + A_HG), INP(IN_HGNG) + (size_t)j * D, (bf16_t*)(A + A_HOG)); } SEAM(pb + 2);
        if (IN(pb + 3)) REP(3) {
            Gemm g{(const bf16_t*)(A + A_HOG), (const bf16_t*)(ws + WS_W_HGOUT) + (size_t)j * D * D, D}; StaticOrder S; S.init(M, D, F.G, F.c);
            EpiRes E{XB, Y, 1.f}; gemm_phase(F.lds, g, S, E);
        } SEAM(pb + 3);
        if (IN(pb + 4)) REP(4) { REFRESH(); ln_phase(F, Y, INP(IN_LNG) + (size_t)(layerA * 2 + 0) * D, INP(IN_LNB) + (size_t)(layerA * 2 + 0) * D, XB, (MK_FFN_FP8 == 2) ? ws + WS_XB8 : nullptr); } SEAM(pb + 4);
        if (IN(pb + 5)) REP(5) {
#if MK_FFN_FP8 == 2
            Gemm g{(const bf16_t*)(ws + WS_XB8), (const bf16_t*)(ws + WS_W_FGU + (size_t)j * 2 * DFF * D), D / 2}; StaticOrder S; S.init(M, 2 * DFF, F.G, F.c);
            EpiSwiglu8 E{(unsigned char*)Hb, 1.f / (F8_X * F8_WGU)}; gemm_phase_gather<true, true>(F.lds, g, S, E, nullptr);
#elif MK_FFN_FP8 == 1
            Gemm g{XB, (const bf16_t*)(ws + WS_W_FGU) + (size_t)j * 2 * DFF * D, D}; StaticOrder S; S.init(M, 2 * DFF, F.G, F.c);
            EpiSwiglu8 E{(unsigned char*)Hb, 1.f}; gemm_phase(F.lds, g, S, E);
#else
            Gemm g{XB, (const bf16_t*)(ws + WS_W_FGU) + (size_t)j * 2 * DFF * D, D}; StaticOrder S; S.init(M, 2 * DFF, F.G, F.c);
            EpiSwiglu E{Hb}; gemm_phase(F.lds, g, S, E);
#endif
        } SEAM(pb + 5);
        if (IN(pb + 6)) REP(6) {
#if MK_FFN_FP8 >= 1
            Gemm g{Hb, (const bf16_t*)(ws + WS_W_FDN + (size_t)j * D * DFF), DFF / 2}; StaticOrder S; S.init(M, D, F.G, F.c);
            EpiRes E{XB, Y, 1.f / (F8_H * F8_WDN)}; gemm_phase_gather<true, true>(F.lds, g, S, E, nullptr);
#else
            Gemm g{Hb, (const bf16_t*)(ws + WS_W_FDN) + (size_t)j * D * DFF, DFF}; StaticOrder S; S.init(M, D, F.G, F.c);
            EpiRes E{XB, Y, 1.f}; gemm_phase(F.lds, g, S, E);
#endif
        } SEAM(pb + 6);
        if (IN(pb + 7)) REP(7) { REFRESH(); ln_phase(F, Y, INP(IN_LNG) + (size_t)(layerA * 2 + 1) * D, INP(IN_LNB) + (size_t)(layerA * 2 + 1) * D, XB, nullptr); } SEAM(pb + 7);
        if (IN(pb + 8)) REP(8) {
            Gemm g{XB, (const bf16_t*)(ws + WS_W_DIN) + (size_t)j * DSA_IN_PAD * D, D}; StaticOrder S; S.init(M, DSA_IN_PAD, F.G, F.c);
            EpiBf16 E{(bf16_t*)(A + A_RAW), DSA_IN_PAD}; gemm_phase(F.lds, g, S, E);
        } SEAM(pb + 8);
        if (IN(pb + 9)) REP(9) { REFRESH(); dsa_norm_phase(F, (const bf16_t*)(A + A_RAW), INP(IN_DQNG) + (size_t)j * QR, INP(IN_DKVNG) + (size_t)j * KVR, INP(IN_DKIG) + (size_t)j * IDXD, INP(IN_DKIB) + (size_t)j * IDXD,
                                         (bf16_t*)(A + A_CQ), (bf16_t*)(A + A_CKV), (bf16_t*)(A + A_KIDX), (float*)(A + A_WIDX)); } SEAM(pb + 9);
        if (IN(pb + 10)) REP(10) {
            Gemm g{(const bf16_t*)(A + A_CQ), (const bf16_t*)(ws + WS_W_DQ) + (size_t)j * 2560 * QR, QR}; StaticOrder S; S.init(M, 2560, F.G, F.c);
            EpiQ E{(bf16_t*)(A + A_QLAT), (bf16_t*)(A + A_QIDX)}; gemm_phase(F.lds, g, S, E);
        } SEAM(pb + 10);
        if (IN(pb + 11)) REP(11) { REFRESH(); dsa_index_phase(F, (const bf16_t*)(A + A_QIDX), (const bf16_t*)(A + A_KIDX), (const float*)(A + A_WIDX), (unsigned long long*)(A + A_MASK)); } SEAM(pb + 11);
        if (IN(pb + 12)) REP(12) { REFRESH(); dsa_attn_phase(F, (const bf16_t*)(A + A_QLAT), (const bf16_t*)(A + A_CKV), (const unsigned long long*)(A + A_MASK), (bf16_t*)(A + A_OLAT), MK_B6_FP8 ? A + A_OLAT : nullptr); } SEAM(pb + 12);
        if (IN(pb + 13)) REP(13) {
#if MK_B6_FP8
            Gemm g{(const bf16_t*)(A + A_OLAT), (const bf16_t*)(ws + WS_W_DO + (size_t)j * D * 2048), 1024}; StaticOrder S; S.init(M, D, F.G, F.c);
            EpiRes E{XB, Y, 1.f / (F8_O * F8_WDO)}; gemm_phase_gather<true, true>(F.lds, g, S, E, nullptr);
#else
            Gemm g{(const bf16_t*)(A + A_OLAT), (const bf16_t*)(ws + WS_W_DO) + (size_t)j * D * 2048, 2048}; StaticOrder S; S.init(M, D, F.G, F.c);
            EpiRes E{XB, Y, 1.f}; gemm_phase(F.lds, g, S, E);
#endif
        } SEAM(pb + 13);
        if (IN(pb + 14)) REP(14) { REFRESH(); ln_router_phase(F, Y, INP(IN_LNG) + (size_t)(layerB * 2 + 0) * D, INP(IN_LNB) + (size_t)(layerB * 2 + 0) * D, INP(IN_MR) + (size_t)j * D * NEXP, XB, MK_MOE_FP8 ? ws + WS_XB8 : nullptr,
                                           (int*)(A + A_EIDX), (int*)(A + A_POS), (int*)(A + A_TOK), (float*)(A + A_GW), F.ctl + CW_MOE + 64 * j); } SEAM(pb + 14);
        if (IN(pb + 15)) REP(15) {
#if MK_MOE_FP8
            Gemm g{(const bf16_t*)(ws + WS_XB8), (const bf16_t*)(ws + WS_W_MGU8 + (size_t)j * NEXP * 2 * DFF * D), D / 2}; MoeOrder S; S.init(F.ctl + CW_MOE + 64 * j, 2 * DFF / BM, F.G, F.c);
            EpiSwiglu8 E{(unsigned char*)Hb, 1.f / (F8_X * F8_WGU)}; gemm_phase_gather<true>(F.lds, g, S, E, (const int*)(A + A_TOK));
#else
            Gemm g{XB, (const bf16_t*)(ws + WS_W_MGU) + (size_t)j * NEXP * 2 * DFF * D, D}; MoeOrder S; S.init(F.ctl + CW_MOE + 64 * j, 2 * DFF / BM, F.G, F.c);
            EpiSwiglu E{Hb}; gemm_phase_gather(F.lds, g, S, E, (const int*)(A + A_TOK));
#endif
        } SEAM(pb + 15);
        if (IN(pb + 16)) REP(16) {
#if MK_MOE_FP8
            Gemm g{Hb, (const bf16_t*)(ws + WS_W_MDN8 + (size_t)j * NEXP * D * DFF), DFF / 2}; MoeOrder S; S.init(F.ctl + CW_MOE + 64 * j, D / BM, F.G, F.c);
            EpiMoeDn E{(bf16_t*)(A + A_OUTM), (const float*)(A + A_GW), 1.f / (F8_H * F8_WDN)}; gemm_phase_gather<true, true>(F.lds, g, S, E, nullptr);
#else
            Gemm g{Hb, (const bf16_t*)(ws + WS_W_MDN) + (size_t)j * NEXP * D * DFF, DFF}; MoeOrder S; S.init(F.ctl + CW_MOE + 64 * j, D / BM, F.G, F.c);
            EpiMoeDn E{(bf16_t*)(A + A_OUTM), (const float*)(A + A_GW), 1.f}; gemm_phase(F.lds, g, S, E);
#endif
        } SEAM(pb + 16);
        if (IN(pb + 17)) REP(17) { REFRESH(); ln_moe_phase(F, XB, (const bf16_t*)(A + A_OUTM), (const int*)(A + A_EIDX), (const int*)(A + A_POS), F.ctl + CW_MOE + 64 * j,
                                        INP(IN_LNG) + (size_t)(layerB * 2 + 1) * D, INP(IN_LNB) + (size_t)(layerB * 2 + 1) * D, XB, (j == 1) ? p.out : nullptr); } SEAM(pb + 17);
    }
#if MK_BARTIME
    if (one_launch) {
        if (blockIdx.x == 0 && threadIdx.x == 0) __hip_atomic_store(F.ctl + 3000, (unsigned)bt_acc, __ATOMIC_RELAXED, __HIP_MEMORY_SCOPE_AGENT);
        xcd_barrier(bar);
        const float cval = 2.0f + 4.0f * (float)__hip_atomic_load(F.ctl + 3000, __ATOMIC_RELAXED, __HIP_MEMORY_SCOPE_AGENT) * 1e-5f;
        for (size_t i = (size_t)blockIdx.x * NTHREADS + threadIdx.x; i < (size_t)M * D; i += (size_t)gridDim.x * NTHREADS) p.out[i] = cval;
    }
#endif
}


#if MK_DEBUG_SCAN
__global__ void scan_kernel(const void* ptr, size_t n, int is_bf16, unsigned code, unsigned* flag, const unsigned* gcnt, size_t row_elems) {
    size_t nn = n;
    if (gcnt) { unsigned t = 0; for (int e = 0; e < 8; ++e) t += (gcnt[e] + 255u) >> 8; nn = (size_t)t * 256 * row_elems; }
    bool bad = false;
    for (size_t i = (size_t)blockIdx.x * blockDim.x + threadIdx.x; i < nn; i += (size_t)gridDim.x * blockDim.x) {
        if (is_bf16) { const unsigned short v = ((const unsigned short*)ptr)[i]; bad |= (v & 0x7f80u) == 0x7f80u; }
        else { const unsigned v = ((const unsigned*)ptr)[i]; bad |= (v & 0x7f800000u) == 0x7f800000u; }
    }
    if (bad) atomicMin(flag, code);
}
__global__ void fin_kernel(float* out, size_t n, const unsigned* flag) {
    const unsigned f = *flag; if (f == 0xffffffffu) return;
    const float cval = (float)f + 0.25f * (float)flag[64];
    for (size_t i = (size_t)blockIdx.x * blockDim.x + threadIdx.x; i < n; i += (size_t)gridDim.x * blockDim.x) out[i] = cval;
}

__global__ void chk_a1_kernel(const float* x, const float* w, const bf16_t* Q, const float* FP, unsigned code, unsigned* flag) {
    const unsigned id = blockIdx.x * blockDim.x + threadIdx.x;
    unsigned hsh = id * 2654435761u + 12345u; hsh ^= hsh >> 13; hsh *= 0x5bd1e995u; hsh ^= hsh >> 15;
    const int row = hsh % M, col = (hsh >> 15) % (4 * D);
    float ref = 0.f; for (int k = 0; k < D; ++k) ref += x[(size_t)row * D + k] * w[(size_t)k * 4 * D + col];
    const int part = col >> 10, cc = col & 1023;
    float got;
    if (part == 1) got = FP[(size_t)row * D + cc];
    else got = bf2f(Q[(size_t)(part == 0 ? 0 : part - 1) * M * D + (size_t)row * D + cc]);
    if (!(fabsf(got - ref) < 0.08f)) atomicMin(flag, code);
}
__global__ void chk_hgrn_kernel(const bf16_t* Q, const float* FP, const bf16_t* V, const bf16_t* O, unsigned* bits) {
    const int sample = blockIdx.x, lane = threadIdx.x;
    const int b = sample % BATCH, h = (sample / BATCH) % HG_H, e = (sample * 37 + 11) % 128;
    float s0 = 0.f, s1 = 0.f; unsigned r = 0;
    for (int t = 0; t < 128; ++t) {
        const size_t base = ((size_t)b * SEQ + t) * D + h * 128;
        const float f0 = sigmoidf_(FP[base + lane]), f1 = sigmoidf_(FP[base + lane + 64]);
        const float v = bf2f(V[base + e]);
        s0 = f0 * s0 + (1.f - f0) * v; s1 = f1 * s1 + (1.f - f1) * v;
        const float o = wave_sum(bf2f(Q[base + lane]) * s0 + bf2f(Q[base + lane + 64]) * s1);
        const unsigned short gb = O[base + e]; const float got = bf2f(gb);
        const bool nf = (gb & 0x7f80u) == 0x7f80u;
        if (t < 64) { if (nf) r |= 4u; else if (!(fabsf(got - o) < 0.05f + 0.03f * fabsf(o))) r |= 2u; }
        else if (nf) r |= 1u;
    }
    if (r && lane == 0) atomicOr(bits, r);
}
__global__ void flaginit_kernel(unsigned* flag) { *flag = 0xffffffffu; }
#endif

extern "C" void kernel_launch(void* const* d_in, const int* in_sizes, int n_in, void* d_out, int out_size, void* d_ws, size_t ws_size, hipStream_t stream) {
    static int grid = 0;
    if (grid == 0) {
        if (n_in != 22 || out_size != M * D || ws_size < WS_END) { fprintf(stderr, "kernel_launch: unexpected problem (n_in %d out %d ws %zu need %zu)\n", n_in, out_size, ws_size, (size_t)WS_END); grid = -1; return; }
        int dev = 0, cus = 0, per_cu = 0;
        if (hipGetDevice(&dev) != hipSuccess || hipDeviceGetAttribute(&cus, hipDeviceAttributeMultiprocessorCount, dev) != hipSuccess) { grid = -1; return; }
        if (hipFuncSetAttribute((const void*)fwd_kernel, hipFuncAttributeMaxDynamicSharedMemorySize, LDS_BYTES) != hipSuccess) { fprintf(stderr, "kernel_launch: hipFuncSetAttribute failed\n"); grid = -1; return; }
        if (hipOccupancyMaxActiveBlocksPerMultiprocessor(&per_cu, (const void*)fwd_kernel, NTHREADS, LDS_BYTES) != hipSuccess || per_cu < 1) fprintf(stderr, "kernel_launch: occupancy query reports %d\n", per_cu);
        grid = cus;
    }
    if (grid <= 0) return;
    (void)hipMemsetAsync((char*)d_ws + WS_CTL, 0, CTL_ZERO_BYTES, stream);
    Params p{};
    for (int i = 0; i < 22; ++i) p.in[i] = (const float*)d_in[i];
    p.out = (float*)d_out; p.ws = (unsigned char*)d_ws;
#if MK_N_LAUNCHES == 1
    p.ph_lo = 0; p.ph_hi = N_PHASES;
    hipLaunchKernelGGL(fwd_kernel, dim3(grid), dim3(NTHREADS), LDS_BYTES, stream, p);
#ifdef MK_EXTRA_PHASES
    { const int extra[] = {MK_EXTRA_PHASES}; for (int r = 0; r < MK_EXTRA_REPS; ++r) for (int k : extra) { p.ph_lo = k; p.ph_hi = k + 1; hipLaunchKernelGGL(fwd_kernel, dim3(grid), dim3(NTHREADS), LDS_BYTES, stream, p); } }
#endif
#else
#if MK_DEBUG_SCAN
    unsigned char* ws = (unsigned char*)d_ws; unsigned* flag = (unsigned*)(ws + WS_CTL) + 2048;
    hipLaunchKernelGGL(flaginit_kernel, dim3(1), dim3(1), 0, stream, flag);
#define SCAN(ptr, n, isbf, k) hipLaunchKernelGGL(scan_kernel, dim3(1024), dim3(256), 0, stream, (const void*)(ptr), (size_t)(n), isbf, (unsigned)((k) + 1), flag, (const unsigned*)nullptr, (size_t)0)
#define SCANM(ptr, re, isbf, k, jj) hipLaunchKernelGGL(scan_kernel, dim3(1024), dim3(256), 0, stream, (const void*)(ptr), (size_t)0, isbf, (unsigned)((k) + 1), flag, (const unsigned*)(ws + WS_CTL) + CW_MOE + 64 * (jj), (size_t)(re))
#endif
    for (int k = 0; k < N_PHASES; ++k) { p.ph_lo = k; p.ph_hi = k + 1; hipLaunchKernelGGL(fwd_kernel, dim3(grid), dim3(NTHREADS), LDS_BYTES, stream, p);
#if MK_DEBUG_SCAN
        unsigned char* A = ws + WS_A; const size_t MD = (size_t)M * D;
        if (k == 0) { SCAN(ws + WS_W_HGIN, 2 * 4 * MD / M * D, 1, k); SCAN(ws + WS_W_HGOUT, 2 * (size_t)D * D, 1, k); SCAN(ws + WS_W_FGU, 2 * (size_t)2 * DFF * D, 1, k); SCAN(ws + WS_W_FDN, 2 * (size_t)DFF * D, 1, k);
            SCAN(ws + WS_W_DIN, 2 * (size_t)DSA_IN_PAD * D, 1, k); SCAN(ws + WS_W_DQ, 2 * (size_t)2560 * QR, 1, k); SCAN(ws + WS_W_DO, 2 * (size_t)D * 2048, 1, k);
            SCAN(ws + WS_W_MGU, 16 * (size_t)2 * DFF * D, 1, k); SCAN(ws + WS_W_MDN, 16 * (size_t)DFF * D, 1, k); SCAN(ws + WS_XB, MD, 1, k); }
        else { const int l = (k - 1) % PH_PER_PAIR, jj = (k - 1) / PH_PER_PAIR;
            switch (l) {
            case 0: SCAN(A + A_HQ, 3 * MD, 1, k); SCAN(A + A_HF, MD, 0, k);
                if (jj == 0) hipLaunchKernelGGL(chk_a1_kernel, dim3(64), dim3(256), 0, stream, (const float*)d_in[IN_X], (const float*)d_in[IN_HGWIN], (const bf16_t*)(A + A_HQ), (const float*)(A + A_HF), (unsigned)(k + 1), flag);
                break;
            case 1: SCAN(A + A_HO, MD, 1, k);
                if (jj == 0) hipLaunchKernelGGL(chk_hgrn_kernel, dim3(256), dim3(64), 0, stream, (const bf16_t*)(A + A_HQ), (const float*)(A + A_HF), (const bf16_t*)(A + A_HV), (const bf16_t*)(A + A_HO), flag + 64);
                break;
            case 2: SCAN(A + A_HOG, MD, 1, k); break;
            case 3: case 6: case 13: SCAN(ws + WS_Y, MD, 1, k); break;
            case 4: case 7: case 14: SCAN(ws + WS_XB, MD, 1, k); break;
            case 5: SCAN(ws + WS_H, (size_t)M * DFF, 1, k); break;
            case 8: SCAN(A + A_RAW, (size_t)M * DSA_IN_PAD, 0, k); break;
            case 9: SCAN(A + A_CQ, (size_t)M * 256, 1, k); SCAN(A + A_CKV, (size_t)M * 256, 1, k); SCAN(A + A_KIDX, (size_t)M * 64, 1, k); SCAN(A + A_WIDX, (size_t)M * 8, 0, k); break;
            case 10: SCAN(A + A_QLAT, (size_t)M * 2048, 1, k); SCAN(A + A_QIDX, (size_t)M * 512, 1, k); break;
            case 12: SCAN(A + A_OLAT, (size_t)M * 2048, 1, k); break;
            case 16: SCANM(ws + WS_H, DFF, 1, k, jj); break;
            case 17: SCANM(A + A_OUTM, D, 0, k, jj); break;
            case 18: if (jj == 0) SCAN(ws + WS_XB, MD, 1, k); else SCAN(d_out, MD, 0, k); break;
            default: break; } }
#endif
    }
#if MK_DEBUG_SCAN
    hipLaunchKernelGGL(fin_kernel, dim3(1024), dim3(256), 0, stream, (float*)d_out, (size_t)M * D, (const unsigned*)flag);
#endif
#endif
}
```

```cpp
#include <hip/hip_runtime.h>
#include <cstdio>
#include <cstdint>

#ifndef MK_DEBUG_SCAN
#define MK_DEBUG_SCAN 0
#endif
#ifndef MK_MOE_FP8
#define MK_MOE_FP8 1
#endif
#ifndef MK_FFN_FP8
#define MK_FFN_FP8 1
#endif
#ifndef MK_B6_FP8
#define MK_B6_FP8 1
#endif
#ifndef MK_N_LAUNCHES
#define MK_N_LAUNCHES 1
#endif

#define GAS __attribute__((address_space(1)))
#define LAS __attribute__((address_space(3)))
typedef unsigned short bf16_t;
typedef short bf16x8 __attribute__((ext_vector_type(8)));
typedef short s16x4 __attribute__((ext_vector_type(4)));
typedef float f32x4 __attribute__((ext_vector_type(4)));
typedef float f32x2 __attribute__((ext_vector_type(2)));
typedef unsigned u32x4 __attribute__((ext_vector_type(4)));
typedef unsigned u32x2 __attribute__((ext_vector_type(2)));
typedef int v8i32 __attribute__((ext_vector_type(8)));
typedef int v4i32 __attribute__((ext_vector_type(4)));

constexpr int D = 1024, BATCH = 16, SEQ = 2048, M = BATCH * SEQ;
constexpr int DFF = 3584, NEXP = 8;
constexpr int HG_H = 8, HG_DK = 128, HG_C = 64;
constexpr int QR = 256, KVR = 256, IDXD = 64, IDXH = 8, DSA_H = 8, DSA_HD = 128, TOPK = 256;
constexpr int DSA_IN = 584, DSA_IN_PAD = 768;
constexpr int MOE_ROWS = 2 * M + NEXP * 256;
constexpr float ALPHA = 1.6817928305074290f;
constexpr float LN_EPS = 1e-5f, RMS_EPS = 1e-6f;
constexpr int NWAVES = 8, NTHREADS = 512;

constexpr size_t MiB = 1u << 20;
constexpr size_t WS_CTL = 0, CTL_ZERO_BYTES = 1 * MiB;
constexpr size_t WS_W_HGIN = 1 * MiB;
constexpr size_t WS_W_HGOUT = 17 * MiB;
constexpr size_t WS_W_FGU = 21 * MiB;
constexpr size_t WS_W_FDN = 49 * MiB;
constexpr size_t WS_W_DIN = 63 * MiB;
constexpr size_t WS_W_DQ = 66 * MiB;
constexpr size_t WS_W_DO = 69 * MiB;
constexpr size_t WS_W_MGU = 77 * MiB;
constexpr size_t WS_W_MDN = 301 * MiB;
constexpr size_t WS_XB8 = 416 * MiB;
constexpr size_t WS_W_MGU8 = 77 * MiB;
constexpr size_t WS_W_MDN8 = 192 * MiB;
constexpr size_t WS_XB = 544 * MiB;
constexpr size_t WS_Y = 608 * MiB;
constexpr size_t WS_A = 736 * MiB;
constexpr size_t WS_H = 1184 * MiB;
constexpr size_t WS_END = 1648 * MiB;
constexpr size_t A_HQ = 0, A_HF = 64 * MiB, A_HV = 128 * MiB, A_HG = 192 * MiB, A_HO = 320 * MiB, A_HOG = 384 * MiB;
constexpr size_t A_RAW = 0, A_CQ = 96 * MiB, A_CKV = 112 * MiB, A_KIDX = 128 * MiB, A_WIDX = 132 * MiB, A_MASK = 136 * MiB, A_QLAT = 144 * MiB, A_QIDX = 272 * MiB, A_OLAT = 304 * MiB;
constexpr size_t A_OUTM = 136 * MiB, A_EIDX = 404 * MiB, A_POS = 405 * MiB, A_TOK = 406 * MiB, A_GW = 407 * MiB;
constexpr int CW_BAR = 4096, CW_MOE = 16384;

constexpr int RING_BYTES = 131072;
constexpr int LDSCTL_OFF = RING_BYTES, MISC_OFF = LDSCTL_OFF + 320;
constexpr int STAGE_TOKL = RING_BYTES + 2048;
constexpr int LDS_BYTES = 147456;

typedef __bf16 hwbf16x2 __attribute__((ext_vector_type(2)));
__device__ __forceinline__ unsigned cvt_pk_bf16(float lo, float hi) { const f32x2 v = {lo, hi}; const hwbf16x2 b = __builtin_convertvector(v, hwbf16x2); return __builtin_bit_cast(unsigned, b); }
__device__ __forceinline__ bf16_t f2bf(float f) { return (bf16_t)(cvt_pk_bf16(f, 0.f) & 0xffffu); }
__device__ __forceinline__ float bf2f(bf16_t b) { return __uint_as_float(((unsigned)b) << 16); }
__device__ __forceinline__ float wave_sum(float v) {
    v += __builtin_bit_cast(float, __builtin_amdgcn_update_dpp(0, __builtin_bit_cast(int, v), 0xB1, 0xF, 0xF, true));
    v += __builtin_bit_cast(float, __builtin_amdgcn_update_dpp(0, __builtin_bit_cast(int, v), 0x4E, 0xF, 0xF, true));
    v += __builtin_bit_cast(float, __builtin_amdgcn_update_dpp(0, __builtin_bit_cast(int, v), 0x141, 0xF, 0xF, true));
    v += __builtin_bit_cast(float, __builtin_amdgcn_update_dpp(0, __builtin_bit_cast(int, v), 0x140, 0xF, 0xF, true));
    const float r0 = __builtin_bit_cast(float, __builtin_amdgcn_readlane(__builtin_bit_cast(int, v), 0)), r1 = __builtin_bit_cast(float, __builtin_amdgcn_readlane(__builtin_bit_cast(int, v), 16));
    const float r2 = __builtin_bit_cast(float, __builtin_amdgcn_readlane(__builtin_bit_cast(int, v), 32)), r3 = __builtin_bit_cast(float, __builtin_amdgcn_readlane(__builtin_bit_cast(int, v), 48));
    return (r0 + r1) + (r2 + r3);
}
__device__ __forceinline__ float fast_exp2(float x) { return __builtin_amdgcn_exp2f(x); }
__device__ __forceinline__ float fast_rcp(float x) { return __builtin_amdgcn_rcpf(x); }
__device__ __forceinline__ float sigmoidf_(float x) { return fast_rcp(1.0f + __expf(-x)); }
__device__ __forceinline__ float siluf_(float x) { return x * sigmoidf_(x); }
#define LDS_WAIT() asm volatile("s_waitcnt lgkmcnt(0)" ::: "memory")
#define VM_WAIT() asm volatile("s_waitcnt vmcnt(0)" ::: "memory")

#define XB_TMO      128
#define XB_XCNT(j)  (256  + 64 * (j))
#define XB_XSUB(j)  (1280 + 64 * (j))
#define XB_XGEN(j)  (2304 + 64 * (j))
#define XB_TOP      3328
#define XB_TOPGEN   3392
#define XCD_BAR_WORDS 3456
#define XB_SPIN_CAP (1u << 20)

__device__ __forceinline__ unsigned xb_ld(unsigned* p)              { return __hip_atomic_load(p, __ATOMIC_RELAXED, __HIP_MEMORY_SCOPE_AGENT); }
__device__ __forceinline__ unsigned xb_add(unsigned* p, unsigned v) { return __hip_atomic_fetch_add(p, v, __ATOMIC_RELAXED, __HIP_MEMORY_SCOPE_AGENT); }
__device__ __forceinline__ unsigned xb_xcc_id() { return (unsigned)__builtin_amdgcn_s_getreg((3 << 11) | 20) & 0xFu; }
#define XB_SPIN(cond, bar) do { unsigned _sp = 0; while (cond) { __builtin_amdgcn_s_sleep(1); \
    if ((++_sp & 255u) == 0u) { if (xb_ld(&(bar)[XB_TMO])) break; if (_sp > XB_SPIN_CAP) { atomicAdd(&(bar)[XB_TMO], 1u); break; } } } } while (0)

struct XcdBarrier { unsigned* bar; unsigned x; volatile LAS unsigned* st; };

__device__ __forceinline__ XcdBarrier xcd_barrier_post(unsigned* bar, volatile LAS unsigned* st) {
    XcdBarrier b; b.bar = bar; b.x = xb_xcc_id(); b.st = st;
    if (threadIdx.x == 0) (void)xb_add(&bar[XB_XCNT(b.x)], 1u);
    return b;
}
__device__ __forceinline__ void xcd_barrier_complete(unsigned* bar, unsigned x, unsigned& nloc, unsigned& nx) {
    const unsigned G = gridDim.x * gridDim.y * gridDim.z;
    unsigned sum, cnt, mine, sp = 0u;
    for (;;) {
        sum = 0u; cnt = 0u; mine = 0u;
#pragma unroll
        for (unsigned j = 0; j < 16; ++j) { const unsigned c = xb_ld(&bar[XB_XCNT(j)]); sum += c; cnt += (c > 0u) ? 1u : 0u; mine = (j == x) ? c : mine; }
        if (sum == G) break;
        __builtin_amdgcn_s_sleep(1);
        if ((++sp & 255u) == 0u) { if (xb_ld(&bar[XB_TMO])) break; if (sp > XB_SPIN_CAP) { atomicAdd(&bar[XB_TMO], 1u); break; } }
    }
    nloc = mine > 0u ? mine : 1u; nx = cnt > 0u ? cnt : 1u;
}
__device__ __forceinline__ void xcd_barrier(const XcdBarrier& b) {
    asm volatile("s_waitcnt vmcnt(0)" ::: "memory");
    __syncthreads();
    if (threadIdx.x == 0) {
        unsigned* bar = b.bar;
        __builtin_amdgcn_s_waitcnt(0);
        unsigned nloc = b.st[0], nx = b.st[1];
        if (nloc == 0u) { xcd_barrier_complete(bar, b.x, nloc, nx); b.st[0] = nloc; b.st[1] = nx; }
        const unsigned old = xb_add(&bar[XB_XSUB(b.x)], 1u);
        const unsigned gen = old / nloc;
        if (old + 1u == (gen + 1u) * nloc) {
            __builtin_amdgcn_fence(__ATOMIC_RELEASE, "agent");
            asm volatile("s_waitcnt vmcnt(0)" ::: "memory");
            const unsigned og = xb_add(&bar[XB_TOP], 1u);
            const unsigned tg = og / nx;
            if (og + 1u == (tg + 1u) * nx) xb_add(&bar[XB_TOPGEN], 1u);
            else XB_SPIN(xb_ld(&bar[XB_TOPGEN]) == tg, bar);
            __builtin_amdgcn_fence(__ATOMIC_ACQUIRE, "agent");
            xb_add(&bar[XB_XGEN(b.x)], 1u);
            asm volatile("s_waitcnt vmcnt(0)" ::: "memory");
        } else {
            XB_SPIN(xb_ld(&bar[XB_XGEN(b.x)]) == gen, bar);
            __builtin_amdgcn_fence(__ATOMIC_ACQUIRE, "agent");
            asm volatile("s_waitcnt vmcnt(0)" ::: "memory");
        }
    }
    __syncthreads();
}

constexpr int BM = 256, BK = 64, HALF = 128, HTB = HALF * BK * 2, NXCD = 8, WGM = 8;
__device__ __forceinline__ int lds_byte(int r, int c) { const int st = (r >> 4) * 2 + (c >> 5), rr = r & 15, cc = c & 31, ob = rr * 64 + cc * 2; return st * 1024 + (ob ^ (((ob >> 9) & 1) << 5)); }
__device__ __forceinline__ void stage_rc(int b, int& R, int& C) { const int st = b / 1024, sb = b % 1024, swz = sb ^ (((sb >> 9) & 1) << 5); R = (st >> 1) * 16 + swz / 64; C = (st & 1) * 32 + (swz % 64) / 2; }
__device__ __forceinline__ int perm32(int rho) { const int n = rho >> 4, i = rho & 15; return 8 * (i >> 2) + 4 * n + (i & 3); }

struct Unit { int pm, pn, pb, lt, cnt, e; };
struct Gemm { const bf16_t* A; const bf16_t* Bt; int K; int sc = 0x7f7f7f7f; };

__device__ __forceinline__ void tile_map(int L, int nM, int nN, int& pm, int& pn) {
    const int nwg = nM * nN;
    int wgid = L; { const int q = nwg / NXCD, r = nwg % NXCD, xcd = wgid % NXCD, off = wgid / NXCD; wgid = (xcd < r ? xcd * (q + 1) : r * (q + 1) + (xcd - r) * q) + off; }
    const int nig = WGM * nN, gid = wgid / nig, fm = gid * WGM, gsz = (nM - fm) < WGM ? (nM - fm) : WGM;
    pm = fm + ((wgid % nig) % gsz); pn = (wgid % nig) / gsz;
}
struct StaticOrder {
    int nM, nN, nwg, G, c;
    __device__ __forceinline__ void init(int M_, int N_, int G_, int c_) { nM = M_ / BM; nN = N_ / BM; nwg = nM * nN; G = G_; c = c_; }
    __device__ __forceinline__ bool next(int i, Unit& u) const {
        const long L = (long)i * G + c; if (L >= nwg) return false;
        tile_map((int)L, nM, nN, u.pm, u.pn); u.pb = u.pn; u.lt = 0; u.cnt = 0; u.e = 0; return true;
    }
};
struct MoeOrder {
    int t1, t2, t3, t4, t5, t6, t7, nM, nN, nwg, G, c; const unsigned* cntp;
    __device__ __forceinline__ void init(const unsigned* cnt, int nN_, int G_, int c_) {
        int t = 0, o[9];
#pragma unroll
        for (int e = 0; e < 8; ++e) { o[e] = t; const int ce = __builtin_amdgcn_readfirstlane((int)__hip_atomic_load(cnt + e, __ATOMIC_RELAXED, __HIP_MEMORY_SCOPE_AGENT)); t += (ce + 255) >> 8; }
        o[8] = t; t1 = o[1]; t2 = o[2]; t3 = o[3]; t4 = o[4]; t5 = o[5]; t6 = o[6]; t7 = o[7];
        nM = t; nN = nN_; nwg = nM * nN; G = G_; c = c_; cntp = cnt;
    }
    __device__ __forceinline__ bool next(int i, Unit& u) const {
        const long L = (long)i * G + c; if (L >= nwg) return false;
        tile_map((int)L, nM, nN, u.pm, u.pn);
        const int e = (u.pm >= t1) + (u.pm >= t2) + (u.pm >= t3) + (u.pm >= t4) + (u.pm >= t5) + (u.pm >= t6) + (u.pm >= t7);
        const int tb = e == 0 ? 0 : e == 1 ? t1 : e == 2 ? t2 : e == 3 ? t3 : e == 4 ? t4 : e == 5 ? t5 : e == 6 ? t6 : t7;
        u.cnt = __builtin_amdgcn_readfirstlane((int)__hip_atomic_load(cntp + e, __ATOMIC_RELAXED, __HIP_MEMORY_SCOPE_AGENT));
        u.lt = u.pm - tb; u.e = e; u.pb = e * nN + u.pn; return true;
    }
};

typedef f32x4 Acc[2][2][4][2];

template <bool F8 = false, class Epi, class Sched>
__device__ __forceinline__ void gemm_phase(LAS unsigned char* lds, const Gemm g, const Sched& S, const Epi& E) {
    int tid_ = threadIdx.x; asm volatile("" : "+v"(tid_));
    const int tid = tid_, wid = __builtin_amdgcn_readfirstlane(tid >> 6), lane = tid & 63, wr = wid >> 2, wc = wid & 3, fr = lane & 15, fq = lane >> 4;
    const int K = g.K, nt = K / BK;
    unsigned voffA[2], voffB[2];
#pragma unroll
    for (int i = 0; i < 2; ++i) { int R, C; stage_rc(tid * 16 + i * 8192, R, C); const int Rb = (R & ~31) + perm32(R & 31);
        voffA[i] = (unsigned)(R * K + C) * 2u; voffB[i] = (unsigned)(Rb * K + C) * 2u; }
    const size_t kstep = (size_t)(BK * 2);
    const size_t hstep = (size_t)HALF * K * 2;
    const size_t tstep = 2 * hstep;
    const unsigned ldsw = (unsigned)wid * 1024u;
    const int aoff = lds_byte(wr * 64 + fr, fq * 8), boff = lds_byte(wc * 32 + fr, fq * 8);
#define PG8_SA(b, h) (((b) * 2 + (h)) * HTB)
#define PG8_SB(b, h) ((4 + (b) * 2 + (h)) * HTB)
#define PG8_STAGE(bufoff, gbase, voff) do { _Pragma("unroll") for (int _i = 0; _i < 2; ++_i) \
        __builtin_amdgcn_global_load_lds((const unsigned*)((const char*)(gbase) + (voff)[_i]), (LAS unsigned*)(lds + (bufoff) + ldsw + _i * 8192), 16, 0, 0); } while (0)
#define PG8_LDA(dst, b, h) do { _Pragma("unroll") for (int m = 0; m < 4; ++m) _Pragma("unroll") for (int k = 0; k < 2; ++k) dst[m][k] = *(const LAS bf16x8*)(lds + PG8_SA(b, h) + aoff + m * 2048 + k * 1024); } while (0)
#define PG8_LDB(dst, b, h) do { _Pragma("unroll") for (int n = 0; n < 2; ++n) _Pragma("unroll") for (int k = 0; k < 2; ++k) dst[n][k] = *(const LAS bf16x8*)(lds + PG8_SB(b, h) + boff + n * 2048 + k * 1024); } while (0)
#define PG8_MMA(ai, bj, At, Bt) do { __builtin_amdgcn_s_setprio(1); \
        if constexpr (F8) {        \
            _Pragma("unroll") for (int m = 0; m < 4; ++m) _Pragma("unroll") for (int n = 0; n < 2; ++n) { \
                const v8i32 bv_ = __builtin_shufflevector(__builtin_bit_cast(v4i32, Bt[n][0]), __builtin_bit_cast(v4i32, Bt[n][1]), 0, 1, 2, 3, 4, 5, 6, 7); \
                const v8i32 av_ = __builtin_shufflevector(__builtin_bit_cast(v4i32, At[m][0]), __builtin_bit_cast(v4i32, At[m][1]), 0, 1, 2, 3, 4, 5, 6, 7); \
                acc[ai][bj][m][n] = __builtin_amdgcn_mfma_scale_f32_16x16x128_f8f6f4(bv_, av_, acc[ai][bj][m][n], 0, 0, 0, g.sc, 0, 0x7f7f7f7f); } \
        } else { \
            _Pragma("unroll") for (int m = 0; m < 4; ++m) _Pragma("unroll") for (int n = 0; n < 2; ++n) _Pragma("unroll") for (int k = 0; k < 2; ++k) \
                acc[ai][bj][m][n] = __builtin_amdgcn_mfma_f32_16x16x32_bf16(Bt[n][k], At[m][k], acc[ai][bj][m][n], 0, 0, 0); } \
        __builtin_amdgcn_s_setprio(0); } while (0)
#define PG8_WAIT_V(n) asm volatile("s_waitcnt vmcnt(" #n ")" ::: "memory")
#define PG8_WAIT_L(n) asm volatile("s_waitcnt lgkmcnt(" #n ")" ::: "memory")
#define PG8_BAR __builtin_amdgcn_s_barrier()
#define PG8_SCHED __builtin_amdgcn_sched_barrier(0)
    Unit cur, nxt; int ui = 0;
    if (!S.next(0, cur)) return;
    Acc acc;
#pragma unroll
    for (int a = 0; a < 2; ++a)
#pragma unroll
        for (int b = 0; b < 2; ++b)
#pragma unroll
            for (int m = 0; m < 4; ++m)
#pragma unroll
                for (int n = 0; n < 2; ++n) acc[a][b][m][n] = (f32x4){0.f, 0.f, 0.f, 0.f};
    bf16x8 At[4][2], B0[2][2], B1[2][2];
    const char* cA = (const char*)g.A + (size_t)cur.pm * tstep; const char* cB = (const char*)g.Bt + (size_t)cur.pb * tstep;
    PG8_STAGE(PG8_SB(0, 0), cB, voffB); PG8_STAGE(PG8_SA(0, 0), cA, voffA); PG8_STAGE(PG8_SB(0, 1), cB + hstep, voffB); PG8_STAGE(PG8_SA(0, 1), cA + hstep, voffA);
    if (wr == 1) PG8_BAR;
    PG8_WAIT_V(4); PG8_BAR;
    PG8_STAGE(PG8_SB(1, 0), cB + kstep, voffB); PG8_STAGE(PG8_SA(1, 0), cA + kstep, voffA); PG8_STAGE(PG8_SB(1, 1), cB + hstep + kstep, voffB);
    PG8_WAIT_V(6); PG8_BAR;
    for (;;) {
        const bool has_next = S.next(ui + 1, nxt);
        const char* nA = has_next ? (const char*)g.A + (size_t)nxt.pm * tstep : cA; const char* nB = has_next ? (const char*)g.Bt + (size_t)nxt.pb * tstep : cB;
#pragma nounroll
        for (int t = 0; t < nt; t += 2) {
            const bool last = (t == nt - 2);
            const char* a1 = cA + (size_t)(t + 1) * kstep;
            const char* a2 = last ? nA : cA + (size_t)(t + 2) * kstep; const char* b2 = last ? nB : cB + (size_t)(t + 2) * kstep;
            const char* a3 = a2 + kstep; const char* b3 = b2 + kstep;
            PG8_LDB(B0, 0, 0); PG8_SCHED; PG8_LDA(At, 0, 0); PG8_STAGE(PG8_SA(1, 1), a1 + hstep, voffA);
            PG8_WAIT_L(8); PG8_BAR; PG8_WAIT_L(0); PG8_MMA(0, 0, At, B0); PG8_BAR; PG8_SCHED;
            PG8_LDB(B1, 0, 1); PG8_STAGE(PG8_SB(0, 0), b2, voffB);
            PG8_BAR; PG8_WAIT_L(0); PG8_MMA(0, 1, At, B1); PG8_BAR;
            PG8_LDA(At, 0, 1); PG8_STAGE(PG8_SA(0, 0), a2, voffA);
            PG8_BAR; PG8_WAIT_L(0); PG8_MMA(1, 0, At, B0); PG8_BAR; PG8_SCHED;
            PG8_STAGE(PG8_SB(0, 1), b2 + hstep, voffB);
            PG8_WAIT_V(6); PG8_BAR; PG8_MMA(1, 1, At, B1); PG8_BAR;
            PG8_LDB(B0, 1, 0); PG8_SCHED; PG8_LDA(At, 1, 0); PG8_STAGE(PG8_SA(0, 1), a2 + hstep, voffA);
            PG8_WAIT_L(8); PG8_BAR; PG8_WAIT_L(0); PG8_MMA(0, 0, At, B0); PG8_BAR; PG8_SCHED;
            PG8_LDB(B1, 1, 1); PG8_STAGE(PG8_SB(1, 0), b3, voffB);
            PG8_BAR; PG8_WAIT_L(0); PG8_MMA(0, 1, At, B1); PG8_BAR;
            PG8_LDA(At, 1, 1); PG8_STAGE(PG8_SA(1, 0), a3, voffA);
            PG8_BAR; PG8_WAIT_L(0); PG8_MMA(1, 0, At, B0); PG8_BAR; PG8_SCHED;
            PG8_STAGE(PG8_SB(1, 1), b3 + hstep, voffB);
            PG8_WAIT_V(6); PG8_BAR; PG8_MMA(1, 1, At, B1); PG8_BAR;
        }
        E(acc, cur, wr, wc, fr, fq);
        if (!has_next) break;
#pragma unroll
        for (int a = 0; a < 2; ++a)
#pragma unroll
            for (int b = 0; b < 2; ++b)
#pragma unroll
                for (int m = 0; m < 4; ++m)
#pragma unroll
                    for (int n = 0; n < 2; ++n) acc[a][b][m][n] = (f32x4){0.f, 0.f, 0.f, 0.f};
        cur = nxt; cA = nA; cB = nB; ++ui;
    }
    PG8_WAIT_V(0);
    if (wr == 0) PG8_BAR;
    PG8_BAR;
#undef PG8_SA
#undef PG8_SB
#undef PG8_STAGE
#undef PG8_LDA
#undef PG8_LDB
#undef PG8_MMA
#undef PG8_WAIT_V
#undef PG8_WAIT_L
#undef PG8_BAR
#undef PG8_SCHED
}

template <bool F8 = false, bool IDENT = false, class Epi, class Sched>
__device__ __forceinline__ void gemm_phase_gather(LAS unsigned char* lds, const Gemm g, const Sched& S, const Epi& E, const int* TOKV) {
    int tid_ = threadIdx.x; asm volatile("" : "+v"(tid_));
    const int tid = tid_, wid = __builtin_amdgcn_readfirstlane(tid >> 6), lane = tid & 63, wr = wid >> 2, wc = wid & 3, fr = lane & 15, fq = lane >> 4;
    const int K = g.K, nt = K / BK;
    unsigned voffB[2];
#pragma unroll
    for (int i = 0; i < 2; ++i) { int R, C; stage_rc(tid * 16 + i * 8192, R, C); const int Rb = (R & ~31) + perm32(R & 31); voffB[i] = (unsigned)(Rb * K + C) * 2u; }
    unsigned vgC[2][2];
    LAS int* TOKL = (LAS int*)(lds + STAGE_TOKL);
#define PG8_GROWS(dst, u_) do { int tq_ = threadIdx.x; asm volatile("" : "+v"(tq_)); _Pragma("unroll") for (int i_ = 0; i_ < 2; ++i_) { int R_, C_; stage_rc(tq_ * 16 + i_ * 8192, R_, C_); \
            _Pragma("unroll") for (int h_ = 0; h_ < 2; ++h_) { const int pos_ = 256 * (u_).lt + 128 * h_ + R_; \
                int tok_; if constexpr (IDENT) tok_ = 256 * (u_).pm + 128 * h_ + R_; else tok_ = (pos_ < (u_).cnt) ? TOKV[(size_t)(u_).e * M + pos_] : 0; dst[h_][i_] = (unsigned)tok_ * (unsigned)(K * 2) + (unsigned)C_ * 2u; } } } while (0)
#define PG8_GROWS_LDS(dst, u_, par_) do { int tq_ = threadIdx.x; asm volatile("" : "+v"(tq_)); _Pragma("unroll") for (int i_ = 0; i_ < 2; ++i_) { int R_, C_; stage_rc(tq_ * 16 + i_ * 8192, R_, C_); \
            _Pragma("unroll") for (int h_ = 0; h_ < 2; ++h_) { const int rl_ = 128 * h_ + R_; \
                int tok_; if constexpr (IDENT) tok_ = 256 * (u_).pm + rl_; else tok_ = (256 * (u_).lt + rl_ < (u_).cnt) ? TOKL[256 * (par_) + rl_] : 0; dst[h_][i_] = (unsigned)tok_ * (unsigned)(K * 2) + (unsigned)C_ * 2u; } } } while (0)
    const size_t kstep = (size_t)(BK * 2);
    const size_t hstep = (size_t)HALF * K * 2;
    const size_t tstep = 2 * hstep;
    const unsigned ldsw = (unsigned)wid * 1024u;
    const int aoff = lds_byte(wr * 64 + fr, fq * 8), boff = lds_byte(wc * 32 + fr, fq * 8);
#define PG8_SA(b, h) (((b) * 2 + (h)) * HTB)
#define PG8_SB(b, h) ((4 + (b) * 2 + (h)) * HTB)
#define PG8_STAGE(bufoff, gbase, voff) do { _Pragma("unroll") for (int _i = 0; _i < 2; ++_i) \
        __builtin_amdgcn_global_load_lds((const unsigned*)((const char*)(gbase) + (voff)[_i]), (LAS unsigned*)(lds + (bufoff) + ldsw + _i * 8192), 16, 0, 0); } while (0)
#define PG8_STAGEA(bufoff, gbase, h_, nx_) PG8_STAGE(bufoff, gbase, vgC[h_])
#define PG8_LDA(dst, b, h) do { _Pragma("unroll") for (int m = 0; m < 4; ++m) _Pragma("unroll") for (int k = 0; k < 2; ++k) dst[m][k] = *(const LAS bf16x8*)(lds + PG8_SA(b, h) + aoff + m * 2048 + k * 1024); } while (0)
#define PG8_LDB(dst, b, h) do { _Pragma("unroll") for (int n = 0; n < 2; ++n) _Pragma("unroll") for (int k = 0; k < 2; ++k) dst[n][k] = *(const LAS bf16x8*)(lds + PG8_SB(b, h) + boff + n * 2048 + k * 1024); } while (0)
#define PG8_MMA(ai, bj, At, Bt) do { __builtin_amdgcn_s_setprio(1); \
        if constexpr (F8) {        \
            _Pragma("unroll") for (int m = 0; m < 4; ++m) _Pragma("unroll") for (int n = 0; n < 2; ++n) { \
                const v8i32 bv_ = __builtin_shufflevector(__builtin_bit_cast(v4i32, Bt[n][0]), __builtin_bit_cast(v4i32, Bt[n][1]), 0, 1, 2, 3, 4, 5, 6, 7); \
                const v8i32 av_ = __builtin_shufflevector(__builtin_bit_cast(v4i32, At[m][0]), __builtin_bit_cast(v4i32, At[m][1]), 0, 1, 2, 3, 4, 5, 6, 7); \
                acc[ai][bj][m][n] = __builtin_amdgcn_mfma_scale_f32_16x16x128_f8f6f4(bv_, av_, acc[ai][bj][m][n], 0, 0, 0, g.sc, 0, 0x7f7f7f7f); } \
        } else { \
            _Pragma("unroll") for (int m = 0; m < 4; ++m) _Pragma("unroll") for (int n = 0; n < 2; ++n) _Pragma("unroll") for (int k = 0; k < 2; ++k) \
                acc[ai][bj][m][n] = __builtin_amdgcn_mfma_f32_16x16x32_bf16(Bt[n][k], At[m][k], acc[ai][bj][m][n], 0, 0, 0); } \
        __builtin_amdgcn_s_setprio(0); } while (0)
#define PG8_WAIT_V(n) asm volatile("s_waitcnt vmcnt(" #n ")" ::: "memory")
#define PG8_WAIT_L(n) asm volatile("s_waitcnt lgkmcnt(" #n ")" ::: "memory")
#define PG8_BAR __builtin_amdgcn_s_barrier()
#define PG8_SCHED __builtin_amdgcn_sched_barrier(0)
    Unit cur, nxt; int ui = 0;
    if (!S.next(0, cur)) return;
    Acc acc;
#pragma unroll
    for (int a = 0; a < 2; ++a)
#pragma unroll
        for (int b = 0; b < 2; ++b)
#pragma unroll
            for (int m = 0; m < 4; ++m)
#pragma unroll
                for (int n = 0; n < 2; ++n) acc[a][b][m][n] = (f32x4){0.f, 0.f, 0.f, 0.f};
    bf16x8 At[4][2], B0[2][2], B1[2][2];
    const char* cA = (const char*)g.A; const char* cB = (const char*)g.Bt + (size_t)cur.pb * tstep;
    PG8_GROWS(vgC, cur);
    PG8_STAGE(PG8_SB(0, 0), cB, voffB); PG8_STAGEA(PG8_SA(0, 0), cA, 0, false); PG8_STAGE(PG8_SB(0, 1), cB + hstep, voffB); PG8_STAGEA(PG8_SA(0, 1), cA, 1, false);
    if (wr == 1) PG8_BAR;
    PG8_WAIT_V(4); PG8_BAR;
    PG8_STAGE(PG8_SB(1, 0), cB + kstep, voffB); PG8_STAGEA(PG8_SA(1, 0), cA + kstep, 0, false); PG8_STAGE(PG8_SB(1, 1), cB + hstep + kstep, voffB);
    PG8_WAIT_V(6); PG8_BAR;
    for (;;) {
        const bool has_next = S.next(ui + 1, nxt);
        const char* nA = cA; const char* nB = has_next ? (const char*)g.Bt + (size_t)nxt.pb * tstep : cB;
        if (!IDENT && has_next && wid == 0) __builtin_amdgcn_global_load_lds((const unsigned*)(TOKV + (size_t)nxt.e * M + 256 * nxt.lt + 4 * lane), (LAS unsigned*)(TOKL + 256 * ((ui + 1) & 1)), 16, 0, 0);

#pragma nounroll
        for (int t = 0; t < nt; t += 2) {
            const bool last = (t == nt - 2);
            const char* a1 = cA + (size_t)(t + 1) * kstep;
            const char* a2 = last ? nA : cA + (size_t)(t + 2) * kstep; const char* b2 = last ? nB : cB + (size_t)(t + 2) * kstep;
            const char* a3 = a2 + kstep; const char* b3 = b2 + kstep;
            PG8_LDB(B0, 0, 0); PG8_SCHED; PG8_LDA(At, 0, 0); PG8_STAGEA(PG8_SA(1, 1), a1, 1, false);
            if (last && has_next) { PG8_GROWS_LDS(vgC, nxt, (ui + 1) & 1); }
            PG8_WAIT_L(8); PG8_BAR; PG8_WAIT_L(0); PG8_MMA(0, 0, At, B0); PG8_BAR; PG8_SCHED;
            PG8_LDB(B1, 0, 1); PG8_STAGE(PG8_SB(0, 0), b2, voffB);
            PG8_BAR; PG8_WAIT_L(0); PG8_MMA(0, 1, At, B1); PG8_BAR;
            PG8_LDA(At, 0, 1); PG8_STAGEA(PG8_SA(0, 0), a2, 0, last);
            PG8_BAR; PG8_WAIT_L(0); PG8_MMA(1, 0, At, B0); PG8_BAR; PG8_SCHED;
            PG8_STAGE(PG8_SB(0, 1), b2 + hstep, voffB);
            PG8_WAIT_V(6); PG8_BAR; PG8_MMA(1, 1, At, B1); PG8_BAR;
            PG8_LDB(B0, 1, 0); PG8_SCHED; PG8_LDA(At, 1, 0); PG8_STAGEA(PG8_SA(0, 1), a2, 1, last);
            PG8_WAIT_L(8); PG8_BAR; PG8_WAIT_L(0); PG8_MMA(0, 0, At, B0); PG8_BAR; PG8_SCHED;
            PG8_LDB(B1, 1, 1); PG8_STAGE(PG8_SB(1, 0), b3, voffB);
            PG8_BAR; PG8_WAIT_L(0); PG8_MMA(0, 1, At, B1); PG8_BAR;
            PG8_LDA(At, 1, 1); PG8_STAGEA(PG8_SA(1, 0), a3, 0, last);
            PG8_BAR; PG8_WAIT_L(0); PG8_MMA(1, 0, At, B0); PG8_BAR; PG8_SCHED;
            PG8_STAGE(PG8_SB(1, 1), b3 + hstep, voffB);
            PG8_WAIT_V(6); PG8_BAR; PG8_MMA(1, 1, At, B1); PG8_BAR;
        }
        E(acc, cur, wr, wc, fr, fq);
        if (!has_next) break;
#pragma unroll
        for (int a = 0; a < 2; ++a)
#pragma unroll
            for (int b = 0; b < 2; ++b)
#pragma unroll
                for (int m = 0; m < 4; ++m)
#pragma unroll
                    for (int n = 0; n < 2; ++n) acc[a][b][m][n] = (f32x4){0.f, 0.f, 0.f, 0.f};
        cur = nxt; cB = nB; ++ui;
    }
    PG8_WAIT_V(0);
    if (wr == 0) PG8_BAR;
    PG8_BAR;
#undef PG8_SA
#undef PG8_STAGEA
#undef PG8_GROWS
#undef PG8_GROWS_LDS
#undef PG8_SB
#undef PG8_STAGE
#undef PG8_LDA
#undef PG8_LDB
#undef PG8_MMA
#undef PG8_WAIT_V
#undef PG8_WAIT_L
#undef PG8_BAR
#undef PG8_SCHED
}

__device__ __forceinline__ u32x4 pack8(const f32x4 a, const f32x4 b) { u32x4 w; w.x = cvt_pk_bf16(a[0], a[1]); w.y = cvt_pk_bf16(a[2], a[3]); w.z = cvt_pk_bf16(b[0], b[1]); w.w = cvt_pk_bf16(b[2], b[3]); return w; }

struct EpiHgIn {
    bf16_t* QFVG;
    __device__ __forceinline__ void operator()(const Acc& acc, const Unit& u, int wr, int wc, int fr, int fq) const {
        const int part = u.pn >> 2, row0 = u.pm * BM + wr * 64 + fr, col0 = (u.pn & 3) * 256 + wc * 32 + 8 * fq;
        bf16_t* base = QFVG + (size_t)part * ((size_t)M * D);
#pragma unroll
        for (int ai = 0; ai < 2; ++ai)
#pragma unroll
            for (int m = 0; m < 4; ++m) { bf16_t* rowp = base + (size_t)(row0 + ai * HALF + m * 16) * D + col0;
#pragma unroll
                for (int bj = 0; bj < 2; ++bj) *(u32x4*)(rowp + bj * HALF) = pack8(acc[ai][bj][m][0], acc[ai][bj][m][1]); }
    }
};
struct EpiRes {
    const bf16_t* X; bf16_t* Y;
    __device__ __forceinline__ void operator()(const Acc& acc, const Unit& u, int wr, int wc, int fr, int fq) const {
        const int row0 = u.pm * BM + wr * 64 + fr, col0 = u.pn * BM + wc * 32 + 8 * fq;
#pragma unroll
        for (int ai = 0; ai < 2; ++ai)
#pragma unroll
            for (int m = 0; m < 4; ++m) { const size_t o = (size_t)(row0 + ai * HALF + m * 16) * D + col0;
#pragma unroll
                for (int bj = 0; bj < 2; ++bj) {
                    const u32x4 xv = *(const u32x4*)(X + o + bj * HALF);
                    f32x4 y0, y1;
#pragma unroll
                    for (int q = 0; q < 2; ++q) { y0[2 * q] = __uint_as_float(xv[q] << 16) * ALPHA + acc[ai][bj][m][0][2 * q]; y0[2 * q + 1] = __uint_as_float(xv[q] & 0xffff0000u) * ALPHA + acc[ai][bj][m][0][2 * q + 1];
                        y1[2 * q] = __uint_as_float(xv[2 + q] << 16) * ALPHA + acc[ai][bj][m][1][2 * q]; y1[2 * q + 1] = __uint_as_float(xv[2 + q] & 0xffff0000u) * ALPHA + acc[ai][bj][m][1][2 * q + 1]; }
                    *(u32x4*)(Y + o + bj * HALF) = pack8(y0, y1); } }
    }
};
__device__ __forceinline__ unsigned pack4_fp8(float a, float b, float c, float d) {
    a = fminf(fmaxf(a, -448.f), 448.f); b = fminf(fmaxf(b, -448.f), 448.f); c = fminf(fmaxf(c, -448.f), 448.f); d = fminf(fmaxf(d, -448.f), 448.f);
    int p = 0; p = __builtin_amdgcn_cvt_pk_fp8_f32(a, b, p, false); p = __builtin_amdgcn_cvt_pk_fp8_f32(c, d, p, true); return (unsigned)p;
}
constexpr float F8_X = 16.f, F8_WGU = 64.f, F8_H = 4.f, F8_WDN = 256.f, F8_O = 64.f, F8_WDO = 128.f;
constexpr int e8m0x4(int e) { return (127 + e) * 0x01010101; }
constexpr int SC_UP = e8m0x4(-10), SC_DN = e8m0x4(-10), SC_DO = e8m0x4(-13);
struct EpiSwiglu8 {
    unsigned char* H;
    __device__ __forceinline__ void operator()(const Acc& acc, const Unit& u, int wr, int wc, int fr, int fq) const {
        const int row0 = u.pm * BM + wr * 64 + fr, col0 = u.pn * 128 + wc * 32 + 8 * fq;
#pragma unroll
        for (int ai = 0; ai < 2; ++ai)
#pragma unroll
            for (int m = 0; m < 4; ++m) { unsigned char* rowp = H + (size_t)(row0 + ai * HALF + m * 16) * DFF + col0;
                float h[8];
#pragma unroll
                for (int j = 0; j < 8; ++j) { const float gt = acc[ai][0][m][j >> 2][j & 3], up = acc[ai][1][m][j >> 2][j & 3];
                    h[j] = __builtin_amdgcn_fmed3f(gt * (up * F8_H) * fast_rcp(1.0f + fast_exp2(gt * -1.4426950408889634f)), -448.f, 448.f); }
                int p0 = 0, p1 = 0;
                p0 = __builtin_amdgcn_cvt_pk_fp8_f32(h[0], h[1], p0, false); p0 = __builtin_amdgcn_cvt_pk_fp8_f32(h[2], h[3], p0, true);
                p1 = __builtin_amdgcn_cvt_pk_fp8_f32(h[4], h[5], p1, false); p1 = __builtin_amdgcn_cvt_pk_fp8_f32(h[6], h[7], p1, true);
                *(u32x2*)rowp = (u32x2){(unsigned)p0, (unsigned)p1}; }
    }
};
struct EpiSwiglu {
    bf16_t* H;
    __device__ __forceinline__ void operator()(const Acc& acc, const Unit& u, int wr, int wc, int fr, int fq) const {
        const int row0 = u.pm * BM + wr * 64 + fr, col0 = u.pn * 128 + wc * 32 + 8 * fq;
#pragma unroll
        for (int ai = 0; ai < 2; ++ai)
#pragma unroll
            for (int m = 0; m < 4; ++m) { bf16_t* rowp = H + (size_t)(row0 + ai * HALF + m * 16) * DFF + col0;
                f32x4 h0, h1;
#pragma unroll
                for (int j = 0; j < 4; ++j) { h0[j] = siluf_(acc[ai][0][m][0][j]) * acc[ai][1][m][0][j]; h1[j] = siluf_(acc[ai][0][m][1][j]) * acc[ai][1][m][1][j]; }
                *(u32x4*)rowp = pack8(h0, h1); }
    }
};
struct EpiBf16 {
    bf16_t* C; int ldc;
    __device__ __forceinline__ void operator()(const Acc& acc, const Unit& u, int wr, int wc, int fr, int fq) const {
        const int row0 = u.pm * BM + wr * 64 + fr, col0 = u.pn * BM + wc * 32 + 8 * fq;
#pragma unroll
        for (int ai = 0; ai < 2; ++ai)
#pragma unroll
            for (int m = 0; m < 4; ++m) { bf16_t* rowp = C + (size_t)(row0 + ai * HALF + m * 16) * ldc + col0;
#pragma unroll
                for (int bj = 0; bj < 2; ++bj) *(u32x4*)(rowp + bj * HALF) = pack8(acc[ai][bj][m][0], acc[ai][bj][m][1]); }
    }
};
struct EpiQ {
    bf16_t* QLAT; bf16_t* QIDX;
    __device__ __forceinline__ void operator()(const Acc& acc, const Unit& u, int wr, int wc, int fr, int fq) const {
        const bool lat = u.pn < 8; bf16_t* base = lat ? QLAT : QIDX; const int ld = lat ? 2048 : 512;
        const int row0 = u.pm * BM + wr * 64 + fr, col0 = (lat ? u.pn : u.pn - 8) * BM + wc * 32 + 8 * fq;
#pragma unroll
        for (int ai = 0; ai < 2; ++ai)
#pragma unroll
            for (int m = 0; m < 4; ++m) { bf16_t* rowp = base + (size_t)(row0 + ai * HALF + m * 16) * ld + col0;
#pragma unroll
                for (int bj = 0; bj < 2; ++bj) *(u32x4*)(rowp + bj * HALF) = pack8(acc[ai][bj][m][0], acc[ai][bj][m][1]); }
    }
};
struct EpiMoeDn {
    bf16_t* O; const float* GW;
    __device__ __forceinline__ void operator()(const Acc& acc, const Unit& u, int wr, int wc, int fr, int fq) const {
        const int rl0 = wr * 64 + fr, col0 = u.pn * BM + wc * 32 + 8 * fq; const float* gwp = GW + (size_t)u.e * M + 256 * u.lt;
#pragma unroll
        for (int ai = 0; ai < 2; ++ai)
#pragma unroll
            for (int m = 0; m < 4; ++m) { const int rl = rl0 + ai * HALF + m * 16; const float gv = (256 * u.lt + rl < u.cnt) ? gwp[rl] : 0.f; bf16_t* rowp = O + (size_t)(u.pm * BM + rl) * D + col0;
#pragma unroll
                for (int bj = 0; bj < 2; ++bj) *(u32x4*)(rowp + bj * HALF) = pack8(acc[ai][bj][m][0] * gv, acc[ai][bj][m][1] * gv); }
    }
};

struct Params { const float* in[22]; float* out; unsigned char* ws; int ph_lo, ph_hi; };
enum { IN_X = 0, IN_LNG, IN_LNB, IN_HGWIN, IN_HGLB, IN_HGNG, IN_HGWOUT, IN_DWIN, IN_DQNG, IN_DKVNG, IN_DWUQ, IN_DWUK, IN_DWUV, IN_DWQIDX, IN_DKIG, IN_DKIB, IN_DWOUT, IN_FGU, IN_FDN, IN_MR, IN_MGU, IN_MDN };

__device__ __forceinline__ const float* inptr(int i) {
    int off = i * 8; asm volatile("" : "+s"(off));
    typedef const float* cfp;
    return *(const __attribute__((address_space(4))) cfp*)((const __attribute__((address_space(4))) char*)__builtin_amdgcn_kernarg_segment_ptr() + off);
}
#define INP(i) inptr(i)
struct Frame {
    LAS unsigned char* lds;
    unsigned* ctl;
    int tid, lane, wave, G, c;
};

__device__ __forceinline__ void p0_transpose_item(const float* W, int K, int Nsrc, int nblk, bf16_t* WT, int mode, float f8scale, LAS float* scr, int item, int lane) {
    const int kb = item / nblk, nb = item % nblk, k0 = 64 * kb, n0 = 32 * nb;
    const int c4 = (lane & 7) * 4, kr = lane >> 3;
#pragma unroll
    for (int i = 0; i < 8; ++i) { const int kk = 8 * i + kr;
        f32x4 v = (f32x4){0.f, 0.f, 0.f, 0.f};
        if (n0 + c4 < Nsrc) v = *(const f32x4*)(W + (size_t)(k0 + kk) * Nsrc + n0 + c4);
        scr[kk * 33 + c4 + 0] = v[0]; scr[kk * 33 + c4 + 1] = v[1]; scr[kk * 33 + c4 + 2] = v[2]; scr[kk * 33 + c4 + 3] = v[3]; }
    LDS_WAIT(); asm volatile("" ::: "memory");
    int drow0 = n0;
    if (mode == 1) { const int half = n0 / DFF, r = n0 % DFF; drow0 = 256 * (r / 128) + 128 * half + (r % 128); }
    if (f8scale > 0.f) {
        const int c = lane & 3;
#pragma unroll
        for (int j = 0; j < 2; ++j) { const int n = (lane >> 2) + 16 * j; const LAS float* s = scr + (16 * c) * 33 + n;
            u32x4 o;
#pragma unroll
            for (int q = 0; q < 4; ++q) o[q] = pack4_fp8(s[(4 * q) * 33] * f8scale, s[(4 * q + 1) * 33] * f8scale, s[(4 * q + 2) * 33] * f8scale, s[(4 * q + 3) * 33] * f8scale);
            *(u32x4*)((unsigned char*)WT + (size_t)(drow0 + n) * K + k0 + 16 * c) = o; }
    } else {
        const int c = lane & 7;
#pragma unroll
        for (int j = 0; j < 4; ++j) { const int n = (lane >> 3) + 8 * j; const LAS float* s = scr + (8 * c) * 33 + n;
            u32x4 o; o.x = cvt_pk_bf16(s[0 * 33], s[1 * 33]); o.y = cvt_pk_bf16(s[2 * 33], s[3 * 33]); o.z = cvt_pk_bf16(s[4 * 33], s[5 * 33]); o.w = cvt_pk_bf16(s[6 * 33], s[7 * 33]);
            *(u32x4*)(WT + (size_t)(drow0 + n) * K + k0 + 8 * c) = o; }
    }
    LDS_WAIT(); asm volatile("" ::: "memory");
}
__device__ __forceinline__ void p0_combo_item(Frame& F, const float* A, int lda, const float* B, int ldb, bf16_t* out, int ldo, float scale, bool f8 = false) {
    LAS float* As = (LAS float*)F.lds; LAS float* Bs = As + 64 * 128;
    const int t = F.tid;
#pragma unroll
    for (int q = 0; q < 4; ++q) { const int r = (t >> 5) + 16 * q, c4 = (t & 31) * 4; *(LAS f32x4*)(As + r * 128 + c4) = *(const f32x4*)(A + (size_t)r * lda + c4); }
#pragma unroll
    for (int q = 0; q < 4; ++q) { const int r = (t >> 4) + 32 * q, c4 = (t & 15) * 4; *(LAS f32x4*)(Bs + r * 64 + c4) = *(const f32x4*)(B + (size_t)r * ldb + c4); }
    __syncthreads();
    const int tj = t & 63, ti = t >> 6;
    float acc[8];
#pragma unroll
    for (int ii = 0; ii < 8; ++ii) acc[ii] = 0.f;
    for (int d = 0; d < 128; d += 4) {
        const float b0 = Bs[(d + 0) * 64 + tj], b1 = Bs[(d + 1) * 64 + tj], b2 = Bs[(d + 2) * 64 + tj], b3 = Bs[(d + 3) * 64 + tj];
#pragma unroll
        for (int ii = 0; ii < 8; ++ii) { const f32x4 a = *(const LAS f32x4*)(As + (8 * ti + ii) * 128 + d); acc[ii] += a[0] * b0 + a[1] * b1 + a[2] * b2 + a[3] * b3; }
    }
    u32x4 o; o.x = cvt_pk_bf16(acc[0] * scale, acc[1] * scale); o.y = cvt_pk_bf16(acc[2] * scale, acc[3] * scale); o.z = cvt_pk_bf16(acc[4] * scale, acc[5] * scale); o.w = cvt_pk_bf16(acc[6] * scale, acc[7] * scale);
    if (f8) { u32x2 o8; o8.x = pack4_fp8(acc[0] * scale, acc[1] * scale, acc[2] * scale, acc[3] * scale); o8.y = pack4_fp8(acc[4] * scale, acc[5] * scale, acc[6] * scale, acc[7] * scale);
        *(u32x2*)((unsigned char*)out + (size_t)tj * ldo + 8 * ti) = o8; }
    else *(u32x4*)(out + (size_t)tj * ldo + 8 * ti) = o;
    __syncthreads();
}
__device__ __forceinline__ void p0_prologue(Frame& F, const Params& p) {
    unsigned char* ws = p.ws;
    LAS float* scr = (LAS float*)(F.lds + F.wave * 8448);
    const int gw = F.c * NWAVES + F.wave, NGW = F.G * NWAVES;
    constexpr int I0 = 16 * 128, I1 = 16 * 32, I2 = 16 * 224, I3 = 56 * 32, I4 = 16 * 24, I5 = 4 * 16;
    constexpr int NITEMS = 2 * (I0 + I1 + I2 + I3 + I4 + I5) + 16 * (I2 + I3);
    for (int it = gw; it < NITEMS; it += NGW) {
        int r = it;
        if (r < 16 * I2) { const int job = r / I2;
#if MK_MOE_FP8
            p0_transpose_item(INP(IN_MGU) + (size_t)job * D * 2 * DFF, D, 2 * DFF, 224, (bf16_t*)(ws + WS_W_MGU8 + (size_t)job * 2 * DFF * D), 1, F8_WGU, scr, r % I2, F.lane);
#else
            p0_transpose_item(INP(IN_MGU) + (size_t)job * D * 2 * DFF, D, 2 * DFF, 224, (bf16_t*)(ws + WS_W_MGU) + (size_t)job * 2 * DFF * D, 1, 0.f, scr, r % I2, F.lane);
#endif
            continue; } r -= 16 * I2;
        if (r < 16 * I3) { const int job = r / I3;
#if MK_MOE_FP8
            p0_transpose_item(INP(IN_MDN) + (size_t)job * DFF * D, DFF, D, 32, (bf16_t*)(ws + WS_W_MDN8 + (size_t)job * D * DFF), 0, F8_WDN, scr, r % I3, F.lane);
#else
            p0_transpose_item(INP(IN_MDN) + (size_t)job * DFF * D, DFF, D, 32, (bf16_t*)(ws + WS_W_MDN) + (size_t)job * D * DFF, 0, 0.f, scr, r % I3, F.lane);
#endif
            continue; } r -= 16 * I3;
        if (r < 2 * I0) { const int job = r / I0; p0_transpose_item(INP(IN_HGWIN) + (size_t)job * D * 4 * D, D, 4 * D, 128, (bf16_t*)(ws + WS_W_HGIN) + (size_t)job * 4 * D * D, 0, 0.f, scr, r % I0, F.lane); continue; } r -= 2 * I0;
        if (r < 2 * I1) { const int job = r / I1; p0_transpose_item(INP(IN_HGWOUT) + (size_t)job * D * D, D, D, 32, (bf16_t*)(ws + WS_W_HGOUT) + (size_t)job * D * D, 0, 0.f, scr, r % I1, F.lane); continue; } r -= 2 * I1;
        if (r < 2 * I2) { const int job = r / I2;
#if MK_FFN_FP8 == 2
            p0_transpose_item(INP(IN_FGU) + (size_t)job * D * 2 * DFF, D, 2 * DFF, 224, (bf16_t*)(ws + WS_W_FGU + (size_t)job * 2 * DFF * D), 1, F8_WGU, scr, r % I2, F.lane);
#else
            p0_transpose_item(INP(IN_FGU) + (size_t)job * D * 2 * DFF, D, 2 * DFF, 224, (bf16_t*)(ws + WS_W_FGU) + (size_t)job * 2 * DFF * D, 1, 0.f, scr, r % I2, F.lane);
#endif
            continue; } r -= 2 * I2;
        if (r < 2 * I3) { const int job = r / I3;
#if MK_FFN_FP8 >= 1
            p0_transpose_item(INP(IN_FDN) + (size_t)job * DFF * D, DFF, D, 32, (bf16_t*)(ws + WS_W_FDN + (size_t)job * D * DFF), 0, F8_WDN, scr, r % I3, F.lane);
#else
            p0_transpose_item(INP(IN_FDN) + (size_t)job * DFF * D, DFF, D, 32, (bf16_t*)(ws + WS_W_FDN) + (size_t)job * D * DFF, 0, 0.f, scr, r % I3, F.lane);
#endif
            continue; } r -= 2 * I3;
        if (r < 2 * I4) { const int job = r / I4; p0_transpose_item(INP(IN_DWIN) + (size_t)job * D * DSA_IN, D, DSA_IN, 24, (bf16_t*)(ws + WS_W_DIN) + (size_t)job * DSA_IN_PAD * D, 0, 0.f, scr, r % I4, F.lane); continue; } r -= 2 * I4;
        { const int job = r / I5; p0_transpose_item(INP(IN_DWQIDX) + (size_t)job * QR * 512, QR, 512, 16, (bf16_t*)(ws + WS_W_DQ) + (size_t)job * 2560 * QR + (size_t)2048 * QR, 0, 0.f, scr, r % I5, F.lane); }
    }
    { const f32x4* x4 = (const f32x4*)INP(IN_X); u32x2* xb = (u32x2*)(ws + WS_XB); const size_t n4 = (size_t)M * D / 4;
      for (size_t i = (size_t)F.c * NTHREADS + F.tid; i < n4; i += (size_t)F.G * NTHREADS) { const f32x4 v = x4[i]; u32x2 o; o.x = cvt_pk_bf16(v[0], v[1]); o.y = cvt_pk_bf16(v[2], v[3]); xb[i] = o; } }
    __syncthreads();
    const float qscale = 0.08838834764831845f * 1.4426950408889634f;
    for (int it = F.c; it < 256 + 1024; it += F.G) {
        if (it < 256) { const int j = it >> 7, h = (it >> 4) & 7, ib = (it >> 2) & 3, jb = it & 3;
            p0_combo_item(F, INP(IN_DWUQ) + (size_t)j * QR * D + (size_t)(64 * ib) * D + h * 128, D, INP(IN_DWUK) + ((size_t)j * 8 + h) * 128 * KVR + 64 * jb, KVR,
                          (bf16_t*)(ws + WS_W_DQ) + (size_t)j * 2560 * QR + (size_t)(h * 256 + 64 * jb) * QR + 64 * ib, QR, qscale);
        } else { const int r = it - 256, j = r >> 9, h = (r >> 6) & 7, ib = (r >> 4) & 3, jb = r & 15;
            p0_combo_item(F, INP(IN_DWUV) + (((size_t)j * 8 + h) * KVR + 64 * ib) * 128, 128, INP(IN_DWOUT) + (size_t)j * D * D + (size_t)(h * 128) * D + 64 * jb, D,
#if MK_B6_FP8
                          (bf16_t*)(ws + WS_W_DO + (size_t)j * D * 2048 + (size_t)(64 * jb) * 2048 + h * 256 + 64 * ib), 2048, F8_WDO, true);
#else
                          (bf16_t*)(ws + WS_W_DO) + (size_t)j * D * 2048 + (size_t)(64 * jb) * 2048 + h * 256 + 64 * ib, 2048, 1.0f);
#endif
        }
    }
}

__device__ __forceinline__ void unpack8(const u32x4 w, float* v) {
#pragma unroll
    for (int q = 0; q < 4; ++q) { v[2 * q] = __uint_as_float(w[q] << 16); v[2 * q + 1] = __uint_as_float(w[q] & 0xffff0000u); }
}
__device__ __forceinline__ void load_row_bf16(const bf16_t* row, int lane, float (&v)[16]) {
    const u32x4 a = *(const u32x4*)(row + 8 * lane), b = *(const u32x4*)(row + 512 + 8 * lane); unpack8(a, v); unpack8(b, v + 8);
}
__device__ __forceinline__ void load_vec_f32(const float* p, int lane, float (&v)[16]) {
#pragma unroll
    for (int h = 0; h < 2; ++h)
#pragma unroll
        for (int q = 0; q < 2; ++q) { const f32x4 x = *(const f32x4*)(p + 512 * h + 8 * lane + 4 * q); v[8 * h + 4 * q] = x[0]; v[8 * h + 4 * q + 1] = x[1]; v[8 * h + 4 * q + 2] = x[2]; v[8 * h + 4 * q + 3] = x[3]; }
}
__device__ __forceinline__ void store_row_bf16(const float (&v)[16], bf16_t* row, int lane) {
    u32x4 a, b;
#pragma unroll
    for (int q = 0; q < 4; ++q) { a[q] = cvt_pk_bf16(v[2 * q], v[2 * q + 1]); b[q] = cvt_pk_bf16(v[8 + 2 * q], v[8 + 2 * q + 1]); }
    *(u32x4*)(row + 8 * lane) = a; *(u32x4*)(row + 512 + 8 * lane) = b;
}
__device__ __forceinline__ void store_row_fp8(const float (&v)[16], unsigned char* row, int lane) {
    u32x2 o0, o1; o0.x = pack4_fp8(v[0] * F8_X, v[1] * F8_X, v[2] * F8_X, v[3] * F8_X); o0.y = pack4_fp8(v[4] * F8_X, v[5] * F8_X, v[6] * F8_X, v[7] * F8_X);
    o1.x = pack4_fp8(v[8] * F8_X, v[9] * F8_X, v[10] * F8_X, v[11] * F8_X); o1.y = pack4_fp8(v[12] * F8_X, v[13] * F8_X, v[14] * F8_X, v[15] * F8_X);
    *(u32x2*)(row + 8 * lane) = o0; *(u32x2*)(row + 512 + 8 * lane) = o1;
}
__device__ __forceinline__ void store_row_f32(const float (&v)[16], float* row, int lane) {
#pragma unroll
    for (int h = 0; h < 2; ++h)
#pragma unroll
        for (int q = 0; q < 2; ++q) *(f32x4*)(row + 512 * h + 8 * lane + 4 * q) = (f32x4){v[8 * h + 4 * q], v[8 * h + 4 * q + 1], v[8 * h + 4 * q + 2], v[8 * h + 4 * q + 3]};
}
__device__ __forceinline__ void ln_row(float (&v)[16], const float (&g)[16], const float (&b)[16]) {
    float s = 0.f;
#pragma unroll
    for (int i = 0; i < 16; ++i) s += v[i];
    const float mean = wave_sum(s) * (1.f / D); float s2 = 0.f;
#pragma unroll
    for (int i = 0; i < 16; ++i) { v[i] -= mean; s2 += v[i] * v[i]; }
    const float rstd = 1.f / sqrtf(wave_sum(s2) * (1.f / D) + LN_EPS);
#pragma unroll
    for (int i = 0; i < 16; ++i) v[i] = v[i] * rstd * g[i] + b[i];
}
__device__ __forceinline__ void ln_phase(Frame& F, const bf16_t* Y, const float* g, const float* b, bf16_t* XB, unsigned char* XB8) {
    float gv[16], bv[16]; load_vec_f32(g, F.lane, gv); load_vec_f32(b, F.lane, bv);
    const int gw = F.c * NWAVES + F.wave, NGW = F.G * NWAVES;
    for (int m = gw; m < M; m += NGW) {
        float v[16]; load_row_bf16(Y + (size_t)m * D, F.lane, v);
        ln_row(v, gv, bv);
        store_row_bf16(v, XB + (size_t)m * D, F.lane);
        if (XB8) store_row_fp8(v, XB8 + (size_t)m * D, F.lane);
    }
}
__device__ __forceinline__ void ln_moe_phase(Frame& F, const bf16_t* Xin, const bf16_t* OUTM, const int* EIDX, const int* POS, const unsigned* gcnt, const float* g, const float* b, bf16_t* XB, float* OUT) {
    float gv[16], bv[16]; load_vec_f32(g, F.lane, gv); load_vec_f32(b, F.lane, bv);
    int roff[8]; { int t = 0;
#pragma unroll
        for (int e = 0; e < 8; ++e) { roff[e] = t * 256; t += (__builtin_amdgcn_readfirstlane((int)__hip_atomic_load(gcnt + e, __ATOMIC_RELAXED, __HIP_MEMORY_SCOPE_AGENT)) + 255) >> 8; } }
    const int gw = F.c * NWAVES + F.wave, NGW = F.G * NWAVES;
    for (int m = gw; m < M; m += NGW) {
        const int e0 = EIDX[2 * m], e1 = EIDX[2 * m + 1]; int s0 = POS[2 * m], s1 = POS[2 * m + 1];
#pragma unroll
        for (int k = 0; k < 8; ++k) { s0 += (e0 == k) ? roff[k] : 0; s1 += (e1 == k) ? roff[k] : 0; }
        float v[16], o0[16], o1[16]; load_row_bf16(Xin + (size_t)m * D, F.lane, v); load_row_bf16(OUTM + (size_t)s0 * D, F.lane, o0); load_row_bf16(OUTM + (size_t)s1 * D, F.lane, o1);
#pragma unroll
        for (int i = 0; i < 16; ++i) v[i] = v[i] * ALPHA + o0[i] + o1[i];
        ln_row(v, gv, bv);
        if (OUT) store_row_f32(v, OUT + (size_t)m * D, F.lane); else store_row_bf16(v, XB + (size_t)m * D, F.lane);
    }
}
__device__ __forceinline__ void ln_router_phase(Frame& F, const bf16_t* Y, const float* g, const float* b, const float* wrouter, bf16_t* XB, unsigned char* XB8,
                                                int* EIDX, int* POS, int* TOK, float* GW, unsigned* gcnt) {
    LAS float* WR = (LAS float*)F.lds;
    LAS int* SEL = (LAS int*)(F.lds + 32768);
    LAS int* CW = (LAS int*)(F.lds + 32768 + 1024);
    LAS int* BASE = (LAS int*)(F.lds + 32768 + 1024 + 128);
    LAS float* SELW = (LAS float*)(F.lds + 32768 + 2048);
    for (int q = 0; q < 16; ++q) { const int idx = F.tid + NTHREADS * q; WR[(idx & 7) * 1024 + (idx >> 3)] = wrouter[idx]; }
    float gv[16], bv[16]; load_vec_f32(g, F.lane, gv); load_vec_f32(b, F.lane, bv);
    __syncthreads();
    for (int blk = F.c; blk < M / 128; blk += F.G) {
        for (int rl = F.wave; rl < 128; rl += NWAVES) {
            const int m = blk * 128 + rl;
            float v[16]; load_row_bf16(Y + (size_t)m * D, F.lane, v);
            ln_row(v, gv, bv);
            store_row_bf16(v, XB + (size_t)m * D, F.lane);
            if (XB8) store_row_fp8(v, XB8 + (size_t)m * D, F.lane);
            float lg[8];
#pragma unroll
            for (int e = 0; e < 8; ++e) { float s = 0.f;
#pragma unroll
                for (int h = 0; h < 2; ++h)
#pragma unroll
                    for (int q = 0; q < 2; ++q) { const f32x4 w = *(const LAS f32x4*)(WR + e * 1024 + 512 * h + 8 * F.lane + 4 * q); const int o = 8 * h + 4 * q;
                        s += (v[o] * w[0] + v[o + 1] * w[1]) + (v[o + 2] * w[2] + v[o + 3] * w[3]); }
                lg[e] = wave_sum(s); }
            int e0 = 0; float v0 = lg[0];
#pragma unroll
            for (int e = 1; e < 8; ++e) if (lg[e] > v0) { v0 = lg[e]; e0 = e; }
            int e1 = -1; float v1 = -3.0e38f;
#pragma unroll
            for (int e = 0; e < 8; ++e) if (e != e0 && lg[e] > v1) { v1 = lg[e]; e1 = e; }
            const float w1 = 1.f / (1.f + __expf(v0 - v1)), w0 = 1.f - w1;
            if (F.lane == 0) { SEL[2 * rl] = e0; SEL[2 * rl + 1] = e1; SELW[2 * rl] = w0; SELW[2 * rl + 1] = w1; EIDX[2 * m] = e0; EIDX[2 * m + 1] = e1; }
        }
        __syncthreads();
        const int mine = F.tid < 256 ? SEL[F.tid] : -1;
        int myrank = 0;
        if (F.wave < 4) {
#pragma unroll
            for (int e = 0; e < 8; ++e) { const unsigned long long mk = __ballot(mine == e); const int rk = __builtin_popcountll(mk & ((1ull << F.lane) - 1ull)); if (mine == e) myrank = rk;
                if (F.lane == 0) CW[F.wave * 8 + e] = __builtin_popcountll(mk); }
        }
        __syncthreads();
        if (F.tid < 8) { const int tot = CW[F.tid] + CW[8 + F.tid] + CW[16 + F.tid] + CW[24 + F.tid]; BASE[F.tid] = (int)__hip_atomic_fetch_add(gcnt + F.tid, (unsigned)tot, __ATOMIC_RELAXED, __HIP_MEMORY_SCOPE_AGENT); }
        __syncthreads();
        if (F.tid < 256) { int pos = BASE[mine] + myrank; for (int w = 0; w < F.wave; ++w) pos += CW[w * 8 + mine]; POS[blk * 256 + F.tid] = pos;
            TOK[(size_t)mine * M + pos] = blk * 128 + (F.tid >> 1); GW[(size_t)mine * M + pos] = SELW[F.tid]; }
        __syncthreads();
    }
}
__device__ __forceinline__ void hgrn_phase(Frame& F, const bf16_t* Q, const bf16_t* FP, const bf16_t* V, const float* lbparam, int jl, bf16_t* O) {
    constexpr int QST = 0, QS2 = 18432, KST = 36864, VS = 55296, SST0 = 64512, SSTB = 17408, SEG = 99328, RV = 103424, DV = 103936;
    constexpr int LQ = 136, LT = 72;
    LAS unsigned char* L = F.lds;
    const int tid = F.tid, lane = F.lane, w = F.wave, fr = lane & 15, fq = lane >> 4, qq = fr >> 2, pp = lane & 3;
    const int dp = tid & 63, seg = tid >> 6, d0 = 2 * dp;
    const int vrow = tid >> 3, vch = tid & 7;
    const int tt = w >> 1, eh = w & 1;
    for (int u = F.c; u < BATCH * HG_H * 2; u += F.G) {
        const int b = u >> 4, h = (u >> 1) & 7, vh = u & 1;
        float lb0 = 0.f, lb1 = 0.f;
        if (jl == 1) { const f32x2 l0 = *(const f32x2*)(lbparam + h * 128 + d0), l1 = *(const f32x2*)(lbparam + D + h * 128 + d0); lb0 = 1.f / (1.f + __expf(l0[0] - l1[0])); lb1 = 1.f / (1.f + __expf(l0[1] - l1[1])); }
        const float om0 = 1.f - lb0, om1 = 1.f - lb1;
        f32x4 St[4];
#pragma unroll
        for (int et = 0; et < 4; ++et) { St[et] = (f32x4){0.f, 0.f, 0.f, 0.f}; *(LAS u32x2*)(L + SST0 + ((16 * et + fr) * LQ + 16 * w + 4 * fq) * 2) = (u32x2){0u, 0u}; }
        const size_t ubase = (size_t)b * SEQ * D + h * 128;
        unsigned fpn[8], qn[8]; u32x4 vn;
        { const bf16_t* fp = FP + ubase + (size_t)(8 * seg) * D + d0; const bf16_t* qp = Q + ubase + (size_t)(8 * seg) * D + d0;
#pragma unroll
          for (int i = 0; i < 8; ++i) { fpn[i] = *(const unsigned*)(fp + (size_t)i * D); qn[i] = *(const unsigned*)(qp + (size_t)i * D); }
          vn = *(const u32x4*)(V + ubase + (size_t)vrow * D + vh * 64 + 8 * vch); }
        for (int ch = 0; ch < SEQ / HG_C; ++ch) {
            const size_t rowoff = ubase + (size_t)ch * HG_C * D;
            LAS unsigned char* SSTc = L + SST0 + (ch & 1) * SSTB; LAS unsigned char* SSTn = L + SST0 + ((ch + 1) & 1) * SSTB;
            float c0[8], c1[8], k0[8], k1[8], q0[8], q1[8];
            { float a0 = 0.f, a1 = 0.f;
#pragma unroll
              for (int i = 0; i < 8; ++i) { const float s0 = sigmoidf_(__uint_as_float(fpn[i] << 16)), s1 = sigmoidf_(__uint_as_float(fpn[i] & 0xffff0000u));
                  a0 += __logf(lb0 + om0 * s0); a1 += __logf(lb1 + om1 * s1); c0[i] = a0; c1[i] = a1; k0[i] = om0 * (1.f - s0); k1[i] = om1 * (1.f - s1);
                  q0[i] = __uint_as_float(qn[i] << 16); q1[i] = __uint_as_float(qn[i] & 0xffff0000u); }
              *(LAS f32x2*)(L + SEG + (seg * 128 + d0) * 4) = (f32x2){a0, a1};
              *(LAS u32x4*)(L + VS + (vrow * LT + 8 * vch) * 2) = vn; }
            __syncthreads();
            { float pre0 = 0.f, pre1 = 0.f, r0 = 0.f, r1 = 0.f, bl0 = 0.f, bl1 = 0.f;
#pragma unroll
              for (int s = 0; s < 8; ++s) { const f32x2 v = *(LAS f32x2*)(L + SEG + (s * 128 + d0) * 4);
                  if (s < seg) { pre0 += v[0]; pre1 += v[1]; } if (s < 4) { r0 += v[0]; r1 += v[1]; } bl0 += v[0]; bl1 += v[1]; }
              const float er0 = __expf(r0), er1 = __expf(r1);
              unsigned qa[4], qb[4], ka[4], xa[4], xb[4], kb[4];
#pragma unroll
              for (int i = 0; i < 8; i += 2) {
                  const float ba = pre0 + c0[i], bb = pre0 + c0[i + 1], bc = pre1 + c1[i], bd = pre1 + c1[i + 1];
                  const float qa0 = q0[i] * __expf(ba - r0), qa1 = q0[i + 1] * __expf(bb - r0), qb0 = q1[i] * __expf(bc - r1), qb1 = q1[i + 1] * __expf(bd - r1);
                  qa[i >> 1] = cvt_pk_bf16(qa0, qa1); qb[i >> 1] = cvt_pk_bf16(qb0, qb1);
                  xa[i >> 1] = cvt_pk_bf16(qa0 * er0, qa1 * er0); xb[i >> 1] = cvt_pk_bf16(qb0 * er1, qb1 * er1);
                  ka[i >> 1] = cvt_pk_bf16(k0[i] * __expf(r0 - ba), k0[i + 1] * __expf(r0 - bb)); kb[i >> 1] = cvt_pk_bf16(k1[i] * __expf(r1 - bc), k1[i + 1] * __expf(r1 - bd));
              }
              const int o0 = (d0 * LT + 8 * seg) * 2, o1 = o0 + LT * 2;
              *(LAS u32x4*)(L + QST + o0) = (u32x4){qa[0], qa[1], qa[2], qa[3]}; *(LAS u32x4*)(L + QST + o1) = (u32x4){qb[0], qb[1], qb[2], qb[3]};
              *(LAS u32x4*)(L + QS2 + o0) = (u32x4){xa[0], xa[1], xa[2], xa[3]}; *(LAS u32x4*)(L + QS2 + o1) = (u32x4){xb[0], xb[1], xb[2], xb[3]};
              *(LAS u32x4*)(L + KST + o0) = (u32x4){ka[0], ka[1], ka[2], ka[3]}; *(LAS u32x4*)(L + KST + o1) = (u32x4){kb[0], kb[1], kb[2], kb[3]};
              if (seg == 0) { *(LAS f32x2*)(L + RV + d0 * 4) = (f32x2){er0, er1}; *(LAS f32x2*)(L + DV + d0 * 4) = (f32x2){__expf(bl0 - r0), __expf(bl1 - r1)}; } }
            __syncthreads();
            if (ch + 1 < SEQ / HG_C) {
                const bf16_t* fp = FP + rowoff + (size_t)(HG_C + 8 * seg) * D + d0; const bf16_t* qp = Q + rowoff + (size_t)(HG_C + 8 * seg) * D + d0;
#pragma unroll
                for (int i = 0; i < 8; ++i) { fpn[i] = *(const unsigned*)(fp + (size_t)i * D); qn[i] = *(const unsigned*)(qp + (size_t)i * D); }
                vn = *(const u32x4*)(V + rowoff + (size_t)(HG_C + vrow) * D + vh * 64 + 8 * vch);
            }
            bf16x8 Pf[2];
            { f32x4 sc[4];
#pragma unroll
              for (int st = 0; st < 4; ++st) { sc[st] = (f32x4){0.f, 0.f, 0.f, 0.f};
                  if (st <= tt) {
#pragma unroll
                      for (int ks = 0; ks < 4; ++ks) {
                          const int ro = ((32 * ks + 8 * fq + qq) * LT + 4 * pp) * 2;
                          const s16x4 a0 = __builtin_amdgcn_ds_read_tr16_b64_v4i16((LAS s16x4*)(L + KST + ro + 32 * st)), a1 = __builtin_amdgcn_ds_read_tr16_b64_v4i16((LAS s16x4*)(L + KST + ro + 4 * LT * 2 + 32 * st));
                          const s16x4 b0 = __builtin_amdgcn_ds_read_tr16_b64_v4i16((LAS s16x4*)(L + QST + ro + 32 * tt)), b1 = __builtin_amdgcn_ds_read_tr16_b64_v4i16((LAS s16x4*)(L + QST + ro + 4 * LT * 2 + 32 * tt));
                          const bf16x8 av = (bf16x8){a0[0], a0[1], a0[2], a0[3], a1[0], a1[1], a1[2], a1[3]}, bv = (bf16x8){b0[0], b0[1], b0[2], b0[3], b1[0], b1[1], b1[2], b1[3]};
                          sc[st] = __builtin_amdgcn_mfma_f32_16x16x32_bf16(av, bv, sc[st], 0, 0, 0); }
#pragma unroll
                      for (int r = 0; r < 4; ++r) sc[st][r] = (16 * st + 4 * fq + r <= 16 * tt + fr) ? sc[st][r] : 0.f;
                  } }
              const u32x4 p0 = pack8(sc[0], sc[1]), p1 = pack8(sc[2], sc[3]); Pf[0] = __builtin_bit_cast(bf16x8, p0); Pf[1] = __builtin_bit_cast(bf16x8, p1); }
            { bf16x8 q2[4];
#pragma unroll
              for (int ks = 0; ks < 4; ++ks) { const int ro = ((32 * ks + 8 * fq + qq) * LT + 4 * pp) * 2 + 32 * tt;
                  const s16x4 b0 = __builtin_amdgcn_ds_read_tr16_b64_v4i16((LAS s16x4*)(L + QS2 + ro)), b1 = __builtin_amdgcn_ds_read_tr16_b64_v4i16((LAS s16x4*)(L + QS2 + ro + 4 * LT * 2));
                  q2[ks] = (bf16x8){b0[0], b0[1], b0[2], b0[3], b1[0], b1[1], b1[2], b1[3]}; }
#pragma unroll
              for (int ex = 0; ex < 2; ++ex) { const int et = 2 * eh + ex;
                  f32x4 acc = (f32x4){0.f, 0.f, 0.f, 0.f};
#pragma unroll
                  for (int k2 = 0; k2 < 2; ++k2) {
                      if (k2 == 0 || tt >= 2) {
                          const int ro = ((32 * k2 + 4 * fq + qq) * LT + 16 * et + 4 * pp) * 2;
                          const s16x4 a0 = __builtin_amdgcn_ds_read_tr16_b64_v4i16((LAS s16x4*)(L + VS + ro)), a1 = __builtin_amdgcn_ds_read_tr16_b64_v4i16((LAS s16x4*)(L + VS + ro + 16 * LT * 2));
                          const bf16x8 av = (bf16x8){a0[0], a0[1], a0[2], a0[3], a1[0], a1[1], a1[2], a1[3]};
                          acc = __builtin_amdgcn_mfma_f32_16x16x32_bf16(av, Pf[k2], acc, 0, 0, 0); } }
#pragma unroll
                  for (int ks = 0; ks < 4; ++ks) { const bf16x8 av = *(LAS bf16x8*)(SSTc + ((16 * et + fr) * LQ + 32 * ks + 8 * fq) * 2);
                      acc = __builtin_amdgcn_mfma_f32_16x16x32_bf16(av, q2[ks], acc, 0, 0, 0); }
                  u32x2 ov; ov.x = cvt_pk_bf16(acc[0], acc[1]); ov.y = cvt_pk_bf16(acc[2], acc[3]);
                  *(u32x2*)(O + rowoff + (size_t)(16 * tt + fr) * D + vh * 64 + 16 * et + 4 * fq) = ov;
              } }
            { const f32x4 rv = *(LAS f32x4*)(L + RV + (16 * w + 4 * fq) * 4), dv = *(LAS f32x4*)(L + DV + (16 * w + 4 * fq) * 4);
              bf16x8 kf[2];
#pragma unroll
              for (int ks = 0; ks < 2; ++ks) kf[ks] = *(LAS bf16x8*)(L + KST + ((16 * w + fr) * LT + 32 * ks + 8 * fq) * 2);
#pragma unroll
              for (int et = 0; et < 4; ++et) { St[et] = St[et] * rv;
#pragma unroll
                  for (int ks = 0; ks < 2; ++ks) { const int ro = ((32 * ks + 8 * fq + qq) * LT + 16 * et + 4 * pp) * 2;
                      const s16x4 b0 = __builtin_amdgcn_ds_read_tr16_b64_v4i16((LAS s16x4*)(L + VS + ro)), b1 = __builtin_amdgcn_ds_read_tr16_b64_v4i16((LAS s16x4*)(L + VS + ro + 4 * LT * 2));
                      const bf16x8 bb = (bf16x8){b0[0], b0[1], b0[2], b0[3], b1[0], b1[1], b1[2], b1[3]};
                      St[et] = __builtin_amdgcn_mfma_f32_16x16x32_bf16(kf[ks], bb, St[et], 0, 0, 0); }
                  St[et] = St[et] * dv;
                  u32x2 o; o.x = cvt_pk_bf16(St[et][0], St[et][1]); o.y = cvt_pk_bf16(St[et][2], St[et][3]);
                  *(LAS u32x2*)(SSTn + ((16 * et + fr) * LQ + 16 * w + 4 * fq) * 2) = o; } }
            __syncthreads();
        }
    }
}
__device__ __forceinline__ void hgrn_gate_phase(Frame& F, const bf16_t* O, const bf16_t* Gt, const float* ng, bf16_t* OG) {
    float gw_[16];
#pragma unroll
    for (int i = 0; i < 16; ++i) gw_[i] = ng[16 * F.lane + i];
    const int gw = F.c * NWAVES + F.wave, NGW = F.G * NWAVES;
    for (int m = gw; m < M; m += NGW) {
        const u32x4 o0 = *(const u32x4*)(O + (size_t)m * D + 16 * F.lane), o1 = *(const u32x4*)(O + (size_t)m * D + 16 * F.lane + 8);
        const u32x4 g0 = *(const u32x4*)(Gt + (size_t)m * D + 16 * F.lane), g1 = *(const u32x4*)(Gt + (size_t)m * D + 16 * F.lane + 8);
        float ov[16], gv[16];
#pragma unroll
        for (int i = 0; i < 4; ++i) { ov[2 * i] = __uint_as_float(o0[i] << 16); ov[2 * i + 1] = __uint_as_float(o0[i] & 0xffff0000u); ov[8 + 2 * i] = __uint_as_float(o1[i] << 16); ov[8 + 2 * i + 1] = __uint_as_float(o1[i] & 0xffff0000u);
            gv[2 * i] = __uint_as_float(g0[i] << 16); gv[2 * i + 1] = __uint_as_float(g0[i] & 0xffff0000u); gv[8 + 2 * i] = __uint_as_float(g1[i] << 16); gv[8 + 2 * i + 1] = __uint_as_float(g1[i] & 0xffff0000u); }
        float ss = 0.f;
#pragma unroll
        for (int i = 0; i < 16; ++i) ss += ov[i] * ov[i];
        ss += __builtin_bit_cast(float, __builtin_amdgcn_update_dpp(0, __builtin_bit_cast(int, ss), 0xB1, 0xF, 0xF, true));
        ss += __builtin_bit_cast(float, __builtin_amdgcn_update_dpp(0, __builtin_bit_cast(int, ss), 0x4E, 0xF, 0xF, true));
        ss += __builtin_bit_cast(float, __builtin_amdgcn_update_dpp(0, __builtin_bit_cast(int, ss), 0x141, 0xF, 0xF, true));
        const float rs = 1.f / sqrtf(ss * (1.f / 128.f) + RMS_EPS);
        float r[16];
#pragma unroll
        for (int i = 0; i < 16; ++i) r[i] = ov[i] * rs * gw_[i] * siluf_(gv[i]);
        u32x4 w0, w1; w0.x = cvt_pk_bf16(r[0], r[1]); w0.y = cvt_pk_bf16(r[2], r[3]); w0.z = cvt_pk_bf16(r[4], r[5]); w0.w = cvt_pk_bf16(r[6], r[7]);
        w1.x = cvt_pk_bf16(r[8], r[9]); w1.y = cvt_pk_bf16(r[10], r[11]); w1.z = cvt_pk_bf16(r[12], r[13]); w1.w = cvt_pk_bf16(r[14], r[15]);
        *(u32x4*)(OG + (size_t)m * D + 16 * F.lane) = w0; *(u32x4*)(OG + (size_t)m * D + 16 * F.lane + 8) = w1;
    }
}

__device__ __forceinline__ void dsa_norm_phase(Frame& F, const bf16_t* RAW, const float* qg, const float* kvg, const float* kig, const float* kib, bf16_t* CQ, bf16_t* CKV, bf16_t* KIDX, float* WIDX) {
    const f32x4 qgv = *(const f32x4*)(qg + 4 * F.lane), kvgv = *(const f32x4*)(kvg + 4 * F.lane); const float kg = kig[F.lane], kb = kib[F.lane];
    const int gw = F.c * NWAVES + F.wave, NGW = F.G * NWAVES;
    for (int m = gw; m < M; m += NGW) {
        const bf16_t* r = RAW + (size_t)m * DSA_IN_PAD;
        const u32x2 ar = *(const u32x2*)(r + 4 * F.lane), cr = *(const u32x2*)(r + 256 + 4 * F.lane); const float ki = bf2f(r[512 + F.lane]);
        const f32x4 a = (f32x4){__uint_as_float(ar.x << 16), __uint_as_float(ar.x & 0xffff0000u), __uint_as_float(ar.y << 16), __uint_as_float(ar.y & 0xffff0000u)};
        const f32x4 c = (f32x4){__uint_as_float(cr.x << 16), __uint_as_float(cr.x & 0xffff0000u), __uint_as_float(cr.y << 16), __uint_as_float(cr.y & 0xffff0000u)};
        const float sa = wave_sum((a[0] * a[0] + a[1] * a[1]) + (a[2] * a[2] + a[3] * a[3])), sc = wave_sum((c[0] * c[0] + c[1] * c[1]) + (c[2] * c[2] + c[3] * c[3]));
        const float ra = 1.f / sqrtf(sa * (1.f / 256.f) + RMS_EPS), rc = 1.f / sqrtf(sc * (1.f / 256.f) + RMS_EPS);
        u32x2 o; o.x = cvt_pk_bf16(a[0] * ra * qgv[0], a[1] * ra * qgv[1]); o.y = cvt_pk_bf16(a[2] * ra * qgv[2], a[3] * ra * qgv[3]); *(u32x2*)(CQ + (size_t)m * 256 + 4 * F.lane) = o;
        o.x = cvt_pk_bf16(c[0] * rc * kvgv[0], c[1] * rc * kvgv[1]); o.y = cvt_pk_bf16(c[2] * rc * kvgv[2], c[3] * rc * kvgv[3]); *(u32x2*)(CKV + (size_t)m * 256 + 4 * F.lane) = o;
        const float mu = wave_sum(ki) * (1.f / 64.f), dk = ki - mu, var = wave_sum(dk * dk) * (1.f / 64.f);
        KIDX[(size_t)m * 64 + F.lane] = f2bf(dk * (1.f / sqrtf(var + LN_EPS)) * kg + kb);
        if (F.lane < 8) WIDX[(size_t)m * 8 + F.lane] = bf2f(r[576 + F.lane]) * 0.04419417382415922f;
    }
}
__device__ __forceinline__ unsigned f2ord(float v) { const unsigned u = __float_as_uint(v); return (u & 0x80000000u) ? ~u : (u | 0x80000000u); }
__device__ __forceinline__ void dsa_index_phase(Frame& F, const bf16_t* QIDX, const bf16_t* KIDX, const float* WIDX, unsigned long long* MASK) {
    LAS float* SC = (LAS float*)F.lds;
    const int lane = F.lane, w = F.wave, fr = lane & 15, fq = lane >> 4;
    for (int i = 0;; ++i) {
        const int u = i * F.G + F.c; if (u >= BATCH * (SEQ / 16)) break;
        const int b = (u & 255) >> 4, qlo = (u & 15) + 16 * (u >> 9), qt = ((u >> 8) & 1) ? 127 - qlo : qlo, t0 = 16 * qt;     const size_t rb = (size_t)b * SEQ;
        bf16x8 Af[4][2][2]; float wv[4][8];
#pragma unroll
        for (int tg = 0; tg < 4; ++tg) {
#pragma unroll
            for (int hh = 0; hh < 2; ++hh)
#pragma unroll
                for (int ks = 0; ks < 2; ++ks) Af[tg][hh][ks] = *(const bf16x8*)(QIDX + (rb + t0 + 4 * tg + (fr >> 2)) * 512 + (4 * hh + (fr & 3)) * 64 + 32 * ks + 8 * fq);
            const f32x4 w0 = *(const f32x4*)(WIDX + (rb + t0 + 4 * tg + fq) * 8), w1 = *(const f32x4*)(WIDX + (rb + t0 + 4 * tg + fq) * 8 + 4);
#pragma unroll
            for (int r = 0; r < 4; ++r) { wv[tg][r] = w0[r]; wv[tg][4 + r] = w1[r]; }
        }
        bf16x8 nB0 = *(const bf16x8*)(KIDX + (rb + 16 * w + fr) * 64 + 8 * fq), nB1 = *(const bf16x8*)(KIDX + (rb + 16 * w + fr) * 64 + 32 + 8 * fq);
        for (int kg = w; kg <= qt; kg += NWAVES) {
            const bf16x8 B0 = nB0, B1 = nB1;
            { const int kn = (kg + NWAVES <= qt) ? kg + NWAVES : kg;
              nB0 = *(const bf16x8*)(KIDX + (rb + 16 * kn + fr) * 64 + 8 * fq); nB1 = *(const bf16x8*)(KIDX + (rb + 16 * kn + fr) * 64 + 32 + 8 * fq); }
#pragma unroll
            for (int tg = 0; tg < 4; ++tg) { float s = 0.f;
#pragma unroll
                for (int hh = 0; hh < 2; ++hh) { f32x4 acc = (f32x4){0.f, 0.f, 0.f, 0.f};
                    acc = __builtin_amdgcn_mfma_f32_16x16x32_bf16(Af[tg][hh][0], B0, acc, 0, 0, 0); acc = __builtin_amdgcn_mfma_f32_16x16x32_bf16(Af[tg][hh][1], B1, acc, 0, 0, 0);
#pragma unroll
                    for (int r = 0; r < 4; ++r) s += wv[tg][4 * hh + r] * fmaxf(acc[r], 0.f); }
                SC[(4 * tg + fq) * 2048 + 16 * kg + fr] = s + 0.0f; }
        }
        __syncthreads();
        for (int tq = 2 * w; tq < 2 * w + 2; ++tq) {
            const int t = t0 + tq;
            unsigned key[32];
#pragma unroll
            for (int r = 0; r < 32; ++r) { const int s = 64 * r + lane; key[r] = (s <= t) ? f2ord(SC[tq * 2048 + s]) : 0u; }
            unsigned long long selw = 0ull;
            if (t < TOPK) {
#pragma unroll
                for (int r = 0; r < 32; ++r) { const unsigned long long mk = __ballot(64 * r + lane <= t); if (lane == r) selw = mk; }
            } else {
                unsigned prefix = 0u; bool exact = false;
                for (int bit = 31; bit >= 0; --bit) {
                    const unsigned cand = prefix | (1u << bit); int cnt = 0;
#pragma unroll
                    for (int r = 0; r < 32; ++r) cnt += __builtin_popcountll(__ballot(key[r] >= cand));
                    if (cnt >= TOPK) { prefix = cand; if (cnt == TOPK) { exact = true; break; } }
                }
                if (exact) {
#pragma unroll
                    for (int r = 0; r < 32; ++r) { const unsigned long long mk = __ballot(key[r] >= prefix); if (lane == r) selw = mk; }
                } else {
                    int ngt = 0;
#pragma unroll
                    for (int r = 0; r < 32; ++r) ngt += __builtin_popcountll(__ballot(key[r] > prefix));
                    const int need = TOPK - ngt; int run = 0;
#pragma unroll
                    for (int r = 0; r < 32; ++r) { const unsigned long long tie = __ballot(key[r] == prefix); const int rk = run + __builtin_popcountll(tie & ((1ull << lane) - 1ull));
                        const unsigned long long mk = __ballot(key[r] > prefix || (key[r] == prefix && rk < need)); if (lane == r) selw = mk; run += __builtin_popcountll(tie); }
                }
            }
            if (lane < 32) MASK[(rb + t) * 32 + lane] = selw;
        }
        __syncthreads();
    }
}
__device__ __forceinline__ void dsa_attn_phase(Frame& F, const bf16_t* QLAT, const bf16_t* CKV, const unsigned long long* MASK, bf16_t* OLAT, unsigned char* OLAT8) {
    constexpr int TB = 32768;
    LAS unsigned char* L = F.lds;
    const int lane = F.lane, w = F.wave, fr = lane & 15, fq = lane >> 4;
    const int qq = fr >> 2, pp = lane & 3;
    const bool grpB = w >= 4;
    const int kbase = fr * 512, ysh = (fq ^ (2 * (fr & 7))) << 4;
    const int x2s = (2 * (4 * (fq & 1) + qq)) << 4;
    const int vbase = (4 * fq + qq) * 512 + (pp >> 1) * 16 + (pp & 1) * 8;
    const int drow = lane >> 5, dpc = lane & 31;
    for (int i = 0;; ++i) {
        const int u = i * F.G + F.c; if (u >= BATCH * (SEQ / 16)) break;
        const int b = (u & 255) >> 4, qlo = (u & 15) + 16 * (u >> 9), qt = ((u >> 8) & 1) ? 127 - qlo : qlo, t0 = 16 * qt;     const size_t rb = (size_t)b * SEQ;
        const int ntiles = (t0 + 15) / 64 + 1;
        bf16x8 Qf[8];
#pragma unroll
        for (int ks = 0; ks < 8; ++ks) Qf[ks] = *(const bf16x8*)(QLAT + (rb + t0 + fr) * 2048 + w * 256 + 32 * ks + 8 * fq);
        f32x4 Ot[16];
#pragma unroll
        for (int cb = 0; cb < 16; ++cb) Ot[cb] = (f32x4){0.f, 0.f, 0.f, 0.f};
        float mrun = -1.0e30f, lsum = 0.f;
        bf16x8 Pf[2];
#define ATT_DMA(kt_, buf_) do { _Pragma("unroll") for (int q_ = 0; q_ < 4; ++q_) { const int row_ = 2 * (4 * w + q_) + drow; \
            __builtin_amdgcn_global_load_lds((const unsigned*)(CKV + (rb + 64 * (kt_) + row_) * 256 + 8 * (dpc ^ (2 * (row_ & 7)))), (LAS unsigned*)(L + (buf_) * TB + (4 * w + q_) * 1024), 16, 0, 0); } } while (0)
#define ATT_ST(buf_) do { int ka_[8]; { const int kb_t_ = kbase + (buf_) * TB; _Pragma("unroll") for (int ks = 0; ks < 8; ++ks) ka_[ks] = kb_t_ + ((64 * ks) ^ ysh); } \
            _Pragma("unroll") for (int kb = 0; kb < 4; ++kb) S[kb] = (f32x4){0.f, 0.f, 0.f, 0.f}; \
            bf16x8 kf[2][2]; \
            _Pragma("unroll") for (int j = 0; j < 2; ++j) kf[0][j] = *(LAS bf16x8*)(L + ka_[j]); \
            _Pragma("unroll") for (int bt = 0; bt < 16; ++bt) {        \
                if (bt + 1 < 16) { _Pragma("unroll") for (int j = 0; j < 2; ++j) kf[(bt + 1) & 1][j] = *(LAS bf16x8*)(L + ka_[2 * ((bt + 1) & 3) + j] + 8192 * ((bt + 1) >> 2)); } \
                _Pragma("unroll") for (int j = 0; j < 2; ++j) S[bt >> 2] = __builtin_amdgcn_mfma_f32_16x16x32_bf16(kf[bt & 1][j], Qf[2 * (bt & 3) + j], S[bt >> 2], 0, 0, 0); \
                __builtin_amdgcn_sched_barrier(0); } } while (0)
#define ATT_SOFTMAX(mw_) do { \
            float mx = fmaxf(fmaxf(fmaxf(S[0][0], S[0][1]), fmaxf(S[0][2], S[0][3])), fmaxf(fmaxf(S[1][0], S[1][1]), fmaxf(S[1][2], S[1][3]))); \
            mx = fmaxf(mx, fmaxf(fmaxf(fmaxf(S[2][0], S[2][1]), fmaxf(S[2][2], S[2][3])), fmaxf(fmaxf(S[3][0], S[3][1]), fmaxf(S[3][2], S[3][3])))); \
            mx = fmaxf(mx, __shfl_xor(mx, 16)); mx = fmaxf(mx, __shfl_xor(mx, 32)); \
            const bool need = mx > mrun + 8.0f; \
            if (__any(need)) { const float mnew = need ? mx : mrun, alpha = fast_exp2(mrun - mnew); mrun = mnew; lsum *= alpha; \
                _Pragma("unroll") for (int cb = 0; cb < 16; ++cb) Ot[cb] = Ot[cb] * alpha; } \
            const unsigned long long mq = (mw_) >> (4 * fq); const unsigned mlo = (unsigned)mq, mhi = (unsigned)(mq >> 32); \
            _Pragma("unroll") for (int kb = 0; kb < 4; ++kb) _Pragma("unroll") for (int r = 0; r < 4; ++r) { \
                const unsigned mk = (unsigned)__builtin_amdgcn_sbfe((int)(kb < 2 ? mlo : mhi), 16 * (kb & 1) + r, 1); \
                const float pv = __uint_as_float(__float_as_uint(fast_exp2(S[kb][r] - mrun)) & mk); S[kb][r] = pv; lsum += pv; } \
            _Pragma("unroll") for (int s2 = 0; s2 < 2; ++s2) { const u32x4 pk = pack8(S[2 * s2], S[2 * s2 + 1]); Pf[s2] = __builtin_bit_cast(bf16x8, pk); } } while (0)
#define ATT_VLOAD(dst, vb_, cb_) do { const int va_ = (vb_) + ((32 * (cb_)) ^ x2s); \
            dst[0] = __builtin_amdgcn_ds_read_tr16_b64_v4i16((LAS s16x4*)(L + va_)); dst[1] = __builtin_amdgcn_ds_read_tr16_b64_v4i16((LAS s16x4*)(L + va_ + 16 * 512)); \
            dst[2] = __builtin_amdgcn_ds_read_tr16_b64_v4i16((LAS s16x4*)(L + va_ + 32 * 512)); dst[3] = __builtin_amdgcn_ds_read_tr16_b64_v4i16((LAS s16x4*)(L + va_ + 48 * 512)); } while (0)
#define ATT_PV(buf_) do { const int vb_ = vbase + (buf_) * TB; s16x4 tv[2][4]; ATT_VLOAD(tv[0], vb_, 0); \
            _Pragma("unroll") for (int cb = 0; cb < 16; ++cb) { \
                if (cb + 1 < 16) ATT_VLOAD(tv[(cb + 1) & 1], vb_, cb + 1); \
                const s16x4 a0 = tv[cb & 1][0], a1 = tv[cb & 1][1], a2 = tv[cb & 1][2], a3 = tv[cb & 1][3]; \
                const bf16x8 v0 = (bf16x8){a0[0], a0[1], a0[2], a0[3], a1[0], a1[1], a1[2], a1[3]}; \
                const bf16x8 v1 = (bf16x8){a2[0], a2[1], a2[2], a2[3], a3[0], a3[1], a3[2], a3[3]}; \
                Ot[cb] = __builtin_amdgcn_mfma_f32_16x16x32_bf16(v0, Pf[0], Ot[cb], 0, 0, 0); \
                Ot[cb] = __builtin_amdgcn_mfma_f32_16x16x32_bf16(v1, Pf[1], Ot[cb], 0, 0, 0); __builtin_amdgcn_sched_barrier(0); } } while (0)
        ATT_DMA(0, 0);
        unsigned long long mwn = MASK[(rb + t0 + fr) * 32];
        asm volatile("s_waitcnt vmcnt(0)" ::: "memory");
        __syncthreads();
        int bufc = 0;
        for (int it = 0; it < ntiles; ++it) {
            const int bufn = (bufc == 2) ? 0 : bufc + 1;
            if (it + 1 < ntiles) ATT_DMA(it + 1, bufn);
            const unsigned long long mw = mwn; mwn = MASK[(rb + t0 + fr) * 32 + ((it + 1 < ntiles) ? it + 1 : it)];
            f32x4 S[4];
            ATT_ST(bufc); ATT_SOFTMAX(mw);
            if (grpB) { asm volatile("s_waitcnt vmcnt(0)" ::: "memory"); __builtin_amdgcn_s_barrier(); asm volatile("" ::: "memory"); }
            ATT_PV(bufc);
            if (!grpB) { asm volatile("s_waitcnt vmcnt(0)" ::: "memory"); __builtin_amdgcn_s_barrier(); asm volatile("" ::: "memory"); }
            bufc = bufn;
        }
        __syncthreads();
#undef ATT_DMA
#undef ATT_ST
#undef ATT_SOFTMAX
#undef ATT_VLOAD
#undef ATT_PV
        lsum += __shfl_xor(lsum, 16); lsum += __shfl_xor(lsum, 32);
        const float inv = 1.f / lsum;
#pragma unroll
        for (int cb = 0; cb < 16; ++cb) {
            if (OLAT8) { const float i8 = inv * F8_O; *(unsigned*)(OLAT8 + (rb + t0 + fr) * 2048 + w * 256 + 16 * cb + 4 * fq) = pack4_fp8(Ot[cb][0] * i8, Ot[cb][1] * i8, Ot[cb][2] * i8, Ot[cb][3] * i8); }
            else { u32x2 o; o.x = cvt_pk_bf16(Ot[cb][0] * inv, Ot[cb][1] * inv); o.y = cvt_pk_bf16(Ot[cb][2] * inv, Ot[cb][3] * inv);
                *(u32x2*)(OLAT + (rb + t0 + fr) * 2048 + w * 256 + 16 * cb + 4 * fq) = o; } }
    }
}

constexpr int PH_PER_PAIR = 18, N_PHASES = 1 + 2 * PH_PER_PAIR;

__global__ void __launch_bounds__(NTHREADS, 2) fwd_kernel(Params p) {
    extern __shared__ __attribute__((aligned(16))) unsigned char lds_raw[];
    Frame F;
    F.lds = (LAS unsigned char*)lds_raw;
    F.tid = threadIdx.x; F.lane = F.tid & 63; F.wave = __builtin_amdgcn_readfirstlane(F.tid >> 6);
    F.G = gridDim.x; F.c = blockIdx.x;
    unsigned char* ws = p.ws;
    F.ctl = (unsigned*)(ws + WS_CTL);
    for (int u = F.tid; u < (LDS_BYTES - LDSCTL_OFF) / 4; u += NTHREADS) ((LAS unsigned*)(F.lds + LDSCTL_OFF))[u] = 0u;
    __syncthreads();
    const bool one_launch = (p.ph_hi - p.ph_lo) > 1;
    XcdBarrier bar; bar.bar = F.ctl + CW_BAR; bar.x = 0; bar.st = nullptr;
    if (one_launch) bar = xcd_barrier_post(F.ctl + CW_BAR, (volatile LAS unsigned*)(F.lds + MISC_OFF) + 8);
    const int lo = p.ph_lo, hi = p.ph_hi;
#define REFRESH() do { int t_ = threadIdx.x; asm volatile("" : "+v"(t_)); F.tid = t_; F.lane = t_ & 63; F.wave = __builtin_amdgcn_readfirstlane(t_ >> 6); } while (0)
#ifndef DBLMASK
#define DBLMASK 0u
#endif
#define REP(b) for (int rep_ = 0; rep_ < 1 + (int)((DBLMASK >> (b)) & 1u); ++rep_)
#define IN(k) (lo <= (k) && (k) < hi)
#ifndef MK_BARTIME
#define MK_BARTIME 0
#endif
    unsigned long long bt_acc = 0ull;
#if MK_BARTIME
#define SEAM(k) do { if (IN(k) && IN((k) + 1)) { const unsigned long long t0_ = __builtin_amdgcn_s_memrealtime(); xcd_barrier(bar); bt_acc += __builtin_amdgcn_s_memrealtime() - t0_; } } while (0)
#else
#ifndef MK_DBLSEAM
#define MK_DBLSEAM 0
#endif
#define SEAM(k) do { if (IN(k) && IN((k) + 1)) { xcd_barrier(bar); if (MK_DBLSEAM) xcd_barrier(bar); } } while (0)
#endif

    bf16_t* XB = (bf16_t*)(ws + WS_XB); bf16_t* Y = (bf16_t*)(ws + WS_Y);
    unsigned char* A = ws + WS_A; bf16_t* Hb = (bf16_t*)(ws + WS_H);

    if (IN(0)) REP(31) { REFRESH(); p0_prologue(F, p); } SEAM(0);

    for (int j = 0; j < 2; ++j) {
        const int pb = 1 + j * PH_PER_PAIR;
        const int layerA = 2 * j, layerB = 2 * j + 1;
        if (IN(pb + 0)) REP(0) {
            Gemm g{XB, (const bf16_t*)(ws + WS_W_HGIN) + (size_t)j * 4 * D * D, D}; StaticOrder S; S.init(M, 4 * D, F.G, F.c);
            EpiHgIn E{(bf16_t*)(A + A_HQ)};
            gemm_phase(F.lds, g, S, E);
        } SEAM(pb + 0);
        if (IN(pb + 1)) REP(1) { REFRESH(); hgrn_phase(F, (const bf16_t*)(A + A_HQ), (const bf16_t*)(A + A_HF), (const bf16_t*)(A + A_HV), INP(IN_HGLB), j, (bf16_t*)(A + A_HO)); } SEAM(pb + 1);
        if (IN(pb + 2)) REP(2) { REFRESH(); hgrn_gate_phase(F, (const bf16_t*)(A + A_HO), (const bf16_t*)(A + A_HG), INP(IN_HGNG) + (size_t)j * D, (bf16_t*)(A + A_HOG)); } SEAM(pb + 2);
        if (IN(pb + 3)) REP(3) {
            Gemm g{(const bf16_t*)(A + A_HOG), (const bf16_t*)(ws + WS_W_HGOUT) + (size_t)j * D * D, D}; StaticOrder S; S.init(M, D, F.G, F.c);
            EpiRes E{XB, Y}; gemm_phase(F.lds, g, S, E);
        } SEAM(pb + 3);
        if (IN(pb + 4)) REP(4) { REFRESH(); ln_phase(F, Y, INP(IN_LNG) + (size_t)(layerA * 2 + 0) * D, INP(IN_LNB) + (size_t)(layerA * 2 + 0) * D, XB, (MK_FFN_FP8 == 2) ? ws + WS_XB8 : nullptr); } SEAM(pb + 4);
        if (IN(pb + 5)) REP(5) {
#if MK_FFN_FP8 == 2
            Gemm g{(const bf16_t*)(ws + WS_XB8), (const bf16_t*)(ws + WS_W_FGU + (size_t)j * 2 * DFF * D), D / 2, SC_UP}; StaticOrder S; S.init(M, 2 * DFF, F.G, F.c);
            EpiSwiglu8 E{(unsigned char*)Hb}; gemm_phase_gather<true, true>(F.lds, g, S, E, nullptr);
#elif MK_FFN_FP8 == 1
            Gemm g{XB, (const bf16_t*)(ws + WS_W_FGU) + (size_t)j * 2 * DFF * D, D}; StaticOrder S; S.init(M, 2 * DFF, F.G, F.c);
            EpiSwiglu8 E{(unsigned char*)Hb}; gemm_phase(F.lds, g, S, E);
#else
            Gemm g{XB, (const bf16_t*)(ws + WS_W_FGU) + (size_t)j * 2 * DFF * D, D}; StaticOrder S; S.init(M, 2 * DFF, F.G, F.c);
            EpiSwiglu E{Hb}; gemm_phase(F.lds, g, S, E);
#endif
        } SEAM(pb + 5);
        if (IN(pb + 6)) REP(6) {
#if MK_FFN_FP8 >= 1
            Gemm g{Hb, (const bf16_t*)(ws + WS_W_FDN + (size_t)j * D * DFF), DFF / 2, SC_DN}; StaticOrder S; S.init(M, D, F.G, F.c);
            EpiRes E{XB, Y}; gemm_phase_gather<true, true>(F.lds, g, S, E, nullptr);
#else
            Gemm g{Hb, (const bf16_t*)(ws + WS_W_FDN) + (size_t)j * D * DFF, DFF}; StaticOrder S; S.init(M, D, F.G, F.c);
            EpiRes E{XB, Y}; gemm_phase(F.lds, g, S, E);
#endif
        } SEAM(pb + 6);
        if (IN(pb + 7)) REP(7) { REFRESH(); ln_phase(F, Y, INP(IN_LNG) + (size_t)(layerA * 2 + 1) * D, INP(IN_LNB) + (size_t)(layerA * 2 + 1) * D, XB, nullptr); } SEAM(pb + 7);
        if (IN(pb + 8)) REP(8) {
            Gemm g{XB, (const bf16_t*)(ws + WS_W_DIN) + (size_t)j * DSA_IN_PAD * D, D}; StaticOrder S; S.init(M, DSA_IN_PAD, F.G, F.c);
            EpiBf16 E{(bf16_t*)(A + A_RAW), DSA_IN_PAD}; gemm_phase(F.lds, g, S, E);
        } SEAM(pb + 8);
        if (IN(pb + 9)) REP(9) { REFRESH(); dsa_norm_phase(F, (const bf16_t*)(A + A_RAW), INP(IN_DQNG) + (size_t)j * QR, INP(IN_DKVNG) + (size_t)j * KVR, INP(IN_DKIG) + (size_t)j * IDXD, INP(IN_DKIB) + (size_t)j * IDXD,
                                         (bf16_t*)(A + A_CQ), (bf16_t*)(A + A_CKV), (bf16_t*)(A + A_KIDX), (float*)(A + A_WIDX)); } SEAM(pb + 9);
        if (IN(pb + 10)) REP(10) {
            Gemm g{(const bf16_t*)(A + A_CQ), (const bf16_t*)(ws + WS_W_DQ) + (size_t)j * 2560 * QR, QR}; StaticOrder S; S.init(M, 2560, F.G, F.c);
            EpiQ E{(bf16_t*)(A + A_QLAT), (bf16_t*)(A + A_QIDX)}; gemm_phase(F.lds, g, S, E);
        } SEAM(pb + 10);
        if (IN(pb + 11)) REP(11) { REFRESH(); dsa_index_phase(F, (const bf16_t*)(A + A_QIDX), (const bf16_t*)(A + A_KIDX), (const float*)(A + A_WIDX), (unsigned long long*)(A + A_MASK)); } SEAM(pb + 11);
        if (IN(pb + 12)) REP(12) { REFRESH(); dsa_attn_phase(F, (const bf16_t*)(A + A_QLAT), (const bf16_t*)(A + A_CKV), (const unsigned long long*)(A + A_MASK), (bf16_t*)(A + A_OLAT), MK_B6_FP8 ? A + A_OLAT : nullptr); } SEAM(pb + 12);
        if (IN(pb + 13)) REP(13) {
#if MK_B6_FP8
            Gemm g{(const bf16_t*)(A + A_OLAT), (const bf16_t*)(ws + WS_W_DO + (size_t)j * D * 2048), 1024, SC_DO}; StaticOrder S; S.init(M, D, F.G, F.c);
            EpiRes E{XB, Y}; gemm_phase_gather<true, true>(F.lds, g, S, E, nullptr);
#else
            Gemm g{(const bf16_t*)(A + A_OLAT), (const bf16_t*)(ws + WS_W_DO) + (size_t)j * D * 2048, 2048}; StaticOrder S; S.init(M, D, F.G, F.c);
            EpiRes E{XB, Y}; gemm_phase(F.lds, g, S, E);
#endif
        } SEAM(pb + 13);
        if (IN(pb + 14)) REP(14) { REFRESH(); ln_router_phase(F, Y, INP(IN_LNG) + (size_t)(layerB * 2 + 0) * D, INP(IN_LNB) + (size_t)(layerB * 2 + 0) * D, INP(IN_MR) + (size_t)j * D * NEXP, XB, MK_MOE_FP8 ? ws + WS_XB8 : nullptr,
                                           (int*)(A + A_EIDX), (int*)(A + A_POS), (int*)(A + A_TOK), (float*)(A + A_GW), F.ctl + CW_MOE + 64 * j); } SEAM(pb + 14);
        if (IN(pb + 15)) REP(15) {
#if MK_MOE_FP8
            Gemm g{(const bf16_t*)(ws + WS_XB8), (const bf16_t*)(ws + WS_W_MGU8 + (size_t)j * NEXP * 2 * DFF * D), D / 2, SC_UP}; MoeOrder S; S.init(F.ctl + CW_MOE + 64 * j, 2 * DFF / BM, F.G, F.c);
            EpiSwiglu8 E{(unsigned char*)Hb}; gemm_phase_gather<true>(F.lds, g, S, E, (const int*)(A + A_TOK));
#else
            Gemm g{XB, (const bf16_t*)(ws + WS_W_MGU) + (size_t)j * NEXP * 2 * DFF * D, D}; MoeOrder S; S.init(F.ctl + CW_MOE + 64 * j, 2 * DFF / BM, F.G, F.c);
            EpiSwiglu E{Hb}; gemm_phase_gather(F.lds, g, S, E, (const int*)(A + A_TOK));
#endif
        } SEAM(pb + 15);
        if (IN(pb + 16)) REP(16) {
#if MK_MOE_FP8
            Gemm g{Hb, (const bf16_t*)(ws + WS_W_MDN8 + (size_t)j * NEXP * D * DFF), DFF / 2, SC_DN}; MoeOrder S; S.init(F.ctl + CW_MOE + 64 * j, D / BM, F.G, F.c);
            EpiMoeDn E{(bf16_t*)(A + A_OUTM), (const float*)(A + A_GW)}; gemm_phase_gather<true, true>(F.lds, g, S, E, nullptr);
#else
            Gemm g{Hb, (const bf16_t*)(ws + WS_W_MDN) + (size_t)j * NEXP * D * DFF, DFF}; MoeOrder S; S.init(F.ctl + CW_MOE + 64 * j, D / BM, F.G, F.c);
            EpiMoeDn E{(bf16_t*)(A + A_OUTM), (const float*)(A + A_GW)}; gemm_phase(F.lds, g, S, E);
#endif
        } SEAM(pb + 16);
        if (IN(pb + 17)) REP(17) { REFRESH(); ln_moe_phase(F, XB, (const bf16_t*)(A + A_OUTM), (const int*)(A + A_EIDX), (const int*)(A + A_POS), F.ctl + CW_MOE + 64 * j,
                                        INP(IN_LNG) + (size_t)(layerB * 2 + 1) * D, INP(IN_LNB) + (size_t)(layerB * 2 + 1) * D, XB, (j == 1) ? p.out : nullptr); } SEAM(pb + 17);
    }
#if MK_BARTIME
    if (one_launch) {
        if (blockIdx.x == 0 && threadIdx.x == 0) __hip_atomic_store(F.ctl + 3000, (unsigned)bt_acc, __ATOMIC_RELAXED, __HIP_MEMORY_SCOPE_AGENT);
        xcd_barrier(bar);
        const float cval = 2.0f + 4.0f * (float)__hip_atomic_load(F.ctl + 3000, __ATOMIC_RELAXED, __HIP_MEMORY_SCOPE_AGENT) * 1e-5f;
        for (size_t i = (size_t)blockIdx.x * NTHREADS + threadIdx.x; i < (size_t)M * D; i += (size_t)gridDim.x * NTHREADS) p.out[i] = cval;
    }
#endif
}


#if MK_DEBUG_SCAN
__global__ void scan_kernel(const void* ptr, size_t n, int is_bf16, unsigned code, unsigned* flag, const unsigned* gcnt, size_t row_elems) {
    size_t nn = n;
    if (gcnt) { unsigned t = 0; for (int e = 0; e < 8; ++e) t += (gcnt[e] + 255u) >> 8; nn = (size_t)t * 256 * row_elems; }
    bool bad = false;
    for (size_t i = (size_t)blockIdx.x * blockDim.x + threadIdx.x; i < nn; i += (size_t)gridDim.x * blockDim.x) {
        if (is_bf16) { const unsigned short v = ((const unsigned short*)ptr)[i]; bad |= (v & 0x7f80u) == 0x7f80u; }
        else { const unsigned v = ((const unsigned*)ptr)[i]; bad |= (v & 0x7f800000u) == 0x7f800000u; }
    }
    if (bad) atomicMin(flag, code);
}
__global__ void fin_kernel(float* out, size_t n, const unsigned* flag) {
    const unsigned f = *flag; if (f == 0xffffffffu) return;
    const float cval = (float)f + 0.25f * (float)flag[64];
    for (size_t i = (size_t)blockIdx.x * blockDim.x + threadIdx.x; i < n; i += (size_t)gridDim.x * blockDim.x) out[i] = cval;
}

__global__ void chk_a1_kernel(const float* x, const float* w, const bf16_t* Q, const float* FP, unsigned code, unsigned* flag) {
    const unsigned id = blockIdx.x * blockDim.x + threadIdx.x;
    unsigned hsh = id * 2654435761u + 12345u; hsh ^= hsh >> 13; hsh *= 0x5bd1e995u; hsh ^= hsh >> 15;
    const int row = hsh % M, col = (hsh >> 15) % (4 * D);
    float ref = 0.f; for (int k = 0; k < D; ++k) ref += x[(size_t)row * D + k] * w[(size_t)k * 4 * D + col];
    const int part = col >> 10, cc = col & 1023;
    float got;
    if (part == 1) got = FP[(size_t)row * D + cc];
    else got = bf2f(Q[(size_t)(part == 0 ? 0 : part - 1) * M * D + (size_t)row * D + cc]);
    if (!(fabsf(got - ref) < 0.08f)) atomicMin(flag, code);
}
__global__ void chk_hgrn_kernel(const bf16_t* Q, const float* FP, const bf16_t* V, const bf16_t* O, unsigned* bits) {
    const int sample = blockIdx.x, lane = threadIdx.x;
    const int b = sample % BATCH, h = (sample / BATCH) % HG_H, e = (sample * 37 + 11) % 128;
    float s0 = 0.f, s1 = 0.f; unsigned r = 0;
    for (int t = 0; t < 128; ++t) {
        const size_t base = ((size_t)b * SEQ + t) * D + h * 128;
        const float f0 = sigmoidf_(FP[base + lane]), f1 = sigmoidf_(FP[base + lane + 64]);
        const float v = bf2f(V[base + e]);
        s0 = f0 * s0 + (1.f - f0) * v; s1 = f1 * s1 + (1.f - f1) * v;
        const float o = wave_sum(bf2f(Q[base + lane]) * s0 + bf2f(Q[base + lane + 64]) * s1);
        const unsigned short gb = O[base + e]; const float got = bf2f(gb);
        const bool nf = (gb & 0x7f80u) == 0x7f80u;
        if (t < 64) { if (nf) r |= 4u; else if (!(fabsf(got - o) < 0.05f + 0.03f * fabsf(o))) r |= 2u; }
        else if (nf) r |= 1u;
    }
    if (r && lane == 0) atomicOr(bits, r);
}
__global__ void flaginit_kernel(unsigned* flag) { *flag = 0xffffffffu; }
#endif

extern "C" void kernel_launch(void* const* d_in, const int* in_sizes, int n_in, void* d_out, int out_size, void* d_ws, size_t ws_size, hipStream_t stream) {
    static int grid = 0;
    if (grid == 0) {
        if (n_in != 22 || out_size != M * D || ws_size < WS_END) { fprintf(stderr, "kernel_launch: unexpected problem (n_in %d out %d ws %zu need %zu)\n", n_in, out_size, ws_size, (size_t)WS_END); grid = -1; return; }
        int dev = 0, cus = 0, per_cu = 0;
        if (hipGetDevice(&dev) != hipSuccess || hipDeviceGetAttribute(&cus, hipDeviceAttributeMultiprocessorCount, dev) != hipSuccess) { grid = -1; return; }
        if (hipFuncSetAttribute((const void*)fwd_kernel, hipFuncAttributeMaxDynamicSharedMemorySize, LDS_BYTES) != hipSuccess) { fprintf(stderr, "kernel_launch: hipFuncSetAttribute failed\n"); grid = -1; return; }
        if (hipOccupancyMaxActiveBlocksPerMultiprocessor(&per_cu, (const void*)fwd_kernel, NTHREADS, LDS_BYTES) != hipSuccess || per_cu < 1) fprintf(stderr, "kernel_launch: occupancy query reports %d\n", per_cu);
        grid = cus;
    }
    if (grid <= 0) return;
    (void)hipMemsetAsync((char*)d_ws + WS_CTL, 0, CTL_ZERO_BYTES, stream);
    Params p{};
    for (int i = 0; i < 22; ++i) p.in[i] = (const float*)d_in[i];
    p.out = (float*)d_out; p.ws = (unsigned char*)d_ws;
#if MK_N_LAUNCHES == 1
    p.ph_lo = 0; p.ph_hi = N_PHASES;
    hipLaunchKernelGGL(fwd_kernel, dim3(grid), dim3(NTHREADS), LDS_BYTES, stream, p);
#ifdef MK_EXTRA_PHASES
    { const int extra[] = {MK_EXTRA_PHASES}; for (int r = 0; r < MK_EXTRA_REPS; ++r) for (int k : extra) { p.ph_lo = k; p.ph_hi = k + 1; hipLaunchKernelGGL(fwd_kernel, dim3(grid), dim3(NTHREADS), LDS_BYTES, stream, p); } }
#endif
#else
#if MK_DEBUG_SCAN
    unsigned char* ws = (unsigned char*)d_ws; unsigned* flag = (unsigned*)(ws + WS_CTL) + 2048;
    hipLaunchKernelGGL(flaginit_kernel, dim3(1), dim3(1), 0, stream, flag);
#define SCAN(ptr, n, isbf, k) hipLaunchKernelGGL(scan_kernel, dim3(1024), dim3(256), 0, stream, (const void*)(ptr), (size_t)(n), isbf, (unsigned)((k) + 1), flag, (const unsigned*)nullptr, (size_t)0)
#define SCANM(ptr, re, isbf, k, jj) hipLaunchKernelGGL(scan_kernel, dim3(1024), dim3(256), 0, stream, (const void*)(ptr), (size_t)0, isbf, (unsigned)((k) + 1), flag, (const unsigned*)(ws + WS_CTL) + CW_MOE + 64 * (jj), (size_t)(re))
#endif
    for (int k = 0; k < N_PHASES; ++k) { p.ph_lo = k; p.ph_hi = k + 1; hipLaunchKernelGGL(fwd_kernel, dim3(grid), dim3(NTHREADS), LDS_BYTES, stream, p);
#if MK_DEBUG_SCAN
        unsigned char* A = ws + WS_A; const size_t MD = (size_t)M * D;
        if (k == 0) { SCAN(ws + WS_W_HGIN, 2 * 4 * MD / M * D, 1, k); SCAN(ws + WS_W_HGOUT, 2 * (size_t)D * D, 1, k); SCAN(ws + WS_W_FGU, 2 * (size_t)2 * DFF * D, 1, k); SCAN(ws + WS_W_FDN, 2 * (size_t)DFF * D, 1, k);
            SCAN(ws + WS_W_DIN, 2 * (size_t)DSA_IN_PAD * D, 1, k); SCAN(ws + WS_W_DQ, 2 * (size_t)2560 * QR, 1, k); SCAN(ws + WS_W_DO, 2 * (size_t)D * 2048, 1, k);
            SCAN(ws + WS_W_MGU, 16 * (size_t)2 * DFF * D, 1, k); SCAN(ws + WS_W_MDN, 16 * (size_t)DFF * D, 1, k); SCAN(ws + WS_XB, MD, 1, k); }
        else { const int l = (k - 1) % PH_PER_PAIR, jj = (k - 1) / PH_PER_PAIR;
            switch (l) {
            case 0: SCAN(A + A_HQ, 3 * MD, 1, k); SCAN(A + A_HF, MD, 0, k);
                if (jj == 0) hipLaunchKernelGGL(chk_a1_kernel, dim3(64), dim3(256), 0, stream, (const float*)d_in[IN_X], (const float*)d_in[IN_HGWIN], (const bf16_t*)(A + A_HQ), (const float*)(A + A_HF), (unsigned)(k + 1), flag);
                break;
            case 1: SCAN(A + A_HO, MD, 1, k);
                if (jj == 0) hipLaunchKernelGGL(chk_hgrn_kernel, dim3(256), dim3(64), 0, stream, (const bf16_t*)(A + A_HQ), (const float*)(A + A_HF), (const bf16_t*)(A + A_HV), (const bf16_t*)(A + A_HO), flag + 64);
                break;
            case 2: SCAN(A + A_HOG, MD, 1, k); break;
            case 3: case 6: case 13: SCAN(ws + WS_Y, MD, 1, k); break;
            case 4: case 7: case 14: SCAN(ws + WS_XB, MD, 1, k); break;
            case 5: SCAN(ws + WS_H, (size_t)M * DFF, 1, k); break;
            case 8: SCAN(A + A_RAW, (size_t)M * DSA_IN_PAD, 0, k); break;
            case 9: SCAN(A + A_CQ, (size_t)M * 256, 1, k); SCAN(A + A_CKV, (size_t)M * 256, 1, k); SCAN(A + A_KIDX, (size_t)M * 64, 1, k); SCAN(A + A_WIDX, (size_t)M * 8, 0, k); break;
            case 10: SCAN(A + A_QLAT, (size_t)M * 2048, 1, k); SCAN(A + A_QIDX, (size_t)M * 512, 1, k); break;
            case 12: SCAN(A + A_OLAT, (size_t)M * 2048, 1, k); break;
            case 16: SCANM(ws + WS_H, DFF, 1, k, jj); break;
            case 17: SCANM(A + A_OUTM, D, 0, k, jj); break;
            case 18: if (jj == 0) SCAN(ws + WS_XB, MD, 1, k); else SCAN(d_out, MD, 0, k); break;
            default: break; } }
#endif
    }
#if MK_DEBUG_SCAN
    hipLaunchKernelGGL(fin_kernel, dim3(1024), dim3(256), 0, stream, (float*)d_out, (size_t)M * D, (const unsigned*)flag);
#endif
#endif
}
```

```cpp
#include <hip/hip_runtime.h>
#include <cstdio>
#include <cstdint>

#ifndef MK_DEBUG_SCAN
#define MK_DEBUG_SCAN 0
#endif
#ifndef MK_MOE_FP8
#define MK_MOE_FP8 1
#endif
#ifndef MK_FFN_FP8
#define MK_FFN_FP8 2
#endif
#ifndef MK_B6_FP8
#define MK_B6_FP8 1
#endif
#ifndef MK_N_LAUNCHES
#define MK_N_LAUNCHES 1
#endif

#define GAS __attribute__((address_space(1)))
#define LAS __attribute__((address_space(3)))
typedef unsigned short bf16_t;
typedef short bf16x8 __attribute__((ext_vector_type(8)));
typedef short s16x4 __attribute__((ext_vector_type(4)));
typedef float f32x4 __attribute__((ext_vector_type(4)));
typedef float f32x2 __attribute__((ext_vector_type(2)));
typedef unsigned u32x4 __attribute__((ext_vector_type(4)));
typedef unsigned u32x2 __attribute__((ext_vector_type(2)));
typedef int v8i32 __attribute__((ext_vector_type(8)));
typedef int v4i32 __attribute__((ext_vector_type(4)));

constexpr int D = 1024, BATCH = 16, SEQ = 2048, M = BATCH * SEQ;
constexpr int DFF = 3584, NEXP = 8;
constexpr int HG_H = 8, HG_DK = 128, HG_C = 64;
constexpr int QR = 256, KVR = 256, IDXD = 64, IDXH = 8, DSA_H = 8, DSA_HD = 128, TOPK = 256;
constexpr int DSA_IN = 584, DSA_IN_PAD = 768;
constexpr int MOE_ROWS = 2 * M + NEXP * 256;
constexpr float ALPHA = 1.6817928305074290f;
constexpr float LN_EPS = 1e-5f, RMS_EPS = 1e-6f;
constexpr int NWAVES = 8, NTHREADS = 512;

constexpr size_t MiB = 1u << 20;
constexpr size_t WS_CTL = 0, CTL_ZERO_BYTES = 1 * MiB;
constexpr size_t WS_W_HGIN = 1 * MiB;
constexpr size_t WS_W_HGOUT = 17 * MiB;
constexpr size_t WS_W_FGU = 21 * MiB;
constexpr size_t WS_W_FDN = 49 * MiB;
constexpr size_t WS_W_DIN = 63 * MiB;
constexpr size_t WS_W_DQ = 66 * MiB;
constexpr size_t WS_W_DO = 69 * MiB;
constexpr size_t WS_W_MGU = 77 * MiB;
constexpr size_t WS_W_MDN = 301 * MiB;
constexpr size_t WS_XB8 = 416 * MiB;
constexpr size_t WS_W_MGU8 = 77 * MiB;
constexpr size_t WS_W_MDN8 = 192 * MiB;
constexpr size_t WS_XB = 544 * MiB;
constexpr size_t WS_Y = 608 * MiB;
constexpr size_t WS_A = 736 * MiB;
constexpr size_t WS_H = 1184 * MiB;
constexpr size_t WS_END = 1648 * MiB;
constexpr size_t A_HQ = 0, A_HF = 64 * MiB, A_HV = 128 * MiB, A_HG = 192 * MiB, A_HO = 320 * MiB, A_HOG = 384 * MiB;
constexpr size_t A_RAW = 0, A_CQ = 96 * MiB, A_CKV = 112 * MiB, A_KIDX = 128 * MiB, A_WIDX = 132 * MiB, A_MASK = 136 * MiB, A_QLAT = 144 * MiB, A_QIDX = 272 * MiB, A_OLAT = 304 * MiB;
constexpr size_t A_OUTM = 136 * MiB, A_EIDX = 404 * MiB, A_POS = 405 * MiB, A_TOK = 406 * MiB, A_GW = 407 * MiB;
constexpr int CW_BAR = 4096, CW_MOE = 16384;

constexpr int RING_BYTES = 131072;
constexpr int LDSCTL_OFF = RING_BYTES, MISC_OFF = LDSCTL_OFF + 320;
constexpr int STAGE_TOKL = RING_BYTES + 2048;
constexpr int LDS_BYTES = 147456;

typedef __bf16 hwbf16x2 __attribute__((ext_vector_type(2)));
__device__ __forceinline__ unsigned cvt_pk_bf16(float lo, float hi) { const f32x2 v = {lo, hi}; const hwbf16x2 b = __builtin_convertvector(v, hwbf16x2); return __builtin_bit_cast(unsigned, b); }
__device__ __forceinline__ bf16_t f2bf(float f) { return (bf16_t)(cvt_pk_bf16(f, 0.f) & 0xffffu); }
__device__ __forceinline__ float bf2f(bf16_t b) { return __uint_as_float(((unsigned)b) << 16); }
__device__ __forceinline__ float wave_sum(float v) {
    v += __builtin_bit_cast(float, __builtin_amdgcn_update_dpp(0, __builtin_bit_cast(int, v), 0xB1, 0xF, 0xF, true));
    v += __builtin_bit_cast(float, __builtin_amdgcn_update_dpp(0, __builtin_bit_cast(int, v), 0x4E, 0xF, 0xF, true));
    v += __builtin_bit_cast(float, __builtin_amdgcn_update_dpp(0, __builtin_bit_cast(int, v), 0x141, 0xF, 0xF, true));
    v += __builtin_bit_cast(float, __builtin_amdgcn_update_dpp(0, __builtin_bit_cast(int, v), 0x140, 0xF, 0xF, true));
    const float r0 = __builtin_bit_cast(float, __builtin_amdgcn_readlane(__builtin_bit_cast(int, v), 0)), r1 = __builtin_bit_cast(float, __builtin_amdgcn_readlane(__builtin_bit_cast(int, v), 16));
    const float r2 = __builtin_bit_cast(float, __builtin_amdgcn_readlane(__builtin_bit_cast(int, v), 32)), r3 = __builtin_bit_cast(float, __builtin_amdgcn_readlane(__builtin_bit_cast(int, v), 48));
    return (r0 + r1) + (r2 + r3);
}
__device__ __forceinline__ float fast_exp2(float x) { return __builtin_amdgcn_exp2f(x); }
__device__ __forceinline__ float fast_rcp(float x) { return __builtin_amdgcn_rcpf(x); }
__device__ __forceinline__ float sigmoidf_(float x) { return fast_rcp(1.0f + __expf(-x)); }
__device__ __forceinline__ float siluf_(float x) { return x * sigmoidf_(x); }
#define LDS_WAIT() asm volatile("s_waitcnt lgkmcnt(0)" ::: "memory")
#define VM_WAIT() asm volatile("s_waitcnt vmcnt(0)" ::: "memory")

#define XB_TMO      128
#define XB_XCNT(j)  (256  + 64 * (j))
#define XB_XSUB(j)  (1280 + 64 * (j))
#define XB_XGEN(j)  (2304 + 64 * (j))
#define XB_TOP      3328
#define XB_TOPGEN   3392
#define XCD_BAR_WORDS 3456
#define XB_SPIN_CAP (1u << 20)

__device__ __forceinline__ unsigned xb_ld(unsigned* p)              { return __hip_atomic_load(p, __ATOMIC_RELAXED, __HIP_MEMORY_SCOPE_AGENT); }
__device__ __forceinline__ unsigned xb_add(unsigned* p, unsigned v) { return __hip_atomic_fetch_add(p, v, __ATOMIC_RELAXED, __HIP_MEMORY_SCOPE_AGENT); }
__device__ __forceinline__ unsigned xb_xcc_id() { return (unsigned)__builtin_amdgcn_s_getreg((3 << 11) | 20) & 0xFu; }
#define XB_SPIN(cond, bar) do { unsigned _sp = 0; while (cond) { __builtin_amdgcn_s_sleep(1); \
    if ((++_sp & 255u) == 0u) { if (xb_ld(&(bar)[XB_TMO])) break; if (_sp > XB_SPIN_CAP) { atomicAdd(&(bar)[XB_TMO], 1u); break; } } } } while (0)

struct XcdBarrier { unsigned* bar; unsigned x; volatile LAS unsigned* st; };

__device__ __forceinline__ XcdBarrier xcd_barrier_post(unsigned* bar, volatile LAS unsigned* st) {
    XcdBarrier b; b.bar = bar; b.x = xb_xcc_id(); b.st = st;
    if (threadIdx.x == 0) (void)xb_add(&bar[XB_XCNT(b.x)], 1u);
    return b;
}
__device__ __forceinline__ void xcd_barrier_complete(unsigned* bar, unsigned x, unsigned& nloc, unsigned& nx) {
    const unsigned G = gridDim.x * gridDim.y * gridDim.z;
    unsigned sum, cnt, mine, sp = 0u;
    for (;;) {
        sum = 0u; cnt = 0u; mine = 0u;
#pragma unroll
        for (unsigned j = 0; j < 16; ++j) { const unsigned c = xb_ld(&bar[XB_XCNT(j)]); sum += c; cnt += (c > 0u) ? 1u : 0u; mine = (j == x) ? c : mine; }
        if (sum == G) break;
        __builtin_amdgcn_s_sleep(1);
        if ((++sp & 255u) == 0u) { if (xb_ld(&bar[XB_TMO])) break; if (sp > XB_SPIN_CAP) { atomicAdd(&bar[XB_TMO], 1u); break; } }
    }
    nloc = mine > 0u ? mine : 1u; nx = cnt > 0u ? cnt : 1u;
}
__device__ __forceinline__ void xcd_barrier(const XcdBarrier& b) {
    asm volatile("s_waitcnt vmcnt(0)" ::: "memory");
    __syncthreads();
    if (threadIdx.x == 0) {
        unsigned* bar = b.bar;
        __builtin_amdgcn_s_waitcnt(0);
        unsigned nloc = b.st[0], nx = b.st[1];
        if (nloc == 0u) { xcd_barrier_complete(bar, b.x, nloc, nx); b.st[0] = nloc; b.st[1] = nx; }
        const unsigned old = xb_add(&bar[XB_XSUB(b.x)], 1u);
        const unsigned gen = old / nloc;
        if (old + 1u == (gen + 1u) * nloc) {
            __builtin_amdgcn_fence(__ATOMIC_RELEASE, "agent");
            asm volatile("s_waitcnt vmcnt(0)" ::: "memory");
            const unsigned og = xb_add(&bar[XB_TOP], 1u);
            const unsigned tg = og / nx;
            if (og + 1u == (tg + 1u) * nx) xb_add(&bar[XB_TOPGEN], 1u);
            else XB_SPIN(xb_ld(&bar[XB_TOPGEN]) == tg, bar);
            __builtin_amdgcn_fence(__ATOMIC_ACQUIRE, "agent");
            xb_add(&bar[XB_XGEN(b.x)], 1u);
            asm volatile("s_waitcnt vmcnt(0)" ::: "memory");
        } else {
            XB_SPIN(xb_ld(&bar[XB_XGEN(b.x)]) == gen, bar);
            __builtin_amdgcn_fence(__ATOMIC_ACQUIRE, "agent");
            asm volatile("s_waitcnt vmcnt(0)" ::: "memory");
        }
    }
    __syncthreads();
}

constexpr int BM = 256, BK = 64, HALF = 128, HTB = HALF * BK * 2, NXCD = 8, WGM = 8;
__device__ __forceinline__ int lds_byte(int r, int c) { const int st = (r >> 4) * 2 + (c >> 5), rr = r & 15, cc = c & 31, ob = rr * 64 + cc * 2; return st * 1024 + (ob ^ (((ob >> 9) & 1) << 5)); }
__device__ __forceinline__ void stage_rc(int b, int& R, int& C) { const int st = b / 1024, sb = b % 1024, swz = sb ^ (((sb >> 9) & 1) << 5); R = (st >> 1) * 16 + swz / 64; C = (st & 1) * 32 + (swz % 64) / 2; }
__device__ __forceinline__ int perm32(int rho) { const int n = rho >> 4, i = rho & 15; return 8 * (i >> 2) + 4 * n + (i & 3); }

struct Unit { int pm, pn, pb, lt, cnt, e; };
struct Gemm { const bf16_t* A; const bf16_t* Bt; int K; int sc = 0x7f7f7f7f; };

__device__ __forceinline__ void tile_map(int L, int nM, int nN, int& pm, int& pn) {
    const int nwg = nM * nN;
    int wgid = L; { const int q = nwg / NXCD, r = nwg % NXCD, xcd = wgid % NXCD, off = wgid / NXCD; wgid = (xcd < r ? xcd * (q + 1) : r * (q + 1) + (xcd - r) * q) + off; }
    const int nig = WGM * nN, gid = wgid / nig, fm = gid * WGM, gsz = (nM - fm) < WGM ? (nM - fm) : WGM;
    pm = fm + ((wgid % nig) % gsz); pn = (wgid % nig) / gsz;
}
struct StaticOrder {
    int nM, nN, nwg, G, c;
    __device__ __forceinline__ void init(int M_, int N_, int G_, int c_) { nM = M_ / BM; nN = N_ / BM; nwg = nM * nN; G = G_; c = c_; }
    __device__ __forceinline__ bool next(int i, Unit& u) const {
        const long L = (long)i * G + c; if (L >= nwg) return false;
        tile_map((int)L, nM, nN, u.pm, u.pn); u.pb = u.pn; u.lt = 0; u.cnt = 0; u.e = 0; return true;
    }
};
struct MoeOrder {
    int t1, t2, t3, t4, t5, t6, t7, nM, nN, nwg, G, c; const unsigned* cntp;
    __device__ __forceinline__ void init(const unsigned* cnt, int nN_, int G_, int c_) {
        int t = 0, o[9];
#pragma unroll
        for (int e = 0; e < 8; ++e) { o[e] = t; const int ce = __builtin_amdgcn_readfirstlane((int)__hip_atomic_load(cnt + e, __ATOMIC_RELAXED, __HIP_MEMORY_SCOPE_AGENT)); t += (ce + 255) >> 8; }
        o[8] = t; t1 = o[1]; t2 = o[2]; t3 = o[3]; t4 = o[4]; t5 = o[5]; t6 = o[6]; t7 = o[7];
        nM = t; nN = nN_; nwg = nM * nN; G = G_; c = c_; cntp = cnt;
    }
    __device__ __forceinline__ bool next(int i, Unit& u) const {
        const long L = (long)i * G + c; if (L >= nwg) return false;
        tile_map((int)L, nM, nN, u.pm, u.pn);
        const int e = (u.pm >= t1) + (u.pm >= t2) + (u.pm >= t3) + (u.pm >= t4) + (u.pm >= t5) + (u.pm >= t6) + (u.pm >= t7);
        const int tb = e == 0 ? 0 : e == 1 ? t1 : e == 2 ? t2 : e == 3 ? t3 : e == 4 ? t4 : e == 5 ? t5 : e == 6 ? t6 : t7;
        u.cnt = __builtin_amdgcn_readfirstlane((int)__hip_atomic_load(cntp + e, __ATOMIC_RELAXED, __HIP_MEMORY_SCOPE_AGENT));
        u.lt = u.pm - tb; u.e = e; u.pb = e * nN + u.pn; return true;
    }
};

typedef f32x4 Acc[2][2][4][2];

template <bool F8 = false, class Epi, class Sched>
__device__ __forceinline__ void gemm_phase(LAS unsigned char* lds, const Gemm g, const Sched& S, const Epi& E) {
    int tid_ = threadIdx.x; asm volatile("" : "+v"(tid_));
    const int tid = tid_, wid = __builtin_amdgcn_readfirstlane(tid >> 6), lane = tid & 63, wr = wid >> 2, wc = wid & 3, fr = lane & 15, fq = lane >> 4;
    const int K = g.K, nt = K / BK;
    unsigned voffA[2], voffB[2];
#pragma unroll
    for (int i = 0; i < 2; ++i) { int R, C; stage_rc(tid * 16 + i * 8192, R, C); const int Rb = (R & ~31) + perm32(R & 31);
        voffA[i] = (unsigned)(R * K + C) * 2u; voffB[i] = (unsigned)(Rb * K + C) * 2u; }
    const size_t kstep = (size_t)(BK * 2);
    const size_t hstep = (size_t)HALF * K * 2;
    const size_t tstep = 2 * hstep;
    const unsigned ldsw = (unsigned)wid * 1024u;
    const int aoff = lds_byte(wr * 64 + fr, fq * 8), boff = lds_byte(wc * 32 + fr, fq * 8);
#define PG8_SA(b, h) (((b) * 2 + (h)) * HTB)
#define PG8_SB(b, h) ((4 + (b) * 2 + (h)) * HTB)
#define PG8_STAGE(bufoff, gbase, voff) do { _Pragma("unroll") for (int _i = 0; _i < 2; ++_i) \
        __builtin_amdgcn_global_load_lds((const unsigned*)((const char*)(gbase) + (voff)[_i]), (LAS unsigned*)(lds + (bufoff) + ldsw + _i * 8192), 16, 0, 0); } while (0)
#define PG8_LDA(dst, b, h) do { _Pragma("unroll") for (int m = 0; m < 4; ++m) _Pragma("unroll") for (int k = 0; k < 2; ++k) dst[m][k] = *(const LAS bf16x8*)(lds + PG8_SA(b, h) + aoff + m * 2048 + k * 1024); } while (0)
#define PG8_LDB(dst, b, h) do { _Pragma("unroll") for (int n = 0; n < 2; ++n) _Pragma("unroll") for (int k = 0; k < 2; ++k) dst[n][k] = *(const LAS bf16x8*)(lds + PG8_SB(b, h) + boff + n * 2048 + k * 1024); } while (0)
#define PG8_MMA(ai, bj, At, Bt) do { __builtin_amdgcn_s_setprio(1); \
        if constexpr (F8) {        \
            _Pragma("unroll") for (int m = 0; m < 4; ++m) _Pragma("unroll") for (int n = 0; n < 2; ++n) { \
                const v8i32 bv_ = __builtin_shufflevector(__builtin_bit_cast(v4i32, Bt[n][0]), __builtin_bit_cast(v4i32, Bt[n][1]), 0, 1, 2, 3, 4, 5, 6, 7); \
                const v8i32 av_ = __builtin_shufflevector(__builtin_bit_cast(v4i32, At[m][0]), __builtin_bit_cast(v4i32, At[m][1]), 0, 1, 2, 3, 4, 5, 6, 7); \
                acc[ai][bj][m][n] = __builtin_amdgcn_mfma_scale_f32_16x16x128_f8f6f4(bv_, av_, acc[ai][bj][m][n], 0, 0, 0, g.sc, 0, 0x7f7f7f7f); } \
        } else { \
            _Pragma("unroll") for (int m = 0; m < 4; ++m) _Pragma("unroll") for (int n = 0; n < 2; ++n) _Pragma("unroll") for (int k = 0; k < 2; ++k) \
                acc[ai][bj][m][n] = __builtin_amdgcn_mfma_f32_16x16x32_bf16(Bt[n][k], At[m][k], acc[ai][bj][m][n], 0, 0, 0); } \
        __builtin_amdgcn_s_setprio(0); } while (0)
#define PG8_WAIT_V(n) asm volatile("s_waitcnt vmcnt(" #n ")" ::: "memory")
#define PG8_WAIT_L(n) asm volatile("s_waitcnt lgkmcnt(" #n ")" ::: "memory")
#define PG8_BAR __builtin_amdgcn_s_barrier()
#define PG8_SCHED __builtin_amdgcn_sched_barrier(0)
    Unit cur, nxt; int ui = 0;
    if (!S.next(0, cur)) return;
    Acc acc;
#pragma unroll
    for (int a = 0; a < 2; ++a)
#pragma unroll
        for (int b = 0; b < 2; ++b)
#pragma unroll
            for (int m = 0; m < 4; ++m)
#pragma unroll
                for (int n = 0; n < 2; ++n) acc[a][b][m][n] = (f32x4){0.f, 0.f, 0.f, 0.f};
    bf16x8 At[4][2], B0[2][2], B1[2][2];
    const char* cA = (const char*)g.A + (size_t)cur.pm * tstep; const char* cB = (const char*)g.Bt + (size_t)cur.pb * tstep;
    PG8_STAGE(PG8_SB(0, 0), cB, voffB); PG8_STAGE(PG8_SA(0, 0), cA, voffA); PG8_STAGE(PG8_SB(0, 1), cB + hstep, voffB); PG8_STAGE(PG8_SA(0, 1), cA + hstep, voffA);
    if (wr == 1) PG8_BAR;
    PG8_WAIT_V(4); PG8_BAR;
    PG8_STAGE(PG8_SB(1, 0), cB + kstep, voffB); PG8_STAGE(PG8_SA(1, 0), cA + kstep, voffA); PG8_STAGE(PG8_SB(1, 1), cB + hstep + kstep, voffB);
    PG8_WAIT_V(6); PG8_BAR;
    for (;;) {
        const bool has_next = S.next(ui + 1, nxt);
        const char* nA = has_next ? (const char*)g.A + (size_t)nxt.pm * tstep : cA; const char* nB = has_next ? (const char*)g.Bt + (size_t)nxt.pb * tstep : cB;
#pragma nounroll
        for (int t = 0; t < nt; t += 2) {
            const bool last = (t == nt - 2);
            const char* a1 = cA + (size_t)(t + 1) * kstep;
            const char* a2 = last ? nA : cA + (size_t)(t + 2) * kstep; const char* b2 = last ? nB : cB + (size_t)(t + 2) * kstep;
            const char* a3 = a2 + kstep; const char* b3 = b2 + kstep;
            PG8_LDB(B0, 0, 0); PG8_SCHED; PG8_LDA(At, 0, 0); PG8_STAGE(PG8_SA(1, 1), a1 + hstep, voffA);
            PG8_WAIT_L(8); PG8_BAR; PG8_WAIT_L(0); PG8_MMA(0, 0, At, B0); PG8_BAR; PG8_SCHED;
            PG8_LDB(B1, 0, 1); PG8_STAGE(PG8_SB(0, 0), b2, voffB);
            PG8_BAR; PG8_WAIT_L(0); PG8_MMA(0, 1, At, B1); PG8_BAR;
            PG8_LDA(At, 0, 1); PG8_STAGE(PG8_SA(0, 0), a2, voffA);
            PG8_BAR; PG8_WAIT_L(0); PG8_MMA(1, 0, At, B0); PG8_BAR; PG8_SCHED;
            PG8_STAGE(PG8_SB(0, 1), b2 + hstep, voffB);
            PG8_WAIT_V(6); PG8_BAR; PG8_MMA(1, 1, At, B1); PG8_BAR;
            PG8_LDB(B0, 1, 0); PG8_SCHED; PG8_LDA(At, 1, 0); PG8_STAGE(PG8_SA(0, 1), a2 + hstep, voffA);
            PG8_WAIT_L(8); PG8_BAR; PG8_WAIT_L(0); PG8_MMA(0, 0, At, B0); PG8_BAR; PG8_SCHED;
            PG8_LDB(B1, 1, 1); PG8_STAGE(PG8_SB(1, 0), b3, voffB);
            PG8_BAR; PG8_WAIT_L(0); PG8_MMA(0, 1, At, B1); PG8_BAR;
            PG8_LDA(At, 1, 1); PG8_STAGE(PG8_SA(1, 0), a3, voffA);
            PG8_BAR; PG8_WAIT_L(0); PG8_MMA(1, 0, At, B0); PG8_BAR; PG8_SCHED;
            PG8_STAGE(PG8_SB(1, 1), b3 + hstep, voffB);
            PG8_WAIT_V(6); PG8_BAR; PG8_MMA(1, 1, At, B1); PG8_BAR;
        }
        E(acc, cur, wr, wc, fr, fq);
        if (!has_next) break;
#pragma unroll
        for (int a = 0; a < 2; ++a)
#pragma unroll
            for (int b = 0; b < 2; ++b)
#pragma unroll
                for (int m = 0; m < 4; ++m)
#pragma unroll
                    for (int n = 0; n < 2; ++n) acc[a][b][m][n] = (f32x4){0.f, 0.f, 0.f, 0.f};
        cur = nxt; cA = nA; cB = nB; ++ui;
    }
    PG8_WAIT_V(0);
    if (wr == 0) PG8_BAR;
    PG8_BAR;
#undef PG8_SA
#undef PG8_SB
#undef PG8_STAGE
#undef PG8_LDA
#undef PG8_LDB
#undef PG8_MMA
#undef PG8_WAIT_V
#undef PG8_WAIT_L
#undef PG8_BAR
#undef PG8_SCHED
}

template <bool F8 = false, bool IDENT = false, class Epi, class Sched>
__device__ __forceinline__ void gemm_phase_gather(LAS unsigned char* lds, const Gemm g, const Sched& S, const Epi& E, const int* TOKV) {
    int tid_ = threadIdx.x; asm volatile("" : "+v"(tid_));
    const int tid = tid_, wid = __builtin_amdgcn_readfirstlane(tid >> 6), lane = tid & 63, wr = wid >> 2, wc = wid & 3, fr = lane & 15, fq = lane >> 4;
    const int K = g.K, nt = K / BK;
    unsigned voffB[2];
#pragma unroll
    for (int i = 0; i < 2; ++i) { int R, C; stage_rc(tid * 16 + i * 8192, R, C); const int Rb = (R & ~31) + perm32(R & 31); voffB[i] = (unsigned)(Rb * K + C) * 2u; }
    unsigned vgC[2][2];
    LAS int* TOKL = (LAS int*)(lds + STAGE_TOKL);
#define PG8_GROWS(dst, u_) do { int tq_ = threadIdx.x; asm volatile("" : "+v"(tq_)); _Pragma("unroll") for (int i_ = 0; i_ < 2; ++i_) { int R_, C_; stage_rc(tq_ * 16 + i_ * 8192, R_, C_); \
            _Pragma("unroll") for (int h_ = 0; h_ < 2; ++h_) { const int pos_ = 256 * (u_).lt + 128 * h_ + R_; \
                int tok_; if constexpr (IDENT) tok_ = 256 * (u_).pm + 128 * h_ + R_; else tok_ = (pos_ < (u_).cnt) ? TOKV[(size_t)(u_).e * M + pos_] : 0; dst[h_][i_] = (unsigned)tok_ * (unsigned)(K * 2) + (unsigned)C_ * 2u; } } } while (0)
#define PG8_GROWS_LDS(dst, u_, par_) do { int tq_ = threadIdx.x; asm volatile("" : "+v"(tq_)); _Pragma("unroll") for (int i_ = 0; i_ < 2; ++i_) { int R_, C_; stage_rc(tq_ * 16 + i_ * 8192, R_, C_); \
            _Pragma("unroll") for (int h_ = 0; h_ < 2; ++h_) { const int rl_ = 128 * h_ + R_; \
                int tok_; if constexpr (IDENT) tok_ = 256 * (u_).pm + rl_; else tok_ = (256 * (u_).lt + rl_ < (u_).cnt) ? TOKL[256 * (par_) + rl_] : 0; dst[h_][i_] = (unsigned)tok_ * (unsigned)(K * 2) + (unsigned)C_ * 2u; } } } while (0)
    const size_t kstep = (size_t)(BK * 2);
    const size_t hstep = (size_t)HALF * K * 2;
    const size_t tstep = 2 * hstep;
    const unsigned ldsw = (unsigned)wid * 1024u;
    const int aoff = lds_byte(wr * 64 + fr, fq * 8), boff = lds_byte(wc * 32 + fr, fq * 8);
#define PG8_SA(b, h) (((b) * 2 + (h)) * HTB)
#define PG8_SB(b, h) ((4 + (b) * 2 + (h)) * HTB)
#define PG8_STAGE(bufoff, gbase, voff) do { _Pragma("unroll") for (int _i = 0; _i < 2; ++_i) \
        __builtin_amdgcn_global_load_lds((const unsigned*)((const char*)(gbase) + (voff)[_i]), (LAS unsigned*)(lds + (bufoff) + ldsw + _i * 8192), 16, 0, 0); } while (0)
#define PG8_STAGEA(bufoff, gbase, h_, nx_) PG8_STAGE(bufoff, gbase, vgC[h_])
#define PG8_LDA(dst, b, h) do { _Pragma("unroll") for (int m = 0; m < 4; ++m) _Pragma("unroll") for (int k = 0; k < 2; ++k) dst[m][k] = *(const LAS bf16x8*)(lds + PG8_SA(b, h) + aoff + m * 2048 + k * 1024); } while (0)
#define PG8_LDB(dst, b, h) do { _Pragma("unroll") for (int n = 0; n < 2; ++n) _Pragma("unroll") for (int k = 0; k < 2; ++k) dst[n][k] = *(const LAS bf16x8*)(lds + PG8_SB(b, h) + boff + n * 2048 + k * 1024); } while (0)
#define PG8_MMA(ai, bj, At, Bt) do { __builtin_amdgcn_s_setprio(1); \
        if constexpr (F8) {        \
            _Pragma("unroll") for (int m = 0; m < 4; ++m) _Pragma("unroll") for (int n = 0; n < 2; ++n) { \
                const v8i32 bv_ = __builtin_shufflevector(__builtin_bit_cast(v4i32, Bt[n][0]), __builtin_bit_cast(v4i32, Bt[n][1]), 0, 1, 2, 3, 4, 5, 6, 7); \
                const v8i32 av_ = __builtin_shufflevector(__builtin_bit_cast(v4i32, At[m][0]), __builtin_bit_cast(v4i32, At[m][1]), 0, 1, 2, 3, 4, 5, 6, 7); \
                acc[ai][bj][m][n] = __builtin_amdgcn_mfma_scale_f32_16x16x128_f8f6f4(bv_, av_, acc[ai][bj][m][n], 0, 0, 0, g.sc, 0, 0x7f7f7f7f); } \
        } else { \
            _Pragma("unroll") for (int m = 0; m < 4; ++m) _Pragma("unroll") for (int n = 0; n < 2; ++n) _Pragma("unroll") for (int k = 0; k < 2; ++k) \
                acc[ai][bj][m][n] = __builtin_amdgcn_mfma_f32_16x16x32_bf16(Bt[n][k], At[m][k], acc[ai][bj][m][n], 0, 0, 0); } \
        __builtin_amdgcn_s_setprio(0); } while (0)
#define PG8_WAIT_V(n) asm volatile("s_waitcnt vmcnt(" #n ")" ::: "memory")
#define PG8_WAIT_L(n) asm volatile("s_waitcnt lgkmcnt(" #n ")" ::: "memory")
#define PG8_BAR __builtin_amdgcn_s_barrier()
#define PG8_SCHED __builtin_amdgcn_sched_barrier(0)
    Unit cur, nxt; int ui = 0;
    if (!S.next(0, cur)) return;
    Acc acc;
#pragma unroll
    for (int a = 0; a < 2; ++a)
#pragma unroll
        for (int b = 0; b < 2; ++b)
#pragma unroll
            for (int m = 0; m < 4; ++m)
#pragma unroll
                for (int n = 0; n < 2; ++n) acc[a][b][m][n] = (f32x4){0.f, 0.f, 0.f, 0.f};
    bf16x8 At[4][2], B0[2][2], B1[2][2];
    const char* cA = (const char*)g.A; const char* cB = (const char*)g.Bt + (size_t)cur.pb * tstep;
    PG8_GROWS(vgC, cur);
    PG8_STAGE(PG8_SB(0, 0), cB, voffB); PG8_STAGEA(PG8_SA(0, 0), cA, 0, false); PG8_STAGE(PG8_SB(0, 1), cB + hstep, voffB); PG8_STAGEA(PG8_SA(0, 1), cA, 1, false);
    if (wr == 1) PG8_BAR;
    PG8_WAIT_V(4); PG8_BAR;
    PG8_STAGE(PG8_SB(1, 0), cB + kstep, voffB); PG8_STAGEA(PG8_SA(1, 0), cA + kstep, 0, false); PG8_STAGE(PG8_SB(1, 1), cB + hstep + kstep, voffB);
    PG8_WAIT_V(6); PG8_BAR;
    for (;;) {
        const bool has_next = S.next(ui + 1, nxt);
        const char* nA = cA; const char* nB = has_next ? (const char*)g.Bt + (size_t)nxt.pb * tstep : cB;
        if (!IDENT && has_next && wid == 0) __builtin_amdgcn_global_load_lds((const unsigned*)(TOKV + (size_t)nxt.e * M + 256 * nxt.lt + 4 * lane), (LAS unsigned*)(TOKL + 256 * ((ui + 1) & 1)), 16, 0, 0);

#pragma nounroll
        for (int t = 0; t < nt; t += 2) {
            const bool last = (t == nt - 2);
            const char* a1 = cA + (size_t)(t + 1) * kstep;
            const char* a2 = last ? nA : cA + (size_t)(t + 2) * kstep; const char* b2 = last ? nB : cB + (size_t)(t + 2) * kstep;
            const char* a3 = a2 + kstep; const char* b3 = b2 + kstep;
            PG8_LDB(B0, 0, 0); PG8_SCHED; PG8_LDA(At, 0, 0); PG8_STAGEA(PG8_SA(1, 1), a1, 1, false);
            if (last && has_next) { PG8_GROWS_LDS(vgC, nxt, (ui + 1) & 1); }
            PG8_WAIT_L(8); PG8_BAR; PG8_WAIT_L(0); PG8_MMA(0, 0, At, B0); PG8_BAR; PG8_SCHED;
            PG8_LDB(B1, 0, 1); PG8_STAGE(PG8_SB(0, 0), b2, voffB);
            PG8_BAR; PG8_WAIT_L(0); PG8_MMA(0, 1, At, B1); PG8_BAR;
            PG8_LDA(At, 0, 1); PG8_STAGEA(PG8_SA(0, 0), a2, 0, last);
            PG8_BAR; PG8_WAIT_L(0); PG8_MMA(1, 0, At, B0); PG8_BAR; PG8_SCHED;
            PG8_STAGE(PG8_SB(0, 1), b2 + hstep, voffB);
            PG8_WAIT_V(6); PG8_BAR; PG8_MMA(1, 1, At, B1); PG8_BAR;
            PG8_LDB(B0, 1, 0); PG8_SCHED; PG8_LDA(At, 1, 0); PG8_STAGEA(PG8_SA(0, 1), a2, 1, last);
            PG8_WAIT_L(8); PG8_BAR; PG8_WAIT_L(0); PG8_MMA(0, 0, At, B0); PG8_BAR; PG8_SCHED;
            PG8_LDB(B1, 1, 1); PG8_STAGE(PG8_SB(1, 0), b3, voffB);
            PG8_BAR; PG8_WAIT_L(0); PG8_MMA(0, 1, At, B1); PG8_BAR;
            PG8_LDA(At, 1, 1); PG8_STAGEA(PG8_SA(1, 0), a3, 0, last);
            PG8_BAR; PG8_WAIT_L(0); PG8_MMA(1, 0, At, B0); PG8_BAR; PG8_SCHED;
            PG8_STAGE(PG8_SB(1, 1), b3 + hstep, voffB);
            PG8_WAIT_V(6); PG8_BAR; PG8_MMA(1, 1, At, B1); PG8_BAR;
        }
        E(acc, cur, wr, wc, fr, fq);
        if (!has_next) break;
#pragma unroll
        for (int a = 0; a < 2; ++a)
#pragma unroll
            for (int b = 0; b < 2; ++b)
#pragma unroll
                for (int m = 0; m < 4; ++m)
#pragma unroll
                    for (int n = 0; n < 2; ++n) acc[a][b][m][n] = (f32x4){0.f, 0.f, 0.f, 0.f};
        cur = nxt; cB = nB; ++ui;
    }
    PG8_WAIT_V(0);
    if (wr == 0) PG8_BAR;
    PG8_BAR;
#undef PG8_SA
#undef PG8_STAGEA
#undef PG8_GROWS
#undef PG8_GROWS_LDS
#undef PG8_SB
#undef PG8_STAGE
#undef PG8_LDA
#undef PG8_LDB
#undef PG8_MMA
#undef PG8_WAIT_V
#undef PG8_WAIT_L
#undef PG8_BAR
#undef PG8_SCHED
}

__device__ __forceinline__ u32x4 pack8(const f32x4 a, const f32x4 b) { u32x4 w; w.x = cvt_pk_bf16(a[0], a[1]); w.y = cvt_pk_bf16(a[2], a[3]); w.z = cvt_pk_bf16(b[0], b[1]); w.w = cvt_pk_bf16(b[2], b[3]); return w; }

struct EpiHgIn {
    bf16_t* QFVG;
    __device__ __forceinline__ void operator()(const Acc& acc, const Unit& u, int wr, int wc, int fr, int fq) const {
        const int part = u.pn >> 2, row0 = u.pm * BM + wr * 64 + fr, col0 = (u.pn & 3) * 256 + wc * 32 + 8 * fq;
        bf16_t* base = QFVG + (size_t)part * ((size_t)M * D);
#pragma unroll
        for (int ai = 0; ai < 2; ++ai)
#pragma unroll
            for (int m = 0; m < 4; ++m) { bf16_t* rowp = base + (size_t)(row0 + ai * HALF + m * 16) * D + col0;
#pragma unroll
                for (int bj = 0; bj < 2; ++bj) *(u32x4*)(rowp + bj * HALF) = pack8(acc[ai][bj][m][0], acc[ai][bj][m][1]); }
    }
};
struct EpiRes {
    const bf16_t* X; bf16_t* Y;
    __device__ __forceinline__ void operator()(const Acc& acc, const Unit& u, int wr, int wc, int fr, int fq) const {
        const int row0 = u.pm * BM + wr * 64 + fr, col0 = u.pn * BM + wc * 32 + 8 * fq;
#pragma unroll
        for (int ai = 0; ai < 2; ++ai)
#pragma unroll
            for (int m = 0; m < 4; ++m) { const size_t o = (size_t)(row0 + ai * HALF + m * 16) * D + col0;
#pragma unroll
                for (int bj = 0; bj < 2; ++bj) {
                    const u32x4 xv = *(const u32x4*)(X + o + bj * HALF);
                    f32x4 y0, y1;
#pragma unroll
                    for (int q = 0; q < 2; ++q) { y0[2 * q] = __uint_as_float(xv[q] << 16) * ALPHA + acc[ai][bj][m][0][2 * q]; y0[2 * q + 1] = __uint_as_float(xv[q] & 0xffff0000u) * ALPHA + acc[ai][bj][m][0][2 * q + 1];
                        y1[2 * q] = __uint_as_float(xv[2 + q] << 16) * ALPHA + acc[ai][bj][m][1][2 * q]; y1[2 * q + 1] = __uint_as_float(xv[2 + q] & 0xffff0000u) * ALPHA + acc[ai][bj][m][1][2 * q + 1]; }
                    *(u32x4*)(Y + o + bj * HALF) = pack8(y0, y1); } }
    }
};
__device__ __forceinline__ unsigned pack4_fp8(float a, float b, float c, float d) {
    a = fminf(fmaxf(a, -448.f), 448.f); b = fminf(fmaxf(b, -448.f), 448.f); c = fminf(fmaxf(c, -448.f), 448.f); d = fminf(fmaxf(d, -448.f), 448.f);
    int p = 0; p = __builtin_amdgcn_cvt_pk_fp8_f32(a, b, p, false); p = __builtin_amdgcn_cvt_pk_fp8_f32(c, d, p, true); return (unsigned)p;
}
constexpr float F8_X = 16.f, F8_WGU = 64.f, F8_H = 4.f, F8_WDN = 256.f, F8_O = 64.f, F8_WDO = 128.f;
constexpr int e8m0x4(int e) { return (127 + e) * 0x01010101; }
constexpr int SC_UP = e8m0x4(-10), SC_DN = e8m0x4(-10), SC_DO = e8m0x4(-13);
struct EpiSwiglu8 {
    unsigned char* H;
    __device__ __forceinline__ void operator()(const Acc& acc, const Unit& u, int wr, int wc, int fr, int fq) const {
        const int row0 = u.pm * BM + wr * 64 + fr, col0 = u.pn * 128 + wc * 32 + 8 * fq;
#pragma unroll
        for (int ai = 0; ai < 2; ++ai)
#pragma unroll
            for (int m = 0; m < 4; ++m) { unsigned char* rowp = H + (size_t)(row0 + ai * HALF + m * 16) * DFF + col0;
                float h[8];
#pragma unroll
                for (int j = 0; j < 8; ++j) { const float gt = acc[ai][0][m][j >> 2][j & 3], up = acc[ai][1][m][j >> 2][j & 3];
                    h[j] = __builtin_amdgcn_fmed3f(gt * (up * F8_H) * fast_rcp(1.0f + fast_exp2(gt * -1.4426950408889634f)), -448.f, 448.f); }
                int p0 = 0, p1 = 0;
                p0 = __builtin_amdgcn_cvt_pk_fp8_f32(h[0], h[1], p0, false); p0 = __builtin_amdgcn_cvt_pk_fp8_f32(h[2], h[3], p0, true);
                p1 = __builtin_amdgcn_cvt_pk_fp8_f32(h[4], h[5], p1, false); p1 = __builtin_amdgcn_cvt_pk_fp8_f32(h[6], h[7], p1, true);
                *(u32x2*)rowp = (u32x2){(unsigned)p0, (unsigned)p1}; }
    }
};
struct EpiSwiglu {
    bf16_t* H;
    __device__ __forceinline__ void operator()(const Acc& acc, const Unit& u, int wr, int wc, int fr, int fq) const {
        const int row0 = u.pm * BM + wr * 64 + fr, col0 = u.pn * 128 + wc * 32 + 8 * fq;
#pragma unroll
        for (int ai = 0; ai < 2; ++ai)
#pragma unroll
            for (int m = 0; m < 4; ++m) { bf16_t* rowp = H + (size_t)(row0 + ai * HALF + m * 16) * DFF + col0;
                f32x4 h0, h1;
#pragma unroll
                for (int j = 0; j < 4; ++j) { h0[j] = siluf_(acc[ai][0][m][0][j]) * acc[ai][1][m][0][j]; h1[j] = siluf_(acc[ai][0][m][1][j]) * acc[ai][1][m][1][j]; }
                *(u32x4*)rowp = pack8(h0, h1); }
    }
};
struct EpiBf16 {
    bf16_t* C; int ldc;
    __device__ __forceinline__ void operator()(const Acc& acc, const Unit& u, int wr, int wc, int fr, int fq) const {
        const int row0 = u.pm * BM + wr * 64 + fr, col0 = u.pn * BM + wc * 32 + 8 * fq;
#pragma unroll
        for (int ai = 0; ai < 2; ++ai)
#pragma unroll
            for (int m = 0; m < 4; ++m) { bf16_t* rowp = C + (size_t)(row0 + ai * HALF + m * 16) * ldc + col0;
#pragma unroll
                for (int bj = 0; bj < 2; ++bj) *(u32x4*)(rowp + bj * HALF) = pack8(acc[ai][bj][m][0], acc[ai][bj][m][1]); }
    }
};
struct EpiQ {
    bf16_t* QLAT; bf16_t* QIDX;
    __device__ __forceinline__ void operator()(const Acc& acc, const Unit& u, int wr, int wc, int fr, int fq) const {
        const bool lat = u.pn < 8; bf16_t* base = lat ? QLAT : QIDX; const int ld = lat ? 2048 : 512;
        const int row0 = u.pm * BM + wr * 64 + fr, col0 = (lat ? u.pn : u.pn - 8) * BM + wc * 32 + 8 * fq;
#pragma unroll
        for (int ai = 0; ai < 2; ++ai)
#pragma unroll
            for (int m = 0; m < 4; ++m) { bf16_t* rowp = base + (size_t)(row0 + ai * HALF + m * 16) * ld + col0;
#pragma unroll
                for (int bj = 0; bj < 2; ++bj) *(u32x4*)(rowp + bj * HALF) = pack8(acc[ai][bj][m][0], acc[ai][bj][m][1]); }
    }
};
struct EpiMoeDn {
    bf16_t* O; const float* GW;
    __device__ __forceinline__ void operator()(const Acc& acc, const Unit& u, int wr, int wc, int fr, int fq) const {
        const int rl0 = wr * 64 + fr, col0 = u.pn * BM + wc * 32 + 8 * fq; const float* gwp = GW + (size_t)u.e * M + 256 * u.lt;
#pragma unroll
        for (int ai = 0; ai < 2; ++ai)
#pragma unroll
            for (int m = 0; m < 4; ++m) { const int rl = rl0 + ai * HALF + m * 16; const float gv = (256 * u.lt + rl < u.cnt) ? gwp[rl] : 0.f; bf16_t* rowp = O + (size_t)(u.pm * BM + rl) * D + col0;
#pragma unroll
                for (int bj = 0; bj < 2; ++bj) *(u32x4*)(rowp + bj * HALF) = pack8(acc[ai][bj][m][0] * gv, acc[ai][bj][m][1] * gv); }
    }
};

struct Params { const float* in[22]; float* out; unsigned char* ws; int ph_lo, ph_hi; };
enum { IN_X = 0, IN_LNG, IN_LNB, IN_HGWIN, IN_HGLB, IN_HGNG, IN_HGWOUT, IN_DWIN, IN_DQNG, IN_DKVNG, IN_DWUQ, IN_DWUK, IN_DWUV, IN_DWQIDX, IN_DKIG, IN_DKIB, IN_DWOUT, IN_FGU, IN_FDN, IN_MR, IN_MGU, IN_MDN };

__device__ __forceinline__ const float* inptr(int i) {
    int off = i * 8; asm volatile("" : "+s"(off));
    typedef const float* cfp;
    return *(const __attribute__((address_space(4))) cfp*)((const __attribute__((address_space(4))) char*)__builtin_amdgcn_kernarg_segment_ptr() + off);
}
#define INP(i) inptr(i)
struct Frame {
    LAS unsigned char* lds;
    unsigned* ctl;
    int tid, lane, wave, G, c;
};

__device__ __forceinline__ void p0_transpose_item(const float* W, int K, int Nsrc, int nblk, bf16_t* WT, int mode, float f8scale, LAS float* scr, int item, int lane) {
    const int kb = item / nblk, nb = item % nblk, k0 = 64 * kb, n0 = 32 * nb;
    const int c4 = (lane & 7) * 4, kr = lane >> 3;
#pragma unroll
    for (int i = 0; i < 8; ++i) { const int kk = 8 * i + kr;
        f32x4 v = (f32x4){0.f, 0.f, 0.f, 0.f};
        if (n0 + c4 < Nsrc) v = *(const f32x4*)(W + (size_t)(k0 + kk) * Nsrc + n0 + c4);
        scr[kk * 33 + c4 + 0] = v[0]; scr[kk * 33 + c4 + 1] = v[1]; scr[kk * 33 + c4 + 2] = v[2]; scr[kk * 33 + c4 + 3] = v[3]; }
    LDS_WAIT(); asm volatile("" ::: "memory");
    int drow0 = n0;
    if (mode == 1) { const int half = n0 / DFF, r = n0 % DFF; drow0 = 256 * (r / 128) + 128 * half + (r % 128); }
    if (f8scale > 0.f) {
        const int c = lane & 3;
#pragma unroll
        for (int j = 0; j < 2; ++j) { const int n = (lane >> 2) + 16 * j; const LAS float* s = scr + (16 * c) * 33 + n;
            u32x4 o;
#pragma unroll
            for (int q = 0; q < 4; ++q) o[q] = pack4_fp8(s[(4 * q) * 33] * f8scale, s[(4 * q + 1) * 33] * f8scale, s[(4 * q + 2) * 33] * f8scale, s[(4 * q + 3) * 33] * f8scale);
            *(u32x4*)((unsigned char*)WT + (size_t)(drow0 + n) * K + k0 + 16 * c) = o; }
    } else {
        const int c = lane & 7;
#pragma unroll
        for (int j = 0; j < 4; ++j) { const int n = (lane >> 3) + 8 * j; const LAS float* s = scr + (8 * c) * 33 + n;
            u32x4 o; o.x = cvt_pk_bf16(s[0 * 33], s[1 * 33]); o.y = cvt_pk_bf16(s[2 * 33], s[3 * 33]); o.z = cvt_pk_bf16(s[4 * 33], s[5 * 33]); o.w = cvt_pk_bf16(s[6 * 33], s[7 * 33]);
            *(u32x4*)(WT + (size_t)(drow0 + n) * K + k0 + 8 * c) = o; }
    }
    LDS_WAIT(); asm volatile("" ::: "memory");
}
__device__ __forceinline__ void p0_combo_item(Frame& F, const float* A, int lda, const float* B, int ldb, bf16_t* out, int ldo, float scale, bool f8 = false) {
    LAS float* As = (LAS float*)F.lds; LAS float* Bs = As + 64 * 128;
    const int t = F.tid;
#pragma unroll
    for (int q = 0; q < 4; ++q) { const int r = (t >> 5) + 16 * q, c4 = (t & 31) * 4; *(LAS f32x4*)(As + r * 128 + c4) = *(const f32x4*)(A + (size_t)r * lda + c4); }
#pragma unroll
    for (int q = 0; q < 4; ++q) { const int r = (t >> 4) + 32 * q, c4 = (t & 15) * 4; *(LAS f32x4*)(Bs + r * 64 + c4) = *(const f32x4*)(B + (size_t)r * ldb + c4); }
    __syncthreads();
    const int tj = t & 63, ti = t >> 6;
    float acc[8];
#pragma unroll
    for (int ii = 0; ii < 8; ++ii) acc[ii] = 0.f;
    for (int d = 0; d < 128; d += 4) {
        const float b0 = Bs[(d + 0) * 64 + tj], b1 = Bs[(d + 1) * 64 + tj], b2 = Bs[(d + 2) * 64 + tj], b3 = Bs[(d + 3) * 64 + tj];
#pragma unroll
        for (int ii = 0; ii < 8; ++ii) { const f32x4 a = *(const LAS f32x4*)(As + (8 * ti + ii) * 128 + d); acc[ii] += a[0] * b0 + a[1] * b1 + a[2] * b2 + a[3] * b3; }
    }
    u32x4 o; o.x = cvt_pk_bf16(acc[0] * scale, acc[1] * scale); o.y = cvt_pk_bf16(acc[2] * scale, acc[3] * scale); o.z = cvt_pk_bf16(acc[4] * scale, acc[5] * scale); o.w = cvt_pk_bf16(acc[6] * scale, acc[7] * scale);
    if (f8) { u32x2 o8; o8.x = pack4_fp8(acc[0] * scale, acc[1] * scale, acc[2] * scale, acc[3] * scale); o8.y = pack4_fp8(acc[4] * scale, acc[5] * scale, acc[6] * scale, acc[7] * scale);
        *(u32x2*)((unsigned char*)out + (size_t)tj * ldo + 8 * ti) = o8; }
    else *(u32x4*)(out + (size_t)tj * ldo + 8 * ti) = o;
    __syncthreads();
}
__device__ __forceinline__ void p0_prologue(Frame& F, const Params& p) {
    unsigned char* ws = p.ws;
    LAS float* scr = (LAS float*)(F.lds + F.wave * 8448);
    const int gw = F.c * NWAVES + F.wave, NGW = F.G * NWAVES;
    constexpr int I0 = 16 * 128, I1 = 16 * 32, I2 = 16 * 224, I3 = 56 * 32, I4 = 16 * 24, I5 = 4 * 16;
    constexpr int NITEMS = 2 * (I0 + I1 + I2 + I3 + I4 + I5) + 16 * (I2 + I3);
    for (int it = gw; it < NITEMS; it += NGW) {
        int r = it;
        if (r < 16 * I2) { const int job = r / I2;
#if MK_MOE_FP8
            p0_transpose_item(INP(IN_MGU) + (size_t)job * D * 2 * DFF, D, 2 * DFF, 224, (bf16_t*)(ws + WS_W_MGU8 + (size_t)job * 2 * DFF * D), 1, F8_WGU, scr, r % I2, F.lane);
#else
            p0_transpose_item(INP(IN_MGU) + (size_t)job * D * 2 * DFF, D, 2 * DFF, 224, (bf16_t*)(ws + WS_W_MGU) + (size_t)job * 2 * DFF * D, 1, 0.f, scr, r % I2, F.lane);
#endif
            continue; } r -= 16 * I2;
        if (r < 16 * I3) { const int job = r / I3;
#if MK_MOE_FP8
            p0_transpose_item(INP(IN_MDN) + (size_t)job * DFF * D, DFF, D, 32, (bf16_t*)(ws + WS_W_MDN8 + (size_t)job * D * DFF), 0, F8_WDN, scr, r % I3, F.lane);
#else
            p0_transpose_item(INP(IN_MDN) + (size_t)job * DFF * D, DFF, D, 32, (bf16_t*)(ws + WS_W_MDN) + (size_t)job * D * DFF, 0, 0.f, scr, r % I3, F.lane);
#endif
            continue; } r -= 16 * I3;
        if (r < 2 * I0) { const int job = r / I0; p0_transpose_item(INP(IN_HGWIN) + (size_t)job * D * 4 * D, D, 4 * D, 128, (bf16_t*)(ws + WS_W_HGIN) + (size_t)job * 4 * D * D, 0, 0.f, scr, r % I0, F.lane); continue; } r -= 2 * I0;
        if (r < 2 * I1) { const int job = r / I1; p0_transpose_item(INP(IN_HGWOUT) + (size_t)job * D * D, D, D, 32, (bf16_t*)(ws + WS_W_HGOUT) + (size_t)job * D * D, 0, 0.f, scr, r % I1, F.lane); continue; } r -= 2 * I1;
        if (r < 2 * I2) { const int job = r / I2;
#if MK_FFN_FP8 == 2
            p0_transpose_item(INP(IN_FGU) + (size_t)job * D * 2 * DFF, D, 2 * DFF, 224, (bf16_t*)(ws + WS_W_FGU + (size_t)job * 2 * DFF * D), 1, F8_WGU, scr, r % I2, F.lane);
#else
            p0_transpose_item(INP(IN_FGU) + (size_t)job * D * 2 * DFF, D, 2 * DFF, 224, (bf16_t*)(ws + WS_W_FGU) + (size_t)job * 2 * DFF * D, 1, 0.f, scr, r % I2, F.lane);
#endif
            continue; } r -= 2 * I2;
        if (r < 2 * I3) { const int job = r / I3;
#if MK_FFN_FP8 >= 1
            p0_transpose_item(INP(IN_FDN) + (size_t)job * DFF * D, DFF, D, 32, (bf16_t*)(ws + WS_W_FDN + (size_t)job * D * DFF), 0, F8_WDN, scr, r % I3, F.lane);
#else
            p0_transpose_item(INP(IN_FDN) + (size_t)job * DFF * D, DFF, D, 32, (bf16_t*)(ws + WS_W_FDN) + (size_t)job * D * DFF, 0, 0.f, scr, r % I3, F.lane);
#endif
            continue; } r -= 2 * I3;
        if (r < 2 * I4) { const int job = r / I4; p0_transpose_item(INP(IN_DWIN) + (size_t)job * D * DSA_IN, D, DSA_IN, 24, (bf16_t*)(ws + WS_W_DIN) + (size_t)job * DSA_IN_PAD * D, 0, 0.f, scr, r % I4, F.lane); continue; } r -= 2 * I4;
        { const int job = r / I5; p0_transpose_item(INP(IN_DWQIDX) + (size_t)job * QR * 512, QR, 512, 16, (bf16_t*)(ws + WS_W_DQ) + (size_t)job * 2560 * QR + (size_t)2048 * QR, 0, 0.f, scr, r % I5, F.lane); }
    }
    { const f32x4* x4 = (const f32x4*)INP(IN_X); u32x2* xb = (u32x2*)(ws + WS_XB); const size_t n4 = (size_t)M * D / 4;
      for (size_t i = (size_t)F.c * NTHREADS + F.tid; i < n4; i += (size_t)F.G * NTHREADS) { const f32x4 v = x4[i]; u32x2 o; o.x = cvt_pk_bf16(v[0], v[1]); o.y = cvt_pk_bf16(v[2], v[3]); xb[i] = o; } }
    __syncthreads();
    const float qscale = 0.08838834764831845f * 1.4426950408889634f;
    for (int it = F.c; it < 256 + 1024; it += F.G) {
        if (it < 256) { const int j = it >> 7, h = (it >> 4) & 7, ib = (it >> 2) & 3, jb = it & 3;
            p0_combo_item(F, INP(IN_DWUQ) + (size_t)j * QR * D + (size_t)(64 * ib) * D + h * 128, D, INP(IN_DWUK) + ((size_t)j * 8 + h) * 128 * KVR + 64 * jb, KVR,
                          (bf16_t*)(ws + WS_W_DQ) + (size_t)j * 2560 * QR + (size_t)(h * 256 + 64 * jb) * QR + 64 * ib, QR, qscale);
        } else { const int r = it - 256, j = r >> 9, h = (r >> 6) & 7, ib = (r >> 4) & 3, jb = r & 15;
            p0_combo_item(F, INP(IN_DWUV) + (((size_t)j * 8 + h) * KVR + 64 * ib) * 128, 128, INP(IN_DWOUT) + (size_t)j * D * D + (size_t)(h * 128) * D + 64 * jb, D,
#if MK_B6_FP8
                          (bf16_t*)(ws + WS_W_DO + (size_t)j * D * 2048 + (size_t)(64 * jb) * 2048 + h * 256 + 64 * ib), 2048, F8_WDO, true);
#else
                          (bf16_t*)(ws + WS_W_DO) + (size_t)j * D * 2048 + (size_t)(64 * jb) * 2048 + h * 256 + 64 * ib, 2048, 1.0f);
#endif
        }
    }
}

__device__ __forceinline__ void unpack8(const u32x4 w, float* v) {
#pragma unroll
    for (int q = 0; q < 4; ++q) { v[2 * q] = __uint_as_float(w[q] << 16); v[2 * q + 1] = __uint_as_float(w[q] & 0xffff0000u); }
}
__device__ __forceinline__ void load_row_bf16(const bf16_t* row, int lane, float (&v)[16]) {
    const u32x4 a = *(const u32x4*)(row + 8 * lane), b = *(const u32x4*)(row + 512 + 8 * lane); unpack8(a, v); unpack8(b, v + 8);
}
__device__ __forceinline__ void load_vec_f32(const float* p, int lane, float (&v)[16]) {
#pragma unroll
    for (int h = 0; h < 2; ++h)
#pragma unroll
        for (int q = 0; q < 2; ++q) { const f32x4 x = *(const f32x4*)(p + 512 * h + 8 * lane + 4 * q); v[8 * h + 4 * q] = x[0]; v[8 * h + 4 * q + 1] = x[1]; v[8 * h + 4 * q + 2] = x[2]; v[8 * h + 4 * q + 3] = x[3]; }
}
__device__ __forceinline__ void store_row_bf16(const float (&v)[16], bf16_t* row, int lane) {
    u32x4 a, b;
#pragma unroll
    for (int q = 0; q < 4; ++q) { a[q] = cvt_pk_bf16(v[2 * q], v[2 * q + 1]); b[q] = cvt_pk_bf16(v[8 + 2 * q], v[8 + 2 * q + 1]); }
    *(u32x4*)(row + 8 * lane) = a; *(u32x4*)(row + 512 + 8 * lane) = b;
}
__device__ __forceinline__ void store_row_fp8(const float (&v)[16], unsigned char* row, int lane) {
    u32x2 o0, o1; o0.x = pack4_fp8(v[0] * F8_X, v[1] * F8_X, v[2] * F8_X, v[3] * F8_X); o0.y = pack4_fp8(v[4] * F8_X, v[5] * F8_X, v[6] * F8_X, v[7] * F8_X);
    o1.x = pack4_fp8(v[8] * F8_X, v[9] * F8_X, v[10] * F8_X, v[11] * F8_X); o1.y = pack4_fp8(v[12] * F8_X, v[13] * F8_X, v[14] * F8_X, v[15] * F8_X);
    *(u32x2*)(row + 8 * lane) = o0; *(u32x2*)(row + 512 + 8 * lane) = o1;
}
__device__ __forceinline__ void store_row_f32(const float (&v)[16], float* row, int lane) {
#pragma unroll
    for (int h = 0; h < 2; ++h)
#pragma unroll
        for (int q = 0; q < 2; ++q) *(f32x4*)(row + 512 * h + 8 * lane + 4 * q) = (f32x4){v[8 * h + 4 * q], v[8 * h + 4 * q + 1], v[8 * h + 4 * q + 2], v[8 * h + 4 * q + 3]};
}
__device__ __forceinline__ void ln_row(float (&v)[16], const float (&g)[16], const float (&b)[16]) {
    float s = 0.f;
#pragma unroll
    for (int i = 0; i < 16; ++i) s += v[i];
    const float mean = wave_sum(s) * (1.f / D); float s2 = 0.f;
#pragma unroll
    for (int i = 0; i < 16; ++i) { v[i] -= mean; s2 += v[i] * v[i]; }
    const float rstd = 1.f / sqrtf(wave_sum(s2) * (1.f / D) + LN_EPS);
#pragma unroll
    for (int i = 0; i < 16; ++i) v[i] = v[i] * rstd * g[i] + b[i];
}
__device__ __forceinline__ void ln_phase(Frame& F, const bf16_t* Y, const float* g, const float* b, bf16_t* XB, unsigned char* XB8) {
    float gv[16], bv[16]; load_vec_f32(g, F.lane, gv); load_vec_f32(b, F.lane, bv);
    const int gw = F.c * NWAVES + F.wave, NGW = F.G * NWAVES;
    for (int m = gw; m < M; m += NGW) {
        float v[16]; load_row_bf16(Y + (size_t)m * D, F.lane, v);
        ln_row(v, gv, bv);
        store_row_bf16(v, XB + (size_t)m * D, F.lane);
        if (XB8) store_row_fp8(v, XB8 + (size_t)m * D, F.lane);
    }
}
__device__ __forceinline__ void ln_moe_phase(Frame& F, const bf16_t* Xin, const bf16_t* OUTM, const int* EIDX, const int* POS, const unsigned* gcnt, const float* g, const float* b, bf16_t* XB, float* OUT) {
    float gv[16], bv[16]; load_vec_f32(g, F.lane, gv); load_vec_f32(b, F.lane, bv);
    int roff[8]; { int t = 0;
#pragma unroll
        for (int e = 0; e < 8; ++e) { roff[e] = t * 256; t += (__builtin_amdgcn_readfirstlane((int)__hip_atomic_load(gcnt + e, __ATOMIC_RELAXED, __HIP_MEMORY_SCOPE_AGENT)) + 255) >> 8; } }
    const int gw = F.c * NWAVES + F.wave, NGW = F.G * NWAVES;
    for (int m = gw; m < M; m += NGW) {
        const int e0 = EIDX[2 * m], e1 = EIDX[2 * m + 1]; int s0 = POS[2 * m], s1 = POS[2 * m + 1];
#pragma unroll
        for (int k = 0; k < 8; ++k) { s0 += (e0 == k) ? roff[k] : 0; s1 += (e1 == k) ? roff[k] : 0; }
        float v[16], o0[16], o1[16]; load_row_bf16(Xin + (size_t)m * D, F.lane, v); load_row_bf16(OUTM + (size_t)s0 * D, F.lane, o0); load_row_bf16(OUTM + (size_t)s1 * D, F.lane, o1);
#pragma unroll
        for (int i = 0; i < 16; ++i) v[i] = v[i] * ALPHA + o0[i] + o1[i];
        ln_row(v, gv, bv);
        if (OUT) store_row_f32(v, OUT + (size_t)m * D, F.lane); else store_row_bf16(v, XB + (size_t)m * D, F.lane);
    }
}
__device__ __forceinline__ void ln_router_phase(Frame& F, const bf16_t* Y, const float* g, const float* b, const float* wrouter, bf16_t* XB, unsigned char* XB8,
                                                int* EIDX, int* POS, int* TOK, float* GW, unsigned* gcnt) {
    LAS float* WR = (LAS float*)F.lds;
    LAS int* SEL = (LAS int*)(F.lds + 32768);
    LAS int* CW = (LAS int*)(F.lds + 32768 + 1024);
    LAS int* BASE = (LAS int*)(F.lds + 32768 + 1024 + 128);
    LAS float* SELW = (LAS float*)(F.lds + 32768 + 2048);
    for (int q = 0; q < 16; ++q) { const int idx = F.tid + NTHREADS * q; WR[(idx & 7) * 1024 + (idx >> 3)] = wrouter[idx]; }
    float gv[16], bv[16]; load_vec_f32(g, F.lane, gv); load_vec_f32(b, F.lane, bv);
    __syncthreads();
    for (int blk = F.c; blk < M / 128; blk += F.G) {
        for (int rl = F.wave; rl < 128; rl += NWAVES) {
            const int m = blk * 128 + rl;
            float v[16]; load_row_bf16(Y + (size_t)m * D, F.lane, v);
            ln_row(v, gv, bv);
            store_row_bf16(v, XB + (size_t)m * D, F.lane);
            if (XB8) store_row_fp8(v, XB8 + (size_t)m * D, F.lane);
            float lg[8];
#pragma unroll
            for (int e = 0; e < 8; ++e) { float s = 0.f;
#pragma unroll
                for (int h = 0; h < 2; ++h)
#pragma unroll
                    for (int q = 0; q < 2; ++q) { const f32x4 w = *(const LAS f32x4*)(WR + e * 1024 + 512 * h + 8 * F.lane + 4 * q); const int o = 8 * h + 4 * q;
                        s += (v[o] * w[0] + v[o + 1] * w[1]) + (v[o + 2] * w[2] + v[o + 3] * w[3]); }
                lg[e] = wave_sum(s); }
            int e0 = 0; float v0 = lg[0];
#pragma unroll
            for (int e = 1; e < 8; ++e) if (lg[e] > v0) { v0 = lg[e]; e0 = e; }
            int e1 = -1; float v1 = -3.0e38f;
#pragma unroll
            for (int e = 0; e < 8; ++e) if (e != e0 && lg[e] > v1) { v1 = lg[e]; e1 = e; }
            const float w1 = 1.f / (1.f + __expf(v0 - v1)), w0 = 1.f - w1;
            if (F.lane == 0) { SEL[2 * rl] = e0; SEL[2 * rl + 1] = e1; SELW[2 * rl] = w0; SELW[2 * rl + 1] = w1; EIDX[2 * m] = e0; EIDX[2 * m + 1] = e1; }
        }
        __syncthreads();
        const int mine = F.tid < 256 ? SEL[F.tid] : -1;
        int myrank = 0;
        if (F.wave < 4) {
#pragma unroll
            for (int e = 0; e < 8; ++e) { const unsigned long long mk = __ballot(mine == e); const int rk = __builtin_popcountll(mk & ((1ull << F.lane) - 1ull)); if (mine == e) myrank = rk;
                if (F.lane == 0) CW[F.wave * 8 + e] = __builtin_popcountll(mk); }
        }
        __syncthreads();
        if (F.tid < 8) { const int tot = CW[F.tid] + CW[8 + F.tid] + CW[16 + F.tid] + CW[24 + F.tid]; BASE[F.tid] = (int)__hip_atomic_fetch_add(gcnt + F.tid, (unsigned)tot, __ATOMIC_RELAXED, __HIP_MEMORY_SCOPE_AGENT); }
        __syncthreads();
        if (F.tid < 256) { int pos = BASE[mine] + myrank; for (int w = 0; w < F.wave; ++w) pos += CW[w * 8 + mine]; POS[blk * 256 + F.tid] = pos;
            TOK[(size_t)mine * M + pos] = blk * 128 + (F.tid >> 1); GW[(size_t)mine * M + pos] = SELW[F.tid]; }
        __syncthreads();
    }
}
__device__ __forceinline__ void hgrn_phase(Frame& F, const bf16_t* Q, const bf16_t* FP, const bf16_t* V, const float* lbparam, int jl, bf16_t* O) {
    constexpr int QST = 0, QS2 = 18432, KST = 36864, VS = 55296, SST0 = 64512, SSTB = 17408, SEG = 99328, RV = 103424, DV = 103936;
    constexpr int LQ = 136, LT = 72;
    LAS unsigned char* L = F.lds;
    const int tid = F.tid, lane = F.lane, w = F.wave, fr = lane & 15, fq = lane >> 4, qq = fr >> 2, pp = lane & 3;
    const int dp = tid & 63, seg = tid >> 6, d0 = 2 * dp;
    const int vrow = tid >> 3, vch = tid & 7;
    const int tt = w >> 1, eh = w & 1;
    for (int u = F.c; u < BATCH * HG_H * 2; u += F.G) {
        const int b = u >> 4, h = (u >> 1) & 7, vh = u & 1;
        float lb0 = 0.f, lb1 = 0.f;
        if (jl == 1) { const f32x2 l0 = *(const f32x2*)(lbparam + h * 128 + d0), l1 = *(const f32x2*)(lbparam + D + h * 128 + d0); lb0 = 1.f / (1.f + __expf(l0[0] - l1[0])); lb1 = 1.f / (1.f + __expf(l0[1] - l1[1])); }
        const float om0 = 1.f - lb0, om1 = 1.f - lb1;
        f32x4 St[4];
#pragma unroll
        for (int et = 0; et < 4; ++et) { St[et] = (f32x4){0.f, 0.f, 0.f, 0.f}; *(LAS u32x2*)(L + SST0 + ((16 * et + fr) * LQ + 16 * w + 4 * fq) * 2) = (u32x2){0u, 0u}; }
        const size_t ubase = (size_t)b * SEQ * D + h * 128;
        unsigned fpn[8], qn[8]; u32x4 vn;
        { const bf16_t* fp = FP + ubase + (size_t)(8 * seg) * D + d0; const bf16_t* qp = Q + ubase + (size_t)(8 * seg) * D + d0;
#pragma unroll
          for (int i = 0; i < 8; ++i) { fpn[i] = *(const unsigned*)(fp + (size_t)i * D); qn[i] = *(const unsigned*)(qp + (size_t)i * D); }
          vn = *(const u32x4*)(V + ubase + (size_t)vrow * D + vh * 64 + 8 * vch); }
        for (int ch = 0; ch < SEQ / HG_C; ++ch) {
            const size_t rowoff = ubase + (size_t)ch * HG_C * D;
            LAS unsigned char* SSTc = L + SST0 + (ch & 1) * SSTB; LAS unsigned char* SSTn = L + SST0 + ((ch + 1) & 1) * SSTB;
            float c0[8], c1[8], k0[8], k1[8], q0[8], q1[8];
            { float a0 = 0.f, a1 = 0.f;
#pragma unroll
              for (int i = 0; i < 8; ++i) { const float s0 = sigmoidf_(__uint_as_float(fpn[i] << 16)), s1 = sigmoidf_(__uint_as_float(fpn[i] & 0xffff0000u));
                  a0 += __logf(lb0 + om0 * s0); a1 += __logf(lb1 + om1 * s1); c0[i] = a0; c1[i] = a1; k0[i] = om0 * (1.f - s0); k1[i] = om1 * (1.f - s1);
                  q0[i] = __uint_as_float(qn[i] << 16); q1[i] = __uint_as_float(qn[i] & 0xffff0000u); }
              *(LAS f32x2*)(L + SEG + (seg * 128 + d0) * 4) = (f32x2){a0, a1};
              *(LAS u32x4*)(L + VS + (vrow * LT + 8 * vch) * 2) = vn; }
            __syncthreads();
            { float pre0 = 0.f, pre1 = 0.f, r0 = 0.f, r1 = 0.f, bl0 = 0.f, bl1 = 0.f;
#pragma unroll
              for (int s = 0; s < 8; ++s) { const f32x2 v = *(LAS f32x2*)(L + SEG + (s * 128 + d0) * 4);
                  if (s < seg) { pre0 += v[0]; pre1 += v[1]; } if (s < 4) { r0 += v[0]; r1 += v[1]; } bl0 += v[0]; bl1 += v[1]; }
              const float er0 = __expf(r0), er1 = __expf(r1);
              unsigned qa[4], qb[4], ka[4], xa[4], xb[4], kb[4];
#pragma unroll
              for (int i = 0; i < 8; i += 2) {
                  const float ba = pre0 + c0[i], bb = pre0 + c0[i + 1], bc = pre1 + c1[i], bd = pre1 + c1[i + 1];
                  const float qa0 = q0[i] * __expf(ba - r0), qa1 = q0[i + 1] * __expf(bb - r0), qb0 = q1[i] * __expf(bc - r1), qb1 = q1[i + 1] * __expf(bd - r1);
                  qa[i >> 1] = cvt_pk_bf16(qa0, qa1); qb[i >> 1] = cvt_pk_bf16(qb0, qb1);
                  xa[i >> 1] = cvt_pk_bf16(qa0 * er0, qa1 * er0); xb[i >> 1] = cvt_pk_bf16(qb0 * er1, qb1 * er1);
                  ka[i >> 1] = cvt_pk_bf16(k0[i] * __expf(r0 - ba), k0[i + 1] * __expf(r0 - bb)); kb[i >> 1] = cvt_pk_bf16(k1[i] * __expf(r1 - bc), k1[i + 1] * __expf(r1 - bd));
              }
              const int o0 = (d0 * LT + 8 * seg) * 2, o1 = o0 + LT * 2;
              *(LAS u32x4*)(L + QST + o0) = (u32x4){qa[0], qa[1], qa[2], qa[3]}; *(LAS u32x4*)(L + QST + o1) = (u32x4){qb[0], qb[1], qb[2], qb[3]};
              *(LAS u32x4*)(L + QS2 + o0) = (u32x4){xa[0], xa[1], xa[2], xa[3]}; *(LAS u32x4*)(L + QS2 + o1) = (u32x4){xb[0], xb[1], xb[2], xb[3]};
              *(LAS u32x4*)(L + KST + o0) = (u32x4){ka[0], ka[1], ka[2], ka[3]}; *(LAS u32x4*)(L + KST + o1) = (u32x4){kb[0], kb[1], kb[2], kb[3]};
              if (seg == 0) { *(LAS f32x2*)(L + RV + d0 * 4) = (f32x2){er0, er1}; *(LAS f32x2*)(L + DV + d0 * 4) = (f32x2){__expf(bl0 - r0), __expf(bl1 - r1)}; } }
            __syncthreads();
            if (ch + 1 < SEQ / HG_C) {
                const bf16_t* fp = FP + rowoff + (size_t)(HG_C + 8 * seg) * D + d0; const bf16_t* qp = Q + rowoff + (size_t)(HG_C + 8 * seg) * D + d0;
#pragma unroll
                for (int i = 0; i < 8; ++i) { fpn[i] = *(const unsigned*)(fp + (size_t)i * D); qn[i] = *(const unsigned*)(qp + (size_t)i * D); }
                vn = *(const u32x4*)(V + rowoff + (size_t)(HG_C + vrow) * D + vh * 64 + 8 * vch);
            }
            bf16x8 Pf[2];
            { f32x4 sc[4];
#pragma unroll
              for (int st = 0; st < 4; ++st) { sc[st] = (f32x4){0.f, 0.f, 0.f, 0.f};
                  if (st <= tt) {
#pragma unroll
                      for (int ks = 0; ks < 4; ++ks) {
                          const int ro = ((32 * ks + 8 * fq + qq) * LT + 4 * pp) * 2;
                          const s16x4 a0 = __builtin_amdgcn_ds_read_tr16_b64_v4i16((LAS s16x4*)(L + KST + ro + 32 * st)), a1 = __builtin_amdgcn_ds_read_tr16_b64_v4i16((LAS s16x4*)(L + KST + ro + 4 * LT * 2 + 32 * st));
                          const s16x4 b0 = __builtin_amdgcn_ds_read_tr16_b64_v4i16((LAS s16x4*)(L + QST + ro + 32 * tt)), b1 = __builtin_amdgcn_ds_read_tr16_b64_v4i16((LAS s16x4*)(L + QST + ro + 4 * LT * 2 + 32 * tt));
                          const bf16x8 av = (bf16x8){a0[0], a0[1], a0[2], a0[3], a1[0], a1[1], a1[2], a1[3]}, bv = (bf16x8){b0[0], b0[1], b0[2], b0[3], b1[0], b1[1], b1[2], b1[3]};
                          sc[st] = __builtin_amdgcn_mfma_f32_16x16x32_bf16(av, bv, sc[st], 0, 0, 0); }
#pragma unroll
                      for (int r = 0; r < 4; ++r) sc[st][r] = (16 * st + 4 * fq + r <= 16 * tt + fr) ? sc[st][r] : 0.f;
                  } }
              const u32x4 p0 = pack8(sc[0], sc[1]), p1 = pack8(sc[2], sc[3]); Pf[0] = __builtin_bit_cast(bf16x8, p0); Pf[1] = __builtin_bit_cast(bf16x8, p1); }
            { bf16x8 q2[4];
#pragma unroll
              for (int ks = 0; ks < 4; ++ks) { const int ro = ((32 * ks + 8 * fq + qq) * LT + 4 * pp) * 2 + 32 * tt;
                  const s16x4 b0 = __builtin_amdgcn_ds_read_tr16_b64_v4i16((LAS s16x4*)(L + QS2 + ro)), b1 = __builtin_amdgcn_ds_read_tr16_b64_v4i16((LAS s16x4*)(L + QS2 + ro + 4 * LT * 2));
                  q2[ks] = (bf16x8){b0[0], b0[1], b0[2], b0[3], b1[0], b1[1], b1[2], b1[3]}; }
#pragma unroll
              for (int ex = 0; ex < 2; ++ex) { const int et = 2 * eh + ex;
                  f32x4 acc = (f32x4){0.f, 0.f, 0.f, 0.f};
#pragma unroll
                  for (int k2 = 0; k2 < 2; ++k2) {
                      if (k2 == 0 || tt >= 2) {
                          const int ro = ((32 * k2 + 4 * fq + qq) * LT + 16 * et + 4 * pp) * 2;
                          const s16x4 a0 = __builtin_amdgcn_ds_read_tr16_b64_v4i16((LAS s16x4*)(L + VS + ro)), a1 = __builtin_amdgcn_ds_read_tr16_b64_v4i16((LAS s16x4*)(L + VS + ro + 16 * LT * 2));
                          const bf16x8 av = (bf16x8){a0[0], a0[1], a0[2], a0[3], a1[0], a1[1], a1[2], a1[3]};
                          acc = __builtin_amdgcn_mfma_f32_16x16x32_bf16(av, Pf[k2], acc, 0, 0, 0); } }
#pragma unroll
                  for (int ks = 0; ks < 4; ++ks) { const bf16x8 av = *(LAS bf16x8*)(SSTc + ((16 * et + fr) * LQ + 32 * ks + 8 * fq) * 2);
                      acc = __builtin_amdgcn_mfma_f32_16x16x32_bf16(av, q2[ks], acc, 0, 0, 0); }
                  u32x2 ov; ov.x = cvt_pk_bf16(acc[0], acc[1]); ov.y = cvt_pk_bf16(acc[2], acc[3]);
                  *(u32x2*)(O + rowoff + (size_t)(16 * tt + fr) * D + vh * 64 + 16 * et + 4 * fq) = ov;
              } }
            { const f32x4 rv = *(LAS f32x4*)(L + RV + (16 * w + 4 * fq) * 4), dv = *(LAS f32x4*)(L + DV + (16 * w + 4 * fq) * 4);
              bf16x8 kf[2];
#pragma unroll
              for (int ks = 0; ks < 2; ++ks) kf[ks] = *(LAS bf16x8*)(L + KST + ((16 * w + fr) * LT + 32 * ks + 8 * fq) * 2);
#pragma unroll
              for (int et = 0; et < 4; ++et) { St[et] = St[et] * rv;
#pragma unroll
                  for (int ks = 0; ks < 2; ++ks) { const int ro = ((32 * ks + 8 * fq + qq) * LT + 16 * et + 4 * pp) * 2;
                      const s16x4 b0 = __builtin_amdgcn_ds_read_tr16_b64_v4i16((LAS s16x4*)(L + VS + ro)), b1 = __builtin_amdgcn_ds_read_tr16_b64_v4i16((LAS s16x4*)(L + VS + ro + 4 * LT * 2));
                      const bf16x8 bb = (bf16x8){b0[0], b0[1], b0[2], b0[3], b1[0], b1[1], b1[2], b1[3]};
                      St[et] = __builtin_amdgcn_mfma_f32_16x16x32_bf16(kf[ks], bb, St[et], 0, 0, 0); }
                  St[et] = St[et] * dv;
                  u32x2 o; o.x = cvt_pk_bf16(St[et][0], St[et][1]); o.y = cvt_pk_bf16(St[et][2], St[et][3]);
                  *(LAS u32x2*)(SSTn + ((16 * et + fr) * LQ + 16 * w + 4 * fq) * 2) = o; } }
            __syncthreads();
        }
    }
}
__device__ __forceinline__ void hgrn_gate_phase(Frame& F, const bf16_t* O, const bf16_t* Gt, const float* ng, bf16_t* OG) {
    float gw_[16];
#pragma unroll
    for (int i = 0; i < 16; ++i) gw_[i] = ng[16 * F.lane + i];
    const int gw = F.c * NWAVES + F.wave, NGW = F.G * NWAVES;
    for (int m = gw; m < M; m += NGW) {
        const u32x4 o0 = *(const u32x4*)(O + (size_t)m * D + 16 * F.lane), o1 = *(const u32x4*)(O + (size_t)m * D + 16 * F.lane + 8);
        const u32x4 g0 = *(const u32x4*)(Gt + (size_t)m * D + 16 * F.lane), g1 = *(const u32x4*)(Gt + (size_t)m * D + 16 * F.lane + 8);
        float ov[16], gv[16];
#pragma unroll
        for (int i = 0; i < 4; ++i) { ov[2 * i] = __uint_as_float(o0[i] << 16); ov[2 * i + 1] = __uint_as_float(o0[i] & 0xffff0000u); ov[8 + 2 * i] = __uint_as_float(o1[i] << 16); ov[8 + 2 * i + 1] = __uint_as_float(o1[i] & 0xffff0000u);
            gv[2 * i] = __uint_as_float(g0[i] << 16); gv[2 * i + 1] = __uint_as_float(g0[i] & 0xffff0000u); gv[8 + 2 * i] = __uint_as_float(g1[i] << 16); gv[8 + 2 * i + 1] = __uint_as_float(g1[i] & 0xffff0000u); }
        float ss = 0.f;
#pragma unroll
        for (int i = 0; i < 16; ++i) ss += ov[i] * ov[i];
        ss += __builtin_bit_cast(float, __builtin_amdgcn_update_dpp(0, __builtin_bit_cast(int, ss), 0xB1, 0xF, 0xF, true));
        ss += __builtin_bit_cast(float, __builtin_amdgcn_update_dpp(0, __builtin_bit_cast(int, ss), 0x4E, 0xF, 0xF, true));
        ss += __builtin_bit_cast(float, __builtin_amdgcn_update_dpp(0, __builtin_bit_cast(int, ss), 0x141, 0xF, 0xF, true));
        const float rs = 1.f / sqrtf(ss * (1.f / 128.f) + RMS_EPS);
        float r[16];
#pragma unroll
        for (int i = 0; i < 16; ++i) r[i] = ov[i] * rs * gw_[i] * siluf_(gv[i]);
        u32x4 w0, w1; w0.x = cvt_pk_bf16(r[0], r[1]); w0.y = cvt_pk_bf16(r[2], r[3]); w0.z = cvt_pk_bf16(r[4], r[5]); w0.w = cvt_pk_bf16(r[6], r[7]);
        w1.x = cvt_pk_bf16(r[8], r[9]); w1.y = cvt_pk_bf16(r[10], r[11]); w1.z = cvt_pk_bf16(r[12], r[13]); w1.w = cvt_pk_bf16(r[14], r[15]);
        *(u32x4*)(OG + (size_t)m * D + 16 * F.lane) = w0; *(u32x4*)(OG + (size_t)m * D + 16 * F.lane + 8) = w1;
    }
}

__device__ __forceinline__ void dsa_norm_phase(Frame& F, const bf16_t* RAW, const float* qg, const float* kvg, const float* kig, const float* kib, bf16_t* CQ, bf16_t* CKV, bf16_t* KIDX, float* WIDX) {
    const f32x4 qgv = *(const f32x4*)(qg + 4 * F.lane), kvgv = *(const f32x4*)(kvg + 4 * F.lane); const float kg = kig[F.lane], kb = kib[F.lane];
    const int gw = F.c * NWAVES + F.wave, NGW = F.G * NWAVES;
    for (int m = gw; m < M; m += NGW) {
        const bf16_t* r = RAW + (size_t)m * DSA_IN_PAD;
        const u32x2 ar = *(const u32x2*)(r + 4 * F.lane), cr = *(const u32x2*)(r + 256 + 4 * F.lane); const float ki = bf2f(r[512 + F.lane]);
        const f32x4 a = (f32x4){__uint_as_float(ar.x << 16), __uint_as_float(ar.x & 0xffff0000u), __uint_as_float(ar.y << 16), __uint_as_float(ar.y & 0xffff0000u)};
        const f32x4 c = (f32x4){__uint_as_float(cr.x << 16), __uint_as_float(cr.x & 0xffff0000u), __uint_as_float(cr.y << 16), __uint_as_float(cr.y & 0xffff0000u)};
        const float sa = wave_sum((a[0] * a[0] + a[1] * a[1]) + (a[2] * a[2] + a[3] * a[3])), sc = wave_sum((c[0] * c[0] + c[1] * c[1]) + (c[2] * c[2] + c[3] * c[3]));
        const float ra = 1.f / sqrtf(sa * (1.f / 256.f) + RMS_EPS), rc = 1.f / sqrtf(sc * (1.f / 256.f) + RMS_EPS);
        u32x2 o; o.x = cvt_pk_bf16(a[0] * ra * qgv[0], a[1] * ra * qgv[1]); o.y = cvt_pk_bf16(a[2] * ra * qgv[2], a[3] * ra * qgv[3]); *(u32x2*)(CQ + (size_t)m * 256 + 4 * F.lane) = o;
        o.x = cvt_pk_bf16(c[0] * rc * kvgv[0], c[1] * rc * kvgv[1]); o.y = cvt_pk_bf16(c[2] * rc * kvgv[2], c[3] * rc * kvgv[3]); *(u32x2*)(CKV + (size_t)m * 256 + 4 * F.lane) = o;
        const float mu = wave_sum(ki) * (1.f / 64.f), dk = ki - mu, var = wave_sum(dk * dk) * (1.f / 64.f);
        KIDX[(size_t)m * 64 + F.lane] = f2bf(dk * (1.f / sqrtf(var + LN_EPS)) * kg + kb);
        if (F.lane < 8) WIDX[(size_t)m * 8 + F.lane] = bf2f(r[576 + F.lane]) * 0.04419417382415922f;
    }
}
__device__ __forceinline__ unsigned f2ord(float v) { const unsigned u = __float_as_uint(v); return (u & 0x80000000u) ? ~u : (u | 0x80000000u); }
__device__ __forceinline__ void dsa_index_phase(Frame& F, const bf16_t* QIDX, const bf16_t* KIDX, const float* WIDX, unsigned long long* MASK) {
    LAS float* SC = (LAS float*)F.lds;
    const int lane = F.lane, w = F.wave, fr = lane & 15, fq = lane >> 4;
    for (int i = 0;; ++i) {
        const int u = i * F.G + F.c; if (u >= BATCH * (SEQ / 16)) break;
        const int b = (u & 255) >> 4, qlo = (u & 15) + 16 * (u >> 9), qt = ((u >> 8) & 1) ? 127 - qlo : qlo, t0 = 16 * qt;     const size_t rb = (size_t)b * SEQ;
        bf16x8 Af[4][2][2]; float wv[4][8];
#pragma unroll
        for (int tg = 0; tg < 4; ++tg) {
#pragma unroll
            for (int hh = 0; hh < 2; ++hh)
#pragma unroll
                for (int ks = 0; ks < 2; ++ks) Af[tg][hh][ks] = *(const bf16x8*)(QIDX + (rb + t0 + 4 * tg + (fr >> 2)) * 512 + (4 * hh + (fr & 3)) * 64 + 32 * ks + 8 * fq);
            const f32x4 w0 = *(const f32x4*)(WIDX + (rb + t0 + 4 * tg + fq) * 8), w1 = *(const f32x4*)(WIDX + (rb + t0 + 4 * tg + fq) * 8 + 4);
#pragma unroll
            for (int r = 0; r < 4; ++r) { wv[tg][r] = w0[r]; wv[tg][4 + r] = w1[r]; }
        }
        bf16x8 nB0 = *(const bf16x8*)(KIDX + (rb + 16 * w + fr) * 64 + 8 * fq), nB1 = *(const bf16x8*)(KIDX + (rb + 16 * w + fr) * 64 + 32 + 8 * fq);
        for (int kg = w; kg <= qt; kg += NWAVES) {
            const bf16x8 B0 = nB0, B1 = nB1;
            { const int kn = (kg + NWAVES <= qt) ? kg + NWAVES : kg;
              nB0 = *(const bf16x8*)(KIDX + (rb + 16 * kn + fr) * 64 + 8 * fq); nB1 = *(const bf16x8*)(KIDX + (rb + 16 * kn + fr) * 64 + 32 + 8 * fq); }
#pragma unroll
            for (int tg = 0; tg < 4; ++tg) { float s = 0.f;
#pragma unroll
                for (int hh = 0; hh < 2; ++hh) { f32x4 acc = (f32x4){0.f, 0.f, 0.f, 0.f};
                    acc = __builtin_amdgcn_mfma_f32_16x16x32_bf16(Af[tg][hh][0], B0, acc, 0, 0, 0); acc = __builtin_amdgcn_mfma_f32_16x16x32_bf16(Af[tg][hh][1], B1, acc, 0, 0, 0);
#pragma unroll
                    for (int r = 0; r < 4; ++r) s += wv[tg][4 * hh + r] * fmaxf(acc[r], 0.f); }
                SC[(4 * tg + fq) * 2048 + 16 * kg + fr] = s + 0.0f; }
        }
        __syncthreads();
        for (int tq = 2 * w; tq < 2 * w + 2; ++tq) {
            const int t = t0 + tq;
            unsigned key[32];
#pragma unroll
            for (int r = 0; r < 32; ++r) { const int s = 64 * r + lane; key[r] = (s <= t) ? f2ord(SC[tq * 2048 + s]) : 0u; }
            unsigned long long selw = 0ull;
            if (t < TOPK) {
#pragma unroll
                for (int r = 0; r < 32; ++r) { const unsigned long long mk = __ballot(64 * r + lane <= t); if (lane == r) selw = mk; }
            } else {
                unsigned prefix = 0u; bool exact = false;
                for (int bit = 31; bit >= 0; --bit) {
                    const unsigned cand = prefix | (1u << bit); int cnt = 0;
#pragma unroll
                    for (int r = 0; r < 32; ++r) cnt += __builtin_popcountll(__ballot(key[r] >= cand));
                    if (cnt >= TOPK) { prefix = cand; if (cnt == TOPK) { exact = true; break; } }
                }
                if (exact) {
#pragma unroll
                    for (int r = 0; r < 32; ++r) { const unsigned long long mk = __ballot(key[r] >= prefix); if (lane == r) selw = mk; }
                } else {
                    int ngt = 0;
#pragma unroll
                    for (int r = 0; r < 32; ++r) ngt += __builtin_popcountll(__ballot(key[r] > prefix));
                    const int need = TOPK - ngt; int run = 0;
#pragma unroll
                    for (int r = 0; r < 32; ++r) { const unsigned long long tie = __ballot(key[r] == prefix); const int rk = run + __builtin_popcountll(tie & ((1ull << lane) - 1ull));
                        const unsigned long long mk = __ballot(key[r] > prefix || (key[r] == prefix && rk < need)); if (lane == r) selw = mk; run += __builtin_popcountll(tie); }
                }
            }
            if (lane < 32) MASK[(rb + t) * 32 + lane] = selw;
        }
        __syncthreads();
    }
}
__device__ __forceinline__ void dsa_attn_phase(Frame& F, const bf16_t* QLAT, const bf16_t* CKV, const unsigned long long* MASK, bf16_t* OLAT, unsigned char* OLAT8) {
    constexpr int TB = 32768;
    LAS unsigned char* L = F.lds;
    const int lane = F.lane, w = F.wave, fr = lane & 15, fq = lane >> 4;
    const int qq = fr >> 2, pp = lane & 3;
    const bool grpB = w >= 4;
    const int kbase = fr * 512, ysh = (fq ^ (2 * (fr & 7))) << 4;
    const int x2s = (2 * (4 * (fq & 1) + qq)) << 4;
    const int vbase = (4 * fq + qq) * 512 + (pp >> 1) * 16 + (pp & 1) * 8;
    const int drow = lane >> 5, dpc = lane & 31;
    for (int i = 0;; ++i) {
        const int u = i * F.G + F.c; if (u >= BATCH * (SEQ / 16)) break;
        const int b = (u & 255) >> 4, qlo = (u & 15) + 16 * (u >> 9), qt = ((u >> 8) & 1) ? 127 - qlo : qlo, t0 = 16 * qt;     const size_t rb = (size_t)b * SEQ;
        const int ntiles = (t0 + 15) / 64 + 1;
        bf16x8 Qf[8];
#pragma unroll
        for (int ks = 0; ks < 8; ++ks) Qf[ks] = *(const bf16x8*)(QLAT + (rb + t0 + fr) * 2048 + w * 256 + 32 * ks + 8 * fq);
        f32x4 Ot[16];
#pragma unroll
        for (int cb = 0; cb < 16; ++cb) Ot[cb] = (f32x4){0.f, 0.f, 0.f, 0.f};
        float mrun = -1.0e30f, lsum = 0.f;
        bf16x8 Pf[2];
#define ATT_DMA(kt_, buf_) do { _Pragma("unroll") for (int q_ = 0; q_ < 4; ++q_) { const int row_ = 2 * (4 * w + q_) + drow; \
            __builtin_amdgcn_global_load_lds((const unsigned*)(CKV + (rb + 64 * (kt_) + row_) * 256 + 8 * (dpc ^ (2 * (row_ & 7)))), (LAS unsigned*)(L + (buf_) * TB + (4 * w + q_) * 1024), 16, 0, 0); } } while (0)
#define ATT_ST(buf_) do { int ka_[8]; { const int kb_t_ = kbase + (buf_) * TB; _Pragma("unroll") for (int ks = 0; ks < 8; ++ks) ka_[ks] = kb_t_ + ((64 * ks) ^ ysh); } \
            _Pragma("unroll") for (int kb = 0; kb < 4; ++kb) S[kb] = (f32x4){0.f, 0.f, 0.f, 0.f}; \
            bf16x8 kf[2][2]; \
            _Pragma("unroll") for (int j = 0; j < 2; ++j) kf[0][j] = *(LAS bf16x8*)(L + ka_[j]); \
            _Pragma("unroll") for (int bt = 0; bt < 16; ++bt) {        \
                if (bt + 1 < 16) { _Pragma("unroll") for (int j = 0; j < 2; ++j) kf[(bt + 1) & 1][j] = *(LAS bf16x8*)(L + ka_[2 * ((bt + 1) & 3) + j] + 8192 * ((bt + 1) >> 2)); } \
                _Pragma("unroll") for (int j = 0; j < 2; ++j) S[bt >> 2] = __builtin_amdgcn_mfma_f32_16x16x32_bf16(kf[bt & 1][j], Qf[2 * (bt & 3) + j], S[bt >> 2], 0, 0, 0); \
                __builtin_amdgcn_sched_barrier(0); } } while (0)
#define ATT_SOFTMAX(mw_) do { \
            float mx = fmaxf(fmaxf(fmaxf(S[0][0], S[0][1]), fmaxf(S[0][2], S[0][3])), fmaxf(fmaxf(S[1][0], S[1][1]), fmaxf(S[1][2], S[1][3]))); \
            mx = fmaxf(mx, fmaxf(fmaxf(fmaxf(S[2][0], S[2][1]), fmaxf(S[2][2], S[2][3])), fmaxf(fmaxf(S[3][0], S[3][1]), fmaxf(S[3][2], S[3][3])))); \
            mx = fmaxf(mx, __shfl_xor(mx, 16)); mx = fmaxf(mx, __shfl_xor(mx, 32)); \
            const bool need = mx > mrun + 8.0f; \
            if (__any(need)) { const float mnew = need ? mx : mrun, alpha = fast_exp2(mrun - mnew); mrun = mnew; lsum *= alpha; \
                _Pragma("unroll") for (int cb = 0; cb < 16; ++cb) Ot[cb] = Ot[cb] * alpha; } \
            const unsigned long long mq = (mw_) >> (4 * fq); const unsigned mlo = (unsigned)mq, mhi = (unsigned)(mq >> 32); \
            _Pragma("unroll") for (int kb = 0; kb < 4; ++kb) _Pragma("unroll") for (int r = 0; r < 4; ++r) { \
                const unsigned mk = (unsigned)__builtin_amdgcn_sbfe((int)(kb < 2 ? mlo : mhi), 16 * (kb & 1) + r, 1); \
                const float pv = __uint_as_float(__float_as_uint(fast_exp2(S[kb][r] - mrun)) & mk); S[kb][r] = pv; lsum += pv; } \
            _Pragma("unroll") for (int s2 = 0; s2 < 2; ++s2) { const u32x4 pk = pack8(S[2 * s2], S[2 * s2 + 1]); Pf[s2] = __builtin_bit_cast(bf16x8, pk); } } while (0)
#define ATT_VLOAD(dst, vb_, cb_) do { const int va_ = (vb_) + ((32 * (cb_)) ^ x2s); \
            dst[0] = __builtin_amdgcn_ds_read_tr16_b64_v4i16((LAS s16x4*)(L + va_)); dst[1] = __builtin_amdgcn_ds_read_tr16_b64_v4i16((LAS s16x4*)(L + va_ + 16 * 512)); \
            dst[2] = __builtin_amdgcn_ds_read_tr16_b64_v4i16((LAS s16x4*)(L + va_ + 32 * 512)); dst[3] = __builtin_amdgcn_ds_read_tr16_b64_v4i16((LAS s16x4*)(L + va_ + 48 * 512)); } while (0)
#define ATT_PV(buf_) do { const int vb_ = vbase + (buf_) * TB; s16x4 tv[2][4]; ATT_VLOAD(tv[0], vb_, 0); \
            _Pragma("unroll") for (int cb = 0; cb < 16; ++cb) { \
                if (cb + 1 < 16) ATT_VLOAD(tv[(cb + 1) & 1], vb_, cb + 1); \
                const s16x4 a0 = tv[cb & 1][0], a1 = tv[cb & 1][1], a2 = tv[cb & 1][2], a3 = tv[cb & 1][3]; \
                const bf16x8 v0 = (bf16x8){a0[0], a0[1], a0[2], a0[3], a1[0], a1[1], a1[2], a1[3]}; \
                const bf16x8 v1 = (bf16x8){a2[0], a2[1], a2[2], a2[3], a3[0], a3[1], a3[2], a3[3]}; \
                Ot[cb] = __builtin_amdgcn_mfma_f32_16x16x32_bf16(v0, Pf[0], Ot[cb], 0, 0, 0); \
                Ot[cb] = __builtin_amdgcn_mfma_f32_16x16x32_bf16(v1, Pf[1], Ot[cb], 0, 0, 0); __builtin_amdgcn_sched_barrier(0); } } while (0)
        ATT_DMA(0, 0);
        unsigned long long mwn = MASK[(rb + t0 + fr) * 32];
        asm volatile("s_waitcnt vmcnt(0)" ::: "memory");
        __syncthreads();
        int bufc = 0;
        for (int it = 0; it < ntiles; ++it) {
            const int bufn = (bufc == 2) ? 0 : bufc + 1;
            if (it + 1 < ntiles) ATT_DMA(it + 1, bufn);
            const unsigned long long mw = mwn; mwn = MASK[(rb + t0 + fr) * 32 + ((it + 1 < ntiles) ? it + 1 : it)];
            f32x4 S[4];
            ATT_ST(bufc); ATT_SOFTMAX(mw);
            if (grpB) { asm volatile("s_waitcnt vmcnt(0)" ::: "memory"); __builtin_amdgcn_s_barrier(); asm volatile("" ::: "memory"); }
            ATT_PV(bufc);
            if (!grpB) { asm volatile("s_waitcnt vmcnt(0)" ::: "memory"); __builtin_amdgcn_s_barrier(); asm volatile("" ::: "memory"); }
            bufc = bufn;
        }
        __syncthreads();
#undef ATT_DMA
#undef ATT_ST
#undef ATT_SOFTMAX
#undef ATT_VLOAD
#undef ATT_PV
        lsum += __shfl_xor(lsum, 16); lsum += __shfl_xor(lsum, 32);
        const float inv = 1.f / lsum;
#pragma unroll
        for (int cb = 0; cb < 16; ++cb) {
            if (OLAT8) { const float i8 = inv * F8_O; *(unsigned*)(OLAT8 + (rb + t0 + fr) * 2048 + w * 256 + 16 * cb + 4 * fq) = pack4_fp8(Ot[cb][0] * i8, Ot[cb][1] * i8, Ot[cb][2] * i8, Ot[cb][3] * i8); }
            else { u32x2 o; o.x = cvt_pk_bf16(Ot[cb][0] * inv, Ot[cb][1] * inv); o.y = cvt_pk_bf16(Ot[cb][2] * inv, Ot[cb][3] * inv);
                *(u32x2*)(OLAT + (rb + t0 + fr) * 2048 + w * 256 + 16 * cb + 4 * fq) = o; } }
    }
}

constexpr int PH_PER_PAIR = 18, N_PHASES = 1 + 2 * PH_PER_PAIR;

__global__ void __launch_bounds__(NTHREADS, 2) fwd_kernel(Params p) {
    extern __shared__ __attribute__((aligned(16))) unsigned char lds_raw[];
    Frame F;
    F.lds = (LAS unsigned char*)lds_raw;
    F.tid = threadIdx.x; F.lane = F.tid & 63; F.wave = __builtin_amdgcn_readfirstlane(F.tid >> 6);
    F.G = gridDim.x; F.c = blockIdx.x;
    unsigned char* ws = p.ws;
    F.ctl = (unsigned*)(ws + WS_CTL);
    for (int u = F.tid; u < (LDS_BYTES - LDSCTL_OFF) / 4; u += NTHREADS) ((LAS unsigned*)(F.lds + LDSCTL_OFF))[u] = 0u;
    __syncthreads();
    const bool one_launch = (p.ph_hi - p.ph_lo) > 1;
    XcdBarrier bar; bar.bar = F.ctl + CW_BAR; bar.x = 0; bar.st = nullptr;
    if (one_launch) bar = xcd_barrier_post(F.ctl + CW_BAR, (volatile LAS unsigned*)(F.lds + MISC_OFF) + 8);
    const int lo = p.ph_lo, hi = p.ph_hi;
#define REFRESH() do { int t_ = threadIdx.x; asm volatile("" : "+v"(t_)); F.tid = t_; F.lane = t_ & 63; F.wave = __builtin_amdgcn_readfirstlane(t_ >> 6); } while (0)
#ifndef DBLMASK
#define DBLMASK 0u
#endif
#define REP(b) for (int rep_ = 0; rep_ < 1 + (int)((DBLMASK >> (b)) & 1u); ++rep_)
#define IN(k) (lo <= (k) && (k) < hi)
#ifndef MK_BARTIME
#define MK_BARTIME 0
#endif
    unsigned long long bt_acc = 0ull;
#if MK_BARTIME
#define SEAM(k) do { if (IN(k) && IN((k) + 1)) { const unsigned long long t0_ = __builtin_amdgcn_s_memrealtime(); xcd_barrier(bar); bt_acc += __builtin_amdgcn_s_memrealtime() - t0_; } } while (0)
#else
#ifndef MK_DBLSEAM
#define MK_DBLSEAM 0
#endif
#define SEAM(k) do { if (IN(k) && IN((k) + 1)) { xcd_barrier(bar); if (MK_DBLSEAM) xcd_barrier(bar); } } while (0)
#endif

    bf16_t* XB = (bf16_t*)(ws + WS_XB); bf16_t* Y = (bf16_t*)(ws + WS_Y);
    unsigned char* A = ws + WS_A; bf16_t* Hb = (bf16_t*)(ws + WS_H);

    if (IN(0)) REP(31) { REFRESH(); p0_prologue(F, p); } SEAM(0);

    for (int j = 0; j < 2; ++j) {
        const int pb = 1 + j * PH_PER_PAIR;
        const int layerA = 2 * j, layerB = 2 * j + 1;
        if (IN(pb + 0)) REP(0) {
            Gemm g{XB, (const bf16_t*)(ws + WS_W_HGIN) + (size_t)j * 4 * D * D, D}; StaticOrder S; S.init(M, 4 * D, F.G, F.c);
            EpiHgIn E{(bf16_t*)(A + A_HQ)};
            gemm_phase(F.lds, g, S, E);
        } SEAM(pb + 0);
        if (IN(pb + 1)) REP(1) { REFRESH(); hgrn_phase(F, (const bf16_t*)(A + A_HQ), (const bf16_t*)(A + A_HF), (const bf16_t*)(A + A_HV), INP(IN_HGLB), j, (bf16_t*)(A + A_HO)); } SEAM(pb + 1);
        if (IN(pb + 2)) REP(2) { REFRESH(); hgrn_gate_phase(F, (const bf16_t*)(A + A_HO), (const bf16_t*)(A + A_HG), INP(IN_HGNG) + (size_t)j * D, (bf16_t*)(A + A_HOG)); } SEAM(pb + 2);
        if (IN(pb + 3)) REP(3) {
            Gemm g{(const bf16_t*)(A + A_HOG), (const bf16_t*)(ws + WS_W_HGOUT) + (size_t)j * D * D, D}; StaticOrder S; S.init(M, D, F.G, F.c);
            EpiRes E{XB, Y}; gemm_phase(F.lds, g, S, E);
        } SEAM(pb + 3);
        if (IN(pb + 4)) REP(4) { REFRESH(); ln_phase(F, Y, INP(IN_LNG) + (size_t)(layerA * 2 + 0) * D, INP(IN_LNB) + (size_t)(layerA * 2 + 0) * D, XB, (MK_FFN_FP8 == 2) ? ws + WS_XB8 : nullptr); } SEAM(pb + 4);
        if (IN(pb + 5)) REP(5) {
#if MK_FFN_FP8 == 2
            Gemm g{(const bf16_t*)(ws + WS_XB8), (const bf16_t*)(ws + WS_W_FGU + (size_t)j * 2 * DFF * D), D / 2, SC_UP}; StaticOrder S; S.init(M, 2 * DFF, F.G, F.c);
            EpiSwiglu8 E{(unsigned char*)Hb}; gemm_phase_gather<true, true>(F.lds, g, S, E, nullptr);
#elif MK_FFN_FP8 == 1
            Gemm g{XB, (const bf16_t*)(ws + WS_W_FGU) + (size_t)j * 2 * DFF * D, D}; StaticOrder S; S.init(M, 2 * DFF, F.G, F.c);
            EpiSwiglu8 E{(unsigned char*)Hb}; gemm_phase(F.lds, g, S, E);
#else
            Gemm g{XB, (const bf16_t*)(ws + WS_W_FGU) + (size_t)j * 2 * DFF * D, D}; StaticOrder S; S.init(M, 2 * DFF, F.G, F.c);
            EpiSwiglu E{Hb}; gemm_phase(F.lds, g, S, E);
#endif
        } SEAM(pb + 5);
        if (IN(pb + 6)) REP(6) {
#if MK_FFN_FP8 >= 1
            Gemm g{Hb, (const bf16_t*)(ws + WS_W_FDN + (size_t)j * D * DFF), DFF / 2, SC_DN}; StaticOrder S; S.init(M, D, F.G, F.c);
            EpiRes E{XB, Y}; gemm_phase_gather<true, true>(F.lds, g, S, E, nullptr);
#else
            Gemm g{Hb, (const bf16_t*)(ws + WS_W_FDN) + (size_t)j * D * DFF, DFF}; StaticOrder S; S.init(M, D, F.G, F.c);
            EpiRes E{XB, Y}; gemm_phase(F.lds, g, S, E);
#endif
        } SEAM(pb + 6);
        if (IN(pb + 7)) REP(7) { REFRESH(); ln_phase(F, Y, INP(IN_LNG) + (size_t)(layerA * 2 + 1) * D, INP(IN_LNB) + (size_t)(layerA * 2 + 1) * D, XB, nullptr); } SEAM(pb + 7);
        if (IN(pb + 8)) REP(8) {
            Gemm g{XB, (const bf16_t*)(ws + WS_W_DIN) + (size_t)j * DSA_IN_PAD * D, D}; StaticOrder S; S.init(M, DSA_IN_PAD, F.G, F.c);
            EpiBf16 E{(bf16_t*)(A + A_RAW), DSA_IN_PAD}; gemm_phase(F.lds, g, S, E);
        } SEAM(pb + 8);
        if (IN(pb + 9)) REP(9) { REFRESH(); dsa_norm_phase(F, (const bf16_t*)(A + A_RAW), INP(IN_DQNG) + (size_t)j * QR, INP(IN_DKVNG) + (size_t)j * KVR, INP(IN_DKIG) + (size_t)j * IDXD, INP(IN_DKIB) + (size_t)j * IDXD,
                                         (bf16_t*)(A + A_CQ), (bf16_t*)(A + A_CKV), (bf16_t*)(A + A_KIDX), (float*)(A + A_WIDX)); } SEAM(pb + 9);
        if (IN(pb + 10)) REP(10) {
            Gemm g{(const bf16_t*)(A + A_CQ), (const bf16_t*)(ws + WS_W_DQ) + (size_t)j * 2560 * QR, QR}; StaticOrder S; S.init(M, 2560, F.G, F.c);
            EpiQ E{(bf16_t*)(A + A_QLAT), (bf16_t*)(A + A_QIDX)}; gemm_phase(F.lds, g, S, E);
        } SEAM(pb + 10);
        if (IN(pb + 11)) REP(11) { REFRESH(); dsa_index_phase(F, (const bf16_t*)(A + A_QIDX), (const bf16_t*)(A + A_KIDX), (const float*)(A + A_WIDX), (unsigned long long*)(A + A_MASK)); } SEAM(pb + 11);
        if (IN(pb + 12)) REP(12) { REFRESH(); dsa_attn_phase(F, (const bf16_t*)(A + A_QLAT), (const bf16_t*)(A + A_CKV), (const unsigned long long*)(A + A_MASK), (bf16_t*)(A + A_OLAT), MK_B6_FP8 ? A + A_OLAT : nullptr); } SEAM(pb + 12);
        if (IN(pb + 13)) REP(13) {
#if MK_B6_FP8
            Gemm g{(const bf16_t*)(A + A_OLAT), (const bf16_t*)(ws + WS_W_DO + (size_t)j * D * 2048), 1024, SC_DO}; StaticOrder S; S.init(M, D, F.G, F.c);
            EpiRes E{XB, Y}; gemm_phase_gather<true, true>(F.lds, g, S, E, nullptr);
#else
            Gemm g{(const bf16_t*)(A + A_OLAT), (const bf16_t*)(ws + WS_W_DO) + (size_t)j * D * 2048, 2048}; StaticOrder S; S.init(M, D, F.G, F.c);
            EpiRes E{XB, Y}; gemm_phase(F.lds, g, S, E);
#endif
        } SEAM(pb + 13);
        if (IN(pb + 14)) REP(14) { REFRESH(); ln_router_phase(F, Y, INP(IN_LNG) + (size_t)(layerB * 2 + 0) * D, INP(IN_LNB) + (size_t)(layerB * 2 + 0) * D, INP(IN_MR) + (size_t)j * D * NEXP, XB, MK_MOE_FP8 ? ws + WS_XB8 : nullptr,
                                           (int*)(A + A_EIDX), (int*)(A + A_POS), (int*)(A + A_TOK), (float*)(A + A_GW), F.ctl + CW_MOE + 64 * j); } SEAM(pb + 14);
        if (IN(pb + 15)) REP(15) {
#if MK_MOE_FP8
            Gemm g{(const bf16_t*)(ws + WS_XB8), (const bf16_t*)(ws + WS_W_MGU8 + (size_t)j * NEXP * 2 * DFF * D), D / 2, SC_UP}; MoeOrder S; S.init(F.ctl + CW_MOE + 64 * j, 2 * DFF / BM, F.G, F.c);
            EpiSwiglu8 E{(unsigned char*)Hb}; gemm_phase_gather<true>(F.lds, g, S, E, (const int*)(A + A_TOK));
#else
            Gemm g{XB, (const bf16_t*)(ws + WS_W_MGU) + (size_t)j * NEXP * 2 * DFF * D, D}; MoeOrder S; S.init(F.ctl + CW_MOE + 64 * j, 2 * DFF / BM, F.G, F.c);
            EpiSwiglu E{Hb}; gemm_phase_gather(F.lds, g, S, E, (const int*)(A + A_TOK));
#endif
        } SEAM(pb + 15);
        if (IN(pb + 16)) REP(16) {
#if MK_MOE_FP8
            Gemm g{Hb, (const bf16_t*)(ws + WS_W_MDN8 + (size_t)j * NEXP * D * DFF), DFF / 2, SC_DN}; MoeOrder S; S.init(F.ctl + CW_MOE + 64 * j, D / BM, F.G, F.c);
            EpiMoeDn E{(bf16_t*)(A + A_OUTM), (const float*)(A + A_GW)}; gemm_phase_gather<true, true>(F.lds, g, S, E, nullptr);
#else
            Gemm g{Hb, (const bf16_t*)(ws + WS_W_MDN) + (size_t)j * NEXP * D * DFF, DFF}; MoeOrder S; S.init(F.ctl + CW_MOE + 64 * j, D / BM, F.G, F.c);
            EpiMoeDn E{(bf16_t*)(A + A_OUTM), (const float*)(A + A_GW)}; gemm_phase(F.lds, g, S, E);
#endif
        } SEAM(pb + 16);
        if (IN(pb + 17)) REP(17) { REFRESH(); ln_moe_phase(F, XB, (const bf16_t*)(A + A_OUTM), (const int*)(A + A_EIDX), (const int*)(A + A_POS), F.ctl + CW_MOE + 64 * j,
                                        INP(IN_LNG) + (size_t)(layerB * 2 + 1) * D, INP(IN_LNB) + (size_t)(layerB * 2 + 1) * D, XB, (j == 1) ? p.out : nullptr); } SEAM(pb + 17);
    }
#if MK_BARTIME
    if (one_launch) {
        if (blockIdx.x == 0 && threadIdx.x == 0) __hip_atomic_store(F.ctl + 3000, (unsigned)bt_acc, __ATOMIC_RELAXED, __HIP_MEMORY_SCOPE_AGENT);
        xcd_barrier(bar);
        const float cval = 2.0f + 4.0f * (float)__hip_atomic_load(F.ctl + 3000, __ATOMIC_RELAXED, __HIP_MEMORY_SCOPE_AGENT) * 1e-5f;
        for (size_t i = (size_t)blockIdx.x * NTHREADS + threadIdx.x; i < (size_t)M * D; i += (size_t)gridDim.x * NTHREADS) p.out[i] = cval;
    }
#endif
}


#if MK_DEBUG_SCAN
__global__ void scan_kernel(const void* ptr, size_t n, int is_bf16, unsigned code, unsigned* flag, const unsigned* gcnt, size_t row_elems) {
    size_t nn = n;
    if (gcnt) { unsigned t = 0; for (int e = 0; e < 8; ++e) t += (gcnt[e] + 255u) >> 8; nn = (size_t)t * 256 * row_elems; }
    bool bad = false;
    for (size_t i = (size_t)blockIdx.x * blockDim.x + threadIdx.x; i < nn; i += (size_t)gridDim.x * blockDim.x) {
        if (is_bf16) { const unsigned short v = ((const unsigned short*)ptr)[i]; bad |= (v & 0x7f80u) == 0x7f80u; }
        else { const unsigned v = ((const unsigned*)ptr)[i]; bad |= (v & 0x7f800000u) == 0x7f800000u; }
    }
    if (bad) atomicMin(flag, code);
}
__global__ void fin_kernel(float* out, size_t n, const unsigned* flag) {
    const unsigned f = *flag; if (f == 0xffffffffu) return;
    const float cval = (float)f + 0.25f * (float)flag[64];
    for (size_t i = (size_t)blockIdx.x * blockDim.x + threadIdx.x; i < n; i += (size_t)gridDim.x * blockDim.x) out[i] = cval;
}

__global__ void chk_a1_kernel(const float* x, const float* w, const bf16_t* Q, const float* FP, unsigned code, unsigned* flag) {
    const unsigned id = blockIdx.x * blockDim.x + threadIdx.x;
    unsigned hsh = id * 2654435761u + 12345u; hsh ^= hsh >> 13; hsh *= 0x5bd1e995u; hsh ^= hsh >> 15;
    const int row = hsh % M, col = (hsh >> 15) % (4 * D);
    float ref = 0.f; for (int k = 0; k < D; ++k) ref += x[(size_t)row * D + k] * w[(size_t)k * 4 * D + col];
    const int part = col >> 10, cc = col & 1023;
    float got;
    if (part == 1) got = FP[(size_t)row * D + cc];
    else got = bf2f(Q[(size_t)(part == 0 ? 0 : part - 1) * M * D + (size_t)row * D + cc]);
    if (!(fabsf(got - ref) < 0.08f)) atomicMin(flag, code);
}
__global__ void chk_hgrn_kernel(const bf16_t* Q, const float* FP, const bf16_t* V, const bf16_t* O, unsigned* bits) {
    const int sample = blockIdx.x, lane = threadIdx.x;
    const int b = sample % BATCH, h = (sample / BATCH) % HG_H, e = (sample * 37 + 11) % 128;
    float s0 = 0.f, s1 = 0.f; unsigned r = 0;
    for (int t = 0; t < 128; ++t) {
        const size_t base = ((size_t)b * SEQ + t) * D + h * 128;
        const float f0 = sigmoidf_(FP[base + lane]), f1 = sigmoidf_(FP[base + lane + 64]);
        const float v = bf2f(V[base + e]);
        s0 = f0 * s0 + (1.f - f0) * v; s1 = f1 * s1 + (1.f - f1) * v;
        const float o = wave_sum(bf2f(Q[base + lane]) * s0 + bf2f(Q[base + lane + 64]) * s1);
        const unsigned short gb = O[base + e]; const float got = bf2f(gb);
        const bool nf = (gb & 0x7f80u) == 0x7f80u;
        if (t < 64) { if (nf) r |= 4u; else if (!(fabsf(got - o) < 0.05f + 0.03f * fabsf(o))) r |= 2u; }
        else if (nf) r |= 1u;
    }
    if (r && lane == 0) atomicOr(bits, r);
}
__global__ void flaginit_kernel(unsigned* flag) { *flag = 0xffffffffu; }
#endif

extern "C" void kernel_launch(void* const* d_in, const int* in_sizes, int n_in, void* d_out, int out_size, void* d_ws, size_t ws_size, hipStream_t stream) {
    static int grid = 0;
    if (grid == 0) {
        if (n_in != 22 || out_size != M * D || ws_size < WS_END) { fprintf(stderr, "kernel_launch: unexpected problem (n_in %d out %d ws %zu need %zu)\n", n_in, out_size, ws_size, (size_t)WS_END); grid = -1; return; }
        int dev = 0, cus = 0, per_cu = 0;
        if (hipGetDevice(&dev) != hipSuccess || hipDeviceGetAttribute(&cus, hipDeviceAttributeMultiprocessorCount, dev) != hipSuccess) { grid = -1; return; }
        if (hipFuncSetAttribute((const void*)fwd_kernel, hipFuncAttributeMaxDynamicSharedMemorySize, LDS_BYTES) != hipSuccess) { fprintf(stderr, "kernel_launch: hipFuncSetAttribute failed\n"); grid = -1; return; }
        if (hipOccupancyMaxActiveBlocksPerMultiprocessor(&per_cu, (const void*)fwd_kernel, NTHREADS, LDS_BYTES) != hipSuccess || per_cu < 1) fprintf(stderr, "kernel_launch: occupancy query reports %d\n", per_cu);
        grid = cus;
    }
    if (grid <= 0) return;
    (void)hipMemsetAsync((char*)d_ws + WS_CTL, 0, CTL_ZERO_BYTES, stream);
    Params p{};
    for (int i = 0; i < 22; ++i) p.in[i] = (const float*)d_in[i];
    p.out = (float*)d_out; p.ws = (unsigned char*)d_ws;
#if MK_N_LAUNCHES == 1
    p.ph_lo = 0; p.ph_hi = N_PHASES;
    hipLaunchKernelGGL(fwd_kernel, dim3(grid), dim3(NTHREADS), LDS_BYTES, stream, p);
#ifdef MK_EXTRA_PHASES
    { const int extra[] = {MK_EXTRA_PHASES}; for (int r = 0; r < MK_EXTRA_REPS; ++r) for (int k : extra) { p.ph_lo = k; p.ph_hi = k + 1; hipLaunchKernelGGL(fwd_kernel, dim3(grid), dim3(NTHREADS), LDS_BYTES, stream, p); } }
#endif
#else
#if MK_DEBUG_SCAN
    unsigned char* ws = (unsigned char*)d_ws; unsigned* flag = (unsigned*)(ws + WS_CTL) + 2048;
    hipLaunchKernelGGL(flaginit_kernel, dim3(1), dim3(1), 0, stream, flag);
#define SCAN(ptr, n, isbf, k) hipLaunchKernelGGL(scan_kernel, dim3(1024), dim3(256), 0, stream, (const void*)(ptr), (size_t)(n), isbf, (unsigned)((k) + 1), flag, (const unsigned*)nullptr, (size_t)0)
#define SCANM(ptr, re, isbf, k, jj) hipLaunchKernelGGL(scan_kernel, dim3(1024), dim3(256), 0, stream, (const void*)(ptr), (size_t)0, isbf, (unsigned)((k) + 1), flag, (const unsigned*)(ws + WS_CTL) + CW_MOE + 64 * (jj), (size_t)(re))
#endif
    for (int k = 0; k < N_PHASES; ++k) { p.ph_lo = k; p.ph_hi = k + 1; hipLaunchKernelGGL(fwd_kernel, dim3(grid), dim3(NTHREADS), LDS_BYTES, stream, p);
#if MK_DEBUG_SCAN
        unsigned char* A = ws + WS_A; const size_t MD = (size_t)M * D;
        if (k == 0) { SCAN(ws + WS_W_HGIN, 2 * 4 * MD / M * D, 1, k); SCAN(ws + WS_W_HGOUT, 2 * (size_t)D * D, 1, k); SCAN(ws + WS_W_FGU, 2 * (size_t)2 * DFF * D, 1, k); SCAN(ws + WS_W_FDN, 2 * (size_t)DFF * D, 1, k);
            SCAN(ws + WS_W_DIN, 2 * (size_t)DSA_IN_PAD * D, 1, k); SCAN(ws + WS_W_DQ, 2 * (size_t)2560 * QR, 1, k); SCAN(ws + WS_W_DO, 2 * (size_t)D * 2048, 1, k);
            SCAN(ws + WS_W_MGU, 16 * (size_t)2 * DFF * D, 1, k); SCAN(ws + WS_W_MDN, 16 * (size_t)DFF * D, 1, k); SCAN(ws + WS_XB, MD, 1, k); }
        else { const int l = (k - 1) % PH_PER_PAIR, jj = (k - 1) / PH_PER_PAIR;
            switch (l) {
            case 0: SCAN(A + A_HQ, 3 * MD, 1, k); SCAN(A + A_HF, MD, 0, k);
                if (jj == 0) hipLaunchKernelGGL(chk_a1_kernel, dim3(64), dim3(256), 0, stream, (const float*)d_in[IN_X], (const float*)d_in[IN_HGWIN], (const bf16_t*)(A + A_HQ), (const float*)(A + A_HF), (unsigned)(k + 1), flag);
                break;
            case 1: SCAN(A + A_HO, MD, 1, k);
                if (jj == 0) hipLaunchKernelGGL(chk_hgrn_kernel, dim3(256), dim3(64), 0, stream, (const bf16_t*)(A + A_HQ), (const float*)(A + A_HF), (const bf16_t*)(A + A_HV), (const bf16_t*)(A + A_HO), flag + 64);
                break;
            case 2: SCAN(A + A_HOG, MD, 1, k); break;
            case 3: case 6: case 13: SCAN(ws + WS_Y, MD, 1, k); break;
            case 4: case 7: case 14: SCAN(ws + WS_XB, MD, 1, k); break;
            case 5: SCAN(ws + WS_H, (size_t)M * DFF, 1, k); break;
            case 8: SCAN(A + A_RAW, (size_t)M * DSA_IN_PAD, 0, k); break;
            case 9: SCAN(A + A_CQ, (size_t)M * 256, 1, k); SCAN(A + A_CKV, (size_t)M * 256, 1, k); SCAN(A + A_KIDX, (size_t)M * 64, 1, k); SCAN(A + A_WIDX, (size_t)M * 8, 0, k); break;
            case 10: SCAN(A + A_QLAT, (size_t)M * 2048, 1, k); SCAN(A + A_QIDX, (size_t)M * 512, 1, k); break;
            case 12: SCAN(A + A_OLAT, (size_t)M * 2048, 1, k); break;
            case 16: SCANM(ws + WS_H, DFF, 1, k, jj); break;
            case 17: SCANM(A + A_OUTM, D, 0, k, jj); break;
            case 18: if (jj == 0) SCAN(ws + WS_XB, MD, 1, k); else SCAN(d_out, MD, 0, k); break;
            default: break; } }
#endif
    }
#if MK_DEBUG_SCAN
    hipLaunchKernelGGL(fin_kernel, dim3(1024), dim3(256), 0, stream, (float*)d_out, (size_t)M * D, (const unsigned*)flag);
#endif
#endif
}
```

```cpp
#include <hip/hip_runtime.h>
#include <cstdio>
#include <cstdint>

#ifndef MK_DEBUG_SCAN
#define MK_DEBUG_SCAN 0
#endif
#ifndef MK_MOE_FP8
#define MK_MOE_FP8 1
#endif
#ifndef MK_FFN_FP8
#define MK_FFN_FP8 2
#endif
#ifndef MK_ATT_FP8
#define MK_ATT_FP8 1
#endif
#ifndef MK_B6_FP8
#define MK_B6_FP8 1
#endif
#ifndef MK_N_LAUNCHES
#define MK_N_LAUNCHES 1
#endif

#define GAS __attribute__((address_space(1)))
#define LAS __attribute__((address_space(3)))
typedef unsigned short bf16_t;
typedef short bf16x8 __attribute__((ext_vector_type(8)));
typedef short s16x4 __attribute__((ext_vector_type(4)));
typedef float f32x4 __attribute__((ext_vector_type(4)));
typedef float f32x2 __attribute__((ext_vector_type(2)));
typedef unsigned u32x4 __attribute__((ext_vector_type(4)));
typedef unsigned u32x2 __attribute__((ext_vector_type(2)));
typedef int v8i32 __attribute__((ext_vector_type(8)));
typedef int v4i32 __attribute__((ext_vector_type(4)));

constexpr int D = 1024, BATCH = 16, SEQ = 2048, M = BATCH * SEQ;
constexpr int DFF = 3584, NEXP = 8;
constexpr int HG_H = 8, HG_DK = 128, HG_C = 64;
constexpr int QR = 256, KVR = 256, IDXD = 64, IDXH = 8, DSA_H = 8, DSA_HD = 128, TOPK = 256;
constexpr int DSA_IN = 584, DSA_IN_PAD = 768;
constexpr int MOE_ROWS = 2 * M + NEXP * 256;
constexpr float ALPHA = 1.6817928305074290f;
constexpr float LN_EPS = 1e-5f, RMS_EPS = 1e-6f;
constexpr int NWAVES = 8, NTHREADS = 512;

constexpr size_t MiB = 1u << 20;
constexpr size_t WS_CTL = 0, CTL_ZERO_BYTES = 1 * MiB;
constexpr size_t WS_W_HGIN = 1 * MiB;
constexpr size_t WS_W_HGOUT = 17 * MiB;
constexpr size_t WS_W_FGU = 21 * MiB;
constexpr size_t WS_W_FDN = 49 * MiB;
constexpr size_t WS_W_DIN = 63 * MiB;
constexpr size_t WS_W_DQ = 66 * MiB;
constexpr size_t WS_W_DO = 69 * MiB;
constexpr size_t WS_W_MGU = 77 * MiB;
constexpr size_t WS_W_MDN = 301 * MiB;
constexpr size_t WS_XB8 = 416 * MiB;
constexpr size_t WS_W_MGU8 = 77 * MiB;
constexpr size_t WS_W_MDN8 = 192 * MiB;
constexpr size_t WS_XB = 544 * MiB;
constexpr size_t WS_Y = 608 * MiB;
constexpr size_t WS_A = 736 * MiB;
constexpr size_t WS_H = 1184 * MiB;
constexpr size_t WS_END = 1648 * MiB;
constexpr size_t A_HQ = 0, A_HF = 64 * MiB, A_HV = 128 * MiB, A_HG = 192 * MiB, A_HO = 320 * MiB, A_HOG = 384 * MiB;
constexpr size_t A_RAW = 0, A_CQ = 96 * MiB, A_CKV = 112 * MiB, A_KIDX = 128 * MiB, A_WIDX = 132 * MiB, A_MASK = 136 * MiB, A_QLAT = 144 * MiB, A_QIDX = 272 * MiB, A_OLAT = 304 * MiB;
constexpr size_t A_OUTM = 136 * MiB, A_EIDX = 404 * MiB, A_POS = 405 * MiB, A_TOK = 406 * MiB, A_GW = 407 * MiB;
constexpr int CW_BAR = 4096, CW_MOE = 16384;

constexpr int RING_BYTES = 131072;
constexpr int LDSCTL_OFF = RING_BYTES, MISC_OFF = LDSCTL_OFF + 320;
constexpr int STAGE_TOKL = RING_BYTES + 2048;
constexpr int LDS_BYTES = 147456;

typedef __bf16 hwbf16x2 __attribute__((ext_vector_type(2)));
__device__ __forceinline__ unsigned cvt_pk_bf16(float lo, float hi) { const f32x2 v = {lo, hi}; const hwbf16x2 b = __builtin_convertvector(v, hwbf16x2); return __builtin_bit_cast(unsigned, b); }
__device__ __forceinline__ bf16_t f2bf(float f) { return (bf16_t)(cvt_pk_bf16(f, 0.f) & 0xffffu); }
__device__ __forceinline__ float bf2f(bf16_t b) { return __uint_as_float(((unsigned)b) << 16); }
__device__ __forceinline__ float wave_sum(float v) {
    v += __builtin_bit_cast(float, __builtin_amdgcn_update_dpp(0, __builtin_bit_cast(int, v), 0xB1, 0xF, 0xF, true));
    v += __builtin_bit_cast(float, __builtin_amdgcn_update_dpp(0, __builtin_bit_cast(int, v), 0x4E, 0xF, 0xF, true));
    v += __builtin_bit_cast(float, __builtin_amdgcn_update_dpp(0, __builtin_bit_cast(int, v), 0x141, 0xF, 0xF, true));
    v += __builtin_bit_cast(float, __builtin_amdgcn_update_dpp(0, __builtin_bit_cast(int, v), 0x140, 0xF, 0xF, true));
    const float r0 = __builtin_bit_cast(float, __builtin_amdgcn_readlane(__builtin_bit_cast(int, v), 0)), r1 = __builtin_bit_cast(float, __builtin_amdgcn_readlane(__builtin_bit_cast(int, v), 16));
    const float r2 = __builtin_bit_cast(float, __builtin_amdgcn_readlane(__builtin_bit_cast(int, v), 32)), r3 = __builtin_bit_cast(float, __builtin_amdgcn_readlane(__builtin_bit_cast(int, v), 48));
    return (r0 + r1) + (r2 + r3);
}
__device__ __forceinline__ float fast_exp2(float x) { return __builtin_amdgcn_exp2f(x); }
__device__ __forceinline__ float fast_rcp(float x) { return __builtin_amdgcn_rcpf(x); }
__device__ __forceinline__ float sigmoidf_(float x) { return fast_rcp(1.0f + __expf(-x)); }
__device__ __forceinline__ float siluf_(float x) { return x * sigmoidf_(x); }
#define LDS_WAIT() asm volatile("s_waitcnt lgkmcnt(0)" ::: "memory")
#define VM_WAIT() asm volatile("s_waitcnt vmcnt(0)" ::: "memory")

#define XB_TMO      128
#define XB_XCNT(j)  (256  + 64 * (j))
#define XB_XSUB(j)  (1280 + 64 * (j))
#define XB_XGEN(j)  (2304 + 64 * (j))
#define XB_TOP      3328
#define XB_TOPGEN   3392
#define XCD_BAR_WORDS 3456
#define XB_SPIN_CAP (1u << 20)

__device__ __forceinline__ unsigned xb_ld(unsigned* p)              { return __hip_atomic_load(p, __ATOMIC_RELAXED, __HIP_MEMORY_SCOPE_AGENT); }
__device__ __forceinline__ unsigned xb_add(unsigned* p, unsigned v) { return __hip_atomic_fetch_add(p, v, __ATOMIC_RELAXED, __HIP_MEMORY_SCOPE_AGENT); }
__device__ __forceinline__ unsigned xb_xcc_id() { return (unsigned)__builtin_amdgcn_s_getreg((3 << 11) | 20) & 0xFu; }
#define XB_SPIN(cond, bar) do { unsigned _sp = 0; while (cond) { __builtin_amdgcn_s_sleep(1); \
    if ((++_sp & 255u) == 0u) { if (xb_ld(&(bar)[XB_TMO])) break; if (_sp > XB_SPIN_CAP) { atomicAdd(&(bar)[XB_TMO], 1u); break; } } } } while (0)

struct XcdBarrier { unsigned* bar; unsigned x; volatile LAS unsigned* st; };

__device__ __forceinline__ XcdBarrier xcd_barrier_post(unsigned* bar, volatile LAS unsigned* st) {
    XcdBarrier b; b.bar = bar; b.x = xb_xcc_id(); b.st = st;
    if (threadIdx.x == 0) (void)xb_add(&bar[XB_XCNT(b.x)], 1u);
    return b;
}
__device__ __forceinline__ void xcd_barrier_complete(unsigned* bar, unsigned x, unsigned& nloc, unsigned& nx) {
    const unsigned G = gridDim.x * gridDim.y * gridDim.z;
    unsigned sum, cnt, mine, sp = 0u;
    for (;;) {
        sum = 0u; cnt = 0u; mine = 0u;
#pragma unroll
        for (unsigned j = 0; j < 16; ++j) { const unsigned c = xb_ld(&bar[XB_XCNT(j)]); sum += c; cnt += (c > 0u) ? 1u : 0u; mine = (j == x) ? c : mine; }
        if (sum == G) break;
        __builtin_amdgcn_s_sleep(1);
        if ((++sp & 255u) == 0u) { if (xb_ld(&bar[XB_TMO])) break; if (sp > XB_SPIN_CAP) { atomicAdd(&bar[XB_TMO], 1u); break; } }
    }
    nloc = mine > 0u ? mine : 1u; nx = cnt > 0u ? cnt : 1u;
}
__device__ __forceinline__ void xcd_barrier(const XcdBarrier& b) {
    asm volatile("s_waitcnt vmcnt(0)" ::: "memory");
    __syncthreads();
    if (threadIdx.x == 0) {
        unsigned* bar = b.bar;
        __builtin_amdgcn_s_waitcnt(0);
        unsigned nloc = b.st[0], nx = b.st[1];
        if (nloc == 0u) { xcd_barrier_complete(bar, b.x, nloc, nx); b.st[0] = nloc; b.st[1] = nx; }
        const unsigned old = xb_add(&bar[XB_XSUB(b.x)], 1u);
        const unsigned gen = old / nloc;
        if (old + 1u == (gen + 1u) * nloc) {
            __builtin_amdgcn_fence(__ATOMIC_RELEASE, "agent");
            asm volatile("s_waitcnt vmcnt(0)" ::: "memory");
            const unsigned og = xb_add(&bar[XB_TOP], 1u);
            const unsigned tg = og / nx;
            if (og + 1u == (tg + 1u) * nx) xb_add(&bar[XB_TOPGEN], 1u);
            else XB_SPIN(xb_ld(&bar[XB_TOPGEN]) == tg, bar);
            __builtin_amdgcn_fence(__ATOMIC_ACQUIRE, "agent");
            xb_add(&bar[XB_XGEN(b.x)], 1u);
            asm volatile("s_waitcnt vmcnt(0)" ::: "memory");
        } else {
            XB_SPIN(xb_ld(&bar[XB_XGEN(b.x)]) == gen, bar);
            __builtin_amdgcn_fence(__ATOMIC_ACQUIRE, "agent");
            asm volatile("s_waitcnt vmcnt(0)" ::: "memory");
        }
    }
    __syncthreads();
}

constexpr int BM = 256, BK = 64, HALF = 128, HTB = HALF * BK * 2, NXCD = 8, WGM = 8;
__device__ __forceinline__ int lds_byte(int r, int c) { const int st = (r >> 4) * 2 + (c >> 5), rr = r & 15, cc = c & 31, ob = rr * 64 + cc * 2; return st * 1024 + (ob ^ (((ob >> 9) & 1) << 5)); }
__device__ __forceinline__ void stage_rc(int b, int& R, int& C) { const int st = b / 1024, sb = b % 1024, swz = sb ^ (((sb >> 9) & 1) << 5); R = (st >> 1) * 16 + swz / 64; C = (st & 1) * 32 + (swz % 64) / 2; }
__device__ __forceinline__ int perm32(int rho) { const int n = rho >> 4, i = rho & 15; return 8 * (i >> 2) + 4 * n + (i & 3); }

struct Unit { int pm, pn, pb, lt, cnt, e; };
struct Gemm { const bf16_t* A; const bf16_t* Bt; int K; int sc = 0x7f7f7f7f; };

__device__ __forceinline__ void tile_map(int L, int nM, int nN, int& pm, int& pn) {
    const int nwg = nM * nN;
    int wgid = L; { const int q = nwg / NXCD, r = nwg % NXCD, xcd = wgid % NXCD, off = wgid / NXCD; wgid = (xcd < r ? xcd * (q + 1) : r * (q + 1) + (xcd - r) * q) + off; }
    const int nig = WGM * nN, gid = wgid / nig, fm = gid * WGM, gsz = (nM - fm) < WGM ? (nM - fm) : WGM;
    pm = fm + ((wgid % nig) % gsz); pn = (wgid % nig) / gsz;
}
struct StaticOrder {
    int nM, nN, nwg, G, c;
    __device__ __forceinline__ void init(int M_, int N_, int G_, int c_) { nM = M_ / BM; nN = N_ / BM; nwg = nM * nN; G = G_; c = c_; }
    __device__ __forceinline__ bool next(int i, Unit& u) const {
        const long L = (long)i * G + c; if (L >= nwg) return false;
        tile_map((int)L, nM, nN, u.pm, u.pn); u.pb = u.pn; u.lt = 0; u.cnt = 0; u.e = 0; return true;
    }
};
struct MoeOrder {
    int t1, t2, t3, t4, t5, t6, t7, nM, nN, nwg, G, c; const unsigned* cntp;
    __device__ __forceinline__ void init(const unsigned* cnt, int nN_, int G_, int c_) {
        int t = 0, o[9];
#pragma unroll
        for (int e = 0; e < 8; ++e) { o[e] = t; const int ce = __builtin_amdgcn_readfirstlane((int)__hip_atomic_load(cnt + e, __ATOMIC_RELAXED, __HIP_MEMORY_SCOPE_AGENT)); t += (ce + 255) >> 8; }
        o[8] = t; t1 = o[1]; t2 = o[2]; t3 = o[3]; t4 = o[4]; t5 = o[5]; t6 = o[6]; t7 = o[7];
        nM = t; nN = nN_; nwg = nM * nN; G = G_; c = c_; cntp = cnt;
    }
    __device__ __forceinline__ bool next(int i, Unit& u) const {
        const long L = (long)i * G + c; if (L >= nwg) return false;
        tile_map((int)L, nM, nN, u.pm, u.pn);
        const int e = (u.pm >= t1) + (u.pm >= t2) + (u.pm >= t3) + (u.pm >= t4) + (u.pm >= t5) + (u.pm >= t6) + (u.pm >= t7);
        const int tb = e == 0 ? 0 : e == 1 ? t1 : e == 2 ? t2 : e == 3 ? t3 : e == 4 ? t4 : e == 5 ? t5 : e == 6 ? t6 : t7;
        u.cnt = __builtin_amdgcn_readfirstlane((int)__hip_atomic_load(cntp + e, __ATOMIC_RELAXED, __HIP_MEMORY_SCOPE_AGENT));
        u.lt = u.pm - tb; u.e = e; u.pb = e * nN + u.pn; return true;
    }
};

typedef f32x4 Acc[2][2][4][2];

template <bool F8 = false, class Epi, class Sched>
__device__ __forceinline__ void gemm_phase(LAS unsigned char* lds, const Gemm g, const Sched& S, const Epi& E) {
    int tid_ = threadIdx.x; asm volatile("" : "+v"(tid_));
    const int tid = tid_, wid = __builtin_amdgcn_readfirstlane(tid >> 6), lane = tid & 63, wr = wid >> 2, wc = wid & 3, fr = lane & 15, fq = lane >> 4;
    const int K = g.K, nt = K / BK;
    unsigned voffA[2], voffB[2];
#pragma unroll
    for (int i = 0; i < 2; ++i) { int R, C; stage_rc(tid * 16 + i * 8192, R, C); const int Rb = (R & ~31) + perm32(R & 31);
        voffA[i] = (unsigned)(R * K + C) * 2u; voffB[i] = (unsigned)(Rb * K + C) * 2u; }
    const size_t kstep = (size_t)(BK * 2);
    const size_t hstep = (size_t)HALF * K * 2;
    const size_t tstep = 2 * hstep;
    const unsigned ldsw = (unsigned)wid * 1024u;
    const int aoff = lds_byte(wr * 64 + fr, fq * 8), boff = lds_byte(wc * 32 + fr, fq * 8);
#define PG8_SA(b, h) (((b) * 2 + (h)) * HTB)
#define PG8_SB(b, h) ((4 + (b) * 2 + (h)) * HTB)
#define PG8_STAGE(bufoff, gbase, voff) do { _Pragma("unroll") for (int _i = 0; _i < 2; ++_i) \
        __builtin_amdgcn_global_load_lds((const unsigned*)((const char*)(gbase) + (voff)[_i]), (LAS unsigned*)(lds + (bufoff) + ldsw + _i * 8192), 16, 0, 0); } while (0)
#define PG8_LDA(dst, b, h) do { _Pragma("unroll") for (int m = 0; m < 4; ++m) _Pragma("unroll") for (int k = 0; k < 2; ++k) dst[m][k] = *(const LAS bf16x8*)(lds + PG8_SA(b, h) + aoff + m * 2048 + k * 1024); } while (0)
#define PG8_LDB(dst, b, h) do { _Pragma("unroll") for (int n = 0; n < 2; ++n) _Pragma("unroll") for (int k = 0; k < 2; ++k) dst[n][k] = *(const LAS bf16x8*)(lds + PG8_SB(b, h) + boff + n * 2048 + k * 1024); } while (0)
#define PG8_MMA(ai, bj, At, Bt) do { __builtin_amdgcn_s_setprio(1); \
        if constexpr (F8) {        \
            _Pragma("unroll") for (int m = 0; m < 4; ++m) _Pragma("unroll") for (int n = 0; n < 2; ++n) { \
                const v8i32 bv_ = __builtin_shufflevector(__builtin_bit_cast(v4i32, Bt[n][0]), __builtin_bit_cast(v4i32, Bt[n][1]), 0, 1, 2, 3, 4, 5, 6, 7); \
                const v8i32 av_ = __builtin_shufflevector(__builtin_bit_cast(v4i32, At[m][0]), __builtin_bit_cast(v4i32, At[m][1]), 0, 1, 2, 3, 4, 5, 6, 7); \
                acc[ai][bj][m][n] = __builtin_amdgcn_mfma_scale_f32_16x16x128_f8f6f4(bv_, av_, acc[ai][bj][m][n], 0, 0, 0, g.sc, 0, 0x7f7f7f7f); } \
        } else { \
            _Pragma("unroll") for (int m = 0; m < 4; ++m) _Pragma("unroll") for (int n = 0; n < 2; ++n) _Pragma("unroll") for (int k = 0; k < 2; ++k) \
                acc[ai][bj][m][n] = __builtin_amdgcn_mfma_f32_16x16x32_bf16(Bt[n][k], At[m][k], acc[ai][bj][m][n], 0, 0, 0); } \
        __builtin_amdgcn_s_setprio(0); } while (0)
#define PG8_WAIT_V(n) asm volatile("s_waitcnt vmcnt(" #n ")" ::: "memory")
#define PG8_WAIT_L(n) asm volatile("s_waitcnt lgkmcnt(" #n ")" ::: "memory")
#define PG8_BAR __builtin_amdgcn_s_barrier()
#define PG8_SCHED __builtin_amdgcn_sched_barrier(0)
    Unit cur, nxt; int ui = 0;
    if (!S.next(0, cur)) return;
    Acc acc;
#pragma unroll
    for (int a = 0; a < 2; ++a)
#pragma unroll
        for (int b = 0; b < 2; ++b)
#pragma unroll
            for (int m = 0; m < 4; ++m)
#pragma unroll
                for (int n = 0; n < 2; ++n) acc[a][b][m][n] = (f32x4){0.f, 0.f, 0.f, 0.f};
    bf16x8 At[4][2], B0[2][2], B1[2][2];
    const char* cA = (const char*)g.A + (size_t)cur.pm * tstep; const char* cB = (const char*)g.Bt + (size_t)cur.pb * tstep;
    PG8_STAGE(PG8_SB(0, 0), cB, voffB); PG8_STAGE(PG8_SA(0, 0), cA, voffA); PG8_STAGE(PG8_SB(0, 1), cB + hstep, voffB); PG8_STAGE(PG8_SA(0, 1), cA + hstep, voffA);
    if (wr == 1) PG8_BAR;
    PG8_WAIT_V(4); PG8_BAR;
    PG8_STAGE(PG8_SB(1, 0), cB + kstep, voffB); PG8_STAGE(PG8_SA(1, 0), cA + kstep, voffA); PG8_STAGE(PG8_SB(1, 1), cB + hstep + kstep, voffB);
    PG8_WAIT_V(6); PG8_BAR;
    for (;;) {
        const bool has_next = S.next(ui + 1, nxt);
        const char* nA = has_next ? (const char*)g.A + (size_t)nxt.pm * tstep : cA; const char* nB = has_next ? (const char*)g.Bt + (size_t)nxt.pb * tstep : cB;
#pragma nounroll
        for (int t = 0; t < nt; t += 2) {
            const bool last = (t == nt - 2);
            const char* a1 = cA + (size_t)(t + 1) * kstep;
            const char* a2 = last ? nA : cA + (size_t)(t + 2) * kstep; const char* b2 = last ? nB : cB + (size_t)(t + 2) * kstep;
            const char* a3 = a2 + kstep; const char* b3 = b2 + kstep;
            PG8_LDB(B0, 0, 0); PG8_SCHED; PG8_LDA(At, 0, 0); PG8_STAGE(PG8_SA(1, 1), a1 + hstep, voffA);
            PG8_WAIT_L(8); PG8_BAR; PG8_WAIT_L(0); PG8_MMA(0, 0, At, B0); PG8_BAR; PG8_SCHED;
            PG8_LDB(B1, 0, 1); PG8_STAGE(PG8_SB(0, 0), b2, voffB);
            PG8_BAR; PG8_WAIT_L(0); PG8_MMA(0, 1, At, B1); PG8_BAR;
            PG8_LDA(At, 0, 1); PG8_STAGE(PG8_SA(0, 0), a2, voffA);
            PG8_BAR; PG8_WAIT_L(0); PG8_MMA(1, 0, At, B0); PG8_BAR; PG8_SCHED;
            PG8_STAGE(PG8_SB(0, 1), b2 + hstep, voffB);
            PG8_WAIT_V(6); PG8_BAR; PG8_MMA(1, 1, At, B1); PG8_BAR;
            PG8_LDB(B0, 1, 0); PG8_SCHED; PG8_LDA(At, 1, 0); PG8_STAGE(PG8_SA(0, 1), a2 + hstep, voffA);
            PG8_WAIT_L(8); PG8_BAR; PG8_WAIT_L(0); PG8_MMA(0, 0, At, B0); PG8_BAR; PG8_SCHED;
            PG8_LDB(B1, 1, 1); PG8_STAGE(PG8_SB(1, 0), b3, voffB);
            PG8_BAR; PG8_WAIT_L(0); PG8_MMA(0, 1, At, B1); PG8_BAR;
            PG8_LDA(At, 1, 1); PG8_STAGE(PG8_SA(1, 0), a3, voffA);
            PG8_BAR; PG8_WAIT_L(0); PG8_MMA(1, 0, At, B0); PG8_BAR; PG8_SCHED;
            PG8_STAGE(PG8_SB(1, 1), b3 + hstep, voffB);
            PG8_WAIT_V(6); PG8_BAR; PG8_MMA(1, 1, At, B1); PG8_BAR;
        }
        E(acc, cur, wr, wc, fr, fq);
        if (!has_next) break;
#pragma unroll
        for (int a = 0; a < 2; ++a)
#pragma unroll
            for (int b = 0; b < 2; ++b)
#pragma unroll
                for (int m = 0; m < 4; ++m)
#pragma unroll
                    for (int n = 0; n < 2; ++n) acc[a][b][m][n] = (f32x4){0.f, 0.f, 0.f, 0.f};
        cur = nxt; cA = nA; cB = nB; ++ui;
    }
    PG8_WAIT_V(0);
    if (wr == 0) PG8_BAR;
    PG8_BAR;
#undef PG8_SA
#undef PG8_SB
#undef PG8_STAGE
#undef PG8_LDA
#undef PG8_LDB
#undef PG8_MMA
#undef PG8_WAIT_V
#undef PG8_WAIT_L
#undef PG8_BAR
#undef PG8_SCHED
}

template <bool F8 = false, bool IDENT = false, class Epi, class Sched>
__device__ __forceinline__ void gemm_phase_gather(LAS unsigned char* lds, const Gemm g, const Sched& S, const Epi& E, const int* TOKV) {
    int tid_ = threadIdx.x; asm volatile("" : "+v"(tid_));
    const int tid = tid_, wid = __builtin_amdgcn_readfirstlane(tid >> 6), lane = tid & 63, wr = wid >> 2, wc = wid & 3, fr = lane & 15, fq = lane >> 4;
    const int K = g.K, nt = K / BK;
    unsigned voffB[2];
#pragma unroll
    for (int i = 0; i < 2; ++i) { int R, C; stage_rc(tid * 16 + i * 8192, R, C); const int Rb = (R & ~31) + perm32(R & 31); voffB[i] = (unsigned)(Rb * K + C) * 2u; }
    unsigned vgC[2][2];
    LAS int* TOKL = (LAS int*)(lds + STAGE_TOKL);
#define PG8_GROWS(dst, u_) do { int tq_ = threadIdx.x; asm volatile("" : "+v"(tq_)); _Pragma("unroll") for (int i_ = 0; i_ < 2; ++i_) { int R_, C_; stage_rc(tq_ * 16 + i_ * 8192, R_, C_); \
            _Pragma("unroll") for (int h_ = 0; h_ < 2; ++h_) { const int pos_ = 256 * (u_).lt + 128 * h_ + R_; \
                int tok_; if constexpr (IDENT) tok_ = 256 * (u_).pm + 128 * h_ + R_; else tok_ = (pos_ < (u_).cnt) ? TOKV[(size_t)(u_).e * M + pos_] : 0; dst[h_][i_] = (unsigned)tok_ * (unsigned)(K * 2) + (unsigned)C_ * 2u; } } } while (0)
#define PG8_GROWS_LDS(dst, u_, par_) do { int tq_ = threadIdx.x; asm volatile("" : "+v"(tq_)); _Pragma("unroll") for (int i_ = 0; i_ < 2; ++i_) { int R_, C_; stage_rc(tq_ * 16 + i_ * 8192, R_, C_); \
            _Pragma("unroll") for (int h_ = 0; h_ < 2; ++h_) { const int rl_ = 128 * h_ + R_; \
                int tok_; if constexpr (IDENT) tok_ = 256 * (u_).pm + rl_; else tok_ = (256 * (u_).lt + rl_ < (u_).cnt) ? TOKL[256 * (par_) + rl_] : 0; dst[h_][i_] = (unsigned)tok_ * (unsigned)(K * 2) + (unsigned)C_ * 2u; } } } while (0)
    const size_t kstep = (size_t)(BK * 2);
    const size_t hstep = (size_t)HALF * K * 2;
    const size_t tstep = 2 * hstep;
    const unsigned ldsw = (unsigned)wid * 1024u;
    const int aoff = lds_byte(wr * 64 + fr, fq * 8), boff = lds_byte(wc * 32 + fr, fq * 8);
#define PG8_SA(b, h) (((b) * 2 + (h)) * HTB)
#define PG8_SB(b, h) ((4 + (b) * 2 + (h)) * HTB)
#define PG8_STAGE(bufoff, gbase, voff) do { _Pragma("unroll") for (int _i = 0; _i < 2; ++_i) \
        __builtin_amdgcn_global_load_lds((const unsigned*)((const char*)(gbase) + (voff)[_i]), (LAS unsigned*)(lds + (bufoff) + ldsw + _i * 8192), 16, 0, 0); } while (0)
#define PG8_STAGEA(bufoff, gbase, h_, nx_) PG8_STAGE(bufoff, gbase, vgC[h_])
#define PG8_LDA(dst, b, h) do { _Pragma("unroll") for (int m = 0; m < 4; ++m) _Pragma("unroll") for (int k = 0; k < 2; ++k) dst[m][k] = *(const LAS bf16x8*)(lds + PG8_SA(b, h) + aoff + m * 2048 + k * 1024); } while (0)
#define PG8_LDB(dst, b, h) do { _Pragma("unroll") for (int n = 0; n < 2; ++n) _Pragma("unroll") for (int k = 0; k < 2; ++k) dst[n][k] = *(const LAS bf16x8*)(lds + PG8_SB(b, h) + boff + n * 2048 + k * 1024); } while (0)
#define PG8_MMA(ai, bj, At, Bt) do { __builtin_amdgcn_s_setprio(1); \
        if constexpr (F8) {        \
            _Pragma("unroll") for (int m = 0; m < 4; ++m) _Pragma("unroll") for (int n = 0; n < 2; ++n) { \
                const v8i32 bv_ = __builtin_shufflevector(__builtin_bit_cast(v4i32, Bt[n][0]), __builtin_bit_cast(v4i32, Bt[n][1]), 0, 1, 2, 3, 4, 5, 6, 7); \
                const v8i32 av_ = __builtin_shufflevector(__builtin_bit_cast(v4i32, At[m][0]), __builtin_bit_cast(v4i32, At[m][1]), 0, 1, 2, 3, 4, 5, 6, 7); \
                acc[ai][bj][m][n] = __builtin_amdgcn_mfma_scale_f32_16x16x128_f8f6f4(bv_, av_, acc[ai][bj][m][n], 0, 0, 0, g.sc, 0, 0x7f7f7f7f); } \
        } else { \
            _Pragma("unroll") for (int m = 0; m < 4; ++m) _Pragma("unroll") for (int n = 0; n < 2; ++n) _Pragma("unroll") for (int k = 0; k < 2; ++k) \
                acc[ai][bj][m][n] = __builtin_amdgcn_mfma_f32_16x16x32_bf16(Bt[n][k], At[m][k], acc[ai][bj][m][n], 0, 0, 0); } \
        __builtin_amdgcn_s_setprio(0); } while (0)
#define PG8_WAIT_V(n) asm volatile("s_waitcnt vmcnt(" #n ")" ::: "memory")
#define PG8_WAIT_L(n) asm volatile("s_waitcnt lgkmcnt(" #n ")" ::: "memory")
#define PG8_BAR __builtin_amdgcn_s_barrier()
#define PG8_SCHED __builtin_amdgcn_sched_barrier(0)
    Unit cur, nxt; int ui = 0;
    if (!S.next(0, cur)) return;
    Acc acc;
#pragma unroll
    for (int a = 0; a < 2; ++a)
#pragma unroll
        for (int b = 0; b < 2; ++b)
#pragma unroll
            for (int m = 0; m < 4; ++m)
#pragma unroll
                for (int n = 0; n < 2; ++n) acc[a][b][m][n] = (f32x4){0.f, 0.f, 0.f, 0.f};
    bf16x8 At[4][2], B0[2][2], B1[2][2];
    const char* cA = (const char*)g.A; const char* cB = (const char*)g.Bt + (size_t)cur.pb * tstep;
    PG8_GROWS(vgC, cur);
    PG8_STAGE(PG8_SB(0, 0), cB, voffB); PG8_STAGEA(PG8_SA(0, 0), cA, 0, false); PG8_STAGE(PG8_SB(0, 1), cB + hstep, voffB); PG8_STAGEA(PG8_SA(0, 1), cA, 1, false);
    if (wr == 1) PG8_BAR;
    PG8_WAIT_V(4); PG8_BAR;
    PG8_STAGE(PG8_SB(1, 0), cB + kstep, voffB); PG8_STAGEA(PG8_SA(1, 0), cA + kstep, 0, false); PG8_STAGE(PG8_SB(1, 1), cB + hstep + kstep, voffB);
    PG8_WAIT_V(6); PG8_BAR;
    for (;;) {
        const bool has_next = S.next(ui + 1, nxt);
        const char* nA = cA; const char* nB = has_next ? (const char*)g.Bt + (size_t)nxt.pb * tstep : cB;
        if (!IDENT && has_next && wid == 0) __builtin_amdgcn_global_load_lds((const unsigned*)(TOKV + (size_t)nxt.e * M + 256 * nxt.lt + 4 * lane), (LAS unsigned*)(TOKL + 256 * ((ui + 1) & 1)), 16, 0, 0);

#pragma nounroll
        for (int t = 0; t < nt; t += 2) {
            const bool last = (t == nt - 2);
            const char* a1 = cA + (size_t)(t + 1) * kstep;
            const char* a2 = last ? nA : cA + (size_t)(t + 2) * kstep; const char* b2 = last ? nB : cB + (size_t)(t + 2) * kstep;
            const char* a3 = a2 + kstep; const char* b3 = b2 + kstep;
            PG8_LDB(B0, 0, 0); PG8_SCHED; PG8_LDA(At, 0, 0); PG8_STAGEA(PG8_SA(1, 1), a1, 1, false);
            if (last && has_next) { PG8_GROWS_LDS(vgC, nxt, (ui + 1) & 1); }
            PG8_WAIT_L(8); PG8_BAR; PG8_WAIT_L(0); PG8_MMA(0, 0, At, B0); PG8_BAR; PG8_SCHED;
            PG8_LDB(B1, 0, 1); PG8_STAGE(PG8_SB(0, 0), b2, voffB);
            PG8_BAR; PG8_WAIT_L(0); PG8_MMA(0, 1, At, B1); PG8_BAR;
            PG8_LDA(At, 0, 1); PG8_STAGEA(PG8_SA(0, 0), a2, 0, last);
            PG8_BAR; PG8_WAIT_L(0); PG8_MMA(1, 0, At, B0); PG8_BAR; PG8_SCHED;
            PG8_STAGE(PG8_SB(0, 1), b2 + hstep, voffB);
            PG8_WAIT_V(6); PG8_BAR; PG8_MMA(1, 1, At, B1); PG8_BAR;
            PG8_LDB(B0, 1, 0); PG8_SCHED; PG8_LDA(At, 1, 0); PG8_STAGEA(PG8_SA(0, 1), a2, 1, last);
            PG8_WAIT_L(8); PG8_BAR; PG8_WAIT_L(0); PG8_MMA(0, 0, At, B0); PG8_BAR; PG8_SCHED;
            PG8_LDB(B1, 1, 1); PG8_STAGE(PG8_SB(1, 0), b3, voffB);
            PG8_BAR; PG8_WAIT_L(0); PG8_MMA(0, 1, At, B1); PG8_BAR;
            PG8_LDA(At, 1, 1); PG8_STAGEA(PG8_SA(1, 0), a3, 0, last);
            PG8_BAR; PG8_WAIT_L(0); PG8_MMA(1, 0, At, B0); PG8_BAR; PG8_SCHED;
            PG8_STAGE(PG8_SB(1, 1), b3 + hstep, voffB);
            PG8_WAIT_V(6); PG8_BAR; PG8_MMA(1, 1, At, B1); PG8_BAR;
        }
        E(acc, cur, wr, wc, fr, fq);
        if (!has_next) break;
#pragma unroll
        for (int a = 0; a < 2; ++a)
#pragma unroll
            for (int b = 0; b < 2; ++b)
#pragma unroll
                for (int m = 0; m < 4; ++m)
#pragma unroll
                    for (int n = 0; n < 2; ++n) acc[a][b][m][n] = (f32x4){0.f, 0.f, 0.f, 0.f};
        cur = nxt; cB = nB; ++ui;
    }
    PG8_WAIT_V(0);
    if (wr == 0) PG8_BAR;
    PG8_BAR;
#undef PG8_SA
#undef PG8_STAGEA
#undef PG8_GROWS
#undef PG8_GROWS_LDS
#undef PG8_SB
#undef PG8_STAGE
#undef PG8_LDA
#undef PG8_LDB
#undef PG8_MMA
#undef PG8_WAIT_V
#undef PG8_WAIT_L
#undef PG8_BAR
#undef PG8_SCHED
}

__device__ __forceinline__ u32x4 pack8(const f32x4 a, const f32x4 b) { u32x4 w; w.x = cvt_pk_bf16(a[0], a[1]); w.y = cvt_pk_bf16(a[2], a[3]); w.z = cvt_pk_bf16(b[0], b[1]); w.w = cvt_pk_bf16(b[2], b[3]); return w; }

struct EpiHgIn {
    bf16_t* QFVG;
    __device__ __forceinline__ void operator()(const Acc& acc, const Unit& u, int wr, int wc, int fr, int fq) const {
        const int part = u.pn >> 2, row0 = u.pm * BM + wr * 64 + fr, col0 = (u.pn & 3) * 256 + wc * 32 + 8 * fq;
        bf16_t* base = QFVG + (size_t)part * ((size_t)M * D);
#pragma unroll
        for (int ai = 0; ai < 2; ++ai)
#pragma unroll
            for (int m = 0; m < 4; ++m) { bf16_t* rowp = base + (size_t)(row0 + ai * HALF + m * 16) * D + col0;
#pragma unroll
                for (int bj = 0; bj < 2; ++bj) *(u32x4*)(rowp + bj * HALF) = pack8(acc[ai][bj][m][0], acc[ai][bj][m][1]); }
    }
};
struct EpiRes {
    const bf16_t* X; bf16_t* Y;
    __device__ __forceinline__ void operator()(const Acc& acc, const Unit& u, int wr, int wc, int fr, int fq) const {
        const int row0 = u.pm * BM + wr * 64 + fr, col0 = u.pn * BM + wc * 32 + 8 * fq;
#pragma unroll
        for (int ai = 0; ai < 2; ++ai)
#pragma unroll
            for (int m = 0; m < 4; ++m) { const size_t o = (size_t)(row0 + ai * HALF + m * 16) * D + col0;
#pragma unroll
                for (int bj = 0; bj < 2; ++bj) {
                    const u32x4 xv = *(const u32x4*)(X + o + bj * HALF);
                    f32x4 y0, y1;
#pragma unroll
                    for (int q = 0; q < 2; ++q) { y0[2 * q] = __uint_as_float(xv[q] << 16) * ALPHA + acc[ai][bj][m][0][2 * q]; y0[2 * q + 1] = __uint_as_float(xv[q] & 0xffff0000u) * ALPHA + acc[ai][bj][m][0][2 * q + 1];
                        y1[2 * q] = __uint_as_float(xv[2 + q] << 16) * ALPHA + acc[ai][bj][m][1][2 * q]; y1[2 * q + 1] = __uint_as_float(xv[2 + q] & 0xffff0000u) * ALPHA + acc[ai][bj][m][1][2 * q + 1]; }
                    *(u32x4*)(Y + o + bj * HALF) = pack8(y0, y1); } }
    }
};
__device__ __forceinline__ unsigned pack4_fp8(float a, float b, float c, float d) {
    a = fminf(fmaxf(a, -448.f), 448.f); b = fminf(fmaxf(b, -448.f), 448.f); c = fminf(fmaxf(c, -448.f), 448.f); d = fminf(fmaxf(d, -448.f), 448.f);
    int p = 0; p = __builtin_amdgcn_cvt_pk_fp8_f32(a, b, p, false); p = __builtin_amdgcn_cvt_pk_fp8_f32(c, d, p, true); return (unsigned)p;
}
constexpr float F8_X = 16.f, F8_WGU = 64.f, F8_H = 4.f, F8_WDN = 256.f, F8_O = 64.f, F8_WDO = 128.f;
constexpr int e8m0x4(int e) { return (127 + e) * 0x01010101; }
constexpr float F8_Q = 64.f, F8_KV = 16.f;
constexpr int SC_S = e8m0x4(-10), SC_V = e8m0x4(-4);
constexpr int SC_UP = e8m0x4(-10), SC_DN = e8m0x4(-10), SC_DO = e8m0x4(-13);
struct EpiSwiglu8 {
    unsigned char* H;
    __device__ __forceinline__ void operator()(const Acc& acc, const Unit& u, int wr, int wc, int fr, int fq) const {
        const int row0 = u.pm * BM + wr * 64 + fr, col0 = u.pn * 128 + wc * 32 + 8 * fq;
#pragma unroll
        for (int ai = 0; ai < 2; ++ai)
#pragma unroll
            for (int m = 0; m < 4; ++m) { unsigned char* rowp = H + (size_t)(row0 + ai * HALF + m * 16) * DFF + col0;
                float h[8];
#pragma unroll
                for (int j = 0; j < 8; ++j) { const float gt = acc[ai][0][m][j >> 2][j & 3], up = acc[ai][1][m][j >> 2][j & 3];
                    h[j] = __builtin_amdgcn_fmed3f(gt * (up * F8_H) * fast_rcp(1.0f + fast_exp2(gt * -1.4426950408889634f)), -448.f, 448.f); }
                int p0 = 0, p1 = 0;
                p0 = __builtin_amdgcn_cvt_pk_fp8_f32(h[0], h[1], p0, false); p0 = __builtin_amdgcn_cvt_pk_fp8_f32(h[2], h[3], p0, true);
                p1 = __builtin_amdgcn_cvt_pk_fp8_f32(h[4], h[5], p1, false); p1 = __builtin_amdgcn_cvt_pk_fp8_f32(h[6], h[7], p1, true);
                *(u32x2*)rowp = (u32x2){(unsigned)p0, (unsigned)p1}; }
    }
};
struct EpiSwiglu {
    bf16_t* H;
    __device__ __forceinline__ void operator()(const Acc& acc, const Unit& u, int wr, int wc, int fr, int fq) const {
        const int row0 = u.pm * BM + wr * 64 + fr, col0 = u.pn * 128 + wc * 32 + 8 * fq;
#pragma unroll
        for (int ai = 0; ai < 2; ++ai)
#pragma unroll
            for (int m = 0; m < 4; ++m) { bf16_t* rowp = H + (size_t)(row0 + ai * HALF + m * 16) * DFF + col0;
                f32x4 h0, h1;
#pragma unroll
                for (int j = 0; j < 4; ++j) { h0[j] = siluf_(acc[ai][0][m][0][j]) * acc[ai][1][m][0][j]; h1[j] = siluf_(acc[ai][0][m][1][j]) * acc[ai][1][m][1][j]; }
                *(u32x4*)rowp = pack8(h0, h1); }
    }
};
struct EpiBf16 {
    bf16_t* C; int ldc;
    __device__ __forceinline__ void operator()(const Acc& acc, const Unit& u, int wr, int wc, int fr, int fq) const {
        const int row0 = u.pm * BM + wr * 64 + fr, col0 = u.pn * BM + wc * 32 + 8 * fq;
#pragma unroll
        for (int ai = 0; ai < 2; ++ai)
#pragma unroll
            for (int m = 0; m < 4; ++m) { bf16_t* rowp = C + (size_t)(row0 + ai * HALF + m * 16) * ldc + col0;
#pragma unroll
                for (int bj = 0; bj < 2; ++bj) *(u32x4*)(rowp + bj * HALF) = pack8(acc[ai][bj][m][0], acc[ai][bj][m][1]); }
    }
};
struct EpiQ {
    bf16_t* QLAT; bf16_t* QIDX;
    __device__ __forceinline__ void operator()(const Acc& acc, const Unit& u, int wr, int wc, int fr, int fq) const {
        const bool lat = u.pn < 8; bf16_t* base = lat ? QLAT : QIDX; const int ld = lat ? 2048 : 512;
        const int row0 = u.pm * BM + wr * 64 + fr, col0 = (lat ? u.pn : u.pn - 8) * BM + wc * 32 + 8 * fq;
#pragma unroll
        for (int ai = 0; ai < 2; ++ai)
#pragma unroll
            for (int m = 0; m < 4; ++m) { bf16_t* rowp = base + (size_t)(row0 + ai * HALF + m * 16) * ld + col0;
#pragma unroll
                for (int bj = 0; bj < 2; ++bj) *(u32x4*)(rowp + bj * HALF) = pack8(acc[ai][bj][m][0], acc[ai][bj][m][1]); }
    }
};
struct EpiQ8 {
    unsigned char* QLAT8; bf16_t* QIDX;
    __device__ __forceinline__ void operator()(const Acc& acc, const Unit& u, int wr, int wc, int fr, int fq) const {
        const int row0 = u.pm * BM + wr * 64 + fr;
        if (u.pn < 8) { const int col0 = u.pn * BM + wc * 32 + 8 * fq;
#pragma unroll
            for (int ai = 0; ai < 2; ++ai)
#pragma unroll
                for (int m = 0; m < 4; ++m) { unsigned char* rowp = QLAT8 + (size_t)(row0 + ai * HALF + m * 16) * 2048 + col0;
#pragma unroll
                    for (int bj = 0; bj < 2; ++bj) { u32x2 o;
                        o.x = pack4_fp8(acc[ai][bj][m][0][0] * F8_Q, acc[ai][bj][m][0][1] * F8_Q, acc[ai][bj][m][0][2] * F8_Q, acc[ai][bj][m][0][3] * F8_Q);
                        o.y = pack4_fp8(acc[ai][bj][m][1][0] * F8_Q, acc[ai][bj][m][1][1] * F8_Q, acc[ai][bj][m][1][2] * F8_Q, acc[ai][bj][m][1][3] * F8_Q);
                        *(u32x2*)(rowp + bj * HALF) = o; } }
        } else { const int col0 = (u.pn - 8) * BM + wc * 32 + 8 * fq;
#pragma unroll
            for (int ai = 0; ai < 2; ++ai)
#pragma unroll
                for (int m = 0; m < 4; ++m) { bf16_t* rowp = QIDX + (size_t)(row0 + ai * HALF + m * 16) * 512 + col0;
#pragma unroll
                    for (int bj = 0; bj < 2; ++bj) *(u32x4*)(rowp + bj * HALF) = pack8(acc[ai][bj][m][0], acc[ai][bj][m][1]); }
        }
    }
};
struct EpiMoeDn {
    bf16_t* O; const float* GW;
    __device__ __forceinline__ void operator()(const Acc& acc, const Unit& u, int wr, int wc, int fr, int fq) const {
        const int rl0 = wr * 64 + fr, col0 = u.pn * BM + wc * 32 + 8 * fq; const float* gwp = GW + (size_t)u.e * M + 256 * u.lt;
#pragma unroll
        for (int ai = 0; ai < 2; ++ai)
#pragma unroll
            for (int m = 0; m < 4; ++m) { const int rl = rl0 + ai * HALF + m * 16; const float gv = (256 * u.lt + rl < u.cnt) ? gwp[rl] : 0.f; bf16_t* rowp = O + (size_t)(u.pm * BM + rl) * D + col0;
#pragma unroll
                for (int bj = 0; bj < 2; ++bj) *(u32x4*)(rowp + bj * HALF) = pack8(acc[ai][bj][m][0] * gv, acc[ai][bj][m][1] * gv); }
    }
};

struct Params { const float* in[22]; float* out; unsigned char* ws; int ph_lo, ph_hi; };
enum { IN_X = 0, IN_LNG, IN_LNB, IN_HGWIN, IN_HGLB, IN_HGNG, IN_HGWOUT, IN_DWIN, IN_DQNG, IN_DKVNG, IN_DWUQ, IN_DWUK, IN_DWUV, IN_DWQIDX, IN_DKIG, IN_DKIB, IN_DWOUT, IN_FGU, IN_FDN, IN_MR, IN_MGU, IN_MDN };

__device__ __forceinline__ const float* inptr(int i) {
    int off = i * 8; asm volatile("" : "+s"(off));
    typedef const float* cfp;
    return *(const __attribute__((address_space(4))) cfp*)((const __attribute__((address_space(4))) char*)__builtin_amdgcn_kernarg_segment_ptr() + off);
}
#define INP(i) inptr(i)
struct Frame {
    LAS unsigned char* lds;
    unsigned* ctl;
    int tid, lane, wave, G, c;
};

__device__ __forceinline__ void p0_transpose_item(const float* W, int K, int Nsrc, int nblk, bf16_t* WT, int mode, float f8scale, LAS float* scr, int item, int lane) {
    const int kb = item / nblk, nb = item % nblk, k0 = 64 * kb, n0 = 32 * nb;
    const int c4 = (lane & 7) * 4, kr = lane >> 3;
#pragma unroll
    for (int i = 0; i < 8; ++i) { const int kk = 8 * i + kr;
        f32x4 v = (f32x4){0.f, 0.f, 0.f, 0.f};
        if (n0 + c4 < Nsrc) v = *(const f32x4*)(W + (size_t)(k0 + kk) * Nsrc + n0 + c4);
        scr[kk * 33 + c4 + 0] = v[0]; scr[kk * 33 + c4 + 1] = v[1]; scr[kk * 33 + c4 + 2] = v[2]; scr[kk * 33 + c4 + 3] = v[3]; }
    LDS_WAIT(); asm volatile("" ::: "memory");
    int drow0 = n0;
    if (mode == 1) { const int half = n0 / DFF, r = n0 % DFF; drow0 = 256 * (r / 128) + 128 * half + (r % 128); }
    if (f8scale > 0.f) {
        const int c = lane & 3;
#pragma unroll
        for (int j = 0; j < 2; ++j) { const int n = (lane >> 2) + 16 * j; const LAS float* s = scr + (16 * c) * 33 + n;
            u32x4 o;
#pragma unroll
            for (int q = 0; q < 4; ++q) o[q] = pack4_fp8(s[(4 * q) * 33] * f8scale, s[(4 * q + 1) * 33] * f8scale, s[(4 * q + 2) * 33] * f8scale, s[(4 * q + 3) * 33] * f8scale);
            *(u32x4*)((unsigned char*)WT + (size_t)(drow0 + n) * K + k0 + 16 * c) = o; }
    } else {
        const int c = lane & 7;
#pragma unroll
        for (int j = 0; j < 4; ++j) { const int n = (lane >> 3) + 8 * j; const LAS float* s = scr + (8 * c) * 33 + n;
            u32x4 o; o.x = cvt_pk_bf16(s[0 * 33], s[1 * 33]); o.y = cvt_pk_bf16(s[2 * 33], s[3 * 33]); o.z = cvt_pk_bf16(s[4 * 33], s[5 * 33]); o.w = cvt_pk_bf16(s[6 * 33], s[7 * 33]);
            *(u32x4*)(WT + (size_t)(drow0 + n) * K + k0 + 8 * c) = o; }
    }
    LDS_WAIT(); asm volatile("" ::: "memory");
}
__device__ __forceinline__ void p0_combo_item(Frame& F, const float* A, int lda, const float* B, int ldb, bf16_t* out, int ldo, float scale, bool f8 = false) {
    LAS float* As = (LAS float*)F.lds; LAS float* Bs = As + 64 * 128;
    const int t = F.tid;
#pragma unroll
    for (int q = 0; q < 4; ++q) { const int r = (t >> 5) + 16 * q, c4 = (t & 31) * 4; *(LAS f32x4*)(As + r * 128 + c4) = *(const f32x4*)(A + (size_t)r * lda + c4); }
#pragma unroll
    for (int q = 0; q < 4; ++q) { const int r = (t >> 4) + 32 * q, c4 = (t & 15) * 4; *(LAS f32x4*)(Bs + r * 64 + c4) = *(const f32x4*)(B + (size_t)r * ldb + c4); }
    __syncthreads();
    const int tj = t & 63, ti = t >> 6;
    float acc[8];
#pragma unroll
    for (int ii = 0; ii < 8; ++ii) acc[ii] = 0.f;
    for (int d = 0; d < 128; d += 4) {
        const float b0 = Bs[(d + 0) * 64 + tj], b1 = Bs[(d + 1) * 64 + tj], b2 = Bs[(d + 2) * 64 + tj], b3 = Bs[(d + 3) * 64 + tj];
#pragma unroll
        for (int ii = 0; ii < 8; ++ii) { const f32x4 a = *(const LAS f32x4*)(As + (8 * ti + ii) * 128 + d); acc[ii] += a[0] * b0 + a[1] * b1 + a[2] * b2 + a[3] * b3; }
    }
    u32x4 o; o.x = cvt_pk_bf16(acc[0] * scale, acc[1] * scale); o.y = cvt_pk_bf16(acc[2] * scale, acc[3] * scale); o.z = cvt_pk_bf16(acc[4] * scale, acc[5] * scale); o.w = cvt_pk_bf16(acc[6] * scale, acc[7] * scale);
    if (f8) { u32x2 o8; o8.x = pack4_fp8(acc[0] * scale, acc[1] * scale, acc[2] * scale, acc[3] * scale); o8.y = pack4_fp8(acc[4] * scale, acc[5] * scale, acc[6] * scale, acc[7] * scale);
        *(u32x2*)((unsigned char*)out + (size_t)tj * ldo + 8 * ti) = o8; }
    else *(u32x4*)(out + (size_t)tj * ldo + 8 * ti) = o;
    __syncthreads();
}
__device__ __forceinline__ void p0_prologue(Frame& F, const Params& p) {
    unsigned char* ws = p.ws;
    LAS float* scr = (LAS float*)(F.lds + F.wave * 8448);
    const int gw = F.c * NWAVES + F.wave, NGW = F.G * NWAVES;
    constexpr int I0 = 16 * 128, I1 = 16 * 32, I2 = 16 * 224, I3 = 56 * 32, I4 = 16 * 24, I5 = 4 * 16;
    constexpr int NITEMS = 2 * (I0 + I1 + I2 + I3 + I4 + I5) + 16 * (I2 + I3);
    for (int it = gw; it < NITEMS; it += NGW) {
        int r = it;
        if (r < 16 * I2) { const int job = r / I2;
#if MK_MOE_FP8
            p0_transpose_item(INP(IN_MGU) + (size_t)job * D * 2 * DFF, D, 2 * DFF, 224, (bf16_t*)(ws + WS_W_MGU8 + (size_t)job * 2 * DFF * D), 1, F8_WGU, scr, r % I2, F.lane);
#else
            p0_transpose_item(INP(IN_MGU) + (size_t)job * D * 2 * DFF, D, 2 * DFF, 224, (bf16_t*)(ws + WS_W_MGU) + (size_t)job * 2 * DFF * D, 1, 0.f, scr, r % I2, F.lane);
#endif
            continue; } r -= 16 * I2;
        if (r < 16 * I3) { const int job = r / I3;
#if MK_MOE_FP8
            p0_transpose_item(INP(IN_MDN) + (size_t)job * DFF * D, DFF, D, 32, (bf16_t*)(ws + WS_W_MDN8 + (size_t)job * D * DFF), 0, F8_WDN, scr, r % I3, F.lane);
#else
            p0_transpose_item(INP(IN_MDN) + (size_t)job * DFF * D, DFF, D, 32, (bf16_t*)(ws + WS_W_MDN) + (size_t)job * D * DFF, 0, 0.f, scr, r % I3, F.lane);
#endif
            continue; } r -= 16 * I3;
        if (r < 2 * I0) { const int job = r / I0; p0_transpose_item(INP(IN_HGWIN) + (size_t)job * D * 4 * D, D, 4 * D, 128, (bf16_t*)(ws + WS_W_HGIN) + (size_t)job * 4 * D * D, 0, 0.f, scr, r % I0, F.lane); continue; } r -= 2 * I0;
        if (r < 2 * I1) { const int job = r / I1; p0_transpose_item(INP(IN_HGWOUT) + (size_t)job * D * D, D, D, 32, (bf16_t*)(ws + WS_W_HGOUT) + (size_t)job * D * D, 0, 0.f, scr, r % I1, F.lane); continue; } r -= 2 * I1;
        if (r < 2 * I2) { const int job = r / I2;
#if MK_FFN_FP8 == 2
            p0_transpose_item(INP(IN_FGU) + (size_t)job * D * 2 * DFF, D, 2 * DFF, 224, (bf16_t*)(ws + WS_W_FGU + (size_t)job * 2 * DFF * D), 1, F8_WGU, scr, r % I2, F.lane);
#else
            p0_transpose_item(INP(IN_FGU) + (size_t)job * D * 2 * DFF, D, 2 * DFF, 224, (bf16_t*)(ws + WS_W_FGU) + (size_t)job * 2 * DFF * D, 1, 0.f, scr, r % I2, F.lane);
#endif
            continue; } r -= 2 * I2;
        if (r < 2 * I3) { const int job = r / I3;
#if MK_FFN_FP8 >= 1
            p0_transpose_item(INP(IN_FDN) + (size_t)job * DFF * D, DFF, D, 32, (bf16_t*)(ws + WS_W_FDN + (size_t)job * D * DFF), 0, F8_WDN, scr, r % I3, F.lane);
#else
            p0_transpose_item(INP(IN_FDN) + (size_t)job * DFF * D, DFF, D, 32, (bf16_t*)(ws + WS_W_FDN) + (size_t)job * D * DFF, 0, 0.f, scr, r % I3, F.lane);
#endif
            continue; } r -= 2 * I3;
        if (r < 2 * I4) { const int job = r / I4; p0_transpose_item(INP(IN_DWIN) + (size_t)job * D * DSA_IN, D, DSA_IN, 24, (bf16_t*)(ws + WS_W_DIN) + (size_t)job * DSA_IN_PAD * D, 0, 0.f, scr, r % I4, F.lane); continue; } r -= 2 * I4;
        { const int job = r / I5; p0_transpose_item(INP(IN_DWQIDX) + (size_t)job * QR * 512, QR, 512, 16, (bf16_t*)(ws + WS_W_DQ) + (size_t)job * 2560 * QR + (size_t)2048 * QR, 0, 0.f, scr, r % I5, F.lane); }
    }
    { const f32x4* x4 = (const f32x4*)INP(IN_X); u32x2* xb = (u32x2*)(ws + WS_XB); const size_t n4 = (size_t)M * D / 4;
      for (size_t i = (size_t)F.c * NTHREADS + F.tid; i < n4; i += (size_t)F.G * NTHREADS) { const f32x4 v = x4[i]; u32x2 o; o.x = cvt_pk_bf16(v[0], v[1]); o.y = cvt_pk_bf16(v[2], v[3]); xb[i] = o; } }
    __syncthreads();
    const float qscale = 0.08838834764831845f * 1.4426950408889634f;
    for (int it = F.c; it < 256 + 1024; it += F.G) {
        if (it < 256) { const int j = it >> 7, h = (it >> 4) & 7, ib = (it >> 2) & 3, jb = it & 3;
            p0_combo_item(F, INP(IN_DWUQ) + (size_t)j * QR * D + (size_t)(64 * ib) * D + h * 128, D, INP(IN_DWUK) + ((size_t)j * 8 + h) * 128 * KVR + 64 * jb, KVR,
                          (bf16_t*)(ws + WS_W_DQ) + (size_t)j * 2560 * QR + (size_t)(h * 256 + 64 * jb) * QR + 64 * ib, QR, qscale);
        } else { const int r = it - 256, j = r >> 9, h = (r >> 6) & 7, ib = (r >> 4) & 3, jb = r & 15;
            p0_combo_item(F, INP(IN_DWUV) + (((size_t)j * 8 + h) * KVR + 64 * ib) * 128, 128, INP(IN_DWOUT) + (size_t)j * D * D + (size_t)(h * 128) * D + 64 * jb, D,
#if MK_B6_FP8
                          (bf16_t*)(ws + WS_W_DO + (size_t)j * D * 2048 + (size_t)(64 * jb) * 2048 + h * 256 + 64 * ib), 2048, F8_WDO, true);
#else
                          (bf16_t*)(ws + WS_W_DO) + (size_t)j * D * 2048 + (size_t)(64 * jb) * 2048 + h * 256 + 64 * ib, 2048, 1.0f);
#endif
        }
    }
}

__device__ __forceinline__ void unpack8(const u32x4 w, float* v) {
#pragma unroll
    for (int q = 0; q < 4; ++q) { v[2 * q] = __uint_as_float(w[q] << 16); v[2 * q + 1] = __uint_as_float(w[q] & 0xffff0000u); }
}
__device__ __forceinline__ void load_row_bf16(const bf16_t* row, int lane, float (&v)[16]) {
    const u32x4 a = *(const u32x4*)(row + 8 * lane), b = *(const u32x4*)(row + 512 + 8 * lane); unpack8(a, v); unpack8(b, v + 8);
}
__device__ __forceinline__ void load_vec_f32(const float* p, int lane, float (&v)[16]) {
#pragma unroll
    for (int h = 0; h < 2; ++h)
#pragma unroll
        for (int q = 0; q < 2; ++q) { const f32x4 x = *(const f32x4*)(p + 512 * h + 8 * lane + 4 * q); v[8 * h + 4 * q] = x[0]; v[8 * h + 4 * q + 1] = x[1]; v[8 * h + 4 * q + 2] = x[2]; v[8 * h + 4 * q + 3] = x[3]; }
}
__device__ __forceinline__ void store_row_bf16(const float (&v)[16], bf16_t* row, int lane) {
    u32x4 a, b;
#pragma unroll
    for (int q = 0; q < 4; ++q) { a[q] = cvt_pk_bf16(v[2 * q], v[2 * q + 1]); b[q] = cvt_pk_bf16(v[8 + 2 * q], v[8 + 2 * q + 1]); }
    *(u32x4*)(row + 8 * lane) = a; *(u32x4*)(row + 512 + 8 * lane) = b;
}
__device__ __forceinline__ void store_row_fp8(const float (&v)[16], unsigned char* row, int lane) {
    u32x2 o0, o1; o0.x = pack4_fp8(v[0] * F8_X, v[1] * F8_X, v[2] * F8_X, v[3] * F8_X); o0.y = pack4_fp8(v[4] * F8_X, v[5] * F8_X, v[6] * F8_X, v[7] * F8_X);
    o1.x = pack4_fp8(v[8] * F8_X, v[9] * F8_X, v[10] * F8_X, v[11] * F8_X); o1.y = pack4_fp8(v[12] * F8_X, v[13] * F8_X, v[14] * F8_X, v[15] * F8_X);
    *(u32x2*)(row + 8 * lane) = o0; *(u32x2*)(row + 512 + 8 * lane) = o1;
}
__device__ __forceinline__ void store_row_f32(const float (&v)[16], float* row, int lane) {
#pragma unroll
    for (int h = 0; h < 2; ++h)
#pragma unroll
        for (int q = 0; q < 2; ++q) *(f32x4*)(row + 512 * h + 8 * lane + 4 * q) = (f32x4){v[8 * h + 4 * q], v[8 * h + 4 * q + 1], v[8 * h + 4 * q + 2], v[8 * h + 4 * q + 3]};
}
__device__ __forceinline__ void ln_row(float (&v)[16], const float (&g)[16], const float (&b)[16]) {
    float s = 0.f;
#pragma unroll
    for (int i = 0; i < 16; ++i) s += v[i];
    const float mean = wave_sum(s) * (1.f / D); float s2 = 0.f;
#pragma unroll
    for (int i = 0; i < 16; ++i) { v[i] -= mean; s2 += v[i] * v[i]; }
    const float rstd = 1.f / sqrtf(wave_sum(s2) * (1.f / D) + LN_EPS);
#pragma unroll
    for (int i = 0; i < 16; ++i) v[i] = v[i] * rstd * g[i] + b[i];
}
__device__ __forceinline__ void ln_phase(Frame& F, const bf16_t* Y, const float* g, const float* b, bf16_t* XB, unsigned char* XB8) {
    float gv[16], bv[16]; load_vec_f32(g, F.lane, gv); load_vec_f32(b, F.lane, bv);
    const int gw = F.c * NWAVES + F.wave, NGW = F.G * NWAVES;
    for (int m = gw; m < M; m += NGW) {
        float v[16]; load_row_bf16(Y + (size_t)m * D, F.lane, v);
        ln_row(v, gv, bv);
        store_row_bf16(v, XB + (size_t)m * D, F.lane);
        if (XB8) store_row_fp8(v, XB8 + (size_t)m * D, F.lane);
    }
}
__device__ __forceinline__ void ln_moe_phase(Frame& F, const bf16_t* Xin, const bf16_t* OUTM, const int* EIDX, const int* POS, const unsigned* gcnt, const float* g, const float* b, bf16_t* XB, float* OUT) {
    float gv[16], bv[16]; load_vec_f32(g, F.lane, gv); load_vec_f32(b, F.lane, bv);
    int roff[8]; { int t = 0;
#pragma unroll
        for (int e = 0; e < 8; ++e) { roff[e] = t * 256; t += (__builtin_amdgcn_readfirstlane((int)__hip_atomic_load(gcnt + e, __ATOMIC_RELAXED, __HIP_MEMORY_SCOPE_AGENT)) + 255) >> 8; } }
    const int gw = F.c * NWAVES + F.wave, NGW = F.G * NWAVES;
    for (int m = gw; m < M; m += NGW) {
        const int e0 = EIDX[2 * m], e1 = EIDX[2 * m + 1]; int s0 = POS[2 * m], s1 = POS[2 * m + 1];
#pragma unroll
        for (int k = 0; k < 8; ++k) { s0 += (e0 == k) ? roff[k] : 0; s1 += (e1 == k) ? roff[k] : 0; }
        float v[16], o0[16], o1[16]; load_row_bf16(Xin + (size_t)m * D, F.lane, v); load_row_bf16(OUTM + (size_t)s0 * D, F.lane, o0); load_row_bf16(OUTM + (size_t)s1 * D, F.lane, o1);
#pragma unroll
        for (int i = 0; i < 16; ++i) v[i] = v[i] * ALPHA + o0[i] + o1[i];
        ln_row(v, gv, bv);
        if (OUT) store_row_f32(v, OUT + (size_t)m * D, F.lane); else store_row_bf16(v, XB + (size_t)m * D, F.lane);
    }
}
__device__ __forceinline__ void ln_router_phase(Frame& F, const bf16_t* Y, const float* g, const float* b, const float* wrouter, bf16_t* XB, unsigned char* XB8,
                                                int* EIDX, int* POS, int* TOK, float* GW, unsigned* gcnt) {
    LAS float* WR = (LAS float*)F.lds;
    LAS int* SEL = (LAS int*)(F.lds + 32768);
    LAS int* CW = (LAS int*)(F.lds + 32768 + 1024);
    LAS int* BASE = (LAS int*)(F.lds + 32768 + 1024 + 128);
    LAS float* SELW = (LAS float*)(F.lds + 32768 + 2048);
    for (int q = 0; q < 16; ++q) { const int idx = F.tid + NTHREADS * q; WR[(idx & 7) * 1024 + (idx >> 3)] = wrouter[idx]; }
    float gv[16], bv[16]; load_vec_f32(g, F.lane, gv); load_vec_f32(b, F.lane, bv);
    __syncthreads();
    for (int blk = F.c; blk < M / 128; blk += F.G) {
        for (int rl = F.wave; rl < 128; rl += NWAVES) {
            const int m = blk * 128 + rl;
            float v[16]; load_row_bf16(Y + (size_t)m * D, F.lane, v);
            ln_row(v, gv, bv);
            store_row_bf16(v, XB + (size_t)m * D, F.lane);
            if (XB8) store_row_fp8(v, XB8 + (size_t)m * D, F.lane);
            float lg[8];
#pragma unroll
            for (int e = 0; e < 8; ++e) { float s = 0.f;
#pragma unroll
                for (int h = 0; h < 2; ++h)
#pragma unroll
                    for (int q = 0; q < 2; ++q) { const f32x4 w = *(const LAS f32x4*)(WR + e * 1024 + 512 * h + 8 * F.lane + 4 * q); const int o = 8 * h + 4 * q;
                        s += (v[o] * w[0] + v[o + 1] * w[1]) + (v[o + 2] * w[2] + v[o + 3] * w[3]); }
                lg[e] = wave_sum(s); }
            int e0 = 0; float v0 = lg[0];
#pragma unroll
            for (int e = 1; e < 8; ++e) if (lg[e] > v0) { v0 = lg[e]; e0 = e; }
            int e1 = -1; float v1 = -3.0e38f;
#pragma unroll
            for (int e = 0; e < 8; ++e) if (e != e0 && lg[e] > v1) { v1 = lg[e]; e1 = e; }
            const float w1 = 1.f / (1.f + __expf(v0 - v1)), w0 = 1.f - w1;
            if (F.lane == 0) { SEL[2 * rl] = e0; SEL[2 * rl + 1] = e1; SELW[2 * rl] = w0; SELW[2 * rl + 1] = w1; EIDX[2 * m] = e0; EIDX[2 * m + 1] = e1; }
        }
        __syncthreads();
        const int mine = F.tid < 256 ? SEL[F.tid] : -1;
        int myrank = 0;
        if (F.wave < 4) {
#pragma unroll
            for (int e = 0; e < 8; ++e) { const unsigned long long mk = __ballot(mine == e); const int rk = __builtin_popcountll(mk & ((1ull << F.lane) - 1ull)); if (mine == e) myrank = rk;
                if (F.lane == 0) CW[F.wave * 8 + e] = __builtin_popcountll(mk); }
        }
        __syncthreads();
        if (F.tid < 8) { const int tot = CW[F.tid] + CW[8 + F.tid] + CW[16 + F.tid] + CW[24 + F.tid]; BASE[F.tid] = (int)__hip_atomic_fetch_add(gcnt + F.tid, (unsigned)tot, __ATOMIC_RELAXED, __HIP_MEMORY_SCOPE_AGENT); }
        __syncthreads();
        if (F.tid < 256) { int pos = BASE[mine] + myrank; for (int w = 0; w < F.wave; ++w) pos += CW[w * 8 + mine]; POS[blk * 256 + F.tid] = pos;
            TOK[(size_t)mine * M + pos] = blk * 128 + (F.tid >> 1); GW[(size_t)mine * M + pos] = SELW[F.tid]; }
        __syncthreads();
    }
}
__device__ __forceinline__ void hgrn_phase(Frame& F, const bf16_t* Q, const bf16_t* FP, const bf16_t* V, const float* lbparam, int jl, bf16_t* O) {
    constexpr int QST = 0, QS2 = 18432, KST = 36864, VS = 55296, SST0 = 64512, SSTB = 17408, SEG = 99328, RV = 103424, DV = 103936;
    constexpr int LQ = 136, LT = 72;
    LAS unsigned char* L = F.lds;
    const int tid = F.tid, lane = F.lane, w = F.wave, fr = lane & 15, fq = lane >> 4, qq = fr >> 2, pp = lane & 3;
    const int dp = tid & 63, seg = tid >> 6, d0 = 2 * dp;
    const int vrow = tid >> 3, vch = tid & 7;
    const int tt = w >> 1, eh = w & 1;
    for (int u = F.c; u < BATCH * HG_H * 2; u += F.G) {
        const int b = u >> 4, h = (u >> 1) & 7, vh = u & 1;
        float lb0 = 0.f, lb1 = 0.f;
        if (jl == 1) { const f32x2 l0 = *(const f32x2*)(lbparam + h * 128 + d0), l1 = *(const f32x2*)(lbparam + D + h * 128 + d0); lb0 = 1.f / (1.f + __expf(l0[0] - l1[0])); lb1 = 1.f / (1.f + __expf(l0[1] - l1[1])); }
        const float om0 = 1.f - lb0, om1 = 1.f - lb1;
        f32x4 St[4];
#pragma unroll
        for (int et = 0; et < 4; ++et) { St[et] = (f32x4){0.f, 0.f, 0.f, 0.f}; *(LAS u32x2*)(L + SST0 + ((16 * et + fr) * LQ + 16 * w + 4 * fq) * 2) = (u32x2){0u, 0u}; }
        const size_t ubase = (size_t)b * SEQ * D + h * 128;
        unsigned fpn[8], qn[8]; u32x4 vn;
        { const bf16_t* fp = FP + ubase + (size_t)(8 * seg) * D + d0; const bf16_t* qp = Q + ubase + (size_t)(8 * seg) * D + d0;
#pragma unroll
          for (int i = 0; i < 8; ++i) { fpn[i] = *(const unsigned*)(fp + (size_t)i * D); qn[i] = *(const unsigned*)(qp + (size_t)i * D); }
          vn = *(const u32x4*)(V + ubase + (size_t)vrow * D + vh * 64 + 8 * vch); }
        for (int ch = 0; ch < SEQ / HG_C; ++ch) {
            const size_t rowoff = ubase + (size_t)ch * HG_C * D;
            LAS unsigned char* SSTc = L + SST0 + (ch & 1) * SSTB; LAS unsigned char* SSTn = L + SST0 + ((ch + 1) & 1) * SSTB;
            float c0[8], c1[8], k0[8], k1[8], q0[8], q1[8];
            { float a0 = 0.f, a1 = 0.f;
#pragma unroll
              for (int i = 0; i < 8; ++i) { const float s0 = sigmoidf_(__uint_as_float(fpn[i] << 16)), s1 = sigmoidf_(__uint_as_float(fpn[i] & 0xffff0000u));
                  a0 += __logf(lb0 + om0 * s0); a1 += __logf(lb1 + om1 * s1); c0[i] = a0; c1[i] = a1; k0[i] = om0 * (1.f - s0); k1[i] = om1 * (1.f - s1);
                  q0[i] = __uint_as_float(qn[i] << 16); q1[i] = __uint_as_float(qn[i] & 0xffff0000u); }
              *(LAS f32x2*)(L + SEG + (seg * 128 + d0) * 4) = (f32x2){a0, a1};
              *(LAS u32x4*)(L + VS + (vrow * LT + 8 * vch) * 2) = vn; }
            __syncthreads();
            { float pre0 = 0.f, pre1 = 0.f, r0 = 0.f, r1 = 0.f, bl0 = 0.f, bl1 = 0.f;
#pragma unroll
              for (int s = 0; s < 8; ++s) { const f32x2 v = *(LAS f32x2*)(L + SEG + (s * 128 + d0) * 4);
                  if (s < seg) { pre0 += v[0]; pre1 += v[1]; } if (s < 4) { r0 += v[0]; r1 += v[1]; } bl0 += v[0]; bl1 += v[1]; }
              const float er0 = __expf(r0), er1 = __expf(r1);
              unsigned qa[4], qb[4], ka[4], xa[4], xb[4], kb[4];
#pragma unroll
              for (int i = 0; i < 8; i += 2) {
                  const float ba = pre0 + c0[i], bb = pre0 + c0[i + 1], bc = pre1 + c1[i], bd = pre1 + c1[i + 1];
                  const float qa0 = q0[i] * __expf(ba - r0), qa1 = q0[i + 1] * __expf(bb - r0), qb0 = q1[i] * __expf(bc - r1), qb1 = q1[i + 1] * __expf(bd - r1);
                  qa[i >> 1] = cvt_pk_bf16(qa0, qa1); qb[i >> 1] = cvt_pk_bf16(qb0, qb1);
                  xa[i >> 1] = cvt_pk_bf16(qa0 * er0, qa1 * er0); xb[i >> 1] = cvt_pk_bf16(qb0 * er1, qb1 * er1);
                  ka[i >> 1] = cvt_pk_bf16(k0[i] * __expf(r0 - ba), k0[i + 1] * __expf(r0 - bb)); kb[i >> 1] = cvt_pk_bf16(k1[i] * __expf(r1 - bc), k1[i + 1] * __expf(r1 - bd));
              }
              const int o0 = (d0 * LT + 8 * seg) * 2, o1 = o0 + LT * 2;
              *(LAS u32x4*)(L + QST + o0) = (u32x4){qa[0], qa[1], qa[2], qa[3]}; *(LAS u32x4*)(L + QST + o1) = (u32x4){qb[0], qb[1], qb[2], qb[3]};
              *(LAS u32x4*)(L + QS2 + o0) = (u32x4){xa[0], xa[1], xa[2], xa[3]}; *(LAS u32x4*)(L + QS2 + o1) = (u32x4){xb[0], xb[1], xb[2], xb[3]};
              *(LAS u32x4*)(L + KST + o0) = (u32x4){ka[0], ka[1], ka[2], ka[3]}; *(LAS u32x4*)(L + KST + o1) = (u32x4){kb[0], kb[1], kb[2], kb[3]};
              if (seg == 0) { *(LAS f32x2*)(L + RV + d0 * 4) = (f32x2){er0, er1}; *(LAS f32x2*)(L + DV + d0 * 4) = (f32x2){__expf(bl0 - r0), __expf(bl1 - r1)}; } }
            __syncthreads();
            if (ch + 1 < SEQ / HG_C) {
                const bf16_t* fp = FP + rowoff + (size_t)(HG_C + 8 * seg) * D + d0; const bf16_t* qp = Q + rowoff + (size_t)(HG_C + 8 * seg) * D + d0;
#pragma unroll
                for (int i = 0; i < 8; ++i) { fpn[i] = *(const unsigned*)(fp + (size_t)i * D); qn[i] = *(const unsigned*)(qp + (size_t)i * D); }
                vn = *(const u32x4*)(V + rowoff + (size_t)(HG_C + vrow) * D + vh * 64 + 8 * vch);
            }
            bf16x8 Pf[2];
            { f32x4 sc[4];
#pragma unroll
              for (int st = 0; st < 4; ++st) { sc[st] = (f32x4){0.f, 0.f, 0.f, 0.f};
                  if (st <= tt) {
#pragma unroll
                      for (int ks = 0; ks < 4; ++ks) {
                          const int ro = ((32 * ks + 8 * fq + qq) * LT + 4 * pp) * 2;
                          const s16x4 a0 = __builtin_amdgcn_ds_read_tr16_b64_v4i16((LAS s16x4*)(L + KST + ro + 32 * st)), a1 = __builtin_amdgcn_ds_read_tr16_b64_v4i16((LAS s16x4*)(L + KST + ro + 4 * LT * 2 + 32 * st));
                          const s16x4 b0 = __builtin_amdgcn_ds_read_tr16_b64_v4i16((LAS s16x4*)(L + QST + ro + 32 * tt)), b1 = __builtin_amdgcn_ds_read_tr16_b64_v4i16((LAS s16x4*)(L + QST + ro + 4 * LT * 2 + 32 * tt));
                          const bf16x8 av = (bf16x8){a0[0], a0[1], a0[2], a0[3], a1[0], a1[1], a1[2], a1[3]}, bv = (bf16x8){b0[0], b0[1], b0[2], b0[3], b1[0], b1[1], b1[2], b1[3]};
                          sc[st] = __builtin_amdgcn_mfma_f32_16x16x32_bf16(av, bv, sc[st], 0, 0, 0); }
#pragma unroll
                      for (int r = 0; r < 4; ++r) sc[st][r] = (16 * st + 4 * fq + r <= 16 * tt + fr) ? sc[st][r] : 0.f;
                  } }
              const u32x4 p0 = pack8(sc[0], sc[1]), p1 = pack8(sc[2], sc[3]); Pf[0] = __builtin_bit_cast(bf16x8, p0); Pf[1] = __builtin_bit_cast(bf16x8, p1); }
            { bf16x8 q2[4];
#pragma unroll
              for (int ks = 0; ks < 4; ++ks) { const int ro = ((32 * ks + 8 * fq + qq) * LT + 4 * pp) * 2 + 32 * tt;
                  const s16x4 b0 = __builtin_amdgcn_ds_read_tr16_b64_v4i16((LAS s16x4*)(L + QS2 + ro)), b1 = __builtin_amdgcn_ds_read_tr16_b64_v4i16((LAS s16x4*)(L + QS2 + ro + 4 * LT * 2));
                  q2[ks] = (bf16x8){b0[0], b0[1], b0[2], b0[3], b1[0], b1[1], b1[2], b1[3]}; }
#pragma unroll
              for (int ex = 0; ex < 2; ++ex) { const int et = 2 * eh + ex;
                  f32x4 acc = (f32x4){0.f, 0.f, 0.f, 0.f};
#pragma unroll
                  for (int k2 = 0; k2 < 2; ++k2) {
                      if (k2 == 0 || tt >= 2) {
                          const int ro = ((32 * k2 + 4 * fq + qq) * LT + 16 * et + 4 * pp) * 2;
                          const s16x4 a0 = __builtin_amdgcn_ds_read_tr16_b64_v4i16((LAS s16x4*)(L + VS + ro)), a1 = __builtin_amdgcn_ds_read_tr16_b64_v4i16((LAS s16x4*)(L + VS + ro + 16 * LT * 2));
                          const bf16x8 av = (bf16x8){a0[0], a0[1], a0[2], a0[3], a1[0], a1[1], a1[2], a1[3]};
                          acc = __builtin_amdgcn_mfma_f32_16x16x32_bf16(av, Pf[k2], acc, 0, 0, 0); } }
#pragma unroll
                  for (int ks = 0; ks < 4; ++ks) { const bf16x8 av = *(LAS bf16x8*)(SSTc + ((16 * et + fr) * LQ + 32 * ks + 8 * fq) * 2);
                      acc = __builtin_amdgcn_mfma_f32_16x16x32_bf16(av, q2[ks], acc, 0, 0, 0); }
                  u32x2 ov; ov.x = cvt_pk_bf16(acc[0], acc[1]); ov.y = cvt_pk_bf16(acc[2], acc[3]);
                  *(u32x2*)(O + rowoff + (size_t)(16 * tt + fr) * D + vh * 64 + 16 * et + 4 * fq) = ov;
              } }
            { const f32x4 rv = *(LAS f32x4*)(L + RV + (16 * w + 4 * fq) * 4), dv = *(LAS f32x4*)(L + DV + (16 * w + 4 * fq) * 4);
              bf16x8 kf[2];
#pragma unroll
              for (int ks = 0; ks < 2; ++ks) kf[ks] = *(LAS bf16x8*)(L + KST + ((16 * w + fr) * LT + 32 * ks + 8 * fq) * 2);
#pragma unroll
              for (int et = 0; et < 4; ++et) { St[et] = St[et] * rv;
#pragma unroll
                  for (int ks = 0; ks < 2; ++ks) { const int ro = ((32 * ks + 8 * fq + qq) * LT + 16 * et + 4 * pp) * 2;
                      const s16x4 b0 = __builtin_amdgcn_ds_read_tr16_b64_v4i16((LAS s16x4*)(L + VS + ro)), b1 = __builtin_amdgcn_ds_read_tr16_b64_v4i16((LAS s16x4*)(L + VS + ro + 4 * LT * 2));
                      const bf16x8 bb = (bf16x8){b0[0], b0[1], b0[2], b0[3], b1[0], b1[1], b1[2], b1[3]};
                      St[et] = __builtin_amdgcn_mfma_f32_16x16x32_bf16(kf[ks], bb, St[et], 0, 0, 0); }
                  St[et] = St[et] * dv;
                  u32x2 o; o.x = cvt_pk_bf16(St[et][0], St[et][1]); o.y = cvt_pk_bf16(St[et][2], St[et][3]);
                  *(LAS u32x2*)(SSTn + ((16 * et + fr) * LQ + 16 * w + 4 * fq) * 2) = o; } }
            __syncthreads();
        }
    }
}
__device__ __forceinline__ void hgrn_gate_phase(Frame& F, const bf16_t* O, const bf16_t* Gt, const float* ng, bf16_t* OG) {
    float gw_[16];
#pragma unroll
    for (int i = 0; i < 16; ++i) gw_[i] = ng[16 * F.lane + i];
    const int gw = F.c * NWAVES + F.wave, NGW = F.G * NWAVES;
    for (int m = gw; m < M; m += NGW) {
        const u32x4 o0 = *(const u32x4*)(O + (size_t)m * D + 16 * F.lane), o1 = *(const u32x4*)(O + (size_t)m * D + 16 * F.lane + 8);
        const u32x4 g0 = *(const u32x4*)(Gt + (size_t)m * D + 16 * F.lane), g1 = *(const u32x4*)(Gt + (size_t)m * D + 16 * F.lane + 8);
        float ov[16], gv[16];
#pragma unroll
        for (int i = 0; i < 4; ++i) { ov[2 * i] = __uint_as_float(o0[i] << 16); ov[2 * i + 1] = __uint_as_float(o0[i] & 0xffff0000u); ov[8 + 2 * i] = __uint_as_float(o1[i] << 16); ov[8 + 2 * i + 1] = __uint_as_float(o1[i] & 0xffff0000u);
            gv[2 * i] = __uint_as_float(g0[i] << 16); gv[2 * i + 1] = __uint_as_float(g0[i] & 0xffff0000u); gv[8 + 2 * i] = __uint_as_float(g1[i] << 16); gv[8 + 2 * i + 1] = __uint_as_float(g1[i] & 0xffff0000u); }
        float ss = 0.f;
#pragma unroll
        for (int i = 0; i < 16; ++i) ss += ov[i] * ov[i];
        ss += __builtin_bit_cast(float, __builtin_amdgcn_update_dpp(0, __builtin_bit_cast(int, ss), 0xB1, 0xF, 0xF, true));
        ss += __builtin_bit_cast(float, __builtin_amdgcn_update_dpp(0, __builtin_bit_cast(int, ss), 0x4E, 0xF, 0xF, true));
        ss += __builtin_bit_cast(float, __builtin_amdgcn_update_dpp(0, __builtin_bit_cast(int, ss), 0x141, 0xF, 0xF, true));
        const float rs = 1.f / sqrtf(ss * (1.f / 128.f) + RMS_EPS);
        float r[16];
#pragma unroll
        for (int i = 0; i < 16; ++i) r[i] = ov[i] * rs * gw_[i] * siluf_(gv[i]);
        u32x4 w0, w1; w0.x = cvt_pk_bf16(r[0], r[1]); w0.y = cvt_pk_bf16(r[2], r[3]); w0.z = cvt_pk_bf16(r[4], r[5]); w0.w = cvt_pk_bf16(r[6], r[7]);
        w1.x = cvt_pk_bf16(r[8], r[9]); w1.y = cvt_pk_bf16(r[10], r[11]); w1.z = cvt_pk_bf16(r[12], r[13]); w1.w = cvt_pk_bf16(r[14], r[15]);
        *(u32x4*)(OG + (size_t)m * D + 16 * F.lane) = w0; *(u32x4*)(OG + (size_t)m * D + 16 * F.lane + 8) = w1;
    }
}

__device__ __forceinline__ void dsa_norm_phase(Frame& F, const bf16_t* RAW, const float* qg, const float* kvg, const float* kig, const float* kib, bf16_t* CQ, bf16_t* CKV, bf16_t* KIDX, float* WIDX) {
    const f32x4 qgv = *(const f32x4*)(qg + 4 * F.lane), kvgv = *(const f32x4*)(kvg + 4 * F.lane); const float kg = kig[F.lane], kb = kib[F.lane];
    const int gw = F.c * NWAVES + F.wave, NGW = F.G * NWAVES;
    for (int m = gw; m < M; m += NGW) {
        const bf16_t* r = RAW + (size_t)m * DSA_IN_PAD;
        const u32x2 ar = *(const u32x2*)(r + 4 * F.lane), cr = *(const u32x2*)(r + 256 + 4 * F.lane); const float ki = bf2f(r[512 + F.lane]);
        const f32x4 a = (f32x4){__uint_as_float(ar.x << 16), __uint_as_float(ar.x & 0xffff0000u), __uint_as_float(ar.y << 16), __uint_as_float(ar.y & 0xffff0000u)};
        const f32x4 c = (f32x4){__uint_as_float(cr.x << 16), __uint_as_float(cr.x & 0xffff0000u), __uint_as_float(cr.y << 16), __uint_as_float(cr.y & 0xffff0000u)};
        const float sa = wave_sum((a[0] * a[0] + a[1] * a[1]) + (a[2] * a[2] + a[3] * a[3])), sc = wave_sum((c[0] * c[0] + c[1] * c[1]) + (c[2] * c[2] + c[3] * c[3]));
        const float ra = 1.f / sqrtf(sa * (1.f / 256.f) + RMS_EPS), rc = 1.f / sqrtf(sc * (1.f / 256.f) + RMS_EPS);
        u32x2 o; o.x = cvt_pk_bf16(a[0] * ra * qgv[0], a[1] * ra * qgv[1]); o.y = cvt_pk_bf16(a[2] * ra * qgv[2], a[3] * ra * qgv[3]); *(u32x2*)(CQ + (size_t)m * 256 + 4 * F.lane) = o;
        o.x = cvt_pk_bf16(c[0] * rc * kvgv[0], c[1] * rc * kvgv[1]); o.y = cvt_pk_bf16(c[2] * rc * kvgv[2], c[3] * rc * kvgv[3]); *(u32x2*)(CKV + (size_t)m * 256 + 4 * F.lane) = o;
        const float mu = wave_sum(ki) * (1.f / 64.f), dk = ki - mu, var = wave_sum(dk * dk) * (1.f / 64.f);
        KIDX[(size_t)m * 64 + F.lane] = f2bf(dk * (1.f / sqrtf(var + LN_EPS)) * kg + kb);
        if (F.lane < 8) WIDX[(size_t)m * 8 + F.lane] = bf2f(r[576 + F.lane]) * 0.04419417382415922f;
    }
}
__device__ __forceinline__ unsigned f2ord(float v) { const unsigned u = __float_as_uint(v); return (u & 0x80000000u) ? ~u : (u | 0x80000000u); }
__device__ __forceinline__ void dsa_index_phase(Frame& F, const bf16_t* QIDX, const bf16_t* KIDX, const float* WIDX, unsigned long long* MASK) {
    LAS float* SC = (LAS float*)F.lds;
    const int lane = F.lane, w = F.wave, fr = lane & 15, fq = lane >> 4;
    for (int i = 0;; ++i) {
        const int u = i * F.G + F.c; if (u >= BATCH * (SEQ / 16)) break;
        const int b = (u & 255) >> 4, qlo = (u & 15) + 16 * (u >> 9), qt = ((u >> 8) & 1) ? 127 - qlo : qlo, t0 = 16 * qt;     const size_t rb = (size_t)b * SEQ;
        bf16x8 Af[4][2][2]; float wv[4][8];
#pragma unroll
        for (int tg = 0; tg < 4; ++tg) {
#pragma unroll
            for (int hh = 0; hh < 2; ++hh)
#pragma unroll
                for (int ks = 0; ks < 2; ++ks) Af[tg][hh][ks] = *(const bf16x8*)(QIDX + (rb + t0 + 4 * tg + (fr >> 2)) * 512 + (4 * hh + (fr & 3)) * 64 + 32 * ks + 8 * fq);
            const f32x4 w0 = *(const f32x4*)(WIDX + (rb + t0 + 4 * tg + fq) * 8), w1 = *(const f32x4*)(WIDX + (rb + t0 + 4 * tg + fq) * 8 + 4);
#pragma unroll
            for (int r = 0; r < 4; ++r) { wv[tg][r] = w0[r]; wv[tg][4 + r] = w1[r]; }
        }
        bf16x8 nB0 = *(const bf16x8*)(KIDX + (rb + 16 * w + fr) * 64 + 8 * fq), nB1 = *(const bf16x8*)(KIDX + (rb + 16 * w + fr) * 64 + 32 + 8 * fq);
        for (int kg = w; kg <= qt; kg += NWAVES) {
            const bf16x8 B0 = nB0, B1 = nB1;
            { const int kn = (kg + NWAVES <= qt) ? kg + NWAVES : kg;
              nB0 = *(const bf16x8*)(KIDX + (rb + 16 * kn + fr) * 64 + 8 * fq); nB1 = *(const bf16x8*)(KIDX + (rb + 16 * kn + fr) * 64 + 32 + 8 * fq); }
#pragma unroll
            for (int tg = 0; tg < 4; ++tg) { float s = 0.f;
#pragma unroll
                for (int hh = 0; hh < 2; ++hh) { f32x4 acc = (f32x4){0.f, 0.f, 0.f, 0.f};
                    acc = __builtin_amdgcn_mfma_f32_16x16x32_bf16(Af[tg][hh][0], B0, acc, 0, 0, 0); acc = __builtin_amdgcn_mfma_f32_16x16x32_bf16(Af[tg][hh][1], B1, acc, 0, 0, 0);
#pragma unroll
                    for (int r = 0; r < 4; ++r) s += wv[tg][4 * hh + r] * fmaxf(acc[r], 0.f); }
                SC[(4 * tg + fq) * 2048 + 16 * kg + fr] = s + 0.0f; }
        }
        __syncthreads();
        for (int tq = 2 * w; tq < 2 * w + 2; ++tq) {
            const int t = t0 + tq;
            unsigned key[32];
#pragma unroll
            for (int r = 0; r < 32; ++r) { const int s = 64 * r + lane; key[r] = (s <= t) ? f2ord(SC[tq * 2048 + s]) : 0u; }
            unsigned long long selw = 0ull;
            if (t < TOPK) {
#pragma unroll
                for (int r = 0; r < 32; ++r) { const unsigned long long mk = __ballot(64 * r + lane <= t); if (lane == r) selw = mk; }
            } else {
                unsigned prefix = 0u; bool exact = false;
                for (int bit = 31; bit >= 0; --bit) {
                    const unsigned cand = prefix | (1u << bit); int cnt = 0;
#pragma unroll
                    for (int r = 0; r < 32; ++r) cnt += __builtin_popcountll(__ballot(key[r] >= cand));
                    if (cnt >= TOPK) { prefix = cand; if (cnt == TOPK) { exact = true; break; } }
                }
                if (exact) {
#pragma unroll
                    for (int r = 0; r < 32; ++r) { const unsigned long long mk = __ballot(key[r] >= prefix); if (lane == r) selw = mk; }
                } else {
                    int ngt = 0;
#pragma unroll
                    for (int r = 0; r < 32; ++r) ngt += __builtin_popcountll(__ballot(key[r] > prefix));
                    const int need = TOPK - ngt; int run = 0;
#pragma unroll
                    for (int r = 0; r < 32; ++r) { const unsigned long long tie = __ballot(key[r] == prefix); const int rk = run + __builtin_popcountll(tie & ((1ull << lane) - 1ull));
                        const unsigned long long mk = __ballot(key[r] > prefix || (key[r] == prefix && rk < need)); if (lane == r) selw = mk; run += __builtin_popcountll(tie); }
                }
            }
            if (lane < 32) MASK[(rb + t) * 32 + lane] = selw;
        }
        __syncthreads();
    }
}
__device__ __forceinline__ void dsa_attn_phase(Frame& F, const bf16_t* QLAT, const bf16_t* CKV, const unsigned long long* MASK, bf16_t* OLAT, unsigned char* OLAT8) {
    constexpr int TB = 32768;
    LAS unsigned char* L = F.lds;
    const int lane = F.lane, w = F.wave, fr = lane & 15, fq = lane >> 4;
    const int qq = fr >> 2, pp = lane & 3;
    const bool grpB = w >= 4;
    const int kbase = fr * 512, ysh = (fq ^ (2 * (fr & 7))) << 4;
    const int x2s = (2 * (4 * (fq & 1) + qq)) << 4;
    const int vbase = (4 * fq + qq) * 512 + (pp >> 1) * 16 + (pp & 1) * 8;
    const int drow = lane >> 5, dpc = lane & 31;
    for (int i = 0;; ++i) {
        const int u = i * F.G + F.c; if (u >= BATCH * (SEQ / 16)) break;
        const int b = (u & 255) >> 4, qlo = (u & 15) + 16 * (u >> 9), qt = ((u >> 8) & 1) ? 127 - qlo : qlo, t0 = 16 * qt;     const size_t rb = (size_t)b * SEQ;
        const int ntiles = (t0 + 15) / 64 + 1;
        bf16x8 Qf[8];
#pragma unroll
        for (int ks = 0; ks < 8; ++ks) Qf[ks] = *(const bf16x8*)(QLAT + (rb + t0 + fr) * 2048 + w * 256 + 32 * ks + 8 * fq);
        f32x4 Ot[16];
#pragma unroll
        for (int cb = 0; cb < 16; ++cb) Ot[cb] = (f32x4){0.f, 0.f, 0.f, 0.f};
        float mrun = -1.0e30f, lsum = 0.f;
        bf16x8 Pf[2];
#define ATT_DMA(kt_, buf_) do { _Pragma("unroll") for (int q_ = 0; q_ < 4; ++q_) { const int row_ = 2 * (4 * w + q_) + drow; \
            __builtin_amdgcn_global_load_lds((const unsigned*)(CKV + (rb + 64 * (kt_) + row_) * 256 + 8 * (dpc ^ (2 * (row_ & 7)))), (LAS unsigned*)(L + (buf_) * TB + (4 * w + q_) * 1024), 16, 0, 0); } } while (0)
#define ATT_ST(buf_) do { int ka_[8]; { const int kb_t_ = kbase + (buf_) * TB; _Pragma("unroll") for (int ks = 0; ks < 8; ++ks) ka_[ks] = kb_t_ + ((64 * ks) ^ ysh); } \
            _Pragma("unroll") for (int kb = 0; kb < 4; ++kb) S[kb] = (f32x4){0.f, 0.f, 0.f, 0.f}; \
            bf16x8 kf[2][2]; \
            _Pragma("unroll") for (int j = 0; j < 2; ++j) kf[0][j] = *(LAS bf16x8*)(L + ka_[j]); \
            _Pragma("unroll") for (int bt = 0; bt < 16; ++bt) {        \
                if (bt + 1 < 16) { _Pragma("unroll") for (int j = 0; j < 2; ++j) kf[(bt + 1) & 1][j] = *(LAS bf16x8*)(L + ka_[2 * ((bt + 1) & 3) + j] + 8192 * ((bt + 1) >> 2)); } \
                _Pragma("unroll") for (int j = 0; j < 2; ++j) S[bt >> 2] = __builtin_amdgcn_mfma_f32_16x16x32_bf16(kf[bt & 1][j], Qf[2 * (bt & 3) + j], S[bt >> 2], 0, 0, 0); \
                __builtin_amdgcn_sched_barrier(0); } } while (0)
#define ATT_SOFTMAX(mw_) do { \
            float mx = fmaxf(fmaxf(fmaxf(S[0][0], S[0][1]), fmaxf(S[0][2], S[0][3])), fmaxf(fmaxf(S[1][0], S[1][1]), fmaxf(S[1][2], S[1][3]))); \
            mx = fmaxf(mx, fmaxf(fmaxf(fmaxf(S[2][0], S[2][1]), fmaxf(S[2][2], S[2][3])), fmaxf(fmaxf(S[3][0], S[3][1]), fmaxf(S[3][2], S[3][3])))); \
            mx = fmaxf(mx, __shfl_xor(mx, 16)); mx = fmaxf(mx, __shfl_xor(mx, 32)); \
            const bool need = mx > mrun + 8.0f; \
            if (__any(need)) { const float mnew = need ? mx : mrun, alpha = fast_exp2(mrun - mnew); mrun = mnew; lsum *= alpha; \
                _Pragma("unroll") for (int cb = 0; cb < 16; ++cb) Ot[cb] = Ot[cb] * alpha; } \
            const unsigned long long mq = (mw_) >> (4 * fq); const unsigned mlo = (unsigned)mq, mhi = (unsigned)(mq >> 32); \
            _Pragma("unroll") for (int kb = 0; kb < 4; ++kb) _Pragma("unroll") for (int r = 0; r < 4; ++r) { \
                const unsigned mk = (unsigned)__builtin_amdgcn_sbfe((int)(kb < 2 ? mlo : mhi), 16 * (kb & 1) + r, 1); \
                const float pv = __uint_as_float(__float_as_uint(fast_exp2(S[kb][r] - mrun)) & mk); S[kb][r] = pv; lsum += pv; } \
            _Pragma("unroll") for (int s2 = 0; s2 < 2; ++s2) { const u32x4 pk = pack8(S[2 * s2], S[2 * s2 + 1]); Pf[s2] = __builtin_bit_cast(bf16x8, pk); } } while (0)
#define ATT_VLOAD(dst, vb_, cb_) do { const int va_ = (vb_) + ((32 * (cb_)) ^ x2s); \
            dst[0] = __builtin_amdgcn_ds_read_tr16_b64_v4i16((LAS s16x4*)(L + va_)); dst[1] = __builtin_amdgcn_ds_read_tr16_b64_v4i16((LAS s16x4*)(L + va_ + 16 * 512)); \
            dst[2] = __builtin_amdgcn_ds_read_tr16_b64_v4i16((LAS s16x4*)(L + va_ + 32 * 512)); dst[3] = __builtin_amdgcn_ds_read_tr16_b64_v4i16((LAS s16x4*)(L + va_ + 48 * 512)); } while (0)
#define ATT_PV(buf_) do { const int vb_ = vbase + (buf_) * TB; s16x4 tv[2][4]; ATT_VLOAD(tv[0], vb_, 0); \
            _Pragma("unroll") for (int cb = 0; cb < 16; ++cb) { \
                if (cb + 1 < 16) ATT_VLOAD(tv[(cb + 1) & 1], vb_, cb + 1); \
                const s16x4 a0 = tv[cb & 1][0], a1 = tv[cb & 1][1], a2 = tv[cb & 1][2], a3 = tv[cb & 1][3]; \
                const bf16x8 v0 = (bf16x8){a0[0], a0[1], a0[2], a0[3], a1[0], a1[1], a1[2], a1[3]}; \
                const bf16x8 v1 = (bf16x8){a2[0], a2[1], a2[2], a2[3], a3[0], a3[1], a3[2], a3[3]}; \
                Ot[cb] = __builtin_amdgcn_mfma_f32_16x16x32_bf16(v0, Pf[0], Ot[cb], 0, 0, 0); \
                Ot[cb] = __builtin_amdgcn_mfma_f32_16x16x32_bf16(v1, Pf[1], Ot[cb], 0, 0, 0); __builtin_amdgcn_sched_barrier(0); } } while (0)
        ATT_DMA(0, 0);
        unsigned long long mwn = MASK[(rb + t0 + fr) * 32];
        asm volatile("s_waitcnt vmcnt(0)" ::: "memory");
        __syncthreads();
        int bufc = 0;
        for (int it = 0; it < ntiles; ++it) {
            const int bufn = (bufc == 2) ? 0 : bufc + 1;
            if (it + 1 < ntiles) ATT_DMA(it + 1, bufn);
            const unsigned long long mw = mwn; mwn = MASK[(rb + t0 + fr) * 32 + ((it + 1 < ntiles) ? it + 1 : it)];
            f32x4 S[4];
            ATT_ST(bufc); ATT_SOFTMAX(mw);
            if (grpB) { asm volatile("s_waitcnt vmcnt(0)" ::: "memory"); __builtin_amdgcn_s_barrier(); asm volatile("" ::: "memory"); }
            ATT_PV(bufc);
            if (!grpB) { asm volatile("s_waitcnt vmcnt(0)" ::: "memory"); __builtin_amdgcn_s_barrier(); asm volatile("" ::: "memory"); }
            bufc = bufn;
        }
        __syncthreads();
#undef ATT_DMA
#undef ATT_ST
#undef ATT_SOFTMAX
#undef ATT_VLOAD
#undef ATT_PV
        lsum += __shfl_xor(lsum, 16); lsum += __shfl_xor(lsum, 32);
        const float inv = 1.f / lsum;
#pragma unroll
        for (int cb = 0; cb < 16; ++cb) {
            if (OLAT8) { const float i8 = inv * F8_O; *(unsigned*)(OLAT8 + (rb + t0 + fr) * 2048 + w * 256 + 16 * cb + 4 * fq) = pack4_fp8(Ot[cb][0] * i8, Ot[cb][1] * i8, Ot[cb][2] * i8, Ot[cb][3] * i8); }
            else { u32x2 o; o.x = cvt_pk_bf16(Ot[cb][0] * inv, Ot[cb][1] * inv); o.y = cvt_pk_bf16(Ot[cb][2] * inv, Ot[cb][3] * inv);
                *(u32x2*)(OLAT + (rb + t0 + fr) * 2048 + w * 256 + 16 * cb + 4 * fq) = o; } }
    }
}


__device__ __forceinline__ void dsa_norm8_phase(Frame& F, const bf16_t* RAW, const float* qg, const float* kvg, const float* kig, const float* kib, bf16_t* CQ, unsigned char* CKV8, unsigned char* CKVT8, bf16_t* KIDX, float* WIDX) {
    LAS unsigned char* T = F.lds;
    const f32x4 qgv = *(const f32x4*)(qg + 4 * F.lane), kvgv = *(const f32x4*)(kvg + 4 * F.lane); const float kg = kig[F.lane], kb = kib[F.lane];
    for (int blk = F.c; blk < M / 128; blk += F.G) {
        for (int rr = 0; rr < 16; ++rr) {
            const int rl = 16 * F.wave + rr, m = 128 * blk + rl;
            const bf16_t* r = RAW + (size_t)m * DSA_IN_PAD;
            const u32x2 ar = *(const u32x2*)(r + 4 * F.lane), cr = *(const u32x2*)(r + 256 + 4 * F.lane); const float ki = bf2f(r[512 + F.lane]);
            const f32x4 a = (f32x4){__uint_as_float(ar.x << 16), __uint_as_float(ar.x & 0xffff0000u), __uint_as_float(ar.y << 16), __uint_as_float(ar.y & 0xffff0000u)};
            const f32x4 c = (f32x4){__uint_as_float(cr.x << 16), __uint_as_float(cr.x & 0xffff0000u), __uint_as_float(cr.y << 16), __uint_as_float(cr.y & 0xffff0000u)};
            const float sa = wave_sum((a[0] * a[0] + a[1] * a[1]) + (a[2] * a[2] + a[3] * a[3])), sc = wave_sum((c[0] * c[0] + c[1] * c[1]) + (c[2] * c[2] + c[3] * c[3]));
            const float ra = 1.f / sqrtf(sa * (1.f / 256.f) + RMS_EPS), rc = F8_KV / sqrtf(sc * (1.f / 256.f) + RMS_EPS);
            u32x2 o; o.x = cvt_pk_bf16(a[0] * ra * qgv[0], a[1] * ra * qgv[1]); o.y = cvt_pk_bf16(a[2] * ra * qgv[2], a[3] * ra * qgv[3]); *(u32x2*)(CQ + (size_t)m * 256 + 4 * F.lane) = o;
            const unsigned c8 = pack4_fp8(c[0] * rc * kvgv[0], c[1] * rc * kvgv[1], c[2] * rc * kvgv[2], c[3] * rc * kvgv[3]);
            *(unsigned*)(CKV8 + (size_t)m * 256 + 4 * F.lane) = c8; *(LAS unsigned*)(T + rl * 260 + 4 * F.lane) = c8;
            const float mu = wave_sum(ki) * (1.f / 64.f), dk = ki - mu, var = wave_sum(dk * dk) * (1.f / 64.f);
            KIDX[(size_t)m * 64 + F.lane] = f2bf(dk * (1.f / sqrtf(var + LN_EPS)) * kg + kb);
            if (F.lane < 8) WIDX[(size_t)m * 8 + F.lane] = bf2f(r[576 + F.lane]) * 0.04419417382415922f;
        }
        __syncthreads();
        { const int dim = F.tid >> 1, half = F.tid & 1;
          unsigned char* dst = CKVT8 + (size_t)blk * 32768 + dim * 128 + 64 * half;
#pragma unroll
          for (int q4 = 0; q4 < 4; ++q4) { u32x4 o;
#pragma unroll
              for (int dd = 0; dd < 4; ++dd) { const int d = 4 * q4 + dd, key0 = 16 * (d & 7) + 4 * (2 * half + (d >> 3));
                  LAS unsigned char* tp = T + key0 * 260 + dim;
                  o[dd] = (unsigned)tp[0] | ((unsigned)tp[260] << 8) | ((unsigned)tp[520] << 16) | ((unsigned)tp[780] << 24); }
              *(u32x4*)(dst + 16 * q4) = o; } }
        __syncthreads();
    }
}
__device__ __forceinline__ void dsa_attn8_phase(Frame& F, const unsigned char* QLAT8, const unsigned char* CKV8, const unsigned char* CKVT8, const unsigned long long* MASK, unsigned char* OLAT8) {
    constexpr int TB = 65536, VOFF = 32768;
    LAS unsigned char* L = F.lds;
    const int lane = F.lane, w = F.wave, fr = lane & 15, fq = lane >> 4;
    const int gsw = ((fr >> 1) & 1) | (((fr >> 3) & 1) << 2);
    const int ka00 = fr * 256 + (((2 * fq) ^ fr) << 4), ka01 = fr * 256 + (((2 * fq + 1) ^ fr) << 4), ka10 = fr * 256 + (((8 + 2 * fq) ^ fr) << 4), ka11 = fr * 256 + (((9 + 2 * fq) ^ fr) << 4);
    const int va0 = VOFF + fr * 128 + (((2 * fq) ^ gsw) << 4), va1 = VOFF + fr * 128 + (((2 * fq + 1) ^ gsw) << 4);
    for (int i = 0;; ++i) {
        const int u = i * F.G + F.c; if (u >= BATCH * (SEQ / 16)) break;
        const int b = (u & 255) >> 4, qlo = (u & 15) + 16 * (u >> 9), qt = ((u >> 8) & 1) ? 127 - qlo : qlo, t0 = 16 * qt;     const size_t rb = (size_t)b * SEQ;
        const int ntiles = (t0 + 15) / 128 + 1;
        v8i32 Q8[2];
#pragma unroll
        for (int h = 0; h < 2; ++h) { const unsigned char* qp = QLAT8 + (rb + t0 + fr) * 2048 + w * 256 + 128 * h + 32 * fq;
            Q8[h] = __builtin_shufflevector(*(const v4i32*)qp, *(const v4i32*)(qp + 16), 0, 1, 2, 3, 4, 5, 6, 7); }
        f32x4 Ot[16];
#pragma unroll
        for (int cb = 0; cb < 16; ++cb) Ot[cb] = (f32x4){0.f, 0.f, 0.f, 0.f};
        float mrun = -1.0e30f, lsum = 0.f;
#define ATT_DMA(kt_, buf_) do { _Pragma("unroll") for (int q_ = 0; q_ < 4; ++q_) { const int ins_ = 4 * w + q_; \
            { const int row_ = 4 * ins_ + (lane >> 4); \
              __builtin_amdgcn_global_load_lds((const unsigned*)(CKV8 + (rb + 128 * (kt_) + row_) * 256 + 16 * ((lane & 15) ^ (row_ & 15))), (LAS unsigned*)(L + (buf_) * TB + ins_ * 1024), 16, 0, 0); } \
            { const int row_ = 8 * ins_ + (lane >> 3); const int g_ = ((lane >> 4) & 1) | ((ins_ & 1) << 2); \
              __builtin_amdgcn_global_load_lds((const unsigned*)(CKVT8 + ((rb >> 7) + (kt_)) * 32768 + row_ * 128 + 16 * ((lane & 7) ^ g_)), (LAS unsigned*)(L + (buf_) * TB + VOFF + ins_ * 1024), 16, 0, 0); } } } while (0)
#define ATT_KLOAD(dst, kb_o_) do { dst[0] = *(LAS v4i32*)(L + ka00 + (kb_o_)); dst[1] = *(LAS v4i32*)(L + ka01 + (kb_o_)); dst[2] = *(LAS v4i32*)(L + ka10 + (kb_o_)); dst[3] = *(LAS v4i32*)(L + ka11 + (kb_o_)); } while (0)
#define ATT_VLOAD(dst, vb_o_) do { dst[0] = *(LAS v4i32*)(L + va0 + (vb_o_)); dst[1] = *(LAS v4i32*)(L + va1 + (vb_o_)); } while (0)
        ATT_DMA(0, 0);
        u32x4 mwn = *(const u32x4*)(MASK + (rb + t0 + fr) * 32);
        asm volatile("s_waitcnt vmcnt(0)" ::: "memory");
        __syncthreads();
        int bufc = 0;
        for (int it = 0; it < ntiles; ++it) {
            const int bo = bufc * TB;
            if (it + 1 < ntiles) ATT_DMA(it + 1, bufc ^ 1);
            const u32x4 mw = mwn; mwn = *(const u32x4*)(MASK + (rb + t0 + fr) * 32 + 2 * ((it + 1 < ntiles) ? it + 1 : it));
            f32x4 S[8];
            { v4i32 kf[2][4]; ATT_KLOAD(kf[0], bo);
#pragma unroll
              for (int kb = 0; kb < 8; ++kb) {
                  if (kb + 1 < 8) ATT_KLOAD(kf[(kb + 1) & 1], bo + 4096 * (kb + 1));
                  f32x4 s = (f32x4){0.f, 0.f, 0.f, 0.f};
                  s = __builtin_amdgcn_mfma_scale_f32_16x16x128_f8f6f4(__builtin_shufflevector(kf[kb & 1][0], kf[kb & 1][1], 0, 1, 2, 3, 4, 5, 6, 7), Q8[0], s, 0, 0, 0, SC_S, 0, 0x7f7f7f7f);
                  s = __builtin_amdgcn_mfma_scale_f32_16x16x128_f8f6f4(__builtin_shufflevector(kf[kb & 1][2], kf[kb & 1][3], 0, 1, 2, 3, 4, 5, 6, 7), Q8[1], s, 0, 0, 0, SC_S, 0, 0x7f7f7f7f);
                  S[kb] = s; __builtin_amdgcn_sched_barrier(0); } }
            v8i32 P8;
            { float mx = S[0][0];
#pragma unroll
              for (int kb = 0; kb < 8; ++kb) mx = fmaxf(mx, fmaxf(fmaxf(S[kb][0], S[kb][1]), fmaxf(S[kb][2], S[kb][3])));
              mx = fmaxf(mx, __shfl_xor(mx, 16)); mx = fmaxf(mx, __shfl_xor(mx, 32));
              const bool need = mx > mrun + 8.0f;
              if (__any(need)) { const float mnew = need ? mx : mrun, alpha = fast_exp2(mrun - mnew); mrun = mnew; lsum *= alpha;
#pragma unroll
                  for (int cb = 0; cb < 16; ++cb) Ot[cb] = Ot[cb] * alpha; }
              const unsigned m0 = mw[0] >> (4 * fq), m1 = mw[1] >> (4 * fq), m2 = mw[2] >> (4 * fq), m3 = mw[3] >> (4 * fq);
#pragma unroll
              for (int kb = 0; kb < 8; ++kb) { const unsigned mm = (kb >> 1) == 0 ? m0 : (kb >> 1) == 1 ? m1 : (kb >> 1) == 2 ? m2 : m3; float pv[4];
#pragma unroll
                  for (int r = 0; r < 4; ++r) { const unsigned mk = (unsigned)__builtin_amdgcn_sbfe((int)mm, 16 * (kb & 1) + r, 1);
                      pv[r] = __uint_as_float(__float_as_uint(fast_exp2(S[kb][r] - mrun)) & mk); lsum += pv[r]; }
                  int pk = 0; pk = __builtin_amdgcn_cvt_pk_fp8_f32(pv[0], pv[1], pk, false); pk = __builtin_amdgcn_cvt_pk_fp8_f32(pv[2], pv[3], pk, true); P8[kb] = pk; } }
            { v4i32 vf[2][2]; ATT_VLOAD(vf[0], bo);
#pragma unroll
              for (int cb = 0; cb < 16; ++cb) {
                  if (cb + 1 < 16) ATT_VLOAD(vf[(cb + 1) & 1], bo + 2048 * (cb + 1));
                  Ot[cb] = __builtin_amdgcn_mfma_scale_f32_16x16x128_f8f6f4(__builtin_shufflevector(vf[cb & 1][0], vf[cb & 1][1], 0, 1, 2, 3, 4, 5, 6, 7), P8, Ot[cb], 0, 0, 0, SC_V, 0, 0x7f7f7f7f);
                  __builtin_amdgcn_sched_barrier(0); } }
            asm volatile("s_waitcnt vmcnt(0)" ::: "memory"); __builtin_amdgcn_s_barrier(); asm volatile("" ::: "memory");
            bufc ^= 1;
        }
#undef ATT_DMA
#undef ATT_KLOAD
#undef ATT_VLOAD
        lsum += __shfl_xor(lsum, 16); lsum += __shfl_xor(lsum, 32);
        const float i8 = F8_O / lsum;
#pragma unroll
        for (int cb = 0; cb < 16; ++cb)
            *(unsigned*)(OLAT8 + (rb + t0 + fr) * 2048 + w * 256 + 16 * cb + 4 * fq) = pack4_fp8(Ot[cb][0] * i8, Ot[cb][1] * i8, Ot[cb][2] * i8, Ot[cb][3] * i8);
    }
}

constexpr int PH_PER_PAIR = 18, N_PHASES = 1 + 2 * PH_PER_PAIR;

__global__ void __launch_bounds__(NTHREADS, 2) fwd_kernel(Params p) {
    extern __shared__ __attribute__((aligned(16))) unsigned char lds_raw[];
    Frame F;
    F.lds = (LAS unsigned char*)lds_raw;
    F.tid = threadIdx.x; F.lane = F.tid & 63; F.wave = __builtin_amdgcn_readfirstlane(F.tid >> 6);
    F.G = gridDim.x; F.c = blockIdx.x;
    unsigned char* ws = p.ws;
    F.ctl = (unsigned*)(ws + WS_CTL);
    for (int u = F.tid; u < (LDS_BYTES - LDSCTL_OFF) / 4; u += NTHREADS) ((LAS unsigned*)(F.lds + LDSCTL_OFF))[u] = 0u;
    __syncthreads();
    const bool one_launch = (p.ph_hi - p.ph_lo) > 1;
    XcdBarrier bar; bar.bar = F.ctl + CW_BAR; bar.x = 0; bar.st = nullptr;
    if (one_launch) bar = xcd_barrier_post(F.ctl + CW_BAR, (volatile LAS unsigned*)(F.lds + MISC_OFF) + 8);
    const int lo = p.ph_lo, hi = p.ph_hi;
#define REFRESH() do { int t_ = threadIdx.x; asm volatile("" : "+v"(t_)); F.tid = t_; F.lane = t_ & 63; F.wave = __builtin_amdgcn_readfirstlane(t_ >> 6); } while (0)
#ifndef DBLMASK
#define DBLMASK 0u
#endif
#define REP(b) for (int rep_ = 0; rep_ < 1 + (int)((DBLMASK >> (b)) & 1u); ++rep_)
#define IN(k) (lo <= (k) && (k) < hi)
#ifndef MK_BARTIME
#define MK_BARTIME 0
#endif
    unsigned long long bt_acc = 0ull;
#if MK_BARTIME
#define SEAM(k) do { if (IN(k) && IN((k) + 1)) { const unsigned long long t0_ = __builtin_amdgcn_s_memrealtime(); xcd_barrier(bar); bt_acc += __builtin_amdgcn_s_memrealtime() - t0_; } } while (0)
#else
#ifndef MK_DBLSEAM
#define MK_DBLSEAM 0
#endif
#define SEAM(k) do { if (IN(k) && IN((k) + 1)) { xcd_barrier(bar); if (MK_DBLSEAM) xcd_barrier(bar); } } while (0)
#endif

    bf16_t* XB = (bf16_t*)(ws + WS_XB); bf16_t* Y = (bf16_t*)(ws + WS_Y);
    unsigned char* A = ws + WS_A; bf16_t* Hb = (bf16_t*)(ws + WS_H);

    if (IN(0)) REP(31) { REFRESH(); p0_prologue(F, p); } SEAM(0);

    for (int j = 0; j < 2; ++j) {
        const int pb = 1 + j * PH_PER_PAIR;
        const int layerA = 2 * j, layerB = 2 * j + 1;
        if (IN(pb + 0)) REP(0) {
            Gemm g{XB, (const bf16_t*)(ws + WS_W_HGIN) + (size_t)j * 4 * D * D, D}; StaticOrder S; S.init(M, 4 * D, F.G, F.c);
            EpiHgIn E{(bf16_t*)(A + A_HQ)};
            gemm_phase(F.lds, g, S, E);
        } SEAM(pb + 0);
        if (IN(pb + 1)) REP(1) { REFRESH(); hgrn_phase(F, (const bf16_t*)(A + A_HQ), (const bf16_t*)(A + A_HF), (const bf16_t*)(A + A_HV), INP(IN_HGLB), j, (bf16_t*)(A + A_HO)); } SEAM(pb + 1);
        if (IN(pb + 2)) REP(2) { REFRESH(); hgrn_gate_phase(F, (const bf16_t*)(A + A_HO), (const bf16_t*)(A + A_HG), INP(IN_HGNG) + (size_t)j * D, (bf16_t*)(A + A_HOG)); } SEAM(pb + 2);
        if (IN(pb + 3)) REP(3) {
            Gemm g{(const bf16_t*)(A + A_HOG), (const bf16_t*)(ws + WS_W_HGOUT) + (size_t)j * D * D, D}; StaticOrder S; S.init(M, D, F.G, F.c);
            EpiRes E{XB, Y}; gemm_phase(F.lds, g, S, E);
        } SEAM(pb + 3);
        if (IN(pb + 4)) REP(4) { REFRESH(); ln_phase(F, Y, INP(IN_LNG) + (size_t)(layerA * 2 + 0) * D, INP(IN_LNB) + (size_t)(layerA * 2 + 0) * D, XB, (MK_FFN_FP8 == 2) ? ws + WS_XB8 : nullptr); } SEAM(pb + 4);
        if (IN(pb + 5)) REP(5) {
#if MK_FFN_FP8 == 2
            Gemm g{(const bf16_t*)(ws + WS_XB8), (const bf16_t*)(ws + WS_W_FGU + (size_t)j * 2 * DFF * D), D / 2, SC_UP}; StaticOrder S; S.init(M, 2 * DFF, F.G, F.c);
            EpiSwiglu8 E{(unsigned char*)Hb}; gemm_phase_gather<true, true>(F.lds, g, S, E, nullptr);
#elif MK_FFN_FP8 == 1
            Gemm g{XB, (const bf16_t*)(ws + WS_W_FGU) + (size_t)j * 2 * DFF * D, D}; StaticOrder S; S.init(M, 2 * DFF, F.G, F.c);
            EpiSwiglu8 E{(unsigned char*)Hb}; gemm_phase(F.lds, g, S, E);
#else
            Gemm g{XB, (const bf16_t*)(ws + WS_W_FGU) + (size_t)j * 2 * DFF * D, D}; StaticOrder S; S.init(M, 2 * DFF, F.G, F.c);
            EpiSwiglu E{Hb}; gemm_phase(F.lds, g, S, E);
#endif
        } SEAM(pb + 5);
        if (IN(pb + 6)) REP(6) {
#if MK_FFN_FP8 >= 1
            Gemm g{Hb, (const bf16_t*)(ws + WS_W_FDN + (size_t)j * D * DFF), DFF / 2, SC_DN}; StaticOrder S; S.init(M, D, F.G, F.c);
            EpiRes E{XB, Y}; gemm_phase_gather<true, true>(F.lds, g, S, E, nullptr);
#else
            Gemm g{Hb, (const bf16_t*)(ws + WS_W_FDN) + (size_t)j * D * DFF, DFF}; StaticOrder S; S.init(M, D, F.G, F.c);
            EpiRes E{XB, Y}; gemm_phase(F.lds, g, S, E);
#endif
        } SEAM(pb + 6);
        if (IN(pb + 7)) REP(7) { REFRESH(); ln_phase(F, Y, INP(IN_LNG) + (size_t)(layerA * 2 + 1) * D, INP(IN_LNB) + (size_t)(layerA * 2 + 1) * D, XB, nullptr); } SEAM(pb + 7);
        if (IN(pb + 8)) REP(8) {
            Gemm g{XB, (const bf16_t*)(ws + WS_W_DIN) + (size_t)j * DSA_IN_PAD * D, D}; StaticOrder S; S.init(M, DSA_IN_PAD, F.G, F.c);
            EpiBf16 E{(bf16_t*)(A + A_RAW), DSA_IN_PAD}; gemm_phase(F.lds, g, S, E);
        } SEAM(pb + 8);
#if MK_ATT_FP8
        if (IN(pb + 9)) REP(9) { REFRESH(); dsa_norm8_phase(F, (const bf16_t*)(A + A_RAW), INP(IN_DQNG) + (size_t)j * QR, INP(IN_DKVNG) + (size_t)j * KVR, INP(IN_DKIG) + (size_t)j * IDXD, INP(IN_DKIB) + (size_t)j * IDXD,
                                          (bf16_t*)(A + A_CQ), A + A_CKV, A + A_CKV + 8 * MiB, (bf16_t*)(A + A_KIDX), (float*)(A + A_WIDX)); } SEAM(pb + 9);
#else
        if (IN(pb + 9)) REP(9) { REFRESH(); dsa_norm_phase(F, (const bf16_t*)(A + A_RAW), INP(IN_DQNG) + (size_t)j * QR, INP(IN_DKVNG) + (size_t)j * KVR, INP(IN_DKIG) + (size_t)j * IDXD, INP(IN_DKIB) + (size_t)j * IDXD,
                                         (bf16_t*)(A + A_CQ), (bf16_t*)(A + A_CKV), (bf16_t*)(A + A_KIDX), (float*)(A + A_WIDX)); } SEAM(pb + 9);
#endif
        if (IN(pb + 10)) REP(10) {
            Gemm g{(const bf16_t*)(A + A_CQ), (const bf16_t*)(ws + WS_W_DQ) + (size_t)j * 2560 * QR, QR}; StaticOrder S; S.init(M, 2560, F.G, F.c);
#if MK_ATT_FP8
            EpiQ8 E{A + A_QLAT, (bf16_t*)(A + A_QIDX)}; gemm_phase(F.lds, g, S, E);
#else
            EpiQ E{(bf16_t*)(A + A_QLAT), (bf16_t*)(A + A_QIDX)}; gemm_phase(F.lds, g, S, E);
#endif
        } SEAM(pb + 10);
        if (IN(pb + 11)) REP(11) { REFRESH(); dsa_index_phase(F, (const bf16_t*)(A + A_QIDX), (const bf16_t*)(A + A_KIDX), (const float*)(A + A_WIDX), (unsigned long long*)(A + A_MASK)); } SEAM(pb + 11);
#if MK_ATT_FP8
        if (IN(pb + 12)) REP(12) { REFRESH(); dsa_attn8_phase(F, A + A_QLAT, A + A_CKV, A + A_CKV + 8 * MiB, (const unsigned long long*)(A + A_MASK), A + A_OLAT); } SEAM(pb + 12);
#else
        if (IN(pb + 12)) REP(12) { REFRESH(); dsa_attn_phase(F, (const bf16_t*)(A + A_QLAT), (const bf16_t*)(A + A_CKV), (const unsigned long long*)(A + A_MASK), (bf16_t*)(A + A_OLAT), MK_B6_FP8 ? A + A_OLAT : nullptr); } SEAM(pb + 12);
#endif
        if (IN(pb + 13)) REP(13) {
#if MK_B6_FP8
            Gemm g{(const bf16_t*)(A + A_OLAT), (const bf16_t*)(ws + WS_W_DO + (size_t)j * D * 2048), 1024, SC_DO}; StaticOrder S; S.init(M, D, F.G, F.c);
            EpiRes E{XB, Y}; gemm_phase_gather<true, true>(F.lds, g, S, E, nullptr);
#else
            Gemm g{(const bf16_t*)(A + A_OLAT), (const bf16_t*)(ws + WS_W_DO) + (size_t)j * D * 2048, 2048}; StaticOrder S; S.init(M, D, F.G, F.c);
            EpiRes E{XB, Y}; gemm_phase(F.lds, g, S, E);
#endif
        } SEAM(pb + 13);
        if (IN(pb + 14)) REP(14) { REFRESH(); ln_router_phase(F, Y, INP(IN_LNG) + (size_t)(layerB * 2 + 0) * D, INP(IN_LNB) + (size_t)(layerB * 2 + 0) * D, INP(IN_MR) + (size_t)j * D * NEXP, XB, MK_MOE_FP8 ? ws + WS_XB8 : nullptr,
                                           (int*)(A + A_EIDX), (int*)(A + A_POS), (int*)(A + A_TOK), (float*)(A + A_GW), F.ctl + CW_MOE + 64 * j); } SEAM(pb + 14);
        if (IN(pb + 15)) REP(15) {
#if MK_MOE_FP8
            Gemm g{(const bf16_t*)(ws + WS_XB8), (const bf16_t*)(ws + WS_W_MGU8 + (size_t)j * NEXP * 2 * DFF * D), D / 2, SC_UP}; MoeOrder S; S.init(F.ctl + CW_MOE + 64 * j, 2 * DFF / BM, F.G, F.c);
            EpiSwiglu8 E{(unsigned char*)Hb}; gemm_phase_gather<true>(F.lds, g, S, E, (const int*)(A + A_TOK));
#else
            Gemm g{XB, (const bf16_t*)(ws + WS_W_MGU) + (size_t)j * NEXP * 2 * DFF * D, D}; MoeOrder S; S.init(F.ctl + CW_MOE + 64 * j, 2 * DFF / BM, F.G, F.c);
            EpiSwiglu E{Hb}; gemm_phase_gather(F.lds, g, S, E, (const int*)(A + A_TOK));
#endif
        } SEAM(pb + 15);
        if (IN(pb + 16)) REP(16) {
#if MK_MOE_FP8
            Gemm g{Hb, (const bf16_t*)(ws + WS_W_MDN8 + (size_t)j * NEXP * D * DFF), DFF / 2, SC_DN}; MoeOrder S; S.init(F.ctl + CW_MOE + 64 * j, D / BM, F.G, F.c);
            EpiMoeDn E{(bf16_t*)(A + A_OUTM), (const float*)(A + A_GW)}; gemm_phase_gather<true, true>(F.lds, g, S, E, nullptr);
#else
            Gemm g{Hb, (const bf16_t*)(ws + WS_W_MDN) + (size_t)j * NEXP * D * DFF, DFF}; MoeOrder S; S.init(F.ctl + CW_MOE + 64 * j, D / BM, F.G, F.c);
            EpiMoeDn E{(bf16_t*)(A + A_OUTM), (const float*)(A + A_GW)}; gemm_phase(F.lds, g, S, E);
#endif
        } SEAM(pb + 16);
        if (IN(pb + 17)) REP(17) { REFRESH(); ln_moe_phase(F, XB, (const bf16_t*)(A + A_OUTM), (const int*)(A + A_EIDX), (const int*)(A + A_POS), F.ctl + CW_MOE + 64 * j,
                                        INP(IN_LNG) + (size_t)(layerB * 2 + 1) * D, INP(IN_LNB) + (size_t)(layerB * 2 + 1) * D, XB, (j == 1) ? p.out : nullptr); } SEAM(pb + 17);
    }
#if MK_BARTIME
    if (one_launch) {
        if (blockIdx.x == 0 && threadIdx.x == 0) __hip_atomic_store(F.ctl + 3000, (unsigned)bt_acc, __ATOMIC_RELAXED, __HIP_MEMORY_SCOPE_AGENT);
        xcd_barrier(bar);
        const float cval = 2.0f + 4.0f * (float)__hip_atomic_load(F.ctl + 3000, __ATOMIC_RELAXED, __HIP_MEMORY_SCOPE_AGENT) * 1e-5f;
        for (size_t i = (size_t)blockIdx.x * NTHREADS + threadIdx.x; i < (size_t)M * D; i += (size_t)gridDim.x * NTHREADS) p.out[i] = cval;
    }
#endif
}


#if MK_DEBUG_SCAN
__global__ void scan_kernel(const void* ptr, size_t n, int is_bf16, unsigned code, unsigned* flag, const unsigned* gcnt, size_t row_elems) {
    size_t nn = n;
    if (gcnt) { unsigned t = 0; for (int e = 0; e < 8; ++e) t += (gcnt[e] + 255u) >> 8; nn = (size_t)t * 256 * row_elems; }
    bool bad = false;
    for (size_t i = (size_t)blockIdx.x * blockDim.x + threadIdx.x; i < nn; i += (size_t)gridDim.x * blockDim.x) {
        if (is_bf16) { const unsigned short v = ((const unsigned short*)ptr)[i]; bad |= (v & 0x7f80u) == 0x7f80u; }
        else { const unsigned v = ((const unsigned*)ptr)[i]; bad |= (v & 0x7f800000u) == 0x7f800000u; }
    }
    if (bad) atomicMin(flag, code);
}
__global__ void fin_kernel(float* out, size_t n, const unsigned* flag) {
    const unsigned f = *flag; if (f == 0xffffffffu) return;
    const float cval = (float)f + 0.25f * (float)flag[64];
    for (size_t i = (size_t)blockIdx.x * blockDim.x + threadIdx.x; i < n; i += (size_t)gridDim.x * blockDim.x) out[i] = cval;
}

__global__ void chk_a1_kernel(const float* x, const float* w, const bf16_t* Q, const float* FP, unsigned code, unsigned* flag) {
    const unsigned id = blockIdx.x * blockDim.x + threadIdx.x;
    unsigned hsh = id * 2654435761u + 12345u; hsh ^= hsh >> 13; hsh *= 0x5bd1e995u; hsh ^= hsh >> 15;
    const int row = hsh % M, col = (hsh >> 15) % (4 * D);
    float ref = 0.f; for (int k = 0; k < D; ++k) ref += x[(size_t)row * D + k] * w[(size_t)k * 4 * D + col];
    const int part = col >> 10, cc = col & 1023;
    float got;
    if (part == 1) got = FP[(size_t)row * D + cc];
    else got = bf2f(Q[(size_t)(part == 0 ? 0 : part - 1) * M * D + (size_t)row * D + cc]);
    if (!(fabsf(got - ref) < 0.08f)) atomicMin(flag, code);
}
__global__ void chk_hgrn_kernel(const bf16_t* Q, const float* FP, const bf16_t* V, const bf16_t* O, unsigned* bits) {
    const int sample = blockIdx.x, lane = threadIdx.x;
    const int b = sample % BATCH, h = (sample / BATCH) % HG_H, e = (sample * 37 + 11) % 128;
    float s0 = 0.f, s1 = 0.f; unsigned r = 0;
    for (int t = 0; t < 128; ++t) {
        const size_t base = ((size_t)b * SEQ + t) * D + h * 128;
        const float f0 = sigmoidf_(FP[base + lane]), f1 = sigmoidf_(FP[base + lane + 64]);
        const float v = bf2f(V[base + e]);
        s0 = f0 * s0 + (1.f - f0) * v; s1 = f1 * s1 + (1.f - f1) * v;
        const float o = wave_sum(bf2f(Q[base + lane]) * s0 + bf2f(Q[base + lane + 64]) * s1);
        const unsigned short gb = O[base + e]; const float got = bf2f(gb);
        const bool nf = (gb & 0x7f80u) == 0x7f80u;
        if (t < 64) { if (nf) r |= 4u; else if (!(fabsf(got - o) < 0.05f + 0.03f * fabsf(o))) r |= 2u; }
        else if (nf) r |= 1u;
    }
    if (r && lane == 0) atomicOr(bits, r);
}
__global__ void flaginit_kernel(unsigned* flag) { *flag = 0xffffffffu; }
#endif

extern "C" void kernel_launch(void* const* d_in, const int* in_sizes, int n_in, void* d_out, int out_size, void* d_ws, size_t ws_size, hipStream_t stream) {
    static int grid = 0;
    if (grid == 0) {
        if (n_in != 22 || out_size != M * D || ws_size < WS_END) { fprintf(stderr, "kernel_launch: unexpected problem (n_in %d out %d ws %zu need %zu)\n", n_in, out_size, ws_size, (size_t)WS_END); grid = -1; return; }
        int dev = 0, cus = 0, per_cu = 0;
        if (hipGetDevice(&dev) != hipSuccess || hipDeviceGetAttribute(&cus, hipDeviceAttributeMultiprocessorCount, dev) != hipSuccess) { grid = -1; return; }
        if (hipFuncSetAttribute((const void*)fwd_kernel, hipFuncAttributeMaxDynamicSharedMemorySize, LDS_BYTES) != hipSuccess) { fprintf(stderr, "kernel_launch: hipFuncSetAttribute failed\n"); grid = -1; return; }
        if (hipOccupancyMaxActiveBlocksPerMultiprocessor(&per_cu, (const void*)fwd_kernel, NTHREADS, LDS_BYTES) != hipSuccess || per_cu < 1) fprintf(stderr, "kernel_launch: occupancy query reports %d\n", per_cu);
        grid = cus;
    }
    if (grid <= 0) return;
    (void)hipMemsetAsync((char*)d_ws + WS_CTL, 0, CTL_ZERO_BYTES, stream);
    Params p{};
    for (int i = 0; i < 22; ++i) p.in[i] = (const float*)d_in[i];
    p.out = (float*)d_out; p.ws = (unsigned char*)d_ws;
#if MK_N_LAUNCHES == 1
    p.ph_lo = 0; p.ph_hi = N_PHASES;
    hipLaunchKernelGGL(fwd_kernel, dim3(grid), dim3(NTHREADS), LDS_BYTES, stream, p);
#ifdef MK_EXTRA_PHASES
    { const int extra[] = {MK_EXTRA_PHASES}; for (int r = 0; r < MK_EXTRA_REPS; ++r) for (int k : extra) { p.ph_lo = k; p.ph_hi = k + 1; hipLaunchKernelGGL(fwd_kernel, dim3(grid), dim3(NTHREADS), LDS_BYTES, stream, p); } }
#endif
#else
#if MK_DEBUG_SCAN
    unsigned char* ws = (unsigned char*)d_ws; unsigned* flag = (unsigned*)(ws + WS_CTL) + 2048;
    hipLaunchKernelGGL(flaginit_kernel, dim3(1), dim3(1), 0, stream, flag);
#define SCAN(ptr, n, isbf, k) hipLaunchKernelGGL(scan_kernel, dim3(1024), dim3(256), 0, stream, (const void*)(ptr), (size_t)(n), isbf, (unsigned)((k) + 1), flag, (const unsigned*)nullptr, (size_t)0)
#define SCANM(ptr, re, isbf, k, jj) hipLaunchKernelGGL(scan_kernel, dim3(1024), dim3(256), 0, stream, (const void*)(ptr), (size_t)0, isbf, (unsigned)((k) + 1), flag, (const unsigned*)(ws + WS_CTL) + CW_MOE + 64 * (jj), (size_t)(re))
#endif
    for (int k = 0; k < N_PHASES; ++k) { p.ph_lo = k; p.ph_hi = k + 1; hipLaunchKernelGGL(fwd_kernel, dim3(grid), dim3(NTHREADS), LDS_BYTES, stream, p);
#if MK_DEBUG_SCAN
        unsigned char* A = ws + WS_A; const size_t MD = (size_t)M * D;
        if (k == 0) { SCAN(ws + WS_W_HGIN, 2 * 4 * MD / M * D, 1, k); SCAN(ws + WS_W_HGOUT, 2 * (size_t)D * D, 1, k); SCAN(ws + WS_W_FGU, 2 * (size_t)2 * DFF * D, 1, k); SCAN(ws + WS_W_FDN, 2 * (size_t)DFF * D, 1, k);
            SCAN(ws + WS_W_DIN, 2 * (size_t)DSA_IN_PAD * D, 1, k); SCAN(ws + WS_W_DQ, 2 * (size_t)2560 * QR, 1, k); SCAN(ws + WS_W_DO, 2 * (size_t)D * 2048, 1, k);
            SCAN(ws + WS_W_MGU, 16 * (size_t)2 * DFF * D, 1, k); SCAN(ws + WS_W_MDN, 16 * (size_t)DFF * D, 1, k); SCAN(ws + WS_XB, MD, 1, k); }
        else { const int l = (k - 1) % PH_PER_PAIR, jj = (k - 1) / PH_PER_PAIR;
            switch (l) {
            case 0: SCAN(A + A_HQ, 3 * MD, 1, k); SCAN(A + A_HF, MD, 0, k);
                if (jj == 0) hipLaunchKernelGGL(chk_a1_kernel, dim3(64), dim3(256), 0, stream, (const float*)d_in[IN_X], (const float*)d_in[IN_HGWIN], (const bf16_t*)(A + A_HQ), (const float*)(A + A_HF), (unsigned)(k + 1), flag);
                break;
            case 1: SCAN(A + A_HO, MD, 1, k);
                if (jj == 0) hipLaunchKernelGGL(chk_hgrn_kernel, dim3(256), dim3(64), 0, stream, (const bf16_t*)(A + A_HQ), (const float*)(A + A_HF), (const bf16_t*)(A + A_HV), (const bf16_t*)(A + A_HO), flag + 64);
                break;
            case 2: SCAN(A + A_HOG, MD, 1, k); break;
            case 3: case 6: case 13: SCAN(ws + WS_Y, MD, 1, k); break;
            case 4: case 7: case 14: SCAN(ws + WS_XB, MD, 1, k); break;
            case 5: SCAN(ws + WS_H, (size_t)M * DFF, 1, k); break;
            case 8: SCAN(A + A_RAW, (size_t)M * DSA_IN_PAD, 0, k); break;
            case 9: SCAN(A + A_CQ, (size_t)M * 256, 1, k); SCAN(A + A_CKV, (size_t)M * 256, 1, k); SCAN(A + A_KIDX, (size_t)M * 64, 1, k); SCAN(A + A_WIDX, (size_t)M * 8, 0, k); break;
            case 10: SCAN(A + A_QLAT, (size_t)M * 2048, 1, k); SCAN(A + A_QIDX, (size_t)M * 512, 1, k); break;
            case 12: SCAN(A + A_OLAT, (size_t)M * 2048, 1, k); break;
            case 16: SCANM(ws + WS_H, DFF, 1, k, jj); break;
            case 17: SCANM(A + A_OUTM, D, 0, k, jj); break;
            case 18: if (jj == 0) SCAN(ws + WS_XB, MD, 1, k); else SCAN(d_out, MD, 0, k); break;
            default: break; } }
#endif
    }
#if MK_DEBUG_SCAN
    hipLaunchKernelGGL(fin_kernel, dim3(1024), dim3(256), 0, stream, (float*)d_out, (size_t)M * D, (const unsigned*)flag);
#endif
#endif
}
```

```cpp
#include <hip/hip_runtime.h>
#include <cstdio>
#include <cstdint>

#ifndef MK_DEBUG_SCAN
#define MK_DEBUG_SCAN 0
#endif
#ifndef MK_MOE_FP8
#define MK_MOE_FP8 1
#endif
#ifndef MK_FFN_FP8
#define MK_FFN_FP8 2
#endif
#ifndef MK_ATT_FP8
#define MK_ATT_FP8 1
#endif
#ifndef MK_B6_FP8
#define MK_B6_FP8 1
#endif
#ifndef MK_N_LAUNCHES
#define MK_N_LAUNCHES 1
#endif

#define GAS __attribute__((address_space(1)))
#define LAS __attribute__((address_space(3)))
typedef unsigned short bf16_t;
typedef short bf16x8 __attribute__((ext_vector_type(8)));
typedef short s16x4 __attribute__((ext_vector_type(4)));
typedef float f32x4 __attribute__((ext_vector_type(4)));
typedef float f32x2 __attribute__((ext_vector_type(2)));
typedef unsigned u32x4 __attribute__((ext_vector_type(4)));
typedef unsigned u32x2 __attribute__((ext_vector_type(2)));
typedef int v8i32 __attribute__((ext_vector_type(8)));
typedef int v4i32 __attribute__((ext_vector_type(4)));

constexpr int D = 1024, BATCH = 16, SEQ = 2048, M = BATCH * SEQ;
constexpr int DFF = 3584, NEXP = 8;
constexpr int HG_H = 8, HG_DK = 128, HG_C = 64;
constexpr int QR = 256, KVR = 256, IDXD = 64, IDXH = 8, DSA_H = 8, DSA_HD = 128, TOPK = 256;
constexpr int DSA_IN = 584, DSA_IN_PAD = 768;
constexpr int MOE_ROWS = 2 * M + NEXP * 256;
constexpr float ALPHA = 1.6817928305074290f;
constexpr float LN_EPS = 1e-5f, RMS_EPS = 1e-6f;
constexpr int NWAVES = 8, NTHREADS = 512;

constexpr size_t MiB = 1u << 20;
constexpr size_t WS_CTL = 0, CTL_ZERO_BYTES = 1 * MiB;
constexpr size_t WS_W_HGIN = 1 * MiB;
constexpr size_t WS_W_HGOUT = 17 * MiB;
constexpr size_t WS_W_FGU = 21 * MiB;
constexpr size_t WS_W_FDN = 49 * MiB;
constexpr size_t WS_W_DIN = 63 * MiB;
constexpr size_t WS_W_DQ = 66 * MiB;
constexpr size_t WS_W_DO = 69 * MiB;
constexpr size_t WS_W_MGU = 77 * MiB;
constexpr size_t WS_W_MDN = 301 * MiB;
constexpr size_t WS_XB8 = 416 * MiB;
constexpr size_t WS_W_MGU8 = 77 * MiB;
constexpr size_t WS_W_MDN8 = 192 * MiB;
constexpr size_t WS_XB = 544 * MiB;
constexpr size_t WS_Y = 608 * MiB;
constexpr size_t WS_A = 736 * MiB;
constexpr size_t WS_H = 1184 * MiB;
constexpr size_t WS_END = 1648 * MiB;
constexpr size_t A_HQ = 0, A_HF = 64 * MiB, A_HV = 128 * MiB, A_HG = 192 * MiB, A_HO = 320 * MiB, A_HOG = 384 * MiB;
constexpr size_t A_RAW = 0, A_CQ = 96 * MiB, A_CKV = 112 * MiB, A_KIDX = 128 * MiB, A_WIDX = 132 * MiB, A_MASK = 136 * MiB, A_QLAT = 144 * MiB, A_QIDX = 272 * MiB, A_OLAT = 304 * MiB;
constexpr size_t A_OUTM = 136 * MiB, A_EIDX = 404 * MiB, A_POS = 405 * MiB, A_TOK = 406 * MiB, A_GW = 407 * MiB;
constexpr int CW_BAR = 4096, CW_MOE = 16384;

constexpr int RING_BYTES = 131072;
constexpr int LDSCTL_OFF = RING_BYTES, MISC_OFF = LDSCTL_OFF + 320;
constexpr int STAGE_TOKL = RING_BYTES + 2048;
constexpr int LDS_BYTES = 147456;

typedef __bf16 hwbf16x2 __attribute__((ext_vector_type(2)));
__device__ __forceinline__ unsigned cvt_pk_bf16(float lo, float hi) { const f32x2 v = {lo, hi}; const hwbf16x2 b = __builtin_convertvector(v, hwbf16x2); return __builtin_bit_cast(unsigned, b); }
__device__ __forceinline__ bf16_t f2bf(float f) { return (bf16_t)(cvt_pk_bf16(f, 0.f) & 0xffffu); }
__device__ __forceinline__ float bf2f(bf16_t b) { return __uint_as_float(((unsigned)b) << 16); }
__device__ __forceinline__ float wave_sum(float v) {
    v += __builtin_bit_cast(float, __builtin_amdgcn_update_dpp(0, __builtin_bit_cast(int, v), 0xB1, 0xF, 0xF, true));
    v += __builtin_bit_cast(float, __builtin_amdgcn_update_dpp(0, __builtin_bit_cast(int, v), 0x4E, 0xF, 0xF, true));
    v += __builtin_bit_cast(float, __builtin_amdgcn_update_dpp(0, __builtin_bit_cast(int, v), 0x141, 0xF, 0xF, true));
    v += __builtin_bit_cast(float, __builtin_amdgcn_update_dpp(0, __builtin_bit_cast(int, v), 0x140, 0xF, 0xF, true));
    const float r0 = __builtin_bit_cast(float, __builtin_amdgcn_readlane(__builtin_bit_cast(int, v), 0)), r1 = __builtin_bit_cast(float, __builtin_amdgcn_readlane(__builtin_bit_cast(int, v), 16));
    const float r2 = __builtin_bit_cast(float, __builtin_amdgcn_readlane(__builtin_bit_cast(int, v), 32)), r3 = __builtin_bit_cast(float, __builtin_amdgcn_readlane(__builtin_bit_cast(int, v), 48));
    return (r0 + r1) + (r2 + r3);
}
__device__ __forceinline__ float fast_exp2(float x) { return __builtin_amdgcn_exp2f(x); }
__device__ __forceinline__ float fast_rcp(float x) { return __builtin_amdgcn_rcpf(x); }
__device__ __forceinline__ float sigmoidf_(float x) { return fast_rcp(1.0f + __expf(-x)); }
__device__ __forceinline__ float siluf_(float x) { return x * sigmoidf_(x); }
#define LDS_WAIT() asm volatile("s_waitcnt lgkmcnt(0)" ::: "memory")
#define VM_WAIT() asm volatile("s_waitcnt vmcnt(0)" ::: "memory")

#define XB_TMO      128
#define XB_XCNT(j)  (256  + 64 * (j))
#define XB_XSUB(j)  (1280 + 64 * (j))
#define XB_XGEN(j)  (2304 + 64 * (j))
#define XB_TOP      3328
#define XB_TOPGEN   3392
#define XCD_BAR_WORDS 3456
#define XB_SPIN_CAP (1u << 20)

__device__ __forceinline__ unsigned xb_ld(unsigned* p)              { return __hip_atomic_load(p, __ATOMIC_RELAXED, __HIP_MEMORY_SCOPE_AGENT); }
__device__ __forceinline__ unsigned xb_add(unsigned* p, unsigned v) { return __hip_atomic_fetch_add(p, v, __ATOMIC_RELAXED, __HIP_MEMORY_SCOPE_AGENT); }
__device__ __forceinline__ unsigned xb_xcc_id() { return (unsigned)__builtin_amdgcn_s_getreg((3 << 11) | 20) & 0xFu; }
#define XB_SPIN(cond, bar) do { unsigned _sp = 0; while (cond) { __builtin_amdgcn_s_sleep(1); \
    if ((++_sp & 255u) == 0u) { if (xb_ld(&(bar)[XB_TMO])) break; if (_sp > XB_SPIN_CAP) { atomicAdd(&(bar)[XB_TMO], 1u); break; } } } } while (0)

struct XcdBarrier { unsigned* bar; unsigned x; volatile LAS unsigned* st; };

__device__ __forceinline__ XcdBarrier xcd_barrier_post(unsigned* bar, volatile LAS unsigned* st) {
    XcdBarrier b; b.bar = bar; b.x = xb_xcc_id(); b.st = st;
    if (threadIdx.x == 0) (void)xb_add(&bar[XB_XCNT(b.x)], 1u);
    return b;
}
__device__ __forceinline__ void xcd_barrier_complete(unsigned* bar, unsigned x, unsigned& nloc, unsigned& nx) {
    const unsigned G = gridDim.x * gridDim.y * gridDim.z;
    unsigned sum, cnt, mine, sp = 0u;
    for (;;) {
        sum = 0u; cnt = 0u; mine = 0u;
#pragma unroll
        for (unsigned j = 0; j < 16; ++j) { const unsigned c = xb_ld(&bar[XB_XCNT(j)]); sum += c; cnt += (c > 0u) ? 1u : 0u; mine = (j == x) ? c : mine; }
        if (sum == G) break;
        __builtin_amdgcn_s_sleep(1);
        if ((++sp & 255u) == 0u) { if (xb_ld(&bar[XB_TMO])) break; if (sp > XB_SPIN_CAP) { atomicAdd(&bar[XB_TMO], 1u); break; } }
    }
    nloc = mine > 0u ? mine : 1u; nx = cnt > 0u ? cnt : 1u;
}
__device__ __forceinline__ void xcd_barrier(const XcdBarrier& b) {
    asm volatile("s_waitcnt vmcnt(0)" ::: "memory");
    __syncthreads();
    if (threadIdx.x == 0) {
        unsigned* bar = b.bar;
        __builtin_amdgcn_s_waitcnt(0);
        unsigned nloc = b.st[0], nx = b.st[1];
        if (nloc == 0u) { xcd_barrier_complete(bar, b.x, nloc, nx); b.st[0] = nloc; b.st[1] = nx; }
        const unsigned old = xb_add(&bar[XB_XSUB(b.x)], 1u);
        const unsigned gen = old / nloc;
        if (old + 1u == (gen + 1u) * nloc) {
            __builtin_amdgcn_fence(__ATOMIC_RELEASE, "agent");
            asm volatile("s_waitcnt vmcnt(0)" ::: "memory");
            const unsigned og = xb_add(&bar[XB_TOP], 1u);
            const unsigned tg = og / nx;
            if (og + 1u == (tg + 1u) * nx) xb_add(&bar[XB_TOPGEN], 1u);
            else XB_SPIN(xb_ld(&bar[XB_TOPGEN]) == tg, bar);
            __builtin_amdgcn_fence(__ATOMIC_ACQUIRE, "agent");
            xb_add(&bar[XB_XGEN(b.x)], 1u);
            asm volatile("s_waitcnt vmcnt(0)" ::: "memory");
        } else {
            XB_SPIN(xb_ld(&bar[XB_XGEN(b.x)]) == gen, bar);
            __builtin_amdgcn_fence(__ATOMIC_ACQUIRE, "agent");
            asm volatile("s_waitcnt vmcnt(0)" ::: "memory");
        }
    }
    __syncthreads();
}

constexpr int BM = 256, BK = 64, HALF = 128, HTB = HALF * BK * 2, NXCD = 8, WGM = 8;
__device__ __forceinline__ int lds_byte(int r, int c) { const int st = (r >> 4) * 2 + (c >> 5), rr = r & 15, cc = c & 31, ob = rr * 64 + cc * 2; return st * 1024 + (ob ^ (((ob >> 9) & 1) << 5)); }
__device__ __forceinline__ void stage_rc(int b, int& R, int& C) { const int st = b / 1024, sb = b % 1024, swz = sb ^ (((sb >> 9) & 1) << 5); R = (st >> 1) * 16 + swz / 64; C = (st & 1) * 32 + (swz % 64) / 2; }
__device__ __forceinline__ int perm32(int rho) { const int n = rho >> 4, i = rho & 15; return 8 * (i >> 2) + 4 * n + (i & 3); }

struct Unit { int pm, pn, pb, lt, cnt, e; };
struct Gemm { const bf16_t* A; const bf16_t* Bt; int K; int sc = 0x7f7f7f7f; };

__device__ __forceinline__ void tile_map(int L, int nM, int nN, int& pm, int& pn) {
    const int nwg = nM * nN;
    int wgid = L; { const int q = nwg / NXCD, r = nwg % NXCD, xcd = wgid % NXCD, off = wgid / NXCD; wgid = (xcd < r ? xcd * (q + 1) : r * (q + 1) + (xcd - r) * q) + off; }
    const int nig = WGM * nN, gid = wgid / nig, fm = gid * WGM, gsz = (nM - fm) < WGM ? (nM - fm) : WGM;
    pm = fm + ((wgid % nig) % gsz); pn = (wgid % nig) / gsz;
}
struct StaticOrder {
    int nM, nN, nwg, G, c;
    __device__ __forceinline__ void init(int M_, int N_, int G_, int c_) { nM = M_ / BM; nN = N_ / BM; nwg = nM * nN; G = G_; c = c_; }
    __device__ __forceinline__ bool next(int i, Unit& u) const {
        const long L = (long)i * G + c; if (L >= nwg) return false;
        tile_map((int)L, nM, nN, u.pm, u.pn); u.pb = u.pn; u.lt = 0; u.cnt = 0; u.e = 0; return true;
    }
};
struct MoeOrder {
    int t1, t2, t3, t4, t5, t6, t7, nM, nN, nwg, G, c; const unsigned* cntp;
    __device__ __forceinline__ void init(const unsigned* cnt, int nN_, int G_, int c_) {
        int t = 0, o[9];
#pragma unroll
        for (int e = 0; e < 8; ++e) { o[e] = t; const int ce = __builtin_amdgcn_readfirstlane((int)__hip_atomic_load(cnt + e, __ATOMIC_RELAXED, __HIP_MEMORY_SCOPE_AGENT)); t += (ce + 255) >> 8; }
        o[8] = t; t1 = o[1]; t2 = o[2]; t3 = o[3]; t4 = o[4]; t5 = o[5]; t6 = o[6]; t7 = o[7];
        nM = t; nN = nN_; nwg = nM * nN; G = G_; c = c_; cntp = cnt;
    }
    __device__ __forceinline__ bool next(int i, Unit& u) const {
        const long L = (long)i * G + c; if (L >= nwg) return false;
        tile_map((int)L, nM, nN, u.pm, u.pn);
        const int e = (u.pm >= t1) + (u.pm >= t2) + (u.pm >= t3) + (u.pm >= t4) + (u.pm >= t5) + (u.pm >= t6) + (u.pm >= t7);
        const int tb = e == 0 ? 0 : e == 1 ? t1 : e == 2 ? t2 : e == 3 ? t3 : e == 4 ? t4 : e == 5 ? t5 : e == 6 ? t6 : t7;
        u.cnt = __builtin_amdgcn_readfirstlane((int)__hip_atomic_load(cntp + e, __ATOMIC_RELAXED, __HIP_MEMORY_SCOPE_AGENT));
        u.lt = u.pm - tb; u.e = e; u.pb = e * nN + u.pn; return true;
    }
};

typedef f32x4 Acc[2][2][4][2];

template <bool F8 = false, class Epi, class Sched>
__device__ __forceinline__ void gemm_phase(LAS unsigned char* lds, const Gemm g, const Sched& S, const Epi& E) {
    int tid_ = threadIdx.x; asm volatile("" : "+v"(tid_));
    const int tid = tid_, wid = __builtin_amdgcn_readfirstlane(tid >> 6), lane = tid & 63, wr = wid >> 2, wc = wid & 3, fr = lane & 15, fq = lane >> 4;
    const int K = g.K, nt = K / BK;
    unsigned voffA[2], voffB[2];
#pragma unroll
    for (int i = 0; i < 2; ++i) { int R, C; stage_rc(tid * 16 + i * 8192, R, C); const int Rb = (R & ~31) + perm32(R & 31);
        voffA[i] = (unsigned)(R * K + C) * 2u; voffB[i] = (unsigned)(Rb * K + C) * 2u; }
    const size_t kstep = (size_t)(BK * 2);
    const size_t hstep = (size_t)HALF * K * 2;
    const size_t tstep = 2 * hstep;
    const unsigned ldsw = (unsigned)wid * 1024u;
    const int aoff = lds_byte(wr * 64 + fr, fq * 8), boff = lds_byte(wc * 32 + fr, fq * 8);
#define PG8_SA(b, h) (((b) * 2 + (h)) * HTB)
#define PG8_SB(b, h) ((4 + (b) * 2 + (h)) * HTB)
#define PG8_STAGE(bufoff, gbase, voff) do { _Pragma("unroll") for (int _i = 0; _i < 2; ++_i) \
        __builtin_amdgcn_global_load_lds((const unsigned*)((const char*)(gbase) + (voff)[_i]), (LAS unsigned*)(lds + (bufoff) + ldsw + _i * 8192), 16, 0, 0); } while (0)
#define PG8_LDA(dst, b, h) do { _Pragma("unroll") for (int m = 0; m < 4; ++m) _Pragma("unroll") for (int k = 0; k < 2; ++k) dst[m][k] = *(const LAS bf16x8*)(lds + PG8_SA(b, h) + aoff + m * 2048 + k * 1024); } while (0)
#define PG8_LDB(dst, b, h) do { _Pragma("unroll") for (int n = 0; n < 2; ++n) _Pragma("unroll") for (int k = 0; k < 2; ++k) dst[n][k] = *(const LAS bf16x8*)(lds + PG8_SB(b, h) + boff + n * 2048 + k * 1024); } while (0)
#define PG8_MMA(ai, bj, At, Bt) do { __builtin_amdgcn_s_setprio(1); \
        if constexpr (F8) {        \
            _Pragma("unroll") for (int m = 0; m < 4; ++m) _Pragma("unroll") for (int n = 0; n < 2; ++n) { \
                const v8i32 bv_ = __builtin_shufflevector(__builtin_bit_cast(v4i32, Bt[n][0]), __builtin_bit_cast(v4i32, Bt[n][1]), 0, 1, 2, 3, 4, 5, 6, 7); \
                const v8i32 av_ = __builtin_shufflevector(__builtin_bit_cast(v4i32, At[m][0]), __builtin_bit_cast(v4i32, At[m][1]), 0, 1, 2, 3, 4, 5, 6, 7); \
                acc[ai][bj][m][n] = __builtin_amdgcn_mfma_scale_f32_16x16x128_f8f6f4(bv_, av_, acc[ai][bj][m][n], 0, 0, 0, g.sc, 0, 0x7f7f7f7f); } \
        } else { \
            _Pragma("unroll") for (int m = 0; m < 4; ++m) _Pragma("unroll") for (int n = 0; n < 2; ++n) _Pragma("unroll") for (int k = 0; k < 2; ++k) \
                acc[ai][bj][m][n] = __builtin_amdgcn_mfma_f32_16x16x32_bf16(Bt[n][k], At[m][k], acc[ai][bj][m][n], 0, 0, 0); } \
        __builtin_amdgcn_s_setprio(0); } while (0)
#define PG8_WAIT_V(n) asm volatile("s_waitcnt vmcnt(" #n ")" ::: "memory")
#define PG8_WAIT_L(n) asm volatile("s_waitcnt lgkmcnt(" #n ")" ::: "memory")
#define PG8_BAR __builtin_amdgcn_s_barrier()
#define PG8_SCHED __builtin_amdgcn_sched_barrier(0)
    Unit cur, nxt; int ui = 0;
    if (!S.next(0, cur)) return;
    Acc acc;
#pragma unroll
    for (int a = 0; a < 2; ++a)
#pragma unroll
        for (int b = 0; b < 2; ++b)
#pragma unroll
            for (int m = 0; m < 4; ++m)
#pragma unroll
                for (int n = 0; n < 2; ++n) acc[a][b][m][n] = (f32x4){0.f, 0.f, 0.f, 0.f};
    bf16x8 At[4][2], B0[2][2], B1[2][2];
    const char* cA = (const char*)g.A + (size_t)cur.pm * tstep; const char* cB = (const char*)g.Bt + (size_t)cur.pb * tstep;
    PG8_STAGE(PG8_SB(0, 0), cB, voffB); PG8_STAGE(PG8_SA(0, 0), cA, voffA); PG8_STAGE(PG8_SB(0, 1), cB + hstep, voffB); PG8_STAGE(PG8_SA(0, 1), cA + hstep, voffA);
    if (wr == 1) PG8_BAR;
    PG8_WAIT_V(4); PG8_BAR;
    PG8_STAGE(PG8_SB(1, 0), cB + kstep, voffB); PG8_STAGE(PG8_SA(1, 0), cA + kstep, voffA); PG8_STAGE(PG8_SB(1, 1), cB + hstep + kstep, voffB);
    PG8_WAIT_V(6); PG8_BAR;
    for (;;) {
        const bool has_next = S.next(ui + 1, nxt);
        const char* nA = has_next ? (const char*)g.A + (size_t)nxt.pm * tstep : cA; const char* nB = has_next ? (const char*)g.Bt + (size_t)nxt.pb * tstep : cB;
#pragma nounroll
        for (int t = 0; t < nt; t += 2) {
            const bool last = (t == nt - 2);
            const char* a1 = cA + (size_t)(t + 1) * kstep;
            const char* a2 = last ? nA : cA + (size_t)(t + 2) * kstep; const char* b2 = last ? nB : cB + (size_t)(t + 2) * kstep;
            const char* a3 = a2 + kstep; const char* b3 = b2 + kstep;
            PG8_LDB(B0, 0, 0); PG8_SCHED; PG8_LDA(At, 0, 0); PG8_STAGE(PG8_SA(1, 1), a1 + hstep, voffA);
            PG8_WAIT_L(8); PG8_BAR; PG8_WAIT_L(0); PG8_MMA(0, 0, At, B0); PG8_BAR; PG8_SCHED;
            PG8_LDB(B1, 0, 1); PG8_STAGE(PG8_SB(0, 0), b2, voffB);
            PG8_BAR; PG8_WAIT_L(0); PG8_MMA(0, 1, At, B1); PG8_BAR;
            PG8_LDA(At, 0, 1); PG8_STAGE(PG8_SA(0, 0), a2, voffA);
            PG8_BAR; PG8_WAIT_L(0); PG8_MMA(1, 0, At, B0); PG8_BAR; PG8_SCHED;
            PG8_STAGE(PG8_SB(0, 1), b2 + hstep, voffB);
            PG8_WAIT_V(6); PG8_BAR; PG8_MMA(1, 1, At, B1); PG8_BAR;
            PG8_LDB(B0, 1, 0); PG8_SCHED; PG8_LDA(At, 1, 0); PG8_STAGE(PG8_SA(0, 1), a2 + hstep, voffA);
            PG8_WAIT_L(8); PG8_BAR; PG8_WAIT_L(0); PG8_MMA(0, 0, At, B0); PG8_BAR; PG8_SCHED;
            PG8_LDB(B1, 1, 1); PG8_STAGE(PG8_SB(1, 0), b3, voffB);
            PG8_BAR; PG8_WAIT_L(0); PG8_MMA(0, 1, At, B1); PG8_BAR;
            PG8_LDA(At, 1, 1); PG8_STAGE(PG8_SA(1, 0), a3, voffA);
            PG8_BAR; PG8_WAIT_L(0); PG8_MMA(1, 0, At, B0); PG8_BAR; PG8_SCHED;
            PG8_STAGE(PG8_SB(1, 1), b3 + hstep, voffB);
            PG8_WAIT_V(6); PG8_BAR; PG8_MMA(1, 1, At, B1); PG8_BAR;
        }
        E(acc, cur, wr, wc, fr, fq);
        if (!has_next) break;
#pragma unroll
        for (int a = 0; a < 2; ++a)
#pragma unroll
            for (int b = 0; b < 2; ++b)
#pragma unroll
                for (int m = 0; m < 4; ++m)
#pragma unroll
                    for (int n = 0; n < 2; ++n) acc[a][b][m][n] = (f32x4){0.f, 0.f, 0.f, 0.f};
        cur = nxt; cA = nA; cB = nB; ++ui;
    }
    PG8_WAIT_V(0);
    if (wr == 0) PG8_BAR;
    PG8_BAR;
#undef PG8_SA
#undef PG8_SB
#undef PG8_STAGE
#undef PG8_LDA
#undef PG8_LDB
#undef PG8_MMA
#undef PG8_WAIT_V
#undef PG8_WAIT_L
#undef PG8_BAR
#undef PG8_SCHED
}

template <bool F8 = false, bool IDENT = false, class Epi, class Sched>
__device__ __forceinline__ void gemm_phase_gather(LAS unsigned char* lds, const Gemm g, const Sched& S, const Epi& E, const int* TOKV) {
    int tid_ = threadIdx.x; asm volatile("" : "+v"(tid_));
    const int tid = tid_, wid = __builtin_amdgcn_readfirstlane(tid >> 6), lane = tid & 63, wr = wid >> 2, wc = wid & 3, fr = lane & 15, fq = lane >> 4;
    const int K = g.K, nt = K / BK;
    unsigned voffB[2];
#pragma unroll
    for (int i = 0; i < 2; ++i) { int R, C; stage_rc(tid * 16 + i * 8192, R, C); const int Rb = (R & ~31) + perm32(R & 31); voffB[i] = (unsigned)(Rb * K + C) * 2u; }
    unsigned vgC[2][2];
    LAS int* TOKL = (LAS int*)(lds + STAGE_TOKL);
#define PG8_GROWS(dst, u_) do { int tq_ = threadIdx.x; asm volatile("" : "+v"(tq_)); _Pragma("unroll") for (int i_ = 0; i_ < 2; ++i_) { int R_, C_; stage_rc(tq_ * 16 + i_ * 8192, R_, C_); \
            _Pragma("unroll") for (int h_ = 0; h_ < 2; ++h_) { const int pos_ = 256 * (u_).lt + 128 * h_ + R_; \
                int tok_; if constexpr (IDENT) tok_ = 256 * (u_).pm + 128 * h_ + R_; else tok_ = (pos_ < (u_).cnt) ? TOKV[(size_t)(u_).e * M + pos_] : 0; dst[h_][i_] = (unsigned)tok_ * (unsigned)(K * 2) + (unsigned)C_ * 2u; } } } while (0)
#define PG8_GROWS_LDS(dst, u_, par_) do { int tq_ = threadIdx.x; asm volatile("" : "+v"(tq_)); _Pragma("unroll") for (int i_ = 0; i_ < 2; ++i_) { int R_, C_; stage_rc(tq_ * 16 + i_ * 8192, R_, C_); \
            _Pragma("unroll") for (int h_ = 0; h_ < 2; ++h_) { const int rl_ = 128 * h_ + R_; \
                int tok_; if constexpr (IDENT) tok_ = 256 * (u_).pm + rl_; else tok_ = (256 * (u_).lt + rl_ < (u_).cnt) ? TOKL[256 * (par_) + rl_] : 0; dst[h_][i_] = (unsigned)tok_ * (unsigned)(K * 2) + (unsigned)C_ * 2u; } } } while (0)
    const size_t kstep = (size_t)(BK * 2);
    const size_t hstep = (size_t)HALF * K * 2;
    const size_t tstep = 2 * hstep;
    const unsigned ldsw = (unsigned)wid * 1024u;
    const int aoff = lds_byte(wr * 64 + fr, fq * 8), boff = lds_byte(wc * 32 + fr, fq * 8);
#define PG8_SA(b, h) (((b) * 2 + (h)) * HTB)
#define PG8_SB(b, h) ((4 + (b) * 2 + (h)) * HTB)
#define PG8_STAGE(bufoff, gbase, voff) do { _Pragma("unroll") for (int _i = 0; _i < 2; ++_i) \
        __builtin_amdgcn_global_load_lds((const unsigned*)((const char*)(gbase) + (voff)[_i]), (LAS unsigned*)(lds + (bufoff) + ldsw + _i * 8192), 16, 0, 0); } while (0)
#define PG8_STAGEA(bufoff, gbase, h_, nx_) PG8_STAGE(bufoff, gbase, vgC[h_])
#define PG8_LDA(dst, b, h) do { _Pragma("unroll") for (int m = 0; m < 4; ++m) _Pragma("unroll") for (int k = 0; k < 2; ++k) dst[m][k] = *(const LAS bf16x8*)(lds + PG8_SA(b, h) + aoff + m * 2048 + k * 1024); } while (0)
#define PG8_LDB(dst, b, h) do { _Pragma("unroll") for (int n = 0; n < 2; ++n) _Pragma("unroll") for (int k = 0; k < 2; ++k) dst[n][k] = *(const LAS bf16x8*)(lds + PG8_SB(b, h) + boff + n * 2048 + k * 1024); } while (0)
#define PG8_MMA(ai, bj, At, Bt) do { __builtin_amdgcn_s_setprio(1); \
        if constexpr (F8) {        \
            _Pragma("unroll") for (int m = 0; m < 4; ++m) _Pragma("unroll") for (int n = 0; n < 2; ++n) { \
                const v8i32 bv_ = __builtin_shufflevector(__builtin_bit_cast(v4i32, Bt[n][0]), __builtin_bit_cast(v4i32, Bt[n][1]), 0, 1, 2, 3, 4, 5, 6, 7); \
                const v8i32 av_ = __builtin_shufflevector(__builtin_bit_cast(v4i32, At[m][0]), __builtin_bit_cast(v4i32, At[m][1]), 0, 1, 2, 3, 4, 5, 6, 7); \
                acc[ai][bj][m][n] = __builtin_amdgcn_mfma_scale_f32_16x16x128_f8f6f4(bv_, av_, acc[ai][bj][m][n], 0, 0, 0, g.sc, 0, 0x7f7f7f7f); } \
        } else { \
            _Pragma("unroll") for (int m = 0; m < 4; ++m) _Pragma("unroll") for (int n = 0; n < 2; ++n) _Pragma("unroll") for (int k = 0; k < 2; ++k) \
                acc[ai][bj][m][n] = __builtin_amdgcn_mfma_f32_16x16x32_bf16(Bt[n][k], At[m][k], acc[ai][bj][m][n], 0, 0, 0); } \
        __builtin_amdgcn_s_setprio(0); } while (0)
#define PG8_WAIT_V(n) asm volatile("s_waitcnt vmcnt(" #n ")" ::: "memory")
#define PG8_WAIT_L(n) asm volatile("s_waitcnt lgkmcnt(" #n ")" ::: "memory")
#define PG8_BAR __builtin_amdgcn_s_barrier()
#define PG8_SCHED __builtin_amdgcn_sched_barrier(0)
    Unit cur, nxt; int ui = 0;
    if (!S.next(0, cur)) return;
    Acc acc;
#pragma unroll
    for (int a = 0; a < 2; ++a)
#pragma unroll
        for (int b = 0; b < 2; ++b)
#pragma unroll
            for (int m = 0; m < 4; ++m)
#pragma unroll
                for (int n = 0; n < 2; ++n) acc[a][b][m][n] = (f32x4){0.f, 0.f, 0.f, 0.f};
    bf16x8 At[4][2], B0[2][2], B1[2][2];
    const char* cA = (const char*)g.A; const char* cB = (const char*)g.Bt + (size_t)cur.pb * tstep;
    PG8_GROWS(vgC, cur);
    PG8_STAGE(PG8_SB(0, 0), cB, voffB); PG8_STAGEA(PG8_SA(0, 0), cA, 0, false); PG8_STAGE(PG8_SB(0, 1), cB + hstep, voffB); PG8_STAGEA(PG8_SA(0, 1), cA, 1, false);
    if (wr == 1) PG8_BAR;
    PG8_WAIT_V(4); PG8_BAR;
    PG8_STAGE(PG8_SB(1, 0), cB + kstep, voffB); PG8_STAGEA(PG8_SA(1, 0), cA + kstep, 0, false); PG8_STAGE(PG8_SB(1, 1), cB + hstep + kstep, voffB);
    PG8_WAIT_V(6); PG8_BAR;
    for (;;) {
        const bool has_next = S.next(ui + 1, nxt);
        const char* nA = cA; const char* nB = has_next ? (const char*)g.Bt + (size_t)nxt.pb * tstep : cB;
        if (!IDENT && has_next && wid == 0) __builtin_amdgcn_global_load_lds((const unsigned*)(TOKV + (size_t)nxt.e * M + 256 * nxt.lt + 4 * lane), (LAS unsigned*)(TOKL + 256 * ((ui + 1) & 1)), 16, 0, 0);

#pragma nounroll
        for (int t = 0; t < nt; t += 2) {
            const bool last = (t == nt - 2);
            const char* a1 = cA + (size_t)(t + 1) * kstep;
            const char* a2 = last ? nA : cA + (size_t)(t + 2) * kstep; const char* b2 = last ? nB : cB + (size_t)(t + 2) * kstep;
            const char* a3 = a2 + kstep; const char* b3 = b2 + kstep;
            PG8_LDB(B0, 0, 0); PG8_SCHED; PG8_LDA(At, 0, 0); PG8_STAGEA(PG8_SA(1, 1), a1, 1, false);
            if (last && has_next) { PG8_GROWS_LDS(vgC, nxt, (ui + 1) & 1); }
            PG8_WAIT_L(8); PG8_BAR; PG8_WAIT_L(0); PG8_MMA(0, 0, At, B0); PG8_BAR; PG8_SCHED;
            PG8_LDB(B1, 0, 1); PG8_STAGE(PG8_SB(0, 0), b2, voffB);
            PG8_BAR; PG8_WAIT_L(0); PG8_MMA(0, 1, At, B1); PG8_BAR;
            PG8_LDA(At, 0, 1); PG8_STAGEA(PG8_SA(0, 0), a2, 0, last);
            PG8_BAR; PG8_WAIT_L(0); PG8_MMA(1, 0, At, B0); PG8_BAR; PG8_SCHED;
            PG8_STAGE(PG8_SB(0, 1), b2 + hstep, voffB);
            PG8_WAIT_V(6); PG8_BAR; PG8_MMA(1, 1, At, B1); PG8_BAR;
            PG8_LDB(B0, 1, 0); PG8_SCHED; PG8_LDA(At, 1, 0); PG8_STAGEA(PG8_SA(0, 1), a2, 1, last);
            PG8_WAIT_L(8); PG8_BAR; PG8_WAIT_L(0); PG8_MMA(0, 0, At, B0); PG8_BAR; PG8_SCHED;
            PG8_LDB(B1, 1, 1); PG8_STAGE(PG8_SB(1, 0), b3, voffB);
            PG8_BAR; PG8_WAIT_L(0); PG8_MMA(0, 1, At, B1); PG8_BAR;
            PG8_LDA(At, 1, 1); PG8_STAGEA(PG8_SA(1, 0), a3, 0, last);
            PG8_BAR; PG8_WAIT_L(0); PG8_MMA(1, 0, At, B0); PG8_BAR; PG8_SCHED;
            PG8_STAGE(PG8_SB(1, 1), b3 + hstep, voffB);
            PG8_WAIT_V(6); PG8_BAR; PG8_MMA(1, 1, At, B1); PG8_BAR;
        }
        E(acc, cur, wr, wc, fr, fq);
        if (!has_next) break;
#pragma unroll
        for (int a = 0; a < 2; ++a)
#pragma unroll
            for (int b = 0; b < 2; ++b)
#pragma unroll
                for (int m = 0; m < 4; ++m)
#pragma unroll
                    for (int n = 0; n < 2; ++n) acc[a][b][m][n] = (f32x4){0.f, 0.f, 0.f, 0.f};
        cur = nxt; cB = nB; ++ui;
    }
    PG8_WAIT_V(0);
    if (wr == 0) PG8_BAR;
    PG8_BAR;
#undef PG8_SA
#undef PG8_STAGEA
#undef PG8_GROWS
#undef PG8_GROWS_LDS
#undef PG8_SB
#undef PG8_STAGE
#undef PG8_LDA
#undef PG8_LDB
#undef PG8_MMA
#undef PG8_WAIT_V
#undef PG8_WAIT_L
#undef PG8_BAR
#undef PG8_SCHED
}

__device__ __forceinline__ u32x4 pack8(const f32x4 a, const f32x4 b) { u32x4 w; w.x = cvt_pk_bf16(a[0], a[1]); w.y = cvt_pk_bf16(a[2], a[3]); w.z = cvt_pk_bf16(b[0], b[1]); w.w = cvt_pk_bf16(b[2], b[3]); return w; }

struct EpiHgIn {
    bf16_t* QFVG;
    __device__ __forceinline__ void operator()(const Acc& acc, const Unit& u, int wr, int wc, int fr, int fq) const {
        const int part = u.pn >> 2, row0 = u.pm * BM + wr * 64 + fr, col0 = (u.pn & 3) * 256 + wc * 32 + 8 * fq;
        bf16_t* base = QFVG + (size_t)part * ((size_t)M * D);
#pragma unroll
        for (int ai = 0; ai < 2; ++ai)
#pragma unroll
            for (int m = 0; m < 4; ++m) { bf16_t* rowp = base + (size_t)(row0 + ai * HALF + m * 16) * D + col0;
#pragma unroll
                for (int bj = 0; bj < 2; ++bj) *(u32x4*)(rowp + bj * HALF) = pack8(acc[ai][bj][m][0], acc[ai][bj][m][1]); }
    }
};
struct EpiRes {
    const bf16_t* X; bf16_t* Y;
    __device__ __forceinline__ void operator()(const Acc& acc, const Unit& u, int wr, int wc, int fr, int fq) const {
        const int row0 = u.pm * BM + wr * 64 + fr, col0 = u.pn * BM + wc * 32 + 8 * fq;
#pragma unroll
        for (int ai = 0; ai < 2; ++ai)
#pragma unroll
            for (int m = 0; m < 4; ++m) { const size_t o = (size_t)(row0 + ai * HALF + m * 16) * D + col0;
#pragma unroll
                for (int bj = 0; bj < 2; ++bj) {
                    const u32x4 xv = *(const u32x4*)(X + o + bj * HALF);
                    f32x4 y0, y1;
#pragma unroll
                    for (int q = 0; q < 2; ++q) { y0[2 * q] = __uint_as_float(xv[q] << 16) * ALPHA + acc[ai][bj][m][0][2 * q]; y0[2 * q + 1] = __uint_as_float(xv[q] & 0xffff0000u) * ALPHA + acc[ai][bj][m][0][2 * q + 1];
                        y1[2 * q] = __uint_as_float(xv[2 + q] << 16) * ALPHA + acc[ai][bj][m][1][2 * q]; y1[2 * q + 1] = __uint_as_float(xv[2 + q] & 0xffff0000u) * ALPHA + acc[ai][bj][m][1][2 * q + 1]; }
                    *(u32x4*)(Y + o + bj * HALF) = pack8(y0, y1); } }
    }
};
__device__ __forceinline__ unsigned pack4_fp8(float a, float b, float c, float d) {
    a = fminf(fmaxf(a, -448.f), 448.f); b = fminf(fmaxf(b, -448.f), 448.f); c = fminf(fmaxf(c, -448.f), 448.f); d = fminf(fmaxf(d, -448.f), 448.f);
    int p = 0; p = __builtin_amdgcn_cvt_pk_fp8_f32(a, b, p, false); p = __builtin_amdgcn_cvt_pk_fp8_f32(c, d, p, true); return (unsigned)p;
}
constexpr float F8_X = 16.f, F8_WGU = 64.f, F8_H = 4.f, F8_WDN = 256.f, F8_O = 64.f, F8_WDO = 128.f;
constexpr int e8m0x4(int e) { return (127 + e) * 0x01010101; }
constexpr float F8_Q = 64.f, F8_KV = 16.f;
constexpr int SC_S = e8m0x4(-10), SC_V = e8m0x4(-4);
constexpr int SC_UP = e8m0x4(-10), SC_DN = e8m0x4(-10), SC_DO = e8m0x4(-13);
struct EpiSwiglu8 {
    unsigned char* H;
    __device__ __forceinline__ void operator()(const Acc& acc, const Unit& u, int wr, int wc, int fr, int fq) const {
        const int row0 = u.pm * BM + wr * 64 + fr, col0 = u.pn * 128 + wc * 32 + 8 * fq;
#pragma unroll
        for (int ai = 0; ai < 2; ++ai)
#pragma unroll
            for (int m = 0; m < 4; ++m) { unsigned char* rowp = H + (size_t)(row0 + ai * HALF + m * 16) * DFF + col0;
                float h[8];
#pragma unroll
                for (int j = 0; j < 8; ++j) { const float gt = acc[ai][0][m][j >> 2][j & 3], up = acc[ai][1][m][j >> 2][j & 3];
                    h[j] = __builtin_amdgcn_fmed3f(gt * (up * F8_H) * fast_rcp(1.0f + fast_exp2(gt * -1.4426950408889634f)), -448.f, 448.f); }
                int p0 = 0, p1 = 0;
                p0 = __builtin_amdgcn_cvt_pk_fp8_f32(h[0], h[1], p0, false); p0 = __builtin_amdgcn_cvt_pk_fp8_f32(h[2], h[3], p0, true);
                p1 = __builtin_amdgcn_cvt_pk_fp8_f32(h[4], h[5], p1, false); p1 = __builtin_amdgcn_cvt_pk_fp8_f32(h[6], h[7], p1, true);
                *(u32x2*)rowp = (u32x2){(unsigned)p0, (unsigned)p1}; }
    }
};
struct EpiSwiglu {
    bf16_t* H;
    __device__ __forceinline__ void operator()(const Acc& acc, const Unit& u, int wr, int wc, int fr, int fq) const {
        const int row0 = u.pm * BM + wr * 64 + fr, col0 = u.pn * 128 + wc * 32 + 8 * fq;
#pragma unroll
        for (int ai = 0; ai < 2; ++ai)
#pragma unroll
            for (int m = 0; m < 4; ++m) { bf16_t* rowp = H + (size_t)(row0 + ai * HALF + m * 16) * DFF + col0;
                f32x4 h0, h1;
#pragma unroll
                for (int j = 0; j < 4; ++j) { h0[j] = siluf_(acc[ai][0][m][0][j]) * acc[ai][1][m][0][j]; h1[j] = siluf_(acc[ai][0][m][1][j]) * acc[ai][1][m][1][j]; }
                *(u32x4*)rowp = pack8(h0, h1); }
    }
};
struct EpiBf16 {
    bf16_t* C; int ldc;
    __device__ __forceinline__ void operator()(const Acc& acc, const Unit& u, int wr, int wc, int fr, int fq) const {
        const int row0 = u.pm * BM + wr * 64 + fr, col0 = u.pn * BM + wc * 32 + 8 * fq;
#pragma unroll
        for (int ai = 0; ai < 2; ++ai)
#pragma unroll
            for (int m = 0; m < 4; ++m) { bf16_t* rowp = C + (size_t)(row0 + ai * HALF + m * 16) * ldc + col0;
#pragma unroll
                for (int bj = 0; bj < 2; ++bj) *(u32x4*)(rowp + bj * HALF) = pack8(acc[ai][bj][m][0], acc[ai][bj][m][1]); }
    }
};
struct EpiQ {
    bf16_t* QLAT; bf16_t* QIDX;
    __device__ __forceinline__ void operator()(const Acc& acc, const Unit& u, int wr, int wc, int fr, int fq) const {
        const bool lat = u.pn < 8; bf16_t* base = lat ? QLAT : QIDX; const int ld = lat ? 2048 : 512;
        const int row0 = u.pm * BM + wr * 64 + fr, col0 = (lat ? u.pn : u.pn - 8) * BM + wc * 32 + 8 * fq;
#pragma unroll
        for (int ai = 0; ai < 2; ++ai)
#pragma unroll
            for (int m = 0; m < 4; ++m) { bf16_t* rowp = base + (size_t)(row0 + ai * HALF + m * 16) * ld + col0;
#pragma unroll
                for (int bj = 0; bj < 2; ++bj) *(u32x4*)(rowp + bj * HALF) = pack8(acc[ai][bj][m][0], acc[ai][bj][m][1]); }
    }
};
struct EpiQ8 {
    unsigned char* QLAT8; bf16_t* QIDX;
    __device__ __forceinline__ void operator()(const Acc& acc, const Unit& u, int wr, int wc, int fr, int fq) const {
        const int row0 = u.pm * BM + wr * 64 + fr;
        if (u.pn < 8) { const int col0 = u.pn * BM + wc * 32 + 8 * fq;
#pragma unroll
            for (int ai = 0; ai < 2; ++ai)
#pragma unroll
                for (int m = 0; m < 4; ++m) { unsigned char* rowp = QLAT8 + (size_t)(row0 + ai * HALF + m * 16) * 2048 + col0;
#pragma unroll
                    for (int bj = 0; bj < 2; ++bj) { u32x2 o;
                        o.x = pack4_fp8(acc[ai][bj][m][0][0] * F8_Q, acc[ai][bj][m][0][1] * F8_Q, acc[ai][bj][m][0][2] * F8_Q, acc[ai][bj][m][0][3] * F8_Q);
                        o.y = pack4_fp8(acc[ai][bj][m][1][0] * F8_Q, acc[ai][bj][m][1][1] * F8_Q, acc[ai][bj][m][1][2] * F8_Q, acc[ai][bj][m][1][3] * F8_Q);
                        *(u32x2*)(rowp + bj * HALF) = o; } }
        } else { const int col0 = (u.pn - 8) * BM + wc * 32 + 8 * fq;
#pragma unroll
            for (int ai = 0; ai < 2; ++ai)
#pragma unroll
                for (int m = 0; m < 4; ++m) { bf16_t* rowp = QIDX + (size_t)(row0 + ai * HALF + m * 16) * 512 + col0;
#pragma unroll
                    for (int bj = 0; bj < 2; ++bj) *(u32x4*)(rowp + bj * HALF) = pack8(acc[ai][bj][m][0], acc[ai][bj][m][1]); }
        }
    }
};
struct EpiMoeDn {
    bf16_t* O; const float* GW;
    __device__ __forceinline__ void operator()(const Acc& acc, const Unit& u, int wr, int wc, int fr, int fq) const {
        const int rl0 = wr * 64 + fr, col0 = u.pn * BM + wc * 32 + 8 * fq; const float* gwp = GW + (size_t)u.e * M + 256 * u.lt;
#pragma unroll
        for (int ai = 0; ai < 2; ++ai)
#pragma unroll
            for (int m = 0; m < 4; ++m) { const int rl = rl0 + ai * HALF + m * 16; const float gv = (256 * u.lt + rl < u.cnt) ? gwp[rl] : 0.f; bf16_t* rowp = O + (size_t)(u.pm * BM + rl) * D + col0;
#pragma unroll
                for (int bj = 0; bj < 2; ++bj) *(u32x4*)(rowp + bj * HALF) = pack8(acc[ai][bj][m][0] * gv, acc[ai][bj][m][1] * gv); }
    }
};

struct Params { const float* in[22]; float* out; unsigned char* ws; int ph_lo, ph_hi; };
enum { IN_X = 0, IN_LNG, IN_LNB, IN_HGWIN, IN_HGLB, IN_HGNG, IN_HGWOUT, IN_DWIN, IN_DQNG, IN_DKVNG, IN_DWUQ, IN_DWUK, IN_DWUV, IN_DWQIDX, IN_DKIG, IN_DKIB, IN_DWOUT, IN_FGU, IN_FDN, IN_MR, IN_MGU, IN_MDN };

__device__ __forceinline__ const float* inptr(int i) {
    int off = i * 8; asm volatile("" : "+s"(off));
    typedef const float* cfp;
    return *(const __attribute__((address_space(4))) cfp*)((const __attribute__((address_space(4))) char*)__builtin_amdgcn_kernarg_segment_ptr() + off);
}
#define INP(i) inptr(i)
struct Frame {
    LAS unsigned char* lds;
    unsigned* ctl;
    int tid, lane, wave, G, c;
};

__device__ __forceinline__ void p0_transpose_item(const float* W, int K, int Nsrc, int nblk, bf16_t* WT, int mode, float f8scale, LAS float* scr, int item, int lane) {
    const int kb = item / nblk, nb = item % nblk, k0 = 64 * kb, n0 = 32 * nb;
    const int c4 = (lane & 7) * 4, kr = lane >> 3;
#pragma unroll
    for (int i = 0; i < 8; ++i) { const int kk = 8 * i + kr;
        f32x4 v = (f32x4){0.f, 0.f, 0.f, 0.f};
        if (n0 + c4 < Nsrc) v = *(const f32x4*)(W + (size_t)(k0 + kk) * Nsrc + n0 + c4);
        scr[kk * 33 + c4 + 0] = v[0]; scr[kk * 33 + c4 + 1] = v[1]; scr[kk * 33 + c4 + 2] = v[2]; scr[kk * 33 + c4 + 3] = v[3]; }
    LDS_WAIT(); asm volatile("" ::: "memory");
    int drow0 = n0;
    if (mode == 1) { const int half = n0 / DFF, r = n0 % DFF; drow0 = 256 * (r / 128) + 128 * half + (r % 128); }
    if (f8scale > 0.f) {
        const int c = lane & 3;
#pragma unroll
        for (int j = 0; j < 2; ++j) { const int n = (lane >> 2) + 16 * j; const LAS float* s = scr + (16 * c) * 33 + n;
            u32x4 o;
#pragma unroll
            for (int q = 0; q < 4; ++q) o[q] = pack4_fp8(s[(4 * q) * 33] * f8scale, s[(4 * q + 1) * 33] * f8scale, s[(4 * q + 2) * 33] * f8scale, s[(4 * q + 3) * 33] * f8scale);
            *(u32x4*)((unsigned char*)WT + (size_t)(drow0 + n) * K + k0 + 16 * c) = o; }
    } else {
        const int c = lane & 7;
#pragma unroll
        for (int j = 0; j < 4; ++j) { const int n = (lane >> 3) + 8 * j; const LAS float* s = scr + (8 * c) * 33 + n;
            u32x4 o; o.x = cvt_pk_bf16(s[0 * 33], s[1 * 33]); o.y = cvt_pk_bf16(s[2 * 33], s[3 * 33]); o.z = cvt_pk_bf16(s[4 * 33], s[5 * 33]); o.w = cvt_pk_bf16(s[6 * 33], s[7 * 33]);
            *(u32x4*)(WT + (size_t)(drow0 + n) * K + k0 + 8 * c) = o; }
    }
    LDS_WAIT(); asm volatile("" ::: "memory");
}
__device__ __forceinline__ void p0_combo_item(Frame& F, const float* A, int lda, const float* B, int ldb, bf16_t* out, int ldo, float scale, bool f8 = false) {
    LAS float* As = (LAS float*)F.lds; LAS float* Bs = As + 64 * 128;
    const int t = F.tid;
#pragma unroll
    for (int q = 0; q < 4; ++q) { const int r = (t >> 5) + 16 * q, c4 = (t & 31) * 4; *(LAS f32x4*)(As + r * 128 + c4) = *(const f32x4*)(A + (size_t)r * lda + c4); }
#pragma unroll
    for (int q = 0; q < 4; ++q) { const int r = (t >> 4) + 32 * q, c4 = (t & 15) * 4; *(LAS f32x4*)(Bs + r * 64 + c4) = *(const f32x4*)(B + (size_t)r * ldb + c4); }
    __syncthreads();
    const int tj = t & 63, ti = t >> 6;
    float acc[8];
#pragma unroll
    for (int ii = 0; ii < 8; ++ii) acc[ii] = 0.f;
    for (int d = 0; d < 128; d += 4) {
        const float b0 = Bs[(d + 0) * 64 + tj], b1 = Bs[(d + 1) * 64 + tj], b2 = Bs[(d + 2) * 64 + tj], b3 = Bs[(d + 3) * 64 + tj];
#pragma unroll
        for (int ii = 0; ii < 8; ++ii) { const f32x4 a = *(const LAS f32x4*)(As + (8 * ti + ii) * 128 + d); acc[ii] += a[0] * b0 + a[1] * b1 + a[2] * b2 + a[3] * b3; }
    }
    u32x4 o; o.x = cvt_pk_bf16(acc[0] * scale, acc[1] * scale); o.y = cvt_pk_bf16(acc[2] * scale, acc[3] * scale); o.z = cvt_pk_bf16(acc[4] * scale, acc[5] * scale); o.w = cvt_pk_bf16(acc[6] * scale, acc[7] * scale);
    if (f8) { u32x2 o8; o8.x = pack4_fp8(acc[0] * scale, acc[1] * scale, acc[2] * scale, acc[3] * scale); o8.y = pack4_fp8(acc[4] * scale, acc[5] * scale, acc[6] * scale, acc[7] * scale);
        *(u32x2*)((unsigned char*)out + (size_t)tj * ldo + 8 * ti) = o8; }
    else *(u32x4*)(out + (size_t)tj * ldo + 8 * ti) = o;
    __syncthreads();
}
__device__ __forceinline__ void p0_prologue(Frame& F, const Params& p) {
    unsigned char* ws = p.ws;
    LAS float* scr = (LAS float*)(F.lds + F.wave * 8448);
    const int gw = F.c * NWAVES + F.wave, NGW = F.G * NWAVES;
    constexpr int I0 = 16 * 128, I1 = 16 * 32, I2 = 16 * 224, I3 = 56 * 32, I4 = 16 * 24, I5 = 4 * 16;
    constexpr int NITEMS = 2 * (I0 + I1 + I2 + I3 + I4 + I5) + 16 * (I2 + I3);
    for (int it = gw; it < NITEMS; it += NGW) {
        int r = it;
        if (r < 16 * I2) { const int job = r / I2;
#if MK_MOE_FP8
            p0_transpose_item(INP(IN_MGU) + (size_t)job * D * 2 * DFF, D, 2 * DFF, 224, (bf16_t*)(ws + WS_W_MGU8 + (size_t)job * 2 * DFF * D), 1, F8_WGU, scr, r % I2, F.lane);
#else
            p0_transpose_item(INP(IN_MGU) + (size_t)job * D * 2 * DFF, D, 2 * DFF, 224, (bf16_t*)(ws + WS_W_MGU) + (size_t)job * 2 * DFF * D, 1, 0.f, scr, r % I2, F.lane);
#endif
            continue; } r -= 16 * I2;
        if (r < 16 * I3) { const int job = r / I3;
#if MK_MOE_FP8
            p0_transpose_item(INP(IN_MDN) + (size_t)job * DFF * D, DFF, D, 32, (bf16_t*)(ws + WS_W_MDN8 + (size_t)job * D * DFF), 0, F8_WDN, scr, r % I3, F.lane);
#else
            p0_transpose_item(INP(IN_MDN) + (size_t)job * DFF * D, DFF, D, 32, (bf16_t*)(ws + WS_W_MDN) + (size_t)job * D * DFF, 0, 0.f, scr, r % I3, F.lane);
#endif
            continue; } r -= 16 * I3;
        if (r < 2 * I0) { const int job = r / I0; p0_transpose_item(INP(IN_HGWIN) + (size_t)job * D * 4 * D, D, 4 * D, 128, (bf16_t*)(ws + WS_W_HGIN) + (size_t)job * 4 * D * D, 0, 0.f, scr, r % I0, F.lane); continue; } r -= 2 * I0;
        if (r < 2 * I1) { const int job = r / I1; p0_transpose_item(INP(IN_HGWOUT) + (size_t)job * D * D, D, D, 32, (bf16_t*)(ws + WS_W_HGOUT) + (size_t)job * D * D, 0, 0.f, scr, r % I1, F.lane); continue; } r -= 2 * I1;
        if (r < 2 * I2) { const int job = r / I2;
#if MK_FFN_FP8 == 2
            p0_transpose_item(INP(IN_FGU) + (size_t)job * D * 2 * DFF, D, 2 * DFF, 224, (bf16_t*)(ws + WS_W_FGU + (size_t)job * 2 * DFF * D), 1, F8_WGU, scr, r % I2, F.lane);
#else
            p0_transpose_item(INP(IN_FGU) + (size_t)job * D * 2 * DFF, D, 2 * DFF, 224, (bf16_t*)(ws + WS_W_FGU) + (size_t)job * 2 * DFF * D, 1, 0.f, scr, r % I2, F.lane);
#endif
            continue; } r -= 2 * I2;
        if (r < 2 * I3) { const int job = r / I3;
#if MK_FFN_FP8 >= 1
            p0_transpose_item(INP(IN_FDN) + (size_t)job * DFF * D, DFF, D, 32, (bf16_t*)(ws + WS_W_FDN + (size_t)job * D * DFF), 0, F8_WDN, scr, r % I3, F.lane);
#else
            p0_transpose_item(INP(IN_FDN) + (size_t)job * DFF * D, DFF, D, 32, (bf16_t*)(ws + WS_W_FDN) + (size_t)job * D * DFF, 0, 0.f, scr, r % I3, F.lane);
#endif
            continue; } r -= 2 * I3;
        if (r < 2 * I4) { const int job = r / I4; p0_transpose_item(INP(IN_DWIN) + (size_t)job * D * DSA_IN, D, DSA_IN, 24, (bf16_t*)(ws + WS_W_DIN) + (size_t)job * DSA_IN_PAD * D, 0, 0.f, scr, r % I4, F.lane); continue; } r -= 2 * I4;
        { const int job = r / I5; p0_transpose_item(INP(IN_DWQIDX) + (size_t)job * QR * 512, QR, 512, 16, (bf16_t*)(ws + WS_W_DQ) + (size_t)job * 2560 * QR + (size_t)2048 * QR, 0, 0.f, scr, r % I5, F.lane); }
    }
    { const f32x4* x4 = (const f32x4*)INP(IN_X); u32x2* xb = (u32x2*)(ws + WS_XB); const size_t n4 = (size_t)M * D / 4;
      for (size_t i = (size_t)F.c * NTHREADS + F.tid; i < n4; i += (size_t)F.G * NTHREADS) { const f32x4 v = x4[i]; u32x2 o; o.x = cvt_pk_bf16(v[0], v[1]); o.y = cvt_pk_bf16(v[2], v[3]); xb[i] = o; } }
    __syncthreads();
    const float qscale = 0.08838834764831845f * 1.4426950408889634f;
    for (int it = F.c; it < 256 + 1024; it += F.G) {
        if (it < 256) { const int j = it >> 7, h = (it >> 4) & 7, ib = (it >> 2) & 3, jb = it & 3;
            p0_combo_item(F, INP(IN_DWUQ) + (size_t)j * QR * D + (size_t)(64 * ib) * D + h * 128, D, INP(IN_DWUK) + ((size_t)j * 8 + h) * 128 * KVR + 64 * jb, KVR,
                          (bf16_t*)(ws + WS_W_DQ) + (size_t)j * 2560 * QR + (size_t)(h * 256 + 64 * jb) * QR + 64 * ib, QR, qscale);
        } else { const int r = it - 256, j = r >> 9, h = (r >> 6) & 7, ib = (r >> 4) & 3, jb = r & 15;
            p0_combo_item(F, INP(IN_DWUV) + (((size_t)j * 8 + h) * KVR + 64 * ib) * 128, 128, INP(IN_DWOUT) + (size_t)j * D * D + (size_t)(h * 128) * D + 64 * jb, D,
#if MK_B6_FP8
                          (bf16_t*)(ws + WS_W_DO + (size_t)j * D * 2048 + (size_t)(64 * jb) * 2048 + h * 256 + 64 * ib), 2048, F8_WDO, true);
#else
                          (bf16_t*)(ws + WS_W_DO) + (size_t)j * D * 2048 + (size_t)(64 * jb) * 2048 + h * 256 + 64 * ib, 2048, 1.0f);
#endif
        }
    }
}

__device__ __forceinline__ void unpack8(const u32x4 w, float* v) {
#pragma unroll
    for (int q = 0; q < 4; ++q) { v[2 * q] = __uint_as_float(w[q] << 16); v[2 * q + 1] = __uint_as_float(w[q] & 0xffff0000u); }
}
__device__ __forceinline__ void load_row_bf16(const bf16_t* row, int lane, float (&v)[16]) {
    const u32x4 a = *(const u32x4*)(row + 8 * lane), b = *(const u32x4*)(row + 512 + 8 * lane); unpack8(a, v); unpack8(b, v + 8);
}
__device__ __forceinline__ void load_vec_f32(const float* p, int lane, float (&v)[16]) {
#pragma unroll
    for (int h = 0; h < 2; ++h)
#pragma unroll
        for (int q = 0; q < 2; ++q) { const f32x4 x = *(const f32x4*)(p + 512 * h + 8 * lane + 4 * q); v[8 * h + 4 * q] = x[0]; v[8 * h + 4 * q + 1] = x[1]; v[8 * h + 4 * q + 2] = x[2]; v[8 * h + 4 * q + 3] = x[3]; }
}
__device__ __forceinline__ void store_row_bf16(const float (&v)[16], bf16_t* row, int lane) {
    u32x4 a, b;
#pragma unroll
    for (int q = 0; q < 4; ++q) { a[q] = cvt_pk_bf16(v[2 * q], v[2 * q + 1]); b[q] = cvt_pk_bf16(v[8 + 2 * q], v[8 + 2 * q + 1]); }
    *(u32x4*)(row + 8 * lane) = a; *(u32x4*)(row + 512 + 8 * lane) = b;
}
__device__ __forceinline__ void store_row_fp8(const float (&v)[16], unsigned char* row, int lane) {
    u32x2 o0, o1; o0.x = pack4_fp8(v[0] * F8_X, v[1] * F8_X, v[2] * F8_X, v[3] * F8_X); o0.y = pack4_fp8(v[4] * F8_X, v[5] * F8_X, v[6] * F8_X, v[7] * F8_X);
    o1.x = pack4_fp8(v[8] * F8_X, v[9] * F8_X, v[10] * F8_X, v[11] * F8_X); o1.y = pack4_fp8(v[12] * F8_X, v[13] * F8_X, v[14] * F8_X, v[15] * F8_X);
    *(u32x2*)(row + 8 * lane) = o0; *(u32x2*)(row + 512 + 8 * lane) = o1;
}
__device__ __forceinline__ void store_row_f32(const float (&v)[16], float* row, int lane) {
#pragma unroll
    for (int h = 0; h < 2; ++h)
#pragma unroll
        for (int q = 0; q < 2; ++q) *(f32x4*)(row + 512 * h + 8 * lane + 4 * q) = (f32x4){v[8 * h + 4 * q], v[8 * h + 4 * q + 1], v[8 * h + 4 * q + 2], v[8 * h + 4 * q + 3]};
}
__device__ __forceinline__ void ln_row(float (&v)[16], const float (&g)[16], const float (&b)[16]) {
    float s = 0.f;
#pragma unroll
    for (int i = 0; i < 16; ++i) s += v[i];
    const float mean = wave_sum(s) * (1.f / D); float s2 = 0.f;
#pragma unroll
    for (int i = 0; i < 16; ++i) { v[i] -= mean; s2 += v[i] * v[i]; }
    const float rstd = 1.f / sqrtf(wave_sum(s2) * (1.f / D) + LN_EPS);
#pragma unroll
    for (int i = 0; i < 16; ++i) v[i] = v[i] * rstd * g[i] + b[i];
}
__device__ __forceinline__ void ln_phase(Frame& F, const bf16_t* Y, const float* g, const float* b, bf16_t* XB, unsigned char* XB8) {
    float gv[16], bv[16]; load_vec_f32(g, F.lane, gv); load_vec_f32(b, F.lane, bv);
    const int gw = F.c * NWAVES + F.wave, NGW = F.G * NWAVES;
    for (int m = gw; m < M; m += NGW) {
        float v[16]; load_row_bf16(Y + (size_t)m * D, F.lane, v);
        ln_row(v, gv, bv);
        store_row_bf16(v, XB + (size_t)m * D, F.lane);
        if (XB8) store_row_fp8(v, XB8 + (size_t)m * D, F.lane);
    }
}
__device__ __forceinline__ void ln_moe_phase(Frame& F, const bf16_t* Xin, const bf16_t* OUTM, const int* EIDX, const int* POS, const unsigned* gcnt, const float* g, const float* b, bf16_t* XB, float* OUT) {
    float gv[16], bv[16]; load_vec_f32(g, F.lane, gv); load_vec_f32(b, F.lane, bv);
    int roff[8]; { int t = 0;
#pragma unroll
        for (int e = 0; e < 8; ++e) { roff[e] = t * 256; t += (__builtin_amdgcn_readfirstlane((int)__hip_atomic_load(gcnt + e, __ATOMIC_RELAXED, __HIP_MEMORY_SCOPE_AGENT)) + 255) >> 8; } }
    const int gw = F.c * NWAVES + F.wave, NGW = F.G * NWAVES;
    for (int m = gw; m < M; m += NGW) {
        const int e0 = EIDX[2 * m], e1 = EIDX[2 * m + 1]; int s0 = POS[2 * m], s1 = POS[2 * m + 1];
#pragma unroll
        for (int k = 0; k < 8; ++k) { s0 += (e0 == k) ? roff[k] : 0; s1 += (e1 == k) ? roff[k] : 0; }
        float v[16], o0[16], o1[16]; load_row_bf16(Xin + (size_t)m * D, F.lane, v); load_row_bf16(OUTM + (size_t)s0 * D, F.lane, o0); load_row_bf16(OUTM + (size_t)s1 * D, F.lane, o1);
#pragma unroll
        for (int i = 0; i < 16; ++i) v[i] = v[i] * ALPHA + o0[i] + o1[i];
        ln_row(v, gv, bv);
        if (OUT) store_row_f32(v, OUT + (size_t)m * D, F.lane); else store_row_bf16(v, XB + (size_t)m * D, F.lane);
    }
}
__device__ __forceinline__ void ln_router_phase(Frame& F, const bf16_t* Y, const float* g, const float* b, const float* wrouter, bf16_t* XB, unsigned char* XB8,
                                                int* EIDX, int* POS, int* TOK, float* GW, unsigned* gcnt) {
    LAS float* WR = (LAS float*)F.lds;
    LAS int* SEL = (LAS int*)(F.lds + 32768);
    LAS int* CW = (LAS int*)(F.lds + 32768 + 1024);
    LAS int* BASE = (LAS int*)(F.lds + 32768 + 1024 + 128);
    LAS float* SELW = (LAS float*)(F.lds + 32768 + 2048);
    for (int q = 0; q < 16; ++q) { const int idx = F.tid + NTHREADS * q; WR[(idx & 7) * 1024 + (idx >> 3)] = wrouter[idx]; }
    float gv[16], bv[16]; load_vec_f32(g, F.lane, gv); load_vec_f32(b, F.lane, bv);
    __syncthreads();
    for (int blk = F.c; blk < M / 128; blk += F.G) {
        for (int rl = F.wave; rl < 128; rl += NWAVES) {
            const int m = blk * 128 + rl;
            float v[16]; load_row_bf16(Y + (size_t)m * D, F.lane, v);
            ln_row(v, gv, bv);
            store_row_bf16(v, XB + (size_t)m * D, F.lane);
            if (XB8) store_row_fp8(v, XB8 + (size_t)m * D, F.lane);
            float lg[8];
#pragma unroll
            for (int e = 0; e < 8; ++e) { float s = 0.f;
#pragma unroll
                for (int h = 0; h < 2; ++h)
#pragma unroll
                    for (int q = 0; q < 2; ++q) { const f32x4 w = *(const LAS f32x4*)(WR + e * 1024 + 512 * h + 8 * F.lane + 4 * q); const int o = 8 * h + 4 * q;
                        s += (v[o] * w[0] + v[o + 1] * w[1]) + (v[o + 2] * w[2] + v[o + 3] * w[3]); }
                lg[e] = wave_sum(s); }
            int e0 = 0; float v0 = lg[0];
#pragma unroll
            for (int e = 1; e < 8; ++e) if (lg[e] > v0) { v0 = lg[e]; e0 = e; }
            int e1 = -1; float v1 = -3.0e38f;
#pragma unroll
            for (int e = 0; e < 8; ++e) if (e != e0 && lg[e] > v1) { v1 = lg[e]; e1 = e; }
            const float w1 = 1.f / (1.f + __expf(v0 - v1)), w0 = 1.f - w1;
            if (F.lane == 0) { SEL[2 * rl] = e0; SEL[2 * rl + 1] = e1; SELW[2 * rl] = w0; SELW[2 * rl + 1] = w1; EIDX[2 * m] = e0; EIDX[2 * m + 1] = e1; }
        }
        __syncthreads();
        const int mine = F.tid < 256 ? SEL[F.tid] : -1;
        int myrank = 0;
        if (F.wave < 4) {
#pragma unroll
            for (int e = 0; e < 8; ++e) { const unsigned long long mk = __ballot(mine == e); const int rk = __builtin_popcountll(mk & ((1ull << F.lane) - 1ull)); if (mine == e) myrank = rk;
                if (F.lane == 0) CW[F.wave * 8 + e] = __builtin_popcountll(mk); }
        }
        __syncthreads();
        if (F.tid < 8) { const int tot = CW[F.tid] + CW[8 + F.tid] + CW[16 + F.tid] + CW[24 + F.tid]; BASE[F.tid] = (int)__hip_atomic_fetch_add(gcnt + F.tid, (unsigned)tot, __ATOMIC_RELAXED, __HIP_MEMORY_SCOPE_AGENT); }
        __syncthreads();
        if (F.tid < 256) { int pos = BASE[mine] + myrank; for (int w = 0; w < F.wave; ++w) pos += CW[w * 8 + mine]; POS[blk * 256 + F.tid] = pos;
            TOK[(size_t)mine * M + pos] = blk * 128 + (F.tid >> 1); GW[(size_t)mine * M + pos] = SELW[F.tid]; }
        __syncthreads();
    }
}
__device__ __forceinline__ void hgrn_phase(Frame& F, const bf16_t* Q, const bf16_t* FP, const bf16_t* V, const float* lbparam, int jl, bf16_t* O) {
    constexpr int QST = 0, QS2 = 18432, KST = 36864, VS = 55296, SST0 = 64512, SSTB = 17408, SEG = 99328, RV = 103424, DV = 103936;
    constexpr int LQ = 136, LT = 72;
    LAS unsigned char* L = F.lds;
    const int tid = F.tid, lane = F.lane, w = F.wave, fr = lane & 15, fq = lane >> 4, qq = fr >> 2, pp = lane & 3;
    const int dp = tid & 63, seg = tid >> 6, d0 = 2 * dp;
    const int vrow = tid >> 3, vch = tid & 7;
    const int tt = w >> 1, eh = w & 1;
    for (int u = F.c; u < BATCH * HG_H * 2; u += F.G) {
        const int b = u >> 4, h = (u >> 1) & 7, vh = u & 1;
        float lb0 = 0.f, lb1 = 0.f;
        if (jl == 1) { const f32x2 l0 = *(const f32x2*)(lbparam + h * 128 + d0), l1 = *(const f32x2*)(lbparam + D + h * 128 + d0); lb0 = 1.f / (1.f + __expf(l0[0] - l1[0])); lb1 = 1.f / (1.f + __expf(l0[1] - l1[1])); }
        const float om0 = 1.f - lb0, om1 = 1.f - lb1;
        f32x4 St[4];
#pragma unroll
        for (int et = 0; et < 4; ++et) { St[et] = (f32x4){0.f, 0.f, 0.f, 0.f}; *(LAS u32x2*)(L + SST0 + ((16 * et + fr) * LQ + 16 * w + 4 * fq) * 2) = (u32x2){0u, 0u}; }
        const size_t ubase = (size_t)b * SEQ * D + h * 128;
        unsigned fpn[8], qn[8]; u32x4 vn;
        { const bf16_t* fp = FP + ubase + (size_t)(8 * seg) * D + d0; const bf16_t* qp = Q + ubase + (size_t)(8 * seg) * D + d0;
#pragma unroll
          for (int i = 0; i < 8; ++i) { fpn[i] = *(const unsigned*)(fp + (size_t)i * D); qn[i] = *(const unsigned*)(qp + (size_t)i * D); }
          vn = *(const u32x4*)(V + ubase + (size_t)vrow * D + vh * 64 + 8 * vch); }
        for (int ch = 0; ch < SEQ / HG_C; ++ch) {
            const size_t rowoff = ubase + (size_t)ch * HG_C * D;
            LAS unsigned char* SSTc = L + SST0 + (ch & 1) * SSTB; LAS unsigned char* SSTn = L + SST0 + ((ch + 1) & 1) * SSTB;
            float c0[8], c1[8], k0[8], k1[8], q0[8], q1[8];
            { float a0 = 0.f, a1 = 0.f;
#pragma unroll
              for (int i = 0; i < 8; ++i) { const float s0 = sigmoidf_(__uint_as_float(fpn[i] << 16)), s1 = sigmoidf_(__uint_as_float(fpn[i] & 0xffff0000u));
                  a0 += __logf(lb0 + om0 * s0); a1 += __logf(lb1 + om1 * s1); c0[i] = a0; c1[i] = a1; k0[i] = om0 * (1.f - s0); k1[i] = om1 * (1.f - s1);
                  q0[i] = __uint_as_float(qn[i] << 16); q1[i] = __uint_as_float(qn[i] & 0xffff0000u); }
              *(LAS f32x2*)(L + SEG + (seg * 128 + d0) * 4) = (f32x2){a0, a1};
              *(LAS u32x4*)(L + VS + (vrow * LT + 8 * vch) * 2) = vn; }
            __syncthreads();
            { float pre0 = 0.f, pre1 = 0.f, r0 = 0.f, r1 = 0.f, bl0 = 0.f, bl1 = 0.f;
#pragma unroll
              for (int s = 0; s < 8; ++s) { const f32x2 v = *(LAS f32x2*)(L + SEG + (s * 128 + d0) * 4);
                  if (s < seg) { pre0 += v[0]; pre1 += v[1]; } if (s < 4) { r0 += v[0]; r1 += v[1]; } bl0 += v[0]; bl1 += v[1]; }
              const float er0 = __expf(r0), er1 = __expf(r1);
              unsigned qa[4], qb[4], ka[4], xa[4], xb[4], kb[4];
#pragma unroll
              for (int i = 0; i < 8; i += 2) {
                  const float ba = pre0 + c0[i], bb = pre0 + c0[i + 1], bc = pre1 + c1[i], bd = pre1 + c1[i + 1];
                  const float qa0 = q0[i] * __expf(ba - r0), qa1 = q0[i + 1] * __expf(bb - r0), qb0 = q1[i] * __expf(bc - r1), qb1 = q1[i + 1] * __expf(bd - r1);
                  qa[i >> 1] = cvt_pk_bf16(qa0, qa1); qb[i >> 1] = cvt_pk_bf16(qb0, qb1);
                  xa[i >> 1] = cvt_pk_bf16(qa0 * er0, qa1 * er0); xb[i >> 1] = cvt_pk_bf16(qb0 * er1, qb1 * er1);
                  ka[i >> 1] = cvt_pk_bf16(k0[i] * __expf(r0 - ba), k0[i + 1] * __expf(r0 - bb)); kb[i >> 1] = cvt_pk_bf16(k1[i] * __expf(r1 - bc), k1[i + 1] * __expf(r1 - bd));
              }
              const int o0 = (d0 * LT + 8 * seg) * 2, o1 = o0 + LT * 2;
              *(LAS u32x4*)(L + QST + o0) = (u32x4){qa[0], qa[1], qa[2], qa[3]}; *(LAS u32x4*)(L + QST + o1) = (u32x4){qb[0], qb[1], qb[2], qb[3]};
              *(LAS u32x4*)(L + QS2 + o0) = (u32x4){xa[0], xa[1], xa[2], xa[3]}; *(LAS u32x4*)(L + QS2 + o1) = (u32x4){xb[0], xb[1], xb[2], xb[3]};
              *(LAS u32x4*)(L + KST + o0) = (u32x4){ka[0], ka[1], ka[2], ka[3]}; *(LAS u32x4*)(L + KST + o1) = (u32x4){kb[0], kb[1], kb[2], kb[3]};
              if (seg == 0) { *(LAS f32x2*)(L + RV + d0 * 4) = (f32x2){er0, er1}; *(LAS f32x2*)(L + DV + d0 * 4) = (f32x2){__expf(bl0 - r0), __expf(bl1 - r1)}; } }
            __syncthreads();
            if (ch + 1 < SEQ / HG_C) {
                const bf16_t* fp = FP + rowoff + (size_t)(HG_C + 8 * seg) * D + d0; const bf16_t* qp = Q + rowoff + (size_t)(HG_C + 8 * seg) * D + d0;
#pragma unroll
                for (int i = 0; i < 8; ++i) { fpn[i] = *(const unsigned*)(fp + (size_t)i * D); qn[i] = *(const unsigned*)(qp + (size_t)i * D); }
                vn = *(const u32x4*)(V + rowoff + (size_t)(HG_C + vrow) * D + vh * 64 + 8 * vch);
            }
            bf16x8 Pf[2];
            { f32x4 sc[4];
#pragma unroll
              for (int st = 0; st < 4; ++st) { sc[st] = (f32x4){0.f, 0.f, 0.f, 0.f};
                  if (st <= tt) {
#pragma unroll
                      for (int ks = 0; ks < 4; ++ks) {
                          const int ro = ((32 * ks + 8 * fq + qq) * LT + 4 * pp) * 2;
                          const s16x4 a0 = __builtin_amdgcn_ds_read_tr16_b64_v4i16((LAS s16x4*)(L + KST + ro + 32 * st)), a1 = __builtin_amdgcn_ds_read_tr16_b64_v4i16((LAS s16x4*)(L + KST + ro + 4 * LT * 2 + 32 * st));
                          const s16x4 b0 = __builtin_amdgcn_ds_read_tr16_b64_v4i16((LAS s16x4*)(L + QST + ro + 32 * tt)), b1 = __builtin_amdgcn_ds_read_tr16_b64_v4i16((LAS s16x4*)(L + QST + ro + 4 * LT * 2 + 32 * tt));
                          const bf16x8 av = (bf16x8){a0[0], a0[1], a0[2], a0[3], a1[0], a1[1], a1[2], a1[3]}, bv = (bf16x8){b0[0], b0[1], b0[2], b0[3], b1[0], b1[1], b1[2], b1[3]};
                          sc[st] = __builtin_amdgcn_mfma_f32_16x16x32_bf16(av, bv, sc[st], 0, 0, 0); }
#pragma unroll
                      for (int r = 0; r < 4; ++r) sc[st][r] = (16 * st + 4 * fq + r <= 16 * tt + fr) ? sc[st][r] : 0.f;
                  } }
              const u32x4 p0 = pack8(sc[0], sc[1]), p1 = pack8(sc[2], sc[3]); Pf[0] = __builtin_bit_cast(bf16x8, p0); Pf[1] = __builtin_bit_cast(bf16x8, p1); }
            { bf16x8 q2[4];
#pragma unroll
              for (int ks = 0; ks < 4; ++ks) { const int ro = ((32 * ks + 8 * fq + qq) * LT + 4 * pp) * 2 + 32 * tt;
                  const s16x4 b0 = __builtin_amdgcn_ds_read_tr16_b64_v4i16((LAS s16x4*)(L + QS2 + ro)), b1 = __builtin_amdgcn_ds_read_tr16_b64_v4i16((LAS s16x4*)(L + QS2 + ro + 4 * LT * 2));
                  q2[ks] = (bf16x8){b0[0], b0[1], b0[2], b0[3], b1[0], b1[1], b1[2], b1[3]}; }
#pragma unroll
              for (int ex = 0; ex < 2; ++ex) { const int et = 2 * eh + ex;
                  f32x4 acc = (f32x4){0.f, 0.f, 0.f, 0.f};
#pragma unroll
                  for (int k2 = 0; k2 < 2; ++k2) {
                      if (k2 == 0 || tt >= 2) {
                          const int ro = ((32 * k2 + 4 * fq + qq) * LT + 16 * et + 4 * pp) * 2;
                          const s16x4 a0 = __builtin_amdgcn_ds_read_tr16_b64_v4i16((LAS s16x4*)(L + VS + ro)), a1 = __builtin_amdgcn_ds_read_tr16_b64_v4i16((LAS s16x4*)(L + VS + ro + 16 * LT * 2));
                          const bf16x8 av = (bf16x8){a0[0], a0[1], a0[2], a0[3], a1[0], a1[1], a1[2], a1[3]};
                          acc = __builtin_amdgcn_mfma_f32_16x16x32_bf16(av, Pf[k2], acc, 0, 0, 0); } }
#pragma unroll
                  for (int ks = 0; ks < 4; ++ks) { const bf16x8 av = *(LAS bf16x8*)(SSTc + ((16 * et + fr) * LQ + 32 * ks + 8 * fq) * 2);
                      acc = __builtin_amdgcn_mfma_f32_16x16x32_bf16(av, q2[ks], acc, 0, 0, 0); }
                  u32x2 ov; ov.x = cvt_pk_bf16(acc[0], acc[1]); ov.y = cvt_pk_bf16(acc[2], acc[3]);
                  *(u32x2*)(O + rowoff + (size_t)(16 * tt + fr) * D + vh * 64 + 16 * et + 4 * fq) = ov;
              } }
            { const f32x4 rv = *(LAS f32x4*)(L + RV + (16 * w + 4 * fq) * 4), dv = *(LAS f32x4*)(L + DV + (16 * w + 4 * fq) * 4);
              bf16x8 kf[2];
#pragma unroll
              for (int ks = 0; ks < 2; ++ks) kf[ks] = *(LAS bf16x8*)(L + KST + ((16 * w + fr) * LT + 32 * ks + 8 * fq) * 2);
#pragma unroll
              for (int et = 0; et < 4; ++et) { St[et] = St[et] * rv;
#pragma unroll
                  for (int ks = 0; ks < 2; ++ks) { const int ro = ((32 * ks + 8 * fq + qq) * LT + 16 * et + 4 * pp) * 2;
                      const s16x4 b0 = __builtin_amdgcn_ds_read_tr16_b64_v4i16((LAS s16x4*)(L + VS + ro)), b1 = __builtin_amdgcn_ds_read_tr16_b64_v4i16((LAS s16x4*)(L + VS + ro + 4 * LT * 2));
                      const bf16x8 bb = (bf16x8){b0[0], b0[1], b0[2], b0[3], b1[0], b1[1], b1[2], b1[3]};
                      St[et] = __builtin_amdgcn_mfma_f32_16x16x32_bf16(kf[ks], bb, St[et], 0, 0, 0); }
                  St[et] = St[et] * dv;
                  u32x2 o; o.x = cvt_pk_bf16(St[et][0], St[et][1]); o.y = cvt_pk_bf16(St[et][2], St[et][3]);
                  *(LAS u32x2*)(SSTn + ((16 * et + fr) * LQ + 16 * w + 4 * fq) * 2) = o; } }
            __syncthreads();
        }
    }
}
__device__ __forceinline__ void hgrn_gate_phase(Frame& F, const bf16_t* O, const bf16_t* Gt, const float* ng, bf16_t* OG) {
    float gw_[16];
#pragma unroll
    for (int i = 0; i < 16; ++i) gw_[i] = ng[16 * F.lane + i];
    const int gw = F.c * NWAVES + F.wave, NGW = F.G * NWAVES;
    for (int m = gw; m < M; m += NGW) {
        const u32x4 o0 = *(const u32x4*)(O + (size_t)m * D + 16 * F.lane), o1 = *(const u32x4*)(O + (size_t)m * D + 16 * F.lane + 8);
        const u32x4 g0 = *(const u32x4*)(Gt + (size_t)m * D + 16 * F.lane), g1 = *(const u32x4*)(Gt + (size_t)m * D + 16 * F.lane + 8);
        float ov[16], gv[16];
#pragma unroll
        for (int i = 0; i < 4; ++i) { ov[2 * i] = __uint_as_float(o0[i] << 16); ov[2 * i + 1] = __uint_as_float(o0[i] & 0xffff0000u); ov[8 + 2 * i] = __uint_as_float(o1[i] << 16); ov[8 + 2 * i + 1] = __uint_as_float(o1[i] & 0xffff0000u);
            gv[2 * i] = __uint_as_float(g0[i] << 16); gv[2 * i + 1] = __uint_as_float(g0[i] & 0xffff0000u); gv[8 + 2 * i] = __uint_as_float(g1[i] << 16); gv[8 + 2 * i + 1] = __uint_as_float(g1[i] & 0xffff0000u); }
        float ss = 0.f;
#pragma unroll
        for (int i = 0; i < 16; ++i) ss += ov[i] * ov[i];
        ss += __builtin_bit_cast(float, __builtin_amdgcn_update_dpp(0, __builtin_bit_cast(int, ss), 0xB1, 0xF, 0xF, true));
        ss += __builtin_bit_cast(float, __builtin_amdgcn_update_dpp(0, __builtin_bit_cast(int, ss), 0x4E, 0xF, 0xF, true));
        ss += __builtin_bit_cast(float, __builtin_amdgcn_update_dpp(0, __builtin_bit_cast(int, ss), 0x141, 0xF, 0xF, true));
        const float rs = 1.f / sqrtf(ss * (1.f / 128.f) + RMS_EPS);
        float r[16];
#pragma unroll
        for (int i = 0; i < 16; ++i) r[i] = ov[i] * rs * gw_[i] * siluf_(gv[i]);
        u32x4 w0, w1; w0.x = cvt_pk_bf16(r[0], r[1]); w0.y = cvt_pk_bf16(r[2], r[3]); w0.z = cvt_pk_bf16(r[4], r[5]); w0.w = cvt_pk_bf16(r[6], r[7]);
        w1.x = cvt_pk_bf16(r[8], r[9]); w1.y = cvt_pk_bf16(r[10], r[11]); w1.z = cvt_pk_bf16(r[12], r[13]); w1.w = cvt_pk_bf16(r[14], r[15]);
        *(u32x4*)(OG + (size_t)m * D + 16 * F.lane) = w0; *(u32x4*)(OG + (size_t)m * D + 16 * F.lane + 8) = w1;
    }
}

__device__ __forceinline__ void dsa_norm_phase(Frame& F, const bf16_t* RAW, const float* qg, const float* kvg, const float* kig, const float* kib, bf16_t* CQ, bf16_t* CKV, bf16_t* KIDX, float* WIDX) {
    const f32x4 qgv = *(const f32x4*)(qg + 4 * F.lane), kvgv = *(const f32x4*)(kvg + 4 * F.lane); const float kg = kig[F.lane], kb = kib[F.lane];
    const int gw = F.c * NWAVES + F.wave, NGW = F.G * NWAVES;
    for (int m = gw; m < M; m += NGW) {
        const bf16_t* r = RAW + (size_t)m * DSA_IN_PAD;
        const u32x2 ar = *(const u32x2*)(r + 4 * F.lane), cr = *(const u32x2*)(r + 256 + 4 * F.lane); const float ki = bf2f(r[512 + F.lane]);
        const f32x4 a = (f32x4){__uint_as_float(ar.x << 16), __uint_as_float(ar.x & 0xffff0000u), __uint_as_float(ar.y << 16), __uint_as_float(ar.y & 0xffff0000u)};
        const f32x4 c = (f32x4){__uint_as_float(cr.x << 16), __uint_as_float(cr.x & 0xffff0000u), __uint_as_float(cr.y << 16), __uint_as_float(cr.y & 0xffff0000u)};
        const float sa = wave_sum((a[0] * a[0] + a[1] * a[1]) + (a[2] * a[2] + a[3] * a[3])), sc = wave_sum((c[0] * c[0] + c[1] * c[1]) + (c[2] * c[2] + c[3] * c[3]));
        const float ra = 1.f / sqrtf(sa * (1.f / 256.f) + RMS_EPS), rc = 1.f / sqrtf(sc * (1.f / 256.f) + RMS_EPS);
        u32x2 o; o.x = cvt_pk_bf16(a[0] * ra * qgv[0], a[1] * ra * qgv[1]); o.y = cvt_pk_bf16(a[2] * ra * qgv[2], a[3] * ra * qgv[3]); *(u32x2*)(CQ + (size_t)m * 256 + 4 * F.lane) = o;
        o.x = cvt_pk_bf16(c[0] * rc * kvgv[0], c[1] * rc * kvgv[1]); o.y = cvt_pk_bf16(c[2] * rc * kvgv[2], c[3] * rc * kvgv[3]); *(u32x2*)(CKV + (size_t)m * 256 + 4 * F.lane) = o;
        const float mu = wave_sum(ki) * (1.f / 64.f), dk = ki - mu, var = wave_sum(dk * dk) * (1.f / 64.f);
        KIDX[(size_t)m * 64 + F.lane] = f2bf(dk * (1.f / sqrtf(var + LN_EPS)) * kg + kb);
        if (F.lane < 8) WIDX[(size_t)m * 8 + F.lane] = bf2f(r[576 + F.lane]) * 0.04419417382415922f;
    }
}
__device__ __forceinline__ unsigned f2ord(float v) { const unsigned u = __float_as_uint(v); return (u & 0x80000000u) ? ~u : (u | 0x80000000u); }
__device__ __forceinline__ void dsa_index_phase(Frame& F, const bf16_t* QIDX, const bf16_t* KIDX, const float* WIDX, unsigned long long* MASK) {
    LAS float* SC = (LAS float*)F.lds;
    const int lane = F.lane, w = F.wave, fr = lane & 15, fq = lane >> 4;
    for (int i = 0;; ++i) {
        const int u = i * F.G + F.c; if (u >= BATCH * (SEQ / 16)) break;
        const int b = 2 * (u & 7) + ((u >> 3) & 1), qlo = ((u >> 4) & 15) + 16 * (u >> 9), qt = ((u >> 8) & 1) ? 127 - qlo : qlo, t0 = 16 * qt;     const size_t rb = (size_t)b * SEQ;
        bf16x8 Af[4][2][2]; float wv[4][8];
#pragma unroll
        for (int tg = 0; tg < 4; ++tg) {
#pragma unroll
            for (int hh = 0; hh < 2; ++hh)
#pragma unroll
                for (int ks = 0; ks < 2; ++ks) Af[tg][hh][ks] = *(const bf16x8*)(QIDX + (rb + t0 + 4 * tg + (fr >> 2)) * 512 + (4 * hh + (fr & 3)) * 64 + 32 * ks + 8 * fq);
            const f32x4 w0 = *(const f32x4*)(WIDX + (rb + t0 + 4 * tg + fq) * 8), w1 = *(const f32x4*)(WIDX + (rb + t0 + 4 * tg + fq) * 8 + 4);
#pragma unroll
            for (int r = 0; r < 4; ++r) { wv[tg][r] = w0[r]; wv[tg][4 + r] = w1[r]; }
        }
        bf16x8 nB0 = *(const bf16x8*)(KIDX + (rb + 16 * w + fr) * 64 + 8 * fq), nB1 = *(const bf16x8*)(KIDX + (rb + 16 * w + fr) * 64 + 32 + 8 * fq);
        for (int kg = w; kg <= qt; kg += NWAVES) {
            const bf16x8 B0 = nB0, B1 = nB1;
            { const int kn = (kg + NWAVES <= qt) ? kg + NWAVES : kg;
              nB0 = *(const bf16x8*)(KIDX + (rb + 16 * kn + fr) * 64 + 8 * fq); nB1 = *(const bf16x8*)(KIDX + (rb + 16 * kn + fr) * 64 + 32 + 8 * fq); }
#pragma unroll
            for (int tg = 0; tg < 4; ++tg) { float s = 0.f;
#pragma unroll
                for (int hh = 0; hh < 2; ++hh) { f32x4 acc = (f32x4){0.f, 0.f, 0.f, 0.f};
                    acc = __builtin_amdgcn_mfma_f32_16x16x32_bf16(Af[tg][hh][0], B0, acc, 0, 0, 0); acc = __builtin_amdgcn_mfma_f32_16x16x32_bf16(Af[tg][hh][1], B1, acc, 0, 0, 0);
#pragma unroll
                    for (int r = 0; r < 4; ++r) s += wv[tg][4 * hh + r] * fmaxf(acc[r], 0.f); }
                SC[(4 * tg + fq) * 2048 + 16 * kg + fr] = s + 0.0f; }
        }
        __syncthreads();
        for (int tq = 2 * w; tq < 2 * w + 2; ++tq) {
            const int t = t0 + tq;
            unsigned key[32];
#pragma unroll
            for (int r = 0; r < 32; ++r) { const int s = 64 * r + lane; key[r] = (s <= t) ? f2ord(SC[tq * 2048 + s]) : 0u; }
            unsigned long long selw = 0ull;
            if (t < TOPK) {
#pragma unroll
                for (int r = 0; r < 32; ++r) { const unsigned long long mk = __ballot(64 * r + lane <= t); if (lane == r) selw = mk; }
            } else {
                unsigned prefix = 0u; bool exact = false;
                for (int bit = 31; bit >= 0; --bit) {
                    const unsigned cand = prefix | (1u << bit); int cnt = 0;
#pragma unroll
                    for (int r = 0; r < 32; ++r) cnt += __builtin_popcountll(__ballot(key[r] >= cand));
                    if (cnt >= TOPK) { prefix = cand; if (cnt == TOPK) { exact = true; break; } }
                }
                if (exact) {
#pragma unroll
                    for (int r = 0; r < 32; ++r) { const unsigned long long mk = __ballot(key[r] >= prefix); if (lane == r) selw = mk; }
                } else {
                    int ngt = 0;
#pragma unroll
                    for (int r = 0; r < 32; ++r) ngt += __builtin_popcountll(__ballot(key[r] > prefix));
                    const int need = TOPK - ngt; int run = 0;
#pragma unroll
                    for (int r = 0; r < 32; ++r) { const unsigned long long tie = __ballot(key[r] == prefix); const int rk = run + __builtin_popcountll(tie & ((1ull << lane) - 1ull));
                        const unsigned long long mk = __ballot(key[r] > prefix || (key[r] == prefix && rk < need)); if (lane == r) selw = mk; run += __builtin_popcountll(tie); }
                }
            }
            if (lane < 32) MASK[(rb + t) * 32 + lane] = selw;
        }
        __syncthreads();
    }
}
__device__ __forceinline__ void dsa_attn_phase(Frame& F, const bf16_t* QLAT, const bf16_t* CKV, const unsigned long long* MASK, bf16_t* OLAT, unsigned char* OLAT8) {
    constexpr int TB = 32768;
    LAS unsigned char* L = F.lds;
    const int lane = F.lane, w = F.wave, fr = lane & 15, fq = lane >> 4;
    const int qq = fr >> 2, pp = lane & 3;
    const bool grpB = w >= 4;
    const int kbase = fr * 512, ysh = (fq ^ (2 * (fr & 7))) << 4;
    const int x2s = (2 * (4 * (fq & 1) + qq)) << 4;
    const int vbase = (4 * fq + qq) * 512 + (pp >> 1) * 16 + (pp & 1) * 8;
    const int drow = lane >> 5, dpc = lane & 31;
    for (int i = 0;; ++i) {
        const int u = i * F.G + F.c; if (u >= BATCH * (SEQ / 16)) break;
        const int b = 2 * (u & 7) + ((u >> 3) & 1), qlo = ((u >> 4) & 15) + 16 * (u >> 9), qt = ((u >> 8) & 1) ? 127 - qlo : qlo, t0 = 16 * qt;     const size_t rb = (size_t)b * SEQ;
        const int ntiles = (t0 + 15) / 64 + 1;
        bf16x8 Qf[8];
#pragma unroll
        for (int ks = 0; ks < 8; ++ks) Qf[ks] = *(const bf16x8*)(QLAT + (rb + t0 + fr) * 2048 + w * 256 + 32 * ks + 8 * fq);
        f32x4 Ot[16];
#pragma unroll
        for (int cb = 0; cb < 16; ++cb) Ot[cb] = (f32x4){0.f, 0.f, 0.f, 0.f};
        float mrun = -1.0e30f, lsum = 0.f;
        bf16x8 Pf[2];
#define ATT_DMA(kt_, buf_) do { _Pragma("unroll") for (int q_ = 0; q_ < 4; ++q_) { const int row_ = 2 * (4 * w + q_) + drow; \
            __builtin_amdgcn_global_load_lds((const unsigned*)(CKV + (rb + 64 * (kt_) + row_) * 256 + 8 * (dpc ^ (2 * (row_ & 7)))), (LAS unsigned*)(L + (buf_) * TB + (4 * w + q_) * 1024), 16, 0, 0); } } while (0)
#define ATT_ST(buf_) do { int ka_[8]; { const int kb_t_ = kbase + (buf_) * TB; _Pragma("unroll") for (int ks = 0; ks < 8; ++ks) ka_[ks] = kb_t_ + ((64 * ks) ^ ysh); } \
            _Pragma("unroll") for (int kb = 0; kb < 4; ++kb) S[kb] = (f32x4){0.f, 0.f, 0.f, 0.f}; \
            bf16x8 kf[2][2]; \
            _Pragma("unroll") for (int j = 0; j < 2; ++j) kf[0][j] = *(LAS bf16x8*)(L + ka_[j]); \
            _Pragma("unroll") for (int bt = 0; bt < 16; ++bt) {        \
                if (bt + 1 < 16) { _Pragma("unroll") for (int j = 0; j < 2; ++j) kf[(bt + 1) & 1][j] = *(LAS bf16x8*)(L + ka_[2 * ((bt + 1) & 3) + j] + 8192 * ((bt + 1) >> 2)); } \
                _Pragma("unroll") for (int j = 0; j < 2; ++j) S[bt >> 2] = __builtin_amdgcn_mfma_f32_16x16x32_bf16(kf[bt & 1][j], Qf[2 * (bt & 3) + j], S[bt >> 2], 0, 0, 0); \
                __builtin_amdgcn_sched_barrier(0); } } while (0)
#define ATT_SOFTMAX(mw_) do { \
            float mx = fmaxf(fmaxf(fmaxf(S[0][0], S[0][1]), fmaxf(S[0][2], S[0][3])), fmaxf(fmaxf(S[1][0], S[1][1]), fmaxf(S[1][2], S[1][3]))); \
            mx = fmaxf(mx, fmaxf(fmaxf(fmaxf(S[2][0], S[2][1]), fmaxf(S[2][2], S[2][3])), fmaxf(fmaxf(S[3][0], S[3][1]), fmaxf(S[3][2], S[3][3])))); \
            mx = fmaxf(mx, __shfl_xor(mx, 16)); mx = fmaxf(mx, __shfl_xor(mx, 32)); \
            const bool need = mx > mrun + 8.0f; \
            if (__any(need)) { const float mnew = need ? mx : mrun, alpha = fast_exp2(mrun - mnew); mrun = mnew; lsum *= alpha; \
                _Pragma("unroll") for (int cb = 0; cb < 16; ++cb) Ot[cb] = Ot[cb] * alpha; } \
            const unsigned long long mq = (mw_) >> (4 * fq); const unsigned mlo = (unsigned)mq, mhi = (unsigned)(mq >> 32); \
            _Pragma("unroll") for (int kb = 0; kb < 4; ++kb) _Pragma("unroll") for (int r = 0; r < 4; ++r) { \
                const unsigned mk = (unsigned)__builtin_amdgcn_sbfe((int)(kb < 2 ? mlo : mhi), 16 * (kb & 1) + r, 1); \
                const float pv = __uint_as_float(__float_as_uint(fast_exp2(S[kb][r] - mrun)) & mk); S[kb][r] = pv; lsum += pv; } \
            _Pragma("unroll") for (int s2 = 0; s2 < 2; ++s2) { const u32x4 pk = pack8(S[2 * s2], S[2 * s2 + 1]); Pf[s2] = __builtin_bit_cast(bf16x8, pk); } } while (0)
#define ATT_VLOAD(dst, vb_, cb_) do { const int va_ = (vb_) + ((32 * (cb_)) ^ x2s); \
            dst[0] = __builtin_amdgcn_ds_read_tr16_b64_v4i16((LAS s16x4*)(L + va_)); dst[1] = __builtin_amdgcn_ds_read_tr16_b64_v4i16((LAS s16x4*)(L + va_ + 16 * 512)); \
            dst[2] = __builtin_amdgcn_ds_read_tr16_b64_v4i16((LAS s16x4*)(L + va_ + 32 * 512)); dst[3] = __builtin_amdgcn_ds_read_tr16_b64_v4i16((LAS s16x4*)(L + va_ + 48 * 512)); } while (0)
#define ATT_PV(buf_) do { const int vb_ = vbase + (buf_) * TB; s16x4 tv[2][4]; ATT_VLOAD(tv[0], vb_, 0); \
            _Pragma("unroll") for (int cb = 0; cb < 16; ++cb) { \
                if (cb + 1 < 16) ATT_VLOAD(tv[(cb + 1) & 1], vb_, cb + 1); \
                const s16x4 a0 = tv[cb & 1][0], a1 = tv[cb & 1][1], a2 = tv[cb & 1][2], a3 = tv[cb & 1][3]; \
                const bf16x8 v0 = (bf16x8){a0[0], a0[1], a0[2], a0[3], a1[0], a1[1], a1[2], a1[3]}; \
                const bf16x8 v1 = (bf16x8){a2[0], a2[1], a2[2], a2[3], a3[0], a3[1], a3[2], a3[3]}; \
                Ot[cb] = __builtin_amdgcn_mfma_f32_16x16x32_bf16(v0, Pf[0], Ot[cb], 0, 0, 0); \
                Ot[cb] = __builtin_amdgcn_mfma_f32_16x16x32_bf16(v1, Pf[1], Ot[cb], 0, 0, 0); __builtin_amdgcn_sched_barrier(0); } } while (0)
        ATT_DMA(0, 0);
        unsigned long long mwn = MASK[(rb + t0 + fr) * 32];
        asm volatile("s_waitcnt vmcnt(0)" ::: "memory");
        __syncthreads();
        int bufc = 0;
        for (int it = 0; it < ntiles; ++it) {
            const int bufn = (bufc == 2) ? 0 : bufc + 1;
            if (it + 1 < ntiles) ATT_DMA(it + 1, bufn);
            const unsigned long long mw = mwn; mwn = MASK[(rb + t0 + fr) * 32 + ((it + 1 < ntiles) ? it + 1 : it)];
            f32x4 S[4];
            ATT_ST(bufc); ATT_SOFTMAX(mw);
            if (grpB) { asm volatile("s_waitcnt vmcnt(0)" ::: "memory"); __builtin_amdgcn_s_barrier(); asm volatile("" ::: "memory"); }
            ATT_PV(bufc);
            if (!grpB) { asm volatile("s_waitcnt vmcnt(0)" ::: "memory"); __builtin_amdgcn_s_barrier(); asm volatile("" ::: "memory"); }
            bufc = bufn;
        }
        __syncthreads();
#undef ATT_DMA
#undef ATT_ST
#undef ATT_SOFTMAX
#undef ATT_VLOAD
#undef ATT_PV
        lsum += __shfl_xor(lsum, 16); lsum += __shfl_xor(lsum, 32);
        const float inv = 1.f / lsum;
#pragma unroll
        for (int cb = 0; cb < 16; ++cb) {
            if (OLAT8) { const float i8 = inv * F8_O; *(unsigned*)(OLAT8 + (rb + t0 + fr) * 2048 + w * 256 + 16 * cb + 4 * fq) = pack4_fp8(Ot[cb][0] * i8, Ot[cb][1] * i8, Ot[cb][2] * i8, Ot[cb][3] * i8); }
            else { u32x2 o; o.x = cvt_pk_bf16(Ot[cb][0] * inv, Ot[cb][1] * inv); o.y = cvt_pk_bf16(Ot[cb][2] * inv, Ot[cb][3] * inv);
                *(u32x2*)(OLAT + (rb + t0 + fr) * 2048 + w * 256 + 16 * cb + 4 * fq) = o; } }
    }
}


__device__ __forceinline__ void dsa_norm8_phase(Frame& F, const bf16_t* RAW, const float* qg, const float* kvg, const float* kig, const float* kib, bf16_t* CQ, unsigned char* CKV8, unsigned char* CKVT8, bf16_t* KIDX, float* WIDX) {
    LAS unsigned char* T = F.lds;
    const f32x4 qgv = *(const f32x4*)(qg + 4 * F.lane), kvgv = *(const f32x4*)(kvg + 4 * F.lane); const float kg = kig[F.lane], kb = kib[F.lane];
    for (int blk = F.c; blk < M / 128; blk += F.G) {
        for (int rr = 0; rr < 16; ++rr) {
            const int rl = 16 * F.wave + rr, m = 128 * blk + rl;
            const bf16_t* r = RAW + (size_t)m * DSA_IN_PAD;
            const u32x2 ar = *(const u32x2*)(r + 4 * F.lane), cr = *(const u32x2*)(r + 256 + 4 * F.lane); const float ki = bf2f(r[512 + F.lane]);
            const f32x4 a = (f32x4){__uint_as_float(ar.x << 16), __uint_as_float(ar.x & 0xffff0000u), __uint_as_float(ar.y << 16), __uint_as_float(ar.y & 0xffff0000u)};
            const f32x4 c = (f32x4){__uint_as_float(cr.x << 16), __uint_as_float(cr.x & 0xffff0000u), __uint_as_float(cr.y << 16), __uint_as_float(cr.y & 0xffff0000u)};
            const float sa = wave_sum((a[0] * a[0] + a[1] * a[1]) + (a[2] * a[2] + a[3] * a[3])), sc = wave_sum((c[0] * c[0] + c[1] * c[1]) + (c[2] * c[2] + c[3] * c[3]));
            const float ra = 1.f / sqrtf(sa * (1.f / 256.f) + RMS_EPS), rc = F8_KV / sqrtf(sc * (1.f / 256.f) + RMS_EPS);
            u32x2 o; o.x = cvt_pk_bf16(a[0] * ra * qgv[0], a[1] * ra * qgv[1]); o.y = cvt_pk_bf16(a[2] * ra * qgv[2], a[3] * ra * qgv[3]); *(u32x2*)(CQ + (size_t)m * 256 + 4 * F.lane) = o;
            const unsigned c8 = pack4_fp8(c[0] * rc * kvgv[0], c[1] * rc * kvgv[1], c[2] * rc * kvgv[2], c[3] * rc * kvgv[3]);
            *(unsigned*)(CKV8 + (size_t)m * 256 + 4 * F.lane) = c8; *(LAS unsigned*)(T + rl * 260 + 4 * F.lane) = c8;
            const float mu = wave_sum(ki) * (1.f / 64.f), dk = ki - mu, var = wave_sum(dk * dk) * (1.f / 64.f);
            KIDX[(size_t)m * 64 + F.lane] = f2bf(dk * (1.f / sqrtf(var + LN_EPS)) * kg + kb);
            if (F.lane < 8) WIDX[(size_t)m * 8 + F.lane] = bf2f(r[576 + F.lane]) * 0.04419417382415922f;
        }
        __syncthreads();
        { const int dim = F.tid >> 1, half = F.tid & 1;
          unsigned char* dst = CKVT8 + (size_t)blk * 32768 + dim * 128 + 64 * half;
#pragma unroll
          for (int q4 = 0; q4 < 4; ++q4) { u32x4 o;
#pragma unroll
              for (int dd = 0; dd < 4; ++dd) { const int d = 4 * q4 + dd, key0 = 16 * (d & 7) + 4 * (2 * half + (d >> 3));
                  LAS unsigned char* tp = T + key0 * 260 + dim;
                  o[dd] = (unsigned)tp[0] | ((unsigned)tp[260] << 8) | ((unsigned)tp[520] << 16) | ((unsigned)tp[780] << 24); }
              *(u32x4*)(dst + 16 * q4) = o; } }
        __syncthreads();
    }
}
__device__ __forceinline__ void dsa_attn8_phase(Frame& F, const unsigned char* QLAT8, const unsigned char* CKV8, const unsigned char* CKVT8, const unsigned long long* MASK, unsigned char* OLAT8) {
    constexpr int TB = 65536, VOFF = 32768;
    LAS unsigned char* L = F.lds;
    const int lane = F.lane, w = F.wave, fr = lane & 15, fq = lane >> 4;
    const int gsw = ((fr >> 1) & 1) | (((fr >> 3) & 1) << 2);
    const int ka00 = fr * 256 + (((2 * fq) ^ fr) << 4), ka01 = fr * 256 + (((2 * fq + 1) ^ fr) << 4), ka10 = fr * 256 + (((8 + 2 * fq) ^ fr) << 4), ka11 = fr * 256 + (((9 + 2 * fq) ^ fr) << 4);
    const int va0 = VOFF + fr * 128 + (((2 * fq) ^ gsw) << 4), va1 = VOFF + fr * 128 + (((2 * fq + 1) ^ gsw) << 4);
    for (int i = 0;; ++i) {
        const int u = i * F.G + F.c; if (u >= BATCH * (SEQ / 16)) break;
        const int b = 2 * (u & 7) + ((u >> 3) & 1), qlo = ((u >> 4) & 15) + 16 * (u >> 9), qt = ((u >> 8) & 1) ? 127 - qlo : qlo, t0 = 16 * qt;     const size_t rb = (size_t)b * SEQ;
        const int ntiles = (t0 + 15) / 128 + 1;
        int lu = lane; asm volatile("" : "+v"(lu)); const int fru = lu & 15, fqu = lu >> 4;
        v8i32 Q8[2];
#pragma unroll
        for (int h = 0; h < 2; ++h) { const unsigned char* qp = QLAT8 + (rb + t0 + fru) * 2048 + w * 256 + 128 * h + 32 * fqu;
            Q8[h] = __builtin_shufflevector(*(const v4i32*)qp, *(const v4i32*)(qp + 16), 0, 1, 2, 3, 4, 5, 6, 7); }
        f32x4 Ot[16];
#pragma unroll
        for (int cb = 0; cb < 16; ++cb) Ot[cb] = (f32x4){0.f, 0.f, 0.f, 0.f};
        float mrun = 0.f; bool seen = false; f32x4 negm = (f32x4){0.f, 0.f, 0.f, 0.f}, Ls = (f32x4){0.f, 0.f, 0.f, 0.f};
        const v8i32 ONES8 = (v8i32){0x38383838, 0x38383838, 0x38383838, 0x38383838, 0x38383838, 0x38383838, 0x38383838, 0x38383838};
#define ATT_DMA(kt_, buf_) do { int ln_ = lane; asm volatile("" : "+v"(ln_)); const unsigned char* kp_ = CKV8 + (rb + 128 * (kt_) + 16 * w) * 256; const unsigned char* vp_ = CKVT8 + ((rb >> 7) + (kt_)) * 32768 + w * 4096; \
        _Pragma("unroll") for (int q_ = 0; q_ < 4; ++q_) { const int ins_ = 4 * w + q_, rl_ = 4 * q_ + (ln_ >> 4), g_ = ((ln_ >> 4) & 1) | ((q_ & 1) << 2); \
            __builtin_amdgcn_global_load_lds((const unsigned*)(kp_ + (unsigned)(rl_ * 256 + 16 * ((ln_ & 15) ^ rl_))), (LAS unsigned*)(L + (buf_) * TB + ins_ * 1024), 16, 0, 0); \
            __builtin_amdgcn_global_load_lds((const unsigned*)(vp_ + (unsigned)(q_ * 1024 + (ln_ >> 3) * 128 + 16 * ((ln_ & 7) ^ g_))), (LAS unsigned*)(L + (buf_) * TB + VOFF + ins_ * 1024), 16, 0, 0); } } while (0)
#define ATT_KLOAD(dst, kb_o_) do { dst[0] = *(LAS v4i32*)(L + ka00 + (kb_o_)); dst[1] = *(LAS v4i32*)(L + ka01 + (kb_o_)); dst[2] = *(LAS v4i32*)(L + ka10 + (kb_o_)); dst[3] = *(LAS v4i32*)(L + ka11 + (kb_o_)); } while (0)
#define ATT_VLOAD(dst, vb_o_) do { dst[0] = *(LAS v4i32*)(L + va0 + (vb_o_)); dst[1] = *(LAS v4i32*)(L + va1 + (vb_o_)); } while (0)
        ATT_DMA(0, 0);
        const unsigned long long* mrow = MASK + (rb + t0 + fru) * 32;
        u32x4 mwn = *(const u32x4*)mrow;
        asm volatile("s_waitcnt vmcnt(0)" ::: "memory");
        __syncthreads();
        int bufc = 0;
        for (int it = 0; it < ntiles; ++it) {
            const int bo = bufc * TB;
            if (it + 1 < ntiles) ATT_DMA(it + 1, bufc ^ 1);
            const u32x4 mw = mwn; mwn = *(const u32x4*)(mrow + 2 * ((it + 1 < ntiles) ? it + 1 : it));
            f32x4 S[8];
            { v4i32 kf[2][4]; ATT_KLOAD(kf[0], bo);
#pragma unroll
              for (int kb = 0; kb < 8; ++kb) {
                  if (kb + 1 < 8) ATT_KLOAD(kf[(kb + 1) & 1], bo + 4096 * (kb + 1));
                  f32x4 s = __builtin_amdgcn_mfma_scale_f32_16x16x128_f8f6f4(__builtin_shufflevector(kf[kb & 1][0], kf[kb & 1][1], 0, 1, 2, 3, 4, 5, 6, 7), Q8[0], negm, 0, 0, 0, SC_S, 0, 0x7f7f7f7f);
                  s = __builtin_amdgcn_mfma_scale_f32_16x16x128_f8f6f4(__builtin_shufflevector(kf[kb & 1][2], kf[kb & 1][3], 0, 1, 2, 3, 4, 5, 6, 7), Q8[1], s, 0, 0, 0, SC_S, 0, 0x7f7f7f7f);
                  S[kb] = s; __builtin_amdgcn_sched_barrier(0); } }
            const unsigned m0 = mw[0] >> (4 * fq), m1 = mw[1] >> (4 * fq), m2 = mw[2] >> (4 * fq), m3 = mw[3] >> (4 * fq);
            { float mx = __builtin_fmaxf(__builtin_fmaxf(S[0][0], S[0][1]), __builtin_fmaxf(S[0][2], S[0][3]));
#pragma unroll
              for (int kb = 1; kb < 8; ++kb) { mx = __builtin_fmaxf(__builtin_fmaxf(S[kb][0], S[kb][1]), mx); mx = __builtin_fmaxf(__builtin_fmaxf(S[kb][2], S[kb][3]), mx); }
              if (__any(!seen || mx > 8.0f)) {
                  float mm = -3.0e38f;
#pragma unroll
                  for (int kb = 0; kb < 8; ++kb) { const unsigned mw_ = (kb >> 1) == 0 ? m0 : (kb >> 1) == 1 ? m1 : (kb >> 1) == 2 ? m2 : m3;
#pragma unroll
                      for (int r = 0; r < 4; ++r) mm = ((mw_ >> (16 * (kb & 1) + r)) & 1u) ? __builtin_fmaxf(mm, S[kb][r]) : mm; }
                  mm = fmaxf(mm, __shfl_xor(mm, 16)); mm = fmaxf(mm, __shfl_xor(mm, 32));
                  const bool has = mm > -1.0e38f, rebase = has && (!seen || mm > 8.0f);
                  const float delta = rebase ? mm : 0.f, alpha = (rebase && seen) ? fast_exp2(-delta) : 1.f;
                  seen = seen || has;
                  mrun += delta; negm = (f32x4){-mrun, -mrun, -mrun, -mrun}; Ls = Ls * alpha;
#pragma unroll
                  for (int cb = 0; cb < 16; ++cb) Ot[cb] = Ot[cb] * alpha;
#pragma unroll
                  for (int kb = 0; kb < 8; ++kb) S[kb] = S[kb] - delta; } }
            v8i32 P8;
            {
#pragma unroll
              for (int kb = 0; kb < 8; ++kb) { const unsigned mm = (kb >> 1) == 0 ? m0 : (kb >> 1) == 1 ? m1 : (kb >> 1) == 2 ? m2 : m3;
                  int pk = 0; pk = __builtin_amdgcn_cvt_pk_fp8_f32(fast_exp2(S[kb][0]), fast_exp2(S[kb][1]), pk, false); pk = __builtin_amdgcn_cvt_pk_fp8_f32(fast_exp2(S[kb][2]), fast_exp2(S[kb][3]), pk, true);
                  const unsigned y = (((mm >> (16 * (kb & 1))) & 0xFu) * 0x204081u) & 0x01010101u;
                  P8[kb] = pk & (int)((y << 8) - y); } }
            Ls = __builtin_amdgcn_mfma_scale_f32_16x16x128_f8f6f4(ONES8, P8, Ls, 0, 0, 0, 0x7f7f7f7f, 0, 0x7f7f7f7f);
            { v4i32 vf[2][2]; ATT_VLOAD(vf[0], bo);
#pragma unroll
              for (int cb = 0; cb < 16; ++cb) {
                  if (cb + 1 < 16) ATT_VLOAD(vf[(cb + 1) & 1], bo + 2048 * (cb + 1));
                  Ot[cb] = __builtin_amdgcn_mfma_scale_f32_16x16x128_f8f6f4(__builtin_shufflevector(vf[cb & 1][0], vf[cb & 1][1], 0, 1, 2, 3, 4, 5, 6, 7), P8, Ot[cb], 0, 0, 0, SC_V, 0, 0x7f7f7f7f);
                  __builtin_amdgcn_sched_barrier(0); } }
            asm volatile("s_waitcnt vmcnt(0)" ::: "memory"); __builtin_amdgcn_s_barrier(); asm volatile("" ::: "memory");
            bufc ^= 1;
        }
#undef ATT_DMA
#undef ATT_KLOAD
#undef ATT_VLOAD
        const float i8 = F8_O / Ls[0];
#pragma unroll
        for (int cb = 0; cb < 16; ++cb)
            *(unsigned*)(OLAT8 + (rb + t0 + fru) * 2048 + w * 256 + 16 * cb + 4 * fqu) = pack4_fp8(Ot[cb][0] * i8, Ot[cb][1] * i8, Ot[cb][2] * i8, Ot[cb][3] * i8);
    }
}

constexpr int PH_PER_PAIR = 18, N_PHASES = 1 + 2 * PH_PER_PAIR;

__global__ void __launch_bounds__(NTHREADS, 2) fwd_kernel(Params p) {
    extern __shared__ __attribute__((aligned(16))) unsigned char lds_raw[];
    Frame F;
    F.lds = (LAS unsigned char*)lds_raw;
    F.tid = threadIdx.x; F.lane = F.tid & 63; F.wave = __builtin_amdgcn_readfirstlane(F.tid >> 6);
    F.G = gridDim.x; F.c = blockIdx.x;
    unsigned char* ws = p.ws;
    F.ctl = (unsigned*)(ws + WS_CTL);
    for (int u = F.tid; u < (LDS_BYTES - LDSCTL_OFF) / 4; u += NTHREADS) ((LAS unsigned*)(F.lds + LDSCTL_OFF))[u] = 0u;
    __syncthreads();
    const bool one_launch = (p.ph_hi - p.ph_lo) > 1;
    XcdBarrier bar; bar.bar = F.ctl + CW_BAR; bar.x = 0; bar.st = nullptr;
    if (one_launch) bar = xcd_barrier_post(F.ctl + CW_BAR, (volatile LAS unsigned*)(F.lds + MISC_OFF) + 8);
    const int lo = p.ph_lo, hi = p.ph_hi;
#define REFRESH() do { int t_ = threadIdx.x; asm volatile("" : "+v"(t_)); F.tid = t_; F.lane = t_ & 63; F.wave = __builtin_amdgcn_readfirstlane(t_ >> 6); } while (0)
#ifndef DBLMASK
#define DBLMASK 0u
#endif
#define REP(b) for (int rep_ = 0; rep_ < 1 + (int)((DBLMASK >> (b)) & 1u); ++rep_)
#define IN(k) (lo <= (k) && (k) < hi)
#ifndef MK_BARTIME
#define MK_BARTIME 0
#endif
    unsigned long long bt_acc = 0ull;
#if MK_BARTIME
#define SEAM(k) do { if (IN(k) && IN((k) + 1)) { const unsigned long long t0_ = __builtin_amdgcn_s_memrealtime(); xcd_barrier(bar); bt_acc += __builtin_amdgcn_s_memrealtime() - t0_; } } while (0)
#else
#ifndef MK_DBLSEAM
#define MK_DBLSEAM 0
#endif
#define SEAM(k) do { if (IN(k) && IN((k) + 1)) { xcd_barrier(bar); if (MK_DBLSEAM) xcd_barrier(bar); } } while (0)
#endif

    bf16_t* XB = (bf16_t*)(ws + WS_XB); bf16_t* Y = (bf16_t*)(ws + WS_Y);
    unsigned char* A = ws + WS_A; bf16_t* Hb = (bf16_t*)(ws + WS_H);

    if (IN(0)) REP(31) { REFRESH(); p0_prologue(F, p); } SEAM(0);

    for (int j = 0; j < 2; ++j) {
        const int pb = 1 + j * PH_PER_PAIR;
        const int layerA = 2 * j, layerB = 2 * j + 1;
        if (IN(pb + 0)) REP(0) {
            Gemm g{XB, (const bf16_t*)(ws + WS_W_HGIN) + (size_t)j * 4 * D * D, D}; StaticOrder S; S.init(M, 4 * D, F.G, F.c);
            EpiHgIn E{(bf16_t*)(A + A_HQ)};
            gemm_phase(F.lds, g, S, E);
        } SEAM(pb + 0);
        if (IN(pb + 1)) REP(1) { REFRESH(); hgrn_phase(F, (const bf16_t*)(A + A_HQ), (const bf16_t*)(A + A_HF), (const bf16_t*)(A + A_HV), INP(IN_HGLB), j, (bf16_t*)(A + A_HO)); } SEAM(pb + 1);
        if (IN(pb + 2)) REP(2) { REFRESH(); hgrn_gate_phase(F, (const bf16_t*)(A + A_HO), (const bf16_t*)(A + A_HG), INP(IN_HGNG) + (size_t)j * D, (bf16_t*)(A + A_HOG)); } SEAM(pb + 2);
        if (IN(pb + 3)) REP(3) {
            Gemm g{(const bf16_t*)(A + A_HOG), (const bf16_t*)(ws + WS_W_HGOUT) + (size_t)j * D * D, D}; StaticOrder S; S.init(M, D, F.G, F.c);
            EpiRes E{XB, Y}; gemm_phase(F.lds, g, S, E);
        } SEAM(pb + 3);
        if (IN(pb + 4)) REP(4) { REFRESH(); ln_phase(F, Y, INP(IN_LNG) + (size_t)(layerA * 2 + 0) * D, INP(IN_LNB) + (size_t)(layerA * 2 + 0) * D, XB, (MK_FFN_FP8 == 2) ? ws + WS_XB8 : nullptr); } SEAM(pb + 4);
        if (IN(pb + 5)) REP(5) {
#if MK_FFN_FP8 == 2
            Gemm g{(const bf16_t*)(ws + WS_XB8), (const bf16_t*)(ws + WS_W_FGU + (size_t)j * 2 * DFF * D), D / 2, SC_UP}; StaticOrder S; S.init(M, 2 * DFF, F.G, F.c);
            EpiSwiglu8 E{(unsigned char*)Hb}; gemm_phase_gather<true, true>(F.lds, g, S, E, nullptr);
#elif MK_FFN_FP8 == 1
            Gemm g{XB, (const bf16_t*)(ws + WS_W_FGU) + (size_t)j * 2 * DFF * D, D}; StaticOrder S; S.init(M, 2 * DFF, F.G, F.c);
            EpiSwiglu8 E{(unsigned char*)Hb}; gemm_phase(F.lds, g, S, E);
#else
            Gemm g{XB, (const bf16_t*)(ws + WS_W_FGU) + (size_t)j * 2 * DFF * D, D}; StaticOrder S; S.init(M, 2 * DFF, F.G, F.c);
            EpiSwiglu E{Hb}; gemm_phase(F.lds, g, S, E);
#endif
        } SEAM(pb + 5);
        if (IN(pb + 6)) REP(6) {
#if MK_FFN_FP8 >= 1
            Gemm g{Hb, (const bf16_t*)(ws + WS_W_FDN + (size_t)j * D * DFF), DFF / 2, SC_DN}; StaticOrder S; S.init(M, D, F.G, F.c);
            EpiRes E{XB, Y}; gemm_phase_gather<true, true>(F.lds, g, S, E, nullptr);
#else
            Gemm g{Hb, (const bf16_t*)(ws + WS_W_FDN) + (size_t)j * D * DFF, DFF}; StaticOrder S; S.init(M, D, F.G, F.c);
            EpiRes E{XB, Y}; gemm_phase(F.lds, g, S, E);
#endif
        } SEAM(pb + 6);
        if (IN(pb + 7)) REP(7) { REFRESH(); ln_phase(F, Y, INP(IN_LNG) + (size_t)(layerA * 2 + 1) * D, INP(IN_LNB) + (size_t)(layerA * 2 + 1) * D, XB, nullptr); } SEAM(pb + 7);
        if (IN(pb + 8)) REP(8) {
            Gemm g{XB, (const bf16_t*)(ws + WS_W_DIN) + (size_t)j * DSA_IN_PAD * D, D}; StaticOrder S; S.init(M, DSA_IN_PAD, F.G, F.c);
            EpiBf16 E{(bf16_t*)(A + A_RAW), DSA_IN_PAD}; gemm_phase(F.lds, g, S, E);
        } SEAM(pb + 8);
#if MK_ATT_FP8
        if (IN(pb + 9)) REP(9) { REFRESH(); dsa_norm8_phase(F, (const bf16_t*)(A + A_RAW), INP(IN_DQNG) + (size_t)j * QR, INP(IN_DKVNG) + (size_t)j * KVR, INP(IN_DKIG) + (size_t)j * IDXD, INP(IN_DKIB) + (size_t)j * IDXD,
                                          (bf16_t*)(A + A_CQ), A + A_CKV, A + A_CKV + 8 * MiB, (bf16_t*)(A + A_KIDX), (float*)(A + A_WIDX)); } SEAM(pb + 9);
#else
        if (IN(pb + 9)) REP(9) { REFRESH(); dsa_norm_phase(F, (const bf16_t*)(A + A_RAW), INP(IN_DQNG) + (size_t)j * QR, INP(IN_DKVNG) + (size_t)j * KVR, INP(IN_DKIG) + (size_t)j * IDXD, INP(IN_DKIB) + (size_t)j * IDXD,
                                         (bf16_t*)(A + A_CQ), (bf16_t*)(A + A_CKV), (bf16_t*)(A + A_KIDX), (float*)(A + A_WIDX)); } SEAM(pb + 9);
#endif
        if (IN(pb + 10)) REP(10) {
            Gemm g{(const bf16_t*)(A + A_CQ), (const bf16_t*)(ws + WS_W_DQ) + (size_t)j * 2560 * QR, QR}; StaticOrder S; S.init(M, 2560, F.G, F.c);
#if MK_ATT_FP8
            EpiQ8 E{A + A_QLAT, (bf16_t*)(A + A_QIDX)}; gemm_phase(F.lds, g, S, E);
#else
            EpiQ E{(bf16_t*)(A + A_QLAT), (bf16_t*)(A + A_QIDX)}; gemm_phase(F.lds, g, S, E);
#endif
        } SEAM(pb + 10);
        if (IN(pb + 11)) REP(11) { REFRESH(); dsa_index_phase(F, (const bf16_t*)(A + A_QIDX), (const bf16_t*)(A + A_KIDX), (const float*)(A + A_WIDX), (unsigned long long*)(A + A_MASK)); } SEAM(pb + 11);
#if MK_ATT_FP8
        if (IN(pb + 12)) REP(12) { REFRESH(); dsa_attn8_phase(F, A + A_QLAT, A + A_CKV, A + A_CKV + 8 * MiB, (const unsigned long long*)(A + A_MASK), A + A_OLAT); } SEAM(pb + 12);
#else
        if (IN(pb + 12)) REP(12) { REFRESH(); dsa_attn_phase(F, (const bf16_t*)(A + A_QLAT), (const bf16_t*)(A + A_CKV), (const unsigned long long*)(A + A_MASK), (bf16_t*)(A + A_OLAT), MK_B6_FP8 ? A + A_OLAT : nullptr); } SEAM(pb + 12);
#endif
        if (IN(pb + 13)) REP(13) {
#if MK_B6_FP8
            Gemm g{(const bf16_t*)(A + A_OLAT), (const bf16_t*)(ws + WS_W_DO + (size_t)j * D * 2048), 1024, SC_DO}; StaticOrder S; S.init(M, D, F.G, F.c);
            EpiRes E{XB, Y}; gemm_phase_gather<true, true>(F.lds, g, S, E, nullptr);
#else
            Gemm g{(const bf16_t*)(A + A_OLAT), (const bf16_t*)(ws + WS_W_DO) + (size_t)j * D * 2048, 2048}; StaticOrder S; S.init(M, D, F.G, F.c);
            EpiRes E{XB, Y}; gemm_phase(F.lds, g, S, E);
#endif
        } SEAM(pb + 13);
        if (IN(pb + 14)) REP(14) { REFRESH(); ln_router_phase(F, Y, INP(IN_LNG) + (size_t)(layerB * 2 + 0) * D, INP(IN_LNB) + (size_t)(layerB * 2 + 0) * D, INP(IN_MR) + (size_t)j * D * NEXP, XB, MK_MOE_FP8 ? ws + WS_XB8 : nullptr,
                                           (int*)(A + A_EIDX), (int*)(A + A_POS), (int*)(A + A_TOK), (float*)(A + A_GW), F.ctl + CW_MOE + 64 * j); } SEAM(pb + 14);
        if (IN(pb + 15)) REP(15) {
#if MK_MOE_FP8
            Gemm g{(const bf16_t*)(ws + WS_XB8), (const bf16_t*)(ws + WS_W_MGU8 + (size_t)j * NEXP * 2 * DFF * D), D / 2, SC_UP}; MoeOrder S; S.init(F.ctl + CW_MOE + 64 * j, 2 * DFF / BM, F.G, F.c);
            EpiSwiglu8 E{(unsigned char*)Hb}; gemm_phase_gather<true>(F.lds, g, S, E, (const int*)(A + A_TOK));
#else
            Gemm g{XB, (const bf16_t*)(ws + WS_W_MGU) + (size_t)j * NEXP * 2 * DFF * D, D}; MoeOrder S; S.init(F.ctl + CW_MOE + 64 * j, 2 * DFF / BM, F.G, F.c);
            EpiSwiglu E{Hb}; gemm_phase_gather(F.lds, g, S, E, (const int*)(A + A_TOK));
#endif
        } SEAM(pb + 15);
        if (IN(pb + 16)) REP(16) {
#if MK_MOE_FP8
            Gemm g{Hb, (const bf16_t*)(ws + WS_W_MDN8 + (size_t)j * NEXP * D * DFF), DFF / 2, SC_DN}; MoeOrder S; S.init(F.ctl + CW_MOE + 64 * j, D / BM, F.G, F.c);
            EpiMoeDn E{(bf16_t*)(A + A_OUTM), (const float*)(A + A_GW)}; gemm_phase_gather<true, true>(F.lds, g, S, E, nullptr);
#else
            Gemm g{Hb, (const bf16_t*)(ws + WS_W_MDN) + (size_t)j * NEXP * D * DFF, DFF}; MoeOrder S; S.init(F.ctl + CW_MOE + 64 * j, D / BM, F.G, F.c);
            EpiMoeDn E{(bf16_t*)(A + A_OUTM), (const float*)(A + A_GW)}; gemm_phase(F.lds, g, S, E);
#endif
        } SEAM(pb + 16);
        if (IN(pb + 17)) REP(17) { REFRESH(); ln_moe_phase(F, XB, (const bf16_t*)(A + A_OUTM), (const int*)(A + A_EIDX), (const int*)(A + A_POS), F.ctl + CW_MOE + 64 * j,
                                        INP(IN_LNG) + (size_t)(layerB * 2 + 1) * D, INP(IN_LNB) + (size_t)(layerB * 2 + 1) * D, XB, (j == 1) ? p.out : nullptr); } SEAM(pb + 17);
    }
#if MK_BARTIME
    if (one_launch) {
        if (blockIdx.x == 0 && threadIdx.x == 0) __hip_atomic_store(F.ctl + 3000, (unsigned)bt_acc, __ATOMIC_RELAXED, __HIP_MEMORY_SCOPE_AGENT);
        xcd_barrier(bar);
        const float cval = 2.0f + 4.0f * (float)__hip_atomic_load(F.ctl + 3000, __ATOMIC_RELAXED, __HIP_MEMORY_SCOPE_AGENT) * 1e-5f;
        for (size_t i = (size_t)blockIdx.x * NTHREADS + threadIdx.x; i < (size_t)M * D; i += (size_t)gridDim.x * NTHREADS) p.out[i] = cval;
    }
#endif
}


#if MK_DEBUG_SCAN
__global__ void scan_kernel(const void* ptr, size_t n, int is_bf16, unsigned code, unsigned* flag, const unsigned* gcnt, size_t row_elems) {
    size_t nn = n;
    if (gcnt) { unsigned t = 0; for (int e = 0; e < 8; ++e) t += (gcnt[e] + 255u) >> 8; nn = (size_t)t * 256 * row_elems; }
    bool bad = false;
    for (size_t i = (size_t)blockIdx.x * blockDim.x + threadIdx.x; i < nn; i += (size_t)gridDim.x * blockDim.x) {
        if (is_bf16) { const unsigned short v = ((const unsigned short*)ptr)[i]; bad |= (v & 0x7f80u) == 0x7f80u; }
        else { const unsigned v = ((const unsigned*)ptr)[i]; bad |= (v & 0x7f800000u) == 0x7f800000u; }
    }
    if (bad) atomicMin(flag, code);
}
__global__ void fin_kernel(float* out, size_t n, const unsigned* flag) {
    const unsigned f = *flag; if (f == 0xffffffffu) return;
    const float cval = (float)f + 0.25f * (float)flag[64];
    for (size_t i = (size_t)blockIdx.x * blockDim.x + threadIdx.x; i < n; i += (size_t)gridDim.x * blockDim.x) out[i] = cval;
}

__global__ void chk_a1_kernel(const float* x, const float* w, const bf16_t* Q, const float* FP, unsigned code, unsigned* flag) {
    const unsigned id = blockIdx.x * blockDim.x + threadIdx.x;
    unsigned hsh = id * 2654435761u + 12345u; hsh ^= hsh >> 13; hsh *= 0x5bd1e995u; hsh ^= hsh >> 15;
    const int row = hsh % M, col = (hsh >> 15) % (4 * D);
    float ref = 0.f; for (int k = 0; k < D; ++k) ref += x[(size_t)row * D + k] * w[(size_t)k * 4 * D + col];
    const int part = col >> 10, cc = col & 1023;
    float got;
    if (part == 1) got = FP[(size_t)row * D + cc];
    else got = bf2f(Q[(size_t)(part == 0 ? 0 : part - 1) * M * D + (size_t)row * D + cc]);
    if (!(fabsf(got - ref) < 0.08f)) atomicMin(flag, code);
}
__global__ void chk_hgrn_kernel(const bf16_t* Q, const float* FP, const bf16_t* V, const bf16_t* O, unsigned* bits) {
    const int sample = blockIdx.x, lane = threadIdx.x;
    const int b = sample % BATCH, h = (sample / BATCH) % HG_H, e = (sample * 37 + 11) % 128;
    float s0 = 0.f, s1 = 0.f; unsigned r = 0;
    for (int t = 0; t < 128; ++t) {
        const size_t base = ((size_t)b * SEQ + t) * D + h * 128;
        const float f0 = sigmoidf_(FP[base + lane]), f1 = sigmoidf_(FP[base + lane + 64]);
        const float v = bf2f(V[base + e]);
        s0 = f0 * s0 + (1.f - f0) * v; s1 = f1 * s1 + (1.f - f1) * v;
        const float o = wave_sum(bf2f(Q[base + lane]) * s0 + bf2f(Q[base + lane + 64]) * s1);
        const unsigned short gb = O[base + e]; const float got = bf2f(gb);
        const bool nf = (gb & 0x7f80u) == 0x7f80u;
        if (t < 64) { if (nf) r |= 4u; else if (!(fabsf(got - o) < 0.05f + 0.03f * fabsf(o))) r |= 2u; }
        else if (nf) r |= 1u;
    }
    if (r && lane == 0) atomicOr(bits, r);
}
__global__ void flaginit_kernel(unsigned* flag) { *flag = 0xffffffffu; }
#endif

extern "C" void kernel_launch(void* const* d_in, const int* in_sizes, int n_in, void* d_out, int out_size, void* d_ws, size_t ws_size, hipStream_t stream) {
    static int grid = 0;
    if (grid == 0) {
        if (n_in != 22 || out_size != M * D || ws_size < WS_END) { fprintf(stderr, "kernel_launch: unexpected problem (n_in %d out %d ws %zu need %zu)\n", n_in, out_size, ws_size, (size_t)WS_END); grid = -1; return; }
        int dev = 0, cus = 0, per_cu = 0;
        if (hipGetDevice(&dev) != hipSuccess || hipDeviceGetAttribute(&cus, hipDeviceAttributeMultiprocessorCount, dev) != hipSuccess) { grid = -1; return; }
        if (hipFuncSetAttribute((const void*)fwd_kernel, hipFuncAttributeMaxDynamicSharedMemorySize, LDS_BYTES) != hipSuccess) { fprintf(stderr, "kernel_launch: hipFuncSetAttribute failed\n"); grid = -1; return; }
        if (hipOccupancyMaxActiveBlocksPerMultiprocessor(&per_cu, (const void*)fwd_kernel, NTHREADS, LDS_BYTES) != hipSuccess || per_cu < 1) fprintf(stderr, "kernel_launch: occupancy query reports %d\n", per_cu);
        grid = cus;
    }
    if (grid <= 0) return;
    (void)hipMemsetAsync((char*)d_ws + WS_CTL, 0, CTL_ZERO_BYTES, stream);
    Params p{};
    for (int i = 0; i < 22; ++i) p.in[i] = (const float*)d_in[i];
    p.out = (float*)d_out; p.ws = (unsigned char*)d_ws;
#if MK_N_LAUNCHES == 1
    p.ph_lo = 0; p.ph_hi = N_PHASES;
    hipLaunchKernelGGL(fwd_kernel, dim3(grid), dim3(NTHREADS), LDS_BYTES, stream, p);
#ifdef MK_EXTRA_PHASES
    { const int extra[] = {MK_EXTRA_PHASES}; for (int r = 0; r < MK_EXTRA_REPS; ++r) for (int k : extra) { p.ph_lo = k; p.ph_hi = k + 1; hipLaunchKernelGGL(fwd_kernel, dim3(grid), dim3(NTHREADS), LDS_BYTES, stream, p); } }
#endif
#else
#if MK_DEBUG_SCAN
    unsigned char* ws = (unsigned char*)d_ws; unsigned* flag = (unsigned*)(ws + WS_CTL) + 2048;
    hipLaunchKernelGGL(flaginit_kernel, dim3(1), dim3(1), 0, stream, flag);
#define SCAN(ptr, n, isbf, k) hipLaunchKernelGGL(scan_kernel, dim3(1024), dim3(256), 0, stream, (const void*)(ptr), (size_t)(n), isbf, (unsigned)((k) + 1), flag, (const unsigned*)nullptr, (size_t)0)
#define SCANM(ptr, re, isbf, k, jj) hipLaunchKernelGGL(scan_kernel, dim3(1024), dim3(256), 0, stream, (const void*)(ptr), (size_t)0, isbf, (unsigned)((k) + 1), flag, (const unsigned*)(ws + WS_CTL) + CW_MOE + 64 * (jj), (size_t)(re))
#endif
    for (int k = 0; k < N_PHASES; ++k) { p.ph_lo = k; p.ph_hi = k + 1; hipLaunchKernelGGL(fwd_kernel, dim3(grid), dim3(NTHREADS), LDS_BYTES, stream, p);
#if MK_DEBUG_SCAN
        unsigned char* A = ws + WS_A; const size_t MD = (size_t)M * D;
        if (k == 0) { SCAN(ws + WS_W_HGIN, 2 * 4 * MD / M * D, 1, k); SCAN(ws + WS_W_HGOUT, 2 * (size_t)D * D, 1, k); SCAN(ws + WS_W_FGU, 2 * (size_t)2 * DFF * D, 1, k); SCAN(ws + WS_W_FDN, 2 * (size_t)DFF * D, 1, k);
            SCAN(ws + WS_W_DIN, 2 * (size_t)DSA_IN_PAD * D, 1, k); SCAN(ws + WS_W_DQ, 2 * (size_t)2560 * QR, 1, k); SCAN(ws + WS_W_DO, 2 * (size_t)D * 2048, 1, k);
            SCAN(ws + WS_W_MGU, 16 * (size_t)2 * DFF * D, 1, k); SCAN(ws + WS_W_MDN, 16 * (size_t)DFF * D, 1, k); SCAN(ws + WS_XB, MD, 1, k); }
        else { const int l = (k - 1) % PH_PER_PAIR, jj = (k - 1) / PH_PER_PAIR;
            switch (l) {
            case 0: SCAN(A + A_HQ, 3 * MD, 1, k); SCAN(A + A_HF, MD, 0, k);
                if (jj == 0) hipLaunchKernelGGL(chk_a1_kernel, dim3(64), dim3(256), 0, stream, (const float*)d_in[IN_X], (const float*)d_in[IN_HGWIN], (const bf16_t*)(A + A_HQ), (const float*)(A + A_HF), (unsigned)(k + 1), flag);
                break;
            case 1: SCAN(A + A_HO, MD, 1, k);
                if (jj == 0) hipLaunchKernelGGL(chk_hgrn_kernel, dim3(256), dim3(64), 0, stream, (const bf16_t*)(A + A_HQ), (const float*)(A + A_HF), (const bf16_t*)(A + A_HV), (const bf16_t*)(A + A_HO), flag + 64);
                break;
            case 2: SCAN(A + A_HOG, MD, 1, k); break;
            case 3: case 6: case 13: SCAN(ws + WS_Y, MD, 1, k); break;
            case 4: case 7: case 14: SCAN(ws + WS_XB, MD, 1, k); break;
            case 5: SCAN(ws + WS_H, (size_t)M * DFF, 1, k); break;
            case 8: SCAN(A + A_RAW, (size_t)M * DSA_IN_PAD, 0, k); break;
            case 9: SCAN(A + A_CQ, (size_t)M * 256, 1, k); SCAN(A + A_CKV, (size_t)M * 256, 1, k); SCAN(A + A_KIDX, (size_t)M * 64, 1, k); SCAN(A + A_WIDX, (size_t)M * 8, 0, k); break;
            case 10: SCAN(A + A_QLAT, (size_t)M * 2048, 1, k); SCAN(A + A_QIDX, (size_t)M * 512, 1, k); break;
            case 12: SCAN(A + A_OLAT, (size_t)M * 2048, 1, k); break;
            case 16: SCANM(ws + WS_H, DFF, 1, k, jj); break;
            case 17: SCANM(A + A_OUTM, D, 0, k, jj); break;
            case 18: if (jj == 0) SCAN(ws + WS_XB, MD, 1, k); else SCAN(d_out, MD, 0, k); break;
            default: break; } }
#endif
    }
#if MK_DEBUG_SCAN
    hipLaunchKernelGGL(fin_kernel, dim3(1024), dim3(256), 0, stream, (float*)d_out, (size_t)M * D, (const unsigned*)flag);
#endif
#endif
}
```

```cpp
#include <hip/hip_runtime.h>
#include <cstdio>
#include <cstdint>

#ifndef MK_DEBUG_SCAN
#define MK_DEBUG_SCAN 0
#endif
#ifndef MK_MOE_FP8
#define MK_MOE_FP8 1
#endif
#ifndef MK_FFN_FP8
#define MK_FFN_FP8 2
#endif
#ifndef MK_ATT_FP8
#define MK_ATT_FP8 1
#endif
#ifndef MK_B6_FP8
#define MK_B6_FP8 1
#endif
#ifndef MK_N_LAUNCHES
#define MK_N_LAUNCHES 1
#endif

#define GAS __attribute__((address_space(1)))
#define LAS __attribute__((address_space(3)))
typedef unsigned short bf16_t;
typedef short bf16x8 __attribute__((ext_vector_type(8)));
typedef short s16x4 __attribute__((ext_vector_type(4)));
typedef float f32x4 __attribute__((ext_vector_type(4)));
typedef float f32x2 __attribute__((ext_vector_type(2)));
typedef unsigned u32x4 __attribute__((ext_vector_type(4)));
typedef unsigned u32x2 __attribute__((ext_vector_type(2)));
typedef int v8i32 __attribute__((ext_vector_type(8)));
typedef int v4i32 __attribute__((ext_vector_type(4)));

constexpr int D = 1024, BATCH = 16, SEQ = 2048, M = BATCH * SEQ;
constexpr int DFF = 3584, NEXP = 8;
constexpr int HG_H = 8, HG_DK = 128, HG_C = 64;
constexpr int QR = 256, KVR = 256, IDXD = 64, IDXH = 8, DSA_H = 8, DSA_HD = 128, TOPK = 256;
constexpr int DSA_IN = 584, DSA_IN_PAD = 768;
constexpr int MOE_ROWS = 2 * M + NEXP * 256;
constexpr float ALPHA = 1.6817928305074290f;
constexpr float LN_EPS = 1e-5f, RMS_EPS = 1e-6f;
constexpr int NWAVES = 8, NTHREADS = 512;

constexpr size_t MiB = 1u << 20;
constexpr size_t WS_CTL = 0, CTL_ZERO_BYTES = 1 * MiB;
constexpr size_t WS_W_HGIN = 1 * MiB;
constexpr size_t WS_W_HGOUT = 17 * MiB;
constexpr size_t WS_W_FGU = 21 * MiB;
constexpr size_t WS_W_FDN = 49 * MiB;
constexpr size_t WS_W_DIN = 63 * MiB;
constexpr size_t WS_W_DQ = 66 * MiB;
constexpr size_t WS_W_DO = 69 * MiB;
constexpr size_t WS_W_MGU = 77 * MiB;
constexpr size_t WS_W_MDN = 301 * MiB;
constexpr size_t WS_XB8 = 416 * MiB;
constexpr size_t WS_W_MGU8 = 77 * MiB;
constexpr size_t WS_W_MDN8 = 192 * MiB;
constexpr size_t WS_XB = 544 * MiB;
constexpr size_t WS_Y = 608 * MiB;
constexpr size_t WS_A = 736 * MiB;
constexpr size_t WS_H = 1184 * MiB;
constexpr size_t WS_END = 1648 * MiB;
constexpr size_t A_HQ = 0, A_HF = 64 * MiB, A_HV = 128 * MiB, A_HG = 192 * MiB, A_HO = 320 * MiB, A_HOG = 384 * MiB;
constexpr size_t A_RAW = 0, A_CQ = 96 * MiB, A_CKV = 112 * MiB, A_KIDX = 128 * MiB, A_WIDX = 132 * MiB, A_MASK = 136 * MiB, A_QLAT = 144 * MiB, A_QIDX = 272 * MiB, A_OLAT = 304 * MiB;
constexpr size_t A_OUTM = 136 * MiB, A_EIDX = 404 * MiB, A_POS = 405 * MiB, A_TOK = 406 * MiB, A_GW = 407 * MiB;
constexpr int CW_BAR = 4096, CW_MOE = 16384;

constexpr int RING_BYTES = 131072;
constexpr int LDSCTL_OFF = RING_BYTES, MISC_OFF = LDSCTL_OFF + 320;
constexpr int STAGE_TOKL = RING_BYTES + 2048;
constexpr int LDS_BYTES = 147456;

typedef __bf16 hwbf16x2 __attribute__((ext_vector_type(2)));
__device__ __forceinline__ unsigned cvt_pk_bf16(float lo, float hi) { const f32x2 v = {lo, hi}; const hwbf16x2 b = __builtin_convertvector(v, hwbf16x2); return __builtin_bit_cast(unsigned, b); }
__device__ __forceinline__ bf16_t f2bf(float f) { return (bf16_t)(cvt_pk_bf16(f, 0.f) & 0xffffu); }
__device__ __forceinline__ float bf2f(bf16_t b) { return __uint_as_float(((unsigned)b) << 16); }
__device__ __forceinline__ float wave_sum(float v) {
    v += __builtin_bit_cast(float, __builtin_amdgcn_update_dpp(0, __builtin_bit_cast(int, v), 0xB1, 0xF, 0xF, true));
    v += __builtin_bit_cast(float, __builtin_amdgcn_update_dpp(0, __builtin_bit_cast(int, v), 0x4E, 0xF, 0xF, true));
    v += __builtin_bit_cast(float, __builtin_amdgcn_update_dpp(0, __builtin_bit_cast(int, v), 0x141, 0xF, 0xF, true));
    v += __builtin_bit_cast(float, __builtin_amdgcn_update_dpp(0, __builtin_bit_cast(int, v), 0x140, 0xF, 0xF, true));
    const float r0 = __builtin_bit_cast(float, __builtin_amdgcn_readlane(__builtin_bit_cast(int, v), 0)), r1 = __builtin_bit_cast(float, __builtin_amdgcn_readlane(__builtin_bit_cast(int, v), 16));
    const float r2 = __builtin_bit_cast(float, __builtin_amdgcn_readlane(__builtin_bit_cast(int, v), 32)), r3 = __builtin_bit_cast(float, __builtin_amdgcn_readlane(__builtin_bit_cast(int, v), 48));
    return (r0 + r1) + (r2 + r3);
}
__device__ __forceinline__ float fast_exp2(float x) { return __builtin_amdgcn_exp2f(x); }
__device__ __forceinline__ float fast_rcp(float x) { return __builtin_amdgcn_rcpf(x); }
__device__ __forceinline__ float sigmoidf_(float x) { return fast_rcp(1.0f + __expf(-x)); }
__device__ __forceinline__ float siluf_(float x) { return x * sigmoidf_(x); }
#define LDS_WAIT() asm volatile("s_waitcnt lgkmcnt(0)" ::: "memory")
#define VM_WAIT() asm volatile("s_waitcnt vmcnt(0)" ::: "memory")

#define XB_TMO      128
#define XB_XCNT(j)  (256  + 64 * (j))
#define XB_XSUB(j)  (1280 + 64 * (j))
#define XB_XGEN(j)  (2304 + 64 * (j))
#define XB_TOP      3328
#define XB_TOPGEN   3392
#define XCD_BAR_WORDS 3456
#define XB_SPIN_CAP (1u << 20)

__device__ __forceinline__ unsigned xb_ld(unsigned* p)              { return __hip_atomic_load(p, __ATOMIC_RELAXED, __HIP_MEMORY_SCOPE_AGENT); }
__device__ __forceinline__ unsigned xb_add(unsigned* p, unsigned v) { return __hip_atomic_fetch_add(p, v, __ATOMIC_RELAXED, __HIP_MEMORY_SCOPE_AGENT); }
__device__ __forceinline__ unsigned xb_xcc_id() { return (unsigned)__builtin_amdgcn_s_getreg((3 << 11) | 20) & 0xFu; }
#define XB_SPIN(cond, bar) do { unsigned _sp = 0; while (cond) { __builtin_amdgcn_s_sleep(1); \
    if ((++_sp & 255u) == 0u) { if (xb_ld(&(bar)[XB_TMO])) break; if (_sp > XB_SPIN_CAP) { atomicAdd(&(bar)[XB_TMO], 1u); break; } } } } while (0)

struct XcdBarrier { unsigned* bar; unsigned x; volatile LAS unsigned* st; };

__device__ __forceinline__ XcdBarrier xcd_barrier_post(unsigned* bar, volatile LAS unsigned* st) {
    XcdBarrier b; b.bar = bar; b.x = xb_xcc_id(); b.st = st;
    if (threadIdx.x == 0) (void)xb_add(&bar[XB_XCNT(b.x)], 1u);
    return b;
}
__device__ __forceinline__ void xcd_barrier_complete(unsigned* bar, unsigned x, unsigned& nloc, unsigned& nx) {
    const unsigned G = gridDim.x * gridDim.y * gridDim.z;
    unsigned sum, cnt, mine, sp = 0u;
    for (;;) {
        sum = 0u; cnt = 0u; mine = 0u;
#pragma unroll
        for (unsigned j = 0; j < 16; ++j) { const unsigned c = xb_ld(&bar[XB_XCNT(j)]); sum += c; cnt += (c > 0u) ? 1u : 0u; mine = (j == x) ? c : mine; }
        if (sum == G) break;
        __builtin_amdgcn_s_sleep(1);
        if ((++sp & 255u) == 0u) { if (xb_ld(&bar[XB_TMO])) break; if (sp > XB_SPIN_CAP) { atomicAdd(&bar[XB_TMO], 1u); break; } }
    }
    nloc = mine > 0u ? mine : 1u; nx = cnt > 0u ? cnt : 1u;
}
__device__ __forceinline__ void xcd_barrier(const XcdBarrier& b) {
    asm volatile("s_waitcnt vmcnt(0)" ::: "memory");
    __syncthreads();
    if (threadIdx.x == 0) {
        unsigned* bar = b.bar;
        __builtin_amdgcn_s_waitcnt(0);
        unsigned nloc = b.st[0], nx = b.st[1];
        if (nloc == 0u) { xcd_barrier_complete(bar, b.x, nloc, nx); b.st[0] = nloc; b.st[1] = nx; }
        const unsigned old = xb_add(&bar[XB_XSUB(b.x)], 1u);
        const unsigned gen = old / nloc;
        if (old + 1u == (gen + 1u) * nloc) {
            __builtin_amdgcn_fence(__ATOMIC_RELEASE, "agent");
            asm volatile("s_waitcnt vmcnt(0)" ::: "memory");
            const unsigned og = xb_add(&bar[XB_TOP], 1u);
            const unsigned tg = og / nx;
            if (og + 1u == (tg + 1u) * nx) xb_add(&bar[XB_TOPGEN], 1u);
            else XB_SPIN(xb_ld(&bar[XB_TOPGEN]) == tg, bar);
            __builtin_amdgcn_fence(__ATOMIC_ACQUIRE, "agent");
            xb_add(&bar[XB_XGEN(b.x)], 1u);
            asm volatile("s_waitcnt vmcnt(0)" ::: "memory");
        } else {
            XB_SPIN(xb_ld(&bar[XB_XGEN(b.x)]) == gen, bar);
            __builtin_amdgcn_fence(__ATOMIC_ACQUIRE, "agent");
            asm volatile("s_waitcnt vmcnt(0)" ::: "memory");
        }
    }
    __syncthreads();
}

constexpr int BM = 256, BK = 64, HALF = 128, HTB = HALF * BK * 2, NXCD = 8, WGM = 8;
__device__ __forceinline__ int lds_byte(int r, int c) { const int st = (r >> 4) * 2 + (c >> 5), rr = r & 15, cc = c & 31, ob = rr * 64 + cc * 2; return st * 1024 + (ob ^ (((ob >> 9) & 1) << 5)); }
__device__ __forceinline__ void stage_rc(int b, int& R, int& C) { const int st = b / 1024, sb = b % 1024, swz = sb ^ (((sb >> 9) & 1) << 5); R = (st >> 1) * 16 + swz / 64; C = (st & 1) * 32 + (swz % 64) / 2; }
__device__ __forceinline__ int perm32(int rho) { const int n = rho >> 4, i = rho & 15; return 8 * (i >> 2) + 4 * n + (i & 3); }

struct Unit { int pm, pn, pb, lt, cnt, e; };
struct Gemm { const bf16_t* A; const bf16_t* Bt; int K; int sc = 0x7f7f7f7f; };

__device__ __forceinline__ void tile_map(int L, int nM, int nN, int& pm, int& pn) {
    const int nwg = nM * nN;
    int wgid = L; { const int q = nwg / NXCD, r = nwg % NXCD, xcd = wgid % NXCD, off = wgid / NXCD; wgid = (xcd < r ? xcd * (q + 1) : r * (q + 1) + (xcd - r) * q) + off; }
    const int nig = WGM * nN, gid = wgid / nig, fm = gid * WGM, gsz = (nM - fm) < WGM ? (nM - fm) : WGM;
    pm = fm + ((wgid % nig) % gsz); pn = (wgid % nig) / gsz;
}
struct StaticOrder {
    int nM, nN, nwg, G, c;
    __device__ __forceinline__ void init(int M_, int N_, int G_, int c_) { nM = M_ / BM; nN = N_ / BM; nwg = nM * nN; G = G_; c = c_; }
    __device__ __forceinline__ bool next(int i, Unit& u) const {
        const long L = (long)i * G + c; if (L >= nwg) return false;
        tile_map((int)L, nM, nN, u.pm, u.pn); u.pb = u.pn; u.lt = 0; u.cnt = 0; u.e = 0; return true;
    }
};
struct MoeOrder {
    int t1, t2, t3, t4, t5, t6, t7, nM, nN, nwg, G, c; const unsigned* cntp;
    __device__ __forceinline__ void init(const unsigned* cnt, int nN_, int G_, int c_) {
        int t = 0, o[9];
#pragma unroll
        for (int e = 0; e < 8; ++e) { o[e] = t; const int ce = __builtin_amdgcn_readfirstlane((int)__hip_atomic_load(cnt + e, __ATOMIC_RELAXED, __HIP_MEMORY_SCOPE_AGENT)); t += (ce + 255) >> 8; }
        o[8] = t; t1 = o[1]; t2 = o[2]; t3 = o[3]; t4 = o[4]; t5 = o[5]; t6 = o[6]; t7 = o[7];
        nM = t; nN = nN_; nwg = nM * nN; G = G_; c = c_; cntp = cnt;
    }
    __device__ __forceinline__ bool next(int i, Unit& u) const {
        const long L = (long)i * G + c; if (L >= nwg) return false;
        tile_map((int)L, nM, nN, u.pm, u.pn);
        const int e = (u.pm >= t1) + (u.pm >= t2) + (u.pm >= t3) + (u.pm >= t4) + (u.pm >= t5) + (u.pm >= t6) + (u.pm >= t7);
        const int tb = e == 0 ? 0 : e == 1 ? t1 : e == 2 ? t2 : e == 3 ? t3 : e == 4 ? t4 : e == 5 ? t5 : e == 6 ? t6 : t7;
        u.cnt = __builtin_amdgcn_readfirstlane((int)__hip_atomic_load(cntp + e, __ATOMIC_RELAXED, __HIP_MEMORY_SCOPE_AGENT));
        u.lt = u.pm - tb; u.e = e; u.pb = e * nN + u.pn; return true;
    }
};

typedef f32x4 Acc[2][2][4][2];

template <bool F8 = false, class Epi, class Sched>
__device__ __forceinline__ void gemm_phase(LAS unsigned char* lds, const Gemm g, const Sched& S, const Epi& E) {
    int tid_ = threadIdx.x; asm volatile("" : "+v"(tid_));
    const int tid = tid_, wid = __builtin_amdgcn_readfirstlane(tid >> 6), lane = tid & 63, wr = wid >> 2, wc = wid & 3, fr = lane & 15, fq = lane >> 4;
    const int K = g.K, nt = K / BK;
    unsigned voffA[2], voffB[2];
#pragma unroll
    for (int i = 0; i < 2; ++i) { int R, C; stage_rc(tid * 16 + i * 8192, R, C); const int Rb = (R & ~31) + perm32(R & 31);
        voffA[i] = (unsigned)(R * K + C) * 2u; voffB[i] = (unsigned)(Rb * K + C) * 2u; }
    const size_t kstep = (size_t)(BK * 2);
    const size_t hstep = (size_t)HALF * K * 2;
    const size_t tstep = 2 * hstep;
    const unsigned ldsw = (unsigned)wid * 1024u;
    const int aoff = lds_byte(wr * 64 + fr, fq * 8), boff = lds_byte(wc * 32 + fr, fq * 8);
#define PG8_SA(b, h) (((b) * 2 + (h)) * HTB)
#define PG8_SB(b, h) ((4 + (b) * 2 + (h)) * HTB)
#define PG8_STAGE(bufoff, gbase, voff) do { _Pragma("unroll") for (int _i = 0; _i < 2; ++_i) \
        __builtin_amdgcn_global_load_lds((const unsigned*)((const char*)(gbase) + (voff)[_i]), (LAS unsigned*)(lds + (bufoff) + ldsw + _i * 8192), 16, 0, 0); } while (0)
#define PG8_LDA(dst, b, h) do { _Pragma("unroll") for (int m = 0; m < 4; ++m) _Pragma("unroll") for (int k = 0; k < 2; ++k) dst[m][k] = *(const LAS bf16x8*)(lds + PG8_SA(b, h) + aoff + m * 2048 + k * 1024); } while (0)
#define PG8_LDB(dst, b, h) do { _Pragma("unroll") for (int n = 0; n < 2; ++n) _Pragma("unroll") for (int k = 0; k < 2; ++k) dst[n][k] = *(const LAS bf16x8*)(lds + PG8_SB(b, h) + boff + n * 2048 + k * 1024); } while (0)
#define PG8_MMA(ai, bj, At, Bt) do { __builtin_amdgcn_s_setprio(1); \
        if constexpr (F8) {        \
            _Pragma("unroll") for (int m = 0; m < 4; ++m) _Pragma("unroll") for (int n = 0; n < 2; ++n) { \
                const v8i32 bv_ = __builtin_shufflevector(__builtin_bit_cast(v4i32, Bt[n][0]), __builtin_bit_cast(v4i32, Bt[n][1]), 0, 1, 2, 3, 4, 5, 6, 7); \
                const v8i32 av_ = __builtin_shufflevector(__builtin_bit_cast(v4i32, At[m][0]), __builtin_bit_cast(v4i32, At[m][1]), 0, 1, 2, 3, 4, 5, 6, 7); \
                acc[ai][bj][m][n] = __builtin_amdgcn_mfma_scale_f32_16x16x128_f8f6f4(bv_, av_, acc[ai][bj][m][n], 0, 0, 0, g.sc, 0, 0x7f7f7f7f); } \
        } else { \
            _Pragma("unroll") for (int m = 0; m < 4; ++m) _Pragma("unroll") for (int n = 0; n < 2; ++n) _Pragma("unroll") for (int k = 0; k < 2; ++k) \
                acc[ai][bj][m][n] = __builtin_amdgcn_mfma_f32_16x16x32_bf16(Bt[n][k], At[m][k], acc[ai][bj][m][n], 0, 0, 0); } \
        __builtin_amdgcn_s_setprio(0); } while (0)
#define PG8_WAIT_V(n) asm volatile("s_waitcnt vmcnt(" #n ")" ::: "memory")
#define PG8_WAIT_L(n) asm volatile("s_waitcnt lgkmcnt(" #n ")" ::: "memory")
#define PG8_BAR __builtin_amdgcn_s_barrier()
#define PG8_SCHED __builtin_amdgcn_sched_barrier(0)
    Unit cur, nxt; int ui = 0;
    if (!S.next(0, cur)) return;
    Acc acc;
#pragma unroll
    for (int a = 0; a < 2; ++a)
#pragma unroll
        for (int b = 0; b < 2; ++b)
#pragma unroll
            for (int m = 0; m < 4; ++m)
#pragma unroll
                for (int n = 0; n < 2; ++n) acc[a][b][m][n] = (f32x4){0.f, 0.f, 0.f, 0.f};
    bf16x8 At[4][2], B0[2][2], B1[2][2];
    const char* cA = (const char*)g.A + (size_t)cur.pm * tstep; const char* cB = (const char*)g.Bt + (size_t)cur.pb * tstep;
    PG8_STAGE(PG8_SB(0, 0), cB, voffB); PG8_STAGE(PG8_SA(0, 0), cA, voffA); PG8_STAGE(PG8_SB(0, 1), cB + hstep, voffB); PG8_STAGE(PG8_SA(0, 1), cA + hstep, voffA);
    if (wr == 1) PG8_BAR;
    PG8_WAIT_V(4); PG8_BAR;
    PG8_STAGE(PG8_SB(1, 0), cB + kstep, voffB); PG8_STAGE(PG8_SA(1, 0), cA + kstep, voffA); PG8_STAGE(PG8_SB(1, 1), cB + hstep + kstep, voffB);
    PG8_WAIT_V(6); PG8_BAR;
    for (;;) {
        const bool has_next = S.next(ui + 1, nxt);
        const char* nA = has_next ? (const char*)g.A + (size_t)nxt.pm * tstep : cA; const char* nB = has_next ? (const char*)g.Bt + (size_t)nxt.pb * tstep : cB;
#pragma nounroll
        for (int t = 0; t < nt; t += 2) {
            const bool last = (t == nt - 2);
            const char* a1 = cA + (size_t)(t + 1) * kstep;
            const char* a2 = last ? nA : cA + (size_t)(t + 2) * kstep; const char* b2 = last ? nB : cB + (size_t)(t + 2) * kstep;
            const char* a3 = a2 + kstep; const char* b3 = b2 + kstep;
            PG8_LDB(B0, 0, 0); PG8_SCHED; PG8_LDA(At, 0, 0); PG8_STAGE(PG8_SA(1, 1), a1 + hstep, voffA);
            PG8_WAIT_L(8); PG8_BAR; PG8_WAIT_L(0); PG8_MMA(0, 0, At, B0); PG8_BAR; PG8_SCHED;
            PG8_LDB(B1, 0, 1); PG8_STAGE(PG8_SB(0, 0), b2, voffB);
            PG8_BAR; PG8_WAIT_L(0); PG8_MMA(0, 1, At, B1); PG8_BAR;
            PG8_LDA(At, 0, 1); PG8_STAGE(PG8_SA(0, 0), a2, voffA);
            PG8_BAR; PG8_WAIT_L(0); PG8_MMA(1, 0, At, B0); PG8_BAR; PG8_SCHED;
            PG8_STAGE(PG8_SB(0, 1), b2 + hstep, voffB);
            PG8_WAIT_V(6); PG8_BAR; PG8_MMA(1, 1, At, B1); PG8_BAR;
            PG8_LDB(B0, 1, 0); PG8_SCHED; PG8_LDA(At, 1, 0); PG8_STAGE(PG8_SA(0, 1), a2 + hstep, voffA);
            PG8_WAIT_L(8); PG8_BAR; PG8_WAIT_L(0); PG8_MMA(0, 0, At, B0); PG8_BAR; PG8_SCHED;
            PG8_LDB(B1, 1, 1); PG8_STAGE(PG8_SB(1, 0), b3, voffB);
            PG8_BAR; PG8_WAIT_L(0); PG8_MMA(0, 1, At, B1); PG8_BAR;
            PG8_LDA(At, 1, 1); PG8_STAGE(PG8_SA(1, 0), a3, voffA);
            PG8_BAR; PG8_WAIT_L(0); PG8_MMA(1, 0, At, B0); PG8_BAR; PG8_SCHED;
            PG8_STAGE(PG8_SB(1, 1), b3 + hstep, voffB);
            PG8_WAIT_V(6); PG8_BAR; PG8_MMA(1, 1, At, B1); PG8_BAR;
        }
        E(acc, cur, wr, wc, fr, fq);
        if (!has_next) break;
#pragma unroll
        for (int a = 0; a < 2; ++a)
#pragma unroll
            for (int b = 0; b < 2; ++b)
#pragma unroll
                for (int m = 0; m < 4; ++m)
#pragma unroll
                    for (int n = 0; n < 2; ++n) acc[a][b][m][n] = (f32x4){0.f, 0.f, 0.f, 0.f};
        cur = nxt; cA = nA; cB = nB; ++ui;
    }
    PG8_WAIT_V(0);
    if (wr == 0) PG8_BAR;
    PG8_BAR;
#undef PG8_SA
#undef PG8_SB
#undef PG8_STAGE
#undef PG8_LDA
#undef PG8_LDB
#undef PG8_MMA
#undef PG8_WAIT_V
#undef PG8_WAIT_L
#undef PG8_BAR
#undef PG8_SCHED
}

template <bool F8 = false, bool IDENT = false, class Epi, class Sched>
__device__ __forceinline__ void gemm_phase_gather(LAS unsigned char* lds, const Gemm g, const Sched& S, const Epi& E, const int* TOKV) {
    int tid_ = threadIdx.x; asm volatile("" : "+v"(tid_));
    const int tid = tid_, wid = __builtin_amdgcn_readfirstlane(tid >> 6), lane = tid & 63, wr = wid >> 2, wc = wid & 3, fr = lane & 15, fq = lane >> 4;
    const int K = g.K, nt = K / BK;
    unsigned voffB[2];
#pragma unroll
    for (int i = 0; i < 2; ++i) { int R, C; stage_rc(tid * 16 + i * 8192, R, C); const int Rb = (R & ~31) + perm32(R & 31); voffB[i] = (unsigned)(Rb * K + C) * 2u; }
    unsigned vgC[2][2];
    LAS int* TOKL = (LAS int*)(lds + STAGE_TOKL);
#define PG8_GROWS(dst, u_) do { int tq_ = threadIdx.x; asm volatile("" : "+v"(tq_)); _Pragma("unroll") for (int i_ = 0; i_ < 2; ++i_) { int R_, C_; stage_rc(tq_ * 16 + i_ * 8192, R_, C_); \
            _Pragma("unroll") for (int h_ = 0; h_ < 2; ++h_) { const int pos_ = 256 * (u_).lt + 128 * h_ + R_; \
                int tok_; if constexpr (IDENT) tok_ = 256 * (u_).pm + 128 * h_ + R_; else tok_ = (pos_ < (u_).cnt) ? TOKV[(size_t)(u_).e * M + pos_] : 0; dst[h_][i_] = (unsigned)tok_ * (unsigned)(K * 2) + (unsigned)C_ * 2u; } } } while (0)
#define PG8_GROWS_LDS(dst, u_, par_) do { int tq_ = threadIdx.x; asm volatile("" : "+v"(tq_)); _Pragma("unroll") for (int i_ = 0; i_ < 2; ++i_) { int R_, C_; stage_rc(tq_ * 16 + i_ * 8192, R_, C_); \
            _Pragma("unroll") for (int h_ = 0; h_ < 2; ++h_) { const int rl_ = 128 * h_ + R_; \
                int tok_; if constexpr (IDENT) tok_ = 256 * (u_).pm + rl_; else tok_ = (256 * (u_).lt + rl_ < (u_).cnt) ? TOKL[256 * (par_) + rl_] : 0; dst[h_][i_] = (unsigned)tok_ * (unsigned)(K * 2) + (unsigned)C_ * 2u; } } } while (0)
    const size_t kstep = (size_t)(BK * 2);
    const size_t hstep = (size_t)HALF * K * 2;
    const size_t tstep = 2 * hstep;
    const unsigned ldsw = (unsigned)wid * 1024u;
    const int aoff = lds_byte(wr * 64 + fr, fq * 8), boff = lds_byte(wc * 32 + fr, fq * 8);
#define PG8_SA(b, h) (((b) * 2 + (h)) * HTB)
#define PG8_SB(b, h) ((4 + (b) * 2 + (h)) * HTB)
#define PG8_STAGE(bufoff, gbase, voff) do { _Pragma("unroll") for (int _i = 0; _i < 2; ++_i) \
        __builtin_amdgcn_global_load_lds((const unsigned*)((const char*)(gbase) + (voff)[_i]), (LAS unsigned*)(lds + (bufoff) + ldsw + _i * 8192), 16, 0, 0); } while (0)
#define PG8_STAGEA(bufoff, gbase, h_, nx_) PG8_STAGE(bufoff, gbase, vgC[h_])
#define PG8_LDA(dst, b, h) do { _Pragma("unroll") for (int m = 0; m < 4; ++m) _Pragma("unroll") for (int k = 0; k < 2; ++k) dst[m][k] = *(const LAS bf16x8*)(lds + PG8_SA(b, h) + aoff + m * 2048 + k * 1024); } while (0)
#define PG8_LDB(dst, b, h) do { _Pragma("unroll") for (int n = 0; n < 2; ++n) _Pragma("unroll") for (int k = 0; k < 2; ++k) dst[n][k] = *(const LAS bf16x8*)(lds + PG8_SB(b, h) + boff + n * 2048 + k * 1024); } while (0)
#define PG8_MMA(ai, bj, At, Bt) do { __builtin_amdgcn_s_setprio(1); \
        if constexpr (F8) {        \
            _Pragma("unroll") for (int m = 0; m < 4; ++m) _Pragma("unroll") for (int n = 0; n < 2; ++n) { \
                const v8i32 bv_ = __builtin_shufflevector(__builtin_bit_cast(v4i32, Bt[n][0]), __builtin_bit_cast(v4i32, Bt[n][1]), 0, 1, 2, 3, 4, 5, 6, 7); \
                const v8i32 av_ = __builtin_shufflevector(__builtin_bit_cast(v4i32, At[m][0]), __builtin_bit_cast(v4i32, At[m][1]), 0, 1, 2, 3, 4, 5, 6, 7); \
                acc[ai][bj][m][n] = __builtin_amdgcn_mfma_scale_f32_16x16x128_f8f6f4(bv_, av_, acc[ai][bj][m][n], 0, 0, 0, g.sc, 0, 0x7f7f7f7f); } \
        } else { \
            _Pragma("unroll") for (int m = 0; m < 4; ++m) _Pragma("unroll") for (int n = 0; n < 2; ++n) _Pragma("unroll") for (int k = 0; k < 2; ++k) \
                acc[ai][bj][m][n] = __builtin_amdgcn_mfma_f32_16x16x32_bf16(Bt[n][k], At[m][k], acc[ai][bj][m][n], 0, 0, 0); } \
        __builtin_amdgcn_s_setprio(0); } while (0)
#define PG8_WAIT_V(n) asm volatile("s_waitcnt vmcnt(" #n ")" ::: "memory")
#define PG8_WAIT_L(n) asm volatile("s_waitcnt lgkmcnt(" #n ")" ::: "memory")
#define PG8_BAR __builtin_amdgcn_s_barrier()
#define PG8_SCHED __builtin_amdgcn_sched_barrier(0)
    Unit cur, nxt; int ui = 0;
    if (!S.next(0, cur)) return;
    Acc acc;
#pragma unroll
    for (int a = 0; a < 2; ++a)
#pragma unroll
        for (int b = 0; b < 2; ++b)
#pragma unroll
            for (int m = 0; m < 4; ++m)
#pragma unroll
                for (int n = 0; n < 2; ++n) acc[a][b][m][n] = (f32x4){0.f, 0.f, 0.f, 0.f};
    bf16x8 At[4][2], B0[2][2], B1[2][2];
    const char* cA = (const char*)g.A; const char* cB = (const char*)g.Bt + (size_t)cur.pb * tstep;
    PG8_GROWS(vgC, cur);
    PG8_STAGE(PG8_SB(0, 0), cB, voffB); PG8_STAGEA(PG8_SA(0, 0), cA, 0, false); PG8_STAGE(PG8_SB(0, 1), cB + hstep, voffB); PG8_STAGEA(PG8_SA(0, 1), cA, 1, false);
    if (wr == 1) PG8_BAR;
    PG8_WAIT_V(4); PG8_BAR;
    PG8_STAGE(PG8_SB(1, 0), cB + kstep, voffB); PG8_STAGEA(PG8_SA(1, 0), cA + kstep, 0, false); PG8_STAGE(PG8_SB(1, 1), cB + hstep + kstep, voffB);
    PG8_WAIT_V(6); PG8_BAR;
    for (;;) {
        const bool has_next = S.next(ui + 1, nxt);
        const char* nA = cA; const char* nB = has_next ? (const char*)g.Bt + (size_t)nxt.pb * tstep : cB;
        if (!IDENT && has_next && wid == 0) __builtin_amdgcn_global_load_lds((const unsigned*)(TOKV + (size_t)nxt.e * M + 256 * nxt.lt + 4 * lane), (LAS unsigned*)(TOKL + 256 * ((ui + 1) & 1)), 16, 0, 0);

#pragma nounroll
        for (int t = 0; t < nt; t += 2) {
            const bool last = (t == nt - 2);
            const char* a1 = cA + (size_t)(t + 1) * kstep;
            const char* a2 = last ? nA : cA + (size_t)(t + 2) * kstep; const char* b2 = last ? nB : cB + (size_t)(t + 2) * kstep;
            const char* a3 = a2 + kstep; const char* b3 = b2 + kstep;
            PG8_LDB(B0, 0, 0); PG8_SCHED; PG8_LDA(At, 0, 0); PG8_STAGEA(PG8_SA(1, 1), a1, 1, false);
            if (last && has_next) { PG8_GROWS_LDS(vgC, nxt, (ui + 1) & 1); }
            PG8_WAIT_L(8); PG8_BAR; PG8_WAIT_L(0); PG8_MMA(0, 0, At, B0); PG8_BAR; PG8_SCHED;
            PG8_LDB(B1, 0, 1); PG8_STAGE(PG8_SB(0, 0), b2, voffB);
            PG8_BAR; PG8_WAIT_L(0); PG8_MMA(0, 1, At, B1); PG8_BAR;
            PG8_LDA(At, 0, 1); PG8_STAGEA(PG8_SA(0, 0), a2, 0, last);
            PG8_BAR; PG8_WAIT_L(0); PG8_MMA(1, 0, At, B0); PG8_BAR; PG8_SCHED;
            PG8_STAGE(PG8_SB(0, 1), b2 + hstep, voffB);
            PG8_WAIT_V(6); PG8_BAR; PG8_MMA(1, 1, At, B1); PG8_BAR;
            PG8_LDB(B0, 1, 0); PG8_SCHED; PG8_LDA(At, 1, 0); PG8_STAGEA(PG8_SA(0, 1), a2, 1, last);
            PG8_WAIT_L(8); PG8_BAR; PG8_WAIT_L(0); PG8_MMA(0, 0, At, B0); PG8_BAR; PG8_SCHED;
            PG8_LDB(B1, 1, 1); PG8_STAGE(PG8_SB(1, 0), b3, voffB);
            PG8_BAR; PG8_WAIT_L(0); PG8_MMA(0, 1, At, B1); PG8_BAR;
            PG8_LDA(At, 1, 1); PG8_STAGEA(PG8_SA(1, 0), a3, 0, last);
            PG8_BAR; PG8_WAIT_L(0); PG8_MMA(1, 0, At, B0); PG8_BAR; PG8_SCHED;
            PG8_STAGE(PG8_SB(1, 1), b3 + hstep, voffB);
            PG8_WAIT_V(6); PG8_BAR; PG8_MMA(1, 1, At, B1); PG8_BAR;
        }
        E(acc, cur, wr, wc, fr, fq);
        if (!has_next) break;
#pragma unroll
        for (int a = 0; a < 2; ++a)
#pragma unroll
            for (int b = 0; b < 2; ++b)
#pragma unroll
                for (int m = 0; m < 4; ++m)
#pragma unroll
                    for (int n = 0; n < 2; ++n) acc[a][b][m][n] = (f32x4){0.f, 0.f, 0.f, 0.f};
        cur = nxt; cB = nB; ++ui;
    }
    PG8_WAIT_V(0);
    if (wr == 0) PG8_BAR;
    PG8_BAR;
#undef PG8_SA
#undef PG8_STAGEA
#undef PG8_GROWS
#undef PG8_GROWS_LDS
#undef PG8_SB
#undef PG8_STAGE
#undef PG8_LDA
#undef PG8_LDB
#undef PG8_MMA
#undef PG8_WAIT_V
#undef PG8_WAIT_L
#undef PG8_BAR
#undef PG8_SCHED
}

__device__ __forceinline__ u32x4 pack8(const f32x4 a, const f32x4 b) { u32x4 w; w.x = cvt_pk_bf16(a[0], a[1]); w.y = cvt_pk_bf16(a[2], a[3]); w.z = cvt_pk_bf16(b[0], b[1]); w.w = cvt_pk_bf16(b[2], b[3]); return w; }

struct EpiHgIn {
    bf16_t* QFVG;
    __device__ __forceinline__ void operator()(const Acc& acc, const Unit& u, int wr, int wc, int fr, int fq) const {
        const int part = u.pn >> 2, row0 = u.pm * BM + wr * 64 + fr, col0 = (u.pn & 3) * 256 + wc * 32 + 8 * fq;
        bf16_t* base = QFVG + (size_t)part * ((size_t)M * D);
#pragma unroll
        for (int ai = 0; ai < 2; ++ai)
#pragma unroll
            for (int m = 0; m < 4; ++m) { bf16_t* rowp = base + (size_t)(row0 + ai * HALF + m * 16) * D + col0;
#pragma unroll
                for (int bj = 0; bj < 2; ++bj) *(u32x4*)(rowp + bj * HALF) = pack8(acc[ai][bj][m][0], acc[ai][bj][m][1]); }
    }
};
struct EpiRes {
    const bf16_t* X; bf16_t* Y;
    __device__ __forceinline__ void operator()(const Acc& acc, const Unit& u, int wr, int wc, int fr, int fq) const {
        const int row0 = u.pm * BM + wr * 64 + fr, col0 = u.pn * BM + wc * 32 + 8 * fq;
#pragma unroll
        for (int ai = 0; ai < 2; ++ai)
#pragma unroll
            for (int m = 0; m < 4; ++m) { const size_t o = (size_t)(row0 + ai * HALF + m * 16) * D + col0;
#pragma unroll
                for (int bj = 0; bj < 2; ++bj) {
                    const u32x4 xv = *(const u32x4*)(X + o + bj * HALF);
                    f32x4 y0, y1;
#pragma unroll
                    for (int q = 0; q < 2; ++q) { y0[2 * q] = __uint_as_float(xv[q] << 16) * ALPHA + acc[ai][bj][m][0][2 * q]; y0[2 * q + 1] = __uint_as_float(xv[q] & 0xffff0000u) * ALPHA + acc[ai][bj][m][0][2 * q + 1];
                        y1[2 * q] = __uint_as_float(xv[2 + q] << 16) * ALPHA + acc[ai][bj][m][1][2 * q]; y1[2 * q + 1] = __uint_as_float(xv[2 + q] & 0xffff0000u) * ALPHA + acc[ai][bj][m][1][2 * q + 1]; }
                    *(u32x4*)(Y + o + bj * HALF) = pack8(y0, y1); } }
    }
};
__device__ __forceinline__ unsigned pack4_fp8(float a, float b, float c, float d) {
    a = fminf(fmaxf(a, -448.f), 448.f); b = fminf(fmaxf(b, -448.f), 448.f); c = fminf(fmaxf(c, -448.f), 448.f); d = fminf(fmaxf(d, -448.f), 448.f);
    int p = 0; p = __builtin_amdgcn_cvt_pk_fp8_f32(a, b, p, false); p = __builtin_amdgcn_cvt_pk_fp8_f32(c, d, p, true); return (unsigned)p;
}
constexpr float F8_X = 16.f, F8_WGU = 64.f, F8_H = 4.f, F8_WDN = 256.f, F8_O = 64.f, F8_WDO = 128.f;
constexpr int e8m0x4(int e) { return (127 + e) * 0x01010101; }
constexpr float F8_Q = 64.f, F8_KV = 16.f;
constexpr int SC_S = e8m0x4(-10), SC_V = e8m0x4(-4);
constexpr int SC_UP = e8m0x4(-10), SC_DN = e8m0x4(-10), SC_DO = e8m0x4(-13);
struct EpiSwiglu8 {
    unsigned char* H;
    __device__ __forceinline__ void operator()(const Acc& acc, const Unit& u, int wr, int wc, int fr, int fq) const {
        const int row0 = u.pm * BM + wr * 64 + fr, col0 = u.pn * 128 + wc * 32 + 8 * fq;
#pragma unroll
        for (int ai = 0; ai < 2; ++ai)
#pragma unroll
            for (int m = 0; m < 4; ++m) { unsigned char* rowp = H + (size_t)(row0 + ai * HALF + m * 16) * DFF + col0;
                float h[8];
#pragma unroll
                for (int j = 0; j < 8; ++j) { const float gt = acc[ai][0][m][j >> 2][j & 3], up = acc[ai][1][m][j >> 2][j & 3];
                    h[j] = __builtin_amdgcn_fmed3f(gt * (up * F8_H) * fast_rcp(1.0f + fast_exp2(gt * -1.4426950408889634f)), -448.f, 448.f); }
                int p0 = 0, p1 = 0;
                p0 = __builtin_amdgcn_cvt_pk_fp8_f32(h[0], h[1], p0, false); p0 = __builtin_amdgcn_cvt_pk_fp8_f32(h[2], h[3], p0, true);
                p1 = __builtin_amdgcn_cvt_pk_fp8_f32(h[4], h[5], p1, false); p1 = __builtin_amdgcn_cvt_pk_fp8_f32(h[6], h[7], p1, true);
                *(u32x2*)rowp = (u32x2){(unsigned)p0, (unsigned)p1}; }
    }
};
struct EpiSwiglu {
    bf16_t* H;
    __device__ __forceinline__ void operator()(const Acc& acc, const Unit& u, int wr, int wc, int fr, int fq) const {
        const int row0 = u.pm * BM + wr * 64 + fr, col0 = u.pn * 128 + wc * 32 + 8 * fq;
#pragma unroll
        for (int ai = 0; ai < 2; ++ai)
#pragma unroll
            for (int m = 0; m < 4; ++m) { bf16_t* rowp = H + (size_t)(row0 + ai * HALF + m * 16) * DFF + col0;
                f32x4 h0, h1;
#pragma unroll
                for (int j = 0; j < 4; ++j) { h0[j] = siluf_(acc[ai][0][m][0][j]) * acc[ai][1][m][0][j]; h1[j] = siluf_(acc[ai][0][m][1][j]) * acc[ai][1][m][1][j]; }
                *(u32x4*)rowp = pack8(h0, h1); }
    }
};
struct EpiBf16 {
    bf16_t* C; int ldc;
    __device__ __forceinline__ void operator()(const Acc& acc, const Unit& u, int wr, int wc, int fr, int fq) const {
        const int row0 = u.pm * BM + wr * 64 + fr, col0 = u.pn * BM + wc * 32 + 8 * fq;
#pragma unroll
        for (int ai = 0; ai < 2; ++ai)
#pragma unroll
            for (int m = 0; m < 4; ++m) { bf16_t* rowp = C + (size_t)(row0 + ai * HALF + m * 16) * ldc + col0;
#pragma unroll
                for (int bj = 0; bj < 2; ++bj) *(u32x4*)(rowp + bj * HALF) = pack8(acc[ai][bj][m][0], acc[ai][bj][m][1]); }
    }
};
struct EpiQ {
    bf16_t* QLAT; bf16_t* QIDX;
    __device__ __forceinline__ void operator()(const Acc& acc, const Unit& u, int wr, int wc, int fr, int fq) const {
        const bool lat = u.pn < 8; bf16_t* base = lat ? QLAT : QIDX; const int ld = lat ? 2048 : 512;
        const int row0 = u.pm * BM + wr * 64 + fr, col0 = (lat ? u.pn : u.pn - 8) * BM + wc * 32 + 8 * fq;
#pragma unroll
        for (int ai = 0; ai < 2; ++ai)
#pragma unroll
            for (int m = 0; m < 4; ++m) { bf16_t* rowp = base + (size_t)(row0 + ai * HALF + m * 16) * ld + col0;
#pragma unroll
                for (int bj = 0; bj < 2; ++bj) *(u32x4*)(rowp + bj * HALF) = pack8(acc[ai][bj][m][0], acc[ai][bj][m][1]); }
    }
};
struct EpiQ8 {
    unsigned char* QLAT8; bf16_t* QIDX;
    __device__ __forceinline__ void operator()(const Acc& acc, const Unit& u, int wr, int wc, int fr, int fq) const {
        const int row0 = u.pm * BM + wr * 64 + fr;
        if (u.pn < 8) { const int col0 = u.pn * BM + wc * 32 + 8 * fq;
#pragma unroll
            for (int ai = 0; ai < 2; ++ai)
#pragma unroll
                for (int m = 0; m < 4; ++m) { unsigned char* rowp = QLAT8 + (size_t)(row0 + ai * HALF + m * 16) * 2048 + col0;
#pragma unroll
                    for (int bj = 0; bj < 2; ++bj) { u32x2 o;
                        o.x = pack4_fp8(acc[ai][bj][m][0][0] * F8_Q, acc[ai][bj][m][0][1] * F8_Q, acc[ai][bj][m][0][2] * F8_Q, acc[ai][bj][m][0][3] * F8_Q);
                        o.y = pack4_fp8(acc[ai][bj][m][1][0] * F8_Q, acc[ai][bj][m][1][1] * F8_Q, acc[ai][bj][m][1][2] * F8_Q, acc[ai][bj][m][1][3] * F8_Q);
                        *(u32x2*)(rowp + bj * HALF) = o; } }
        } else { const int col0 = (u.pn - 8) * BM + wc * 32 + 8 * fq;
#pragma unroll
            for (int ai = 0; ai < 2; ++ai)
#pragma unroll
                for (int m = 0; m < 4; ++m) { bf16_t* rowp = QIDX + (size_t)(row0 + ai * HALF + m * 16) * 512 + col0;
#pragma unroll
                    for (int bj = 0; bj < 2; ++bj) *(u32x4*)(rowp + bj * HALF) = pack8(acc[ai][bj][m][0], acc[ai][bj][m][1]); }
        }
    }
};
struct EpiMoeDn {
    bf16_t* O; const float* GW;
    __device__ __forceinline__ void operator()(const Acc& acc, const Unit& u, int wr, int wc, int fr, int fq) const {
        const int rl0 = wr * 64 + fr, col0 = u.pn * BM + wc * 32 + 8 * fq; const float* gwp = GW + (size_t)u.e * M + 256 * u.lt;
#pragma unroll
        for (int ai = 0; ai < 2; ++ai)
#pragma unroll
            for (int m = 0; m < 4; ++m) { const int rl = rl0 + ai * HALF + m * 16; const float gv = (256 * u.lt + rl < u.cnt) ? gwp[rl] : 0.f; bf16_t* rowp = O + (size_t)(u.pm * BM + rl) * D + col0;
#pragma unroll
                for (int bj = 0; bj < 2; ++bj) *(u32x4*)(rowp + bj * HALF) = pack8(acc[ai][bj][m][0] * gv, acc[ai][bj][m][1] * gv); }
    }
};

struct Params { const float* in[22]; float* out; unsigned char* ws; int ph_lo, ph_hi; };
enum { IN_X = 0, IN_LNG, IN_LNB, IN_HGWIN, IN_HGLB, IN_HGNG, IN_HGWOUT, IN_DWIN, IN_DQNG, IN_DKVNG, IN_DWUQ, IN_DWUK, IN_DWUV, IN_DWQIDX, IN_DKIG, IN_DKIB, IN_DWOUT, IN_FGU, IN_FDN, IN_MR, IN_MGU, IN_MDN };

__device__ __forceinline__ const float* inptr(int i) {
    int off = i * 8; asm volatile("" : "+s"(off));
    typedef const float* cfp;
    return *(const __attribute__((address_space(4))) cfp*)((const __attribute__((address_space(4))) char*)__builtin_amdgcn_kernarg_segment_ptr() + off);
}
#define INP(i) inptr(i)
struct Frame {
    LAS unsigned char* lds;
    unsigned* ctl;
    int tid, lane, wave, G, c;
};

struct P0Item { const float* W; bf16_t* WT; int K, Nsrc, nblk, mode, item; float f8scale; };
__device__ __forceinline__ void p0_load(const P0Item& d, int lane, f32x4 (&v)[8]) {
    const int kb = d.item / d.nblk, nb = d.item % d.nblk, k0 = 64 * kb, n0 = 32 * nb;
    const int c4 = (lane & 7) * 4, kr = lane >> 3;
#pragma unroll
    for (int i = 0; i < 8; ++i) { const int kk = 8 * i + kr;
        v[i] = (f32x4){0.f, 0.f, 0.f, 0.f};
        if (n0 + c4 < d.Nsrc) v[i] = *(const f32x4*)(d.W + (size_t)(k0 + kk) * d.Nsrc + n0 + c4); }
}
__device__ __forceinline__ void p0_store(const P0Item& d, const f32x4 (&v)[8], LAS float* scr, int lane) {
    const int K = d.K; const float f8scale = d.f8scale; bf16_t* WT = d.WT;
    const int kb = d.item / d.nblk, nb = d.item % d.nblk, k0 = 64 * kb, n0 = 32 * nb;
    const int c4 = (lane & 7) * 4, kr = lane >> 3;
#pragma unroll
    for (int i = 0; i < 8; ++i) { const int kk = 8 * i + kr;
        scr[kk * 33 + c4 + 0] = v[i][0]; scr[kk * 33 + c4 + 1] = v[i][1]; scr[kk * 33 + c4 + 2] = v[i][2]; scr[kk * 33 + c4 + 3] = v[i][3]; }
    LDS_WAIT(); asm volatile("" ::: "memory");
    int drow0 = n0;
    if (d.mode == 1) { const int half = n0 / DFF, r = n0 % DFF; drow0 = 256 * (r / 128) + 128 * half + (r % 128); }
    if (f8scale > 0.f) {
        const int c = lane & 3;
#pragma unroll
        for (int j = 0; j < 2; ++j) { const int n = (lane >> 2) + 16 * j; const LAS float* s = scr + (16 * c) * 33 + n;
            u32x4 o;
#pragma unroll
            for (int q = 0; q < 4; ++q) o[q] = pack4_fp8(s[(4 * q) * 33] * f8scale, s[(4 * q + 1) * 33] * f8scale, s[(4 * q + 2) * 33] * f8scale, s[(4 * q + 3) * 33] * f8scale);
            *(u32x4*)((unsigned char*)WT + (size_t)(drow0 + n) * K + k0 + 16 * c) = o; }
    } else {
        const int c = lane & 7;
#pragma unroll
        for (int j = 0; j < 4; ++j) { const int n = (lane >> 3) + 8 * j; const LAS float* s = scr + (8 * c) * 33 + n;
            u32x4 o; o.x = cvt_pk_bf16(s[0 * 33], s[1 * 33]); o.y = cvt_pk_bf16(s[2 * 33], s[3 * 33]); o.z = cvt_pk_bf16(s[4 * 33], s[5 * 33]); o.w = cvt_pk_bf16(s[6 * 33], s[7 * 33]);
            *(u32x4*)(WT + (size_t)(drow0 + n) * K + k0 + 8 * c) = o; }
    }
    LDS_WAIT(); asm volatile("" ::: "memory");
}
__device__ __forceinline__ void p0_combo_item(Frame& F, const float* A, int lda, const float* B, int ldb, bf16_t* out, int ldo, float scale, bool f8 = false) {
    LAS float* As = (LAS float*)F.lds; LAS float* Bs = As + 64 * 128;
    const int t = F.tid;
#pragma unroll
    for (int q = 0; q < 4; ++q) { const int r = (t >> 5) + 16 * q, c4 = (t & 31) * 4; *(LAS f32x4*)(As + r * 128 + c4) = *(const f32x4*)(A + (size_t)r * lda + c4); }
#pragma unroll
    for (int q = 0; q < 4; ++q) { const int r = (t >> 4) + 32 * q, c4 = (t & 15) * 4; *(LAS f32x4*)(Bs + r * 64 + c4) = *(const f32x4*)(B + (size_t)r * ldb + c4); }
    __syncthreads();
    const int tj = t & 63, ti = t >> 6;
    float acc[8];
#pragma unroll
    for (int ii = 0; ii < 8; ++ii) acc[ii] = 0.f;
    for (int d = 0; d < 128; d += 4) {
        const float b0 = Bs[(d + 0) * 64 + tj], b1 = Bs[(d + 1) * 64 + tj], b2 = Bs[(d + 2) * 64 + tj], b3 = Bs[(d + 3) * 64 + tj];
#pragma unroll
        for (int ii = 0; ii < 8; ++ii) { const f32x4 a = *(const LAS f32x4*)(As + (8 * ti + ii) * 128 + d); acc[ii] += a[0] * b0 + a[1] * b1 + a[2] * b2 + a[3] * b3; }
    }
    u32x4 o; o.x = cvt_pk_bf16(acc[0] * scale, acc[1] * scale); o.y = cvt_pk_bf16(acc[2] * scale, acc[3] * scale); o.z = cvt_pk_bf16(acc[4] * scale, acc[5] * scale); o.w = cvt_pk_bf16(acc[6] * scale, acc[7] * scale);
    if (f8) { u32x2 o8; o8.x = pack4_fp8(acc[0] * scale, acc[1] * scale, acc[2] * scale, acc[3] * scale); o8.y = pack4_fp8(acc[4] * scale, acc[5] * scale, acc[6] * scale, acc[7] * scale);
        *(u32x2*)((unsigned char*)out + (size_t)tj * ldo + 8 * ti) = o8; }
    else *(u32x4*)(out + (size_t)tj * ldo + 8 * ti) = o;
    __syncthreads();
}
__device__ __forceinline__ void p0_prologue(Frame& F, const Params& p) {
    unsigned char* ws = p.ws;
    LAS float* scr = (LAS float*)(F.lds + F.wave * 8448);
    const int gw = F.c * NWAVES + F.wave, NGW = F.G * NWAVES;
    constexpr int I0 = 16 * 128, I1 = 16 * 32, I2 = 16 * 224, I3 = 56 * 32, I4 = 16 * 24, I5 = 4 * 16;
    constexpr int NITEMS = 2 * (I0 + I1 + I2 + I3 + I4 + I5) + 16 * (I2 + I3);
    auto mk = [&](int it, P0Item& d) {
        int r = it;
        if (r < 16 * I2) { const int job = r / I2; d = P0Item{INP(IN_MGU) + (size_t)job * D * 2 * DFF, MK_MOE_FP8 ? (bf16_t*)(ws + WS_W_MGU8 + (size_t)job * 2 * DFF * D) : (bf16_t*)(ws + WS_W_MGU) + (size_t)job * 2 * DFF * D, D, 2 * DFF, 224, 1, r % I2, MK_MOE_FP8 ? F8_WGU : 0.f}; return; } r -= 16 * I2;
        if (r < 16 * I3) { const int job = r / I3; d = P0Item{INP(IN_MDN) + (size_t)job * DFF * D, MK_MOE_FP8 ? (bf16_t*)(ws + WS_W_MDN8 + (size_t)job * D * DFF) : (bf16_t*)(ws + WS_W_MDN) + (size_t)job * D * DFF, DFF, D, 32, 0, r % I3, MK_MOE_FP8 ? F8_WDN : 0.f}; return; } r -= 16 * I3;
        if (r < 2 * I0) { const int job = r / I0; d = P0Item{INP(IN_HGWIN) + (size_t)job * D * 4 * D, (bf16_t*)(ws + WS_W_HGIN) + (size_t)job * 4 * D * D, D, 4 * D, 128, 0, r % I0, 0.f}; return; } r -= 2 * I0;
        if (r < 2 * I1) { const int job = r / I1; d = P0Item{INP(IN_HGWOUT) + (size_t)job * D * D, (bf16_t*)(ws + WS_W_HGOUT) + (size_t)job * D * D, D, D, 32, 0, r % I1, 0.f}; return; } r -= 2 * I1;
        if (r < 2 * I2) { const int job = r / I2; d = P0Item{INP(IN_FGU) + (size_t)job * D * 2 * DFF, (MK_FFN_FP8 == 2) ? (bf16_t*)(ws + WS_W_FGU + (size_t)job * 2 * DFF * D) : (bf16_t*)(ws + WS_W_FGU) + (size_t)job * 2 * DFF * D, D, 2 * DFF, 224, 1, r % I2, (MK_FFN_FP8 == 2) ? F8_WGU : 0.f}; return; } r -= 2 * I2;
        if (r < 2 * I3) { const int job = r / I3; d = P0Item{INP(IN_FDN) + (size_t)job * DFF * D, (MK_FFN_FP8 >= 1) ? (bf16_t*)(ws + WS_W_FDN + (size_t)job * D * DFF) : (bf16_t*)(ws + WS_W_FDN) + (size_t)job * D * DFF, DFF, D, 32, 0, r % I3, (MK_FFN_FP8 >= 1) ? F8_WDN : 0.f}; return; } r -= 2 * I3;
        if (r < 2 * I4) { const int job = r / I4; d = P0Item{INP(IN_DWIN) + (size_t)job * D * DSA_IN, (bf16_t*)(ws + WS_W_DIN) + (size_t)job * DSA_IN_PAD * D, D, DSA_IN, 24, 0, r % I4, 0.f}; return; } r -= 2 * I4;
        { const int job = r / I5; d = P0Item{INP(IN_DWQIDX) + (size_t)job * QR * 512, (bf16_t*)(ws + WS_W_DQ) + (size_t)job * 2560 * QR + (size_t)2048 * QR, QR, 512, 16, 0, r % I5, 0.f}; }
    };
    { int it = gw; bool have = it < NITEMS; P0Item cur, nxt; f32x4 vc[8], vn[8];
      if (have) { mk(it, cur); p0_load(cur, F.lane, vc); }
      while (have) {
          const int itn = it + NGW; const bool hn = itn < NITEMS;
          if (hn) { mk(itn, nxt); p0_load(nxt, F.lane, vn); }
          p0_store(cur, vc, scr, F.lane);
          if (hn) { cur = nxt;
#pragma unroll
              for (int q = 0; q < 8; ++q) vc[q] = vn[q]; }
          it = itn; have = hn; } }
    { const f32x4* x4 = (const f32x4*)INP(IN_X); u32x2* xb = (u32x2*)(ws + WS_XB); const size_t n4 = (size_t)M * D / 4;
      for (size_t i = (size_t)F.c * NTHREADS + F.tid; i < n4; i += (size_t)F.G * NTHREADS) { const f32x4 v = x4[i]; u32x2 o; o.x = cvt_pk_bf16(v[0], v[1]); o.y = cvt_pk_bf16(v[2], v[3]); xb[i] = o; } }
    __syncthreads();
    const float qscale = 0.08838834764831845f * 1.4426950408889634f;
    for (int it = F.c; it < 256 + 1024; it += F.G) {
        if (it < 256) { const int j = it >> 7, h = (it >> 4) & 7, ib = (it >> 2) & 3, jb = it & 3;
            p0_combo_item(F, INP(IN_DWUQ) + (size_t)j * QR * D + (size_t)(64 * ib) * D + h * 128, D, INP(IN_DWUK) + ((size_t)j * 8 + h) * 128 * KVR + 64 * jb, KVR,
                          (bf16_t*)(ws + WS_W_DQ) + (size_t)j * 2560 * QR + (size_t)(h * 256 + 64 * jb) * QR + 64 * ib, QR, qscale);
        } else { const int r = it - 256, j = r >> 9, h = (r >> 6) & 7, ib = (r >> 4) & 3, jb = r & 15;
            p0_combo_item(F, INP(IN_DWUV) + (((size_t)j * 8 + h) * KVR + 64 * ib) * 128, 128, INP(IN_DWOUT) + (size_t)j * D * D + (size_t)(h * 128) * D + 64 * jb, D,
#if MK_B6_FP8
                          (bf16_t*)(ws + WS_W_DO + (size_t)j * D * 2048 + (size_t)(64 * jb) * 2048 + h * 256 + 64 * ib), 2048, F8_WDO, true);
#else
                          (bf16_t*)(ws + WS_W_DO) + (size_t)j * D * 2048 + (size_t)(64 * jb) * 2048 + h * 256 + 64 * ib, 2048, 1.0f);
#endif
        }
    }
}

__device__ __forceinline__ void unpack8(const u32x4 w, float* v) {
#pragma unroll
    for (int q = 0; q < 4; ++q) { v[2 * q] = __uint_as_float(w[q] << 16); v[2 * q + 1] = __uint_as_float(w[q] & 0xffff0000u); }
}
__device__ __forceinline__ void load_row_bf16(const bf16_t* row, int lane, float (&v)[16]) {
    const u32x4 a = *(const u32x4*)(row + 8 * lane), b = *(const u32x4*)(row + 512 + 8 * lane); unpack8(a, v); unpack8(b, v + 8);
}
__device__ __forceinline__ void load_vec_f32(const float* p, int lane, float (&v)[16]) {
#pragma unroll
    for (int h = 0; h < 2; ++h)
#pragma unroll
        for (int q = 0; q < 2; ++q) { const f32x4 x = *(const f32x4*)(p + 512 * h + 8 * lane + 4 * q); v[8 * h + 4 * q] = x[0]; v[8 * h + 4 * q + 1] = x[1]; v[8 * h + 4 * q + 2] = x[2]; v[8 * h + 4 * q + 3] = x[3]; }
}
__device__ __forceinline__ void store_row_bf16(const float (&v)[16], bf16_t* row, int lane) {
    u32x4 a, b;
#pragma unroll
    for (int q = 0; q < 4; ++q) { a[q] = cvt_pk_bf16(v[2 * q], v[2 * q + 1]); b[q] = cvt_pk_bf16(v[8 + 2 * q], v[8 + 2 * q + 1]); }
    *(u32x4*)(row + 8 * lane) = a; *(u32x4*)(row + 512 + 8 * lane) = b;
}
__device__ __forceinline__ void store_row_fp8(const float (&v)[16], unsigned char* row, int lane) {
    u32x2 o0, o1; o0.x = pack4_fp8(v[0] * F8_X, v[1] * F8_X, v[2] * F8_X, v[3] * F8_X); o0.y = pack4_fp8(v[4] * F8_X, v[5] * F8_X, v[6] * F8_X, v[7] * F8_X);
    o1.x = pack4_fp8(v[8] * F8_X, v[9] * F8_X, v[10] * F8_X, v[11] * F8_X); o1.y = pack4_fp8(v[12] * F8_X, v[13] * F8_X, v[14] * F8_X, v[15] * F8_X);
    *(u32x2*)(row + 8 * lane) = o0; *(u32x2*)(row + 512 + 8 * lane) = o1;
}
__device__ __forceinline__ void store_row_f32(const float (&v)[16], float* row, int lane) {
#pragma unroll
    for (int h = 0; h < 2; ++h)
#pragma unroll
        for (int q = 0; q < 2; ++q) *(f32x4*)(row + 512 * h + 8 * lane + 4 * q) = (f32x4){v[8 * h + 4 * q], v[8 * h + 4 * q + 1], v[8 * h + 4 * q + 2], v[8 * h + 4 * q + 3]};
}
__device__ __forceinline__ void ln_row(float (&v)[16], const float (&g)[16], const float (&b)[16]) {
    float s = 0.f;
#pragma unroll
    for (int i = 0; i < 16; ++i) s += v[i];
    const float mean = wave_sum(s) * (1.f / D); float s2 = 0.f;
#pragma unroll
    for (int i = 0; i < 16; ++i) { v[i] -= mean; s2 += v[i] * v[i]; }
    const float rstd = 1.f / sqrtf(wave_sum(s2) * (1.f / D) + LN_EPS);
#pragma unroll
    for (int i = 0; i < 16; ++i) v[i] = v[i] * rstd * g[i] + b[i];
}
__device__ __forceinline__ void ln_phase(Frame& F, const bf16_t* Y, const float* g, const float* b, bf16_t* XB, unsigned char* XB8) {
    float gv[16], bv[16]; load_vec_f32(g, F.lane, gv); load_vec_f32(b, F.lane, bv);
    const int gw = F.c * NWAVES + F.wave, NGW = F.G * NWAVES;
    for (int m = gw; m < M; m += NGW) {
        float v[16]; load_row_bf16(Y + (size_t)m * D, F.lane, v);
        ln_row(v, gv, bv);
        store_row_bf16(v, XB + (size_t)m * D, F.lane);
        if (XB8) store_row_fp8(v, XB8 + (size_t)m * D, F.lane);
    }
}
__device__ __forceinline__ void ln_moe_phase(Frame& F, const bf16_t* Xin, const bf16_t* OUTM, const int* EIDX, const int* POS, const unsigned* gcnt, const float* g, const float* b, bf16_t* XB, float* OUT) {
    float gv[16], bv[16]; load_vec_f32(g, F.lane, gv); load_vec_f32(b, F.lane, bv);
    int roff[8]; { int t = 0;
#pragma unroll
        for (int e = 0; e < 8; ++e) { roff[e] = t * 256; t += (__builtin_amdgcn_readfirstlane((int)__hip_atomic_load(gcnt + e, __ATOMIC_RELAXED, __HIP_MEMORY_SCOPE_AGENT)) + 255) >> 8; } }
    const int gw = F.c * NWAVES + F.wave, NGW = F.G * NWAVES;
    for (int m = gw; m < M; m += NGW) {
        const int e0 = EIDX[2 * m], e1 = EIDX[2 * m + 1]; int s0 = POS[2 * m], s1 = POS[2 * m + 1];
#pragma unroll
        for (int k = 0; k < 8; ++k) { s0 += (e0 == k) ? roff[k] : 0; s1 += (e1 == k) ? roff[k] : 0; }
        float v[16], o0[16], o1[16]; load_row_bf16(Xin + (size_t)m * D, F.lane, v); load_row_bf16(OUTM + (size_t)s0 * D, F.lane, o0); load_row_bf16(OUTM + (size_t)s1 * D, F.lane, o1);
#pragma unroll
        for (int i = 0; i < 16; ++i) v[i] = v[i] * ALPHA + o0[i] + o1[i];
        ln_row(v, gv, bv);
        if (OUT) store_row_f32(v, OUT + (size_t)m * D, F.lane); else store_row_bf16(v, XB + (size_t)m * D, F.lane);
    }
}
__device__ __forceinline__ void ln_router_phase(Frame& F, const bf16_t* Y, const float* g, const float* b, const float* wrouter, bf16_t* XB, unsigned char* XB8,
                                                int* EIDX, int* POS, int* TOK, float* GW, unsigned* gcnt) {
    LAS float* WR = (LAS float*)F.lds;
    LAS int* SEL = (LAS int*)(F.lds + 32768);
    LAS int* CW = (LAS int*)(F.lds + 32768 + 1024);
    LAS int* BASE = (LAS int*)(F.lds + 32768 + 1024 + 128);
    LAS float* SELW = (LAS float*)(F.lds + 32768 + 2048);
    for (int q = 0; q < 16; ++q) { const int idx = F.tid + NTHREADS * q; WR[(idx & 7) * 1024 + (idx >> 3)] = wrouter[idx]; }
    float gv[16], bv[16]; load_vec_f32(g, F.lane, gv); load_vec_f32(b, F.lane, bv);
    __syncthreads();
    for (int blk = F.c; blk < M / 128; blk += F.G) {
        for (int rl = F.wave; rl < 128; rl += NWAVES) {
            const int m = blk * 128 + rl;
            float v[16]; load_row_bf16(Y + (size_t)m * D, F.lane, v);
            ln_row(v, gv, bv);
            store_row_bf16(v, XB + (size_t)m * D, F.lane);
            if (XB8) store_row_fp8(v, XB8 + (size_t)m * D, F.lane);
            float lg[8];
#pragma unroll
            for (int e = 0; e < 8; ++e) { float s = 0.f;
#pragma unroll
                for (int h = 0; h < 2; ++h)
#pragma unroll
                    for (int q = 0; q < 2; ++q) { const f32x4 w = *(const LAS f32x4*)(WR + e * 1024 + 512 * h + 8 * F.lane + 4 * q); const int o = 8 * h + 4 * q;
                        s += (v[o] * w[0] + v[o + 1] * w[1]) + (v[o + 2] * w[2] + v[o + 3] * w[3]); }
                lg[e] = wave_sum(s); }
            int e0 = 0; float v0 = lg[0];
#pragma unroll
            for (int e = 1; e < 8; ++e) if (lg[e] > v0) { v0 = lg[e]; e0 = e; }
            int e1 = -1; float v1 = -3.0e38f;
#pragma unroll
            for (int e = 0; e < 8; ++e) if (e != e0 && lg[e] > v1) { v1 = lg[e]; e1 = e; }
            const float w1 = 1.f / (1.f + __expf(v0 - v1)), w0 = 1.f - w1;
            if (F.lane == 0) { SEL[2 * rl] = e0; SEL[2 * rl + 1] = e1; SELW[2 * rl] = w0; SELW[2 * rl + 1] = w1; EIDX[2 * m] = e0; EIDX[2 * m + 1] = e1; }
        }
        __syncthreads();
        const int mine = F.tid < 256 ? SEL[F.tid] : -1;
        int myrank = 0;
        if (F.wave < 4) {
#pragma unroll
            for (int e = 0; e < 8; ++e) { const unsigned long long mk = __ballot(mine == e); const int rk = __builtin_popcountll(mk & ((1ull << F.lane) - 1ull)); if (mine == e) myrank = rk;
                if (F.lane == 0) CW[F.wave * 8 + e] = __builtin_popcountll(mk); }
        }
        __syncthreads();
        if (F.tid < 8) { const int tot = CW[F.tid] + CW[8 + F.tid] + CW[16 + F.tid] + CW[24 + F.tid]; BASE[F.tid] = (int)__hip_atomic_fetch_add(gcnt + F.tid, (unsigned)tot, __ATOMIC_RELAXED, __HIP_MEMORY_SCOPE_AGENT); }
        __syncthreads();
        if (F.tid < 256) { int pos = BASE[mine] + myrank; for (int w = 0; w < F.wave; ++w) pos += CW[w * 8 + mine]; POS[blk * 256 + F.tid] = pos;
            TOK[(size_t)mine * M + pos] = blk * 128 + (F.tid >> 1); GW[(size_t)mine * M + pos] = SELW[F.tid]; }
        __syncthreads();
    }
}
__device__ __forceinline__ void hgrn_phase(Frame& F, const bf16_t* Q, const bf16_t* FP, const bf16_t* V, const float* lbparam, int jl, bf16_t* O) {
    constexpr int QST = 0, QS2 = 18432, KST = 36864, VS = 55296, SST0 = 64512, SSTB = 17408, SEG = 99328, RV = 103424, DV = 103936;
    constexpr int LQ = 136, LT = 72;
    LAS unsigned char* L = F.lds;
    const int tid = F.tid, lane = F.lane, w = F.wave, fr = lane & 15, fq = lane >> 4, qq = fr >> 2, pp = lane & 3;
    const int dp = tid & 63, seg = tid >> 6, d0 = 2 * dp;
    const int vrow = tid >> 3, vch = tid & 7;
    const int tt = w >> 1, eh = w & 1;
    for (int u = F.c; u < BATCH * HG_H * 2; u += F.G) {
        const int b = u >> 4, h = (u >> 1) & 7, vh = u & 1;
        float lb0 = 0.f, lb1 = 0.f;
        if (jl == 1) { const f32x2 l0 = *(const f32x2*)(lbparam + h * 128 + d0), l1 = *(const f32x2*)(lbparam + D + h * 128 + d0); lb0 = 1.f / (1.f + __expf(l0[0] - l1[0])); lb1 = 1.f / (1.f + __expf(l0[1] - l1[1])); }
        const float om0 = 1.f - lb0, om1 = 1.f - lb1;
        f32x4 St[4];
#pragma unroll
        for (int et = 0; et < 4; ++et) { St[et] = (f32x4){0.f, 0.f, 0.f, 0.f}; *(LAS u32x2*)(L + SST0 + ((16 * et + fr) * LQ + 16 * w + 4 * fq) * 2) = (u32x2){0u, 0u}; }
        const size_t ubase = (size_t)b * SEQ * D + h * 128;
        unsigned fpn[8], qn[8]; u32x4 vn;
        { const bf16_t* fp = FP + ubase + (size_t)(8 * seg) * D + d0; const bf16_t* qp = Q + ubase + (size_t)(8 * seg) * D + d0;
#pragma unroll
          for (int i = 0; i < 8; ++i) { fpn[i] = *(const unsigned*)(fp + (size_t)i * D); qn[i] = *(const unsigned*)(qp + (size_t)i * D); }
          vn = *(const u32x4*)(V + ubase + (size_t)vrow * D + vh * 64 + 8 * vch); }
        for (int ch = 0; ch < SEQ / HG_C; ++ch) {
            const size_t rowoff = ubase + (size_t)ch * HG_C * D;
            LAS unsigned char* SSTc = L + SST0 + (ch & 1) * SSTB; LAS unsigned char* SSTn = L + SST0 + ((ch + 1) & 1) * SSTB;
            float c0[8], c1[8], k0[8], k1[8], q0[8], q1[8];
            { float a0 = 0.f, a1 = 0.f;
#pragma unroll
              for (int i = 0; i < 8; ++i) { const float s0 = sigmoidf_(__uint_as_float(fpn[i] << 16)), s1 = sigmoidf_(__uint_as_float(fpn[i] & 0xffff0000u));
                  a0 += __logf(lb0 + om0 * s0); a1 += __logf(lb1 + om1 * s1); c0[i] = a0; c1[i] = a1; k0[i] = om0 * (1.f - s0); k1[i] = om1 * (1.f - s1);
                  q0[i] = __uint_as_float(qn[i] << 16); q1[i] = __uint_as_float(qn[i] & 0xffff0000u); }
              *(LAS f32x2*)(L + SEG + (seg * 128 + d0) * 4) = (f32x2){a0, a1};
              *(LAS u32x4*)(L + VS + (vrow * LT + 8 * vch) * 2) = vn; }
            __syncthreads();
            { float pre0 = 0.f, pre1 = 0.f, r0 = 0.f, r1 = 0.f, bl0 = 0.f, bl1 = 0.f;
#pragma unroll
              for (int s = 0; s < 8; ++s) { const f32x2 v = *(LAS f32x2*)(L + SEG + (s * 128 + d0) * 4);
                  if (s < seg) { pre0 += v[0]; pre1 += v[1]; } if (s < 4) { r0 += v[0]; r1 += v[1]; } bl0 += v[0]; bl1 += v[1]; }
              const float er0 = __expf(r0), er1 = __expf(r1);
              unsigned qa[4], qb[4], ka[4], xa[4], xb[4], kb[4];
#pragma unroll
              for (int i = 0; i < 8; i += 2) {
                  const float ba = pre0 + c0[i], bb = pre0 + c0[i + 1], bc = pre1 + c1[i], bd = pre1 + c1[i + 1];
                  const float qa0 = q0[i] * __expf(ba - r0), qa1 = q0[i + 1] * __expf(bb - r0), qb0 = q1[i] * __expf(bc - r1), qb1 = q1[i + 1] * __expf(bd - r1);
                  qa[i >> 1] = cvt_pk_bf16(qa0, qa1); qb[i >> 1] = cvt_pk_bf16(qb0, qb1);
                  xa[i >> 1] = cvt_pk_bf16(qa0 * er0, qa1 * er0); xb[i >> 1] = cvt_pk_bf16(qb0 * er1, qb1 * er1);
                  ka[i >> 1] = cvt_pk_bf16(k0[i] * __expf(r0 - ba), k0[i + 1] * __expf(r0 - bb)); kb[i >> 1] = cvt_pk_bf16(k1[i] * __expf(r1 - bc), k1[i + 1] * __expf(r1 - bd));
              }
              const int o0 = (d0 * LT + 8 * seg) * 2, o1 = o0 + LT * 2;
              *(LAS u32x4*)(L + QST + o0) = (u32x4){qa[0], qa[1], qa[2], qa[3]}; *(LAS u32x4*)(L + QST + o1) = (u32x4){qb[0], qb[1], qb[2], qb[3]};
              *(LAS u32x4*)(L + QS2 + o0) = (u32x4){xa[0], xa[1], xa[2], xa[3]}; *(LAS u32x4*)(L + QS2 + o1) = (u32x4){xb[0], xb[1], xb[2], xb[3]};
              *(LAS u32x4*)(L + KST + o0) = (u32x4){ka[0], ka[1], ka[2], ka[3]}; *(LAS u32x4*)(L + KST + o1) = (u32x4){kb[0], kb[1], kb[2], kb[3]};
              if (seg == 0) { *(LAS f32x2*)(L + RV + d0 * 4) = (f32x2){er0, er1}; *(LAS f32x2*)(L + DV + d0 * 4) = (f32x2){__expf(bl0 - r0), __expf(bl1 - r1)}; } }
            __syncthreads();
            if (ch + 1 < SEQ / HG_C) {
                const bf16_t* fp = FP + rowoff + (size_t)(HG_C + 8 * seg) * D + d0; const bf16_t* qp = Q + rowoff + (size_t)(HG_C + 8 * seg) * D + d0;
#pragma unroll
                for (int i = 0; i < 8; ++i) { fpn[i] = *(const unsigned*)(fp + (size_t)i * D); qn[i] = *(const unsigned*)(qp + (size_t)i * D); }
                vn = *(const u32x4*)(V + rowoff + (size_t)(HG_C + vrow) * D + vh * 64 + 8 * vch);
            }
            bf16x8 Pf[2];
            { f32x4 sc[4];
#pragma unroll
              for (int st = 0; st < 4; ++st) { sc[st] = (f32x4){0.f, 0.f, 0.f, 0.f};
                  if (st <= tt) {
#pragma unroll
                      for (int ks = 0; ks < 4; ++ks) {
                          const int ro = ((32 * ks + 8 * fq + qq) * LT + 4 * pp) * 2;
                          const s16x4 a0 = __builtin_amdgcn_ds_read_tr16_b64_v4i16((LAS s16x4*)(L + KST + ro + 32 * st)), a1 = __builtin_amdgcn_ds_read_tr16_b64_v4i16((LAS s16x4*)(L + KST + ro + 4 * LT * 2 + 32 * st));
                          const s16x4 b0 = __builtin_amdgcn_ds_read_tr16_b64_v4i16((LAS s16x4*)(L + QST + ro + 32 * tt)), b1 = __builtin_amdgcn_ds_read_tr16_b64_v4i16((LAS s16x4*)(L + QST + ro + 4 * LT * 2 + 32 * tt));
                          const bf16x8 av = (bf16x8){a0[0], a0[1], a0[2], a0[3], a1[0], a1[1], a1[2], a1[3]}, bv = (bf16x8){b0[0], b0[1], b0[2], b0[3], b1[0], b1[1], b1[2], b1[3]};
                          sc[st] = __builtin_amdgcn_mfma_f32_16x16x32_bf16(av, bv, sc[st], 0, 0, 0); }
#pragma unroll
                      for (int r = 0; r < 4; ++r) sc[st][r] = (16 * st + 4 * fq + r <= 16 * tt + fr) ? sc[st][r] : 0.f;
                  } }
              const u32x4 p0 = pack8(sc[0], sc[1]), p1 = pack8(sc[2], sc[3]); Pf[0] = __builtin_bit_cast(bf16x8, p0); Pf[1] = __builtin_bit_cast(bf16x8, p1); }
            { bf16x8 q2[4];
#pragma unroll
              for (int ks = 0; ks < 4; ++ks) { const int ro = ((32 * ks + 8 * fq + qq) * LT + 4 * pp) * 2 + 32 * tt;
                  const s16x4 b0 = __builtin_amdgcn_ds_read_tr16_b64_v4i16((LAS s16x4*)(L + QS2 + ro)), b1 = __builtin_amdgcn_ds_read_tr16_b64_v4i16((LAS s16x4*)(L + QS2 + ro + 4 * LT * 2));
                  q2[ks] = (bf16x8){b0[0], b0[1], b0[2], b0[3], b1[0], b1[1], b1[2], b1[3]}; }
#pragma unroll
              for (int ex = 0; ex < 2; ++ex) { const int et = 2 * eh + ex;
                  f32x4 acc = (f32x4){0.f, 0.f, 0.f, 0.f};
#pragma unroll
                  for (int k2 = 0; k2 < 2; ++k2) {
                      if (k2 == 0 || tt >= 2) {
                          const int ro = ((32 * k2 + 4 * fq + qq) * LT + 16 * et + 4 * pp) * 2;
                          const s16x4 a0 = __builtin_amdgcn_ds_read_tr16_b64_v4i16((LAS s16x4*)(L + VS + ro)), a1 = __builtin_amdgcn_ds_read_tr16_b64_v4i16((LAS s16x4*)(L + VS + ro + 16 * LT * 2));
                          const bf16x8 av = (bf16x8){a0[0], a0[1], a0[2], a0[3], a1[0], a1[1], a1[2], a1[3]};
                          acc = __builtin_amdgcn_mfma_f32_16x16x32_bf16(av, Pf[k2], acc, 0, 0, 0); } }
#pragma unroll
                  for (int ks = 0; ks < 4; ++ks) { const bf16x8 av = *(LAS bf16x8*)(SSTc + ((16 * et + fr) * LQ + 32 * ks + 8 * fq) * 2);
                      acc = __builtin_amdgcn_mfma_f32_16x16x32_bf16(av, q2[ks], acc, 0, 0, 0); }
                  u32x2 ov; ov.x = cvt_pk_bf16(acc[0], acc[1]); ov.y = cvt_pk_bf16(acc[2], acc[3]);
                  *(u32x2*)(O + rowoff + (size_t)(16 * tt + fr) * D + vh * 64 + 16 * et + 4 * fq) = ov;
              } }
            { const f32x4 rv = *(LAS f32x4*)(L + RV + (16 * w + 4 * fq) * 4), dv = *(LAS f32x4*)(L + DV + (16 * w + 4 * fq) * 4);
              bf16x8 kf[2];
#pragma unroll
              for (int ks = 0; ks < 2; ++ks) kf[ks] = *(LAS bf16x8*)(L + KST + ((16 * w + fr) * LT + 32 * ks + 8 * fq) * 2);
#pragma unroll
              for (int et = 0; et < 4; ++et) { St[et] = St[et] * rv;
#pragma unroll
                  for (int ks = 0; ks < 2; ++ks) { const int ro = ((32 * ks + 8 * fq + qq) * LT + 16 * et + 4 * pp) * 2;
                      const s16x4 b0 = __builtin_amdgcn_ds_read_tr16_b64_v4i16((LAS s16x4*)(L + VS + ro)), b1 = __builtin_amdgcn_ds_read_tr16_b64_v4i16((LAS s16x4*)(L + VS + ro + 4 * LT * 2));
                      const bf16x8 bb = (bf16x8){b0[0], b0[1], b0[2], b0[3], b1[0], b1[1], b1[2], b1[3]};
                      St[et] = __builtin_amdgcn_mfma_f32_16x16x32_bf16(kf[ks], bb, St[et], 0, 0, 0); }
                  St[et] = St[et] * dv;
                  u32x2 o; o.x = cvt_pk_bf16(St[et][0], St[et][1]); o.y = cvt_pk_bf16(St[et][2], St[et][3]);
                  *(LAS u32x2*)(SSTn + ((16 * et + fr) * LQ + 16 * w + 4 * fq) * 2) = o; } }
            __syncthreads();
        }
    }
}
__device__ __forceinline__ void hgrn_gate_phase(Frame& F, const bf16_t* O, const bf16_t* Gt, const float* ng, bf16_t* OG) {
    float gw_[16];
#pragma unroll
    for (int i = 0; i < 16; ++i) gw_[i] = ng[16 * F.lane + i];
    const int gw = F.c * NWAVES + F.wave, NGW = F.G * NWAVES;
    for (int m = gw; m < M; m += NGW) {
        const u32x4 o0 = *(const u32x4*)(O + (size_t)m * D + 16 * F.lane), o1 = *(const u32x4*)(O + (size_t)m * D + 16 * F.lane + 8);
        const u32x4 g0 = *(const u32x4*)(Gt + (size_t)m * D + 16 * F.lane), g1 = *(const u32x4*)(Gt + (size_t)m * D + 16 * F.lane + 8);
        float ov[16], gv[16];
#pragma unroll
        for (int i = 0; i < 4; ++i) { ov[2 * i] = __uint_as_float(o0[i] << 16); ov[2 * i + 1] = __uint_as_float(o0[i] & 0xffff0000u); ov[8 + 2 * i] = __uint_as_float(o1[i] << 16); ov[8 + 2 * i + 1] = __uint_as_float(o1[i] & 0xffff0000u);
            gv[2 * i] = __uint_as_float(g0[i] << 16); gv[2 * i + 1] = __uint_as_float(g0[i] & 0xffff0000u); gv[8 + 2 * i] = __uint_as_float(g1[i] << 16); gv[8 + 2 * i + 1] = __uint_as_float(g1[i] & 0xffff0000u); }
        float ss = 0.f;
#pragma unroll
        for (int i = 0; i < 16; ++i) ss += ov[i] * ov[i];
        ss += __builtin_bit_cast(float, __builtin_amdgcn_update_dpp(0, __builtin_bit_cast(int, ss), 0xB1, 0xF, 0xF, true));
        ss += __builtin_bit_cast(float, __builtin_amdgcn_update_dpp(0, __builtin_bit_cast(int, ss), 0x4E, 0xF, 0xF, true));
        ss += __builtin_bit_cast(float, __builtin_amdgcn_update_dpp(0, __builtin_bit_cast(int, ss), 0x141, 0xF, 0xF, true));
        const float rs = 1.f / sqrtf(ss * (1.f / 128.f) + RMS_EPS);
        float r[16];
#pragma unroll
        for (int i = 0; i < 16; ++i) r[i] = ov[i] * rs * gw_[i] * siluf_(gv[i]);
        u32x4 w0, w1; w0.x = cvt_pk_bf16(r[0], r[1]); w0.y = cvt_pk_bf16(r[2], r[3]); w0.z = cvt_pk_bf16(r[4], r[5]); w0.w = cvt_pk_bf16(r[6], r[7]);
        w1.x = cvt_pk_bf16(r[8], r[9]); w1.y = cvt_pk_bf16(r[10], r[11]); w1.z = cvt_pk_bf16(r[12], r[13]); w1.w = cvt_pk_bf16(r[14], r[15]);
        *(u32x4*)(OG + (size_t)m * D + 16 * F.lane) = w0; *(u32x4*)(OG + (size_t)m * D + 16 * F.lane + 8) = w1;
    }
}

__device__ __forceinline__ void dsa_norm_phase(Frame& F, const bf16_t* RAW, const float* qg, const float* kvg, const float* kig, const float* kib, bf16_t* CQ, bf16_t* CKV, bf16_t* KIDX, float* WIDX) {
    const f32x4 qgv = *(const f32x4*)(qg + 4 * F.lane), kvgv = *(const f32x4*)(kvg + 4 * F.lane); const float kg = kig[F.lane], kb = kib[F.lane];
    const int gw = F.c * NWAVES + F.wave, NGW = F.G * NWAVES;
    for (int m = gw; m < M; m += NGW) {
        const bf16_t* r = RAW + (size_t)m * DSA_IN_PAD;
        const u32x2 ar = *(const u32x2*)(r + 4 * F.lane), cr = *(const u32x2*)(r + 256 + 4 * F.lane); const float ki = bf2f(r[512 + F.lane]);
        const f32x4 a = (f32x4){__uint_as_float(ar.x << 16), __uint_as_float(ar.x & 0xffff0000u), __uint_as_float(ar.y << 16), __uint_as_float(ar.y & 0xffff0000u)};
        const f32x4 c = (f32x4){__uint_as_float(cr.x << 16), __uint_as_float(cr.x & 0xffff0000u), __uint_as_float(cr.y << 16), __uint_as_float(cr.y & 0xffff0000u)};
        const float sa = wave_sum((a[0] * a[0] + a[1] * a[1]) + (a[2] * a[2] + a[3] * a[3])), sc = wave_sum((c[0] * c[0] + c[1] * c[1]) + (c[2] * c[2] + c[3] * c[3]));
        const float ra = 1.f / sqrtf(sa * (1.f / 256.f) + RMS_EPS), rc = 1.f / sqrtf(sc * (1.f / 256.f) + RMS_EPS);
        u32x2 o; o.x = cvt_pk_bf16(a[0] * ra * qgv[0], a[1] * ra * qgv[1]); o.y = cvt_pk_bf16(a[2] * ra * qgv[2], a[3] * ra * qgv[3]); *(u32x2*)(CQ + (size_t)m * 256 + 4 * F.lane) = o;
        o.x = cvt_pk_bf16(c[0] * rc * kvgv[0], c[1] * rc * kvgv[1]); o.y = cvt_pk_bf16(c[2] * rc * kvgv[2], c[3] * rc * kvgv[3]); *(u32x2*)(CKV + (size_t)m * 256 + 4 * F.lane) = o;
        const float mu = wave_sum(ki) * (1.f / 64.f), dk = ki - mu, var = wave_sum(dk * dk) * (1.f / 64.f);
        KIDX[(size_t)m * 64 + F.lane] = f2bf(dk * (1.f / sqrtf(var + LN_EPS)) * kg + kb);
        if (F.lane < 8) WIDX[(size_t)m * 8 + F.lane] = bf2f(r[576 + F.lane]) * 0.04419417382415922f;
    }
}
__device__ __forceinline__ unsigned f2ord(float v) { const unsigned u = __float_as_uint(v); return (u & 0x80000000u) ? ~u : (u | 0x80000000u); }
__device__ __forceinline__ void dsa_index_phase(Frame& F, const bf16_t* QIDX, const bf16_t* KIDX, const float* WIDX, unsigned long long* MASK) {
    LAS float* SC = (LAS float*)F.lds;
    const int lane = F.lane, w = F.wave, fr = lane & 15, fq = lane >> 4;
    for (int i = 0;; ++i) {
        const int u = i * F.G + F.c; if (u >= BATCH * (SEQ / 16)) break;
        const int b = 2 * (u & 7) + ((u >> 3) & 1), qlo = ((u >> 4) & 15) + 16 * (u >> 9), qt = ((u >> 8) & 1) ? 127 - qlo : qlo, t0 = 16 * qt;     const size_t rb = (size_t)b * SEQ;
        bf16x8 Af[4][2][2]; float wv[4][8];
#pragma unroll
        for (int tg = 0; tg < 4; ++tg) {
#pragma unroll
            for (int hh = 0; hh < 2; ++hh)
#pragma unroll
                for (int ks = 0; ks < 2; ++ks) Af[tg][hh][ks] = *(const bf16x8*)(QIDX + (rb + t0 + 4 * tg + (fr >> 2)) * 512 + (4 * hh + (fr & 3)) * 64 + 32 * ks + 8 * fq);
            const f32x4 w0 = *(const f32x4*)(WIDX + (rb + t0 + 4 * tg + fq) * 8), w1 = *(const f32x4*)(WIDX + (rb + t0 + 4 * tg + fq) * 8 + 4);
#pragma unroll
            for (int r = 0; r < 4; ++r) { wv[tg][r] = w0[r]; wv[tg][4 + r] = w1[r]; }
        }
        bf16x8 nB0 = *(const bf16x8*)(KIDX + (rb + 16 * w + fr) * 64 + 8 * fq), nB1 = *(const bf16x8*)(KIDX + (rb + 16 * w + fr) * 64 + 32 + 8 * fq);
        for (int kg = w; kg <= qt; kg += NWAVES) {
            const bf16x8 B0 = nB0, B1 = nB1;
            { const int kn = (kg + NWAVES <= qt) ? kg + NWAVES : kg;
              nB0 = *(const bf16x8*)(KIDX + (rb + 16 * kn + fr) * 64 + 8 * fq); nB1 = *(const bf16x8*)(KIDX + (rb + 16 * kn + fr) * 64 + 32 + 8 * fq); }
#pragma unroll
            for (int tg = 0; tg < 4; ++tg) { float s = 0.f;
#pragma unroll
                for (int hh = 0; hh < 2; ++hh) { f32x4 acc = (f32x4){0.f, 0.f, 0.f, 0.f};
                    acc = __builtin_amdgcn_mfma_f32_16x16x32_bf16(Af[tg][hh][0], B0, acc, 0, 0, 0); acc = __builtin_amdgcn_mfma_f32_16x16x32_bf16(Af[tg][hh][1], B1, acc, 0, 0, 0);
#pragma unroll
                    for (int r = 0; r < 4; ++r) s += wv[tg][4 * hh + r] * fmaxf(acc[r], 0.f); }
                SC[(4 * tg + fq) * 2048 + 16 * kg + fr] = s + 0.0f; }
        }
        __syncthreads();
        for (int tq = 2 * w; tq < 2 * w + 2; ++tq) {
            const int t = t0 + tq;
            unsigned key[32];
#pragma unroll
            for (int r = 0; r < 32; ++r) { const int s = 64 * r + lane; key[r] = (s <= t) ? f2ord(SC[tq * 2048 + s]) : 0u; }
            unsigned long long selw = 0ull;
            if (t < TOPK) {
#pragma unroll
                for (int r = 0; r < 32; ++r) { const unsigned long long mk = __ballot(64 * r + lane <= t); if (lane == r) selw = mk; }
            } else {
                unsigned prefix = 0u; bool exact = false;
                for (int bit = 31; bit >= 0; --bit) {
                    const unsigned cand = prefix | (1u << bit); int cnt = 0;
#pragma unroll
                    for (int r = 0; r < 32; ++r) cnt += __builtin_popcountll(__ballot(key[r] >= cand));
                    if (cnt >= TOPK) { prefix = cand; if (cnt == TOPK) { exact = true; break; } }
                }
                if (exact) {
#pragma unroll
                    for (int r = 0; r < 32; ++r) { const unsigned long long mk = __ballot(key[r] >= prefix); if (lane == r) selw = mk; }
                } else {
                    int ngt = 0;
#pragma unroll
                    for (int r = 0; r < 32; ++r) ngt += __builtin_popcountll(__ballot(key[r] > prefix));
                    const int need = TOPK - ngt; int run = 0;
#pragma unroll
                    for (int r = 0; r < 32; ++r) { const unsigned long long tie = __ballot(key[r] == prefix); const int rk = run + __builtin_popcountll(tie & ((1ull << lane) - 1ull));
                        const unsigned long long mk = __ballot(key[r] > prefix || (key[r] == prefix && rk < need)); if (lane == r) selw = mk; run += __builtin_popcountll(tie); }
                }
            }
            if (lane < 32) MASK[(rb + t) * 32 + lane] = selw;
        }
        __syncthreads();
    }
}
__device__ __forceinline__ void dsa_attn_phase(Frame& F, const bf16_t* QLAT, const bf16_t* CKV, const unsigned long long* MASK, bf16_t* OLAT, unsigned char* OLAT8) {
    constexpr int TB = 32768;
    LAS unsigned char* L = F.lds;
    const int lane = F.lane, w = F.wave, fr = lane & 15, fq = lane >> 4;
    const int qq = fr >> 2, pp = lane & 3;
    const bool grpB = w >= 4;
    const int kbase = fr * 512, ysh = (fq ^ (2 * (fr & 7))) << 4;
    const int x2s = (2 * (4 * (fq & 1) + qq)) << 4;
    const int vbase = (4 * fq + qq) * 512 + (pp >> 1) * 16 + (pp & 1) * 8;
    const int drow = lane >> 5, dpc = lane & 31;
    for (int i = 0;; ++i) {
        const int u = i * F.G + F.c; if (u >= BATCH * (SEQ / 16)) break;
        const int b = 2 * (u & 7) + ((u >> 3) & 1), qlo = ((u >> 4) & 15) + 16 * (u >> 9), qt = ((u >> 8) & 1) ? 127 - qlo : qlo, t0 = 16 * qt;     const size_t rb = (size_t)b * SEQ;
        const int ntiles = (t0 + 15) / 64 + 1;
        bf16x8 Qf[8];
#pragma unroll
        for (int ks = 0; ks < 8; ++ks) Qf[ks] = *(const bf16x8*)(QLAT + (rb + t0 + fr) * 2048 + w * 256 + 32 * ks + 8 * fq);
        f32x4 Ot[16];
#pragma unroll
        for (int cb = 0; cb < 16; ++cb) Ot[cb] = (f32x4){0.f, 0.f, 0.f, 0.f};
        float mrun = -1.0e30f, lsum = 0.f;
        bf16x8 Pf[2];
#define ATT_DMA(kt_, buf_) do { _Pragma("unroll") for (int q_ = 0; q_ < 4; ++q_) { const int row_ = 2 * (4 * w + q_) + drow; \
            __builtin_amdgcn_global_load_lds((const unsigned*)(CKV + (rb + 64 * (kt_) + row_) * 256 + 8 * (dpc ^ (2 * (row_ & 7)))), (LAS unsigned*)(L + (buf_) * TB + (4 * w + q_) * 1024), 16, 0, 0); } } while (0)
#define ATT_ST(buf_) do { int ka_[8]; { const int kb_t_ = kbase + (buf_) * TB; _Pragma("unroll") for (int ks = 0; ks < 8; ++ks) ka_[ks] = kb_t_ + ((64 * ks) ^ ysh); } \
            _Pragma("unroll") for (int kb = 0; kb < 4; ++kb) S[kb] = (f32x4){0.f, 0.f, 0.f, 0.f}; \
            bf16x8 kf[2][2]; \
            _Pragma("unroll") for (int j = 0; j < 2; ++j) kf[0][j] = *(LAS bf16x8*)(L + ka_[j]); \
            _Pragma("unroll") for (int bt = 0; bt < 16; ++bt) {        \
                if (bt + 1 < 16) { _Pragma("unroll") for (int j = 0; j < 2; ++j) kf[(bt + 1) & 1][j] = *(LAS bf16x8*)(L + ka_[2 * ((bt + 1) & 3) + j] + 8192 * ((bt + 1) >> 2)); } \
                _Pragma("unroll") for (int j = 0; j < 2; ++j) S[bt >> 2] = __builtin_amdgcn_mfma_f32_16x16x32_bf16(kf[bt & 1][j], Qf[2 * (bt & 3) + j], S[bt >> 2], 0, 0, 0); \
                __builtin_amdgcn_sched_barrier(0); } } while (0)
#define ATT_SOFTMAX(mw_) do { \
            float mx = fmaxf(fmaxf(fmaxf(S[0][0], S[0][1]), fmaxf(S[0][2], S[0][3])), fmaxf(fmaxf(S[1][0], S[1][1]), fmaxf(S[1][2], S[1][3]))); \
            mx = fmaxf(mx, fmaxf(fmaxf(fmaxf(S[2][0], S[2][1]), fmaxf(S[2][2], S[2][3])), fmaxf(fmaxf(S[3][0], S[3][1]), fmaxf(S[3][2], S[3][3])))); \
            mx = fmaxf(mx, __shfl_xor(mx, 16)); mx = fmaxf(mx, __shfl_xor(mx, 32)); \
            const bool need = mx > mrun + 8.0f; \
            if (__any(need)) { const float mnew = need ? mx : mrun, alpha = fast_exp2(mrun - mnew); mrun = mnew; lsum *= alpha; \
                _Pragma("unroll") for (int cb = 0; cb < 16; ++cb) Ot[cb] = Ot[cb] * alpha; } \
            const unsigned long long mq = (mw_) >> (4 * fq); const unsigned mlo = (unsigned)mq, mhi = (unsigned)(mq >> 32); \
            _Pragma("unroll") for (int kb = 0; kb < 4; ++kb) _Pragma("unroll") for (int r = 0; r < 4; ++r) { \
                const unsigned mk = (unsigned)__builtin_amdgcn_sbfe((int)(kb < 2 ? mlo : mhi), 16 * (kb & 1) + r, 1); \
                const float pv = __uint_as_float(__float_as_uint(fast_exp2(S[kb][r] - mrun)) & mk); S[kb][r] = pv; lsum += pv; } \
            _Pragma("unroll") for (int s2 = 0; s2 < 2; ++s2) { const u32x4 pk = pack8(S[2 * s2], S[2 * s2 + 1]); Pf[s2] = __builtin_bit_cast(bf16x8, pk); } } while (0)
#define ATT_VLOAD(dst, vb_, cb_) do { const int va_ = (vb_) + ((32 * (cb_)) ^ x2s); \
            dst[0] = __builtin_amdgcn_ds_read_tr16_b64_v4i16((LAS s16x4*)(L + va_)); dst[1] = __builtin_amdgcn_ds_read_tr16_b64_v4i16((LAS s16x4*)(L + va_ + 16 * 512)); \
            dst[2] = __builtin_amdgcn_ds_read_tr16_b64_v4i16((LAS s16x4*)(L + va_ + 32 * 512)); dst[3] = __builtin_amdgcn_ds_read_tr16_b64_v4i16((LAS s16x4*)(L + va_ + 48 * 512)); } while (0)
#define ATT_PV(buf_) do { const int vb_ = vbase + (buf_) * TB; s16x4 tv[2][4]; ATT_VLOAD(tv[0], vb_, 0); \
            _Pragma("unroll") for (int cb = 0; cb < 16; ++cb) { \
                if (cb + 1 < 16) ATT_VLOAD(tv[(cb + 1) & 1], vb_, cb + 1); \
                const s16x4 a0 = tv[cb & 1][0], a1 = tv[cb & 1][1], a2 = tv[cb & 1][2], a3 = tv[cb & 1][3]; \
                const bf16x8 v0 = (bf16x8){a0[0], a0[1], a0[2], a0[3], a1[0], a1[1], a1[2], a1[3]}; \
                const bf16x8 v1 = (bf16x8){a2[0], a2[1], a2[2], a2[3], a3[0], a3[1], a3[2], a3[3]}; \
                Ot[cb] = __builtin_amdgcn_mfma_f32_16x16x32_bf16(v0, Pf[0], Ot[cb], 0, 0, 0); \
                Ot[cb] = __builtin_amdgcn_mfma_f32_16x16x32_bf16(v1, Pf[1], Ot[cb], 0, 0, 0); __builtin_amdgcn_sched_barrier(0); } } while (0)
        ATT_DMA(0, 0);
        unsigned long long mwn = MASK[(rb + t0 + fr) * 32];
        asm volatile("s_waitcnt vmcnt(0)" ::: "memory");
        __syncthreads();
        int bufc = 0;
        for (int it = 0; it < ntiles; ++it) {
            const int bufn = (bufc == 2) ? 0 : bufc + 1;
            if (it + 1 < ntiles) ATT_DMA(it + 1, bufn);
            const unsigned long long mw = mwn; mwn = MASK[(rb + t0 + fr) * 32 + ((it + 1 < ntiles) ? it + 1 : it)];
            f32x4 S[4];
            ATT_ST(bufc); ATT_SOFTMAX(mw);
            if (grpB) { asm volatile("s_waitcnt vmcnt(0)" ::: "memory"); __builtin_amdgcn_s_barrier(); asm volatile("" ::: "memory"); }
            ATT_PV(bufc);
            if (!grpB) { asm volatile("s_waitcnt vmcnt(0)" ::: "memory"); __builtin_amdgcn_s_barrier(); asm volatile("" ::: "memory"); }
            bufc = bufn;
        }
        __syncthreads();
#undef ATT_DMA
#undef ATT_ST
#undef ATT_SOFTMAX
#undef ATT_VLOAD
#undef ATT_PV
        lsum += __shfl_xor(lsum, 16); lsum += __shfl_xor(lsum, 32);
        const float inv = 1.f / lsum;
#pragma unroll
        for (int cb = 0; cb < 16; ++cb) {
            if (OLAT8) { const float i8 = inv * F8_O; *(unsigned*)(OLAT8 + (rb + t0 + fr) * 2048 + w * 256 + 16 * cb + 4 * fq) = pack4_fp8(Ot[cb][0] * i8, Ot[cb][1] * i8, Ot[cb][2] * i8, Ot[cb][3] * i8); }
            else { u32x2 o; o.x = cvt_pk_bf16(Ot[cb][0] * inv, Ot[cb][1] * inv); o.y = cvt_pk_bf16(Ot[cb][2] * inv, Ot[cb][3] * inv);
                *(u32x2*)(OLAT + (rb + t0 + fr) * 2048 + w * 256 + 16 * cb + 4 * fq) = o; } }
    }
}


__device__ __forceinline__ void dsa_norm8_phase(Frame& F, const bf16_t* RAW, const float* qg, const float* kvg, const float* kig, const float* kib, bf16_t* CQ, unsigned char* CKV8, unsigned char* CKVT8, bf16_t* KIDX, float* WIDX) {
    LAS unsigned char* T = F.lds;
    const f32x4 qgv = *(const f32x4*)(qg + 4 * F.lane), kvgv = *(const f32x4*)(kvg + 4 * F.lane); const float kg = kig[F.lane], kb = kib[F.lane];
    for (int blk = F.c; blk < M / 128; blk += F.G) {
        for (int rr = 0; rr < 16; ++rr) {
            const int rl = 16 * F.wave + rr, m = 128 * blk + rl;
            const bf16_t* r = RAW + (size_t)m * DSA_IN_PAD;
            const u32x2 ar = *(const u32x2*)(r + 4 * F.lane), cr = *(const u32x2*)(r + 256 + 4 * F.lane); const float ki = bf2f(r[512 + F.lane]);
            const f32x4 a = (f32x4){__uint_as_float(ar.x << 16), __uint_as_float(ar.x & 0xffff0000u), __uint_as_float(ar.y << 16), __uint_as_float(ar.y & 0xffff0000u)};
            const f32x4 c = (f32x4){__uint_as_float(cr.x << 16), __uint_as_float(cr.x & 0xffff0000u), __uint_as_float(cr.y << 16), __uint_as_float(cr.y & 0xffff0000u)};
            const float sa = wave_sum((a[0] * a[0] + a[1] * a[1]) + (a[2] * a[2] + a[3] * a[3])), sc = wave_sum((c[0] * c[0] + c[1] * c[1]) + (c[2] * c[2] + c[3] * c[3]));
            const float ra = 1.f / sqrtf(sa * (1.f / 256.f) + RMS_EPS), rc = F8_KV / sqrtf(sc * (1.f / 256.f) + RMS_EPS);
            u32x2 o; o.x = cvt_pk_bf16(a[0] * ra * qgv[0], a[1] * ra * qgv[1]); o.y = cvt_pk_bf16(a[2] * ra * qgv[2], a[3] * ra * qgv[3]); *(u32x2*)(CQ + (size_t)m * 256 + 4 * F.lane) = o;
            const unsigned c8 = pack4_fp8(c[0] * rc * kvgv[0], c[1] * rc * kvgv[1], c[2] * rc * kvgv[2], c[3] * rc * kvgv[3]);
            *(unsigned*)(CKV8 + (size_t)m * 256 + 4 * F.lane) = c8; *(LAS unsigned*)(T + rl * 260 + 4 * F.lane) = c8;
            const float mu = wave_sum(ki) * (1.f / 64.f), dk = ki - mu, var = wave_sum(dk * dk) * (1.f / 64.f);
            KIDX[(size_t)m * 64 + F.lane] = f2bf(dk * (1.f / sqrtf(var + LN_EPS)) * kg + kb);
            if (F.lane < 8) WIDX[(size_t)m * 8 + F.lane] = bf2f(r[576 + F.lane]) * 0.04419417382415922f;
        }
        __syncthreads();
        { const int dim = F.tid >> 1, half = F.tid & 1;
          unsigned char* dst = CKVT8 + (size_t)blk * 32768 + dim * 128 + 64 * half;
#pragma unroll
          for (int q4 = 0; q4 < 4; ++q4) { u32x4 o;
#pragma unroll
              for (int dd = 0; dd < 4; ++dd) { const int d = 4 * q4 + dd, key0 = 16 * (d & 7) + 4 * (2 * half + (d >> 3));
                  LAS unsigned char* tp = T + key0 * 260 + dim;
                  o[dd] = (unsigned)tp[0] | ((unsigned)tp[260] << 8) | ((unsigned)tp[520] << 16) | ((unsigned)tp[780] << 24); }
              *(u32x4*)(dst + 16 * q4) = o; } }
        __syncthreads();
    }
}
__device__ __forceinline__ void dsa_attn8_phase(Frame& F, const unsigned char* QLAT8, const unsigned char* CKV8, const unsigned char* CKVT8, const unsigned long long* MASK, unsigned char* OLAT8) {
    constexpr int TB = 65536, VOFF = 32768;
    LAS unsigned char* L = F.lds;
    const int lane = F.lane, w = F.wave, fr = lane & 15, fq = lane >> 4;
    const int gsw = ((fr >> 1) & 1) | (((fr >> 3) & 1) << 2);
    const int ka00 = fr * 256 + (((2 * fq) ^ fr) << 4), ka01 = fr * 256 + (((2 * fq + 1) ^ fr) << 4), ka10 = fr * 256 + (((8 + 2 * fq) ^ fr) << 4), ka11 = fr * 256 + (((9 + 2 * fq) ^ fr) << 4);
    const int va0 = VOFF + fr * 128 + (((2 * fq) ^ gsw) << 4), va1 = VOFF + fr * 128 + (((2 * fq + 1) ^ gsw) << 4);
    for (int i = 0;; ++i) {
        const int u = i * F.G + F.c; if (u >= BATCH * (SEQ / 16)) break;
        const int b = 2 * (u & 7) + ((u >> 3) & 1), qlo = ((u >> 4) & 15) + 16 * (u >> 9), qt = ((u >> 8) & 1) ? 127 - qlo : qlo, t0 = 16 * qt;     const size_t rb = (size_t)b * SEQ;
        const int ntiles = (t0 + 15) / 128 + 1;
        int lu = lane; asm volatile("" : "+v"(lu)); const int fru = lu & 15, fqu = lu >> 4;
        v8i32 Q8[2];
#pragma unroll
        for (int h = 0; h < 2; ++h) { const unsigned char* qp = QLAT8 + (rb + t0 + fru) * 2048 + w * 256 + 128 * h + 32 * fqu;
            Q8[h] = __builtin_shufflevector(*(const v4i32*)qp, *(const v4i32*)(qp + 16), 0, 1, 2, 3, 4, 5, 6, 7); }
        f32x4 Ot[16];
#pragma unroll
        for (int cb = 0; cb < 16; ++cb) Ot[cb] = (f32x4){0.f, 0.f, 0.f, 0.f};
        float mrun = 0.f; bool seen = false; f32x4 negm = (f32x4){0.f, 0.f, 0.f, 0.f}, Ls = (f32x4){0.f, 0.f, 0.f, 0.f};
        const v8i32 ONES8 = (v8i32){0x38383838, 0x38383838, 0x38383838, 0x38383838, 0x38383838, 0x38383838, 0x38383838, 0x38383838};
#define ATT_DMA(kt_, buf_) do { int ln_ = lane; asm volatile("" : "+v"(ln_)); const unsigned char* kp_ = CKV8 + (rb + 128 * (kt_) + 16 * w) * 256; const unsigned char* vp_ = CKVT8 + ((rb >> 7) + (kt_)) * 32768 + w * 4096; \
        _Pragma("unroll") for (int q_ = 0; q_ < 4; ++q_) { const int ins_ = 4 * w + q_, rl_ = 4 * q_ + (ln_ >> 4), g_ = ((ln_ >> 4) & 1) | ((q_ & 1) << 2); \
            __builtin_amdgcn_global_load_lds((const unsigned*)(kp_ + (unsigned)(rl_ * 256 + 16 * ((ln_ & 15) ^ rl_))), (LAS unsigned*)(L + (buf_) * TB + ins_ * 1024), 16, 0, 0); \
            __builtin_amdgcn_global_load_lds((const unsigned*)(vp_ + (unsigned)(q_ * 1024 + (ln_ >> 3) * 128 + 16 * ((ln_ & 7) ^ g_))), (LAS unsigned*)(L + (buf_) * TB + VOFF + ins_ * 1024), 16, 0, 0); } } while (0)
#define ATT_KLOAD(dst, kb_o_) do { dst[0] = *(LAS v4i32*)(L + ka00 + (kb_o_)); dst[1] = *(LAS v4i32*)(L + ka01 + (kb_o_)); dst[2] = *(LAS v4i32*)(L + ka10 + (kb_o_)); dst[3] = *(LAS v4i32*)(L + ka11 + (kb_o_)); } while (0)
#define ATT_VLOAD(dst, vb_o_) do { dst[0] = *(LAS v4i32*)(L + va0 + (vb_o_)); dst[1] = *(LAS v4i32*)(L + va1 + (vb_o_)); } while (0)
        ATT_DMA(0, 0);
        const unsigned long long* mrow = MASK + (rb + t0 + fru) * 32;
        u32x4 mwn = *(const u32x4*)mrow;
        asm volatile("s_waitcnt vmcnt(0)" ::: "memory");
        __syncthreads();
        int bufc = 0;
        for (int it = 0; it < ntiles; ++it) {
            const int bo = bufc * TB;
            if (it + 1 < ntiles) ATT_DMA(it + 1, bufc ^ 1);
            const u32x4 mw = mwn; mwn = *(const u32x4*)(mrow + 2 * ((it + 1 < ntiles) ? it + 1 : it));
            f32x4 S[8];
            { v4i32 kf[2][4]; ATT_KLOAD(kf[0], bo);
#pragma unroll
              for (int kb = 0; kb < 8; ++kb) {
                  if (kb + 1 < 8) ATT_KLOAD(kf[(kb + 1) & 1], bo + 4096 * (kb + 1));
                  f32x4 s = __builtin_amdgcn_mfma_scale_f32_16x16x128_f8f6f4(__builtin_shufflevector(kf[kb & 1][0], kf[kb & 1][1], 0, 1, 2, 3, 4, 5, 6, 7), Q8[0], negm, 0, 0, 0, SC_S, 0, 0x7f7f7f7f);
                  s = __builtin_amdgcn_mfma_scale_f32_16x16x128_f8f6f4(__builtin_shufflevector(kf[kb & 1][2], kf[kb & 1][3], 0, 1, 2, 3, 4, 5, 6, 7), Q8[1], s, 0, 0, 0, SC_S, 0, 0x7f7f7f7f);
                  S[kb] = s; __builtin_amdgcn_sched_barrier(0); } }
            const unsigned m0 = mw[0] >> (4 * fq), m1 = mw[1] >> (4 * fq), m2 = mw[2] >> (4 * fq), m3 = mw[3] >> (4 * fq);
            { float mx = __builtin_fmaxf(__builtin_fmaxf(S[0][0], S[0][1]), __builtin_fmaxf(S[0][2], S[0][3]));
#pragma unroll
              for (int kb = 1; kb < 8; ++kb) { mx = __builtin_fmaxf(__builtin_fmaxf(S[kb][0], S[kb][1]), mx); mx = __builtin_fmaxf(__builtin_fmaxf(S[kb][2], S[kb][3]), mx); }
              if (__any(!seen || mx > 8.0f)) {
                  float mm = -3.0e38f;
#pragma unroll
                  for (int kb = 0; kb < 8; ++kb) { const unsigned mw_ = (kb >> 1) == 0 ? m0 : (kb >> 1) == 1 ? m1 : (kb >> 1) == 2 ? m2 : m3;
#pragma unroll
                      for (int r = 0; r < 4; ++r) mm = ((mw_ >> (16 * (kb & 1) + r)) & 1u) ? __builtin_fmaxf(mm, S[kb][r]) : mm; }
                  mm = fmaxf(mm, __shfl_xor(mm, 16)); mm = fmaxf(mm, __shfl_xor(mm, 32));
                  const bool has = mm > -1.0e38f, rebase = has && (!seen || mm > 8.0f);
                  const float delta = rebase ? mm : 0.f, alpha = (rebase && seen) ? fast_exp2(-delta) : 1.f;
                  seen = seen || has;
                  mrun += delta; negm = (f32x4){-mrun, -mrun, -mrun, -mrun}; Ls = Ls * alpha;
#pragma unroll
                  for (int cb = 0; cb < 16; ++cb) Ot[cb] = Ot[cb] * alpha;
#pragma unroll
                  for (int kb = 0; kb < 8; ++kb) S[kb] = S[kb] - delta; } }
            v8i32 P8;
            {
#pragma unroll
              for (int kb = 0; kb < 8; ++kb) { const unsigned mm = (kb >> 1) == 0 ? m0 : (kb >> 1) == 1 ? m1 : (kb >> 1) == 2 ? m2 : m3;
                  int pk = 0; pk = __builtin_amdgcn_cvt_pk_fp8_f32(fast_exp2(S[kb][0]), fast_exp2(S[kb][1]), pk, false); pk = __builtin_amdgcn_cvt_pk_fp8_f32(fast_exp2(S[kb][2]), fast_exp2(S[kb][3]), pk, true);
                  const unsigned y = (((mm >> (16 * (kb & 1))) & 0xFu) * 0x204081u) & 0x01010101u;
                  P8[kb] = pk & (int)((y << 8) - y); } }
            Ls = __builtin_amdgcn_mfma_scale_f32_16x16x128_f8f6f4(ONES8, P8, Ls, 0, 0, 0, 0x7f7f7f7f, 0, 0x7f7f7f7f);
            { v4i32 vf[2][2]; ATT_VLOAD(vf[0], bo);
#pragma unroll
              for (int cb = 0; cb < 16; ++cb) {
                  if (cb + 1 < 16) ATT_VLOAD(vf[(cb + 1) & 1], bo + 2048 * (cb + 1));
                  Ot[cb] = __builtin_amdgcn_mfma_scale_f32_16x16x128_f8f6f4(__builtin_shufflevector(vf[cb & 1][0], vf[cb & 1][1], 0, 1, 2, 3, 4, 5, 6, 7), P8, Ot[cb], 0, 0, 0, SC_V, 0, 0x7f7f7f7f);
                  __builtin_amdgcn_sched_barrier(0); } }
            asm volatile("s_waitcnt vmcnt(0)" ::: "memory"); __builtin_amdgcn_s_barrier(); asm volatile("" ::: "memory");
            bufc ^= 1;
        }
#undef ATT_DMA
#undef ATT_KLOAD
#undef ATT_VLOAD
        const float i8 = F8_O / Ls[0];
#pragma unroll
        for (int cb = 0; cb < 16; ++cb)
            *(unsigned*)(OLAT8 + (rb + t0 + fru) * 2048 + w * 256 + 16 * cb + 4 * fqu) = pack4_fp8(Ot[cb][0] * i8, Ot[cb][1] * i8, Ot[cb][2] * i8, Ot[cb][3] * i8);
    }
}

constexpr int PH_PER_PAIR = 18, N_PHASES = 1 + 2 * PH_PER_PAIR;

__global__ void __launch_bounds__(NTHREADS, 2) fwd_kernel(Params p) {
    extern __shared__ __attribute__((aligned(16))) unsigned char lds_raw[];
    Frame F;
    F.lds = (LAS unsigned char*)lds_raw;
    F.tid = threadIdx.x; F.lane = F.tid & 63; F.wave = __builtin_amdgcn_readfirstlane(F.tid >> 6);
    F.G = gridDim.x; F.c = blockIdx.x;
    unsigned char* ws = p.ws;
    F.ctl = (unsigned*)(ws + WS_CTL);
    for (int u = F.tid; u < (LDS_BYTES - LDSCTL_OFF) / 4; u += NTHREADS) ((LAS unsigned*)(F.lds + LDSCTL_OFF))[u] = 0u;
    __syncthreads();
    const bool one_launch = (p.ph_hi - p.ph_lo) > 1;
    XcdBarrier bar; bar.bar = F.ctl + CW_BAR; bar.x = 0; bar.st = nullptr;
    if (one_launch) bar = xcd_barrier_post(F.ctl + CW_BAR, (volatile LAS unsigned*)(F.lds + MISC_OFF) + 8);
    const int lo = p.ph_lo, hi = p.ph_hi;
#define REFRESH() do { int t_ = threadIdx.x; asm volatile("" : "+v"(t_)); F.tid = t_; F.lane = t_ & 63; F.wave = __builtin_amdgcn_readfirstlane(t_ >> 6); } while (0)
#ifndef DBLMASK
#define DBLMASK 0u
#endif
#define REP(b) for (int rep_ = 0; rep_ < 1 + (int)((DBLMASK >> (b)) & 1u); ++rep_)
#define IN(k) (lo <= (k) && (k) < hi)
#ifndef MK_BARTIME
#define MK_BARTIME 0
#endif
    unsigned long long bt_acc = 0ull;
#if MK_BARTIME
#define SEAM(k) do { if (IN(k) && IN((k) + 1)) { const unsigned long long t0_ = __builtin_amdgcn_s_memrealtime(); xcd_barrier(bar); bt_acc += __builtin_amdgcn_s_memrealtime() - t0_; } } while (0)
#else
#ifndef MK_DBLSEAM
#define MK_DBLSEAM 0
#endif
#define SEAM(k) do { if (IN(k) && IN((k) + 1)) { xcd_barrier(bar); if (MK_DBLSEAM) xcd_barrier(bar); } } while (0)
#endif

    bf16_t* XB = (bf16_t*)(ws + WS_XB); bf16_t* Y = (bf16_t*)(ws + WS_Y);
    unsigned char* A = ws + WS_A; bf16_t* Hb = (bf16_t*)(ws + WS_H);

    if (IN(0)) REP(31) { REFRESH(); p0_prologue(F, p); } SEAM(0);

    for (int j = 0; j < 2; ++j) {
        const int pb = 1 + j * PH_PER_PAIR;
        const int layerA = 2 * j, layerB = 2 * j + 1;
        if (IN(pb + 0)) REP(0) {
            Gemm g{XB, (const bf16_t*)(ws + WS_W_HGIN) + (size_t)j * 4 * D * D, D}; StaticOrder S; S.init(M, 4 * D, F.G, F.c);
            EpiHgIn E{(bf16_t*)(A + A_HQ)};
            gemm_phase(F.lds, g, S, E);
        } SEAM(pb + 0);
        if (IN(pb + 1)) REP(1) { REFRESH(); hgrn_phase(F, (const bf16_t*)(A + A_HQ), (const bf16_t*)(A + A_HF), (const bf16_t*)(A + A_HV), INP(IN_HGLB), j, (bf16_t*)(A + A_HO)); } SEAM(pb + 1);
        if (IN(pb + 2)) REP(2) { REFRESH(); hgrn_gate_phase(F, (const bf16_t*)(A + A_HO), (const bf16_t*)(A + A_HG), INP(IN_HGNG) + (size_t)j * D, (bf16_t*)(A + A_HOG)); } SEAM(pb + 2);
        if (IN(pb + 3)) REP(3) {
            Gemm g{(const bf16_t*)(A + A_HOG), (const bf16_t*)(ws + WS_W_HGOUT) + (size_t)j * D * D, D}; StaticOrder S; S.init(M, D, F.G, F.c);
            EpiRes E{XB, Y}; gemm_phase(F.lds, g, S, E);
        } SEAM(pb + 3);
        if (IN(pb + 4)) REP(4) { REFRESH(); ln_phase(F, Y, INP(IN_LNG) + (size_t)(layerA * 2 + 0) * D, INP(IN_LNB) + (size_t)(layerA * 2 + 0) * D, XB, (MK_FFN_FP8 == 2) ? ws + WS_XB8 : nullptr); } SEAM(pb + 4);
        if (IN(pb + 5)) REP(5) {
#if MK_FFN_FP8 == 2
            Gemm g{(const bf16_t*)(ws + WS_XB8), (const bf16_t*)(ws + WS_W_FGU + (size_t)j * 2 * DFF * D), D / 2, SC_UP}; StaticOrder S; S.init(M, 2 * DFF, F.G, F.c);
            EpiSwiglu8 E{(unsigned char*)Hb}; gemm_phase_gather<true, true>(F.lds, g, S, E, nullptr);
#elif MK_FFN_FP8 == 1
            Gemm g{XB, (const bf16_t*)(ws + WS_W_FGU) + (size_t)j * 2 * DFF * D, D}; StaticOrder S; S.init(M, 2 * DFF, F.G, F.c);
            EpiSwiglu8 E{(unsigned char*)Hb}; gemm_phase(F.lds, g, S, E);
#else
            Gemm g{XB, (const bf16_t*)(ws + WS_W_FGU) + (size_t)j * 2 * DFF * D, D}; StaticOrder S; S.init(M, 2 * DFF, F.G, F.c);
            EpiSwiglu E{Hb}; gemm_phase(F.lds, g, S, E);
#endif
        } SEAM(pb + 5);
        if (IN(pb + 6)) REP(6) {
#if MK_FFN_FP8 >= 1
            Gemm g{Hb, (const bf16_t*)(ws + WS_W_FDN + (size_t)j * D * DFF), DFF / 2, SC_DN}; StaticOrder S; S.init(M, D, F.G, F.c);
            EpiRes E{XB, Y}; gemm_phase_gather<true, true>(F.lds, g, S, E, nullptr);
#else
            Gemm g{Hb, (const bf16_t*)(ws + WS_W_FDN) + (size_t)j * D * DFF, DFF}; StaticOrder S; S.init(M, D, F.G, F.c);
            EpiRes E{XB, Y}; gemm_phase(F.lds, g, S, E);
#endif
        } SEAM(pb + 6);
        if (IN(pb + 7)) REP(7) { REFRESH(); ln_phase(F, Y, INP(IN_LNG) + (size_t)(layerA * 2 + 1) * D, INP(IN_LNB) + (size_t)(layerA * 2 + 1) * D, XB, nullptr); } SEAM(pb + 7);
        if (IN(pb + 8)) REP(8) {
            Gemm g{XB, (const bf16_t*)(ws + WS_W_DIN) + (size_t)j * DSA_IN_PAD * D, D}; StaticOrder S; S.init(M, DSA_IN_PAD, F.G, F.c);
            EpiBf16 E{(bf16_t*)(A + A_RAW), DSA_IN_PAD}; gemm_phase(F.lds, g, S, E);
        } SEAM(pb + 8);
#if MK_ATT_FP8
        if (IN(pb + 9)) REP(9) { REFRESH(); dsa_norm8_phase(F, (const bf16_t*)(A + A_RAW), INP(IN_DQNG) + (size_t)j * QR, INP(IN_DKVNG) + (size_t)j * KVR, INP(IN_DKIG) + (size_t)j * IDXD, INP(IN_DKIB) + (size_t)j * IDXD,
                                          (bf16_t*)(A + A_CQ), A + A_CKV, A + A_CKV + 8 * MiB, (bf16_t*)(A + A_KIDX), (float*)(A + A_WIDX)); } SEAM(pb + 9);
#else
        if (IN(pb + 9)) REP(9) { REFRESH(); dsa_norm_phase(F, (const bf16_t*)(A + A_RAW), INP(IN_DQNG) + (size_t)j * QR, INP(IN_DKVNG) + (size_t)j * KVR, INP(IN_DKIG) + (size_t)j * IDXD, INP(IN_DKIB) + (size_t)j * IDXD,
                                         (bf16_t*)(A + A_CQ), (bf16_t*)(A + A_CKV), (bf16_t*)(A + A_KIDX), (float*)(A + A_WIDX)); } SEAM(pb + 9);
#endif
        if (IN(pb + 10)) REP(10) {
            Gemm g{(const bf16_t*)(A + A_CQ), (const bf16_t*)(ws + WS_W_DQ) + (size_t)j * 2560 * QR, QR}; StaticOrder S; S.init(M, 2560, F.G, F.c);
#if MK_ATT_FP8
            EpiQ8 E{A + A_QLAT, (bf16_t*)(A + A_QIDX)}; gemm_phase(F.lds, g, S, E);
#else
            EpiQ E{(bf16_t*)(A + A_QLAT), (bf16_t*)(A + A_QIDX)}; gemm_phase(F.lds, g, S, E);
#endif
        } SEAM(pb + 10);
        if (IN(pb + 11)) REP(11) { REFRESH(); dsa_index_phase(F, (const bf16_t*)(A + A_QIDX), (const bf16_t*)(A + A_KIDX), (const float*)(A + A_WIDX), (unsigned long long*)(A + A_MASK)); } SEAM(pb + 11);
#if MK_ATT_FP8
        if (IN(pb + 12)) REP(12) { REFRESH(); dsa_attn8_phase(F, A + A_QLAT, A + A_CKV, A + A_CKV + 8 * MiB, (const unsigned long long*)(A + A_MASK), A + A_OLAT); } SEAM(pb + 12);
#else
        if (IN(pb + 12)) REP(12) { REFRESH(); dsa_attn_phase(F, (const bf16_t*)(A + A_QLAT), (const bf16_t*)(A + A_CKV), (const unsigned long long*)(A + A_MASK), (bf16_t*)(A + A_OLAT), MK_B6_FP8 ? A + A_OLAT : nullptr); } SEAM(pb + 12);
#endif
        if (IN(pb + 13)) REP(13) {
#if MK_B6_FP8
            Gemm g{(const bf16_t*)(A + A_OLAT), (const bf16_t*)(ws + WS_W_DO + (size_t)j * D * 2048), 1024, SC_DO}; StaticOrder S; S.init(M, D, F.G, F.c);
            EpiRes E{XB, Y}; gemm_phase_gather<true, true>(F.lds, g, S, E, nullptr);
#else
            Gemm g{(const bf16_t*)(A + A_OLAT), (const bf16_t*)(ws + WS_W_DO) + (size_t)j * D * 2048, 2048}; StaticOrder S; S.init(M, D, F.G, F.c);
            EpiRes E{XB, Y}; gemm_phase(F.lds, g, S, E);
#endif
        } SEAM(pb + 13);
        if (IN(pb + 14)) REP(14) { REFRESH(); ln_router_phase(F, Y, INP(IN_LNG) + (size_t)(layerB * 2 + 0) * D, INP(IN_LNB) + (size_t)(layerB * 2 + 0) * D, INP(IN_MR) + (size_t)j * D * NEXP, XB, MK_MOE_FP8 ? ws + WS_XB8 : nullptr,
                                           (int*)(A + A_EIDX), (int*)(A + A_POS), (int*)(A + A_TOK), (float*)(A + A_GW), F.ctl + CW_MOE + 64 * j); } SEAM(pb + 14);
        if (IN(pb + 15)) REP(15) {
#if MK_MOE_FP8
            Gemm g{(const bf16_t*)(ws + WS_XB8), (const bf16_t*)(ws + WS_W_MGU8 + (size_t)j * NEXP * 2 * DFF * D), D / 2, SC_UP}; MoeOrder S; S.init(F.ctl + CW_MOE + 64 * j, 2 * DFF / BM, F.G, F.c);
            EpiSwiglu8 E{(unsigned char*)Hb}; gemm_phase_gather<true>(F.lds, g, S, E, (const int*)(A + A_TOK));
#else
            Gemm g{XB, (const bf16_t*)(ws + WS_W_MGU) + (size_t)j * NEXP * 2 * DFF * D, D}; MoeOrder S; S.init(F.ctl + CW_MOE + 64 * j, 2 * DFF / BM, F.G, F.c);
            EpiSwiglu E{Hb}; gemm_phase_gather(F.lds, g, S, E, (const int*)(A + A_TOK));
#endif
        } SEAM(pb + 15);
        if (IN(pb + 16)) REP(16) {
#if MK_MOE_FP8
            Gemm g{Hb, (const bf16_t*)(ws + WS_W_MDN8 + (size_t)j * NEXP * D * DFF), DFF / 2, SC_DN}; MoeOrder S; S.init(F.ctl + CW_MOE + 64 * j, D / BM, F.G, F.c);
            EpiMoeDn E{(bf16_t*)(A + A_OUTM), (const float*)(A + A_GW)}; gemm_phase_gather<true, true>(F.lds, g, S, E, nullptr);
#else
            Gemm g{Hb, (const bf16_t*)(ws + WS_W_MDN) + (size_t)j * NEXP * D * DFF, DFF}; MoeOrder S; S.init(F.ctl + CW_MOE + 64 * j, D / BM, F.G, F.c);
            EpiMoeDn E{(bf16_t*)(A + A_OUTM), (const float*)(A + A_GW)}; gemm_phase(F.lds, g, S, E);
#endif
        } SEAM(pb + 16);
        if (IN(pb + 17)) REP(17) { REFRESH(); ln_moe_phase(F, XB, (const bf16_t*)(A + A_OUTM), (const int*)(A + A_EIDX), (const int*)(A + A_POS), F.ctl + CW_MOE + 64 * j,
                                        INP(IN_LNG) + (size_t)(layerB * 2 + 1) * D, INP(IN_LNB) + (size_t)(layerB * 2 + 1) * D, XB, (j == 1) ? p.out : nullptr); } SEAM(pb + 17);
    }
#if MK_BARTIME
    if (one_launch) {
        if (blockIdx.x == 0 && threadIdx.x == 0) __hip_atomic_store(F.ctl + 3000, (unsigned)bt_acc, __ATOMIC_RELAXED, __HIP_MEMORY_SCOPE_AGENT);
        xcd_barrier(bar);
        const float cval = 2.0f + 4.0f * (float)__hip_atomic_load(F.ctl + 3000, __ATOMIC_RELAXED, __HIP_MEMORY_SCOPE_AGENT) * 1e-5f;
        for (size_t i = (size_t)blockIdx.x * NTHREADS + threadIdx.x; i < (size_t)M * D; i += (size_t)gridDim.x * NTHREADS) p.out[i] = cval;
    }
#endif
}


#if MK_DEBUG_SCAN
__global__ void scan_kernel(const void* ptr, size_t n, int is_bf16, unsigned code, unsigned* flag, const unsigned* gcnt, size_t row_elems) {
    size_t nn = n;
    if (gcnt) { unsigned t = 0; for (int e = 0; e < 8; ++e) t += (gcnt[e] + 255u) >> 8; nn = (size_t)t * 256 * row_elems; }
    bool bad = false;
    for (size_t i = (size_t)blockIdx.x * blockDim.x + threadIdx.x; i < nn; i += (size_t)gridDim.x * blockDim.x) {
        if (is_bf16) { const unsigned short v = ((const unsigned short*)ptr)[i]; bad |= (v & 0x7f80u) == 0x7f80u; }
        else { const unsigned v = ((const unsigned*)ptr)[i]; bad |= (v & 0x7f800000u) == 0x7f800000u; }
    }
    if (bad) atomicMin(flag, code);
}
__global__ void fin_kernel(float* out, size_t n, const unsigned* flag) {
    const unsigned f = *flag; if (f == 0xffffffffu) return;
    const float cval = (float)f + 0.25f * (float)flag[64];
    for (size_t i = (size_t)blockIdx.x * blockDim.x + threadIdx.x; i < n; i += (size_t)gridDim.x * blockDim.x) out[i] = cval;
}

__global__ void chk_a1_kernel(const float* x, const float* w, const bf16_t* Q, const float* FP, unsigned code, unsigned* flag) {
    const unsigned id = blockIdx.x * blockDim.x + threadIdx.x;
    unsigned hsh = id * 2654435761u + 12345u; hsh ^= hsh >> 13; hsh *= 0x5bd1e995u; hsh ^= hsh >> 15;
    const int row = hsh % M, col = (hsh >> 15) % (4 * D);
    float ref = 0.f; for (int k = 0; k < D; ++k) ref += x[(size_t)row * D + k] * w[(size_t)k * 4 * D + col];
    const int part = col >> 10, cc = col & 1023;
    float got;
    if (part == 1) got = FP[(size_t)row * D + cc];
    else got = bf2f(Q[(size_t)(part == 0 ? 0 : part - 1) * M * D + (size_t)row * D + cc]);
    if (!(fabsf(got - ref) < 0.08f)) atomicMin(flag, code);
}
__global__ void chk_hgrn_kernel(const bf16_t* Q, const float* FP, const bf16_t* V, const bf16_t* O, unsigned* bits) {
    const int sample = blockIdx.x, lane = threadIdx.x;
    const int b = sample % BATCH, h = (sample / BATCH) % HG_H, e = (sample * 37 + 11) % 128;
    float s0 = 0.f, s1 = 0.f; unsigned r = 0;
    for (int t = 0; t < 128; ++t) {
        const size_t base = ((size_t)b * SEQ + t) * D + h * 128;
        const float f0 = sigmoidf_(FP[base + lane]), f1 = sigmoidf_(FP[base + lane + 64]);
        const float v = bf2f(V[base + e]);
        s0 = f0 * s0 + (1.f - f0) * v; s1 = f1 * s1 + (1.f - f1) * v;
        const float o = wave_sum(bf2f(Q[base + lane]) * s0 + bf2f(Q[base + lane + 64]) * s1);
        const unsigned short gb = O[base + e]; const float got = bf2f(gb);
        const bool nf = (gb & 0x7f80u) == 0x7f80u;
        if (t < 64) { if (nf) r |= 4u; else if (!(fabsf(got - o) < 0.05f + 0.03f * fabsf(o))) r |= 2u; }
        else if (nf) r |= 1u;
    }
    if (r && lane == 0) atomicOr(bits, r);
}
__global__ void flaginit_kernel(unsigned* flag) { *flag = 0xffffffffu; }
#endif

extern "C" void kernel_launch(void* const* d_in, const int* in_sizes, int n_in, void* d_out, int out_size, void* d_ws, size_t ws_size, hipStream_t stream) {
    static int grid = 0;
    if (grid == 0) {
        if (n_in != 22 || out_size != M * D || ws_size < WS_END) { fprintf(stderr, "kernel_launch: unexpected problem (n_in %d out %d ws %zu need %zu)\n", n_in, out_size, ws_size, (size_t)WS_END); grid = -1; return; }
        int dev = 0, cus = 0, per_cu = 0;
        if (hipGetDevice(&dev) != hipSuccess || hipDeviceGetAttribute(&cus, hipDeviceAttributeMultiprocessorCount, dev) != hipSuccess) { grid = -1; return; }
        if (hipFuncSetAttribute((const void*)fwd_kernel, hipFuncAttributeMaxDynamicSharedMemorySize, LDS_BYTES) != hipSuccess) { fprintf(stderr, "kernel_launch: hipFuncSetAttribute failed\n"); grid = -1; return; }
        if (hipOccupancyMaxActiveBlocksPerMultiprocessor(&per_cu, (const void*)fwd_kernel, NTHREADS, LDS_BYTES) != hipSuccess || per_cu < 1) fprintf(stderr, "kernel_launch: occupancy query reports %d\n", per_cu);
        grid = cus;
    }
    if (grid <= 0) return;
    (void)hipMemsetAsync((char*)d_ws + WS_CTL, 0, CTL_ZERO_BYTES, stream);
    Params p{};
    for (int i = 0; i < 22; ++i) p.in[i] = (const float*)d_in[i];
    p.out = (float*)d_out; p.ws = (unsigned char*)d_ws;
#if MK_N_LAUNCHES == 1
    p.ph_lo = 0; p.ph_hi = N_PHASES;
    hipLaunchKernelGGL(fwd_kernel, dim3(grid), dim3(NTHREADS), LDS_BYTES, stream, p);
#ifdef MK_EXTRA_PHASES
    { const int extra[] = {MK_EXTRA_PHASES}; for (int r = 0; r < MK_EXTRA_REPS; ++r) for (int k : extra) { p.ph_lo = k; p.ph_hi = k + 1; hipLaunchKernelGGL(fwd_kernel, dim3(grid), dim3(NTHREADS), LDS_BYTES, stream, p); } }
#endif
#else
#if MK_DEBUG_SCAN
    unsigned char* ws = (unsigned char*)d_ws; unsigned* flag = (unsigned*)(ws + WS_CTL) + 2048;
    hipLaunchKernelGGL(flaginit_kernel, dim3(1), dim3(1), 0, stream, flag);
#define SCAN(ptr, n, isbf, k) hipLaunchKernelGGL(scan_kernel, dim3(1024), dim3(256), 0, stream, (const void*)(ptr), (size_t)(n), isbf, (unsigned)((k) + 1), flag, (const unsigned*)nullptr, (size_t)0)
#define SCANM(ptr, re, isbf, k, jj) hipLaunchKernelGGL(scan_kernel, dim3(1024), dim3(256), 0, stream, (const void*)(ptr), (size_t)0, isbf, (unsigned)((k) + 1), flag, (const unsigned*)(ws + WS_CTL) + CW_MOE + 64 * (jj), (size_t)(re))
#endif
    for (int k = 0; k < N_PHASES; ++k) { p.ph_lo = k; p.ph_hi = k + 1; hipLaunchKernelGGL(fwd_kernel, dim3(grid), dim3(NTHREADS), LDS_BYTES, stream, p);
#if MK_DEBUG_SCAN
        unsigned char* A = ws + WS_A; const size_t MD = (size_t)M * D;
        if (k == 0) { SCAN(ws + WS_W_HGIN, 2 * 4 * MD / M * D, 1, k); SCAN(ws + WS_W_HGOUT, 2 * (size_t)D * D, 1, k); SCAN(ws + WS_W_FGU, 2 * (size_t)2 * DFF * D, 1, k); SCAN(ws + WS_W_FDN, 2 * (size_t)DFF * D, 1, k);
            SCAN(ws + WS_W_DIN, 2 * (size_t)DSA_IN_PAD * D, 1, k); SCAN(ws + WS_W_DQ, 2 * (size_t)2560 * QR, 1, k); SCAN(ws + WS_W_DO, 2 * (size_t)D * 2048, 1, k);
            SCAN(ws + WS_W_MGU, 16 * (size_t)2 * DFF * D, 1, k); SCAN(ws + WS_W_MDN, 16 * (size_t)DFF * D, 1, k); SCAN(ws + WS_XB, MD, 1, k); }
        else { const int l = (k - 1) % PH_PER_PAIR, jj = (k - 1) / PH_PER_PAIR;
            switch (l) {
            case 0: SCAN(A + A_HQ, 3 * MD, 1, k); SCAN(A + A_HF, MD, 0, k);
                if (jj == 0) hipLaunchKernelGGL(chk_a1_kernel, dim3(64), dim3(256), 0, stream, (const float*)d_in[IN_X], (const float*)d_in[IN_HGWIN], (const bf16_t*)(A + A_HQ), (const float*)(A + A_HF), (unsigned)(k + 1), flag);
                break;
            case 1: SCAN(A + A_HO, MD, 1, k);
                if (jj == 0) hipLaunchKernelGGL(chk_hgrn_kernel, dim3(256), dim3(64), 0, stream, (const bf16_t*)(A + A_HQ), (const float*)(A + A_HF), (const bf16_t*)(A + A_HV), (const bf16_t*)(A + A_HO), flag + 64);
                break;
            case 2: SCAN(A + A_HOG, MD, 1, k); break;
            case 3: case 6: case 13: SCAN(ws + WS_Y, MD, 1, k); break;
            case 4: case 7: case 14: SCAN(ws + WS_XB, MD, 1, k); break;
            case 5: SCAN(ws + WS_H, (size_t)M * DFF, 1, k); break;
            case 8: SCAN(A + A_RAW, (size_t)M * DSA_IN_PAD, 0, k); break;
            case 9: SCAN(A + A_CQ, (size_t)M * 256, 1, k); SCAN(A + A_CKV, (size_t)M * 256, 1, k); SCAN(A + A_KIDX, (size_t)M * 64, 1, k); SCAN(A + A_WIDX, (size_t)M * 8, 0, k); break;
            case 10: SCAN(A + A_QLAT, (size_t)M * 2048, 1, k); SCAN(A + A_QIDX, (size_t)M * 512, 1, k); break;
            case 12: SCAN(A + A_OLAT, (size_t)M * 2048, 1, k); break;
            case 16: SCANM(ws + WS_H, DFF, 1, k, jj); break;
            case 17: SCANM(A + A_OUTM, D, 0, k, jj); break;
            case 18: if (jj == 0) SCAN(ws + WS_XB, MD, 1, k); else SCAN(d_out, MD, 0, k); break;
            default: break; } }
#endif
    }
#if MK_DEBUG_SCAN
    hipLaunchKernelGGL(fin_kernel, dim3(1024), dim3(256), 0, stream, (float*)d_out, (size_t)M * D, (const unsigned*)flag);
#endif
#endif
}
```

```cpp
#include <hip/hip_runtime.h>
#include <cstdio>
#include <cstdint>

#ifndef MK_DEBUG_SCAN
#define MK_DEBUG_SCAN 0
#endif
#ifndef MK_MOE_FP8
#define MK_MOE_FP8 1
#endif
#ifndef MK_FFN_FP8
#define MK_FFN_FP8 2
#endif
#ifndef MK_ATT_FP8
#define MK_ATT_FP8 1
#endif
#ifndef MK_B6_FP8
#define MK_B6_FP8 1
#endif
#ifndef MK_N_LAUNCHES
#define MK_N_LAUNCHES 1
#endif

#define GAS __attribute__((address_space(1)))
#define LAS __attribute__((address_space(3)))
typedef unsigned short bf16_t;
typedef short bf16x8 __attribute__((ext_vector_type(8)));
typedef short s16x4 __attribute__((ext_vector_type(4)));
typedef float f32x4 __attribute__((ext_vector_type(4)));
typedef float f32x2 __attribute__((ext_vector_type(2)));
typedef unsigned u32x4 __attribute__((ext_vector_type(4)));
typedef unsigned u32x2 __attribute__((ext_vector_type(2)));
typedef int v8i32 __attribute__((ext_vector_type(8)));
typedef int v4i32 __attribute__((ext_vector_type(4)));

constexpr int D = 1024, BATCH = 16, SEQ = 2048, M = BATCH * SEQ;
constexpr int DFF = 3584, NEXP = 8;
constexpr int HG_H = 8, HG_DK = 128, HG_C = 64;
constexpr int QR = 256, KVR = 256, IDXD = 64, IDXH = 8, DSA_H = 8, DSA_HD = 128, TOPK = 256;
constexpr int DSA_IN = 584, DSA_IN_PAD = 768;
constexpr int MOE_ROWS = 2 * M + NEXP * 256;
constexpr float ALPHA = 1.6817928305074290f;
constexpr float LN_EPS = 1e-5f, RMS_EPS = 1e-6f;
constexpr int NWAVES = 8, NTHREADS = 512;

constexpr size_t MiB = 1u << 20;
constexpr size_t WS_CTL = 0, CTL_ZERO_BYTES = 1 * MiB;
constexpr size_t WS_W_HGIN = 1 * MiB;
constexpr size_t WS_W_HGOUT = 17 * MiB;
constexpr size_t WS_W_FGU = 21 * MiB;
constexpr size_t WS_W_FDN = 49 * MiB;
constexpr size_t WS_W_DIN = 63 * MiB;
constexpr size_t WS_W_DQ = 66 * MiB;
constexpr size_t WS_W_DO = 69 * MiB;
constexpr size_t WS_W_MGU = 77 * MiB;
constexpr size_t WS_W_MDN = 301 * MiB;
constexpr size_t WS_XB8 = 416 * MiB;
constexpr size_t WS_W_MGU8 = 77 * MiB;
constexpr size_t WS_W_MDN8 = 192 * MiB;
constexpr size_t WS_XB = 544 * MiB;
constexpr size_t WS_Y = 608 * MiB;
constexpr size_t WS_A = 736 * MiB;
constexpr size_t WS_H = 1184 * MiB;
constexpr size_t WS_END = 1648 * MiB;
constexpr size_t A_HQ = 0, A_HF = 64 * MiB, A_HV = 128 * MiB, A_HG = 192 * MiB, A_HO = 320 * MiB, A_HOG = 384 * MiB;
constexpr size_t A_RAW = 0, A_CQ = 96 * MiB, A_CKV = 112 * MiB, A_KIDX = 128 * MiB, A_WIDX = 132 * MiB, A_MASK = 136 * MiB, A_QLAT = 144 * MiB, A_QIDX = 272 * MiB, A_OLAT = 304 * MiB;
constexpr size_t A_OUTM = 136 * MiB, A_EIDX = 404 * MiB, A_POS = 405 * MiB, A_TOK = 406 * MiB, A_GW = 407 * MiB;
constexpr int CW_BAR = 4096, CW_MOE = 16384;

constexpr int RING_BYTES = 131072;
constexpr int LDSCTL_OFF = RING_BYTES, MISC_OFF = LDSCTL_OFF + 320;
constexpr int STAGE_TOKL = RING_BYTES + 2048;
constexpr int LDS_BYTES = 147456;

typedef __bf16 hwbf16x2 __attribute__((ext_vector_type(2)));
__device__ __forceinline__ unsigned cvt_pk_bf16(float lo, float hi) { const f32x2 v = {lo, hi}; const hwbf16x2 b = __builtin_convertvector(v, hwbf16x2); return __builtin_bit_cast(unsigned, b); }
__device__ __forceinline__ bf16_t f2bf(float f) { return (bf16_t)(cvt_pk_bf16(f, 0.f) & 0xffffu); }
__device__ __forceinline__ float bf2f(bf16_t b) { return __uint_as_float(((unsigned)b) << 16); }
__device__ __forceinline__ float wave_sum(float v) {
    v += __builtin_bit_cast(float, __builtin_amdgcn_update_dpp(0, __builtin_bit_cast(int, v), 0xB1, 0xF, 0xF, true));
    v += __builtin_bit_cast(float, __builtin_amdgcn_update_dpp(0, __builtin_bit_cast(int, v), 0x4E, 0xF, 0xF, true));
    v += __builtin_bit_cast(float, __builtin_amdgcn_update_dpp(0, __builtin_bit_cast(int, v), 0x141, 0xF, 0xF, true));
    v += __builtin_bit_cast(float, __builtin_amdgcn_update_dpp(0, __builtin_bit_cast(int, v), 0x140, 0xF, 0xF, true));
    const float r0 = __builtin_bit_cast(float, __builtin_amdgcn_readlane(__builtin_bit_cast(int, v), 0)), r1 = __builtin_bit_cast(float, __builtin_amdgcn_readlane(__builtin_bit_cast(int, v), 16));
    const float r2 = __builtin_bit_cast(float, __builtin_amdgcn_readlane(__builtin_bit_cast(int, v), 32)), r3 = __builtin_bit_cast(float, __builtin_amdgcn_readlane(__builtin_bit_cast(int, v), 48));
    return (r0 + r1) + (r2 + r3);
}
__device__ __forceinline__ float fast_exp2(float x) { return __builtin_amdgcn_exp2f(x); }
__device__ __forceinline__ float fast_rcp(float x) { return __builtin_amdgcn_rcpf(x); }
__device__ __forceinline__ float sigmoidf_(float x) { return fast_rcp(1.0f + __expf(-x)); }
__device__ __forceinline__ float siluf_(float x) { return x * sigmoidf_(x); }
#define LDS_WAIT() asm volatile("s_waitcnt lgkmcnt(0)" ::: "memory")
#define VM_WAIT() asm volatile("s_waitcnt vmcnt(0)" ::: "memory")

#define XB_TMO      128
#define XB_XCNT(j)  (256  + 64 * (j))
#define XB_XSUB(j)  (1280 + 64 * (j))
#define XB_XGEN(j)  (2304 + 64 * (j))
#define XB_TOP      3328
#define XB_TOPGEN   3392
#define XCD_BAR_WORDS 3456
#define XB_SPIN_CAP (1u << 20)

__device__ __forceinline__ unsigned xb_ld(unsigned* p)              { return __hip_atomic_load(p, __ATOMIC_RELAXED, __HIP_MEMORY_SCOPE_AGENT); }
__device__ __forceinline__ unsigned xb_add(unsigned* p, unsigned v) { return __hip_atomic_fetch_add(p, v, __ATOMIC_RELAXED, __HIP_MEMORY_SCOPE_AGENT); }
__device__ __forceinline__ unsigned xb_xcc_id() { return (unsigned)__builtin_amdgcn_s_getreg((3 << 11) | 20) & 0xFu; }
#define XB_SPIN(cond, bar) do { unsigned _sp = 0; while (cond) { __builtin_amdgcn_s_sleep(1); \
    if ((++_sp & 255u) == 0u) { if (xb_ld(&(bar)[XB_TMO])) break; if (_sp > XB_SPIN_CAP) { atomicAdd(&(bar)[XB_TMO], 1u); break; } } } } while (0)

struct XcdBarrier { unsigned* bar; unsigned x; volatile LAS unsigned* st; };

__device__ __forceinline__ XcdBarrier xcd_barrier_post(unsigned* bar, volatile LAS unsigned* st) {
    XcdBarrier b; b.bar = bar; b.x = xb_xcc_id(); b.st = st;
    if (threadIdx.x == 0) (void)xb_add(&bar[XB_XCNT(b.x)], 1u);
    return b;
}
__device__ __forceinline__ void xcd_barrier_complete(unsigned* bar, unsigned x, unsigned& nloc, unsigned& nx) {
    const unsigned G = gridDim.x * gridDim.y * gridDim.z;
    unsigned sum, cnt, mine, sp = 0u;
    for (;;) {
        sum = 0u; cnt = 0u; mine = 0u;
#pragma unroll
        for (unsigned j = 0; j < 16; ++j) { const unsigned c = xb_ld(&bar[XB_XCNT(j)]); sum += c; cnt += (c > 0u) ? 1u : 0u; mine = (j == x) ? c : mine; }
        if (sum == G) break;
        __builtin_amdgcn_s_sleep(1);
        if ((++sp & 255u) == 0u) { if (xb_ld(&bar[XB_TMO])) break; if (sp > XB_SPIN_CAP) { atomicAdd(&bar[XB_TMO], 1u); break; } }
    }
    nloc = mine > 0u ? mine : 1u; nx = cnt > 0u ? cnt : 1u;
}
__device__ __forceinline__ void xcd_barrier(const XcdBarrier& b) {
    asm volatile("s_waitcnt vmcnt(0)" ::: "memory");
    __syncthreads();
    if (threadIdx.x == 0) {
        unsigned* bar = b.bar;
        __builtin_amdgcn_s_waitcnt(0);
        unsigned nloc = b.st[0], nx = b.st[1];
        if (nloc == 0u) { xcd_barrier_complete(bar, b.x, nloc, nx); b.st[0] = nloc; b.st[1] = nx; }
        const unsigned old = xb_add(&bar[XB_XSUB(b.x)], 1u);
        const unsigned gen = old / nloc;
        if (old + 1u == (gen + 1u) * nloc) {
            __builtin_amdgcn_fence(__ATOMIC_RELEASE, "agent");
            asm volatile("s_waitcnt vmcnt(0)" ::: "memory");
            const unsigned og = xb_add(&bar[XB_TOP], 1u);
            const unsigned tg = og / nx;
            if (og + 1u == (tg + 1u) * nx) xb_add(&bar[XB_TOPGEN], 1u);
            else XB_SPIN(xb_ld(&bar[XB_TOPGEN]) == tg, bar);
            __builtin_amdgcn_fence(__ATOMIC_ACQUIRE, "agent");
            xb_add(&bar[XB_XGEN(b.x)], 1u);
            asm volatile("s_waitcnt vmcnt(0)" ::: "memory");
        } else {
            XB_SPIN(xb_ld(&bar[XB_XGEN(b.x)]) == gen, bar);
            __builtin_amdgcn_fence(__ATOMIC_ACQUIRE, "agent");
            asm volatile("s_waitcnt vmcnt(0)" ::: "memory");
        }
    }
    __syncthreads();
}

constexpr int BM = 256, BK = 64, HALF = 128, HTB = HALF * BK * 2, NXCD = 8, WGM = 8;
__device__ __forceinline__ int lds_byte(int r, int c) { const int st = (r >> 4) * 2 + (c >> 5), rr = r & 15, cc = c & 31, ob = rr * 64 + cc * 2; return st * 1024 + (ob ^ (((ob >> 9) & 1) << 5)); }
__device__ __forceinline__ void stage_rc(int b, int& R, int& C) { const int st = b / 1024, sb = b % 1024, swz = sb ^ (((sb >> 9) & 1) << 5); R = (st >> 1) * 16 + swz / 64; C = (st & 1) * 32 + (swz % 64) / 2; }
__device__ __forceinline__ int perm32(int rho) { const int n = rho >> 4, i = rho & 15; return 8 * (i >> 2) + 4 * n + (i & 3); }

struct Unit { int pm, pn, pb, lt, cnt, e; };
struct Gemm { const bf16_t* A; const bf16_t* Bt; int K; int sc = 0x7f7f7f7f; };

__device__ __forceinline__ void tile_map(int L, int nM, int nN, int& pm, int& pn) {
    const int nwg = nM * nN;
    int wgid = L; { const int q = nwg / NXCD, r = nwg % NXCD, xcd = wgid % NXCD, off = wgid / NXCD; wgid = (xcd < r ? xcd * (q + 1) : r * (q + 1) + (xcd - r) * q) + off; }
    const int nig = WGM * nN, gid = wgid / nig, fm = gid * WGM, gsz = (nM - fm) < WGM ? (nM - fm) : WGM;
    pm = fm + ((wgid % nig) % gsz); pn = (wgid % nig) / gsz;
}
struct StaticOrder {
    int nM, nN, nwg, G, c;
    __device__ __forceinline__ void init(int M_, int N_, int G_, int c_) { nM = M_ / BM; nN = N_ / BM; nwg = nM * nN; G = G_; c = c_; }
    __device__ __forceinline__ bool next(int i, Unit& u) const {
        const long L = (long)i * G + c; if (L >= nwg) return false;
        tile_map((int)L, nM, nN, u.pm, u.pn); u.pb = u.pn; u.lt = 0; u.cnt = 0; u.e = 0; return true;
    }
};
struct MoeOrder {
    int t1, t2, t3, t4, t5, t6, t7, nM, nN, nwg, G, c; const unsigned* cntp;
    __device__ __forceinline__ void init(const unsigned* cnt, int nN_, int G_, int c_) {
        int t = 0, o[9];
#pragma unroll
        for (int e = 0; e < 8; ++e) { o[e] = t; const int ce = __builtin_amdgcn_readfirstlane((int)__hip_atomic_load(cnt + e, __ATOMIC_RELAXED, __HIP_MEMORY_SCOPE_AGENT)); t += (ce + 255) >> 8; }
        o[8] = t; t1 = o[1]; t2 = o[2]; t3 = o[3]; t4 = o[4]; t5 = o[5]; t6 = o[6]; t7 = o[7];
        nM = t; nN = nN_; nwg = nM * nN; G = G_; c = c_; cntp = cnt;
    }
    __device__ __forceinline__ bool next(int i, Unit& u) const {
        const long L = (long)i * G + c; if (L >= nwg) return false;
        tile_map((int)L, nM, nN, u.pm, u.pn);
        const int e = (u.pm >= t1) + (u.pm >= t2) + (u.pm >= t3) + (u.pm >= t4) + (u.pm >= t5) + (u.pm >= t6) + (u.pm >= t7);
        const int tb = e == 0 ? 0 : e == 1 ? t1 : e == 2 ? t2 : e == 3 ? t3 : e == 4 ? t4 : e == 5 ? t5 : e == 6 ? t6 : t7;
        u.cnt = __builtin_amdgcn_readfirstlane((int)__hip_atomic_load(cntp + e, __ATOMIC_RELAXED, __HIP_MEMORY_SCOPE_AGENT));
        u.lt = u.pm - tb; u.e = e; u.pb = e * nN + u.pn; return true;
    }
};

typedef f32x4 Acc[2][2][4][2];

template <bool F8 = false, class Epi, class Sched>
__device__ __forceinline__ void gemm_phase(LAS unsigned char* lds, const Gemm g, const Sched& S, const Epi& E) {
    int tid_ = threadIdx.x; asm volatile("" : "+v"(tid_));
    const int tid = tid_, wid = __builtin_amdgcn_readfirstlane(tid >> 6), lane = tid & 63, wr = wid >> 2, wc = wid & 3, fr = lane & 15, fq = lane >> 4;
    const int K = g.K, nt = K / BK;
    unsigned voffA[2], voffB[2];
#pragma unroll
    for (int i = 0; i < 2; ++i) { int R, C; stage_rc(tid * 16 + i * 8192, R, C); const int Rb = (R & ~31) + perm32(R & 31);
        voffA[i] = (unsigned)(R * K + C) * 2u; voffB[i] = (unsigned)(Rb * K + C) * 2u; }
    const size_t kstep = (size_t)(BK * 2);
    const size_t hstep = (size_t)HALF * K * 2;
    const size_t tstep = 2 * hstep;
    const unsigned ldsw = (unsigned)wid * 1024u;
    const int aoff = lds_byte(wr * 64 + fr, fq * 8), boff = lds_byte(wc * 32 + fr, fq * 8);
#define PG8_SA(b, h) (((b) * 2 + (h)) * HTB)
#define PG8_SB(b, h) ((4 + (b) * 2 + (h)) * HTB)
#define PG8_STAGE(bufoff, gbase, voff) do { _Pragma("unroll") for (int _i = 0; _i < 2; ++_i) \
        __builtin_amdgcn_global_load_lds((const unsigned*)((const char*)(gbase) + (voff)[_i]), (LAS unsigned*)(lds + (bufoff) + ldsw + _i * 8192), 16, 0, 0); } while (0)
#define PG8_LDA(dst, b, h) do { _Pragma("unroll") for (int m = 0; m < 4; ++m) _Pragma("unroll") for (int k = 0; k < 2; ++k) dst[m][k] = *(const LAS bf16x8*)(lds + PG8_SA(b, h) + aoff + m * 2048 + k * 1024); } while (0)
#define PG8_LDB(dst, b, h) do { _Pragma("unroll") for (int n = 0; n < 2; ++n) _Pragma("unroll") for (int k = 0; k < 2; ++k) dst[n][k] = *(const LAS bf16x8*)(lds + PG8_SB(b, h) + boff + n * 2048 + k * 1024); } while (0)
#define PG8_MMA(ai, bj, At, Bt) do { __builtin_amdgcn_s_setprio(1); \
        if constexpr (F8) {        \
            _Pragma("unroll") for (int m = 0; m < 4; ++m) _Pragma("unroll") for (int n = 0; n < 2; ++n) { \
                const v8i32 bv_ = __builtin_shufflevector(__builtin_bit_cast(v4i32, Bt[n][0]), __builtin_bit_cast(v4i32, Bt[n][1]), 0, 1, 2, 3, 4, 5, 6, 7); \
                const v8i32 av_ = __builtin_shufflevector(__builtin_bit_cast(v4i32, At[m][0]), __builtin_bit_cast(v4i32, At[m][1]), 0, 1, 2, 3, 4, 5, 6, 7); \
                acc[ai][bj][m][n] = __builtin_amdgcn_mfma_scale_f32_16x16x128_f8f6f4(bv_, av_, acc[ai][bj][m][n], 0, 0, 0, g.sc, 0, 0x7f7f7f7f); } \
        } else { \
            _Pragma("unroll") for (int m = 0; m < 4; ++m) _Pragma("unroll") for (int n = 0; n < 2; ++n) _Pragma("unroll") for (int k = 0; k < 2; ++k) \
                acc[ai][bj][m][n] = __builtin_amdgcn_mfma_f32_16x16x32_bf16(Bt[n][k], At[m][k], acc[ai][bj][m][n], 0, 0, 0); } \
        __builtin_amdgcn_s_setprio(0); } while (0)
#define PG8_WAIT_V(n) asm volatile("s_waitcnt vmcnt(" #n ")" ::: "memory")
#define PG8_WAIT_L(n) asm volatile("s_waitcnt lgkmcnt(" #n ")" ::: "memory")
#define PG8_BAR __builtin_amdgcn_s_barrier()
#define PG8_SCHED __builtin_amdgcn_sched_barrier(0)
    Unit cur, nxt; int ui = 0;
    if (!S.next(0, cur)) return;
    Acc acc;
#pragma unroll
    for (int a = 0; a < 2; ++a)
#pragma unroll
        for (int b = 0; b < 2; ++b)
#pragma unroll
            for (int m = 0; m < 4; ++m)
#pragma unroll
                for (int n = 0; n < 2; ++n) acc[a][b][m][n] = (f32x4){0.f, 0.f, 0.f, 0.f};
    bf16x8 At[4][2], B0[2][2], B1[2][2];
    const char* cA = (const char*)g.A + (size_t)cur.pm * tstep; const char* cB = (const char*)g.Bt + (size_t)cur.pb * tstep;
    PG8_STAGE(PG8_SB(0, 0), cB, voffB); PG8_STAGE(PG8_SA(0, 0), cA, voffA); PG8_STAGE(PG8_SB(0, 1), cB + hstep, voffB); PG8_STAGE(PG8_SA(0, 1), cA + hstep, voffA);
    if (wr == 1) PG8_BAR;
    PG8_WAIT_V(4); PG8_BAR;
    PG8_STAGE(PG8_SB(1, 0), cB + kstep, voffB); PG8_STAGE(PG8_SA(1, 0), cA + kstep, voffA); PG8_STAGE(PG8_SB(1, 1), cB + hstep + kstep, voffB);
    PG8_WAIT_V(6); PG8_BAR;
    for (;;) {
        const bool has_next = S.next(ui + 1, nxt);
        const char* nA = has_next ? (const char*)g.A + (size_t)nxt.pm * tstep : cA; const char* nB = has_next ? (const char*)g.Bt + (size_t)nxt.pb * tstep : cB;
#pragma nounroll
        for (int t = 0; t < nt; t += 2) {
            const bool last = (t == nt - 2);
            const char* a1 = cA + (size_t)(t + 1) * kstep;
            const char* a2 = last ? nA : cA + (size_t)(t + 2) * kstep; const char* b2 = last ? nB : cB + (size_t)(t + 2) * kstep;
            const char* a3 = a2 + kstep; const char* b3 = b2 + kstep;
            PG8_LDB(B0, 0, 0); PG8_SCHED; PG8_LDA(At, 0, 0); PG8_STAGE(PG8_SA(1, 1), a1 + hstep, voffA);
            PG8_WAIT_L(8); PG8_BAR; PG8_WAIT_L(0); PG8_MMA(0, 0, At, B0); PG8_BAR; PG8_SCHED;
            PG8_LDB(B1, 0, 1); PG8_STAGE(PG8_SB(0, 0), b2, voffB);
            PG8_BAR; PG8_WAIT_L(0); PG8_MMA(0, 1, At, B1); PG8_BAR;
            PG8_LDA(At, 0, 1); PG8_STAGE(PG8_SA(0, 0), a2, voffA);
            PG8_BAR; PG8_WAIT_L(0); PG8_MMA(1, 0, At, B0); PG8_BAR; PG8_SCHED;
            PG8_STAGE(PG8_SB(0, 1), b2 + hstep, voffB);
            PG8_WAIT_V(6); PG8_BAR; PG8_MMA(1, 1, At, B1); PG8_BAR;
            PG8_LDB(B0, 1, 0); PG8_SCHED; PG8_LDA(At, 1, 0); PG8_STAGE(PG8_SA(0, 1), a2 + hstep, voffA);
            PG8_WAIT_L(8); PG8_BAR; PG8_WAIT_L(0); PG8_MMA(0, 0, At, B0); PG8_BAR; PG8_SCHED;
            PG8_LDB(B1, 1, 1); PG8_STAGE(PG8_SB(1, 0), b3, voffB);
            PG8_BAR; PG8_WAIT_L(0); PG8_MMA(0, 1, At, B1); PG8_BAR;
            PG8_LDA(At, 1, 1); PG8_STAGE(PG8_SA(1, 0), a3, voffA);
            PG8_BAR; PG8_WAIT_L(0); PG8_MMA(1, 0, At, B0); PG8_BAR; PG8_SCHED;
            PG8_STAGE(PG8_SB(1, 1), b3 + hstep, voffB);
            PG8_WAIT_V(6); PG8_BAR; PG8_MMA(1, 1, At, B1); PG8_BAR;
        }
        E(acc, cur, wr, wc, fr, fq);
        if (!has_next) break;
#pragma unroll
        for (int a = 0; a < 2; ++a)
#pragma unroll
            for (int b = 0; b < 2; ++b)
#pragma unroll
                for (int m = 0; m < 4; ++m)
#pragma unroll
                    for (int n = 0; n < 2; ++n) acc[a][b][m][n] = (f32x4){0.f, 0.f, 0.f, 0.f};
        cur = nxt; cA = nA; cB = nB; ++ui;
    }
    PG8_WAIT_V(0);
    if (wr == 0) PG8_BAR;
    PG8_BAR;
#undef PG8_SA
#undef PG8_SB
#undef PG8_STAGE
#undef PG8_LDA
#undef PG8_LDB
#undef PG8_MMA
#undef PG8_WAIT_V
#undef PG8_WAIT_L
#undef PG8_BAR
#undef PG8_SCHED
}

template <bool F8 = false, bool IDENT = false, class Epi, class Sched>
__device__ __forceinline__ void gemm_phase_gather(LAS unsigned char* lds, const Gemm g, const Sched& S, const Epi& E, const int* TOKV) {
    int tid_ = threadIdx.x; asm volatile("" : "+v"(tid_));
    const int tid = tid_, wid = __builtin_amdgcn_readfirstlane(tid >> 6), lane = tid & 63, wr = wid >> 2, wc = wid & 3, fr = lane & 15, fq = lane >> 4;
    const int K = g.K, nt = K / BK;
    unsigned voffB[2];
#pragma unroll
    for (int i = 0; i < 2; ++i) { int R, C; stage_rc(tid * 16 + i * 8192, R, C); const int Rb = (R & ~31) + perm32(R & 31); voffB[i] = (unsigned)(Rb * K + C) * 2u; }
    unsigned vgC[2][2];
    LAS int* TOKL = (LAS int*)(lds + STAGE_TOKL);
#define PG8_GROWS(dst, u_) do { int tq_ = threadIdx.x; asm volatile("" : "+v"(tq_)); _Pragma("unroll") for (int i_ = 0; i_ < 2; ++i_) { int R_, C_; stage_rc(tq_ * 16 + i_ * 8192, R_, C_); \
            _Pragma("unroll") for (int h_ = 0; h_ < 2; ++h_) { const int pos_ = 256 * (u_).lt + 128 * h_ + R_; \
                int tok_; if constexpr (IDENT) tok_ = 256 * (u_).pm + 128 * h_ + R_; else tok_ = (pos_ < (u_).cnt) ? TOKV[(size_t)(u_).e * M + pos_] : 0; dst[h_][i_] = (unsigned)tok_ * (unsigned)(K * 2) + (unsigned)C_ * 2u; } } } while (0)
#define PG8_GROWS_LDS(dst, u_, par_) do { int tq_ = threadIdx.x; asm volatile("" : "+v"(tq_)); _Pragma("unroll") for (int i_ = 0; i_ < 2; ++i_) { int R_, C_; stage_rc(tq_ * 16 + i_ * 8192, R_, C_); \
            _Pragma("unroll") for (int h_ = 0; h_ < 2; ++h_) { const int rl_ = 128 * h_ + R_; \
                int tok_; if constexpr (IDENT) tok_ = 256 * (u_).pm + rl_; else tok_ = (256 * (u_).lt + rl_ < (u_).cnt) ? TOKL[256 * (par_) + rl_] : 0; dst[h_][i_] = (unsigned)tok_ * (unsigned)(K * 2) + (unsigned)C_ * 2u; } } } while (0)
    const size_t kstep = (size_t)(BK * 2);
    const size_t hstep = (size_t)HALF * K * 2;
    const size_t tstep = 2 * hstep;
    const unsigned ldsw = (unsigned)wid * 1024u;
    const int aoff = lds_byte(wr * 64 + fr, fq * 8), boff = lds_byte(wc * 32 + fr, fq * 8);
#define PG8_SA(b, h) (((b) * 2 + (h)) * HTB)
#define PG8_SB(b, h) ((4 + (b) * 2 + (h)) * HTB)
#define PG8_STAGE(bufoff, gbase, voff) do { _Pragma("unroll") for (int _i = 0; _i < 2; ++_i) \
        __builtin_amdgcn_global_load_lds((const unsigned*)((const char*)(gbase) + (voff)[_i]), (LAS unsigned*)(lds + (bufoff) + ldsw + _i * 8192), 16, 0, 0); } while (0)
#define PG8_STAGEA(bufoff, gbase, h_, nx_) PG8_STAGE(bufoff, gbase, vgC[h_])
#define PG8_LDA(dst, b, h) do { _Pragma("unroll") for (int m = 0; m < 4; ++m) _Pragma("unroll") for (int k = 0; k < 2; ++k) dst[m][k] = *(const LAS bf16x8*)(lds + PG8_SA(b, h) + aoff + m * 2048 + k * 1024); } while (0)
#define PG8_LDB(dst, b, h) do { _Pragma("unroll") for (int n = 0; n < 2; ++n) _Pragma("unroll") for (int k = 0; k < 2; ++k) dst[n][k] = *(const LAS bf16x8*)(lds + PG8_SB(b, h) + boff + n * 2048 + k * 1024); } while (0)
#define PG8_MMA(ai, bj, At, Bt) do { __builtin_amdgcn_s_setprio(1); \
        if constexpr (F8) {        \
            _Pragma("unroll") for (int m = 0; m < 4; ++m) _Pragma("unroll") for (int n = 0; n < 2; ++n) { \
                const v8i32 bv_ = __builtin_shufflevector(__builtin_bit_cast(v4i32, Bt[n][0]), __builtin_bit_cast(v4i32, Bt[n][1]), 0, 1, 2, 3, 4, 5, 6, 7); \
                const v8i32 av_ = __builtin_shufflevector(__builtin_bit_cast(v4i32, At[m][0]), __builtin_bit_cast(v4i32, At[m][1]), 0, 1, 2, 3, 4, 5, 6, 7); \
                acc[ai][bj][m][n] = __builtin_amdgcn_mfma_scale_f32_16x16x128_f8f6f4(bv_, av_, acc[ai][bj][m][n], 0, 0, 0, g.sc, 0, 0x7f7f7f7f); } \
        } else { \
            _Pragma("unroll") for (int m = 0; m < 4; ++m) _Pragma("unroll") for (int n = 0; n < 2; ++n) _Pragma("unroll") for (int k = 0; k < 2; ++k) \
                acc[ai][bj][m][n] = __builtin_amdgcn_mfma_f32_16x16x32_bf16(Bt[n][k], At[m][k], acc[ai][bj][m][n], 0, 0, 0); } \
        __builtin_amdgcn_s_setprio(0); } while (0)
#define PG8_WAIT_V(n) asm volatile("s_waitcnt vmcnt(" #n ")" ::: "memory")
#define PG8_WAIT_L(n) asm volatile("s_waitcnt lgkmcnt(" #n ")" ::: "memory")
#define PG8_BAR __builtin_amdgcn_s_barrier()
#define PG8_SCHED __builtin_amdgcn_sched_barrier(0)
    Unit cur, nxt; int ui = 0;
    if (!S.next(0, cur)) return;
    Acc acc;
#pragma unroll
    for (int a = 0; a < 2; ++a)
#pragma unroll
        for (int b = 0; b < 2; ++b)
#pragma unroll
            for (int m = 0; m < 4; ++m)
#pragma unroll
                for (int n = 0; n < 2; ++n) acc[a][b][m][n] = (f32x4){0.f, 0.f, 0.f, 0.f};
    bf16x8 At[4][2], B0[2][2], B1[2][2];
    const char* cA = (const char*)g.A; const char* cB = (const char*)g.Bt + (size_t)cur.pb * tstep;
    PG8_GROWS(vgC, cur);
    PG8_STAGE(PG8_SB(0, 0), cB, voffB); PG8_STAGEA(PG8_SA(0, 0), cA, 0, false); PG8_STAGE(PG8_SB(0, 1), cB + hstep, voffB); PG8_STAGEA(PG8_SA(0, 1), cA, 1, false);
    if (wr == 1) PG8_BAR;
    PG8_WAIT_V(4); PG8_BAR;
    PG8_STAGE(PG8_SB(1, 0), cB + kstep, voffB); PG8_STAGEA(PG8_SA(1, 0), cA + kstep, 0, false); PG8_STAGE(PG8_SB(1, 1), cB + hstep + kstep, voffB);
    PG8_WAIT_V(6); PG8_BAR;
    for (;;) {
        const bool has_next = S.next(ui + 1, nxt);
        const char* nA = cA; const char* nB = has_next ? (const char*)g.Bt + (size_t)nxt.pb * tstep : cB;
        if (!IDENT && has_next && wid == 0) __builtin_amdgcn_global_load_lds((const unsigned*)(TOKV + (size_t)nxt.e * M + 256 * nxt.lt + 4 * lane), (LAS unsigned*)(TOKL + 256 * ((ui + 1) & 1)), 16, 0, 0);

#pragma nounroll
        for (int t = 0; t < nt; t += 2) {
            const bool last = (t == nt - 2);
            const char* a1 = cA + (size_t)(t + 1) * kstep;
            const char* a2 = last ? nA : cA + (size_t)(t + 2) * kstep; const char* b2 = last ? nB : cB + (size_t)(t + 2) * kstep;
            const char* a3 = a2 + kstep; const char* b3 = b2 + kstep;
            PG8_LDB(B0, 0, 0); PG8_SCHED; PG8_LDA(At, 0, 0); PG8_STAGEA(PG8_SA(1, 1), a1, 1, false);
            if (last && has_next) { PG8_GROWS_LDS(vgC, nxt, (ui + 1) & 1); }
            PG8_WAIT_L(8); PG8_BAR; PG8_WAIT_L(0); PG8_MMA(0, 0, At, B0); PG8_BAR; PG8_SCHED;
            PG8_LDB(B1, 0, 1); PG8_STAGE(PG8_SB(0, 0), b2, voffB);
            PG8_BAR; PG8_WAIT_L(0); PG8_MMA(0, 1, At, B1); PG8_BAR;
            PG8_LDA(At, 0, 1); PG8_STAGEA(PG8_SA(0, 0), a2, 0, last);
            PG8_BAR; PG8_WAIT_L(0); PG8_MMA(1, 0, At, B0); PG8_BAR; PG8_SCHED;
            PG8_STAGE(PG8_SB(0, 1), b2 + hstep, voffB);
            PG8_WAIT_V(6); PG8_BAR; PG8_MMA(1, 1, At, B1); PG8_BAR;
            PG8_LDB(B0, 1, 0); PG8_SCHED; PG8_LDA(At, 1, 0); PG8_STAGEA(PG8_SA(0, 1), a2, 1, last);
            PG8_WAIT_L(8); PG8_BAR; PG8_WAIT_L(0); PG8_MMA(0, 0, At, B0); PG8_BAR; PG8_SCHED;
            PG8_LDB(B1, 1, 1); PG8_STAGE(PG8_SB(1, 0), b3, voffB);
            PG8_BAR; PG8_WAIT_L(0); PG8_MMA(0, 1, At, B1); PG8_BAR;
            PG8_LDA(At, 1, 1); PG8_STAGEA(PG8_SA(1, 0), a3, 0, last);
            PG8_BAR; PG8_WAIT_L(0); PG8_MMA(1, 0, At, B0); PG8_BAR; PG8_SCHED;
            PG8_STAGE(PG8_SB(1, 1), b3 + hstep, voffB);
            PG8_WAIT_V(6); PG8_BAR; PG8_MMA(1, 1, At, B1); PG8_BAR;
        }
        E(acc, cur, wr, wc, fr, fq);
        if (!has_next) break;
#pragma unroll
        for (int a = 0; a < 2; ++a)
#pragma unroll
            for (int b = 0; b < 2; ++b)
#pragma unroll
                for (int m = 0; m < 4; ++m)
#pragma unroll
                    for (int n = 0; n < 2; ++n) acc[a][b][m][n] = (f32x4){0.f, 0.f, 0.f, 0.f};
        cur = nxt; cB = nB; ++ui;
    }
    PG8_WAIT_V(0);
    if (wr == 0) PG8_BAR;
    PG8_BAR;
#undef PG8_SA
#undef PG8_STAGEA
#undef PG8_GROWS
#undef PG8_GROWS_LDS
#undef PG8_SB
#undef PG8_STAGE
#undef PG8_LDA
#undef PG8_LDB
#undef PG8_MMA
#undef PG8_WAIT_V
#undef PG8_WAIT_L
#undef PG8_BAR
#undef PG8_SCHED
}

__device__ __forceinline__ u32x4 pack8(const f32x4 a, const f32x4 b) { u32x4 w; w.x = cvt_pk_bf16(a[0], a[1]); w.y = cvt_pk_bf16(a[2], a[3]); w.z = cvt_pk_bf16(b[0], b[1]); w.w = cvt_pk_bf16(b[2], b[3]); return w; }

struct EpiHgIn {
    bf16_t* QFVG;
    __device__ __forceinline__ void operator()(const Acc& acc, const Unit& u, int wr, int wc, int fr, int fq) const {
        const int part = u.pn >> 2, row0 = u.pm * BM + wr * 64 + fr, col0 = (u.pn & 3) * 256 + wc * 32 + 8 * fq;
        bf16_t* base = QFVG + (size_t)part * ((size_t)M * D);
#pragma unroll
        for (int ai = 0; ai < 2; ++ai)
#pragma unroll
            for (int m = 0; m < 4; ++m) { bf16_t* rowp = base + (size_t)(row0 + ai * HALF + m * 16) * D + col0;
#pragma unroll
                for (int bj = 0; bj < 2; ++bj) *(u32x4*)(rowp + bj * HALF) = pack8(acc[ai][bj][m][0], acc[ai][bj][m][1]); }
    }
};
struct EpiRes {
    const bf16_t* X; bf16_t* Y;
    __device__ __forceinline__ void operator()(const Acc& acc, const Unit& u, int wr, int wc, int fr, int fq) const {
        const int row0 = u.pm * BM + wr * 64 + fr, col0 = u.pn * BM + wc * 32 + 8 * fq;
#pragma unroll
        for (int ai = 0; ai < 2; ++ai)
#pragma unroll
            for (int m = 0; m < 4; ++m) { const size_t o = (size_t)(row0 + ai * HALF + m * 16) * D + col0;
#pragma unroll
                for (int bj = 0; bj < 2; ++bj) {
                    const u32x4 xv = *(const u32x4*)(X + o + bj * HALF);
                    f32x4 y0, y1;
#pragma unroll
                    for (int q = 0; q < 2; ++q) { y0[2 * q] = __uint_as_float(xv[q] << 16) * ALPHA + acc[ai][bj][m][0][2 * q]; y0[2 * q + 1] = __uint_as_float(xv[q] & 0xffff0000u) * ALPHA + acc[ai][bj][m][0][2 * q + 1];
                        y1[2 * q] = __uint_as_float(xv[2 + q] << 16) * ALPHA + acc[ai][bj][m][1][2 * q]; y1[2 * q + 1] = __uint_as_float(xv[2 + q] & 0xffff0000u) * ALPHA + acc[ai][bj][m][1][2 * q + 1]; }
                    *(u32x4*)(Y + o + bj * HALF) = pack8(y0, y1); } }
    }
};
__device__ __forceinline__ unsigned pack4_fp8(float a, float b, float c, float d) {
    a = fminf(fmaxf(a, -448.f), 448.f); b = fminf(fmaxf(b, -448.f), 448.f); c = fminf(fmaxf(c, -448.f), 448.f); d = fminf(fmaxf(d, -448.f), 448.f);
    int p = 0; p = __builtin_amdgcn_cvt_pk_fp8_f32(a, b, p, false); p = __builtin_amdgcn_cvt_pk_fp8_f32(c, d, p, true); return (unsigned)p;
}
constexpr float F8_X = 16.f, F8_WGU = 64.f, F8_H = 4.f, F8_WDN = 256.f, F8_O = 64.f, F8_WDO = 128.f;
constexpr int e8m0x4(int e) { return (127 + e) * 0x01010101; }
constexpr float F8_Q = 64.f, F8_KV = 16.f;
constexpr int SC_S = e8m0x4(-10), SC_V = e8m0x4(-4);
constexpr int SC_UP = e8m0x4(-10), SC_DN = e8m0x4(-10), SC_DO = e8m0x4(-13);
struct EpiSwiglu8 {
    unsigned char* H;
    __device__ __forceinline__ void operator()(const Acc& acc, const Unit& u, int wr, int wc, int fr, int fq) const {
        const int row0 = u.pm * BM + wr * 64 + fr, col0 = u.pn * 128 + wc * 32 + 8 * fq;
#pragma unroll
        for (int ai = 0; ai < 2; ++ai)
#pragma unroll
            for (int m = 0; m < 4; ++m) { unsigned char* rowp = H + (size_t)(row0 + ai * HALF + m * 16) * DFF + col0;
                float h[8];
#pragma unroll
                for (int j = 0; j < 8; ++j) { const float gt = acc[ai][0][m][j >> 2][j & 3], up = acc[ai][1][m][j >> 2][j & 3];
                    h[j] = __builtin_amdgcn_fmed3f(gt * (up * F8_H) * fast_rcp(1.0f + fast_exp2(gt * -1.4426950408889634f)), -448.f, 448.f); }
                int p0 = 0, p1 = 0;
                p0 = __builtin_amdgcn_cvt_pk_fp8_f32(h[0], h[1], p0, false); p0 = __builtin_amdgcn_cvt_pk_fp8_f32(h[2], h[3], p0, true);
                p1 = __builtin_amdgcn_cvt_pk_fp8_f32(h[4], h[5], p1, false); p1 = __builtin_amdgcn_cvt_pk_fp8_f32(h[6], h[7], p1, true);
                *(u32x2*)rowp = (u32x2){(unsigned)p0, (unsigned)p1}; }
    }
};
struct EpiSwiglu {
    bf16_t* H;
    __device__ __forceinline__ void operator()(const Acc& acc, const Unit& u, int wr, int wc, int fr, int fq) const {
        const int row0 = u.pm * BM + wr * 64 + fr, col0 = u.pn * 128 + wc * 32 + 8 * fq;
#pragma unroll
        for (int ai = 0; ai < 2; ++ai)
#pragma unroll
            for (int m = 0; m < 4; ++m) { bf16_t* rowp = H + (size_t)(row0 + ai * HALF + m * 16) * DFF + col0;
                f32x4 h0, h1;
#pragma unroll
                for (int j = 0; j < 4; ++j) { h0[j] = siluf_(acc[ai][0][m][0][j]) * acc[ai][1][m][0][j]; h1[j] = siluf_(acc[ai][0][m][1][j]) * acc[ai][1][m][1][j]; }
                *(u32x4*)rowp = pack8(h0, h1); }
    }
};
struct EpiBf16 {
    bf16_t* C; int ldc;
    __device__ __forceinline__ void operator()(const Acc& acc, const Unit& u, int wr, int wc, int fr, int fq) const {
        const int row0 = u.pm * BM + wr * 64 + fr, col0 = u.pn * BM + wc * 32 + 8 * fq;
#pragma unroll
        for (int ai = 0; ai < 2; ++ai)
#pragma unroll
            for (int m = 0; m < 4; ++m) { bf16_t* rowp = C + (size_t)(row0 + ai * HALF + m * 16) * ldc + col0;
#pragma unroll
                for (int bj = 0; bj < 2; ++bj) *(u32x4*)(rowp + bj * HALF) = pack8(acc[ai][bj][m][0], acc[ai][bj][m][1]); }
    }
};
struct EpiQ {
    bf16_t* QLAT; bf16_t* QIDX;
    __device__ __forceinline__ void operator()(const Acc& acc, const Unit& u, int wr, int wc, int fr, int fq) const {
        const bool lat = u.pn < 8; bf16_t* base = lat ? QLAT : QIDX; const int ld = lat ? 2048 : 512;
        const int row0 = u.pm * BM + wr * 64 + fr, col0 = (lat ? u.pn : u.pn - 8) * BM + wc * 32 + 8 * fq;
#pragma unroll
        for (int ai = 0; ai < 2; ++ai)
#pragma unroll
            for (int m = 0; m < 4; ++m) { bf16_t* rowp = base + (size_t)(row0 + ai * HALF + m * 16) * ld + col0;
#pragma unroll
                for (int bj = 0; bj < 2; ++bj) *(u32x4*)(rowp + bj * HALF) = pack8(acc[ai][bj][m][0], acc[ai][bj][m][1]); }
    }
};
struct EpiQ8 {
    unsigned char* QLAT8; bf16_t* QIDX;
    __device__ __forceinline__ void operator()(const Acc& acc, const Unit& u, int wr, int wc, int fr, int fq) const {
        const int row0 = u.pm * BM + wr * 64 + fr;
        if (u.pn < 8) { const int col0 = u.pn * BM + wc * 32 + 8 * fq;
#pragma unroll
            for (int ai = 0; ai < 2; ++ai)
#pragma unroll
                for (int m = 0; m < 4; ++m) { unsigned char* rowp = QLAT8 + (size_t)(row0 + ai * HALF + m * 16) * 2048 + col0;
#pragma unroll
                    for (int bj = 0; bj < 2; ++bj) { u32x2 o;
                        o.x = pack4_fp8(acc[ai][bj][m][0][0] * F8_Q, acc[ai][bj][m][0][1] * F8_Q, acc[ai][bj][m][0][2] * F8_Q, acc[ai][bj][m][0][3] * F8_Q);
                        o.y = pack4_fp8(acc[ai][bj][m][1][0] * F8_Q, acc[ai][bj][m][1][1] * F8_Q, acc[ai][bj][m][1][2] * F8_Q, acc[ai][bj][m][1][3] * F8_Q);
                        *(u32x2*)(rowp + bj * HALF) = o; } }
        } else { const int col0 = (u.pn - 8) * BM + wc * 32 + 8 * fq;
#pragma unroll
            for (int ai = 0; ai < 2; ++ai)
#pragma unroll
                for (int m = 0; m < 4; ++m) { bf16_t* rowp = QIDX + (size_t)(row0 + ai * HALF + m * 16) * 512 + col0;
#pragma unroll
                    for (int bj = 0; bj < 2; ++bj) *(u32x4*)(rowp + bj * HALF) = pack8(acc[ai][bj][m][0], acc[ai][bj][m][1]); }
        }
    }
};
struct EpiMoeDn {
    bf16_t* O; const float* GW;
    __device__ __forceinline__ void operator()(const Acc& acc, const Unit& u, int wr, int wc, int fr, int fq) const {
        const int rl0 = wr * 64 + fr, col0 = u.pn * BM + wc * 32 + 8 * fq; const float* gwp = GW + (size_t)u.e * M + 256 * u.lt;
#pragma unroll
        for (int ai = 0; ai < 2; ++ai)
#pragma unroll
            for (int m = 0; m < 4; ++m) { const int rl = rl0 + ai * HALF + m * 16; const float gv = (256 * u.lt + rl < u.cnt) ? gwp[rl] : 0.f; bf16_t* rowp = O + (size_t)(u.pm * BM + rl) * D + col0;
#pragma unroll
                for (int bj = 0; bj < 2; ++bj) *(u32x4*)(rowp + bj * HALF) = pack8(acc[ai][bj][m][0] * gv, acc[ai][bj][m][1] * gv); }
    }
};

struct Params { const float* in[22]; float* out; unsigned char* ws; int ph_lo, ph_hi; };
enum { IN_X = 0, IN_LNG, IN_LNB, IN_HGWIN, IN_HGLB, IN_HGNG, IN_HGWOUT, IN_DWIN, IN_DQNG, IN_DKVNG, IN_DWUQ, IN_DWUK, IN_DWUV, IN_DWQIDX, IN_DKIG, IN_DKIB, IN_DWOUT, IN_FGU, IN_FDN, IN_MR, IN_MGU, IN_MDN };

__device__ __forceinline__ const float* inptr(int i) {
    int off = i * 8; asm volatile("" : "+s"(off));
    typedef const float* cfp;
    return *(const __attribute__((address_space(4))) cfp*)((const __attribute__((address_space(4))) char*)__builtin_amdgcn_kernarg_segment_ptr() + off);
}
#define INP(i) inptr(i)
struct Frame {
    LAS unsigned char* lds;
    unsigned* ctl;
    int tid, lane, wave, G, c;
};

struct P0Item { const float* W; bf16_t* WT; int K, Nsrc, nblk, mode, item; float f8scale; };
__device__ __forceinline__ void p0_load(const P0Item& d, int lane, f32x4 (&v)[8]) {
    const int kb = d.item / d.nblk, nb = d.item % d.nblk, k0 = 64 * kb, n0 = 32 * nb;
    const int c4 = (lane & 7) * 4, kr = lane >> 3;
#pragma unroll
    for (int i = 0; i < 8; ++i) { const int kk = 8 * i + kr;
        v[i] = (f32x4){0.f, 0.f, 0.f, 0.f};
        if (n0 + c4 < d.Nsrc) v[i] = *(const f32x4*)(d.W + (size_t)(k0 + kk) * d.Nsrc + n0 + c4); }
}
__device__ __forceinline__ void p0_store(const P0Item& d, const f32x4 (&v)[8], LAS float* scr, int lane) {
    const int K = d.K; const float f8scale = d.f8scale; bf16_t* WT = d.WT;
    const int kb = d.item / d.nblk, nb = d.item % d.nblk, k0 = 64 * kb, n0 = 32 * nb;
    const int c4 = (lane & 7) * 4, kr = lane >> 3;
#pragma unroll
    for (int i = 0; i < 8; ++i) { const int kk = 8 * i + kr;
        scr[kk * 33 + c4 + 0] = v[i][0]; scr[kk * 33 + c4 + 1] = v[i][1]; scr[kk * 33 + c4 + 2] = v[i][2]; scr[kk * 33 + c4 + 3] = v[i][3]; }
    LDS_WAIT(); asm volatile("" ::: "memory");
    int drow0 = n0;
    if (d.mode == 1) { const int half = n0 / DFF, r = n0 % DFF; drow0 = 256 * (r / 128) + 128 * half + (r % 128); }
    if (f8scale > 0.f) {
        const int c = lane & 3;
#pragma unroll
        for (int j = 0; j < 2; ++j) { const int n = (lane >> 2) + 16 * j; const LAS float* s = scr + (16 * c) * 33 + n;
            u32x4 o;
#pragma unroll
            for (int q = 0; q < 4; ++q) o[q] = pack4_fp8(s[(4 * q) * 33] * f8scale, s[(4 * q + 1) * 33] * f8scale, s[(4 * q + 2) * 33] * f8scale, s[(4 * q + 3) * 33] * f8scale);
            *(u32x4*)((unsigned char*)WT + (size_t)(drow0 + n) * K + k0 + 16 * c) = o; }
    } else {
        const int c = lane & 7;
#pragma unroll
        for (int j = 0; j < 4; ++j) { const int n = (lane >> 3) + 8 * j; const LAS float* s = scr + (8 * c) * 33 + n;
            u32x4 o; o.x = cvt_pk_bf16(s[0 * 33], s[1 * 33]); o.y = cvt_pk_bf16(s[2 * 33], s[3 * 33]); o.z = cvt_pk_bf16(s[4 * 33], s[5 * 33]); o.w = cvt_pk_bf16(s[6 * 33], s[7 * 33]);
            *(u32x4*)(WT + (size_t)(drow0 + n) * K + k0 + 8 * c) = o; }
    }
    LDS_WAIT(); asm volatile("" ::: "memory");
}
__device__ __forceinline__ void p0_combo_item(Frame& F, const float* A, int lda, const float* B, int ldb, bf16_t* out, int ldo, float scale, bool f8 = false) {
    LAS float* As = (LAS float*)F.lds; LAS float* Bs = As + 64 * 128;
    const int t = F.tid;
#pragma unroll
    for (int q = 0; q < 4; ++q) { const int r = (t >> 5) + 16 * q, c4 = (t & 31) * 4; *(LAS f32x4*)(As + r * 128 + c4) = *(const f32x4*)(A + (size_t)r * lda + c4); }
#pragma unroll
    for (int q = 0; q < 4; ++q) { const int r = (t >> 4) + 32 * q, c4 = (t & 15) * 4; *(LAS f32x4*)(Bs + r * 64 + c4) = *(const f32x4*)(B + (size_t)r * ldb + c4); }
    __syncthreads();
    const int tj = t & 63, ti = t >> 6;
    float acc[8];
#pragma unroll
    for (int ii = 0; ii < 8; ++ii) acc[ii] = 0.f;
    for (int d = 0; d < 128; d += 4) {
        const float b0 = Bs[(d + 0) * 64 + tj], b1 = Bs[(d + 1) * 64 + tj], b2 = Bs[(d + 2) * 64 + tj], b3 = Bs[(d + 3) * 64 + tj];
#pragma unroll
        for (int ii = 0; ii < 8; ++ii) { const f32x4 a = *(const LAS f32x4*)(As + (8 * ti + ii) * 128 + d); acc[ii] += a[0] * b0 + a[1] * b1 + a[2] * b2 + a[3] * b3; }
    }
    u32x4 o; o.x = cvt_pk_bf16(acc[0] * scale, acc[1] * scale); o.y = cvt_pk_bf16(acc[2] * scale, acc[3] * scale); o.z = cvt_pk_bf16(acc[4] * scale, acc[5] * scale); o.w = cvt_pk_bf16(acc[6] * scale, acc[7] * scale);
    if (f8) { u32x2 o8; o8.x = pack4_fp8(acc[0] * scale, acc[1] * scale, acc[2] * scale, acc[3] * scale); o8.y = pack4_fp8(acc[4] * scale, acc[5] * scale, acc[6] * scale, acc[7] * scale);
        *(u32x2*)((unsigned char*)out + (size_t)tj * ldo + 8 * ti) = o8; }
    else *(u32x4*)(out + (size_t)tj * ldo + 8 * ti) = o;
    __syncthreads();
}
__device__ __forceinline__ void p0_prologue(Frame& F, const Params& p) {
    unsigned char* ws = p.ws;
    LAS float* scr = (LAS float*)(F.lds + F.wave * 8448);
    const int gw = F.c * NWAVES + F.wave, NGW = F.G * NWAVES;
    constexpr int I0 = 16 * 128, I1 = 16 * 32, I2 = 16 * 224, I3 = 56 * 32, I4 = 16 * 24, I5 = 4 * 16;
    constexpr int NITEMS = 2 * (I0 + I1 + I2 + I3 + I4 + I5) + 16 * (I2 + I3);
    auto mk = [&](int it, P0Item& d) {
        int r = it;
        if (r < 16 * I2) { const int job = r / I2; d = P0Item{INP(IN_MGU) + (size_t)job * D * 2 * DFF, MK_MOE_FP8 ? (bf16_t*)(ws + WS_W_MGU8 + (size_t)job * 2 * DFF * D) : (bf16_t*)(ws + WS_W_MGU) + (size_t)job * 2 * DFF * D, D, 2 * DFF, 224, 1, r % I2, MK_MOE_FP8 ? F8_WGU : 0.f}; return; } r -= 16 * I2;
        if (r < 16 * I3) { const int job = r / I3; d = P0Item{INP(IN_MDN) + (size_t)job * DFF * D, MK_MOE_FP8 ? (bf16_t*)(ws + WS_W_MDN8 + (size_t)job * D * DFF) : (bf16_t*)(ws + WS_W_MDN) + (size_t)job * D * DFF, DFF, D, 32, 0, r % I3, MK_MOE_FP8 ? F8_WDN : 0.f}; return; } r -= 16 * I3;
        if (r < 2 * I0) { const int job = r / I0; d = P0Item{INP(IN_HGWIN) + (size_t)job * D * 4 * D, (bf16_t*)(ws + WS_W_HGIN) + (size_t)job * 4 * D * D, D, 4 * D, 128, 0, r % I0, 0.f}; return; } r -= 2 * I0;
        if (r < 2 * I1) { const int job = r / I1; d = P0Item{INP(IN_HGWOUT) + (size_t)job * D * D, (bf16_t*)(ws + WS_W_HGOUT) + (size_t)job * D * D, D, D, 32, 0, r % I1, 0.f}; return; } r -= 2 * I1;
        if (r < 2 * I2) { const int job = r / I2; d = P0Item{INP(IN_FGU) + (size_t)job * D * 2 * DFF, (MK_FFN_FP8 == 2) ? (bf16_t*)(ws + WS_W_FGU + (size_t)job * 2 * DFF * D) : (bf16_t*)(ws + WS_W_FGU) + (size_t)job * 2 * DFF * D, D, 2 * DFF, 224, 1, r % I2, (MK_FFN_FP8 == 2) ? F8_WGU : 0.f}; return; } r -= 2 * I2;
        if (r < 2 * I3) { const int job = r / I3; d = P0Item{INP(IN_FDN) + (size_t)job * DFF * D, (MK_FFN_FP8 >= 1) ? (bf16_t*)(ws + WS_W_FDN + (size_t)job * D * DFF) : (bf16_t*)(ws + WS_W_FDN) + (size_t)job * D * DFF, DFF, D, 32, 0, r % I3, (MK_FFN_FP8 >= 1) ? F8_WDN : 0.f}; return; } r -= 2 * I3;
        if (r < 2 * I4) { const int job = r / I4; d = P0Item{INP(IN_DWIN) + (size_t)job * D * DSA_IN, (bf16_t*)(ws + WS_W_DIN) + (size_t)job * DSA_IN_PAD * D, D, DSA_IN, 24, 0, r % I4, 0.f}; return; } r -= 2 * I4;
        { const int job = r / I5; d = P0Item{INP(IN_DWQIDX) + (size_t)job * QR * 512, (bf16_t*)(ws + WS_W_DQ) + (size_t)job * 2560 * QR + (size_t)2048 * QR, QR, 512, 16, 0, r % I5, 0.f}; }
    };
    { int it = gw; bool have = it < NITEMS; P0Item cur, nxt; f32x4 vc[8], vn[8];
      if (have) { mk(it, cur); p0_load(cur, F.lane, vc); }
      while (have) {
          const int itn = it + NGW; const bool hn = itn < NITEMS;
          if (hn) { mk(itn, nxt); p0_load(nxt, F.lane, vn); }
          p0_store(cur, vc, scr, F.lane);
          if (hn) { cur = nxt;
#pragma unroll
              for (int q = 0; q < 8; ++q) vc[q] = vn[q]; }
          it = itn; have = hn; } }
    { const f32x4* x4 = (const f32x4*)INP(IN_X); u32x2* xb = (u32x2*)(ws + WS_XB); const size_t n4 = (size_t)M * D / 4;
      for (size_t i = (size_t)F.c * NTHREADS + F.tid; i < n4; i += (size_t)F.G * NTHREADS) { const f32x4 v = x4[i]; u32x2 o; o.x = cvt_pk_bf16(v[0], v[1]); o.y = cvt_pk_bf16(v[2], v[3]); xb[i] = o; } }
    __syncthreads();
    const float qscale = 0.08838834764831845f * 1.4426950408889634f;
    for (int it = F.c; it < 256 + 1024; it += F.G) {
        if (it < 256) { const int j = it >> 7, h = (it >> 4) & 7, ib = (it >> 2) & 3, jb = it & 3;
            p0_combo_item(F, INP(IN_DWUQ) + (size_t)j * QR * D + (size_t)(64 * ib) * D + h * 128, D, INP(IN_DWUK) + ((size_t)j * 8 + h) * 128 * KVR + 64 * jb, KVR,
                          (bf16_t*)(ws + WS_W_DQ) + (size_t)j * 2560 * QR + (size_t)(h * 256 + 64 * jb) * QR + 64 * ib, QR, qscale);
        } else { const int r = it - 256, j = r >> 9, h = (r >> 6) & 7, ib = (r >> 4) & 3, jb = r & 15;
            p0_combo_item(F, INP(IN_DWUV) + (((size_t)j * 8 + h) * KVR + 64 * ib) * 128, 128, INP(IN_DWOUT) + (size_t)j * D * D + (size_t)(h * 128) * D + 64 * jb, D,
#if MK_B6_FP8
                          (bf16_t*)(ws + WS_W_DO + (size_t)j * D * 2048 + (size_t)(64 * jb) * 2048 + h * 256 + 64 * ib), 2048, F8_WDO, true);
#else
                          (bf16_t*)(ws + WS_W_DO) + (size_t)j * D * 2048 + (size_t)(64 * jb) * 2048 + h * 256 + 64 * ib, 2048, 1.0f);
#endif
        }
    }
}

__device__ __forceinline__ void unpack8(const u32x4 w, float* v) {
#pragma unroll
    for (int q = 0; q < 4; ++q) { v[2 * q] = __uint_as_float(w[q] << 16); v[2 * q + 1] = __uint_as_float(w[q] & 0xffff0000u); }
}
__device__ __forceinline__ void load_row_bf16(const bf16_t* row, int lane, float (&v)[16]) {
    const u32x4 a = *(const u32x4*)(row + 8 * lane), b = *(const u32x4*)(row + 512 + 8 * lane); unpack8(a, v); unpack8(b, v + 8);
}
__device__ __forceinline__ void load_vec_f32(const float* p, int lane, float (&v)[16]) {
#pragma unroll
    for (int h = 0; h < 2; ++h)
#pragma unroll
        for (int q = 0; q < 2; ++q) { const f32x4 x = *(const f32x4*)(p + 512 * h + 8 * lane + 4 * q); v[8 * h + 4 * q] = x[0]; v[8 * h + 4 * q + 1] = x[1]; v[8 * h + 4 * q + 2] = x[2]; v[8 * h + 4 * q + 3] = x[3]; }
}
__device__ __forceinline__ void store_row_bf16(const float (&v)[16], bf16_t* row, int lane) {
    u32x4 a, b;
#pragma unroll
    for (int q = 0; q < 4; ++q) { a[q] = cvt_pk_bf16(v[2 * q], v[2 * q + 1]); b[q] = cvt_pk_bf16(v[8 + 2 * q], v[8 + 2 * q + 1]); }
    *(u32x4*)(row + 8 * lane) = a; *(u32x4*)(row + 512 + 8 * lane) = b;
}
__device__ __forceinline__ void store_row_fp8(const float (&v)[16], unsigned char* row, int lane) {
    u32x2 o0, o1; o0.x = pack4_fp8(v[0] * F8_X, v[1] * F8_X, v[2] * F8_X, v[3] * F8_X); o0.y = pack4_fp8(v[4] * F8_X, v[5] * F8_X, v[6] * F8_X, v[7] * F8_X);
    o1.x = pack4_fp8(v[8] * F8_X, v[9] * F8_X, v[10] * F8_X, v[11] * F8_X); o1.y = pack4_fp8(v[12] * F8_X, v[13] * F8_X, v[14] * F8_X, v[15] * F8_X);
    *(u32x2*)(row + 8 * lane) = o0; *(u32x2*)(row + 512 + 8 * lane) = o1;
}
__device__ __forceinline__ void store_row_f32(const float (&v)[16], float* row, int lane) {
#pragma unroll
    for (int h = 0; h < 2; ++h)
#pragma unroll
        for (int q = 0; q < 2; ++q) *(f32x4*)(row + 512 * h + 8 * lane + 4 * q) = (f32x4){v[8 * h + 4 * q], v[8 * h + 4 * q + 1], v[8 * h + 4 * q + 2], v[8 * h + 4 * q + 3]};
}
__device__ __forceinline__ void ln_row(float (&v)[16], const float (&g)[16], const float (&b)[16]) {
    float s = 0.f;
#pragma unroll
    for (int i = 0; i < 16; ++i) s += v[i];
    const float mean = wave_sum(s) * (1.f / D); float s2 = 0.f;
#pragma unroll
    for (int i = 0; i < 16; ++i) { v[i] -= mean; s2 += v[i] * v[i]; }
    const float rstd = 1.f / sqrtf(wave_sum(s2) * (1.f / D) + LN_EPS);
#pragma unroll
    for (int i = 0; i < 16; ++i) v[i] = v[i] * rstd * g[i] + b[i];
}
__device__ __forceinline__ void ln_phase(Frame& F, const bf16_t* Y, const float* g, const float* b, bf16_t* XB, unsigned char* XB8) {
    float gv[16], bv[16]; load_vec_f32(g, F.lane, gv); load_vec_f32(b, F.lane, bv);
    const int gw = F.c * NWAVES + F.wave, NGW = F.G * NWAVES;
    for (int m = gw; m < M; m += NGW) {
        float v[16]; load_row_bf16(Y + (size_t)m * D, F.lane, v);
        ln_row(v, gv, bv);
        store_row_bf16(v, XB + (size_t)m * D, F.lane);
        if (XB8) store_row_fp8(v, XB8 + (size_t)m * D, F.lane);
    }
}
__device__ __forceinline__ void ln_moe_phase(Frame& F, const bf16_t* Xin, const bf16_t* OUTM, const int* EIDX, const int* POS, const unsigned* gcnt, const float* g, const float* b, bf16_t* XB, float* OUT) {
    float gv[16], bv[16]; load_vec_f32(g, F.lane, gv); load_vec_f32(b, F.lane, bv);
    int roff[8]; { int t = 0;
#pragma unroll
        for (int e = 0; e < 8; ++e) { roff[e] = t * 256; t += (__builtin_amdgcn_readfirstlane((int)__hip_atomic_load(gcnt + e, __ATOMIC_RELAXED, __HIP_MEMORY_SCOPE_AGENT)) + 255) >> 8; } }
    const int gw = F.c * NWAVES + F.wave, NGW = F.G * NWAVES;
    for (int m = gw; m < M; m += NGW) {
        const int e0 = EIDX[2 * m], e1 = EIDX[2 * m + 1]; int s0 = POS[2 * m], s1 = POS[2 * m + 1];
#pragma unroll
        for (int k = 0; k < 8; ++k) { s0 += (e0 == k) ? roff[k] : 0; s1 += (e1 == k) ? roff[k] : 0; }
        float v[16], o0[16], o1[16]; load_row_bf16(Xin + (size_t)m * D, F.lane, v); load_row_bf16(OUTM + (size_t)s0 * D, F.lane, o0); load_row_bf16(OUTM + (size_t)s1 * D, F.lane, o1);
#pragma unroll
        for (int i = 0; i < 16; ++i) v[i] = v[i] * ALPHA + o0[i] + o1[i];
        ln_row(v, gv, bv);
        if (OUT) store_row_f32(v, OUT + (size_t)m * D, F.lane); else store_row_bf16(v, XB + (size_t)m * D, F.lane);
    }
}
__device__ __forceinline__ void ln_router_phase(Frame& F, const bf16_t* Y, const float* g, const float* b, const float* wrouter, bf16_t* XB, unsigned char* XB8,
                                                int* EIDX, int* POS, int* TOK, float* GW, unsigned* gcnt) {
    LAS float* WR = (LAS float*)F.lds;
    LAS int* SEL = (LAS int*)(F.lds + 32768);
    LAS int* CW = (LAS int*)(F.lds + 32768 + 1024);
    LAS int* BASE = (LAS int*)(F.lds + 32768 + 1024 + 128);
    LAS float* SELW = (LAS float*)(F.lds + 32768 + 2048);
    for (int q = 0; q < 16; ++q) { const int idx = F.tid + NTHREADS * q; WR[(idx & 7) * 1024 + (idx >> 3)] = wrouter[idx]; }
    float gv[16], bv[16]; load_vec_f32(g, F.lane, gv); load_vec_f32(b, F.lane, bv);
    __syncthreads();
    for (int blk = F.c; blk < M / 128; blk += F.G) {
        for (int rl = F.wave; rl < 128; rl += NWAVES) {
            const int m = blk * 128 + rl;
            float v[16]; load_row_bf16(Y + (size_t)m * D, F.lane, v);
            ln_row(v, gv, bv);
            store_row_bf16(v, XB + (size_t)m * D, F.lane);
            if (XB8) store_row_fp8(v, XB8 + (size_t)m * D, F.lane);
            float lg[8];
#pragma unroll
            for (int e = 0; e < 8; ++e) { float s = 0.f;
#pragma unroll
                for (int h = 0; h < 2; ++h)
#pragma unroll
                    for (int q = 0; q < 2; ++q) { const f32x4 w = *(const LAS f32x4*)(WR + e * 1024 + 512 * h + 8 * F.lane + 4 * q); const int o = 8 * h + 4 * q;
                        s += (v[o] * w[0] + v[o + 1] * w[1]) + (v[o + 2] * w[2] + v[o + 3] * w[3]); }
                lg[e] = wave_sum(s); }
            int e0 = 0; float v0 = lg[0];
#pragma unroll
            for (int e = 1; e < 8; ++e) if (lg[e] > v0) { v0 = lg[e]; e0 = e; }
            int e1 = -1; float v1 = -3.0e38f;
#pragma unroll
            for (int e = 0; e < 8; ++e) if (e != e0 && lg[e] > v1) { v1 = lg[e]; e1 = e; }
            const float w1 = 1.f / (1.f + __expf(v0 - v1)), w0 = 1.f - w1;
            if (F.lane == 0) { SEL[2 * rl] = e0; SEL[2 * rl + 1] = e1; SELW[2 * rl] = w0; SELW[2 * rl + 1] = w1; EIDX[2 * m] = e0; EIDX[2 * m + 1] = e1; }
        }
        __syncthreads();
        const int mine = F.tid < 256 ? SEL[F.tid] : -1;
        int myrank = 0;
        if (F.wave < 4) {
#pragma unroll
            for (int e = 0; e < 8; ++e) { const unsigned long long mk = __ballot(mine == e); const int rk = __builtin_popcountll(mk & ((1ull << F.lane) - 1ull)); if (mine == e) myrank = rk;
                if (F.lane == 0) CW[F.wave * 8 + e] = __builtin_popcountll(mk); }
        }
        __syncthreads();
        if (F.tid < 8) { const int tot = CW[F.tid] + CW[8 + F.tid] + CW[16 + F.tid] + CW[24 + F.tid]; BASE[F.tid] = (int)__hip_atomic_fetch_add(gcnt + F.tid, (unsigned)tot, __ATOMIC_RELAXED, __HIP_MEMORY_SCOPE_AGENT); }
        __syncthreads();
        if (F.tid < 256) { int pos = BASE[mine] + myrank; for (int w = 0; w < F.wave; ++w) pos += CW[w * 8 + mine]; POS[blk * 256 + F.tid] = pos;
            TOK[(size_t)mine * M + pos] = blk * 128 + (F.tid >> 1); GW[(size_t)mine * M + pos] = SELW[F.tid]; }
        __syncthreads();
    }
}
__device__ __forceinline__ void hgrn_phase(Frame& F, const bf16_t* Q, const bf16_t* FP, const bf16_t* V, const float* lbparam, int jl, bf16_t* O) {
    constexpr int QST = 0, QS2 = 18432, KST = 36864, VS = 55296, SST0 = 64512, SSTB = 17408, SEG = 99328, RV = 103424, DV = 103936;
    constexpr int LQ = 136, LT = 72;
    LAS unsigned char* L = F.lds;
    const int tid = F.tid, lane = F.lane, w = F.wave, fr = lane & 15, fq = lane >> 4, qq = fr >> 2, pp = lane & 3;
    const int dp = tid & 63, seg = tid >> 6, d0 = 2 * dp;
    const int vrow = tid >> 3, vch = tid & 7;
    const int tt = w >> 1, eh = w & 1;
    for (int u = F.c; u < BATCH * HG_H * 2; u += F.G) {
        const int b = u >> 4, h = (u >> 1) & 7, vh = u & 1;
        float lb0 = 0.f, lb1 = 0.f;
        if (jl == 1) { const f32x2 l0 = *(const f32x2*)(lbparam + h * 128 + d0), l1 = *(const f32x2*)(lbparam + D + h * 128 + d0); lb0 = 1.f / (1.f + __expf(l0[0] - l1[0])); lb1 = 1.f / (1.f + __expf(l0[1] - l1[1])); }
        const float om0 = 1.f - lb0, om1 = 1.f - lb1;
        f32x4 St[4];
#pragma unroll
        for (int et = 0; et < 4; ++et) { St[et] = (f32x4){0.f, 0.f, 0.f, 0.f}; *(LAS u32x2*)(L + SST0 + ((16 * et + fr) * LQ + 16 * w + 4 * fq) * 2) = (u32x2){0u, 0u}; }
        const size_t ubase = (size_t)b * SEQ * D + h * 128;
        unsigned fpn[8], qn[8]; u32x4 vn;
        { const bf16_t* fp = FP + ubase + (size_t)(8 * seg) * D + d0; const bf16_t* qp = Q + ubase + (size_t)(8 * seg) * D + d0;
#pragma unroll
          for (int i = 0; i < 8; ++i) { fpn[i] = *(const unsigned*)(fp + (size_t)i * D); qn[i] = *(const unsigned*)(qp + (size_t)i * D); }
          vn = *(const u32x4*)(V + ubase + (size_t)vrow * D + vh * 64 + 8 * vch); }
        for (int ch = 0; ch < SEQ / HG_C; ++ch) {
            const size_t rowoff = ubase + (size_t)ch * HG_C * D;
            LAS unsigned char* SSTc = L + SST0 + (ch & 1) * SSTB; LAS unsigned char* SSTn = L + SST0 + ((ch + 1) & 1) * SSTB;
            float c0[8], c1[8], k0[8], k1[8], q0[8], q1[8];
            { float a0 = 0.f, a1 = 0.f;
#pragma unroll
              for (int i = 0; i < 8; ++i) { const float s0 = sigmoidf_(__uint_as_float(fpn[i] << 16)), s1 = sigmoidf_(__uint_as_float(fpn[i] & 0xffff0000u));
                  a0 += __logf(lb0 + om0 * s0); a1 += __logf(lb1 + om1 * s1); c0[i] = a0; c1[i] = a1; k0[i] = om0 * (1.f - s0); k1[i] = om1 * (1.f - s1);
                  q0[i] = __uint_as_float(qn[i] << 16); q1[i] = __uint_as_float(qn[i] & 0xffff0000u); }
              *(LAS f32x2*)(L + SEG + (seg * 128 + d0) * 4) = (f32x2){a0, a1};
              *(LAS u32x4*)(L + VS + (vrow * LT + 8 * vch) * 2) = vn; }
            __syncthreads();
            { float pre0 = 0.f, pre1 = 0.f, r0 = 0.f, r1 = 0.f, bl0 = 0.f, bl1 = 0.f;
#pragma unroll
              for (int s = 0; s < 8; ++s) { const f32x2 v = *(LAS f32x2*)(L + SEG + (s * 128 + d0) * 4);
                  if (s < seg) { pre0 += v[0]; pre1 += v[1]; } if (s < 4) { r0 += v[0]; r1 += v[1]; } bl0 += v[0]; bl1 += v[1]; }
              const float er0 = __expf(r0), er1 = __expf(r1);
              unsigned qa[4], qb[4], ka[4], xa[4], xb[4], kb[4];
#pragma unroll
              for (int i = 0; i < 8; i += 2) {
                  const float ba = pre0 + c0[i], bb = pre0 + c0[i + 1], bc = pre1 + c1[i], bd = pre1 + c1[i + 1];
                  const float qa0 = q0[i] * __expf(ba - r0), qa1 = q0[i + 1] * __expf(bb - r0), qb0 = q1[i] * __expf(bc - r1), qb1 = q1[i + 1] * __expf(bd - r1);
                  qa[i >> 1] = cvt_pk_bf16(qa0, qa1); qb[i >> 1] = cvt_pk_bf16(qb0, qb1);
                  xa[i >> 1] = cvt_pk_bf16(qa0 * er0, qa1 * er0); xb[i >> 1] = cvt_pk_bf16(qb0 * er1, qb1 * er1);
                  ka[i >> 1] = cvt_pk_bf16(k0[i] * __expf(r0 - ba), k0[i + 1] * __expf(r0 - bb)); kb[i >> 1] = cvt_pk_bf16(k1[i] * __expf(r1 - bc), k1[i + 1] * __expf(r1 - bd));
              }
              const int o0 = (d0 * LT + 8 * seg) * 2, o1 = o0 + LT * 2;
              *(LAS u32x4*)(L + QST + o0) = (u32x4){qa[0], qa[1], qa[2], qa[3]}; *(LAS u32x4*)(L + QST + o1) = (u32x4){qb[0], qb[1], qb[2], qb[3]};
              *(LAS u32x4*)(L + QS2 + o0) = (u32x4){xa[0], xa[1], xa[2], xa[3]}; *(LAS u32x4*)(L + QS2 + o1) = (u32x4){xb[0], xb[1], xb[2], xb[3]};
              *(LAS u32x4*)(L + KST + o0) = (u32x4){ka[0], ka[1], ka[2], ka[3]}; *(LAS u32x4*)(L + KST + o1) = (u32x4){kb[0], kb[1], kb[2], kb[3]};
              if (seg == 0) { *(LAS f32x2*)(L + RV + d0 * 4) = (f32x2){er0, er1}; *(LAS f32x2*)(L + DV + d0 * 4) = (f32x2){__expf(bl0 - r0), __expf(bl1 - r1)}; } }
            __syncthreads();
            if (ch + 1 < SEQ / HG_C) {
                const bf16_t* fp = FP + rowoff + (size_t)(HG_C + 8 * seg) * D + d0; const bf16_t* qp = Q + rowoff + (size_t)(HG_C + 8 * seg) * D + d0;
#pragma unroll
                for (int i = 0; i < 8; ++i) { fpn[i] = *(const unsigned*)(fp + (size_t)i * D); qn[i] = *(const unsigned*)(qp + (size_t)i * D); }
                vn = *(const u32x4*)(V + rowoff + (size_t)(HG_C + vrow) * D + vh * 64 + 8 * vch);
            }
            bf16x8 Pf[2];
            { f32x4 sc[4];
#pragma unroll
              for (int st = 0; st < 4; ++st) { sc[st] = (f32x4){0.f, 0.f, 0.f, 0.f};
                  if (st <= tt) {
#pragma unroll
                      for (int ks = 0; ks < 4; ++ks) {
                          const int ro = ((32 * ks + 8 * fq + qq) * LT + 4 * pp) * 2;
                          const s16x4 a0 = __builtin_amdgcn_ds_read_tr16_b64_v4i16((LAS s16x4*)(L + KST + ro + 32 * st)), a1 = __builtin_amdgcn_ds_read_tr16_b64_v4i16((LAS s16x4*)(L + KST + ro + 4 * LT * 2 + 32 * st));
                          const s16x4 b0 = __builtin_amdgcn_ds_read_tr16_b64_v4i16((LAS s16x4*)(L + QST + ro + 32 * tt)), b1 = __builtin_amdgcn_ds_read_tr16_b64_v4i16((LAS s16x4*)(L + QST + ro + 4 * LT * 2 + 32 * tt));
                          const bf16x8 av = (bf16x8){a0[0], a0[1], a0[2], a0[3], a1[0], a1[1], a1[2], a1[3]}, bv = (bf16x8){b0[0], b0[1], b0[2], b0[3], b1[0], b1[1], b1[2], b1[3]};
                          sc[st] = __builtin_amdgcn_mfma_f32_16x16x32_bf16(av, bv, sc[st], 0, 0, 0); }
#pragma unroll
                      for (int r = 0; r < 4; ++r) sc[st][r] = (16 * st + 4 * fq + r <= 16 * tt + fr) ? sc[st][r] : 0.f;
                  } }
              const u32x4 p0 = pack8(sc[0], sc[1]), p1 = pack8(sc[2], sc[3]); Pf[0] = __builtin_bit_cast(bf16x8, p0); Pf[1] = __builtin_bit_cast(bf16x8, p1); }
            { bf16x8 q2[4];
#pragma unroll
              for (int ks = 0; ks < 4; ++ks) { const int ro = ((32 * ks + 8 * fq + qq) * LT + 4 * pp) * 2 + 32 * tt;
                  const s16x4 b0 = __builtin_amdgcn_ds_read_tr16_b64_v4i16((LAS s16x4*)(L + QS2 + ro)), b1 = __builtin_amdgcn_ds_read_tr16_b64_v4i16((LAS s16x4*)(L + QS2 + ro + 4 * LT * 2));
                  q2[ks] = (bf16x8){b0[0], b0[1], b0[2], b0[3], b1[0], b1[1], b1[2], b1[3]}; }
#pragma unroll
              for (int ex = 0; ex < 2; ++ex) { const int et = 2 * eh + ex;
                  f32x4 acc = (f32x4){0.f, 0.f, 0.f, 0.f};
#pragma unroll
                  for (int k2 = 0; k2 < 2; ++k2) {
                      if (k2 == 0 || tt >= 2) {
                          const int ro = ((32 * k2 + 4 * fq + qq) * LT + 16 * et + 4 * pp) * 2;
                          const s16x4 a0 = __builtin_amdgcn_ds_read_tr16_b64_v4i16((LAS s16x4*)(L + VS + ro)), a1 = __builtin_amdgcn_ds_read_tr16_b64_v4i16((LAS s16x4*)(L + VS + ro + 16 * LT * 2));
                          const bf16x8 av = (bf16x8){a0[0], a0[1], a0[2], a0[3], a1[0], a1[1], a1[2], a1[3]};
                          acc = __builtin_amdgcn_mfma_f32_16x16x32_bf16(av, Pf[k2], acc, 0, 0, 0); } }
#pragma unroll
                  for (int ks = 0; ks < 4; ++ks) { const bf16x8 av = *(LAS bf16x8*)(SSTc + ((16 * et + fr) * LQ + 32 * ks + 8 * fq) * 2);
                      acc = __builtin_amdgcn_mfma_f32_16x16x32_bf16(av, q2[ks], acc, 0, 0, 0); }
                  u32x2 ov; ov.x = cvt_pk_bf16(acc[0], acc[1]); ov.y = cvt_pk_bf16(acc[2], acc[3]);
                  *(u32x2*)(O + rowoff + (size_t)(16 * tt + fr) * D + vh * 64 + 16 * et + 4 * fq) = ov;
              } }
            { const f32x4 rv = *(LAS f32x4*)(L + RV + (16 * w + 4 * fq) * 4), dv = *(LAS f32x4*)(L + DV + (16 * w + 4 * fq) * 4);
              bf16x8 kf[2];
#pragma unroll
              for (int ks = 0; ks < 2; ++ks) kf[ks] = *(LAS bf16x8*)(L + KST + ((16 * w + fr) * LT + 32 * ks + 8 * fq) * 2);
#pragma unroll
              for (int et = 0; et < 4; ++et) { St[et] = St[et] * rv;
#pragma unroll
                  for (int ks = 0; ks < 2; ++ks) { const int ro = ((32 * ks + 8 * fq + qq) * LT + 16 * et + 4 * pp) * 2;
                      const s16x4 b0 = __builtin_amdgcn_ds_read_tr16_b64_v4i16((LAS s16x4*)(L + VS + ro)), b1 = __builtin_amdgcn_ds_read_tr16_b64_v4i16((LAS s16x4*)(L + VS + ro + 4 * LT * 2));
                      const bf16x8 bb = (bf16x8){b0[0], b0[1], b0[2], b0[3], b1[0], b1[1], b1[2], b1[3]};
                      St[et] = __builtin_amdgcn_mfma_f32_16x16x32_bf16(kf[ks], bb, St[et], 0, 0, 0); }
                  St[et] = St[et] * dv;
                  u32x2 o; o.x = cvt_pk_bf16(St[et][0], St[et][1]); o.y = cvt_pk_bf16(St[et][2], St[et][3]);
                  *(LAS u32x2*)(SSTn + ((16 * et + fr) * LQ + 16 * w + 4 * fq) * 2) = o; } }
            __syncthreads();
        }
    }
}
__device__ __forceinline__ void hgrn_gate_phase(Frame& F, const bf16_t* O, const bf16_t* Gt, const float* ng, bf16_t* OG) {
    float gw_[16];
#pragma unroll
    for (int i = 0; i < 16; ++i) gw_[i] = ng[16 * F.lane + i];
    const int gw = F.c * NWAVES + F.wave, NGW = F.G * NWAVES;
    for (int m = gw; m < M; m += NGW) {
        const u32x4 o0 = *(const u32x4*)(O + (size_t)m * D + 16 * F.lane), o1 = *(const u32x4*)(O + (size_t)m * D + 16 * F.lane + 8);
        const u32x4 g0 = *(const u32x4*)(Gt + (size_t)m * D + 16 * F.lane), g1 = *(const u32x4*)(Gt + (size_t)m * D + 16 * F.lane + 8);
        float ov[16], gv[16];
#pragma unroll
        for (int i = 0; i < 4; ++i) { ov[2 * i] = __uint_as_float(o0[i] << 16); ov[2 * i + 1] = __uint_as_float(o0[i] & 0xffff0000u); ov[8 + 2 * i] = __uint_as_float(o1[i] << 16); ov[8 + 2 * i + 1] = __uint_as_float(o1[i] & 0xffff0000u);
            gv[2 * i] = __uint_as_float(g0[i] << 16); gv[2 * i + 1] = __uint_as_float(g0[i] & 0xffff0000u); gv[8 + 2 * i] = __uint_as_float(g1[i] << 16); gv[8 + 2 * i + 1] = __uint_as_float(g1[i] & 0xffff0000u); }
        float ss = 0.f;
#pragma unroll
        for (int i = 0; i < 16; ++i) ss += ov[i] * ov[i];
        ss += __builtin_bit_cast(float, __builtin_amdgcn_update_dpp(0, __builtin_bit_cast(int, ss), 0xB1, 0xF, 0xF, true));
        ss += __builtin_bit_cast(float, __builtin_amdgcn_update_dpp(0, __builtin_bit_cast(int, ss), 0x4E, 0xF, 0xF, true));
        ss += __builtin_bit_cast(float, __builtin_amdgcn_update_dpp(0, __builtin_bit_cast(int, ss), 0x141, 0xF, 0xF, true));
        const float rs = 1.f / sqrtf(ss * (1.f / 128.f) + RMS_EPS);
        float r[16];
#pragma unroll
        for (int i = 0; i < 16; ++i) r[i] = ov[i] * rs * gw_[i] * siluf_(gv[i]);
        u32x4 w0, w1; w0.x = cvt_pk_bf16(r[0], r[1]); w0.y = cvt_pk_bf16(r[2], r[3]); w0.z = cvt_pk_bf16(r[4], r[5]); w0.w = cvt_pk_bf16(r[6], r[7]);
        w1.x = cvt_pk_bf16(r[8], r[9]); w1.y = cvt_pk_bf16(r[10], r[11]); w1.z = cvt_pk_bf16(r[12], r[13]); w1.w = cvt_pk_bf16(r[14], r[15]);
        *(u32x4*)(OG + (size_t)m * D + 16 * F.lane) = w0; *(u32x4*)(OG + (size_t)m * D + 16 * F.lane + 8) = w1;
    }
}

__device__ __forceinline__ void dsa_norm_phase(Frame& F, const bf16_t* RAW, const float* qg, const float* kvg, const float* kig, const float* kib, bf16_t* CQ, bf16_t* CKV, bf16_t* KIDX, float* WIDX) {
    const f32x4 qgv = *(const f32x4*)(qg + 4 * F.lane), kvgv = *(const f32x4*)(kvg + 4 * F.lane); const float kg = kig[F.lane], kb = kib[F.lane];
    const int gw = F.c * NWAVES + F.wave, NGW = F.G * NWAVES;
    for (int m = gw; m < M; m += NGW) {
        const bf16_t* r = RAW + (size_t)m * DSA_IN_PAD;
        const u32x2 ar = *(const u32x2*)(r + 4 * F.lane), cr = *(const u32x2*)(r + 256 + 4 * F.lane); const float ki = bf2f(r[512 + F.lane]);
        const f32x4 a = (f32x4){__uint_as_float(ar.x << 16), __uint_as_float(ar.x & 0xffff0000u), __uint_as_float(ar.y << 16), __uint_as_float(ar.y & 0xffff0000u)};
        const f32x4 c = (f32x4){__uint_as_float(cr.x << 16), __uint_as_float(cr.x & 0xffff0000u), __uint_as_float(cr.y << 16), __uint_as_float(cr.y & 0xffff0000u)};
        const float sa = wave_sum((a[0] * a[0] + a[1] * a[1]) + (a[2] * a[2] + a[3] * a[3])), sc = wave_sum((c[0] * c[0] + c[1] * c[1]) + (c[2] * c[2] + c[3] * c[3]));
        const float ra = 1.f / sqrtf(sa * (1.f / 256.f) + RMS_EPS), rc = 1.f / sqrtf(sc * (1.f / 256.f) + RMS_EPS);
        u32x2 o; o.x = cvt_pk_bf16(a[0] * ra * qgv[0], a[1] * ra * qgv[1]); o.y = cvt_pk_bf16(a[2] * ra * qgv[2], a[3] * ra * qgv[3]); *(u32x2*)(CQ + (size_t)m * 256 + 4 * F.lane) = o;
        o.x = cvt_pk_bf16(c[0] * rc * kvgv[0], c[1] * rc * kvgv[1]); o.y = cvt_pk_bf16(c[2] * rc * kvgv[2], c[3] * rc * kvgv[3]); *(u32x2*)(CKV + (size_t)m * 256 + 4 * F.lane) = o;
        const float mu = wave_sum(ki) * (1.f / 64.f), dk = ki - mu, var = wave_sum(dk * dk) * (1.f / 64.f);
        KIDX[(size_t)m * 64 + F.lane] = f2bf(dk * (1.f / sqrtf(var + LN_EPS)) * kg + kb);
        if (F.lane < 8) WIDX[(size_t)m * 8 + F.lane] = bf2f(r[576 + F.lane]) * 0.04419417382415922f;
    }
}
__device__ __forceinline__ unsigned f2ord(float v) { const unsigned u = __float_as_uint(v); return (u & 0x80000000u) ? ~u : (u | 0x80000000u); }
template <int NR>
__device__ __forceinline__ unsigned long long topk_words(const unsigned (&key)[32], int lane) {
    unsigned long long selw = 0ull;
    unsigned prefix = 0u; bool exact = false;
    for (int bit = 31; bit >= 0; --bit) {
        const unsigned cand = prefix | (1u << bit); int cnt = 0;
#pragma unroll
        for (int r = 0; r < NR; ++r) cnt += __builtin_popcountll(__ballot(key[r] >= cand));
        if (cnt >= TOPK) { prefix = cand; if (cnt == TOPK) { exact = true; break; } }
    }
    if (exact) {
#pragma unroll
        for (int r = 0; r < NR; ++r) { const unsigned long long mk = __ballot(key[r] >= prefix); if (lane == r) selw = mk; }
    } else {
        int ngt = 0;
#pragma unroll
        for (int r = 0; r < NR; ++r) ngt += __builtin_popcountll(__ballot(key[r] > prefix));
        const int need = TOPK - ngt; int run = 0;
#pragma unroll
        for (int r = 0; r < NR; ++r) { const unsigned long long tie = __ballot(key[r] == prefix); const int rk = run + __builtin_popcountll(tie & ((1ull << lane) - 1ull));
            const unsigned long long mk = __ballot(key[r] > prefix || (key[r] == prefix && rk < need)); if (lane == r) selw = mk; run += __builtin_popcountll(tie); }
    }
    return selw;
}
__device__ __forceinline__ void dsa_index_phase(Frame& F, const bf16_t* QIDX, const bf16_t* KIDX, const float* WIDX, unsigned long long* MASK) {
    LAS float* SC = (LAS float*)F.lds;
    const int lane = F.lane, w = F.wave, fr = lane & 15, fq = lane >> 4;
    for (int i = 0;; ++i) {
        const int u = i * F.G + F.c; if (u >= BATCH * (SEQ / 16)) break;
        const int b = 2 * (u & 7) + ((u >> 3) & 1), qlo = ((u >> 4) & 15) + 16 * (u >> 9), qt = ((u >> 8) & 1) ? 127 - qlo : qlo, t0 = 16 * qt;     const size_t rb = (size_t)b * SEQ;
        bf16x8 Af[4][2][2]; float wv[4][8];
#pragma unroll
        for (int tg = 0; tg < 4; ++tg) {
#pragma unroll
            for (int hh = 0; hh < 2; ++hh)
#pragma unroll
                for (int ks = 0; ks < 2; ++ks) Af[tg][hh][ks] = *(const bf16x8*)(QIDX + (rb + t0 + 4 * tg + (fr >> 2)) * 512 + (4 * hh + (fr & 3)) * 64 + 32 * ks + 8 * fq);
            const f32x4 w0 = *(const f32x4*)(WIDX + (rb + t0 + 4 * tg + fq) * 8), w1 = *(const f32x4*)(WIDX + (rb + t0 + 4 * tg + fq) * 8 + 4);
#pragma unroll
            for (int r = 0; r < 4; ++r) { wv[tg][r] = w0[r]; wv[tg][4 + r] = w1[r]; }
        }
#define IDX_KLOAD(d0, d1, kg_) do { const int kc_ = ((kg_) <= qt) ? (kg_) : w; d0 = *(const bf16x8*)(KIDX + (rb + 16 * kc_ + fr) * 64 + 8 * fq); d1 = *(const bf16x8*)(KIDX + (rb + 16 * kc_ + fr) * 64 + 32 + 8 * fq); } while (0)
        bf16x8 nB0, nB1, pB0, pB1, qB0, qB1;
        IDX_KLOAD(nB0, nB1, w); IDX_KLOAD(pB0, pB1, w + NWAVES); IDX_KLOAD(qB0, qB1, w + 2 * NWAVES);
        for (int kg = w; kg <= qt; kg += NWAVES) {
            const bf16x8 B0 = nB0, B1 = nB1;
            nB0 = pB0; nB1 = pB1; pB0 = qB0; pB1 = qB1; IDX_KLOAD(qB0, qB1, kg + 3 * NWAVES);
#pragma unroll
            for (int tg = 0; tg < 4; ++tg) { float s = 0.f;
#pragma unroll
                for (int hh = 0; hh < 2; ++hh) { f32x4 acc = (f32x4){0.f, 0.f, 0.f, 0.f};
                    acc = __builtin_amdgcn_mfma_f32_16x16x32_bf16(Af[tg][hh][0], B0, acc, 0, 0, 0); acc = __builtin_amdgcn_mfma_f32_16x16x32_bf16(Af[tg][hh][1], B1, acc, 0, 0, 0);
#pragma unroll
                    for (int r = 0; r < 4; ++r) s += wv[tg][4 * hh + r] * fmaxf(acc[r], 0.f); }
                SC[(4 * tg + fq) * 2048 + 16 * kg + fr] = s + 0.0f; }
        }
        __syncthreads();
        for (int tq = 2 * w; tq < 2 * w + 2; ++tq) {
            const int t = t0 + tq;
            unsigned key[32];
#pragma unroll
            for (int r = 0; r < 32; ++r) { const int s = 64 * r + lane; key[r] = (s <= t) ? f2ord(SC[tq * 2048 + s]) : 0u; }
            unsigned long long selw = 0ull;
            if (t < TOPK) {
#pragma unroll
                for (int r = 0; r < 32; ++r) { const unsigned long long mk = __ballot(64 * r + lane <= t); if (lane == r) selw = mk; }
            } else if (t < 512) selw = topk_words<8>(key, lane);
            else if (t < 1024) selw = topk_words<16>(key, lane);
            else if (t < 1536) selw = topk_words<24>(key, lane);
            else selw = topk_words<32>(key, lane);
            if (lane < 32) MASK[(rb + t) * 32 + lane] = selw;
        }
        __syncthreads();
    }
}
__device__ __forceinline__ void dsa_attn_phase(Frame& F, const bf16_t* QLAT, const bf16_t* CKV, const unsigned long long* MASK, bf16_t* OLAT, unsigned char* OLAT8) {
    constexpr int TB = 32768;
    LAS unsigned char* L = F.lds;
    const int lane = F.lane, w = F.wave, fr = lane & 15, fq = lane >> 4;
    const int qq = fr >> 2, pp = lane & 3;
    const bool grpB = w >= 4;
    const int kbase = fr * 512, ysh = (fq ^ (2 * (fr & 7))) << 4;
    const int x2s = (2 * (4 * (fq & 1) + qq)) << 4;
    const int vbase = (4 * fq + qq) * 512 + (pp >> 1) * 16 + (pp & 1) * 8;
    const int drow = lane >> 5, dpc = lane & 31;
    for (int i = 0;; ++i) {
        const int u = i * F.G + F.c; if (u >= BATCH * (SEQ / 16)) break;
        const int b = 2 * (u & 7) + ((u >> 3) & 1), qlo = ((u >> 4) & 15) + 16 * (u >> 9), qt = ((u >> 8) & 1) ? 127 - qlo : qlo, t0 = 16 * qt;     const size_t rb = (size_t)b * SEQ;
        const int ntiles = (t0 + 15) / 64 + 1;
        bf16x8 Qf[8];
#pragma unroll
        for (int ks = 0; ks < 8; ++ks) Qf[ks] = *(const bf16x8*)(QLAT + (rb + t0 + fr) * 2048 + w * 256 + 32 * ks + 8 * fq);
        f32x4 Ot[16];
#pragma unroll
        for (int cb = 0; cb < 16; ++cb) Ot[cb] = (f32x4){0.f, 0.f, 0.f, 0.f};
        float mrun = -1.0e30f, lsum = 0.f;
        bf16x8 Pf[2];
#define ATT_DMA(kt_, buf_) do { _Pragma("unroll") for (int q_ = 0; q_ < 4; ++q_) { const int row_ = 2 * (4 * w + q_) + drow; \
            __builtin_amdgcn_global_load_lds((const unsigned*)(CKV + (rb + 64 * (kt_) + row_) * 256 + 8 * (dpc ^ (2 * (row_ & 7)))), (LAS unsigned*)(L + (buf_) * TB + (4 * w + q_) * 1024), 16, 0, 0); } } while (0)
#define ATT_ST(buf_) do { int ka_[8]; { const int kb_t_ = kbase + (buf_) * TB; _Pragma("unroll") for (int ks = 0; ks < 8; ++ks) ka_[ks] = kb_t_ + ((64 * ks) ^ ysh); } \
            _Pragma("unroll") for (int kb = 0; kb < 4; ++kb) S[kb] = (f32x4){0.f, 0.f, 0.f, 0.f}; \
            bf16x8 kf[2][2]; \
            _Pragma("unroll") for (int j = 0; j < 2; ++j) kf[0][j] = *(LAS bf16x8*)(L + ka_[j]); \
            _Pragma("unroll") for (int bt = 0; bt < 16; ++bt) {        \
                if (bt + 1 < 16) { _Pragma("unroll") for (int j = 0; j < 2; ++j) kf[(bt + 1) & 1][j] = *(LAS bf16x8*)(L + ka_[2 * ((bt + 1) & 3) + j] + 8192 * ((bt + 1) >> 2)); } \
                _Pragma("unroll") for (int j = 0; j < 2; ++j) S[bt >> 2] = __builtin_amdgcn_mfma_f32_16x16x32_bf16(kf[bt & 1][j], Qf[2 * (bt & 3) + j], S[bt >> 2], 0, 0, 0); \
                __builtin_amdgcn_sched_barrier(0); } } while (0)
#define ATT_SOFTMAX(mw_) do { \
            float mx = fmaxf(fmaxf(fmaxf(S[0][0], S[0][1]), fmaxf(S[0][2], S[0][3])), fmaxf(fmaxf(S[1][0], S[1][1]), fmaxf(S[1][2], S[1][3]))); \
            mx = fmaxf(mx, fmaxf(fmaxf(fmaxf(S[2][0], S[2][1]), fmaxf(S[2][2], S[2][3])), fmaxf(fmaxf(S[3][0], S[3][1]), fmaxf(S[3][2], S[3][3])))); \
            mx = fmaxf(mx, __shfl_xor(mx, 16)); mx = fmaxf(mx, __shfl_xor(mx, 32)); \
            const bool need = mx > mrun + 8.0f; \
            if (__any(need)) { const float mnew = need ? mx : mrun, alpha = fast_exp2(mrun - mnew); mrun = mnew; lsum *= alpha; \
                _Pragma("unroll") for (int cb = 0; cb < 16; ++cb) Ot[cb] = Ot[cb] * alpha; } \
            const unsigned long long mq = (mw_) >> (4 * fq); const unsigned mlo = (unsigned)mq, mhi = (unsigned)(mq >> 32); \
            _Pragma("unroll") for (int kb = 0; kb < 4; ++kb) _Pragma("unroll") for (int r = 0; r < 4; ++r) { \
                const unsigned mk = (unsigned)__builtin_amdgcn_sbfe((int)(kb < 2 ? mlo : mhi), 16 * (kb & 1) + r, 1); \
                const float pv = __uint_as_float(__float_as_uint(fast_exp2(S[kb][r] - mrun)) & mk); S[kb][r] = pv; lsum += pv; } \
            _Pragma("unroll") for (int s2 = 0; s2 < 2; ++s2) { const u32x4 pk = pack8(S[2 * s2], S[2 * s2 + 1]); Pf[s2] = __builtin_bit_cast(bf16x8, pk); } } while (0)
#define ATT_VLOAD(dst, vb_, cb_) do { const int va_ = (vb_) + ((32 * (cb_)) ^ x2s); \
            dst[0] = __builtin_amdgcn_ds_read_tr16_b64_v4i16((LAS s16x4*)(L + va_)); dst[1] = __builtin_amdgcn_ds_read_tr16_b64_v4i16((LAS s16x4*)(L + va_ + 16 * 512)); \
            dst[2] = __builtin_amdgcn_ds_read_tr16_b64_v4i16((LAS s16x4*)(L + va_ + 32 * 512)); dst[3] = __builtin_amdgcn_ds_read_tr16_b64_v4i16((LAS s16x4*)(L + va_ + 48 * 512)); } while (0)
#define ATT_PV(buf_) do { const int vb_ = vbase + (buf_) * TB; s16x4 tv[2][4]; ATT_VLOAD(tv[0], vb_, 0); \
            _Pragma("unroll") for (int cb = 0; cb < 16; ++cb) { \
                if (cb + 1 < 16) ATT_VLOAD(tv[(cb + 1) & 1], vb_, cb + 1); \
                const s16x4 a0 = tv[cb & 1][0], a1 = tv[cb & 1][1], a2 = tv[cb & 1][2], a3 = tv[cb & 1][3]; \
                const bf16x8 v0 = (bf16x8){a0[0], a0[1], a0[2], a0[3], a1[0], a1[1], a1[2], a1[3]}; \
                const bf16x8 v1 = (bf16x8){a2[0], a2[1], a2[2], a2[3], a3[0], a3[1], a3[2], a3[3]}; \
                Ot[cb] = __builtin_amdgcn_mfma_f32_16x16x32_bf16(v0, Pf[0], Ot[cb], 0, 0, 0); \
                Ot[cb] = __builtin_amdgcn_mfma_f32_16x16x32_bf16(v1, Pf[1], Ot[cb], 0, 0, 0); __builtin_amdgcn_sched_barrier(0); } } while (0)
        ATT_DMA(0, 0);
        unsigned long long mwn = MASK[(rb + t0 + fr) * 32];
        asm volatile("s_waitcnt vmcnt(0)" ::: "memory");
        __syncthreads();
        int bufc = 0;
        for (int it = 0; it < ntiles; ++it) {
            const int bufn = (bufc == 2) ? 0 : bufc + 1;
            if (it + 1 < ntiles) ATT_DMA(it + 1, bufn);
            const unsigned long long mw = mwn; mwn = MASK[(rb + t0 + fr) * 32 + ((it + 1 < ntiles) ? it + 1 : it)];
            f32x4 S[4];
            ATT_ST(bufc); ATT_SOFTMAX(mw);
            if (grpB) { asm volatile("s_waitcnt vmcnt(0)" ::: "memory"); __builtin_amdgcn_s_barrier(); asm volatile("" ::: "memory"); }
            ATT_PV(bufc);
            if (!grpB) { asm volatile("s_waitcnt vmcnt(0)" ::: "memory"); __builtin_amdgcn_s_barrier(); asm volatile("" ::: "memory"); }
            bufc = bufn;
        }
        __syncthreads();
#undef ATT_DMA
#undef ATT_ST
#undef ATT_SOFTMAX
#undef ATT_VLOAD
#undef ATT_PV
        lsum += __shfl_xor(lsum, 16); lsum += __shfl_xor(lsum, 32);
        const float inv = 1.f / lsum;
#pragma unroll
        for (int cb = 0; cb < 16; ++cb) {
            if (OLAT8) { const float i8 = inv * F8_O; *(unsigned*)(OLAT8 + (rb + t0 + fr) * 2048 + w * 256 + 16 * cb + 4 * fq) = pack4_fp8(Ot[cb][0] * i8, Ot[cb][1] * i8, Ot[cb][2] * i8, Ot[cb][3] * i8); }
            else { u32x2 o; o.x = cvt_pk_bf16(Ot[cb][0] * inv, Ot[cb][1] * inv); o.y = cvt_pk_bf16(Ot[cb][2] * inv, Ot[cb][3] * inv);
                *(u32x2*)(OLAT + (rb + t0 + fr) * 2048 + w * 256 + 16 * cb + 4 * fq) = o; } }
    }
}


__device__ __forceinline__ void dsa_norm8_phase(Frame& F, const bf16_t* RAW, const float* qg, const float* kvg, const float* kig, const float* kib, bf16_t* CQ, unsigned char* CKV8, unsigned char* CKVT8, bf16_t* KIDX, float* WIDX) {
    LAS unsigned char* T = F.lds;
    const f32x4 qgv = *(const f32x4*)(qg + 4 * F.lane), kvgv = *(const f32x4*)(kvg + 4 * F.lane); const float kg = kig[F.lane], kb = kib[F.lane];
    for (int blk = F.c; blk < M / 128; blk += F.G) {
        for (int rr = 0; rr < 16; ++rr) {
            const int rl = 16 * F.wave + rr, m = 128 * blk + rl;
            const bf16_t* r = RAW + (size_t)m * DSA_IN_PAD;
            const u32x2 ar = *(const u32x2*)(r + 4 * F.lane), cr = *(const u32x2*)(r + 256 + 4 * F.lane); const float ki = bf2f(r[512 + F.lane]);
            const f32x4 a = (f32x4){__uint_as_float(ar.x << 16), __uint_as_float(ar.x & 0xffff0000u), __uint_as_float(ar.y << 16), __uint_as_float(ar.y & 0xffff0000u)};
            const f32x4 c = (f32x4){__uint_as_float(cr.x << 16), __uint_as_float(cr.x & 0xffff0000u), __uint_as_float(cr.y << 16), __uint_as_float(cr.y & 0xffff0000u)};
            const float sa = wave_sum((a[0] * a[0] + a[1] * a[1]) + (a[2] * a[2] + a[3] * a[3])), sc = wave_sum((c[0] * c[0] + c[1] * c[1]) + (c[2] * c[2] + c[3] * c[3]));
            const float ra = 1.f / sqrtf(sa * (1.f / 256.f) + RMS_EPS), rc = F8_KV / sqrtf(sc * (1.f / 256.f) + RMS_EPS);
            u32x2 o; o.x = cvt_pk_bf16(a[0] * ra * qgv[0], a[1] * ra * qgv[1]); o.y = cvt_pk_bf16(a[2] * ra * qgv[2], a[3] * ra * qgv[3]); *(u32x2*)(CQ + (size_t)m * 256 + 4 * F.lane) = o;
            const unsigned c8 = pack4_fp8(c[0] * rc * kvgv[0], c[1] * rc * kvgv[1], c[2] * rc * kvgv[2], c[3] * rc * kvgv[3]);
            *(unsigned*)(CKV8 + (size_t)m * 256 + 4 * F.lane) = c8; *(LAS unsigned*)(T + rl * 260 + 4 * F.lane) = c8;
            const float mu = wave_sum(ki) * (1.f / 64.f), dk = ki - mu, var = wave_sum(dk * dk) * (1.f / 64.f);
            KIDX[(size_t)m * 64 + F.lane] = f2bf(dk * (1.f / sqrtf(var + LN_EPS)) * kg + kb);
            if (F.lane < 8) WIDX[(size_t)m * 8 + F.lane] = bf2f(r[576 + F.lane]) * 0.04419417382415922f;
        }
        __syncthreads();
        { const int dim = F.tid >> 1, half = F.tid & 1;
          unsigned char* dst = CKVT8 + (size_t)blk * 32768 + dim * 128 + 64 * half;
#pragma unroll
          for (int q4 = 0; q4 < 4; ++q4) { u32x4 o;
#pragma unroll
              for (int dd = 0; dd < 4; ++dd) { const int d = 4 * q4 + dd, key0 = 16 * (d & 7) + 4 * (2 * half + (d >> 3));
                  LAS unsigned char* tp = T + key0 * 260 + dim;
                  o[dd] = (unsigned)tp[0] | ((unsigned)tp[260] << 8) | ((unsigned)tp[520] << 16) | ((unsigned)tp[780] << 24); }
              *(u32x4*)(dst + 16 * q4) = o; } }
        __syncthreads();
    }
}
__device__ __forceinline__ void dsa_attn8_phase(Frame& F, const unsigned char* QLAT8, const unsigned char* CKV8, const unsigned char* CKVT8, const unsigned long long* MASK, unsigned char* OLAT8) {
    constexpr int TB = 65536, VOFF = 32768;
    LAS unsigned char* L = F.lds;
    const int lane = F.lane, w = F.wave, fr = lane & 15, fq = lane >> 4;
    const int gsw = ((fr >> 1) & 1) | (((fr >> 3) & 1) << 2);
    const int ka00 = fr * 256 + (((2 * fq) ^ fr) << 4), ka01 = fr * 256 + (((2 * fq + 1) ^ fr) << 4), ka10 = fr * 256 + (((8 + 2 * fq) ^ fr) << 4), ka11 = fr * 256 + (((9 + 2 * fq) ^ fr) << 4);
    const int va0 = VOFF + fr * 128 + (((2 * fq) ^ gsw) << 4), va1 = VOFF + fr * 128 + (((2 * fq + 1) ^ gsw) << 4);
    for (int i = 0;; ++i) {
        const int u = i * F.G + F.c; if (u >= BATCH * (SEQ / 16)) break;
        const int b = 2 * (u & 7) + ((u >> 3) & 1), qlo = ((u >> 4) & 15) + 16 * (u >> 9), qt = ((u >> 8) & 1) ? 127 - qlo : qlo, t0 = 16 * qt;     const size_t rb = (size_t)b * SEQ;
        const int ntiles = (t0 + 15) / 128 + 1;
        int lu = lane; asm volatile("" : "+v"(lu)); const int fru = lu & 15, fqu = lu >> 4;
        v8i32 Q8[2];
#pragma unroll
        for (int h = 0; h < 2; ++h) { const unsigned char* qp = QLAT8 + (rb + t0 + fru) * 2048 + w * 256 + 128 * h + 32 * fqu;
            Q8[h] = __builtin_shufflevector(*(const v4i32*)qp, *(const v4i32*)(qp + 16), 0, 1, 2, 3, 4, 5, 6, 7); }
        f32x4 Ot[16];
#pragma unroll
        for (int cb = 0; cb < 16; ++cb) Ot[cb] = (f32x4){0.f, 0.f, 0.f, 0.f};
        float mrun = 0.f; bool seen = false; f32x4 negm = (f32x4){0.f, 0.f, 0.f, 0.f}, Ls = (f32x4){0.f, 0.f, 0.f, 0.f};
        const v8i32 ONES8 = (v8i32){0x38383838, 0x38383838, 0x38383838, 0x38383838, 0x38383838, 0x38383838, 0x38383838, 0x38383838};
#define ATT_DMA(kt_, buf_) do { int ln_ = lane; asm volatile("" : "+v"(ln_)); const unsigned char* kp_ = CKV8 + (rb + 128 * (kt_) + 16 * w) * 256; const unsigned char* vp_ = CKVT8 + ((rb >> 7) + (kt_)) * 32768 + w * 4096; \
        _Pragma("unroll") for (int q_ = 0; q_ < 4; ++q_) { const int ins_ = 4 * w + q_, rl_ = 4 * q_ + (ln_ >> 4), g_ = ((ln_ >> 4) & 1) | ((q_ & 1) << 2); \
            __builtin_amdgcn_global_load_lds((const unsigned*)(kp_ + (unsigned)(rl_ * 256 + 16 * ((ln_ & 15) ^ rl_))), (LAS unsigned*)(L + (buf_) * TB + ins_ * 1024), 16, 0, 0); \
            __builtin_amdgcn_global_load_lds((const unsigned*)(vp_ + (unsigned)(q_ * 1024 + (ln_ >> 3) * 128 + 16 * ((ln_ & 7) ^ g_))), (LAS unsigned*)(L + (buf_) * TB + VOFF + ins_ * 1024), 16, 0, 0); } } while (0)
#define ATT_KLOAD(dst, kb_o_) do { dst[0] = *(LAS v4i32*)(L + ka00 + (kb_o_)); dst[1] = *(LAS v4i32*)(L + ka01 + (kb_o_)); dst[2] = *(LAS v4i32*)(L + ka10 + (kb_o_)); dst[3] = *(LAS v4i32*)(L + ka11 + (kb_o_)); } while (0)
#define ATT_VLOAD(dst, vb_o_) do { dst[0] = *(LAS v4i32*)(L + va0 + (vb_o_)); dst[1] = *(LAS v4i32*)(L + va1 + (vb_o_)); } while (0)
        ATT_DMA(0, 0);
        const unsigned long long* mrow = MASK + (rb + t0 + fru) * 32;
        u32x4 mwn = *(const u32x4*)mrow;
        asm volatile("s_waitcnt vmcnt(0)" ::: "memory");
        __syncthreads();
        int bufc = 0;
        for (int it = 0; it < ntiles; ++it) {
            const int bo = bufc * TB;
            if (it + 1 < ntiles) ATT_DMA(it + 1, bufc ^ 1);
            const u32x4 mw = mwn; mwn = *(const u32x4*)(mrow + 2 * ((it + 1 < ntiles) ? it + 1 : it));
            f32x4 S[8];
            { v4i32 kf[2][4]; ATT_KLOAD(kf[0], bo);
#pragma unroll
              for (int kb = 0; kb < 8; ++kb) {
                  if (kb + 1 < 8) ATT_KLOAD(kf[(kb + 1) & 1], bo + 4096 * (kb + 1));
                  f32x4 s = __builtin_amdgcn_mfma_scale_f32_16x16x128_f8f6f4(__builtin_shufflevector(kf[kb & 1][0], kf[kb & 1][1], 0, 1, 2, 3, 4, 5, 6, 7), Q8[0], negm, 0, 0, 0, SC_S, 0, 0x7f7f7f7f);
                  s = __builtin_amdgcn_mfma_scale_f32_16x16x128_f8f6f4(__builtin_shufflevector(kf[kb & 1][2], kf[kb & 1][3], 0, 1, 2, 3, 4, 5, 6, 7), Q8[1], s, 0, 0, 0, SC_S, 0, 0x7f7f7f7f);
                  S[kb] = s; __builtin_amdgcn_sched_barrier(0); } }
            const unsigned m0 = mw[0] >> (4 * fq), m1 = mw[1] >> (4 * fq), m2 = mw[2] >> (4 * fq), m3 = mw[3] >> (4 * fq);
            { float mx = __builtin_fmaxf(__builtin_fmaxf(S[0][0], S[0][1]), __builtin_fmaxf(S[0][2], S[0][3]));
#pragma unroll
              for (int kb = 1; kb < 8; ++kb) { mx = __builtin_fmaxf(__builtin_fmaxf(S[kb][0], S[kb][1]), mx); mx = __builtin_fmaxf(__builtin_fmaxf(S[kb][2], S[kb][3]), mx); }
              if (__any(!seen || mx > 8.0f)) {
                  float mm = -3.0e38f;
#pragma unroll
                  for (int kb = 0; kb < 8; ++kb) { const unsigned mw_ = (kb >> 1) == 0 ? m0 : (kb >> 1) == 1 ? m1 : (kb >> 1) == 2 ? m2 : m3;
#pragma unroll
                      for (int r = 0; r < 4; ++r) mm = ((mw_ >> (16 * (kb & 1) + r)) & 1u) ? __builtin_fmaxf(mm, S[kb][r]) : mm; }
                  mm = fmaxf(mm, __shfl_xor(mm, 16)); mm = fmaxf(mm, __shfl_xor(mm, 32));
                  const bool has = mm > -1.0e38f, rebase = has && (!seen || mm > 8.0f);
                  const float delta = rebase ? mm : 0.f, alpha = (rebase && seen) ? fast_exp2(-delta) : 1.f;
                  seen = seen || has;
                  mrun += delta; negm = (f32x4){-mrun, -mrun, -mrun, -mrun}; Ls = Ls * alpha;
#pragma unroll
                  for (int cb = 0; cb < 16; ++cb) Ot[cb] = Ot[cb] * alpha;
#pragma unroll
                  for (int kb = 0; kb < 8; ++kb) S[kb] = S[kb] - delta; } }
            v8i32 P8;
            {
#pragma unroll
              for (int kb = 0; kb < 8; ++kb) { const unsigned mm = (kb >> 1) == 0 ? m0 : (kb >> 1) == 1 ? m1 : (kb >> 1) == 2 ? m2 : m3;
                  int pk = 0; pk = __builtin_amdgcn_cvt_pk_fp8_f32(fast_exp2(S[kb][0]), fast_exp2(S[kb][1]), pk, false); pk = __builtin_amdgcn_cvt_pk_fp8_f32(fast_exp2(S[kb][2]), fast_exp2(S[kb][3]), pk, true);
                  const unsigned y = (((mm >> (16 * (kb & 1))) & 0xFu) * 0x204081u) & 0x01010101u;
                  P8[kb] = pk & (int)((y << 8) - y); } }
            Ls = __builtin_amdgcn_mfma_scale_f32_16x16x128_f8f6f4(ONES8, P8, Ls, 0, 0, 0, 0x7f7f7f7f, 0, 0x7f7f7f7f);
            { v4i32 vf[2][2]; ATT_VLOAD(vf[0], bo);
#pragma unroll
              for (int cb = 0; cb < 16; ++cb) {
                  if (cb + 1 < 16) ATT_VLOAD(vf[(cb + 1) & 1], bo + 2048 * (cb + 1));
                  Ot[cb] = __builtin_amdgcn_mfma_scale_f32_16x16x128_f8f6f4(__builtin_shufflevector(vf[cb & 1][0], vf[cb & 1][1], 0, 1, 2, 3, 4, 5, 6, 7), P8, Ot[cb], 0, 0, 0, SC_V, 0, 0x7f7f7f7f);
                  __builtin_amdgcn_sched_barrier(0); } }
            asm volatile("s_waitcnt vmcnt(0)" ::: "memory"); __builtin_amdgcn_s_barrier(); asm volatile("" ::: "memory");
            bufc ^= 1;
        }
#undef ATT_DMA
#undef ATT_KLOAD
#undef ATT_VLOAD
        const float i8 = F8_O / Ls[0];
#pragma unroll
        for (int cb = 0; cb < 16; ++cb)
            *(unsigned*)(OLAT8 + (rb + t0 + fru) * 2048 + w * 256 + 16 * cb + 4 * fqu) = pack4_fp8(Ot[cb][0] * i8, Ot[cb][1] * i8, Ot[cb][2] * i8, Ot[cb][3] * i8);
    }
}

constexpr int PH_PER_PAIR = 18, N_PHASES = 1 + 2 * PH_PER_PAIR;

__global__ void __launch_bounds__(NTHREADS, 2) fwd_kernel(Params p) {
    extern __shared__ __attribute__((aligned(16))) unsigned char lds_raw[];
    Frame F;
    F.lds = (LAS unsigned char*)lds_raw;
    F.tid = threadIdx.x; F.lane = F.tid & 63; F.wave = __builtin_amdgcn_readfirstlane(F.tid >> 6);
    F.G = gridDim.x; F.c = blockIdx.x;
    unsigned char* ws = p.ws;
    F.ctl = (unsigned*)(ws + WS_CTL);
    for (int u = F.tid; u < (LDS_BYTES - LDSCTL_OFF) / 4; u += NTHREADS) ((LAS unsigned*)(F.lds + LDSCTL_OFF))[u] = 0u;
    __syncthreads();
    const bool one_launch = (p.ph_hi - p.ph_lo) > 1;
    XcdBarrier bar; bar.bar = F.ctl + CW_BAR; bar.x = 0; bar.st = nullptr;
    if (one_launch) bar = xcd_barrier_post(F.ctl + CW_BAR, (volatile LAS unsigned*)(F.lds + MISC_OFF) + 8);
    const int lo = p.ph_lo, hi = p.ph_hi;
#define REFRESH() do { int t_ = threadIdx.x; asm volatile("" : "+v"(t_)); F.tid = t_; F.lane = t_ & 63; F.wave = __builtin_amdgcn_readfirstlane(t_ >> 6); } while (0)
#ifndef DBLMASK
#define DBLMASK 0u
#endif
#define REP(b) for (int rep_ = 0; rep_ < 1 + (int)((DBLMASK >> (b)) & 1u); ++rep_)
#define IN(k) (lo <= (k) && (k) < hi)
#ifndef MK_BARTIME
#define MK_BARTIME 0
#endif
    unsigned long long bt_acc = 0ull;
#if MK_BARTIME
#define SEAM(k) do { if (IN(k) && IN((k) + 1)) { const unsigned long long t0_ = __builtin_amdgcn_s_memrealtime(); xcd_barrier(bar); bt_acc += __builtin_amdgcn_s_memrealtime() - t0_; } } while (0)
#else
#ifndef MK_DBLSEAM
#define MK_DBLSEAM 0
#endif
#define SEAM(k) do { if (IN(k) && IN((k) + 1)) { xcd_barrier(bar); if (MK_DBLSEAM) xcd_barrier(bar); } } while (0)
#endif

    bf16_t* XB = (bf16_t*)(ws + WS_XB); bf16_t* Y = (bf16_t*)(ws + WS_Y);
    unsigned char* A = ws + WS_A; bf16_t* Hb = (bf16_t*)(ws + WS_H);

    if (IN(0)) REP(31) { REFRESH(); p0_prologue(F, p); } SEAM(0);

    for (int j = 0; j < 2; ++j) {
        const int pb = 1 + j * PH_PER_PAIR;
        const int layerA = 2 * j, layerB = 2 * j + 1;
        if (IN(pb + 0)) REP(0) {
            Gemm g{XB, (const bf16_t*)(ws + WS_W_HGIN) + (size_t)j * 4 * D * D, D}; StaticOrder S; S.init(M, 4 * D, F.G, F.c);
            EpiHgIn E{(bf16_t*)(A + A_HQ)};
            gemm_phase(F.lds, g, S, E);
        } SEAM(pb + 0);
        if (IN(pb + 1)) REP(1) { REFRESH(); hgrn_phase(F, (const bf16_t*)(A + A_HQ), (const bf16_t*)(A + A_HF), (const bf16_t*)(A + A_HV), INP(IN_HGLB), j, (bf16_t*)(A + A_HO)); } SEAM(pb + 1);
        if (IN(pb + 2)) REP(2) { REFRESH(); hgrn_gate_phase(F, (const bf16_t*)(A + A_HO), (const bf16_t*)(A + A_HG), INP(IN_HGNG) + (size_t)j * D, (bf16_t*)(A + A_HOG)); } SEAM(pb + 2);
        if (IN(pb + 3)) REP(3) {
            Gemm g{(const bf16_t*)(A + A_HOG), (const bf16_t*)(ws + WS_W_HGOUT) + (size_t)j * D * D, D}; StaticOrder S; S.init(M, D, F.G, F.c);
            EpiRes E{XB, Y}; gemm_phase(F.lds, g, S, E);
        } SEAM(pb + 3);
        if (IN(pb + 4)) REP(4) { REFRESH(); ln_phase(F, Y, INP(IN_LNG) + (size_t)(layerA * 2 + 0) * D, INP(IN_LNB) + (size_t)(layerA * 2 + 0) * D, XB, (MK_FFN_FP8 == 2) ? ws + WS_XB8 : nullptr); } SEAM(pb + 4);
        if (IN(pb + 5)) REP(5) {
#if MK_FFN_FP8 == 2
            Gemm g{(const bf16_t*)(ws + WS_XB8), (const bf16_t*)(ws + WS_W_FGU + (size_t)j * 2 * DFF * D), D / 2, SC_UP}; StaticOrder S; S.init(M, 2 * DFF, F.G, F.c);
            EpiSwiglu8 E{(unsigned char*)Hb}; gemm_phase_gather<true, true>(F.lds, g, S, E, nullptr);
#elif MK_FFN_FP8 == 1
            Gemm g{XB, (const bf16_t*)(ws + WS_W_FGU) + (size_t)j * 2 * DFF * D, D}; StaticOrder S; S.init(M, 2 * DFF, F.G, F.c);
            EpiSwiglu8 E{(unsigned char*)Hb}; gemm_phase(F.lds, g, S, E);
#else
            Gemm g{XB, (const bf16_t*)(ws + WS_W_FGU) + (size_t)j * 2 * DFF * D, D}; StaticOrder S; S.init(M, 2 * DFF, F.G, F.c);
            EpiSwiglu E{Hb}; gemm_phase(F.lds, g, S, E);
#endif
        } SEAM(pb + 5);
        if (IN(pb + 6)) REP(6) {
#if MK_FFN_FP8 >= 1
            Gemm g{Hb, (const bf16_t*)(ws + WS_W_FDN + (size_t)j * D * DFF), DFF / 2, SC_DN}; StaticOrder S; S.init(M, D, F.G, F.c);
            EpiRes E{XB, Y}; gemm_phase_gather<true, true>(F.lds, g, S, E, nullptr);
#else
            Gemm g{Hb, (const bf16_t*)(ws + WS_W_FDN) + (size_t)j * D * DFF, DFF}; StaticOrder S; S.init(M, D, F.G, F.c);
            EpiRes E{XB, Y}; gemm_phase(F.lds, g, S, E);
#endif
        } SEAM(pb + 6);
        if (IN(pb + 7)) REP(7) { REFRESH(); ln_phase(F, Y, INP(IN_LNG) + (size_t)(layerA * 2 + 1) * D, INP(IN_LNB) + (size_t)(layerA * 2 + 1) * D, XB, nullptr); } SEAM(pb + 7);
        if (IN(pb + 8)) REP(8) {
            Gemm g{XB, (const bf16_t*)(ws + WS_W_DIN) + (size_t)j * DSA_IN_PAD * D, D}; StaticOrder S; S.init(M, DSA_IN_PAD, F.G, F.c);
            EpiBf16 E{(bf16_t*)(A + A_RAW), DSA_IN_PAD}; gemm_phase(F.lds, g, S, E);
        } SEAM(pb + 8);
#if MK_ATT_FP8
        if (IN(pb + 9)) REP(9) { REFRESH(); dsa_norm8_phase(F, (const bf16_t*)(A + A_RAW), INP(IN_DQNG) + (size_t)j * QR, INP(IN_DKVNG) + (size_t)j * KVR, INP(IN_DKIG) + (size_t)j * IDXD, INP(IN_DKIB) + (size_t)j * IDXD,
                                          (bf16_t*)(A + A_CQ), A + A_CKV, A + A_CKV + 8 * MiB, (bf16_t*)(A + A_KIDX), (float*)(A + A_WIDX)); } SEAM(pb + 9);
#else
        if (IN(pb + 9)) REP(9) { REFRESH(); dsa_norm_phase(F, (const bf16_t*)(A + A_RAW), INP(IN_DQNG) + (size_t)j * QR, INP(IN_DKVNG) + (size_t)j * KVR, INP(IN_DKIG) + (size_t)j * IDXD, INP(IN_DKIB) + (size_t)j * IDXD,
                                         (bf16_t*)(A + A_CQ), (bf16_t*)(A + A_CKV), (bf16_t*)(A + A_KIDX), (float*)(A + A_WIDX)); } SEAM(pb + 9);
#endif
        if (IN(pb + 10)) REP(10) {
            Gemm g{(const bf16_t*)(A + A_CQ), (const bf16_t*)(ws + WS_W_DQ) + (size_t)j * 2560 * QR, QR}; StaticOrder S; S.init(M, 2560, F.G, F.c);
#if MK_ATT_FP8
            EpiQ8 E{A + A_QLAT, (bf16_t*)(A + A_QIDX)}; gemm_phase(F.lds, g, S, E);
#else
            EpiQ E{(bf16_t*)(A + A_QLAT), (bf16_t*)(A + A_QIDX)}; gemm_phase(F.lds, g, S, E);
#endif
        } SEAM(pb + 10);
        if (IN(pb + 11)) REP(11) { REFRESH(); dsa_index_phase(F, (const bf16_t*)(A + A_QIDX), (const bf16_t*)(A + A_KIDX), (const float*)(A + A_WIDX), (unsigned long long*)(A + A_MASK)); } SEAM(pb + 11);
#if MK_ATT_FP8
        if (IN(pb + 12)) REP(12) { REFRESH(); dsa_attn8_phase(F, A + A_QLAT, A + A_CKV, A + A_CKV + 8 * MiB, (const unsigned long long*)(A + A_MASK), A + A_OLAT); } SEAM(pb + 12);
#else
        if (IN(pb + 12)) REP(12) { REFRESH(); dsa_attn_phase(F, (const bf16_t*)(A + A_QLAT), (const bf16_t*)(A + A_CKV), (const unsigned long long*)(A + A_MASK), (bf16_t*)(A + A_OLAT), MK_B6_FP8 ? A + A_OLAT : nullptr); } SEAM(pb + 12);
#endif
        if (IN(pb + 13)) REP(13) {
#if MK_B6_FP8
            Gemm g{(const bf16_t*)(A + A_OLAT), (const bf16_t*)(ws + WS_W_DO + (size_t)j * D * 2048), 1024, SC_DO}; StaticOrder S; S.init(M, D, F.G, F.c);
            EpiRes E{XB, Y}; gemm_phase_gather<true, true>(F.lds, g, S, E, nullptr);
#else
            Gemm g{(const bf16_t*)(A + A_OLAT), (const bf16_t*)(ws + WS_W_DO) + (size_t)j * D * 2048, 2048}; StaticOrder S; S.init(M, D, F.G, F.c);
            EpiRes E{XB, Y}; gemm_phase(F.lds, g, S, E);
#endif
        } SEAM(pb + 13);
        if (IN(pb + 14)) REP(14) { REFRESH(); ln_router_phase(F, Y, INP(IN_LNG) + (size_t)(layerB * 2 + 0) * D, INP(IN_LNB) + (size_t)(layerB * 2 + 0) * D, INP(IN_MR) + (size_t)j * D * NEXP, XB, MK_MOE_FP8 ? ws + WS_XB8 : nullptr,
                                           (int*)(A + A_EIDX), (int*)(A + A_POS), (int*)(A + A_TOK), (float*)(A + A_GW), F.ctl + CW_MOE + 64 * j); } SEAM(pb + 14);
        if (IN(pb + 15)) REP(15) {
#if MK_MOE_FP8
            Gemm g{(const bf16_t*)(ws + WS_XB8), (const bf16_t*)(ws + WS_W_MGU8 + (size_t)j * NEXP * 2 * DFF * D), D / 2, SC_UP}; MoeOrder S; S.init(F.ctl + CW_MOE + 64 * j, 2 * DFF / BM, F.G, F.c);
            EpiSwiglu8 E{(unsigned char*)Hb}; gemm_phase_gather<true>(F.lds, g, S, E, (const int*)(A + A_TOK));
#else
            Gemm g{XB, (const bf16_t*)(ws + WS_W_MGU) + (size_t)j * NEXP * 2 * DFF * D, D}; MoeOrder S; S.init(F.ctl + CW_MOE + 64 * j, 2 * DFF / BM, F.G, F.c);
            EpiSwiglu E{Hb}; gemm_phase_gather(F.lds, g, S, E, (const int*)(A + A_TOK));
#endif
        } SEAM(pb + 15);
        if (IN(pb + 16)) REP(16) {
#if MK_MOE_FP8
            Gemm g{Hb, (const bf16_t*)(ws + WS_W_MDN8 + (size_t)j * NEXP * D * DFF), DFF / 2, SC_DN}; MoeOrder S; S.init(F.ctl + CW_MOE + 64 * j, D / BM, F.G, F.c);
            EpiMoeDn E{(bf16_t*)(A + A_OUTM), (const float*)(A + A_GW)}; gemm_phase_gather<true, true>(F.lds, g, S, E, nullptr);
#else
            Gemm g{Hb, (const bf16_t*)(ws + WS_W_MDN) + (size_t)j * NEXP * D * DFF, DFF}; MoeOrder S; S.init(F.ctl + CW_MOE + 64 * j, D / BM, F.G, F.c);
            EpiMoeDn E{(bf16_t*)(A + A_OUTM), (const float*)(A + A_GW)}; gemm_phase(F.lds, g, S, E);
#endif
        } SEAM(pb + 16);
        if (IN(pb + 17)) REP(17) { REFRESH(); ln_moe_phase(F, XB, (const bf16_t*)(A + A_OUTM), (const int*)(A + A_EIDX), (const int*)(A + A_POS), F.ctl + CW_MOE + 64 * j,
                                        INP(IN_LNG) + (size_t)(layerB * 2 + 1) * D, INP(IN_LNB) + (size_t)(layerB * 2 + 1) * D, XB, (j == 1) ? p.out : nullptr); } SEAM(pb + 17);
    }
#if MK_BARTIME
    if (one_launch) {
        if (blockIdx.x == 0 && threadIdx.x == 0) __hip_atomic_store(F.ctl + 3000, (unsigned)bt_acc, __ATOMIC_RELAXED, __HIP_MEMORY_SCOPE_AGENT);
        xcd_barrier(bar);
        const float cval = 2.0f + 4.0f * (float)__hip_atomic_load(F.ctl + 3000, __ATOMIC_RELAXED, __HIP_MEMORY_SCOPE_AGENT) * 1e-5f;
        for (size_t i = (size_t)blockIdx.x * NTHREADS + threadIdx.x; i < (size_t)M * D; i += (size_t)gridDim.x * NTHREADS) p.out[i] = cval;
    }
#endif
}


#if MK_DEBUG_SCAN
__global__ void scan_kernel(const void* ptr, size_t n, int is_bf16, unsigned code, unsigned* flag, const unsigned* gcnt, size_t row_elems) {
    size_t nn = n;
    if (gcnt) { unsigned t = 0; for (int e = 0; e < 8; ++e) t += (gcnt[e] + 255u) >> 8; nn = (size_t)t * 256 * row_elems; }
    bool bad = false;
    for (size_t i = (size_t)blockIdx.x * blockDim.x + threadIdx.x; i < nn; i += (size_t)gridDim.x * blockDim.x) {
        if (is_bf16) { const unsigned short v = ((const unsigned short*)ptr)[i]; bad |= (v & 0x7f80u) == 0x7f80u; }
        else { const unsigned v = ((const unsigned*)ptr)[i]; bad |= (v & 0x7f800000u) == 0x7f800000u; }
    }
    if (bad) atomicMin(flag, code);
}
__global__ void fin_kernel(float* out, size_t n, const unsigned* flag) {
    const unsigned f = *flag; if (f == 0xffffffffu) return;
    const float cval = (float)f + 0.25f * (float)flag[64];
    for (size_t i = (size_t)blockIdx.x * blockDim.x + threadIdx.x; i < n; i += (size_t)gridDim.x * blockDim.x) out[i] = cval;
}

__global__ void chk_a1_kernel(const float* x, const float* w, const bf16_t* Q, const float* FP, unsigned code, unsigned* flag) {
    const unsigned id = blockIdx.x * blockDim.x + threadIdx.x;
    unsigned hsh = id * 2654435761u + 12345u; hsh ^= hsh >> 13; hsh *= 0x5bd1e995u; hsh ^= hsh >> 15;
    const int row = hsh % M, col = (hsh >> 15) % (4 * D);
    float ref = 0.f; for (int k = 0; k < D; ++k) ref += x[(size_t)row * D + k] * w[(size_t)k * 4 * D + col];
    const int part = col >> 10, cc = col & 1023;
    float got;
    if (part == 1) got = FP[(size_t)row * D + cc];
    else got = bf2f(Q[(size_t)(part == 0 ? 0 : part - 1) * M * D + (size_t)row * D + cc]);
    if (!(fabsf(got - ref) < 0.08f)) atomicMin(flag, code);
}
__global__ void chk_hgrn_kernel(const bf16_t* Q, const float* FP, const bf16_t* V, const bf16_t* O, unsigned* bits) {
    const int sample = blockIdx.x, lane = threadIdx.x;
    const int b = sample % BATCH, h = (sample / BATCH) % HG_H, e = (sample * 37 + 11) % 128;
    float s0 = 0.f, s1 = 0.f; unsigned r = 0;
    for (int t = 0; t < 128; ++t) {
        const size_t base = ((size_t)b * SEQ + t) * D + h * 128;
        const float f0 = sigmoidf_(FP[base + lane]), f1 = sigmoidf_(FP[base + lane + 64]);
        const float v = bf2f(V[base + e]);
        s0 = f0 * s0 + (1.f - f0) * v; s1 = f1 * s1 + (1.f - f1) * v;
        const float o = wave_sum(bf2f(Q[base + lane]) * s0 + bf2f(Q[base + lane + 64]) * s1);
        const unsigned short gb = O[base + e]; const float got = bf2f(gb);
        const bool nf = (gb & 0x7f80u) == 0x7f80u;
        if (t < 64) { if (nf) r |= 4u; else if (!(fabsf(got - o) < 0.05f + 0.03f * fabsf(o))) r |= 2u; }
        else if (nf) r |= 1u;
    }
    if (r && lane == 0) atomicOr(bits, r);
}
__global__ void flaginit_kernel(unsigned* flag) { *flag = 0xffffffffu; }
#endif

extern "C" void kernel_launch(void* const* d_in, const int* in_sizes, int n_in, void* d_out, int out_size, void* d_ws, size_t ws_size, hipStream_t stream) {
    static int grid = 0;
    if (grid == 0) {
        if (n_in != 22 || out_size != M * D || ws_size < WS_END) { fprintf(stderr, "kernel_launch: unexpected problem (n_in %d out %d ws %zu need %zu)\n", n_in, out_size, ws_size, (size_t)WS_END); grid = -1; return; }
        int dev = 0, cus = 0, per_cu = 0;
        if (hipGetDevice(&dev) != hipSuccess || hipDeviceGetAttribute(&cus, hipDeviceAttributeMultiprocessorCount, dev) != hipSuccess) { grid = -1; return; }
        if (hipFuncSetAttribute((const void*)fwd_kernel, hipFuncAttributeMaxDynamicSharedMemorySize, LDS_BYTES) != hipSuccess) { fprintf(stderr, "kernel_launch: hipFuncSetAttribute failed\n"); grid = -1; return; }
        if (hipOccupancyMaxActiveBlocksPerMultiprocessor(&per_cu, (const void*)fwd_kernel, NTHREADS, LDS_BYTES) != hipSuccess || per_cu < 1) fprintf(stderr, "kernel_launch: occupancy query reports %d\n", per_cu);
        grid = cus;
    }
    if (grid <= 0) return;
    (void)hipMemsetAsync((char*)d_ws + WS_CTL, 0, CTL_ZERO_BYTES, stream);
    Params p{};
    for (int i = 0; i < 22; ++i) p.in[i] = (const float*)d_in[i];
    p.out = (float*)d_out; p.ws = (unsigned char*)d_ws;
#if MK_N_LAUNCHES == 1
    p.ph_lo = 0; p.ph_hi = N_PHASES;
    hipLaunchKernelGGL(fwd_kernel, dim3(grid), dim3(NTHREADS), LDS_BYTES, stream, p);
#ifdef MK_EXTRA_PHASES
    { const int extra[] = {MK_EXTRA_PHASES}; for (int r = 0; r < MK_EXTRA_REPS; ++r) for (int k : extra) { p.ph_lo = k; p.ph_hi = k + 1; hipLaunchKernelGGL(fwd_kernel, dim3(grid), dim3(NTHREADS), LDS_BYTES, stream, p); } }
#endif
#else
#if MK_DEBUG_SCAN
    unsigned char* ws = (unsigned char*)d_ws; unsigned* flag = (unsigned*)(ws + WS_CTL) + 2048;
    hipLaunchKernelGGL(flaginit_kernel, dim3(1), dim3(1), 0, stream, flag);
#define SCAN(ptr, n, isbf, k) hipLaunchKernelGGL(scan_kernel, dim3(1024), dim3(256), 0, stream, (const void*)(ptr), (size_t)(n), isbf, (unsigned)((k) + 1), flag, (const unsigned*)nullptr, (size_t)0)
#define SCANM(ptr, re, isbf, k, jj) hipLaunchKernelGGL(scan_kernel, dim3(1024), dim3(256), 0, stream, (const void*)(ptr), (size_t)0, isbf, (unsigned)((k) + 1), flag, (const unsigned*)(ws + WS_CTL) + CW_MOE + 64 * (jj), (size_t)(re))
#endif
    for (int k = 0; k < N_PHASES; ++k) { p.ph_lo = k; p.ph_hi = k + 1; hipLaunchKernelGGL(fwd_kernel, dim3(grid), dim3(NTHREADS), LDS_BYTES, stream, p);
#if MK_DEBUG_SCAN
        unsigned char* A = ws + WS_A; const size_t MD = (size_t)M * D;
        if (k == 0) { SCAN(ws + WS_W_HGIN, 2 * 4 * MD / M * D, 1, k); SCAN(ws + WS_W_HGOUT, 2 * (size_t)D * D, 1, k); SCAN(ws + WS_W_FGU, 2 * (size_t)2 * DFF * D, 1, k); SCAN(ws + WS_W_FDN, 2 * (size_t)DFF * D, 1, k);
            SCAN(ws + WS_W_DIN, 2 * (size_t)DSA_IN_PAD * D, 1, k); SCAN(ws + WS_W_DQ, 2 * (size_t)2560 * QR, 1, k); SCAN(ws + WS_W_DO, 2 * (size_t)D * 2048, 1, k);
            SCAN(ws + WS_W_MGU, 16 * (size_t)2 * DFF * D, 1, k); SCAN(ws + WS_W_MDN, 16 * (size_t)DFF * D, 1, k); SCAN(ws + WS_XB, MD, 1, k); }
        else { const int l = (k - 1) % PH_PER_PAIR, jj = (k - 1) / PH_PER_PAIR;
            switch (l) {
            case 0: SCAN(A + A_HQ, 3 * MD, 1, k); SCAN(A + A_HF, MD, 0, k);
                if (jj == 0) hipLaunchKernelGGL(chk_a1_kernel, dim3(64), dim3(256), 0, stream, (const float*)d_in[IN_X], (const float*)d_in[IN_HGWIN], (const bf16_t*)(A + A_HQ), (const float*)(A + A_HF), (unsigned)(k + 1), flag);
                break;
            case 1: SCAN(A + A_HO, MD, 1, k);
                if (jj == 0) hipLaunchKernelGGL(chk_hgrn_kernel, dim3(256), dim3(64), 0, stream, (const bf16_t*)(A + A_HQ), (const float*)(A + A_HF), (const bf16_t*)(A + A_HV), (const bf16_t*)(A + A_HO), flag + 64);
                break;
            case 2: SCAN(A + A_HOG, MD, 1, k); break;
            case 3: case 6: case 13: SCAN(ws + WS_Y, MD, 1, k); break;
            case 4: case 7: case 14: SCAN(ws + WS_XB, MD, 1, k); break;
            case 5: SCAN(ws + WS_H, (size_t)M * DFF, 1, k); break;
            case 8: SCAN(A + A_RAW, (size_t)M * DSA_IN_PAD, 0, k); break;
            case 9: SCAN(A + A_CQ, (size_t)M * 256, 1, k); SCAN(A + A_CKV, (size_t)M * 256, 1, k); SCAN(A + A_KIDX, (size_t)M * 64, 1, k); SCAN(A + A_WIDX, (size_t)M * 8, 0, k); break;
            case 10: SCAN(A + A_QLAT, (size_t)M * 2048, 1, k); SCAN(A + A_QIDX, (size_t)M * 512, 1, k); break;
            case 12: SCAN(A + A_OLAT, (size_t)M * 2048, 1, k); break;
            case 16: SCANM(ws + WS_H, DFF, 1, k, jj); break;
            case 17: SCANM(A + A_OUTM, D, 0, k, jj); break;
            case 18: if (jj == 0) SCAN(ws + WS_XB, MD, 1, k); else SCAN(d_out, MD, 0, k); break;
            default: break; } }
#endif
    }
#if MK_DEBUG_SCAN
    hipLaunchKernelGGL(fin_kernel, dim3(1024), dim3(256), 0, stream, (float*)d_out, (size_t)M * D, (const unsigned*)flag);
#endif
#endif
}
```
